# Optimizing an MI355X kernel written in HIP

```python
import jax, jax.numpy as jnp
from jax import lax
import numpy as np

D_MODEL = 1024
BATCH = 8
SEQ = 4096
DEPTH = 1

N_MEM = 256
A_HEADS = 8
HEAD_DIM = 64
A_WIDTH = A_HEADS * HEAD_DIM
IDX_HEADS = 4
IDX_DIM = 64
TOPK_MAX = 256
Q_BLOCK = 128
B_GROUPS = 8
B_WIDTH = D_MODEL - A_WIDTH
CONV_B_WIDTH = 31
MIX_WIDTH = A_WIDTH + B_WIDTH
ROPE_THETA = 500000.0
ROT_DIM = HEAD_DIM // 4
CROSS_HEADS = 4
CROSS_HEAD_DIM = D_MODEL // CROSS_HEADS
D_FF = 2816
FFN_CONV_WIDTH = 3
EPS = 1e-6
IN_SPLITS = (A_WIDTH, HEAD_DIM, HEAD_DIM, IDX_HEADS * IDX_DIM, IDX_DIM, IDX_HEADS, 2 * B_WIDTH)
IN_COLS = sum(IN_SPLITS)

kernel_name = 'hybrid_dsa_conformer_parallel_block'


def rmsnorm(x, g):
    xf = x.astype(jnp.float32)
    y = xf * lax.rsqrt(jnp.mean(xf * xf, axis=-1, keepdims=True) + EPS)
    return (y * g.astype(jnp.float32)).astype(x.dtype)


def layernorm(x, g, b):
    xf = x.astype(jnp.float32)
    mu = jnp.mean(xf, axis=-1, keepdims=True)
    var = jnp.mean(jnp.square(xf - mu), axis=-1, keepdims=True)
    y = (xf - mu) * lax.rsqrt(var + EPS)
    return (y * g.astype(jnp.float32) + b.astype(jnp.float32)).astype(x.dtype)


def causal_dwconv(x, w, b):
    width, ch = w.shape
    y = lax.conv_general_dilated(
        x, w.astype(x.dtype)[:, None, :], window_strides=(1,),
        padding=[(width - 1, 0)], dimension_numbers=('NWC', 'WIO', 'NWC'),
        feature_group_count=ch)
    return y + b.astype(x.dtype)


def rope_tables(positions):
    freqs = ROPE_THETA ** (-jnp.arange(0, ROT_DIM, 2, dtype=jnp.float32) / ROT_DIM)
    ang = positions.astype(jnp.float32)[:, :, None, None] * freqs
    return jnp.cos(ang), jnp.sin(ang)


def partial_rope(x, cos, sin):
    xr = x[..., :ROT_DIM].astype(jnp.float32)
    x1, x2 = xr[..., :ROT_DIM // 2], xr[..., ROT_DIM // 2:]
    rot = jnp.concatenate([x1 * cos - x2 * sin, x2 * cos + x1 * sin], axis=-1)
    return jnp.concatenate([rot.astype(x.dtype), x[..., ROT_DIM:]], axis=-1)


def dsa_attention(q, k, v, qi, ki, wi):
    bsz, seq = q.shape[0], q.shape[1]
    nb = seq // Q_BLOCK
    topk = min(TOPK_MAX, seq // 4)
    qi = qi * (IDX_DIM ** -0.5)
    wi = wi * (IDX_HEADS ** -0.5)
    gather = jax.vmap(lambda a, i: a[i])
    key_pos = jnp.arange(seq)

    def block(args):
        bi, qb, qib, wib = args
        t = bi * Q_BLOCK + jnp.arange(Q_BLOCK)
        causal = key_pos[None, :] <= t[:, None]
        rel = jax.nn.relu(jnp.einsum('bqhd,bsd->bqhs', qib, ki).astype(jnp.float32))
        score = jnp.einsum('bqh,bqhs->bqs', wib.astype(jnp.float32), rel)
        score = jnp.where(causal[None], score, -jnp.inf)
        _, sel = lax.top_k(score, topk)
        k_sel = gather(k, sel)
        v_sel = gather(v, sel)
        valid = sel <= t[None, :, None]
        logits = jnp.einsum('bqhd,bqkd->bqhk', qb, k_sel).astype(jnp.float32) * (HEAD_DIM ** -0.5)
        logits = jnp.where(valid[:, :, None, :], logits, -jnp.inf)
        p = jax.nn.softmax(logits, axis=-1).astype(v.dtype)
        return jnp.einsum('bqhk,bqkd->bqhd', p, v_sel)

    to_blocks = lambda a: a.reshape(bsz, nb, Q_BLOCK, *a.shape[2:]).swapaxes(0, 1)
    out = lax.map(block, (jnp.arange(nb), to_blocks(q), to_blocks(qi), to_blocks(wi)))
    return out.swapaxes(0, 1).reshape(bsz, seq, A_WIDTH)


def hybrid_layer(x, mem, cos, sin, norm_mix_g, w_in, w_out, conv_b_w, conv_b_b, ln_b_g, ln_b_b,
                 norm_cross_g, norm_mem_g, w_q_cross, w_k_cross, w_v_cross, w_o_cross,
                 norm_ffn_g, w_gate, w_up, ffn_conv_w, ffn_conv_b, w_down):
    bsz, seq, _ = x.shape
    h = rmsnorm(x, norm_mix_g)
    proj = h @ w_in
    cuts = [int(c) for c in np.cumsum(IN_SPLITS)[:-1]]
    q, k, v, qi, ki, wi, glu = jnp.split(proj, cuts, axis=-1)
    q = partial_rope(q.reshape(bsz, seq, A_HEADS, HEAD_DIM), cos, sin)
    k = partial_rope(k[:, :, None, :], cos, sin)[:, :, 0]
    qi = partial_rope(qi.reshape(bsz, seq, IDX_HEADS, IDX_DIM), cos, sin)
    ki = partial_rope(ki[:, :, None, :], cos, sin)[:, :, 0]
    a_out = dsa_attention(q, k, v, qi, ki, wi)
    ga, gg = jnp.split(glu, 2, axis=-1)
    u = ga * jax.nn.sigmoid(gg)
    u = causal_dwconv(u, conv_b_w, conv_b_b)
    b_out = jax.nn.silu(layernorm(u, ln_b_g, ln_b_b))
    x = x + jnp.concatenate([a_out, b_out], axis=-1) @ w_out
    hq = rmsnorm(x, norm_cross_g)
    m = rmsnorm(mem, norm_mem_g)
    qc = (hq @ w_q_cross).reshape(bsz, seq, CROSS_HEADS, CROSS_HEAD_DIM)
    kc = (m @ w_k_cross).reshape(bsz, -1, CROSS_HEADS, CROSS_HEAD_DIM)
    vc = (m @ w_v_cross).reshape(bsz, -1, CROSS_HEADS, CROSS_HEAD_DIM)
    logits = jnp.einsum('bshd,bnhd->bhsn', qc, kc).astype(jnp.float32) * (CROSS_HEAD_DIM ** -0.5)
    p = jax.nn.softmax(logits, axis=-1).astype(vc.dtype)
    oc = jnp.einsum('bhsn,bnhd->bshd', p, vc).reshape(bsz, seq, D_MODEL)
    x = x + oc @ w_o_cross
    hf = rmsnorm(x, norm_ffn_g)
    g = causal_dwconv(hf @ w_gate, ffn_conv_w, ffn_conv_b)
    x = x + (jax.nn.silu(g) * (hf @ w_up)) @ w_down
    return x


def setup_inputs(seed: int = 0) -> dict:
    key = jax.random.key(seed)
    ks = jax.random.split(key, 24)
    f32 = jnp.float32
    nrm = lambda k, shape, scale: jax.random.normal(k, shape, f32) * scale
    gain = lambda k, shape: 1.0 + 0.02 * jax.random.normal(k, shape, f32)
    L = DEPTH
    offsets = jax.random.randint(ks[2], (BATCH, 1), 0, 2048, dtype=jnp.int32)
    positions = offsets + jnp.arange(SEQ, dtype=jnp.int32)[None, :]
    return {
        'x': nrm(ks[0], (BATCH, SEQ, D_MODEL), 1.0),
        'mem': nrm(ks[1], (BATCH, N_MEM, D_MODEL), 1.0),
        'positions': positions,
        'norm_mix_g': gain(ks[3], (L, D_MODEL)),
        'w_in': nrm(ks[4], (L, D_MODEL, IN_COLS), D_MODEL ** -0.5),
        'w_out': nrm(ks[5], (L, MIX_WIDTH, D_MODEL), MIX_WIDTH ** -0.5),
        'conv_b_w': nrm(ks[6], (L, CONV_B_WIDTH, B_WIDTH), CONV_B_WIDTH ** -0.5),
        'conv_b_b': nrm(ks[7], (L, B_WIDTH), 0.02),
        'ln_b_g': gain(ks[8], (L, B_WIDTH)),
        'ln_b_b': nrm(ks[9], (L, B_WIDTH), 0.02),
        'norm_cross_g': gain(ks[10], (L, D_MODEL)),
        'norm_mem_g': gain(ks[11], (L, D_MODEL)),
        'w_q_cross': nrm(ks[12], (L, D_MODEL, D_MODEL), D_MODEL ** -0.5),
        'w_k_cross': nrm(ks[13], (L, D_MODEL, D_MODEL), D_MODEL ** -0.5),
        'w_v_cross': nrm(ks[14], (L, D_MODEL, D_MODEL), D_MODEL ** -0.5),
        'w_o_cross': nrm(ks[15], (L, D_MODEL, D_MODEL), D_MODEL ** -0.5),
        'norm_ffn_g': gain(ks[16], (L, D_MODEL)),
        'w_gate': nrm(ks[17], (L, D_MODEL, D_FF), D_MODEL ** -0.5),
        'w_up': nrm(ks[18], (L, D_MODEL, D_FF), D_MODEL ** -0.5),
        'ffn_conv_w': nrm(ks[19], (L, FFN_CONV_WIDTH, D_FF), FFN_CONV_WIDTH ** -0.5),
        'ffn_conv_b': nrm(ks[20], (L, D_FF), 0.02),
        'w_down': nrm(ks[21], (L, D_FF, D_MODEL), D_FF ** -0.5),
        'norm_final_g': gain(ks[22], (D_MODEL,)),
    }


def reference(x, mem, positions, norm_mix_g, w_in, w_out, conv_b_w, conv_b_b, ln_b_g, ln_b_b,
              norm_cross_g, norm_mem_g, w_q_cross, w_k_cross, w_v_cross, w_o_cross,
              norm_ffn_g, w_gate, w_up, ffn_conv_w, ffn_conv_b, w_down, norm_final_g):
    cos, sin = rope_tables(positions)
    for l in range(DEPTH):
        x = hybrid_layer(x, mem, cos, sin, norm_mix_g[l], w_in[l], w_out[l], conv_b_w[l], conv_b_b[l],
                         ln_b_g[l], ln_b_b[l], norm_cross_g[l], norm_mem_g[l], w_q_cross[l], w_k_cross[l],
                         w_v_cross[l], w_o_cross[l], norm_ffn_g[l], w_gate[l], w_up[l], ffn_conv_w[l],
                         ffn_conv_b[l], w_down[l])
    return rmsnorm(x, norm_final_g)
```

```cpp
#include <hip/hip_runtime.h>
#include <cstdio>
#include <cstdint>
#include <cmath>
namespace pg8 {
#define PG8_LAS __attribute__((address_space(3)))
typedef unsigned short bf16_t;
typedef short bf16x8 __attribute__((ext_vector_type(8)));
typedef float f32x4 __attribute__((ext_vector_type(4)));
typedef unsigned u32x4 __attribute__((ext_vector_type(4)));
constexpr int BM = 256, BK = 64, HALF = 128, HTB = HALF * BK * 2  , STAGE_BYTES = 8 * HTB, NXCD = 8, WGM = 8;

__host__ __device__ __forceinline__ int lds_byte(int r, int c) { const int st = (r >> 4) * 2 + (c >> 5), rr = r & 15, cc = c & 31, ob = rr * 64 + cc * 2; return st * 1024 + (ob ^ (((ob >> 9) & 1) << 5)); }
__host__ __device__ __forceinline__ void stage_rc(int b, int& R, int& C) { const int st = b / 1024, sb = b % 1024, swz = sb ^ (((sb >> 9) & 1) << 5); R = (st >> 1) * 16 + swz / 64; C = (st & 1) * 32 + (swz % 64) / 2; }
__host__ __device__ __forceinline__ int perm32(int rho) { const int n = rho >> 4, i = rho & 15; return 8 * (i >> 2) + 4 * n + (i & 3); }

struct Unit { int pm, pn; };
struct Gemm { const bf16_t* A; const bf16_t* Bt; int M, N, K; };

struct StaticOrder {
    int nM, nN, nwg, G, c;
    __host__ __device__ void init(int M, int N, int G_, int c_) { nM = M / BM; nN = N / BM; nwg = nM * nN; G = G_; c = c_; }
    __host__ __device__ bool next(int i, Unit& u) const {
        const long L = (long)i * G + c; if (L >= nwg) return false;
        int wgid = (int)L; { const int q = nwg / NXCD, r = nwg % NXCD, xcd = wgid % NXCD, off = wgid / NXCD; wgid = (xcd < r ? xcd * (q + 1) : r * (q + 1) + (xcd - r) * q) + off; }
        const int nig = WGM * nN, gid = wgid / nig, fm = gid * WGM, gsz = (nM - fm) < WGM ? (nM - fm) : WGM;
        u.pm = fm + ((wgid % nig) % gsz); u.pn = (wgid % nig) / gsz; return true;
    }
    __device__ __forceinline__ void a_ready(const Unit&) const {}
    __device__ __forceinline__ void done(const Unit&) const {}
};
__device__ __forceinline__ unsigned cvt_pk_bf16(float lo, float hi) { unsigned r; asm volatile("v_cvt_pk_bf16_f32 %0, %1, %2" : "=v"(r) : "v"(lo), "v"(hi)); return r; }
template <class Epi, class Sched, bool ALIGN_EPI = false, bool SP2 = false>
__device__ __forceinline__ void gemm_phase(PG8_LAS unsigned char* lds, const Gemm g, const Sched& S, const Epi& E) {
    const int tid = threadIdx.x, wid = __builtin_amdgcn_readfirstlane(tid >> 6), lane = tid & 63, wr = wid >> 2, wc = wid & 3, fr = lane & 15, fq = lane >> 4;
    const int K = g.K, nt = K / BK;
    unsigned voffA[2], voffB[2];
#pragma unroll
    for (int i = 0; i < 2; ++i) { int R, C; stage_rc(tid * 16 + i * 8192, R, C); const int Rb = Epi::PERM ? ((R & ~31) + perm32(R & 31)) : R;
        voffA[i] = (unsigned)(R * K + C) * 2u; voffB[i] = (unsigned)(Rb * K + C) * 2u; }
    const size_t kstep = (size_t)(BK * 2);
    const size_t hstep = (size_t)HALF * K * 2;
    const size_t tstep = 2 * hstep;
    const unsigned ldsw = (unsigned)wid * 1024u;
    const int aoff = lds_byte(wr * 64 + fr, fq * 8), boff = lds_byte(wc * 32 + fr, fq * 8);
#define PG8_SA(b, h) (((b) * 2 + (h)) * HTB)
#define PG8_SB(b, h) ((4 + (b) * 2 + (h)) * HTB)
#define PG8_STAGE(bufoff, gbase, voff) do { _Pragma("unroll") for (int _i = 0; _i < 2; ++_i) \
        __builtin_amdgcn_global_load_lds((const unsigned*)((const char*)(gbase) + (voff)[_i]), (PG8_LAS unsigned*)(lds + (bufoff) + ldsw + _i * 8192), 16, 0, 0); } while (0)
#define PG8_LDA(dst, b, h) do { _Pragma("unroll") for (int m = 0; m < 4; ++m) _Pragma("unroll") for (int k = 0; k < 2; ++k) dst[m][k] = *(const PG8_LAS bf16x8*)(lds + PG8_SA(b, h) + aoff + m * 2048 + k * 1024); } while (0)
#define PG8_LDB(dst, b, h) do { _Pragma("unroll") for (int n = 0; n < 2; ++n) _Pragma("unroll") for (int k = 0; k < 2; ++k) dst[n][k] = *(const PG8_LAS bf16x8*)(lds + PG8_SB(b, h) + boff + n * 2048 + k * 1024); } while (0)
#define PG8_MMA(ai, bj, At, Bt) do { __builtin_amdgcn_s_setprio(1); _Pragma("unroll") for (int m = 0; m < 4; ++m) _Pragma("unroll") for (int n = 0; n < 2; ++n) _Pragma("unroll") for (int k = 0; k < 2; ++k) \
        acc[ai][bj][m][n] = __builtin_amdgcn_mfma_f32_16x16x32_bf16(Bt[n][k], At[m][k], acc[ai][bj][m][n], 0, 0, 0); __builtin_amdgcn_s_setprio(0); } while (0)
#define PG8_WAIT_V(n) asm volatile("s_waitcnt vmcnt(" #n ")" ::: "memory")
#define PG8_WAIT_L(n) asm volatile("s_waitcnt lgkmcnt(" #n ")" ::: "memory")
#define PG8_BAR __builtin_amdgcn_s_barrier()
#define PG8_SCHED __builtin_amdgcn_sched_barrier(0)
    Unit cur, nxt; int ui = 0;
    if (!S.next(0, cur)) return;
    f32x4 acc[2][2][4][2];
#pragma unroll
    for (int a = 0; a < 2; ++a)
#pragma unroll
        for (int b = 0; b < 2; ++b)
#pragma unroll
            for (int m = 0; m < 4; ++m)
#pragma unroll
                for (int n = 0; n < 2; ++n) acc[a][b][m][n] = (f32x4){0.f, 0.f, 0.f, 0.f};
    bf16x8 At[4][2], B0[2][2], B1[2][2];
    const char* cA = (const char*)g.A + (size_t)cur.pm * tstep; const char* cB = (const char*)g.Bt + (size_t)cur.pn * tstep;
    S.a_ready(cur);
    if constexpr (SP2) {
        PG8_STAGE(PG8_SB(0, 0), cB, voffB); PG8_STAGE(PG8_SB(0, 1), cB + hstep, voffB); PG8_STAGE(PG8_SA(0, 0), cA, voffA); PG8_STAGE(PG8_SA(0, 1), cA + hstep, voffA);
        if (wr == 1) PG8_BAR;
        PG8_WAIT_V(2); PG8_BAR;
        PG8_STAGE(PG8_SB(1, 0), cB + kstep, voffB); PG8_STAGE(PG8_SA(1, 0), cA + kstep, voffA); PG8_STAGE(PG8_SB(1, 1), cB + hstep + kstep, voffB);
        PG8_WAIT_V(6); PG8_BAR;
    } else {
        PG8_STAGE(PG8_SB(0, 0), cB, voffB); PG8_STAGE(PG8_SA(0, 0), cA, voffA); PG8_STAGE(PG8_SB(0, 1), cB + hstep, voffB); PG8_STAGE(PG8_SA(0, 1), cA + hstep, voffA);
        if (wr == 1) PG8_BAR;
        PG8_WAIT_V(4); PG8_BAR;
        PG8_STAGE(PG8_SB(1, 0), cB + kstep, voffB); PG8_STAGE(PG8_SA(1, 0), cA + kstep, voffA); PG8_STAGE(PG8_SB(1, 1), cB + hstep + kstep, voffB);
        PG8_WAIT_V(6); PG8_BAR;
    }
    for (;;) {
        const bool has_next = S.next(ui + 1, nxt);
        const char* nA = has_next ? (const char*)g.A + (size_t)nxt.pm * tstep : cA; const char* nB = has_next ? (const char*)g.Bt + (size_t)nxt.pn * tstep : cB;
        for (int t = 0; t < nt; t += 2) {
            const bool last = (t == nt - 2);
            const char* a1 = cA + (size_t)(t + 1) * kstep;
            const char* a2 = last ? nA : cA + (size_t)(t + 2) * kstep; const char* b2 = last ? nB : cB + (size_t)(t + 2) * kstep;
            const char* a3 = a2 + kstep; const char* b3 = b2 + kstep;
            if (last && has_next) S.a_ready(nxt);
            if constexpr (SP2) {
            PG8_LDB(B0, 0, 0); PG8_LDB(B1, 0, 1); PG8_SCHED; PG8_LDA(At, 0, 0); PG8_STAGE(PG8_SA(1, 1), a1 + hstep, voffA);
            PG8_WAIT_V(8); PG8_WAIT_L(0); PG8_BAR; PG8_MMA(0, 0, At, B0); PG8_MMA(0, 1, At, B1); PG8_BAR; PG8_SCHED;
            PG8_LDA(At, 0, 1); PG8_STAGE(PG8_SB(0, 0), b2, voffB); PG8_STAGE(PG8_SB(0, 1), b2 + hstep, voffB); PG8_STAGE(PG8_SA(0, 0), a2, voffA);
            PG8_WAIT_V(8); PG8_WAIT_L(0); PG8_BAR; PG8_MMA(1, 0, At, B0); PG8_MMA(1, 1, At, B1); PG8_BAR; PG8_SCHED;
            PG8_LDB(B0, 1, 0); PG8_LDB(B1, 1, 1); PG8_SCHED; PG8_LDA(At, 1, 0); PG8_STAGE(PG8_SA(0, 1), a2 + hstep, voffA);
            PG8_WAIT_V(8); PG8_WAIT_L(0); PG8_BAR; PG8_MMA(0, 0, At, B0); PG8_MMA(0, 1, At, B1); PG8_BAR; PG8_SCHED;
            PG8_LDA(At, 1, 1); PG8_STAGE(PG8_SB(1, 0), b3, voffB); PG8_STAGE(PG8_SB(1, 1), b3 + hstep, voffB); PG8_STAGE(PG8_SA(1, 0), a3, voffA);
            PG8_WAIT_V(8); PG8_WAIT_L(0); PG8_BAR; PG8_MMA(1, 0, At, B0); PG8_MMA(1, 1, At, B1); PG8_BAR; PG8_SCHED;
            } else {
            PG8_LDB(B0, 0, 0); PG8_SCHED; PG8_LDA(At, 0, 0); PG8_STAGE(PG8_SA(1, 1), a1 + hstep, voffA);
            PG8_WAIT_L(8); PG8_BAR; PG8_WAIT_L(0); PG8_MMA(0, 0, At, B0); PG8_BAR; PG8_SCHED;
            PG8_LDB(B1, 0, 1); PG8_STAGE(PG8_SB(0, 0), b2, voffB);
            PG8_BAR; PG8_WAIT_L(0); PG8_MMA(0, 1, At, B1); PG8_BAR;
            PG8_LDA(At, 0, 1); PG8_STAGE(PG8_SA(0, 0), a2, voffA);
            PG8_BAR; PG8_WAIT_L(0); PG8_MMA(1, 0, At, B0); PG8_BAR; PG8_SCHED;
            PG8_STAGE(PG8_SB(0, 1), b2 + hstep, voffB);
            PG8_WAIT_V(6); PG8_BAR; PG8_MMA(1, 1, At, B1); PG8_BAR;
            PG8_LDB(B0, 1, 0); PG8_SCHED; PG8_LDA(At, 1, 0); PG8_STAGE(PG8_SA(0, 1), a2 + hstep, voffA);
            PG8_WAIT_L(8); PG8_BAR; PG8_WAIT_L(0); PG8_MMA(0, 0, At, B0); PG8_BAR; PG8_SCHED;
            PG8_LDB(B1, 1, 1); PG8_STAGE(PG8_SB(1, 0), b3, voffB);
            PG8_BAR; PG8_WAIT_L(0); PG8_MMA(0, 1, At, B1); PG8_BAR;
            PG8_LDA(At, 1, 1); PG8_STAGE(PG8_SA(1, 0), a3, voffA);
            PG8_BAR; PG8_WAIT_L(0); PG8_MMA(1, 0, At, B0); PG8_BAR; PG8_SCHED;
            PG8_STAGE(PG8_SB(1, 1), b3 + hstep, voffB);
            PG8_WAIT_V(6); PG8_BAR; PG8_MMA(1, 1, At, B1); PG8_BAR;
            }
        }
        if constexpr (ALIGN_EPI) { if (wr == 0) PG8_BAR; }
        if constexpr (!Epi::AFTER_DRAIN) { E(acc, cur, wr, wc, fr, fq); S.done(cur); }
        if (!has_next) break;
#pragma unroll
        for (int a = 0; a < 2; ++a)
#pragma unroll
            for (int b = 0; b < 2; ++b)
#pragma unroll
                for (int m = 0; m < 4; ++m)
#pragma unroll
                    for (int n = 0; n < 2; ++n) acc[a][b][m][n] = (f32x4){0.f, 0.f, 0.f, 0.f};
        cur = nxt; cA = nA; cB = nB; ++ui;
        if constexpr (ALIGN_EPI) { if (wr == 1) PG8_BAR; }
    }
    PG8_WAIT_V(0);
    if constexpr (!ALIGN_EPI) { if (wr == 0) PG8_BAR; }
    PG8_BAR;
    if constexpr (Epi::AFTER_DRAIN) { E.fused(acc, cur, wr, wc, fr, fq, lds, wid, lane); S.done(cur); }
#undef PG8_SA
#undef PG8_SB
#undef PG8_STAGE
#undef PG8_LDA
#undef PG8_LDB
#undef PG8_MMA
#undef PG8_WAIT_V
#undef PG8_WAIT_L
#undef PG8_BAR
#undef PG8_SCHED
}
}

constexpr int BATCH = 8, SEQ = 4096, DM = 1024, MTOK = BATCH * SEQ;
constexpr int NMEM = 256, MMEM = BATCH * NMEM;
constexpr int AW = 512, HD = 64, NH = 8, IH = 4, TOPK = 256;
constexpr int INC = 1988, INP = 2048;
constexpr int DFF = 2816;
constexpr float EPS = 1e-6f;
#define LAS __attribute__((address_space(3)))
typedef unsigned short bf16_t;
typedef float f32x4 __attribute__((ext_vector_type(4)));
typedef unsigned u32x4 __attribute__((ext_vector_type(4)));
typedef unsigned u32x2 __attribute__((ext_vector_type(2)));

__device__ __forceinline__ float bf2f(bf16_t v) { return __uint_as_float((unsigned)v << 16); }
__device__ __forceinline__ bf16_t f2bf(float f) { unsigned u = __float_as_uint(f); return (bf16_t)((u + 0x7fffu + ((u >> 16) & 1u)) >> 16); }
__device__ __forceinline__ float wave_sum(float v) {
#pragma unroll
    for (int o = 1; o < 64; o <<= 1) v += __shfl_xor(v, o);
    return v;
}
__device__ __forceinline__ float wave_max(float v) {
#pragma unroll
    for (int o = 1; o < 64; o <<= 1) v = fmaxf(v, __shfl_xor(v, o));
    return v;
}
__device__ __forceinline__ float silu_f(float v) { return v / (1.f + __expf(-v)); }

struct EpiStore {
    static constexpr bool PERM = false, AFTER_DRAIN = false;
    float* outf; bf16_t* outb; const float* res; int ldc;
    __device__ __forceinline__ void operator()(const pg8::f32x4 (&acc)[2][2][4][2], const pg8::Unit& u, int wr, int wc, int fr, int fq) const {
        const int col0 = u.pn * 256 + wc * 32 + 4 * fq;
#pragma unroll
        for (int ai = 0; ai < 2; ++ai)
#pragma unroll
            for (int m = 0; m < 4; ++m) {
                const size_t row = (size_t)(u.pm * 256 + ai * 128 + wr * 64 + m * 16 + fr);
#pragma unroll
                for (int bj = 0; bj < 2; ++bj)
#pragma unroll
                    for (int n = 0; n < 2; ++n) {
                        const size_t off = row * ldc + col0 + bj * 128 + n * 16;
                        pg8::f32x4 v = acc[ai][bj][m][n];
                        if (res) { const pg8::f32x4 r = *(const pg8::f32x4*)(res + off); v = v + r; }
                        if (outf) *(pg8::f32x4*)(outf + off) = v;
                        if (outb) { u32x2 w; w.x = (unsigned)f2bf(v[0]) | ((unsigned)f2bf(v[1]) << 16); w.y = (unsigned)f2bf(v[2]) | ((unsigned)f2bf(v[3]) << 16); *(u32x2*)(outb + off) = w; }
                    }
            }
    }
};
struct GemmArgs { const bf16_t* A; const bf16_t* Bt; float* outf; bf16_t* outb; const float* res; int M, N, K, ldc; };
__global__ void __launch_bounds__(512, 2) gemm_k(GemmArgs a) {
    extern __shared__ __attribute__((aligned(16))) unsigned char lds_raw[];
    pg8::Gemm g{a.A, a.Bt, a.M, a.N, a.K};
    pg8::StaticOrder S; S.init(a.M, a.N, (int)gridDim.x, (int)blockIdx.x);
    EpiStore E{a.outf, a.outb, a.res, a.ldc};
    pg8::gemm_phase<EpiStore, pg8::StaticOrder, true, true>((LAS unsigned char*)lds_raw, g, S, E);
}

__global__ void wt_k(const float* __restrict__ W, int K, int N, bf16_t* __restrict__ WT, int n_off) {
    __shared__ float t[32][33];
    const int k0 = blockIdx.y * 32, n0 = blockIdx.x * 32, tx = threadIdx.x & 31, ty = threadIdx.x >> 5;
    for (int i = ty; i < 32; i += 8) { const int k = k0 + i, n = n0 + tx; t[i][tx] = (k < K && n < N) ? W[(size_t)k * N + n] : 0.f; }
    __syncthreads();
    for (int i = ty; i < 32; i += 8) { const int n = n0 + i, k = k0 + tx; if (n < N && k < K) WT[(size_t)(n_off + n) * K + k] = f2bf(t[tx][i]); }
}

__global__ void rmsnorm_bf16_k(const float* __restrict__ x, const float* __restrict__ g, bf16_t* __restrict__ out, int rows) {
    const int lane = threadIdx.x & 63, row = blockIdx.x * (blockDim.x >> 6) + (threadIdx.x >> 6);
    if (row >= rows) return;
    const f32x4* xr = (const f32x4*)(x + (size_t)row * DM) + lane; const f32x4* gr = (const f32x4*)g + lane;
    f32x4 v[4]; float s = 0.f;
#pragma unroll
    for (int j = 0; j < 4; ++j) { v[j] = xr[64 * j]; s += (v[j].x * v[j].x + v[j].y * v[j].y) + (v[j].z * v[j].z + v[j].w * v[j].w); }
    const float rstd = 1.f / sqrtf(wave_sum(s) * (1.f / DM) + EPS);
    u32x2* o = (u32x2*)(out + (size_t)row * DM) + lane;
#pragma unroll
    for (int j = 0; j < 4; ++j) { const f32x4 gg = gr[64 * j]; u32x2 w;
        w.x = (unsigned)f2bf(v[j].x * rstd * gg.x) | ((unsigned)f2bf(v[j].y * rstd * gg.y) << 16);
        w.y = (unsigned)f2bf(v[j].z * rstd * gg.z) | ((unsigned)f2bf(v[j].w * rstd * gg.w) << 16); o[64 * j] = w; }
}
__global__ void rmsnorm_f32_k(float* __restrict__ x, const float* __restrict__ g, int rows) {
    const int lane = threadIdx.x & 63, row = blockIdx.x * (blockDim.x >> 6) + (threadIdx.x >> 6);
    if (row >= rows) return;
    f32x4* xr = (f32x4*)(x + (size_t)row * DM) + lane; const f32x4* gr = (const f32x4*)g + lane;
    f32x4 v[4]; float s = 0.f;
#pragma unroll
    for (int j = 0; j < 4; ++j) { v[j] = xr[64 * j]; s += (v[j].x * v[j].x + v[j].y * v[j].y) + (v[j].z * v[j].z + v[j].w * v[j].w); }
    const float rstd = 1.f / sqrtf(wave_sum(s) * (1.f / DM) + EPS);
#pragma unroll
    for (int j = 0; j < 4; ++j) { const f32x4 gg = gr[64 * j]; xr[64 * j] = v[j] * rstd * gg; }
}

__device__ __forceinline__ float rope_val(const float* p, int base, int d, const float* cs, const float* sn) {
    if (d < 8) return p[base + d] * cs[d] - p[base + d + 8] * sn[d];
    if (d < 16) return p[base + d] * cs[d - 8] + p[base + d - 8] * sn[d - 8];
    return p[base + d];
}
__global__ void split_rope_k(const float* __restrict__ proj, const int* __restrict__ positions, bf16_t* Q, bf16_t* Kb, bf16_t* Vb, bf16_t* QI, bf16_t* KI, float* WI, bf16_t* U) {
    __shared__ float cs[8], sn[8]; __shared__ float p[INP];
    const int row = blockIdx.x, tid = threadIdx.x;
    for (int c = tid; c < INP; c += 256) p[c] = proj[(size_t)row * INP + c];
    if (tid < 8) { const float freq = (float)pow(500000.0, -0.125 * (double)tid); const float ang = (float)positions[row] * freq; cs[tid] = (float)cos((double)ang); sn[tid] = (float)sin((double)ang); }
    __syncthreads();
    for (int c = tid; c < 512; c += 256) Q[(size_t)row * 512 + c] = f2bf(rope_val(p, (c >> 6) * 64, c & 63, cs, sn));
    if (tid < 64) Kb[(size_t)row * 64 + tid] = f2bf(rope_val(p, 512, tid, cs, sn));
    else if (tid < 128) Vb[(size_t)row * 64 + tid - 64] = f2bf(p[576 + tid - 64]);
    else if (tid < 192) KI[(size_t)row * 64 + tid - 128] = f2bf(rope_val(p, 896, tid - 128, cs, sn));
    else if (tid < 196) WI[(size_t)row * 4 + tid - 192] = p[960 + tid - 192] * 0.5f;
    QI[(size_t)row * 256 + tid] = f2bf(rope_val(p, 640 + (tid >> 6) * 64, tid & 63, cs, sn) * 0.125f);
    for (int c = tid; c < 512; c += 256) { const float ga = p[964 + c], gg = p[1476 + c]; U[(size_t)row * 512 + c] = f2bf(ga / (1.f + __expf(-gg))); }
}

__device__ __forceinline__ unsigned fkey(float s) { unsigned u = __float_as_uint(s); if ((u << 1) == 0u) u = 0u; return (u & 0x80000000u) ? ~u : (u | 0x80000000u); }
__global__ void __launch_bounds__(256) topk_naive_k(const bf16_t* __restrict__ QI, const bf16_t* __restrict__ KI, const float* __restrict__ WI, unsigned short* __restrict__ SEL) {
    __shared__ float qs[256]; __shared__ unsigned key[SEQ]; __shared__ unsigned cnt; __shared__ unsigned scan[256];
    const int row = blockIdx.x, tid = threadIdx.x, b = row / SEQ, t = row % SEQ, n = t + 1;
    unsigned short* sel = SEL + (size_t)row * TOPK;
    if (n <= TOPK) { if (tid < n) sel[tid] = (unsigned short)tid; return; }
    qs[tid] = bf2f(QI[(size_t)row * 256 + tid]);
    const float w0 = WI[(size_t)row * 4 + 0], w1 = WI[(size_t)row * 4 + 1], w2 = WI[(size_t)row * 4 + 2], w3 = WI[(size_t)row * 4 + 3];
    __syncthreads();
    for (int s = tid; s < n; s += 256) {
        const u32x4* kp = (const u32x4*)(KI + ((size_t)b * SEQ + s) * 64);
        float a0 = 0.f, a1 = 0.f, a2 = 0.f, a3 = 0.f;
#pragma unroll
        for (int c = 0; c < 8; ++c) { const u32x4 kv = kp[c];
#pragma unroll
            for (int e = 0; e < 4; ++e) { const float klo = __uint_as_float(kv[e] << 16), khi = __uint_as_float(kv[e] & 0xffff0000u); const int d = c * 8 + e * 2;
                a0 += qs[d] * klo + qs[d + 1] * khi; a1 += qs[64 + d] * klo + qs[64 + d + 1] * khi; a2 += qs[128 + d] * klo + qs[128 + d + 1] * khi; a3 += qs[192 + d] * klo + qs[192 + d + 1] * khi; } }
        const float sc = w0 * fmaxf(a0, 0.f) + w1 * fmaxf(a1, 0.f) + w2 * fmaxf(a2, 0.f) + w3 * fmaxf(a3, 0.f);
        key[s] = fkey(sc);
    }
    __syncthreads();
    unsigned prefix = 0u;
    for (int bit = 31; bit >= 0; --bit) {
        const unsigned cand = prefix | (1u << bit);
        if (tid == 0) cnt = 0u;
        __syncthreads();
        unsigned c = 0u; for (int s = tid; s < n; s += 256) c += (key[s] >= cand) ? 1u : 0u;
        if (c) atomicAdd(&cnt, c);
        __syncthreads();
        if (cnt >= (unsigned)TOPK) prefix = cand;
        __syncthreads();
    }
    if (tid == 0) cnt = 0u;
    __syncthreads();
    { unsigned c = 0u; for (int s = tid; s < n; s += 256) c += (key[s] > prefix) ? 1u : 0u; if (c) atomicAdd(&cnt, c); }
    __syncthreads();
    const unsigned need = (unsigned)TOPK - cnt;
    __syncthreads();
    const int s0 = tid * 16; unsigned eqc = 0u;
    for (int i = 0; i < 16; ++i) { const int s = s0 + i; if (s < n && key[s] == prefix) ++eqc; }
    scan[tid] = eqc; __syncthreads();
    for (int o = 1; o < 256; o <<= 1) { const unsigned v = (tid >= o) ? scan[tid - o] : 0u; __syncthreads(); scan[tid] += v; __syncthreads(); }
    unsigned eq_before = scan[tid] - eqc; __syncthreads();
    unsigned takec = 0u; unsigned takemask = 0u;
    for (int i = 0; i < 16; ++i) { const int s = s0 + i; if (s < n) { const unsigned k = key[s]; bool take = k > prefix; if (k == prefix) { take = eq_before < need; ++eq_before; } if (take) { ++takec; takemask |= 1u << i; } } }
    scan[tid] = takec; __syncthreads();
    for (int o = 1; o < 256; o <<= 1) { const unsigned v = (tid >= o) ? scan[tid - o] : 0u; __syncthreads(); scan[tid] += v; __syncthreads(); }
    unsigned pos = scan[tid] - takec;
    for (int i = 0; i < 16; ++i) if (takemask & (1u << i)) { if (pos < (unsigned)TOPK) sel[pos] = (unsigned short)(s0 + i); ++pos; }
}

__global__ void __launch_bounds__(256) sparse_attn_naive_k(const bf16_t* __restrict__ Q, const bf16_t* __restrict__ Kb, const bf16_t* __restrict__ Vb, const unsigned short* __restrict__ SEL, bf16_t* __restrict__ MIX) {
    __shared__ float qs[512]; __shared__ float lg[NH][TOPK]; __shared__ int idx[TOPK]; __shared__ float red[NH];
    const int row = blockIdx.x, tid = threadIdx.x, b = row / SEQ, t = row % SEQ, n = (t + 1 < TOPK) ? t + 1 : TOPK;
    qs[tid] = bf2f(Q[(size_t)row * 512 + tid]); qs[tid + 256] = bf2f(Q[(size_t)row * 512 + 256 + tid]);
    int myidx = 0; if (tid < n) myidx = (int)SEL[(size_t)row * TOPK + tid]; idx[tid] = myidx;
    __syncthreads();
    if (tid < n) {
        const u32x4* kp = (const u32x4*)(Kb + ((size_t)b * SEQ + myidx) * 64);
        float a[NH];
#pragma unroll
        for (int h = 0; h < NH; ++h) a[h] = 0.f;
#pragma unroll
        for (int c = 0; c < 8; ++c) { const u32x4 kv = kp[c];
#pragma unroll
            for (int e = 0; e < 4; ++e) { const float klo = __uint_as_float(kv[e] << 16), khi = __uint_as_float(kv[e] & 0xffff0000u); const int d = c * 8 + e * 2;
#pragma unroll
                for (int h = 0; h < NH; ++h) a[h] += qs[h * 64 + d] * klo + qs[h * 64 + d + 1] * khi; } }
#pragma unroll
        for (int h = 0; h < NH; ++h) lg[h][tid] = a[h] * 0.125f;
    } else {
#pragma unroll
        for (int h = 0; h < NH; ++h) lg[h][tid] = -INFINITY;
    }
    __syncthreads();
    { const int w = tid >> 6, lane = tid & 63;
      for (int hh = 0; hh < 2; ++hh) { const int h = 2 * w + hh; float v[4], m = -INFINITY;
          for (int i = 0; i < 4; ++i) { v[i] = lg[h][lane + 64 * i]; m = fmaxf(m, v[i]); }
          m = wave_max(m); float s = 0.f;
          for (int i = 0; i < 4; ++i) { v[i] = __expf(v[i] - m); s += v[i]; }
          s = wave_sum(s); const float inv = 1.f / s;
          for (int i = 0; i < 4; ++i) lg[h][lane + 64 * i] = v[i] * inv; } }
    __syncthreads();
    { const int h = tid >> 5, d0 = (tid & 31) * 2; float o0 = 0.f, o1 = 0.f;
      for (int j = 0; j < n; ++j) { const unsigned vv = *(const unsigned*)(Vb + ((size_t)b * SEQ + idx[j]) * 64 + d0); const float p = lg[h][j]; o0 += p * __uint_as_float(vv << 16); o1 += p * __uint_as_float(vv & 0xffff0000u); }
      *(unsigned*)(MIX + (size_t)row * DM + h * 64 + d0) = (unsigned)f2bf(o0) | ((unsigned)f2bf(o1) << 16); }
}

__global__ void __launch_bounds__(256) convb_naive_k(const bf16_t* __restrict__ U, const float* __restrict__ cw, const float* __restrict__ cb, const float* __restrict__ lg, const float* __restrict__ lb, bf16_t* __restrict__ MIX) {
    __shared__ float red[8];
    const int row = blockIdx.x, tid = threadIdx.x, t = row % SEQ;
    float y[2];
    for (int k = 0; k < 2; ++k) { const int c = tid + 256 * k; float acc = cb[c];
        for (int j = 0; j < 31; ++j) { const int tt = t - 30 + j; if (tt >= 0) acc += cw[j * 512 + c] * bf2f(U[(size_t)(row - 30 + j) * 512 + c]); }
        y[k] = acc; }
    float s = wave_sum(y[0] + y[1]); if ((tid & 63) == 0) red[tid >> 6] = s; __syncthreads();
    const float mu = (red[0] + red[1] + red[2] + red[3]) * (1.f / 512.f); __syncthreads();
    float q = wave_sum((y[0] - mu) * (y[0] - mu) + (y[1] - mu) * (y[1] - mu)); if ((tid & 63) == 0) red[4 + (tid >> 6)] = q; __syncthreads();
    const float rstd = 1.f / sqrtf((red[4] + red[5] + red[6] + red[7]) * (1.f / 512.f) + EPS);
    for (int k = 0; k < 2; ++k) { const int c = tid + 256 * k; const float v = (y[k] - mu) * rstd * lg[c] + lb[c]; MIX[(size_t)row * DM + 512 + c] = f2bf(silu_f(v)); }
}

__global__ void __launch_bounds__(256) cross_attn_naive_k(const bf16_t* __restrict__ QC, const bf16_t* __restrict__ KC, const bf16_t* __restrict__ VC, bf16_t* __restrict__ OC) {
    __shared__ float qs[DM]; __shared__ float lg[4][NMEM];
    const int row = blockIdx.x, tid = threadIdx.x, b = row / SEQ;
    for (int c = tid; c < DM; c += 256) qs[c] = bf2f(QC[(size_t)row * DM + c]);
    __syncthreads();
    { const u32x4* kp = (const u32x4*)(KC + ((size_t)b * NMEM + tid) * DM);
      for (int h = 0; h < 4; ++h) { float a = 0.f;
          for (int c = 0; c < 32; ++c) { const u32x4 kv = kp[h * 32 + c];
#pragma unroll
              for (int e = 0; e < 4; ++e) { const int d = h * 256 + c * 8 + e * 2; a += qs[d] * __uint_as_float(kv[e] << 16) + qs[d + 1] * __uint_as_float(kv[e] & 0xffff0000u); } }
          lg[h][tid] = a * 0.0625f; } }
    __syncthreads();
    { const int h = tid >> 6, lane = tid & 63; float v[4], m = -INFINITY;
      for (int i = 0; i < 4; ++i) { v[i] = lg[h][lane + 64 * i]; m = fmaxf(m, v[i]); }
      m = wave_max(m); float s = 0.f;
      for (int i = 0; i < 4; ++i) { v[i] = __expf(v[i] - m); s += v[i]; }
      s = wave_sum(s); const float inv = 1.f / s;
      for (int i = 0; i < 4; ++i) lg[h][lane + 64 * i] = v[i] * inv; }
    __syncthreads();
    { const int h = tid >> 6, d0 = h * 256 + (tid & 63) * 4; float o0 = 0.f, o1 = 0.f, o2 = 0.f, o3 = 0.f;
      for (int j = 0; j < NMEM; ++j) { const u32x2 vv = *(const u32x2*)(VC + ((size_t)b * NMEM + j) * DM + d0); const float p = lg[h][j];
          o0 += p * __uint_as_float(vv.x << 16); o1 += p * __uint_as_float(vv.x & 0xffff0000u); o2 += p * __uint_as_float(vv.y << 16); o3 += p * __uint_as_float(vv.y & 0xffff0000u); }
      u32x2 w; w.x = (unsigned)f2bf(o0) | ((unsigned)f2bf(o1) << 16); w.y = (unsigned)f2bf(o2) | ((unsigned)f2bf(o3) << 16); *(u32x2*)(OC + (size_t)row * DM + d0) = w; }
}

__global__ void ffn_act_naive_k(const bf16_t* __restrict__ G, bf16_t* __restrict__ Uf, const float* __restrict__ cw, const float* __restrict__ cb) {
    const size_t i = (size_t)blockIdx.x * blockDim.x + threadIdx.x; if (i >= (size_t)MTOK * DFF) return;
    const int c = (int)(i % DFF); const size_t row = i / DFF; const int t = (int)(row % SEQ);
    float g = cb[c] + cw[2 * DFF + c] * bf2f(G[i]);
    if (t >= 1) g += cw[1 * DFF + c] * bf2f(G[i - DFF]);
    if (t >= 2) g += cw[0 * DFF + c] * bf2f(G[i - 2 * DFF]);
    Uf[i] = f2bf(silu_f(g) * bf2f(Uf[i]));
}

constexpr size_t MiB = 1u << 20;
static void launch_gemm(hipStream_t st, const bf16_t* A, const bf16_t* Bt, float* outf, bf16_t* outb, const float* res, int M, int N, int K, int ldc) {
    GemmArgs a{A, Bt, outf, outb, res, M, N, K, ldc};
    hipLaunchKernelGGL(gemm_k, dim3(256), dim3(512), 131072, st, a);
}
static void launch_wt(hipStream_t st, const float* W, int K, int N, bf16_t* WT, int n_off) {
    hipLaunchKernelGGL(wt_k, dim3((N + 31) / 32, (K + 31) / 32), dim3(256), 0, st, W, K, N, WT, n_off);
}
extern "C" void kernel_launch(void* const* d_in, const int* in_sizes, int n_in, void* d_out, int out_size, void* d_ws, size_t ws_size, hipStream_t stream) {
    static bool inited = false;
    if (!inited) { hipFuncSetAttribute((const void*)gemm_k, hipFuncAttributeMaxDynamicSharedMemorySize, 131072); inited = true; }
    const float* x = (const float*)d_in[0]; const float* mem = (const float*)d_in[1]; const int* positions = (const int*)d_in[2];
    const float* g_mix = (const float*)d_in[3]; const float* w_in = (const float*)d_in[4]; const float* w_out = (const float*)d_in[5];
    const float* conv_b_w = (const float*)d_in[6]; const float* conv_b_b = (const float*)d_in[7]; const float* ln_b_g = (const float*)d_in[8]; const float* ln_b_b = (const float*)d_in[9];
    const float* g_cross = (const float*)d_in[10]; const float* g_mem = (const float*)d_in[11];
    const float* w_q = (const float*)d_in[12]; const float* w_k = (const float*)d_in[13]; const float* w_v = (const float*)d_in[14]; const float* w_o = (const float*)d_in[15];
    const float* g_ffn = (const float*)d_in[16]; const float* w_gate = (const float*)d_in[17]; const float* w_up = (const float*)d_in[18];
    const float* ffn_cw = (const float*)d_in[19]; const float* ffn_cb = (const float*)d_in[20]; const float* w_down = (const float*)d_in[21]; const float* g_final = (const float*)d_in[22];
    float* out = (float*)d_out; unsigned char* ws = (unsigned char*)d_ws;
    bf16_t* wt_in = (bf16_t*)(ws + 0 * MiB);
    bf16_t* wt_out = (bf16_t*)(ws + 4 * MiB);
    bf16_t* wt_q = (bf16_t*)(ws + 6 * MiB), *wt_k = (bf16_t*)(ws + 8 * MiB), *wt_v = (bf16_t*)(ws + 10 * MiB), *wt_o = (bf16_t*)(ws + 12 * MiB);
    bf16_t* wt_gate = (bf16_t*)(ws + 14 * MiB);
    bf16_t* wt_up = (bf16_t*)(ws + 20 * MiB);
    bf16_t* wt_down = (bf16_t*)(ws + 26 * MiB);
    float* WI = (float*)(ws + 32 * MiB);
    bf16_t* MEMN = (bf16_t*)(ws + 34 * MiB), *KC = (bf16_t*)(ws + 38 * MiB), *VC = (bf16_t*)(ws + 42 * MiB);
    bf16_t* XN = (bf16_t*)(ws + 48 * MiB);
    float* PROJ = (float*)(ws + 112 * MiB);
    bf16_t* Qb = (bf16_t*)(ws + 368 * MiB);
    bf16_t* QI = (bf16_t*)(ws + 400 * MiB);
    bf16_t* Kb = (bf16_t*)(ws + 416 * MiB), *Vb = (bf16_t*)(ws + 420 * MiB), *KI = (bf16_t*)(ws + 424 * MiB);
    bf16_t* U = (bf16_t*)(ws + 428 * MiB);
    unsigned short* SEL = (unsigned short*)(ws + 460 * MiB);
    bf16_t* MIX = (bf16_t*)(ws + 112 * MiB);
    bf16_t* QC = (bf16_t*)(ws + 176 * MiB);
    bf16_t* OC = (bf16_t*)(ws + 240 * MiB);
    bf16_t* G = (bf16_t*)(ws + 112 * MiB);
    bf16_t* UF = (bf16_t*)(ws + 288 * MiB);
    if (ws_size < 476 * MiB) return;
    hipMemsetAsync(wt_in, 0, (size_t)INP * DM * 2, stream);
    launch_wt(stream, w_in, DM, INC, wt_in, 0);
    launch_wt(stream, w_out, DM, DM, wt_out, 0);
    launch_wt(stream, w_q, DM, DM, wt_q, 0); launch_wt(stream, w_k, DM, DM, wt_k, 0); launch_wt(stream, w_v, DM, DM, wt_v, 0); launch_wt(stream, w_o, DM, DM, wt_o, 0);
    launch_wt(stream, w_gate, DM, DFF, wt_gate, 0); launch_wt(stream, w_up, DM, DFF, wt_up, 0); launch_wt(stream, w_down, DFF, DM, wt_down, 0);
    hipLaunchKernelGGL(rmsnorm_bf16_k, dim3(MTOK / 4), dim3(256), 0, stream, x, g_mix, XN, MTOK);
    launch_gemm(stream, XN, wt_in, PROJ, nullptr, nullptr, MTOK, INP, DM, INP);
    hipLaunchKernelGGL(split_rope_k, dim3(MTOK), dim3(256), 0, stream, PROJ, positions, Qb, Kb, Vb, QI, KI, WI, U);
    hipLaunchKernelGGL(topk_naive_k, dim3(MTOK), dim3(256), 0, stream, QI, KI, WI, SEL);
    hipLaunchKernelGGL(sparse_attn_naive_k, dim3(MTOK), dim3(256), 0, stream, Qb, Kb, Vb, SEL, MIX);
    hipLaunchKernelGGL(convb_naive_k, dim3(MTOK), dim3(256), 0, stream, U, conv_b_w, conv_b_b, ln_b_g, ln_b_b, MIX);
    launch_gemm(stream, MIX, wt_out, out, nullptr, x, MTOK, DM, DM, DM);
    hipLaunchKernelGGL(rmsnorm_bf16_k, dim3(MTOK / 4), dim3(256), 0, stream, out, g_cross, XN, MTOK);
    hipLaunchKernelGGL(rmsnorm_bf16_k, dim3(MMEM / 4), dim3(256), 0, stream, mem, g_mem, MEMN, MMEM);
    launch_gemm(stream, XN, wt_q, nullptr, QC, nullptr, MTOK, DM, DM, DM);
    launch_gemm(stream, MEMN, wt_k, nullptr, KC, nullptr, MMEM, DM, DM, DM);
    launch_gemm(stream, MEMN, wt_v, nullptr, VC, nullptr, MMEM, DM, DM, DM);
    hipLaunchKernelGGL(cross_attn_naive_k, dim3(MTOK), dim3(256), 0, stream, QC, KC, VC, OC);
    launch_gemm(stream, OC, wt_o, out, nullptr, out, MTOK, DM, DM, DM);
    hipLaunchKernelGGL(rmsnorm_bf16_k, dim3(MTOK / 4), dim3(256), 0, stream, out, g_ffn, XN, MTOK);
    launch_gemm(stream, XN, wt_gate, nullptr, G, nullptr, MTOK, DFF, DM, DFF);
    launch_gemm(stream, XN, wt_up, nullptr, UF, nullptr, MTOK, DFF, DM, DFF);
    { const size_t tot = (size_t)MTOK * DFF; hipLaunchKernelGGL(ffn_act_naive_k, dim3((unsigned)((tot + 255) / 256)), dim3(256), 0, stream, G, UF, ffn_cw, ffn_cb); }
    launch_gemm(stream, UF, wt_down, out, nullptr, out, MTOK, DM, DFF, DM);
    hipLaunchKernelGGL(rmsnorm_f32_k, dim3(MTOK / 4), dim3(256), 0, stream, out, g_final, MTOK);
}
```

```cpp
#include <hip/hip_runtime.h>
#include <cstdio>
#include <cstdint>
#include <cmath>
namespace pg8 {
#define PG8_LAS __attribute__((address_space(3)))
typedef unsigned short bf16_t;
typedef short bf16x8 __attribute__((ext_vector_type(8)));
typedef float f32x4 __attribute__((ext_vector_type(4)));
typedef unsigned u32x4 __attribute__((ext_vector_type(4)));
constexpr int BM = 256, BK = 64, HALF = 128, HTB = HALF * BK * 2  , STAGE_BYTES = 8 * HTB, NXCD = 8, WGM = 8;

__host__ __device__ __forceinline__ int lds_byte(int r, int c) { const int st = (r >> 4) * 2 + (c >> 5), rr = r & 15, cc = c & 31, ob = rr * 64 + cc * 2; return st * 1024 + (ob ^ (((ob >> 9) & 1) << 5)); }
__host__ __device__ __forceinline__ void stage_rc(int b, int& R, int& C) { const int st = b / 1024, sb = b % 1024, swz = sb ^ (((sb >> 9) & 1) << 5); R = (st >> 1) * 16 + swz / 64; C = (st & 1) * 32 + (swz % 64) / 2; }
__host__ __device__ __forceinline__ int perm32(int rho) { const int n = rho >> 4, i = rho & 15; return 8 * (i >> 2) + 4 * n + (i & 3); }

struct Unit { int pm, pn; };
struct Gemm { const bf16_t* A; const bf16_t* Bt; int M, N, K; };

struct StaticOrder {
    int nM, nN, nwg, G, c;
    __host__ __device__ void init(int M, int N, int G_, int c_) { nM = M / BM; nN = N / BM; nwg = nM * nN; G = G_; c = c_; }
    __host__ __device__ bool next(int i, Unit& u) const {
        const long L = (long)i * G + c; if (L >= nwg) return false;
        int wgid = (int)L; { const int q = nwg / NXCD, r = nwg % NXCD, xcd = wgid % NXCD, off = wgid / NXCD; wgid = (xcd < r ? xcd * (q + 1) : r * (q + 1) + (xcd - r) * q) + off; }
        const int nig = WGM * nN, gid = wgid / nig, fm = gid * WGM, gsz = (nM - fm) < WGM ? (nM - fm) : WGM;
        u.pm = fm + ((wgid % nig) % gsz); u.pn = (wgid % nig) / gsz; return true;
    }
    __device__ __forceinline__ void a_ready(const Unit&) const {}
    __device__ __forceinline__ void done(const Unit&) const {}
};
__device__ __forceinline__ unsigned cvt_pk_bf16(float lo, float hi) { unsigned r; asm volatile("v_cvt_pk_bf16_f32 %0, %1, %2" : "=v"(r) : "v"(lo), "v"(hi)); return r; }
template <class Epi, class Sched, bool ALIGN_EPI = false, bool SP2 = false>
__device__ __forceinline__ void gemm_phase(PG8_LAS unsigned char* lds, const Gemm g, const Sched& S, const Epi& E) {
    const int tid = threadIdx.x, wid = __builtin_amdgcn_readfirstlane(tid >> 6), lane = tid & 63, wr = wid >> 2, wc = wid & 3, fr = lane & 15, fq = lane >> 4;
    const int K = g.K, nt = K / BK;
    unsigned voffA[2], voffB[2];
#pragma unroll
    for (int i = 0; i < 2; ++i) { int R, C; stage_rc(tid * 16 + i * 8192, R, C); const int Rb = Epi::PERM ? ((R & ~31) + perm32(R & 31)) : R;
        voffA[i] = (unsigned)(R * K + C) * 2u; voffB[i] = (unsigned)(Rb * K + C) * 2u; }
    const size_t kstep = (size_t)(BK * 2);
    const size_t hstep = (size_t)HALF * K * 2;
    const size_t tstep = 2 * hstep;
    const unsigned ldsw = (unsigned)wid * 1024u;
    const int aoff = lds_byte(wr * 64 + fr, fq * 8), boff = lds_byte(wc * 32 + fr, fq * 8);
#define PG8_SA(b, h) (((b) * 2 + (h)) * HTB)
#define PG8_SB(b, h) ((4 + (b) * 2 + (h)) * HTB)
#define PG8_STAGE(bufoff, gbase, voff) do { _Pragma("unroll") for (int _i = 0; _i < 2; ++_i) \
        __builtin_amdgcn_global_load_lds((const unsigned*)((const char*)(gbase) + (voff)[_i]), (PG8_LAS unsigned*)(lds + (bufoff) + ldsw + _i * 8192), 16, 0, 0); } while (0)
#define PG8_LDA(dst, b, h) do { _Pragma("unroll") for (int m = 0; m < 4; ++m) _Pragma("unroll") for (int k = 0; k < 2; ++k) dst[m][k] = *(const PG8_LAS bf16x8*)(lds + PG8_SA(b, h) + aoff + m * 2048 + k * 1024); } while (0)
#define PG8_LDB(dst, b, h) do { _Pragma("unroll") for (int n = 0; n < 2; ++n) _Pragma("unroll") for (int k = 0; k < 2; ++k) dst[n][k] = *(const PG8_LAS bf16x8*)(lds + PG8_SB(b, h) + boff + n * 2048 + k * 1024); } while (0)
#define PG8_MMA(ai, bj, At, Bt) do { __builtin_amdgcn_s_setprio(1); _Pragma("unroll") for (int m = 0; m < 4; ++m) _Pragma("unroll") for (int n = 0; n < 2; ++n) _Pragma("unroll") for (int k = 0; k < 2; ++k) \
        acc[ai][bj][m][n] = __builtin_amdgcn_mfma_f32_16x16x32_bf16(Bt[n][k], At[m][k], acc[ai][bj][m][n], 0, 0, 0); __builtin_amdgcn_s_setprio(0); } while (0)
#define PG8_WAIT_V(n) asm volatile("s_waitcnt vmcnt(" #n ")" ::: "memory")
#define PG8_WAIT_L(n) asm volatile("s_waitcnt lgkmcnt(" #n ")" ::: "memory")
#define PG8_BAR __builtin_amdgcn_s_barrier()
#define PG8_SCHED __builtin_amdgcn_sched_barrier(0)
    Unit cur, nxt; int ui = 0;
    if (!S.next(0, cur)) return;
    f32x4 acc[2][2][4][2];
#pragma unroll
    for (int a = 0; a < 2; ++a)
#pragma unroll
        for (int b = 0; b < 2; ++b)
#pragma unroll
            for (int m = 0; m < 4; ++m)
#pragma unroll
                for (int n = 0; n < 2; ++n) acc[a][b][m][n] = (f32x4){0.f, 0.f, 0.f, 0.f};
    bf16x8 At[4][2], B0[2][2], B1[2][2];
    const char* cA = (const char*)g.A + (size_t)cur.pm * tstep; const char* cB = (const char*)g.Bt + (size_t)cur.pn * tstep;
    S.a_ready(cur);
    if constexpr (SP2) {
        PG8_STAGE(PG8_SB(0, 0), cB, voffB); PG8_STAGE(PG8_SB(0, 1), cB + hstep, voffB); PG8_STAGE(PG8_SA(0, 0), cA, voffA); PG8_STAGE(PG8_SA(0, 1), cA + hstep, voffA);
        if (wr == 1) PG8_BAR;
        PG8_WAIT_V(2); PG8_BAR;
        PG8_STAGE(PG8_SB(1, 0), cB + kstep, voffB); PG8_STAGE(PG8_SA(1, 0), cA + kstep, voffA); PG8_STAGE(PG8_SB(1, 1), cB + hstep + kstep, voffB);
        PG8_WAIT_V(6); PG8_BAR;
    } else {
        PG8_STAGE(PG8_SB(0, 0), cB, voffB); PG8_STAGE(PG8_SA(0, 0), cA, voffA); PG8_STAGE(PG8_SB(0, 1), cB + hstep, voffB); PG8_STAGE(PG8_SA(0, 1), cA + hstep, voffA);
        if (wr == 1) PG8_BAR;
        PG8_WAIT_V(4); PG8_BAR;
        PG8_STAGE(PG8_SB(1, 0), cB + kstep, voffB); PG8_STAGE(PG8_SA(1, 0), cA + kstep, voffA); PG8_STAGE(PG8_SB(1, 1), cB + hstep + kstep, voffB);
        PG8_WAIT_V(6); PG8_BAR;
    }
    for (;;) {
        const bool has_next = S.next(ui + 1, nxt);
        const char* nA = has_next ? (const char*)g.A + (size_t)nxt.pm * tstep : cA; const char* nB = has_next ? (const char*)g.Bt + (size_t)nxt.pn * tstep : cB;
        for (int t = 0; t < nt; t += 2) {
            const bool last = (t == nt - 2);
            const char* a1 = cA + (size_t)(t + 1) * kstep;
            const char* a2 = last ? nA : cA + (size_t)(t + 2) * kstep; const char* b2 = last ? nB : cB + (size_t)(t + 2) * kstep;
            const char* a3 = a2 + kstep; const char* b3 = b2 + kstep;
            if (last && has_next) S.a_ready(nxt);
            if constexpr (SP2) {
            PG8_LDB(B0, 0, 0); PG8_LDB(B1, 0, 1); PG8_SCHED; PG8_LDA(At, 0, 0); PG8_STAGE(PG8_SA(1, 1), a1 + hstep, voffA);
            PG8_WAIT_V(8); PG8_WAIT_L(0); PG8_BAR; PG8_MMA(0, 0, At, B0); PG8_MMA(0, 1, At, B1); PG8_BAR; PG8_SCHED;
            PG8_LDA(At, 0, 1); PG8_STAGE(PG8_SB(0, 0), b2, voffB); PG8_STAGE(PG8_SB(0, 1), b2 + hstep, voffB); PG8_STAGE(PG8_SA(0, 0), a2, voffA);
            PG8_WAIT_V(8); PG8_WAIT_L(0); PG8_BAR; PG8_MMA(1, 0, At, B0); PG8_MMA(1, 1, At, B1); PG8_BAR; PG8_SCHED;
            PG8_LDB(B0, 1, 0); PG8_LDB(B1, 1, 1); PG8_SCHED; PG8_LDA(At, 1, 0); PG8_STAGE(PG8_SA(0, 1), a2 + hstep, voffA);
            PG8_WAIT_V(8); PG8_WAIT_L(0); PG8_BAR; PG8_MMA(0, 0, At, B0); PG8_MMA(0, 1, At, B1); PG8_BAR; PG8_SCHED;
            PG8_LDA(At, 1, 1); PG8_STAGE(PG8_SB(1, 0), b3, voffB); PG8_STAGE(PG8_SB(1, 1), b3 + hstep, voffB); PG8_STAGE(PG8_SA(1, 0), a3, voffA);
            PG8_WAIT_V(8); PG8_WAIT_L(0); PG8_BAR; PG8_MMA(1, 0, At, B0); PG8_MMA(1, 1, At, B1); PG8_BAR; PG8_SCHED;
            } else {
            PG8_LDB(B0, 0, 0); PG8_SCHED; PG8_LDA(At, 0, 0); PG8_STAGE(PG8_SA(1, 1), a1 + hstep, voffA);
            PG8_WAIT_L(8); PG8_BAR; PG8_WAIT_L(0); PG8_MMA(0, 0, At, B0); PG8_BAR; PG8_SCHED;
            PG8_LDB(B1, 0, 1); PG8_STAGE(PG8_SB(0, 0), b2, voffB);
            PG8_BAR; PG8_WAIT_L(0); PG8_MMA(0, 1, At, B1); PG8_BAR;
            PG8_LDA(At, 0, 1); PG8_STAGE(PG8_SA(0, 0), a2, voffA);
            PG8_BAR; PG8_WAIT_L(0); PG8_MMA(1, 0, At, B0); PG8_BAR; PG8_SCHED;
            PG8_STAGE(PG8_SB(0, 1), b2 + hstep, voffB);
            PG8_WAIT_V(6); PG8_BAR; PG8_MMA(1, 1, At, B1); PG8_BAR;
            PG8_LDB(B0, 1, 0); PG8_SCHED; PG8_LDA(At, 1, 0); PG8_STAGE(PG8_SA(0, 1), a2 + hstep, voffA);
            PG8_WAIT_L(8); PG8_BAR; PG8_WAIT_L(0); PG8_MMA(0, 0, At, B0); PG8_BAR; PG8_SCHED;
            PG8_LDB(B1, 1, 1); PG8_STAGE(PG8_SB(1, 0), b3, voffB);
            PG8_BAR; PG8_WAIT_L(0); PG8_MMA(0, 1, At, B1); PG8_BAR;
            PG8_LDA(At, 1, 1); PG8_STAGE(PG8_SA(1, 0), a3, voffA);
            PG8_BAR; PG8_WAIT_L(0); PG8_MMA(1, 0, At, B0); PG8_BAR; PG8_SCHED;
            PG8_STAGE(PG8_SB(1, 1), b3 + hstep, voffB);
            PG8_WAIT_V(6); PG8_BAR; PG8_MMA(1, 1, At, B1); PG8_BAR;
            }
        }
        if constexpr (ALIGN_EPI) { if (wr == 0) PG8_BAR; }
        if constexpr (!Epi::AFTER_DRAIN) { E(acc, cur, wr, wc, fr, fq); S.done(cur); }
        if (!has_next) break;
#pragma unroll
        for (int a = 0; a < 2; ++a)
#pragma unroll
            for (int b = 0; b < 2; ++b)
#pragma unroll
                for (int m = 0; m < 4; ++m)
#pragma unroll
                    for (int n = 0; n < 2; ++n) acc[a][b][m][n] = (f32x4){0.f, 0.f, 0.f, 0.f};
        cur = nxt; cA = nA; cB = nB; ++ui;
        if constexpr (ALIGN_EPI) { if (wr == 1) PG8_BAR; }
    }
    PG8_WAIT_V(0);
    if constexpr (!ALIGN_EPI) { if (wr == 0) PG8_BAR; }
    PG8_BAR;
    if constexpr (Epi::AFTER_DRAIN) { E.fused(acc, cur, wr, wc, fr, fq, lds, wid, lane); S.done(cur); }
#undef PG8_SA
#undef PG8_SB
#undef PG8_STAGE
#undef PG8_LDA
#undef PG8_LDB
#undef PG8_MMA
#undef PG8_WAIT_V
#undef PG8_WAIT_L
#undef PG8_BAR
#undef PG8_SCHED
}
}

constexpr int BATCH = 8, SEQ = 4096, DM = 1024, MTOK = BATCH * SEQ;
constexpr int NMEM = 256, MMEM = BATCH * NMEM;
constexpr int AW = 512, HD = 64, NH = 8, IH = 4, TOPK = 256;
constexpr int INC = 1988, INP = 2048;
constexpr int DFF = 2816;
constexpr float EPS = 1e-6f;
#define LAS __attribute__((address_space(3)))
typedef unsigned short bf16_t;
typedef float f32x4 __attribute__((ext_vector_type(4)));
typedef unsigned u32x4 __attribute__((ext_vector_type(4)));
typedef unsigned u32x2 __attribute__((ext_vector_type(2)));

__device__ __forceinline__ float bf2f(bf16_t v) { return __uint_as_float((unsigned)v << 16); }
__device__ __forceinline__ bf16_t f2bf(float f) { unsigned u = __float_as_uint(f); return (bf16_t)((u + 0x7fffu + ((u >> 16) & 1u)) >> 16); }
__device__ __forceinline__ float wave_sum(float v) {
#pragma unroll
    for (int o = 1; o < 64; o <<= 1) v += __shfl_xor(v, o);
    return v;
}
__device__ __forceinline__ float wave_max(float v) {
#pragma unroll
    for (int o = 1; o < 64; o <<= 1) v = fmaxf(v, __shfl_xor(v, o));
    return v;
}
__device__ __forceinline__ float silu_f(float v) { return v / (1.f + __expf(-v)); }

struct EpiStore {
    static constexpr bool PERM = false, AFTER_DRAIN = false;
    float* outf; bf16_t* outb; const float* res; int ldc;
    __device__ __forceinline__ void operator()(const pg8::f32x4 (&acc)[2][2][4][2], const pg8::Unit& u, int wr, int wc, int fr, int fq) const {
        const int col0 = u.pn * 256 + wc * 32 + 4 * fq;
#pragma unroll
        for (int ai = 0; ai < 2; ++ai)
#pragma unroll
            for (int m = 0; m < 4; ++m) {
                const size_t row = (size_t)(u.pm * 256 + ai * 128 + wr * 64 + m * 16 + fr);
#pragma unroll
                for (int bj = 0; bj < 2; ++bj)
#pragma unroll
                    for (int n = 0; n < 2; ++n) {
                        const size_t off = row * ldc + col0 + bj * 128 + n * 16;
                        pg8::f32x4 v = acc[ai][bj][m][n];
                        if (res) { const pg8::f32x4 r = *(const pg8::f32x4*)(res + off); v = v + r; }
                        if (outf) *(pg8::f32x4*)(outf + off) = v;
                        if (outb) { u32x2 w; w.x = (unsigned)f2bf(v[0]) | ((unsigned)f2bf(v[1]) << 16); w.y = (unsigned)f2bf(v[2]) | ((unsigned)f2bf(v[3]) << 16); *(u32x2*)(outb + off) = w; }
                    }
            }
    }
};
#define XB_TMO      128
#define XB_XCNT(j)  (256  + 64 * (j))
#define XB_XSUB(j)  (1280 + 64 * (j))
#define XB_XGEN(j)  (2304 + 64 * (j))
#define XB_TOP      3328
#define XB_TOPGEN   3392
#define XCD_BAR_WORDS 3456
#define XB_SPIN_CAP (1u << 18)

__device__ __forceinline__ unsigned xb_ld(unsigned* p)              { return __hip_atomic_load(p, __ATOMIC_RELAXED, __HIP_MEMORY_SCOPE_AGENT); }
__device__ __forceinline__ unsigned xb_add(unsigned* p, unsigned v) { return __hip_atomic_fetch_add(p, v, __ATOMIC_RELAXED, __HIP_MEMORY_SCOPE_AGENT); }
__device__ __forceinline__ unsigned xb_xcc_id() { return (unsigned)__builtin_amdgcn_s_getreg((3 << 11) | 20) & 0xFu; }
#define XB_SPIN(cond, bar) do { unsigned _sp = 0; while (cond) { __builtin_amdgcn_s_sleep(1); \
    if ((++_sp & 255u) == 0u) { if (xb_ld(&(bar)[XB_TMO])) break; if (_sp > XB_SPIN_CAP) { atomicAdd(&(bar)[XB_TMO], 1u); break; } } } } while (0)

struct XcdBarrier {
    unsigned* bar; unsigned x;
    volatile LAS unsigned* st;
};

__device__ __forceinline__ XcdBarrier xcd_barrier_post(unsigned* bar, volatile LAS unsigned* st) {
    XcdBarrier b; b.bar = bar; b.x = xb_xcc_id(); b.st = st;
    if (threadIdx.x == 0) (void)xb_add(&bar[XB_XCNT(b.x)], 1u);
    return b;
}
__device__ __forceinline__ void xcd_barrier_complete(unsigned* bar, unsigned x, unsigned& nloc, unsigned& nx) {
    const unsigned G = gridDim.x * gridDim.y * gridDim.z;
    unsigned sum, cnt, mine, sp = 0u;
    for (;;) {
        sum = 0u; cnt = 0u; mine = 0u;
#pragma unroll
        for (unsigned j = 0; j < 16; ++j) { const unsigned c = xb_ld(&bar[XB_XCNT(j)]); sum += c; cnt += (c > 0u) ? 1u : 0u; mine = (j == x) ? c : mine; }
        if (sum == G) break;
        __builtin_amdgcn_s_sleep(1);
        if ((++sp & 255u) == 0u) { if (xb_ld(&bar[XB_TMO])) break; if (sp > XB_SPIN_CAP) { atomicAdd(&bar[XB_TMO], 1u); break; } }
    }
    nloc = mine > 0u ? mine : 1u; nx = cnt > 0u ? cnt : 1u;
}

__device__ __forceinline__ void xcd_barrier(const XcdBarrier& b) {
    asm volatile("s_waitcnt vmcnt(0)" ::: "memory");
    __syncthreads();
    if (threadIdx.x == 0) {
        unsigned* bar = b.bar;
        __builtin_amdgcn_s_waitcnt(0);
        unsigned nloc = b.st[0], nx = b.st[1];
        if (nloc == 0u) { xcd_barrier_complete(bar, b.x, nloc, nx); b.st[0] = nloc; b.st[1] = nx; }
        const unsigned old = xb_add(&bar[XB_XSUB(b.x)], 1u);
        const unsigned gen = old / nloc;
        if (old + 1u == (gen + 1u) * nloc) {
            __builtin_amdgcn_fence(__ATOMIC_RELEASE, "agent");
            asm volatile("s_waitcnt vmcnt(0)" ::: "memory");
            const unsigned og = xb_add(&bar[XB_TOP], 1u);
            const unsigned tg = og / nx;
            if (og + 1u == (tg + 1u) * nx) xb_add(&bar[XB_TOPGEN], 1u);
            else XB_SPIN(xb_ld(&bar[XB_TOPGEN]) == tg, bar);
            __builtin_amdgcn_fence(__ATOMIC_ACQUIRE, "agent");
            xb_add(&bar[XB_XGEN(b.x)], 1u);
            asm volatile("s_waitcnt vmcnt(0)" ::: "memory");
        } else {
            XB_SPIN(xb_ld(&bar[XB_XGEN(b.x)]) == gen, bar);
            __builtin_amdgcn_fence(__ATOMIC_ACQUIRE, "agent");
            asm volatile("s_waitcnt vmcnt(0)" ::: "memory");
        }
    }
    __syncthreads();
}

__device__ __forceinline__ void wt_body(LAS unsigned char* sm, int vb, int tid, const float* __restrict__ W, int K, int N, bf16_t* WT) {
    LAS float* t = (LAS float*)sm;
    const int nbx = (N + 31) / 32; const int k0 = (vb / nbx) * 32, n0 = (vb % nbx) * 32, tx = tid & 31, ty = tid >> 5;
    for (int i = ty; i < 32; i += 8) { const int k = k0 + i, n = n0 + tx; t[i * 33 + tx] = (k < K && n < N) ? W[(size_t)k * N + n] : 0.f; }
    __syncthreads();
    for (int i = ty; i < 32; i += 8) { const int n = n0 + i, k = k0 + tx; if (n < N && k < K) WT[(size_t)n * K + k] = f2bf(t[tx * 33 + i]); }
    __syncthreads();
}
__device__ __forceinline__ void rmsnorm_bf16_row(const float* x, const float* __restrict__ g, bf16_t* out, int row, int lane) {
    const f32x4* xr = (const f32x4*)(x + (size_t)row * DM) + lane; const f32x4* gr = (const f32x4*)g + lane;
    f32x4 v[4]; float s = 0.f;
#pragma unroll
    for (int j = 0; j < 4; ++j) { v[j] = xr[64 * j]; s += (v[j].x * v[j].x + v[j].y * v[j].y) + (v[j].z * v[j].z + v[j].w * v[j].w); }
    const float rstd = 1.f / sqrtf(wave_sum(s) * (1.f / DM) + EPS);
    u32x2* o = (u32x2*)(out + (size_t)row * DM) + lane;
#pragma unroll
    for (int j = 0; j < 4; ++j) { const f32x4 gg = gr[64 * j]; u32x2 w;
        w.x = (unsigned)f2bf(v[j].x * rstd * gg.x) | ((unsigned)f2bf(v[j].y * rstd * gg.y) << 16);
        w.y = (unsigned)f2bf(v[j].z * rstd * gg.z) | ((unsigned)f2bf(v[j].w * rstd * gg.w) << 16); o[64 * j] = w; }
}
__device__ __forceinline__ void rmsnorm_f32_row(float* x, const float* __restrict__ g, int row, int lane) {
    f32x4* xr = (f32x4*)(x + (size_t)row * DM) + lane; const f32x4* gr = (const f32x4*)g + lane;
    f32x4 v[4]; float s = 0.f;
#pragma unroll
    for (int j = 0; j < 4; ++j) { v[j] = xr[64 * j]; s += (v[j].x * v[j].x + v[j].y * v[j].y) + (v[j].z * v[j].z + v[j].w * v[j].w); }
    const float rstd = 1.f / sqrtf(wave_sum(s) * (1.f / DM) + EPS);
#pragma unroll
    for (int j = 0; j < 4; ++j) { const f32x4 gg = gr[64 * j]; xr[64 * j] = v[j] * rstd * gg; }
}
__device__ __forceinline__ float rope_val(const LAS float* p, int base, int d, const LAS float* cs, const LAS float* sn) {
    if (d < 8) return p[base + d] * cs[d] - p[base + d + 8] * sn[d];
    if (d < 16) return p[base + d] * cs[d - 8] + p[base + d - 8] * sn[d - 8];
    return p[base + d];
}
__device__ __forceinline__ void split_rope_body(LAS unsigned char* sm, int row, int tid, const float* proj, const int* __restrict__ positions, bf16_t* Q, bf16_t* Kb, bf16_t* Vb, bf16_t* QI, bf16_t* KI, float* WI, bf16_t* U) {
    LAS float* p = (LAS float*)sm; LAS float* cs = p + INP; LAS float* sn = cs + 8;
    for (int c = tid; c < INP; c += 256) p[c] = proj[(size_t)row * INP + c];
    if (tid < 8) { const float freq = (float)pow(500000.0, -0.125 * (double)tid); const float ang = (float)positions[row] * freq; cs[tid] = (float)cos((double)ang); sn[tid] = (float)sin((double)ang); }
    __syncthreads();
    for (int c = tid; c < 512; c += 256) Q[(size_t)row * 512 + c] = f2bf(rope_val(p, (c >> 6) * 64, c & 63, cs, sn));
    if (tid < 64) Kb[(size_t)row * 64 + tid] = f2bf(rope_val(p, 512, tid, cs, sn));
    else if (tid < 128) Vb[(size_t)row * 64 + tid - 64] = f2bf(p[576 + tid - 64]);
    else if (tid < 192) KI[(size_t)row * 64 + tid - 128] = f2bf(rope_val(p, 896, tid - 128, cs, sn));
    else if (tid < 196) WI[(size_t)row * 4 + tid - 192] = p[960 + tid - 192] * 0.5f;
    QI[(size_t)row * 256 + tid] = f2bf(rope_val(p, 640 + (tid >> 6) * 64, tid & 63, cs, sn) * 0.125f);
    for (int c = tid; c < 512; c += 256) { const float ga = p[964 + c], gg = p[1476 + c]; U[(size_t)row * 512 + c] = f2bf(ga / (1.f + __expf(-gg))); }
    __syncthreads();
}
__device__ __forceinline__ unsigned fkey(float s) { unsigned u = __float_as_uint(s); if ((u << 1) == 0u) u = 0u; return (u & 0x80000000u) ? ~u : (u | 0x80000000u); }
__device__ __forceinline__ void topk_body(LAS unsigned char* sm, int row, int tid, const bf16_t* QI, const bf16_t* KI, const float* WI, unsigned short* SEL) {
    LAS float* qs = (LAS float*)sm; LAS unsigned* key = (LAS unsigned*)(sm + 1024); LAS unsigned* scan = (LAS unsigned*)(sm + 1024 + 16384); LAS unsigned* cntp = (LAS unsigned*)(sm + 1024 + 16384 + 1024);
    const int b = row / SEQ, t = row % SEQ, n = t + 1;
    unsigned short* sel = SEL + (size_t)row * TOPK;
    if (n <= TOPK) { if (tid < n) sel[tid] = (unsigned short)tid; return; }
    qs[tid] = bf2f(QI[(size_t)row * 256 + tid]);
    const float w0 = WI[(size_t)row * 4 + 0], w1 = WI[(size_t)row * 4 + 1], w2 = WI[(size_t)row * 4 + 2], w3 = WI[(size_t)row * 4 + 3];
    __syncthreads();
    for (int s = tid; s < n; s += 256) {
        const u32x4* kp = (const u32x4*)(KI + ((size_t)b * SEQ + s) * 64);
        float a0 = 0.f, a1 = 0.f, a2 = 0.f, a3 = 0.f;
#pragma unroll 2
        for (int c = 0; c < 8; ++c) { const u32x4 kv = kp[c];
#pragma unroll
            for (int e = 0; e < 4; ++e) { const float klo = __uint_as_float(kv[e] << 16), khi = __uint_as_float(kv[e] & 0xffff0000u); const int d = c * 8 + e * 2;
                a0 += qs[d] * klo + qs[d + 1] * khi; a1 += qs[64 + d] * klo + qs[64 + d + 1] * khi; a2 += qs[128 + d] * klo + qs[128 + d + 1] * khi; a3 += qs[192 + d] * klo + qs[192 + d + 1] * khi; } }
        const float sc = w0 * fmaxf(a0, 0.f) + w1 * fmaxf(a1, 0.f) + w2 * fmaxf(a2, 0.f) + w3 * fmaxf(a3, 0.f);
        key[s] = fkey(sc);
    }
    __syncthreads();
    unsigned prefix = 0u;
    for (int bit = 31; bit >= 0; --bit) {
        const unsigned cand = prefix | (1u << bit);
        if (tid == 0) *cntp = 0u;
        __syncthreads();
        unsigned c = 0u; for (int s = tid; s < n; s += 256) c += (key[s] >= cand) ? 1u : 0u;
        if (c) atomicAdd((unsigned*)cntp, c);
        __syncthreads();
        if (*cntp >= (unsigned)TOPK) prefix = cand;
        __syncthreads();
    }
    if (tid == 0) *cntp = 0u;
    __syncthreads();
    { unsigned c = 0u; for (int s = tid; s < n; s += 256) c += (key[s] > prefix) ? 1u : 0u; if (c) atomicAdd((unsigned*)cntp, c); }
    __syncthreads();
    const unsigned need = (unsigned)TOPK - *cntp;
    __syncthreads();
    const int s0 = tid * 16; unsigned eqc = 0u;
    for (int i = 0; i < 16; ++i) { const int s = s0 + i; if (s < n && key[s] == prefix) ++eqc; }
    scan[tid] = eqc; __syncthreads();
    for (int o = 1; o < 256; o <<= 1) { const unsigned v = (tid >= o) ? scan[tid - o] : 0u; __syncthreads(); scan[tid] += v; __syncthreads(); }
    unsigned eq_before = scan[tid] - eqc; __syncthreads();
    unsigned takec = 0u; unsigned takemask = 0u;
    for (int i = 0; i < 16; ++i) { const int s = s0 + i; if (s < n) { const unsigned k = key[s]; bool take = k > prefix; if (k == prefix) { take = eq_before < need; ++eq_before; } if (take) { ++takec; takemask |= 1u << i; } } }
    scan[tid] = takec; __syncthreads();
    for (int o = 1; o < 256; o <<= 1) { const unsigned v = (tid >= o) ? scan[tid - o] : 0u; __syncthreads(); scan[tid] += v; __syncthreads(); }
    unsigned pos = scan[tid] - takec;
    for (int i = 0; i < 16; ++i) if (takemask & (1u << i)) { if (pos < (unsigned)TOPK) sel[pos] = (unsigned short)(s0 + i); ++pos; }
    __syncthreads();
}
__device__ __forceinline__ void sparse_attn_body(LAS unsigned char* sm, int row, int tid, const bf16_t* Q, const bf16_t* Kb, const bf16_t* Vb, const unsigned short* SEL, bf16_t* MIX) {
    LAS float* qs = (LAS float*)sm; LAS float* lg = qs + 512;   LAS int* idx = (LAS int*)(lg + NH * TOPK);
    const int b = row / SEQ, t = row % SEQ, n = (t + 1 < TOPK) ? t + 1 : TOPK;
    qs[tid] = bf2f(Q[(size_t)row * 512 + tid]); qs[tid + 256] = bf2f(Q[(size_t)row * 512 + 256 + tid]);
    int myidx = 0; if (tid < n) myidx = (int)SEL[(size_t)row * TOPK + tid]; idx[tid] = myidx;
    __syncthreads();
    if (tid < n) {
        const u32x4* kp = (const u32x4*)(Kb + ((size_t)b * SEQ + myidx) * 64);
        float a[NH];
#pragma unroll
        for (int h = 0; h < NH; ++h) a[h] = 0.f;
#pragma unroll 2
        for (int c = 0; c < 8; ++c) { const u32x4 kv = kp[c];
#pragma unroll
            for (int e = 0; e < 4; ++e) { const float klo = __uint_as_float(kv[e] << 16), khi = __uint_as_float(kv[e] & 0xffff0000u); const int d = c * 8 + e * 2;
#pragma unroll
                for (int h = 0; h < NH; ++h) a[h] += qs[h * 64 + d] * klo + qs[h * 64 + d + 1] * khi; } }
#pragma unroll
        for (int h = 0; h < NH; ++h) lg[h * TOPK + tid] = a[h] * 0.125f;
    } else {
#pragma unroll
        for (int h = 0; h < NH; ++h) lg[h * TOPK + tid] = -INFINITY;
    }
    __syncthreads();
    { const int w = tid >> 6, lane = tid & 63;
      for (int hh = 0; hh < 2; ++hh) { const int h = 2 * w + hh; float v[4], m = -INFINITY;
          for (int i = 0; i < 4; ++i) { v[i] = lg[h * TOPK + lane + 64 * i]; m = fmaxf(m, v[i]); }
          m = wave_max(m); float s = 0.f;
          for (int i = 0; i < 4; ++i) { v[i] = __expf(v[i] - m); s += v[i]; }
          s = wave_sum(s); const float inv = 1.f / s;
          for (int i = 0; i < 4; ++i) lg[h * TOPK + lane + 64 * i] = v[i] * inv; } }
    __syncthreads();
    { const int h = tid >> 5, d0 = (tid & 31) * 2; float o0 = 0.f, o1 = 0.f;
      for (int j = 0; j < n; ++j) { const unsigned vv = *(const unsigned*)(Vb + ((size_t)b * SEQ + idx[j]) * 64 + d0); const float p = lg[h * TOPK + j]; o0 += p * __uint_as_float(vv << 16); o1 += p * __uint_as_float(vv & 0xffff0000u); }
      *(unsigned*)(MIX + (size_t)row * DM + h * 64 + d0) = (unsigned)f2bf(o0) | ((unsigned)f2bf(o1) << 16); }
    __syncthreads();
}
__device__ __forceinline__ void convb_body(LAS unsigned char* sm, int row, int tid, const bf16_t* U, const float* __restrict__ cw, const float* __restrict__ cb, const float* __restrict__ lg, const float* __restrict__ lb, bf16_t* MIX) {
    LAS float* red = (LAS float*)sm;
    const int t = row % SEQ;
    float y[2];
    for (int k = 0; k < 2; ++k) { const int c = tid + 256 * k; float acc = cb[c];
        for (int j = 0; j < 31; ++j) { const int tt = t - 30 + j; if (tt >= 0) acc += cw[j * 512 + c] * bf2f(U[(size_t)(row - 30 + j) * 512 + c]); }
        y[k] = acc; }
    float s = wave_sum(y[0] + y[1]); if ((tid & 63) == 0) red[tid >> 6] = s; __syncthreads();
    const float mu = (red[0] + red[1] + red[2] + red[3]) * (1.f / 512.f); __syncthreads();
    float q = wave_sum((y[0] - mu) * (y[0] - mu) + (y[1] - mu) * (y[1] - mu)); if ((tid & 63) == 0) red[4 + (tid >> 6)] = q; __syncthreads();
    const float rstd = 1.f / sqrtf((red[4] + red[5] + red[6] + red[7]) * (1.f / 512.f) + EPS);
    for (int k = 0; k < 2; ++k) { const int c = tid + 256 * k; const float v = (y[k] - mu) * rstd * lg[c] + lb[c]; MIX[(size_t)row * DM + 512 + c] = f2bf(silu_f(v)); }
    __syncthreads();
}
__device__ __forceinline__ void cross_attn_body(LAS unsigned char* sm, int row, int tid, const bf16_t* QC, const bf16_t* KC, const bf16_t* VC, bf16_t* OC) {
    LAS float* qs = (LAS float*)sm; LAS float* lg = qs + DM;
    const int b = row / SEQ;
    for (int c = tid; c < DM; c += 256) qs[c] = bf2f(QC[(size_t)row * DM + c]);
    __syncthreads();
    { const u32x4* kp = (const u32x4*)(KC + ((size_t)b * NMEM + tid) * DM);
      for (int h = 0; h < 4; ++h) { float a = 0.f;
#pragma unroll 4
          for (int c = 0; c < 32; ++c) { const u32x4 kv = kp[h * 32 + c];
#pragma unroll
              for (int e = 0; e < 4; ++e) { const int d = h * 256 + c * 8 + e * 2; a += qs[d] * __uint_as_float(kv[e] << 16) + qs[d + 1] * __uint_as_float(kv[e] & 0xffff0000u); } }
          lg[h * NMEM + tid] = a * 0.0625f; } }
    __syncthreads();
    { const int h = tid >> 6, lane = tid & 63; float v[4], m = -INFINITY;
      for (int i = 0; i < 4; ++i) { v[i] = lg[h * NMEM + lane + 64 * i]; m = fmaxf(m, v[i]); }
      m = wave_max(m); float s = 0.f;
      for (int i = 0; i < 4; ++i) { v[i] = __expf(v[i] - m); s += v[i]; }
      s = wave_sum(s); const float inv = 1.f / s;
      for (int i = 0; i < 4; ++i) lg[h * NMEM + lane + 64 * i] = v[i] * inv; }
    __syncthreads();
    { const int h = tid >> 6, d0 = h * 256 + (tid & 63) * 4; float o0 = 0.f, o1 = 0.f, o2 = 0.f, o3 = 0.f;
      for (int j = 0; j < NMEM; ++j) { const u32x2 vv = *(const u32x2*)(VC + ((size_t)b * NMEM + j) * DM + d0); const float p = lg[h * NMEM + j];
          o0 += p * __uint_as_float(vv.x << 16); o1 += p * __uint_as_float(vv.x & 0xffff0000u); o2 += p * __uint_as_float(vv.y << 16); o3 += p * __uint_as_float(vv.y & 0xffff0000u); }
      u32x2 w; w.x = (unsigned)f2bf(o0) | ((unsigned)f2bf(o1) << 16); w.y = (unsigned)f2bf(o2) | ((unsigned)f2bf(o3) << 16); *(u32x2*)(OC + (size_t)row * DM + d0) = w; }
    __syncthreads();
}

constexpr size_t MiB = 1u << 20;
constexpr int LDS_RING = 131072, LDSCTL_OFF = LDS_RING, MISC_OFF = LDSCTL_OFF + 320, LDS_BYTES = 147456;
constexpr size_t WS_CTL = 476 * MiB, CTL_ZERO_BYTES = 1 * MiB; constexpr int CW_BAR = 4096;
struct Args { const float* in[23]; float* out; unsigned char* ws; };
static_assert(sizeof(Args) == 25 * 8, "Args has no padding");

__global__ void __launch_bounds__(512, 2) mega_k(Args a) {
    extern __shared__ __attribute__((aligned(16))) unsigned char lds_raw[];
    LAS unsigned char* lds = (LAS unsigned char*)lds_raw;
    const int tid = threadIdx.x, lane = tid & 63, wave = __builtin_amdgcn_readfirstlane(tid >> 6), half = tid >> 8, htid = tid & 255;
    const int G = gridDim.x, bx = blockIdx.x;
    LAS unsigned char* hsm = lds + half * 65536;
    const float* x = a.in[0]; const float* mem = a.in[1]; const int* positions = (const int*)a.in[2];
    const float* g_mix = a.in[3]; const float* w_in = a.in[4]; const float* w_out = a.in[5];
    const float* conv_b_w = a.in[6]; const float* conv_b_b = a.in[7]; const float* ln_b_g = a.in[8]; const float* ln_b_b = a.in[9];
    const float* g_cross = a.in[10]; const float* g_mem = a.in[11];
    const float* w_q = a.in[12]; const float* w_k = a.in[13]; const float* w_v = a.in[14]; const float* w_o = a.in[15];
    const float* g_ffn = a.in[16]; const float* w_gate = a.in[17]; const float* w_up = a.in[18];
    const float* ffn_cw = a.in[19]; const float* ffn_cb = a.in[20]; const float* w_down = a.in[21]; const float* g_final = a.in[22];
    float* out = a.out; unsigned char* ws = a.ws;
    bf16_t* wt_in = (bf16_t*)(ws + 0 * MiB); bf16_t* wt_out = (bf16_t*)(ws + 4 * MiB);
    bf16_t* wt_q = (bf16_t*)(ws + 6 * MiB), *wt_k = (bf16_t*)(ws + 8 * MiB), *wt_v = (bf16_t*)(ws + 10 * MiB), *wt_o = (bf16_t*)(ws + 12 * MiB);
    bf16_t* wt_gate = (bf16_t*)(ws + 14 * MiB); bf16_t* wt_up = (bf16_t*)(ws + 20 * MiB); bf16_t* wt_down = (bf16_t*)(ws + 26 * MiB);
    float* WI = (float*)(ws + 32 * MiB);
    bf16_t* MEMN = (bf16_t*)(ws + 34 * MiB), *KC = (bf16_t*)(ws + 38 * MiB), *VC = (bf16_t*)(ws + 42 * MiB);
    bf16_t* XN = (bf16_t*)(ws + 48 * MiB); float* PROJ = (float*)(ws + 112 * MiB);
    bf16_t* Qb = (bf16_t*)(ws + 368 * MiB); bf16_t* QI = (bf16_t*)(ws + 400 * MiB);
    bf16_t* Kb = (bf16_t*)(ws + 416 * MiB), *Vb = (bf16_t*)(ws + 420 * MiB), *KI = (bf16_t*)(ws + 424 * MiB);
    bf16_t* U = (bf16_t*)(ws + 428 * MiB); unsigned short* SEL = (unsigned short*)(ws + 460 * MiB);
    bf16_t* MIX = (bf16_t*)(ws + 112 * MiB); bf16_t* QC = (bf16_t*)(ws + 176 * MiB); bf16_t* OC = (bf16_t*)(ws + 240 * MiB);
    bf16_t* Gb = (bf16_t*)(ws + 112 * MiB); bf16_t* UF = (bf16_t*)(ws + 288 * MiB);
    unsigned* ctl = (unsigned*)(ws + WS_CTL);

    for (int u = tid; u < (LDS_BYTES - LDSCTL_OFF) / 4; u += 512) ((LAS unsigned*)(lds + LDSCTL_OFF))[u] = 0u;
    __syncthreads();
    XcdBarrier bar = xcd_barrier_post(ctl + CW_BAR, (volatile LAS unsigned*)(lds + MISC_OFF) + 8);
#define GRID_BAR() xcd_barrier(bar)
#define FOR_VB(nvb) for (int vb = 2 * bx + half; vb < (nvb); vb += 2 * G)
#define GEMM(Aptr, Bptr, Mv, Nv, Kv, OF, OB, RES, LDC) do { pg8::Gemm g_{Aptr, Bptr, Mv, Nv, Kv}; pg8::StaticOrder S_; S_.init(Mv, Nv, G, bx); EpiStore E_{OF, OB, RES, LDC}; \
        pg8::gemm_phase<EpiStore, pg8::StaticOrder, true, true>(lds, g_, S_, E_); } while (0)

    for (int i = bx * 512 + tid; i < (INP - INC) * DM; i += G * 512) wt_in[(size_t)INC * DM + i] = 0;
    FOR_VB(32 * 63) wt_body(hsm, vb, htid, w_in, DM, INC, wt_in);
    FOR_VB(32 * 32) wt_body(hsm, vb, htid, w_out, DM, DM, wt_out);
    FOR_VB(32 * 32) wt_body(hsm, vb, htid, w_q, DM, DM, wt_q);
    FOR_VB(32 * 32) wt_body(hsm, vb, htid, w_k, DM, DM, wt_k);
    FOR_VB(32 * 32) wt_body(hsm, vb, htid, w_v, DM, DM, wt_v);
    FOR_VB(32 * 32) wt_body(hsm, vb, htid, w_o, DM, DM, wt_o);
    FOR_VB(32 * 88) wt_body(hsm, vb, htid, w_gate, DM, DFF, wt_gate);
    FOR_VB(32 * 88) wt_body(hsm, vb, htid, w_up, DM, DFF, wt_up);
    FOR_VB(88 * 32) wt_body(hsm, vb, htid, w_down, DFF, DM, wt_down);
    for (int r = bx * 8 + wave; r < MTOK; r += G * 8) rmsnorm_bf16_row(x, g_mix, XN, r, lane);
    for (int r = bx * 8 + wave; r < MMEM; r += G * 8) rmsnorm_bf16_row(mem, g_mem, MEMN, r, lane);
    GRID_BAR();
    GEMM(XN, wt_in, MTOK, INP, DM, PROJ, (bf16_t*)nullptr, (const float*)nullptr, INP);
    GEMM(MEMN, wt_k, MMEM, DM, DM, (float*)nullptr, KC, (const float*)nullptr, DM);
    GEMM(MEMN, wt_v, MMEM, DM, DM, (float*)nullptr, VC, (const float*)nullptr, DM);
    GRID_BAR();
    FOR_VB(MTOK) split_rope_body(hsm, vb, htid, PROJ, positions, Qb, Kb, Vb, QI, KI, WI, U);
    GRID_BAR();
    FOR_VB(MTOK) topk_body(hsm, vb, htid, QI, KI, WI, SEL);
    __syncthreads();
    FOR_VB(MTOK) convb_body(hsm, vb, htid, U, conv_b_w, conv_b_b, ln_b_g, ln_b_b, MIX);
    GRID_BAR();
    FOR_VB(MTOK) sparse_attn_body(hsm, vb, htid, Qb, Kb, Vb, SEL, MIX);
    GRID_BAR();
    GEMM(MIX, wt_out, MTOK, DM, DM, out, (bf16_t*)nullptr, x, DM);
    GRID_BAR();
    for (int r = bx * 8 + wave; r < MTOK; r += G * 8) rmsnorm_bf16_row(out, g_cross, XN, r, lane);
    GRID_BAR();
    GEMM(XN, wt_q, MTOK, DM, DM, (float*)nullptr, QC, (const float*)nullptr, DM);
    GRID_BAR();
    FOR_VB(MTOK) cross_attn_body(hsm, vb, htid, QC, KC, VC, OC);
    GRID_BAR();
    GEMM(OC, wt_o, MTOK, DM, DM, out, (bf16_t*)nullptr, out, DM);
    GRID_BAR();
    for (int r = bx * 8 + wave; r < MTOK; r += G * 8) rmsnorm_bf16_row(out, g_ffn, XN, r, lane);
    GRID_BAR();
    GEMM(XN, wt_gate, MTOK, DFF, DM, (float*)nullptr, Gb, (const float*)nullptr, DFF);
    GEMM(XN, wt_up, MTOK, DFF, DM, (float*)nullptr, UF, (const float*)nullptr, DFF);
    GRID_BAR();
    for (size_t i = (size_t)bx * 512 + tid; i < (size_t)MTOK * DFF; i += (size_t)G * 512) {
        const int c = (int)(i % DFF); const size_t row = i / DFF; const int t = (int)(row % SEQ);
        float g = ffn_cb[c] + ffn_cw[2 * DFF + c] * bf2f(Gb[i]);
        if (t >= 1) g += ffn_cw[1 * DFF + c] * bf2f(Gb[i - DFF]);
        if (t >= 2) g += ffn_cw[0 * DFF + c] * bf2f(Gb[i - 2 * DFF]);
        UF[i] = f2bf(silu_f(g) * bf2f(UF[i]));
    }
    GRID_BAR();
    GEMM(UF, wt_down, MTOK, DM, DFF, out, (bf16_t*)nullptr, out, DM);
    GRID_BAR();
    for (int r = bx * 8 + wave; r < MTOK; r += G * 8) rmsnorm_f32_row(out, g_final, r, lane);
}

extern "C" void kernel_launch(void* const* d_in, const int* in_sizes, int n_in, void* d_out, int out_size, void* d_ws, size_t ws_size, hipStream_t stream) {
    static int grid = 0;
    if (grid == 0) {
        int dev = 0, cus = 0, per_cu = 0;
        if (hipGetDevice(&dev) != hipSuccess || hipDeviceGetAttribute(&cus, hipDeviceAttributeMultiprocessorCount, dev) != hipSuccess) { fprintf(stderr, "kernel_launch: device query failed\n"); grid = -1; return; }
        if (hipFuncSetAttribute((const void*)mega_k, hipFuncAttributeMaxDynamicSharedMemorySize, LDS_BYTES) != hipSuccess) { fprintf(stderr, "kernel_launch: hipFuncSetAttribute failed\n"); grid = -1; return; }
        if (hipOccupancyMaxActiveBlocksPerMultiprocessor(&per_cu, (const void*)mega_k, 512, LDS_BYTES) != hipSuccess || per_cu < 1) { fprintf(stderr, "kernel_launch: occupancy query says %d\n", per_cu); per_cu = 1; }
        (void)hipGetLastError();
        grid = cus * 1;
        if (n_in != 23 || ws_size < 477 * MiB) { fprintf(stderr, "kernel_launch: unexpected n_in %d / ws %zu\n", n_in, ws_size); grid = -1; return; }
    }
    if (grid < 0) return;
    (void)hipMemsetAsync((char*)d_ws + WS_CTL, 0, CTL_ZERO_BYTES, stream);
    Args a{};
    for (int i = 0; i < 23; ++i) a.in[i] = (const float*)d_in[i];
    a.out = (float*)d_out; a.ws = (unsigned char*)d_ws;
    void* params[] = {&a};
    hipError_t e = hipLaunchCooperativeKernel((const void*)mega_k, dim3(grid), dim3(512), params, LDS_BYTES, stream);
    if (e != hipSuccess) fprintf(stderr, "cooperative launch failed: %s (grid %d)\n", hipGetErrorString(e), grid);
}
```

```cpp
#include <hip/hip_runtime.h>
#include <cstdio>
#include <cstdint>
#include <cmath>
namespace pg8 {
#define PG8_LAS __attribute__((address_space(3)))
typedef unsigned short bf16_t;
typedef short bf16x8 __attribute__((ext_vector_type(8)));
typedef float f32x4 __attribute__((ext_vector_type(4)));
typedef unsigned u32x4 __attribute__((ext_vector_type(4)));
constexpr int BM = 256, BK = 64, HALF = 128, HTB = HALF * BK * 2  , STAGE_BYTES = 8 * HTB, NXCD = 8, WGM = 8;

__host__ __device__ __forceinline__ int lds_byte(int r, int c) { const int st = (r >> 4) * 2 + (c >> 5), rr = r & 15, cc = c & 31, ob = rr * 64 + cc * 2; return st * 1024 + (ob ^ (((ob >> 9) & 1) << 5)); }
__host__ __device__ __forceinline__ void stage_rc(int b, int& R, int& C) { const int st = b / 1024, sb = b % 1024, swz = sb ^ (((sb >> 9) & 1) << 5); R = (st >> 1) * 16 + swz / 64; C = (st & 1) * 32 + (swz % 64) / 2; }
__host__ __device__ __forceinline__ int perm32(int rho) { const int n = rho >> 4, i = rho & 15; return 8 * (i >> 2) + 4 * n + (i & 3); }

struct Unit { int pm, pn; };
struct Gemm { const bf16_t* A; const bf16_t* Bt; int M, N, K; };

struct StaticOrder {
    int nM, nN, nwg, G, c;
    __host__ __device__ void init(int M, int N, int G_, int c_) { nM = M / BM; nN = N / BM; nwg = nM * nN; G = G_; c = c_; }
    __host__ __device__ bool next(int i, Unit& u) const {
        const long L = (long)i * G + c; if (L >= nwg) return false;
        int wgid = (int)L; { const int q = nwg / NXCD, r = nwg % NXCD, xcd = wgid % NXCD, off = wgid / NXCD; wgid = (xcd < r ? xcd * (q + 1) : r * (q + 1) + (xcd - r) * q) + off; }
        const int nig = WGM * nN, gid = wgid / nig, fm = gid * WGM, gsz = (nM - fm) < WGM ? (nM - fm) : WGM;
        u.pm = fm + ((wgid % nig) % gsz); u.pn = (wgid % nig) / gsz; return true;
    }
    __device__ __forceinline__ void a_ready(const Unit&) const {}
    __device__ __forceinline__ void done(const Unit&) const {}
};
__device__ __forceinline__ unsigned cvt_pk_bf16(float lo, float hi) { unsigned r; asm volatile("v_cvt_pk_bf16_f32 %0, %1, %2" : "=v"(r) : "v"(lo), "v"(hi)); return r; }
template <class Epi, class Sched, bool ALIGN_EPI = false, bool SP2 = false>
__device__ __forceinline__ void gemm_phase(PG8_LAS unsigned char* lds, const Gemm g, const Sched& S, const Epi& E) {
    int tid_l = threadIdx.x; asm volatile("" : "+v"(tid_l));
    const int tid = tid_l, wid = __builtin_amdgcn_readfirstlane(tid >> 6), lane = tid & 63, wr = wid >> 2, wc = wid & 3, fr = lane & 15, fq = lane >> 4;
    const int K = g.K, nt = K / BK;
    unsigned voffA[2], voffB[2];
#pragma unroll
    for (int i = 0; i < 2; ++i) { int R, C; stage_rc(tid * 16 + i * 8192, R, C); const int Rb = Epi::PERM ? ((R & ~31) + perm32(R & 31)) : R;
        voffA[i] = (unsigned)(R * K + C) * 2u; voffB[i] = (unsigned)(Rb * K + C) * 2u; }
    const size_t kstep = (size_t)(BK * 2);
    const size_t hstep = (size_t)HALF * K * 2;
    const size_t tstep = 2 * hstep;
    const unsigned ldsw = (unsigned)wid * 1024u;
    const int aoff = lds_byte(wr * 64 + fr, fq * 8), boff = lds_byte(wc * 32 + fr, fq * 8);
#define PG8_SA(b, h) (((b) * 2 + (h)) * HTB)
#define PG8_SB(b, h) ((4 + (b) * 2 + (h)) * HTB)
#define PG8_STAGE(bufoff, gbase, voff) do { _Pragma("unroll") for (int _i = 0; _i < 2; ++_i) \
        __builtin_amdgcn_global_load_lds((const unsigned*)((const char*)(gbase) + (voff)[_i]), (PG8_LAS unsigned*)(lds + (bufoff) + ldsw + _i * 8192), 16, 0, 0); } while (0)
#define PG8_LDA(dst, b, h) do { _Pragma("unroll") for (int m = 0; m < 4; ++m) _Pragma("unroll") for (int k = 0; k < 2; ++k) dst[m][k] = *(const PG8_LAS bf16x8*)(lds + PG8_SA(b, h) + aoff + m * 2048 + k * 1024); } while (0)
#define PG8_LDB(dst, b, h) do { _Pragma("unroll") for (int n = 0; n < 2; ++n) _Pragma("unroll") for (int k = 0; k < 2; ++k) dst[n][k] = *(const PG8_LAS bf16x8*)(lds + PG8_SB(b, h) + boff + n * 2048 + k * 1024); } while (0)
#define PG8_MMA(ai, bj, At, Bt) do { __builtin_amdgcn_s_setprio(1); _Pragma("unroll") for (int m = 0; m < 4; ++m) _Pragma("unroll") for (int n = 0; n < 2; ++n) _Pragma("unroll") for (int k = 0; k < 2; ++k) \
        acc[ai][bj][m][n] = __builtin_amdgcn_mfma_f32_16x16x32_bf16(Bt[n][k], At[m][k], acc[ai][bj][m][n], 0, 0, 0); __builtin_amdgcn_s_setprio(0); } while (0)
#define PG8_WAIT_V(n) asm volatile("s_waitcnt vmcnt(" #n ")" ::: "memory")
#define PG8_WAIT_L(n) asm volatile("s_waitcnt lgkmcnt(" #n ")" ::: "memory")
#define PG8_BAR __builtin_amdgcn_s_barrier()
#define PG8_SCHED __builtin_amdgcn_sched_barrier(0)
    Unit cur, nxt; int ui = 0;
    if (!S.next(0, cur)) return;
    f32x4 acc[2][2][4][2];
#pragma unroll
    for (int a = 0; a < 2; ++a)
#pragma unroll
        for (int b = 0; b < 2; ++b)
#pragma unroll
            for (int m = 0; m < 4; ++m)
#pragma unroll
                for (int n = 0; n < 2; ++n) acc[a][b][m][n] = (f32x4){0.f, 0.f, 0.f, 0.f};
    bf16x8 At[4][2], B0[2][2], B1[2][2];
    const char* cA = (const char*)g.A + (size_t)cur.pm * tstep; const char* cB = (const char*)g.Bt + (size_t)cur.pn * tstep;
    S.a_ready(cur);
    if constexpr (SP2) {
        PG8_STAGE(PG8_SB(0, 0), cB, voffB); PG8_STAGE(PG8_SB(0, 1), cB + hstep, voffB); PG8_STAGE(PG8_SA(0, 0), cA, voffA); PG8_STAGE(PG8_SA(0, 1), cA + hstep, voffA);
        if (wr == 1) PG8_BAR;
        PG8_WAIT_V(2); PG8_BAR;
        PG8_STAGE(PG8_SB(1, 0), cB + kstep, voffB); PG8_STAGE(PG8_SA(1, 0), cA + kstep, voffA); PG8_STAGE(PG8_SB(1, 1), cB + hstep + kstep, voffB);
        PG8_WAIT_V(6); PG8_BAR;
    } else {
        PG8_STAGE(PG8_SB(0, 0), cB, voffB); PG8_STAGE(PG8_SA(0, 0), cA, voffA); PG8_STAGE(PG8_SB(0, 1), cB + hstep, voffB); PG8_STAGE(PG8_SA(0, 1), cA + hstep, voffA);
        if (wr == 1) PG8_BAR;
        PG8_WAIT_V(4); PG8_BAR;
        PG8_STAGE(PG8_SB(1, 0), cB + kstep, voffB); PG8_STAGE(PG8_SA(1, 0), cA + kstep, voffA); PG8_STAGE(PG8_SB(1, 1), cB + hstep + kstep, voffB);
        PG8_WAIT_V(6); PG8_BAR;
    }
    for (;;) {
        const bool has_next = S.next(ui + 1, nxt);
        const char* nA = has_next ? (const char*)g.A + (size_t)nxt.pm * tstep : cA; const char* nB = has_next ? (const char*)g.Bt + (size_t)nxt.pn * tstep : cB;
        for (int t = 0; t < nt; t += 2) {
            const bool last = (t == nt - 2);
            const char* a1 = cA + (size_t)(t + 1) * kstep;
            const char* a2 = last ? nA : cA + (size_t)(t + 2) * kstep; const char* b2 = last ? nB : cB + (size_t)(t + 2) * kstep;
            const char* a3 = a2 + kstep; const char* b3 = b2 + kstep;
            if (last && has_next) S.a_ready(nxt);
            if constexpr (SP2) {
            PG8_LDB(B0, 0, 0); PG8_LDB(B1, 0, 1); PG8_SCHED; PG8_LDA(At, 0, 0); PG8_STAGE(PG8_SA(1, 1), a1 + hstep, voffA);
            PG8_WAIT_V(8); PG8_WAIT_L(0); PG8_BAR; PG8_MMA(0, 0, At, B0); PG8_MMA(0, 1, At, B1); PG8_BAR; PG8_SCHED;
            PG8_LDA(At, 0, 1); PG8_STAGE(PG8_SB(0, 0), b2, voffB); PG8_STAGE(PG8_SB(0, 1), b2 + hstep, voffB); PG8_STAGE(PG8_SA(0, 0), a2, voffA);
            PG8_WAIT_V(8); PG8_WAIT_L(0); PG8_BAR; PG8_MMA(1, 0, At, B0); PG8_MMA(1, 1, At, B1); PG8_BAR; PG8_SCHED;
            PG8_LDB(B0, 1, 0); PG8_LDB(B1, 1, 1); PG8_SCHED; PG8_LDA(At, 1, 0); PG8_STAGE(PG8_SA(0, 1), a2 + hstep, voffA);
            PG8_WAIT_V(8); PG8_WAIT_L(0); PG8_BAR; PG8_MMA(0, 0, At, B0); PG8_MMA(0, 1, At, B1); PG8_BAR; PG8_SCHED;
            PG8_LDA(At, 1, 1); PG8_STAGE(PG8_SB(1, 0), b3, voffB); PG8_STAGE(PG8_SB(1, 1), b3 + hstep, voffB); PG8_STAGE(PG8_SA(1, 0), a3, voffA);
            PG8_WAIT_V(8); PG8_WAIT_L(0); PG8_BAR; PG8_MMA(1, 0, At, B0); PG8_MMA(1, 1, At, B1); PG8_BAR; PG8_SCHED;
            } else {
            PG8_LDB(B0, 0, 0); PG8_SCHED; PG8_LDA(At, 0, 0); PG8_STAGE(PG8_SA(1, 1), a1 + hstep, voffA);
            PG8_WAIT_L(8); PG8_BAR; PG8_WAIT_L(0); PG8_MMA(0, 0, At, B0); PG8_BAR; PG8_SCHED;
            PG8_LDB(B1, 0, 1); PG8_STAGE(PG8_SB(0, 0), b2, voffB);
            PG8_BAR; PG8_WAIT_L(0); PG8_MMA(0, 1, At, B1); PG8_BAR;
            PG8_LDA(At, 0, 1); PG8_STAGE(PG8_SA(0, 0), a2, voffA);
            PG8_BAR; PG8_WAIT_L(0); PG8_MMA(1, 0, At, B0); PG8_BAR; PG8_SCHED;
            PG8_STAGE(PG8_SB(0, 1), b2 + hstep, voffB);
            PG8_WAIT_V(6); PG8_BAR; PG8_MMA(1, 1, At, B1); PG8_BAR;
            PG8_LDB(B0, 1, 0); PG8_SCHED; PG8_LDA(At, 1, 0); PG8_STAGE(PG8_SA(0, 1), a2 + hstep, voffA);
            PG8_WAIT_L(8); PG8_BAR; PG8_WAIT_L(0); PG8_MMA(0, 0, At, B0); PG8_BAR; PG8_SCHED;
            PG8_LDB(B1, 1, 1); PG8_STAGE(PG8_SB(1, 0), b3, voffB);
            PG8_BAR; PG8_WAIT_L(0); PG8_MMA(0, 1, At, B1); PG8_BAR;
            PG8_LDA(At, 1, 1); PG8_STAGE(PG8_SA(1, 0), a3, voffA);
            PG8_BAR; PG8_WAIT_L(0); PG8_MMA(1, 0, At, B0); PG8_BAR; PG8_SCHED;
            PG8_STAGE(PG8_SB(1, 1), b3 + hstep, voffB);
            PG8_WAIT_V(6); PG8_BAR; PG8_MMA(1, 1, At, B1); PG8_BAR;
            }
        }
        if constexpr (ALIGN_EPI) { if (wr == 0) PG8_BAR; }
        if constexpr (!Epi::AFTER_DRAIN) { E(acc, cur, wr, wc, fr, fq); S.done(cur); }
        if (!has_next) break;
#pragma unroll
        for (int a = 0; a < 2; ++a)
#pragma unroll
            for (int b = 0; b < 2; ++b)
#pragma unroll
                for (int m = 0; m < 4; ++m)
#pragma unroll
                    for (int n = 0; n < 2; ++n) acc[a][b][m][n] = (f32x4){0.f, 0.f, 0.f, 0.f};
        cur = nxt; cA = nA; cB = nB; ++ui;
        if constexpr (ALIGN_EPI) { if (wr == 1) PG8_BAR; }
    }
    PG8_WAIT_V(0);
    if constexpr (!ALIGN_EPI) { if (wr == 0) PG8_BAR; }
    PG8_BAR;
    if constexpr (Epi::AFTER_DRAIN) { E.fused(acc, cur, wr, wc, fr, fq, lds, wid, lane); S.done(cur); }
#undef PG8_SA
#undef PG8_SB
#undef PG8_STAGE
#undef PG8_LDA
#undef PG8_LDB
#undef PG8_MMA
#undef PG8_WAIT_V
#undef PG8_WAIT_L
#undef PG8_BAR
#undef PG8_SCHED
}
}

constexpr int BATCH = 8, SEQ = 4096, DM = 1024, MTOK = BATCH * SEQ;
constexpr int NMEM = 256, MMEM = BATCH * NMEM;
constexpr int AW = 512, HD = 64, NH = 8, IH = 4, TOPK = 256;
constexpr int INC = 1988, INP = 2048;
constexpr int DFF = 2816;
constexpr float EPS = 1e-6f;
#define LAS __attribute__((address_space(3)))
typedef unsigned short bf16_t;
typedef float f32x4 __attribute__((ext_vector_type(4)));
typedef unsigned u32x4 __attribute__((ext_vector_type(4)));
typedef unsigned u32x2 __attribute__((ext_vector_type(2)));

__device__ __forceinline__ float bf2f(bf16_t v) { return __uint_as_float((unsigned)v << 16); }
__device__ __forceinline__ bf16_t f2bf(float f) { unsigned u = __float_as_uint(f); return (bf16_t)((u + 0x7fffu + ((u >> 16) & 1u)) >> 16); }
__device__ __forceinline__ float wave_sum(float v) {
#pragma unroll
    for (int o = 1; o < 64; o <<= 1) v += __shfl_xor(v, o);
    return v;
}
__device__ __forceinline__ float wave_max(float v) {
#pragma unroll
    for (int o = 1; o < 64; o <<= 1) v = fmaxf(v, __shfl_xor(v, o));
    return v;
}
__device__ __forceinline__ float silu_f(float v) { return v / (1.f + __expf(-v)); }

struct EpiStore {
    static constexpr bool PERM = false, AFTER_DRAIN = false;
    float* outf; bf16_t* outb; const float* res; int ldc;
    __device__ __forceinline__ void operator()(const pg8::f32x4 (&acc)[2][2][4][2], const pg8::Unit& u, int wr, int wc, int fr, int fq) const {
        const int col0 = u.pn * 256 + wc * 32 + 4 * fq;
#pragma unroll
        for (int ai = 0; ai < 2; ++ai)
#pragma unroll
            for (int m = 0; m < 4; ++m) {
                const size_t row = (size_t)(u.pm * 256 + ai * 128 + wr * 64 + m * 16 + fr);
#pragma unroll
                for (int bj = 0; bj < 2; ++bj)
#pragma unroll
                    for (int n = 0; n < 2; ++n) {
                        const size_t off = row * ldc + col0 + bj * 128 + n * 16;
                        pg8::f32x4 v = acc[ai][bj][m][n];
                        if (res) { const pg8::f32x4 r = *(const pg8::f32x4*)(res + off); v = v + r; }
                        if (outf) *(pg8::f32x4*)(outf + off) = v;
                        if (outb) { u32x2 w; w.x = (unsigned)f2bf(v[0]) | ((unsigned)f2bf(v[1]) << 16); w.y = (unsigned)f2bf(v[2]) | ((unsigned)f2bf(v[3]) << 16); *(u32x2*)(outb + off) = w; }
                    }
            }
    }
};
#define XB_TMO      128
#define XB_XCNT(j)  (256  + 64 * (j))
#define XB_XSUB(j)  (1280 + 64 * (j))
#define XB_XGEN(j)  (2304 + 64 * (j))
#define XB_TOP      3328
#define XB_TOPGEN   3392
#define XCD_BAR_WORDS 3456
#define XB_SPIN_CAP (1u << 18)

__device__ __forceinline__ unsigned xb_ld(unsigned* p)              { return __hip_atomic_load(p, __ATOMIC_RELAXED, __HIP_MEMORY_SCOPE_AGENT); }
__device__ __forceinline__ unsigned xb_add(unsigned* p, unsigned v) { return __hip_atomic_fetch_add(p, v, __ATOMIC_RELAXED, __HIP_MEMORY_SCOPE_AGENT); }
__device__ __forceinline__ unsigned xb_xcc_id() { return (unsigned)__builtin_amdgcn_s_getreg((3 << 11) | 20) & 0xFu; }
#define XB_SPIN(cond, bar) do { unsigned _sp = 0; while (cond) { __builtin_amdgcn_s_sleep(1); \
    if ((++_sp & 255u) == 0u) { if (xb_ld(&(bar)[XB_TMO])) break; if (_sp > XB_SPIN_CAP) { atomicAdd(&(bar)[XB_TMO], 1u); break; } } } } while (0)

struct XcdBarrier {
    unsigned* bar; unsigned x;
    volatile LAS unsigned* st;
};

__device__ __forceinline__ XcdBarrier xcd_barrier_post(unsigned* bar, volatile LAS unsigned* st) {
    XcdBarrier b; b.bar = bar; b.x = xb_xcc_id(); b.st = st;
    if (threadIdx.x == 0) (void)xb_add(&bar[XB_XCNT(b.x)], 1u);
    return b;
}
__device__ __forceinline__ void xcd_barrier_complete(unsigned* bar, unsigned x, unsigned& nloc, unsigned& nx) {
    const unsigned G = gridDim.x * gridDim.y * gridDim.z;
    unsigned sum, cnt, mine, sp = 0u;
    for (;;) {
        sum = 0u; cnt = 0u; mine = 0u;
#pragma unroll
        for (unsigned j = 0; j < 16; ++j) { const unsigned c = xb_ld(&bar[XB_XCNT(j)]); sum += c; cnt += (c > 0u) ? 1u : 0u; mine = (j == x) ? c : mine; }
        if (sum == G) break;
        __builtin_amdgcn_s_sleep(1);
        if ((++sp & 255u) == 0u) { if (xb_ld(&bar[XB_TMO])) break; if (sp > XB_SPIN_CAP) { atomicAdd(&bar[XB_TMO], 1u); break; } }
    }
    nloc = mine > 0u ? mine : 1u; nx = cnt > 0u ? cnt : 1u;
}

__device__ __forceinline__ void xcd_barrier(const XcdBarrier& b) {
    asm volatile("s_waitcnt vmcnt(0)" ::: "memory");
    __syncthreads();
    if (threadIdx.x == 0) {
        unsigned* bar = b.bar;
        __builtin_amdgcn_s_waitcnt(0);
        unsigned nloc = b.st[0], nx = b.st[1];
        if (nloc == 0u) { xcd_barrier_complete(bar, b.x, nloc, nx); b.st[0] = nloc; b.st[1] = nx; }
        const unsigned old = xb_add(&bar[XB_XSUB(b.x)], 1u);
        const unsigned gen = old / nloc;
        if (old + 1u == (gen + 1u) * nloc) {
            __builtin_amdgcn_fence(__ATOMIC_RELEASE, "agent");
            asm volatile("s_waitcnt vmcnt(0)" ::: "memory");
            const unsigned og = xb_add(&bar[XB_TOP], 1u);
            const unsigned tg = og / nx;
            if (og + 1u == (tg + 1u) * nx) xb_add(&bar[XB_TOPGEN], 1u);
            else XB_SPIN(xb_ld(&bar[XB_TOPGEN]) == tg, bar);
            __builtin_amdgcn_fence(__ATOMIC_ACQUIRE, "agent");
            xb_add(&bar[XB_XGEN(b.x)], 1u);
            asm volatile("s_waitcnt vmcnt(0)" ::: "memory");
        } else {
            XB_SPIN(xb_ld(&bar[XB_XGEN(b.x)]) == gen, bar);
            __builtin_amdgcn_fence(__ATOMIC_ACQUIRE, "agent");
            asm volatile("s_waitcnt vmcnt(0)" ::: "memory");
        }
    }
    __syncthreads();
}
typedef short bf16x8v __attribute__((ext_vector_type(8)));
constexpr int CA_STRIDE = 528;
__device__ __forceinline__ void cross_attn_unit(LAS unsigned char* lds, int b, int h, int qb, const bf16_t* QC, const bf16_t* KC, const bf16_t* VT, bf16_t* OC, int tid, int lane, int wave) {
    const int q16 = lane & 15, g = lane >> 4;
    const size_t row0 = (size_t)b * SEQ + (size_t)qb * 256 + wave * 32;
    asm volatile("" : "+v"(tid));
    { const bf16_t* src = KC + ((size_t)b * NMEM + (tid >> 5)) * DM + h * 256 + (tid & 31) * 8; LAS unsigned char* dst = lds + (tid >> 5) * CA_STRIDE + (tid & 31) * 16;
#pragma unroll
      for (int i = 0; i < 16; ++i) { const u32x4 v = *(const u32x4*)(src + (size_t)i * 16 * DM); *(LAS u32x4*)(dst + i * 16 * CA_STRIDE) = v; } }
    __syncthreads();
    f32x4 S[2][16];
#pragma unroll
    for (int st = 0; st < 2; ++st)
#pragma unroll
        for (int kt = 0; kt < 16; ++kt) S[st][kt] = (f32x4){0.f, 0.f, 0.f, 0.f};
#pragma unroll 1
    for (int kh = 0; kh < 2; ++kh) {
        bf16x8v qf[2][4];
#pragma unroll
        for (int st = 0; st < 2; ++st)
#pragma unroll
            for (int ks = 0; ks < 4; ++ks) qf[st][ks] = *(const bf16x8v*)(QC + (row0 + st * 16 + q16) * DM + h * 256 + kh * 128 + ks * 32 + g * 8);
        const LAS unsigned char* kb = lds + q16 * CA_STRIDE + kh * 256 + g * 16;
#pragma unroll
        for (int kt = 0; kt < 16; ++kt)
#pragma unroll
            for (int ks = 0; ks < 4; ++ks) { const bf16x8v a = *(const LAS bf16x8v*)(kb + kt * 16 * CA_STRIDE + ks * 64);
                S[0][kt] = __builtin_amdgcn_mfma_f32_16x16x32_bf16(a, qf[0][ks], S[0][kt], 0, 0, 0);
                S[1][kt] = __builtin_amdgcn_mfma_f32_16x16x32_bf16(a, qf[1][ks], S[1][kt], 0, 0, 0); }
    }
    const float c2 = 0.0625f * 1.4426950408889634f;
    float linv[2]; bf16x8v P[2][8];
#pragma unroll
    for (int st = 0; st < 2; ++st) {
        float m = -INFINITY;
#pragma unroll
        for (int kt = 0; kt < 16; ++kt) m = fmaxf(fmaxf(fmaxf(S[st][kt][0], S[st][kt][1]), fmaxf(S[st][kt][2], S[st][kt][3])), m);
        m = fmaxf(m, __shfl_xor(m, 16)); m = fmaxf(m, __shfl_xor(m, 32));
        const float mc = m * c2; float l = 0.f;
#pragma unroll
        for (int kt = 0; kt < 16; ++kt)
#pragma unroll
            for (int r = 0; r < 4; ++r) { const float p = __builtin_amdgcn_exp2f(S[st][kt][r] * c2 - mc); S[st][kt][r] = p; l += p; }
        l += __shfl_xor(l, 16); l += __shfl_xor(l, 32); linv[st] = 1.f / l;
#pragma unroll
        for (int c = 0; c < 8; ++c) { bf16x8v pk;
#pragma unroll
            for (int j = 0; j < 4; ++j) { pk[j] = (short)f2bf(S[st][2 * c][j]); pk[4 + j] = (short)f2bf(S[st][2 * c + 1][j]); }
            P[st][c] = pk; }
    }
    __syncthreads();
    { int tid2 = tid; asm volatile("" : "+v"(tid2));
      const bf16_t* src = VT + (size_t)(h * 256 + (tid2 >> 5)) * MMEM + b * NMEM + (tid2 & 31) * 8; LAS unsigned char* dst = lds + (tid2 >> 5) * CA_STRIDE + (tid2 & 31) * 16;
#pragma unroll
      for (int i = 0; i < 16; ++i) { const u32x4 v = *(const u32x4*)(src + (size_t)i * 16 * MMEM); *(LAS u32x4*)(dst + i * 16 * CA_STRIDE) = v; } }
    __syncthreads();
#pragma unroll 1
    for (int dh = 0; dh < 2; ++dh) {
        f32x4 O[2][8];
#pragma unroll
        for (int st = 0; st < 2; ++st)
#pragma unroll
            for (int dt = 0; dt < 8; ++dt) O[st][dt] = (f32x4){0.f, 0.f, 0.f, 0.f};
        const LAS unsigned char* pb = lds + (dh * 128 + q16) * CA_STRIDE + g * 8;
#pragma unroll
        for (int dt = 0; dt < 8; ++dt)
#pragma unroll
            for (int c = 0; c < 8; ++c) { const LAS unsigned char* p = pb + dt * 16 * CA_STRIDE + c * 64;
                const u32x2 lo = *(const LAS u32x2*)p, hi = *(const LAS u32x2*)(p + 32);
                const u32x4 av = (u32x4){lo.x, lo.y, hi.x, hi.y}; const bf16x8v a = __builtin_bit_cast(bf16x8v, av);
                O[0][dt] = __builtin_amdgcn_mfma_f32_16x16x32_bf16(a, P[0][c], O[0][dt], 0, 0, 0);
                O[1][dt] = __builtin_amdgcn_mfma_f32_16x16x32_bf16(a, P[1][c], O[1][dt], 0, 0, 0); }
#pragma unroll
        for (int st = 0; st < 2; ++st)
#pragma unroll
            for (int dt = 0; dt < 8; ++dt) { const f32x4 o = O[st][dt] * linv[st]; u32x2 w;
                w.x = (unsigned)f2bf(o[0]) | ((unsigned)f2bf(o[1]) << 16); w.y = (unsigned)f2bf(o[2]) | ((unsigned)f2bf(o[3]) << 16);
                *(u32x2*)(OC + (row0 + st * 16 + q16) * DM + h * 256 + dh * 128 + dt * 16 + g * 4) = w; }
    }
    __syncthreads();
}

__device__ __forceinline__ void wt_body(LAS unsigned char* sm, int vb, int tid, const float* __restrict__ W, int K, int N, bf16_t* WT) {
    LAS float* t = (LAS float*)sm;
    const int nbx = (N + 31) / 32; const int k0 = (vb / nbx) * 32, n0 = (vb % nbx) * 32, tx = tid & 31, ty = tid >> 5;
    for (int i = ty; i < 32; i += 8) { const int k = k0 + i, n = n0 + tx; t[i * 33 + tx] = (k < K && n < N) ? W[(size_t)k * N + n] : 0.f; }
    __syncthreads();
    for (int i = ty; i < 32; i += 8) { const int n = n0 + i, k = k0 + tx; if (n < N && k < K) WT[(size_t)n * K + k] = f2bf(t[tx * 33 + i]); }
    __syncthreads();
}
__device__ __forceinline__ void rmsnorm_bf16_row(const float* x, const float* __restrict__ g, bf16_t* out, int row, int lane) {
    const f32x4* xr = (const f32x4*)(x + (size_t)row * DM) + lane; const f32x4* gr = (const f32x4*)g + lane;
    f32x4 v[4]; float s = 0.f;
#pragma unroll
    for (int j = 0; j < 4; ++j) { v[j] = xr[64 * j]; s += (v[j].x * v[j].x + v[j].y * v[j].y) + (v[j].z * v[j].z + v[j].w * v[j].w); }
    const float rstd = 1.f / sqrtf(wave_sum(s) * (1.f / DM) + EPS);
    u32x2* o = (u32x2*)(out + (size_t)row * DM) + lane;
#pragma unroll
    for (int j = 0; j < 4; ++j) { const f32x4 gg = gr[64 * j]; u32x2 w;
        w.x = (unsigned)f2bf(v[j].x * rstd * gg.x) | ((unsigned)f2bf(v[j].y * rstd * gg.y) << 16);
        w.y = (unsigned)f2bf(v[j].z * rstd * gg.z) | ((unsigned)f2bf(v[j].w * rstd * gg.w) << 16); o[64 * j] = w; }
}
__device__ __forceinline__ void rmsnorm_f32_row(float* x, const float* __restrict__ g, int row, int lane) {
    f32x4* xr = (f32x4*)(x + (size_t)row * DM) + lane; const f32x4* gr = (const f32x4*)g + lane;
    f32x4 v[4]; float s = 0.f;
#pragma unroll
    for (int j = 0; j < 4; ++j) { v[j] = xr[64 * j]; s += (v[j].x * v[j].x + v[j].y * v[j].y) + (v[j].z * v[j].z + v[j].w * v[j].w); }
    const float rstd = 1.f / sqrtf(wave_sum(s) * (1.f / DM) + EPS);
#pragma unroll
    for (int j = 0; j < 4; ++j) { const f32x4 gg = gr[64 * j]; xr[64 * j] = v[j] * rstd * gg; }
}
__device__ __forceinline__ float rope_val(const LAS float* p, int base, int d, const LAS float* cs, const LAS float* sn) {
    if (d < 8) return p[base + d] * cs[d] - p[base + d + 8] * sn[d];
    if (d < 16) return p[base + d] * cs[d - 8] + p[base + d - 8] * sn[d - 8];
    return p[base + d];
}
__device__ __forceinline__ void split_rope_body(LAS unsigned char* sm, int row, int tid, const float* proj, const int* __restrict__ positions, bf16_t* Q, bf16_t* Kb, bf16_t* Vb, bf16_t* QI, bf16_t* KI, float* WI, bf16_t* U) {
    LAS float* p = (LAS float*)sm; LAS float* cs = p + INP; LAS float* sn = cs + 8;
    for (int c = tid; c < INP; c += 256) p[c] = proj[(size_t)row * INP + c];
    if (tid < 8) { const float freq = (float)pow(500000.0, -0.125 * (double)tid); const float ang = (float)positions[row] * freq; cs[tid] = (float)cos((double)ang); sn[tid] = (float)sin((double)ang); }
    __syncthreads();
    for (int c = tid; c < 512; c += 256) Q[(size_t)row * 512 + c] = f2bf(rope_val(p, (c >> 6) * 64, c & 63, cs, sn));
    if (tid < 64) Kb[(size_t)row * 64 + tid] = f2bf(rope_val(p, 512, tid, cs, sn));
    else if (tid < 128) Vb[(size_t)row * 64 + tid - 64] = f2bf(p[576 + tid - 64]);
    else if (tid < 192) KI[(size_t)row * 64 + tid - 128] = f2bf(rope_val(p, 896, tid - 128, cs, sn));
    else if (tid < 196) WI[(size_t)row * 4 + tid - 192] = p[960 + tid - 192] * 0.5f;
    QI[(size_t)row * 256 + tid] = f2bf(rope_val(p, 640 + (tid >> 6) * 64, tid & 63, cs, sn) * 0.125f);
    for (int c = tid; c < 512; c += 256) { const float ga = p[964 + c], gg = p[1476 + c]; U[(size_t)row * 512 + c] = f2bf(ga / (1.f + __expf(-gg))); }
    __syncthreads();
}
__device__ __forceinline__ unsigned fkey(float s) { unsigned u = __float_as_uint(s); if ((u << 1) == 0u) u = 0u; return (u & 0x80000000u) ? ~u : (u | 0x80000000u); }
__device__ __forceinline__ void topk_body(LAS unsigned char* sm, int row, int tid, const bf16_t* QI, const bf16_t* KI, const float* WI, unsigned short* SEL) {
    LAS float* qs = (LAS float*)sm; LAS unsigned* key = (LAS unsigned*)(sm + 1024); LAS unsigned* scan = (LAS unsigned*)(sm + 1024 + 16384); LAS unsigned* cntp = (LAS unsigned*)(sm + 1024 + 16384 + 1024);
    const int b = row / SEQ, t = row % SEQ, n = t + 1;
    unsigned short* sel = SEL + (size_t)row * TOPK;
    if (n <= TOPK) { if (tid < n) sel[tid] = (unsigned short)tid; return; }
    qs[tid] = bf2f(QI[(size_t)row * 256 + tid]);
    const float w0 = WI[(size_t)row * 4 + 0], w1 = WI[(size_t)row * 4 + 1], w2 = WI[(size_t)row * 4 + 2], w3 = WI[(size_t)row * 4 + 3];
    __syncthreads();
    for (int s = tid; s < n; s += 256) {
        const u32x4* kp = (const u32x4*)(KI + ((size_t)b * SEQ + s) * 64);
        float a0 = 0.f, a1 = 0.f, a2 = 0.f, a3 = 0.f;
#pragma unroll 2
        for (int c = 0; c < 8; ++c) { const u32x4 kv = kp[c];
#pragma unroll
            for (int e = 0; e < 4; ++e) { const float klo = __uint_as_float(kv[e] << 16), khi = __uint_as_float(kv[e] & 0xffff0000u); const int d = c * 8 + e * 2;
                a0 += qs[d] * klo + qs[d + 1] * khi; a1 += qs[64 + d] * klo + qs[64 + d + 1] * khi; a2 += qs[128 + d] * klo + qs[128 + d + 1] * khi; a3 += qs[192 + d] * klo + qs[192 + d + 1] * khi; } }
        const float sc = w0 * fmaxf(a0, 0.f) + w1 * fmaxf(a1, 0.f) + w2 * fmaxf(a2, 0.f) + w3 * fmaxf(a3, 0.f);
        key[s] = fkey(sc);
    }
    __syncthreads();
    unsigned prefix = 0u;
    for (int bit = 31; bit >= 0; --bit) {
        const unsigned cand = prefix | (1u << bit);
        if (tid == 0) *cntp = 0u;
        __syncthreads();
        unsigned c = 0u; for (int s = tid; s < n; s += 256) c += (key[s] >= cand) ? 1u : 0u;
        if (c) atomicAdd((unsigned*)cntp, c);
        __syncthreads();
        if (*cntp >= (unsigned)TOPK) prefix = cand;
        __syncthreads();
    }
    if (tid == 0) *cntp = 0u;
    __syncthreads();
    { unsigned c = 0u; for (int s = tid; s < n; s += 256) c += (key[s] > prefix) ? 1u : 0u; if (c) atomicAdd((unsigned*)cntp, c); }
    __syncthreads();
    const unsigned need = (unsigned)TOPK - *cntp;
    __syncthreads();
    const int s0 = tid * 16; unsigned eqc = 0u;
    for (int i = 0; i < 16; ++i) { const int s = s0 + i; if (s < n && key[s] == prefix) ++eqc; }
    scan[tid] = eqc; __syncthreads();
    for (int o = 1; o < 256; o <<= 1) { const unsigned v = (tid >= o) ? scan[tid - o] : 0u; __syncthreads(); scan[tid] += v; __syncthreads(); }
    unsigned eq_before = scan[tid] - eqc; __syncthreads();
    unsigned takec = 0u; unsigned takemask = 0u;
    for (int i = 0; i < 16; ++i) { const int s = s0 + i; if (s < n) { const unsigned k = key[s]; bool take = k > prefix; if (k == prefix) { take = eq_before < need; ++eq_before; } if (take) { ++takec; takemask |= 1u << i; } } }
    scan[tid] = takec; __syncthreads();
    for (int o = 1; o < 256; o <<= 1) { const unsigned v = (tid >= o) ? scan[tid - o] : 0u; __syncthreads(); scan[tid] += v; __syncthreads(); }
    unsigned pos = scan[tid] - takec;
    for (int i = 0; i < 16; ++i) if (takemask & (1u << i)) { if (pos < (unsigned)TOPK) sel[pos] = (unsigned short)(s0 + i); ++pos; }
    __syncthreads();
}
__device__ __forceinline__ void sparse_attn_body(LAS unsigned char* sm, int row, int tid, const bf16_t* Q, const bf16_t* Kb, const bf16_t* Vb, const unsigned short* SEL, bf16_t* MIX) {
    LAS float* qs = (LAS float*)sm; LAS float* lg = qs + 512;   LAS int* idx = (LAS int*)(lg + NH * TOPK);
    const int b = row / SEQ, t = row % SEQ, n = (t + 1 < TOPK) ? t + 1 : TOPK;
    qs[tid] = bf2f(Q[(size_t)row * 512 + tid]); qs[tid + 256] = bf2f(Q[(size_t)row * 512 + 256 + tid]);
    int myidx = 0; if (tid < n) myidx = (int)SEL[(size_t)row * TOPK + tid]; idx[tid] = myidx;
    __syncthreads();
    if (tid < n) {
        const u32x4* kp = (const u32x4*)(Kb + ((size_t)b * SEQ + myidx) * 64);
        float a[NH];
#pragma unroll
        for (int h = 0; h < NH; ++h) a[h] = 0.f;
#pragma unroll 2
        for (int c = 0; c < 8; ++c) { const u32x4 kv = kp[c];
#pragma unroll
            for (int e = 0; e < 4; ++e) { const float klo = __uint_as_float(kv[e] << 16), khi = __uint_as_float(kv[e] & 0xffff0000u); const int d = c * 8 + e * 2;
#pragma unroll
                for (int h = 0; h < NH; ++h) a[h] += qs[h * 64 + d] * klo + qs[h * 64 + d + 1] * khi; } }
#pragma unroll
        for (int h = 0; h < NH; ++h) lg[h * TOPK + tid] = a[h] * 0.125f;
    } else {
#pragma unroll
        for (int h = 0; h < NH; ++h) lg[h * TOPK + tid] = -INFINITY;
    }
    __syncthreads();
    { const int w = tid >> 6, lane = tid & 63;
      for (int hh = 0; hh < 2; ++hh) { const int h = 2 * w + hh; float v[4], m = -INFINITY;
          for (int i = 0; i < 4; ++i) { v[i] = lg[h * TOPK + lane + 64 * i]; m = fmaxf(m, v[i]); }
          m = wave_max(m); float s = 0.f;
          for (int i = 0; i < 4; ++i) { v[i] = __expf(v[i] - m); s += v[i]; }
          s = wave_sum(s); const float inv = 1.f / s;
          for (int i = 0; i < 4; ++i) lg[h * TOPK + lane + 64 * i] = v[i] * inv; } }
    __syncthreads();
    { const int h = tid >> 5, d0 = (tid & 31) * 2; float o0 = 0.f, o1 = 0.f;
      for (int j = 0; j < n; ++j) { const unsigned vv = *(const unsigned*)(Vb + ((size_t)b * SEQ + idx[j]) * 64 + d0); const float p = lg[h * TOPK + j]; o0 += p * __uint_as_float(vv << 16); o1 += p * __uint_as_float(vv & 0xffff0000u); }
      *(unsigned*)(MIX + (size_t)row * DM + h * 64 + d0) = (unsigned)f2bf(o0) | ((unsigned)f2bf(o1) << 16); }
    __syncthreads();
}
__device__ __forceinline__ void convb_body(LAS unsigned char* sm, int row, int tid, const bf16_t* U, const float* __restrict__ cw, const float* __restrict__ cb, const float* __restrict__ lg, const float* __restrict__ lb, bf16_t* MIX) {
    LAS float* red = (LAS float*)sm;
    const int t = row % SEQ;
    float y[2];
    for (int k = 0; k < 2; ++k) { const int c = tid + 256 * k; float acc = cb[c];
        for (int j = 0; j < 31; ++j) { const int tt = t - 30 + j; if (tt >= 0) acc += cw[j * 512 + c] * bf2f(U[(size_t)(row - 30 + j) * 512 + c]); }
        y[k] = acc; }
    float s = wave_sum(y[0] + y[1]); if ((tid & 63) == 0) red[tid >> 6] = s; __syncthreads();
    const float mu = (red[0] + red[1] + red[2] + red[3]) * (1.f / 512.f); __syncthreads();
    float q = wave_sum((y[0] - mu) * (y[0] - mu) + (y[1] - mu) * (y[1] - mu)); if ((tid & 63) == 0) red[4 + (tid >> 6)] = q; __syncthreads();
    const float rstd = 1.f / sqrtf((red[4] + red[5] + red[6] + red[7]) * (1.f / 512.f) + EPS);
    for (int k = 0; k < 2; ++k) { const int c = tid + 256 * k; const float v = (y[k] - mu) * rstd * lg[c] + lb[c]; MIX[(size_t)row * DM + 512 + c] = f2bf(silu_f(v)); }
    __syncthreads();
}
__device__ __forceinline__ void cross_attn_body(LAS unsigned char* sm, int row, int tid, const bf16_t* QC, const bf16_t* KC, const bf16_t* VC, bf16_t* OC) {
    LAS float* qs = (LAS float*)sm; LAS float* lg = qs + DM;
    const int b = row / SEQ;
    for (int c = tid; c < DM; c += 256) qs[c] = bf2f(QC[(size_t)row * DM + c]);
    __syncthreads();
    { const u32x4* kp = (const u32x4*)(KC + ((size_t)b * NMEM + tid) * DM);
      for (int h = 0; h < 4; ++h) { float a = 0.f;
#pragma unroll 4
          for (int c = 0; c < 32; ++c) { const u32x4 kv = kp[h * 32 + c];
#pragma unroll
              for (int e = 0; e < 4; ++e) { const int d = h * 256 + c * 8 + e * 2; a += qs[d] * __uint_as_float(kv[e] << 16) + qs[d + 1] * __uint_as_float(kv[e] & 0xffff0000u); } }
          lg[h * NMEM + tid] = a * 0.0625f; } }
    __syncthreads();
    { const int h = tid >> 6, lane = tid & 63; float v[4], m = -INFINITY;
      for (int i = 0; i < 4; ++i) { v[i] = lg[h * NMEM + lane + 64 * i]; m = fmaxf(m, v[i]); }
      m = wave_max(m); float s = 0.f;
      for (int i = 0; i < 4; ++i) { v[i] = __expf(v[i] - m); s += v[i]; }
      s = wave_sum(s); const float inv = 1.f / s;
      for (int i = 0; i < 4; ++i) lg[h * NMEM + lane + 64 * i] = v[i] * inv; }
    __syncthreads();
    { const int h = tid >> 6, d0 = h * 256 + (tid & 63) * 4; float o0 = 0.f, o1 = 0.f, o2 = 0.f, o3 = 0.f;
      for (int j = 0; j < NMEM; ++j) { const u32x2 vv = *(const u32x2*)(VC + ((size_t)b * NMEM + j) * DM + d0); const float p = lg[h * NMEM + j];
          o0 += p * __uint_as_float(vv.x << 16); o1 += p * __uint_as_float(vv.x & 0xffff0000u); o2 += p * __uint_as_float(vv.y << 16); o3 += p * __uint_as_float(vv.y & 0xffff0000u); }
      u32x2 w; w.x = (unsigned)f2bf(o0) | ((unsigned)f2bf(o1) << 16); w.y = (unsigned)f2bf(o2) | ((unsigned)f2bf(o3) << 16); *(u32x2*)(OC + (size_t)row * DM + d0) = w; }
    __syncthreads();
}

constexpr size_t MiB = 1u << 20;
constexpr int LDS_USER = 139264, LDSCTL_OFF = LDS_USER, MISC_OFF = LDSCTL_OFF + 320, LDS_BYTES = 147456;
constexpr size_t WS_CTL = 476 * MiB, CTL_ZERO_BYTES = 1 * MiB; constexpr int CW_BAR = 4096;
struct Args { const float* in[23]; float* out; unsigned char* ws; };
static_assert(sizeof(Args) == 25 * 8, "Args has no padding");

__global__ void __launch_bounds__(512, 2) mega_k(Args a) {
    extern __shared__ __attribute__((aligned(16))) unsigned char lds_raw[];
    LAS unsigned char* lds = (LAS unsigned char*)lds_raw;
    const int tid = threadIdx.x, lane = tid & 63, wave = __builtin_amdgcn_readfirstlane(tid >> 6), half = tid >> 8, htid = tid & 255;
    const int G = gridDim.x, bx = blockIdx.x; const int vcu = (G % 8 == 0) ? (bx % 8) * (G / 8) + bx / 8 : bx;
    LAS unsigned char* hsm = lds + half * 65536;
    const float* x = a.in[0]; const float* mem = a.in[1]; const int* positions = (const int*)a.in[2];
    const float* g_mix = a.in[3]; const float* w_in = a.in[4]; const float* w_out = a.in[5];
    const float* conv_b_w = a.in[6]; const float* conv_b_b = a.in[7]; const float* ln_b_g = a.in[8]; const float* ln_b_b = a.in[9];
    const float* g_cross = a.in[10]; const float* g_mem = a.in[11];
    const float* w_q = a.in[12]; const float* w_k = a.in[13]; const float* w_v = a.in[14]; const float* w_o = a.in[15];
    const float* g_ffn = a.in[16]; const float* w_gate = a.in[17]; const float* w_up = a.in[18];
    const float* ffn_cw = a.in[19]; const float* ffn_cb = a.in[20]; const float* w_down = a.in[21]; const float* g_final = a.in[22];
    float* out = a.out; unsigned char* ws = a.ws;
    bf16_t* wt_in = (bf16_t*)(ws + 0 * MiB); bf16_t* wt_out = (bf16_t*)(ws + 4 * MiB);
    bf16_t* wt_q = (bf16_t*)(ws + 6 * MiB), *wt_k = (bf16_t*)(ws + 8 * MiB), *wt_v = (bf16_t*)(ws + 10 * MiB), *wt_o = (bf16_t*)(ws + 12 * MiB);
    bf16_t* wt_gate = (bf16_t*)(ws + 14 * MiB); bf16_t* wt_up = (bf16_t*)(ws + 20 * MiB); bf16_t* wt_down = (bf16_t*)(ws + 26 * MiB);
    float* WI = (float*)(ws + 32 * MiB);
    bf16_t* MEMN = (bf16_t*)(ws + 34 * MiB), *KC = (bf16_t*)(ws + 38 * MiB), *VC = (bf16_t*)(ws + 42 * MiB);
    bf16_t* XN = (bf16_t*)(ws + 48 * MiB); float* PROJ = (float*)(ws + 112 * MiB);
    bf16_t* Qb = (bf16_t*)(ws + 368 * MiB); bf16_t* QI = (bf16_t*)(ws + 400 * MiB);
    bf16_t* Kb = (bf16_t*)(ws + 416 * MiB), *Vb = (bf16_t*)(ws + 420 * MiB), *KI = (bf16_t*)(ws + 424 * MiB);
    bf16_t* U = (bf16_t*)(ws + 428 * MiB); unsigned short* SEL = (unsigned short*)(ws + 460 * MiB);
    bf16_t* MIX = (bf16_t*)(ws + 112 * MiB); bf16_t* QC = (bf16_t*)(ws + 176 * MiB); bf16_t* OC = (bf16_t*)(ws + 240 * MiB);
    bf16_t* Gb = (bf16_t*)(ws + 112 * MiB); bf16_t* UF = (bf16_t*)(ws + 288 * MiB);
    unsigned* ctl = (unsigned*)(ws + WS_CTL);

    for (int u = tid; u < (LDS_BYTES - LDSCTL_OFF) / 4; u += 512) ((LAS unsigned*)(lds + LDSCTL_OFF))[u] = 0u;
    __syncthreads();
    XcdBarrier bar = xcd_barrier_post(ctl + CW_BAR, (volatile LAS unsigned*)(lds + MISC_OFF) + 8);
#define GRID_BAR() xcd_barrier(bar)
#define FOR_VB(nvb) for (int vb = 2 * bx + half; vb < (nvb); vb += 2 * G)
#define GEMM(Aptr, Bptr, Mv, Nv, Kv, OF, OB, RES, LDC) do { pg8::Gemm g_{Aptr, Bptr, Mv, Nv, Kv}; pg8::StaticOrder S_; S_.init(Mv, Nv, G, bx); EpiStore E_{OF, OB, RES, LDC}; \
        pg8::gemm_phase<EpiStore, pg8::StaticOrder, true, true>(lds, g_, S_, E_); } while (0)

    for (int i = bx * 512 + tid; i < (INP - INC) * DM; i += G * 512) wt_in[(size_t)INC * DM + i] = 0;
    FOR_VB(32 * 63) wt_body(hsm, vb, htid, w_in, DM, INC, wt_in);
    FOR_VB(32 * 32) wt_body(hsm, vb, htid, w_out, DM, DM, wt_out);
    FOR_VB(32 * 32) wt_body(hsm, vb, htid, w_q, DM, DM, wt_q);
    FOR_VB(32 * 32) wt_body(hsm, vb, htid, w_k, DM, DM, wt_k);
    FOR_VB(32 * 32) wt_body(hsm, vb, htid, w_v, DM, DM, wt_v);
    FOR_VB(32 * 32) wt_body(hsm, vb, htid, w_o, DM, DM, wt_o);
    FOR_VB(32 * 88) wt_body(hsm, vb, htid, w_gate, DM, DFF, wt_gate);
    FOR_VB(32 * 88) wt_body(hsm, vb, htid, w_up, DM, DFF, wt_up);
    FOR_VB(88 * 32) wt_body(hsm, vb, htid, w_down, DFF, DM, wt_down);
    for (int r = bx * 8 + wave; r < MTOK; r += G * 8) rmsnorm_bf16_row(x, g_mix, XN, r, lane);
    for (int r = bx * 8 + wave; r < MMEM; r += G * 8) rmsnorm_bf16_row(mem, g_mem, MEMN, r, lane);
    GRID_BAR();
    GEMM(XN, wt_in, MTOK, INP, DM, PROJ, (bf16_t*)nullptr, (const float*)nullptr, INP);
    GEMM(MEMN, wt_k, MMEM, DM, DM, (float*)nullptr, KC, (const float*)nullptr, DM);
    GEMM(wt_v, MEMN, DM, MMEM, DM, (float*)nullptr, VC, (const float*)nullptr, MMEM);
    GRID_BAR();
    FOR_VB(MTOK) split_rope_body(hsm, vb, htid, PROJ, positions, Qb, Kb, Vb, QI, KI, WI, U);
    GRID_BAR();
    FOR_VB(MTOK) topk_body(hsm, vb, htid, QI, KI, WI, SEL);
    __syncthreads();
    FOR_VB(MTOK) convb_body(hsm, vb, htid, U, conv_b_w, conv_b_b, ln_b_g, ln_b_b, MIX);
    GRID_BAR();
    FOR_VB(MTOK) sparse_attn_body(hsm, vb, htid, Qb, Kb, Vb, SEL, MIX);
    GRID_BAR();
    GEMM(MIX, wt_out, MTOK, DM, DM, out, (bf16_t*)nullptr, x, DM);
    GRID_BAR();
    for (int r = bx * 8 + wave; r < MTOK; r += G * 8) rmsnorm_bf16_row(out, g_cross, XN, r, lane);
    GRID_BAR();
    GEMM(XN, wt_q, MTOK, DM, DM, (float*)nullptr, QC, (const float*)nullptr, DM);
    GRID_BAR();
    { const int per = (512 + G - 1) / G; for (int i = 0; i < per; ++i) { const int u = vcu * per + i; if (u < 512) cross_attn_unit(lds, u >> 6, (u >> 4) & 3, u & 15, QC, KC, VC, OC, tid, lane, wave); } }
    GRID_BAR();
    GEMM(OC, wt_o, MTOK, DM, DM, out, (bf16_t*)nullptr, out, DM);
    GRID_BAR();
    for (int r = bx * 8 + wave; r < MTOK; r += G * 8) rmsnorm_bf16_row(out, g_ffn, XN, r, lane);
    GRID_BAR();
    GEMM(XN, wt_gate, MTOK, DFF, DM, (float*)nullptr, Gb, (const float*)nullptr, DFF);
    GEMM(XN, wt_up, MTOK, DFF, DM, (float*)nullptr, UF, (const float*)nullptr, DFF);
    GRID_BAR();
    for (size_t i = (size_t)bx * 512 + tid; i < (size_t)MTOK * DFF; i += (size_t)G * 512) {
        const int c = (int)(i % DFF); const size_t row = i / DFF; const int t = (int)(row % SEQ);
        float g = ffn_cb[c] + ffn_cw[2 * DFF + c] * bf2f(Gb[i]);
        if (t >= 1) g += ffn_cw[1 * DFF + c] * bf2f(Gb[i - DFF]);
        if (t >= 2) g += ffn_cw[0 * DFF + c] * bf2f(Gb[i - 2 * DFF]);
        UF[i] = f2bf(silu_f(g) * bf2f(UF[i]));
    }
    GRID_BAR();
    GEMM(UF, wt_down, MTOK, DM, DFF, out, (bf16_t*)nullptr, out, DM);
    GRID_BAR();
    for (int r = bx * 8 + wave; r < MTOK; r += G * 8) rmsnorm_f32_row(out, g_final, r, lane);
}

extern "C" void kernel_launch(void* const* d_in, const int* in_sizes, int n_in, void* d_out, int out_size, void* d_ws, size_t ws_size, hipStream_t stream) {
    static int grid = 0;
    if (grid == 0) {
        int dev = 0, cus = 0, per_cu = 0;
        if (hipGetDevice(&dev) != hipSuccess || hipDeviceGetAttribute(&cus, hipDeviceAttributeMultiprocessorCount, dev) != hipSuccess) { fprintf(stderr, "kernel_launch: device query failed\n"); grid = -1; return; }
        if (hipFuncSetAttribute((const void*)mega_k, hipFuncAttributeMaxDynamicSharedMemorySize, LDS_BYTES) != hipSuccess) { fprintf(stderr, "kernel_launch: hipFuncSetAttribute failed\n"); grid = -1; return; }
        if (hipOccupancyMaxActiveBlocksPerMultiprocessor(&per_cu, (const void*)mega_k, 512, LDS_BYTES) != hipSuccess || per_cu < 1) { fprintf(stderr, "kernel_launch: occupancy query says %d\n", per_cu); per_cu = 1; }
        (void)hipGetLastError();
        grid = cus * 1;
        if (n_in != 23 || ws_size < 477 * MiB) { fprintf(stderr, "kernel_launch: unexpected n_in %d / ws %zu\n", n_in, ws_size); grid = -1; return; }
    }
    if (grid < 0) return;
    (void)hipMemsetAsync((char*)d_ws + WS_CTL, 0, CTL_ZERO_BYTES, stream);
    Args a{};
    for (int i = 0; i < 23; ++i) a.in[i] = (const float*)d_in[i];
    a.out = (float*)d_out; a.ws = (unsigned char*)d_ws;
    void* params[] = {&a};
    hipError_t e = hipLaunchCooperativeKernel((const void*)mega_k, dim3(grid), dim3(512), params, LDS_BYTES, stream);
    if (e != hipSuccess) fprintf(stderr, "cooperative launch failed: %s (grid %d)\n", hipGetErrorString(e), grid);
}
```

```cpp
#include <hip/hip_runtime.h>
#include <cstdio>
#include <cstdint>
#include <cmath>
namespace pg8 {
#define PG8_LAS __attribute__((address_space(3)))
typedef unsigned short bf16_t;
typedef short bf16x8 __attribute__((ext_vector_type(8)));
typedef float f32x4 __attribute__((ext_vector_type(4)));
typedef unsigned u32x4 __attribute__((ext_vector_type(4)));
constexpr int BM = 256, BK = 64, HALF = 128, HTB = HALF * BK * 2  , STAGE_BYTES = 8 * HTB, NXCD = 8, WGM = 8;

__host__ __device__ __forceinline__ int lds_byte(int r, int c) { const int st = (r >> 4) * 2 + (c >> 5), rr = r & 15, cc = c & 31, ob = rr * 64 + cc * 2; return st * 1024 + (ob ^ (((ob >> 9) & 1) << 5)); }
__host__ __device__ __forceinline__ void stage_rc(int b, int& R, int& C) { const int st = b / 1024, sb = b % 1024, swz = sb ^ (((sb >> 9) & 1) << 5); R = (st >> 1) * 16 + swz / 64; C = (st & 1) * 32 + (swz % 64) / 2; }
__host__ __device__ __forceinline__ int perm32(int rho) { const int n = rho >> 4, i = rho & 15; return 8 * (i >> 2) + 4 * n + (i & 3); }

struct Unit { int pm, pn; };
struct Gemm { const bf16_t* A; const bf16_t* Bt; int M, N, K; };

struct StaticOrder {
    int nM, nN, nwg, G, c;
    __host__ __device__ void init(int M, int N, int G_, int c_) { nM = M / BM; nN = N / BM; nwg = nM * nN; G = G_; c = c_; }
    __host__ __device__ bool next(int i, Unit& u) const {
        const long L = (long)i * G + c; if (L >= nwg) return false;
        int wgid = (int)L; { const int q = nwg / NXCD, r = nwg % NXCD, xcd = wgid % NXCD, off = wgid / NXCD; wgid = (xcd < r ? xcd * (q + 1) : r * (q + 1) + (xcd - r) * q) + off; }
        const int nig = WGM * nN, gid = wgid / nig, fm = gid * WGM, gsz = (nM - fm) < WGM ? (nM - fm) : WGM;
        u.pm = fm + ((wgid % nig) % gsz); u.pn = (wgid % nig) / gsz; return true;
    }
    __device__ __forceinline__ void a_ready(const Unit&) const {}
    __device__ __forceinline__ void done(const Unit&) const {}
};
__device__ __forceinline__ unsigned cvt_pk_bf16(float lo, float hi) { unsigned r; asm volatile("v_cvt_pk_bf16_f32 %0, %1, %2" : "=v"(r) : "v"(lo), "v"(hi)); return r; }
template <class Epi, class Sched, bool ALIGN_EPI = false, bool SP2 = false>
__device__ __forceinline__ void gemm_phase(PG8_LAS unsigned char* lds, const Gemm g, const Sched& S, const Epi& E) {
    int tid_l = threadIdx.x; asm volatile("" : "+v"(tid_l));
    const int tid = tid_l, wid = __builtin_amdgcn_readfirstlane(tid >> 6), lane = tid & 63, wr = wid >> 2, wc = wid & 3, fr = lane & 15, fq = lane >> 4;
    const int K = g.K, nt = K / BK;
    unsigned voffA[2], voffB[2];
#pragma unroll
    for (int i = 0; i < 2; ++i) { int R, C; stage_rc(tid * 16 + i * 8192, R, C); const int Rb = Epi::PERM ? ((R & ~31) + perm32(R & 31)) : R;
        voffA[i] = (unsigned)(R * K + C) * 2u; voffB[i] = (unsigned)(Rb * K + C) * 2u; }
    const size_t kstep = (size_t)(BK * 2);
    const size_t hstep = (size_t)HALF * K * 2;
    const size_t tstep = 2 * hstep;
    const unsigned ldsw = (unsigned)wid * 1024u;
    const int aoff = lds_byte(wr * 64 + fr, fq * 8), boff = lds_byte(wc * 32 + fr, fq * 8);
#define PG8_SA(b, h) (((b) * 2 + (h)) * HTB)
#define PG8_SB(b, h) ((4 + (b) * 2 + (h)) * HTB)
#define PG8_STAGE(bufoff, gbase, voff) do { _Pragma("unroll") for (int _i = 0; _i < 2; ++_i) \
        __builtin_amdgcn_global_load_lds((const unsigned*)((const char*)(gbase) + (voff)[_i]), (PG8_LAS unsigned*)(lds + (bufoff) + ldsw + _i * 8192), 16, 0, 0); } while (0)
#define PG8_LDA(dst, b, h) do { _Pragma("unroll") for (int m = 0; m < 4; ++m) _Pragma("unroll") for (int k = 0; k < 2; ++k) dst[m][k] = *(const PG8_LAS bf16x8*)(lds + PG8_SA(b, h) + aoff + m * 2048 + k * 1024); } while (0)
#define PG8_LDB(dst, b, h) do { _Pragma("unroll") for (int n = 0; n < 2; ++n) _Pragma("unroll") for (int k = 0; k < 2; ++k) dst[n][k] = *(const PG8_LAS bf16x8*)(lds + PG8_SB(b, h) + boff + n * 2048 + k * 1024); } while (0)
#define PG8_MMA(ai, bj, At, Bt) do { __builtin_amdgcn_s_setprio(1); _Pragma("unroll") for (int m = 0; m < 4; ++m) _Pragma("unroll") for (int n = 0; n < 2; ++n) _Pragma("unroll") for (int k = 0; k < 2; ++k) \
        acc[ai][bj][m][n] = __builtin_amdgcn_mfma_f32_16x16x32_bf16(Bt[n][k], At[m][k], acc[ai][bj][m][n], 0, 0, 0); __builtin_amdgcn_s_setprio(0); } while (0)
#define PG8_WAIT_V(n) asm volatile("s_waitcnt vmcnt(" #n ")" ::: "memory")
#define PG8_WAIT_L(n) asm volatile("s_waitcnt lgkmcnt(" #n ")" ::: "memory")
#define PG8_BAR __builtin_amdgcn_s_barrier()
#define PG8_SCHED __builtin_amdgcn_sched_barrier(0)
    Unit cur, nxt; int ui = 0;
    if (!S.next(0, cur)) return;
    f32x4 acc[2][2][4][2];
#pragma unroll
    for (int a = 0; a < 2; ++a)
#pragma unroll
        for (int b = 0; b < 2; ++b)
#pragma unroll
            for (int m = 0; m < 4; ++m)
#pragma unroll
                for (int n = 0; n < 2; ++n) acc[a][b][m][n] = (f32x4){0.f, 0.f, 0.f, 0.f};
    bf16x8 At[4][2], B0[2][2], B1[2][2];
    const char* cA = (const char*)g.A + (size_t)cur.pm * tstep; const char* cB = (const char*)g.Bt + (size_t)cur.pn * tstep;
    S.a_ready(cur);
    if constexpr (SP2) {
        PG8_STAGE(PG8_SB(0, 0), cB, voffB); PG8_STAGE(PG8_SB(0, 1), cB + hstep, voffB); PG8_STAGE(PG8_SA(0, 0), cA, voffA); PG8_STAGE(PG8_SA(0, 1), cA + hstep, voffA);
        if (wr == 1) PG8_BAR;
        PG8_WAIT_V(2); PG8_BAR;
        PG8_STAGE(PG8_SB(1, 0), cB + kstep, voffB); PG8_STAGE(PG8_SA(1, 0), cA + kstep, voffA); PG8_STAGE(PG8_SB(1, 1), cB + hstep + kstep, voffB);
        PG8_WAIT_V(6); PG8_BAR;
    } else {
        PG8_STAGE(PG8_SB(0, 0), cB, voffB); PG8_STAGE(PG8_SA(0, 0), cA, voffA); PG8_STAGE(PG8_SB(0, 1), cB + hstep, voffB); PG8_STAGE(PG8_SA(0, 1), cA + hstep, voffA);
        if (wr == 1) PG8_BAR;
        PG8_WAIT_V(4); PG8_BAR;
        PG8_STAGE(PG8_SB(1, 0), cB + kstep, voffB); PG8_STAGE(PG8_SA(1, 0), cA + kstep, voffA); PG8_STAGE(PG8_SB(1, 1), cB + hstep + kstep, voffB);
        PG8_WAIT_V(6); PG8_BAR;
    }
    for (;;) {
        const bool has_next = S.next(ui + 1, nxt);
        const char* nA = has_next ? (const char*)g.A + (size_t)nxt.pm * tstep : cA; const char* nB = has_next ? (const char*)g.Bt + (size_t)nxt.pn * tstep : cB;
        for (int t = 0; t < nt; t += 2) {
            const bool last = (t == nt - 2);
            const char* a1 = cA + (size_t)(t + 1) * kstep;
            const char* a2 = last ? nA : cA + (size_t)(t + 2) * kstep; const char* b2 = last ? nB : cB + (size_t)(t + 2) * kstep;
            const char* a3 = a2 + kstep; const char* b3 = b2 + kstep;
            if (last && has_next) S.a_ready(nxt);
            if constexpr (SP2) {
            PG8_LDB(B0, 0, 0); PG8_LDB(B1, 0, 1); PG8_SCHED; PG8_LDA(At, 0, 0); PG8_STAGE(PG8_SA(1, 1), a1 + hstep, voffA);
            PG8_WAIT_V(8); PG8_WAIT_L(0); PG8_BAR; PG8_MMA(0, 0, At, B0); PG8_MMA(0, 1, At, B1); PG8_BAR; PG8_SCHED;
            PG8_LDA(At, 0, 1); PG8_STAGE(PG8_SB(0, 0), b2, voffB); PG8_STAGE(PG8_SB(0, 1), b2 + hstep, voffB); PG8_STAGE(PG8_SA(0, 0), a2, voffA);
            PG8_WAIT_V(8); PG8_WAIT_L(0); PG8_BAR; PG8_MMA(1, 0, At, B0); PG8_MMA(1, 1, At, B1); PG8_BAR; PG8_SCHED;
            PG8_LDB(B0, 1, 0); PG8_LDB(B1, 1, 1); PG8_SCHED; PG8_LDA(At, 1, 0); PG8_STAGE(PG8_SA(0, 1), a2 + hstep, voffA);
            PG8_WAIT_V(8); PG8_WAIT_L(0); PG8_BAR; PG8_MMA(0, 0, At, B0); PG8_MMA(0, 1, At, B1); PG8_BAR; PG8_SCHED;
            PG8_LDA(At, 1, 1); PG8_STAGE(PG8_SB(1, 0), b3, voffB); PG8_STAGE(PG8_SB(1, 1), b3 + hstep, voffB); PG8_STAGE(PG8_SA(1, 0), a3, voffA);
            PG8_WAIT_V(8); PG8_WAIT_L(0); PG8_BAR; PG8_MMA(1, 0, At, B0); PG8_MMA(1, 1, At, B1); PG8_BAR; PG8_SCHED;
            } else {
            PG8_LDB(B0, 0, 0); PG8_SCHED; PG8_LDA(At, 0, 0); PG8_STAGE(PG8_SA(1, 1), a1 + hstep, voffA);
            PG8_WAIT_L(8); PG8_BAR; PG8_WAIT_L(0); PG8_MMA(0, 0, At, B0); PG8_BAR; PG8_SCHED;
            PG8_LDB(B1, 0, 1); PG8_STAGE(PG8_SB(0, 0), b2, voffB);
            PG8_BAR; PG8_WAIT_L(0); PG8_MMA(0, 1, At, B1); PG8_BAR;
            PG8_LDA(At, 0, 1); PG8_STAGE(PG8_SA(0, 0), a2, voffA);
            PG8_BAR; PG8_WAIT_L(0); PG8_MMA(1, 0, At, B0); PG8_BAR; PG8_SCHED;
            PG8_STAGE(PG8_SB(0, 1), b2 + hstep, voffB);
            PG8_WAIT_V(6); PG8_BAR; PG8_MMA(1, 1, At, B1); PG8_BAR;
            PG8_LDB(B0, 1, 0); PG8_SCHED; PG8_LDA(At, 1, 0); PG8_STAGE(PG8_SA(0, 1), a2 + hstep, voffA);
            PG8_WAIT_L(8); PG8_BAR; PG8_WAIT_L(0); PG8_MMA(0, 0, At, B0); PG8_BAR; PG8_SCHED;
            PG8_LDB(B1, 1, 1); PG8_STAGE(PG8_SB(1, 0), b3, voffB);
            PG8_BAR; PG8_WAIT_L(0); PG8_MMA(0, 1, At, B1); PG8_BAR;
            PG8_LDA(At, 1, 1); PG8_STAGE(PG8_SA(1, 0), a3, voffA);
            PG8_BAR; PG8_WAIT_L(0); PG8_MMA(1, 0, At, B0); PG8_BAR; PG8_SCHED;
            PG8_STAGE(PG8_SB(1, 1), b3 + hstep, voffB);
            PG8_WAIT_V(6); PG8_BAR; PG8_MMA(1, 1, At, B1); PG8_BAR;
            }
        }
        if constexpr (ALIGN_EPI) { if (wr == 0) PG8_BAR; }
        if constexpr (!Epi::AFTER_DRAIN) { E(acc, cur, wr, wc, fr, fq); S.done(cur); }
        if (!has_next) break;
#pragma unroll
        for (int a = 0; a < 2; ++a)
#pragma unroll
            for (int b = 0; b < 2; ++b)
#pragma unroll
                for (int m = 0; m < 4; ++m)
#pragma unroll
                    for (int n = 0; n < 2; ++n) acc[a][b][m][n] = (f32x4){0.f, 0.f, 0.f, 0.f};
        cur = nxt; cA = nA; cB = nB; ++ui;
        if constexpr (ALIGN_EPI) { if (wr == 1) PG8_BAR; }
    }
    PG8_WAIT_V(0);
    if constexpr (!ALIGN_EPI) { if (wr == 0) PG8_BAR; }
    PG8_BAR;
    if constexpr (Epi::AFTER_DRAIN) { E.fused(acc, cur, wr, wc, fr, fq, lds, wid, lane); S.done(cur); }
#undef PG8_SA
#undef PG8_SB
#undef PG8_STAGE
#undef PG8_LDA
#undef PG8_LDB
#undef PG8_MMA
#undef PG8_WAIT_V
#undef PG8_WAIT_L
#undef PG8_BAR
#undef PG8_SCHED
}
}

constexpr int BATCH = 8, SEQ = 4096, DM = 1024, MTOK = BATCH * SEQ;
constexpr int NMEM = 256, MMEM = BATCH * NMEM;
constexpr int AW = 512, HD = 64, NH = 8, IH = 4, TOPK = 256;
constexpr int INC = 1988, INP = 2048;
constexpr int DFF = 2816;
constexpr float EPS = 1e-6f;
#define LAS __attribute__((address_space(3)))
typedef unsigned short bf16_t;
typedef float f32x4 __attribute__((ext_vector_type(4)));
typedef unsigned u32x4 __attribute__((ext_vector_type(4)));
typedef unsigned u32x2 __attribute__((ext_vector_type(2)));

__device__ __forceinline__ float bf2f(bf16_t v) { return __uint_as_float((unsigned)v << 16); }
__device__ __forceinline__ bf16_t f2bf(float f) { unsigned u = __float_as_uint(f); return (bf16_t)((u + 0x7fffu + ((u >> 16) & 1u)) >> 16); }
__device__ __forceinline__ float wave_sum(float v) {
#pragma unroll
    for (int o = 1; o < 64; o <<= 1) v += __shfl_xor(v, o);
    return v;
}
__device__ __forceinline__ float wave_max(float v) {
#pragma unroll
    for (int o = 1; o < 64; o <<= 1) v = fmaxf(v, __shfl_xor(v, o));
    return v;
}
__device__ __forceinline__ float silu_f(float v) { return v / (1.f + __expf(-v)); }

struct EpiStore {
    static constexpr bool PERM = false, AFTER_DRAIN = false;
    float* outf; bf16_t* outb; const float* res; int ldc;
    __device__ __forceinline__ void operator()(const pg8::f32x4 (&acc)[2][2][4][2], const pg8::Unit& u, int wr, int wc, int fr, int fq) const {
        const int col0 = u.pn * 256 + wc * 32 + 4 * fq;
#pragma unroll
        for (int ai = 0; ai < 2; ++ai)
#pragma unroll
            for (int m = 0; m < 4; ++m) {
                const size_t row = (size_t)(u.pm * 256 + ai * 128 + wr * 64 + m * 16 + fr);
#pragma unroll
                for (int bj = 0; bj < 2; ++bj)
#pragma unroll
                    for (int n = 0; n < 2; ++n) {
                        const size_t off = row * ldc + col0 + bj * 128 + n * 16;
                        pg8::f32x4 v = acc[ai][bj][m][n];
                        if (res) { const pg8::f32x4 r = *(const pg8::f32x4*)(res + off); v = v + r; }
                        if (outf) *(pg8::f32x4*)(outf + off) = v;
                        if (outb) { u32x2 w; w.x = (unsigned)f2bf(v[0]) | ((unsigned)f2bf(v[1]) << 16); w.y = (unsigned)f2bf(v[2]) | ((unsigned)f2bf(v[3]) << 16); *(u32x2*)(outb + off) = w; }
                    }
            }
    }
};
#define XB_TMO      128
#define XB_XCNT(j)  (256  + 64 * (j))
#define XB_XSUB(j)  (1280 + 64 * (j))
#define XB_XGEN(j)  (2304 + 64 * (j))
#define XB_TOP      3328
#define XB_TOPGEN   3392
#define XCD_BAR_WORDS 3456
#define XB_SPIN_CAP (1u << 18)

__device__ __forceinline__ unsigned xb_ld(unsigned* p)              { return __hip_atomic_load(p, __ATOMIC_RELAXED, __HIP_MEMORY_SCOPE_AGENT); }
__device__ __forceinline__ unsigned xb_add(unsigned* p, unsigned v) { return __hip_atomic_fetch_add(p, v, __ATOMIC_RELAXED, __HIP_MEMORY_SCOPE_AGENT); }
__device__ __forceinline__ unsigned xb_xcc_id() { return (unsigned)__builtin_amdgcn_s_getreg((3 << 11) | 20) & 0xFu; }
#define XB_SPIN(cond, bar) do { unsigned _sp = 0; while (cond) { __builtin_amdgcn_s_sleep(1); \
    if ((++_sp & 255u) == 0u) { if (xb_ld(&(bar)[XB_TMO])) break; if (_sp > XB_SPIN_CAP) { atomicAdd(&(bar)[XB_TMO], 1u); break; } } } } while (0)

struct XcdBarrier {
    unsigned* bar; unsigned x;
    volatile LAS unsigned* st;
};

__device__ __forceinline__ XcdBarrier xcd_barrier_post(unsigned* bar, volatile LAS unsigned* st) {
    XcdBarrier b; b.bar = bar; b.x = xb_xcc_id(); b.st = st;
    if (threadIdx.x == 0) (void)xb_add(&bar[XB_XCNT(b.x)], 1u);
    return b;
}
__device__ __forceinline__ void xcd_barrier_complete(unsigned* bar, unsigned x, unsigned& nloc, unsigned& nx) {
    const unsigned G = gridDim.x * gridDim.y * gridDim.z;
    unsigned sum, cnt, mine, sp = 0u;
    for (;;) {
        sum = 0u; cnt = 0u; mine = 0u;
#pragma unroll
        for (unsigned j = 0; j < 16; ++j) { const unsigned c = xb_ld(&bar[XB_XCNT(j)]); sum += c; cnt += (c > 0u) ? 1u : 0u; mine = (j == x) ? c : mine; }
        if (sum == G) break;
        __builtin_amdgcn_s_sleep(1);
        if ((++sp & 255u) == 0u) { if (xb_ld(&bar[XB_TMO])) break; if (sp > XB_SPIN_CAP) { atomicAdd(&bar[XB_TMO], 1u); break; } }
    }
    nloc = mine > 0u ? mine : 1u; nx = cnt > 0u ? cnt : 1u;
}

__device__ __forceinline__ void xcd_barrier(const XcdBarrier& b) {
    asm volatile("s_waitcnt vmcnt(0)" ::: "memory");
    __syncthreads();
    if (threadIdx.x == 0) {
        unsigned* bar = b.bar;
        __builtin_amdgcn_s_waitcnt(0);
        unsigned nloc = b.st[0], nx = b.st[1];
        if (nloc == 0u) { xcd_barrier_complete(bar, b.x, nloc, nx); b.st[0] = nloc; b.st[1] = nx; }
        const unsigned old = xb_add(&bar[XB_XSUB(b.x)], 1u);
        const unsigned gen = old / nloc;
        if (old + 1u == (gen + 1u) * nloc) {
            __builtin_amdgcn_fence(__ATOMIC_RELEASE, "agent");
            asm volatile("s_waitcnt vmcnt(0)" ::: "memory");
            const unsigned og = xb_add(&bar[XB_TOP], 1u);
            const unsigned tg = og / nx;
            if (og + 1u == (tg + 1u) * nx) xb_add(&bar[XB_TOPGEN], 1u);
            else XB_SPIN(xb_ld(&bar[XB_TOPGEN]) == tg, bar);
            __builtin_amdgcn_fence(__ATOMIC_ACQUIRE, "agent");
            xb_add(&bar[XB_XGEN(b.x)], 1u);
            asm volatile("s_waitcnt vmcnt(0)" ::: "memory");
        } else {
            XB_SPIN(xb_ld(&bar[XB_XGEN(b.x)]) == gen, bar);
            __builtin_amdgcn_fence(__ATOMIC_ACQUIRE, "agent");
            asm volatile("s_waitcnt vmcnt(0)" ::: "memory");
        }
    }
    __syncthreads();
}
typedef short bf16x8v __attribute__((ext_vector_type(8)));
constexpr int CA_STRIDE = 528;
__device__ __forceinline__ void cross_attn_unit(LAS unsigned char* lds, int b, int h, int qb, const bf16_t* QC, const bf16_t* KC, const bf16_t* VT, bf16_t* OC, int tid, int lane, int wave) {
    const int q16 = lane & 15, g = lane >> 4;
    const size_t row0 = (size_t)b * SEQ + (size_t)qb * 256 + wave * 32;
    asm volatile("" : "+v"(tid));
    { const bf16_t* src = KC + ((size_t)b * NMEM + (tid >> 5)) * DM + h * 256 + (tid & 31) * 8; LAS unsigned char* dst = lds + (tid >> 5) * CA_STRIDE + (tid & 31) * 16;
#pragma unroll
      for (int i = 0; i < 16; ++i) { const u32x4 v = *(const u32x4*)(src + (size_t)i * 16 * DM); *(LAS u32x4*)(dst + i * 16 * CA_STRIDE) = v; } }
    __syncthreads();
    f32x4 S[2][16];
#pragma unroll
    for (int st = 0; st < 2; ++st)
#pragma unroll
        for (int kt = 0; kt < 16; ++kt) S[st][kt] = (f32x4){0.f, 0.f, 0.f, 0.f};
#pragma unroll 1
    for (int kh = 0; kh < 2; ++kh) {
        bf16x8v qf[2][4];
#pragma unroll
        for (int st = 0; st < 2; ++st)
#pragma unroll
            for (int ks = 0; ks < 4; ++ks) qf[st][ks] = *(const bf16x8v*)(QC + (row0 + st * 16 + q16) * DM + h * 256 + kh * 128 + ks * 32 + g * 8);
        const LAS unsigned char* kb = lds + q16 * CA_STRIDE + kh * 256 + g * 16;
#pragma unroll
        for (int kt = 0; kt < 16; ++kt)
#pragma unroll
            for (int ks = 0; ks < 4; ++ks) { const bf16x8v a = *(const LAS bf16x8v*)(kb + kt * 16 * CA_STRIDE + ks * 64);
                S[0][kt] = __builtin_amdgcn_mfma_f32_16x16x32_bf16(a, qf[0][ks], S[0][kt], 0, 0, 0);
                S[1][kt] = __builtin_amdgcn_mfma_f32_16x16x32_bf16(a, qf[1][ks], S[1][kt], 0, 0, 0); }
    }
    const float c2 = 0.0625f * 1.4426950408889634f;
    float linv[2]; bf16x8v P[2][8];
#pragma unroll
    for (int st = 0; st < 2; ++st) {
        float m = -INFINITY;
#pragma unroll
        for (int kt = 0; kt < 16; ++kt) m = fmaxf(fmaxf(fmaxf(S[st][kt][0], S[st][kt][1]), fmaxf(S[st][kt][2], S[st][kt][3])), m);
        m = fmaxf(m, __shfl_xor(m, 16)); m = fmaxf(m, __shfl_xor(m, 32));
        const float mc = m * c2; float l = 0.f;
#pragma unroll
        for (int kt = 0; kt < 16; ++kt)
#pragma unroll
            for (int r = 0; r < 4; ++r) { const float p = __builtin_amdgcn_exp2f(S[st][kt][r] * c2 - mc); S[st][kt][r] = p; l += p; }
        l += __shfl_xor(l, 16); l += __shfl_xor(l, 32); linv[st] = 1.f / l;
#pragma unroll
        for (int c = 0; c < 8; ++c) { bf16x8v pk;
#pragma unroll
            for (int j = 0; j < 4; ++j) { pk[j] = (short)f2bf(S[st][2 * c][j]); pk[4 + j] = (short)f2bf(S[st][2 * c + 1][j]); }
            P[st][c] = pk; }
    }
    __syncthreads();
    { int tid2 = tid; asm volatile("" : "+v"(tid2));
      const bf16_t* src = VT + (size_t)(h * 256 + (tid2 >> 5)) * MMEM + b * NMEM + (tid2 & 31) * 8; LAS unsigned char* dst = lds + (tid2 >> 5) * CA_STRIDE + (tid2 & 31) * 16;
#pragma unroll
      for (int i = 0; i < 16; ++i) { const u32x4 v = *(const u32x4*)(src + (size_t)i * 16 * MMEM); *(LAS u32x4*)(dst + i * 16 * CA_STRIDE) = v; } }
    __syncthreads();
#pragma unroll 1
    for (int dh = 0; dh < 2; ++dh) {
        f32x4 O[2][8];
#pragma unroll
        for (int st = 0; st < 2; ++st)
#pragma unroll
            for (int dt = 0; dt < 8; ++dt) O[st][dt] = (f32x4){0.f, 0.f, 0.f, 0.f};
        const LAS unsigned char* pb = lds + (dh * 128 + q16) * CA_STRIDE + g * 8;
#pragma unroll
        for (int dt = 0; dt < 8; ++dt)
#pragma unroll
            for (int c = 0; c < 8; ++c) { const LAS unsigned char* p = pb + dt * 16 * CA_STRIDE + c * 64;
                const u32x2 lo = *(const LAS u32x2*)p, hi = *(const LAS u32x2*)(p + 32);
                const u32x4 av = (u32x4){lo.x, lo.y, hi.x, hi.y}; const bf16x8v a = __builtin_bit_cast(bf16x8v, av);
                O[0][dt] = __builtin_amdgcn_mfma_f32_16x16x32_bf16(a, P[0][c], O[0][dt], 0, 0, 0);
                O[1][dt] = __builtin_amdgcn_mfma_f32_16x16x32_bf16(a, P[1][c], O[1][dt], 0, 0, 0); }
#pragma unroll
        for (int st = 0; st < 2; ++st)
#pragma unroll
            for (int dt = 0; dt < 8; ++dt) { const f32x4 o = O[st][dt] * linv[st]; u32x2 w;
                w.x = (unsigned)f2bf(o[0]) | ((unsigned)f2bf(o[1]) << 16); w.y = (unsigned)f2bf(o[2]) | ((unsigned)f2bf(o[3]) << 16);
                *(u32x2*)(OC + (row0 + st * 16 + q16) * DM + h * 256 + dh * 128 + dt * 16 + g * 4) = w; }
    }
    __syncthreads();
}
typedef float f32x16v __attribute__((ext_vector_type(16)));
__device__ __forceinline__ unsigned code16(float s) {
    const _Float16 hf = (_Float16)s; unsigned u = (unsigned)__builtin_bit_cast(unsigned short, hf);
    if ((u & 0x7fffu) == 0u) u = 0u;
    return (u & 0x8000u) ? (~u & 0xffffu) : (u | 0x8000u);
}
__device__ __forceinline__ unsigned mbcnt64(unsigned long long m) { return __builtin_amdgcn_mbcnt_hi((unsigned)(m >> 32), __builtin_amdgcn_mbcnt_lo((unsigned)m, 0u)); }
__device__ __forceinline__ void topk_unit(LAS unsigned char* lds, int b, int j, const bf16_t* QI, const bf16_t* KI, const float* WI, unsigned short* SEL, int tid, int lane, int wave) {
    asm volatile("" : "+v"(tid), "+v"(lane));
    const int t0 = 16 * j, L = t0 + 16, nkt = (L + 31) >> 5;
    const size_t rowbase = (size_t)b * SEQ + t0;
    const int c32 = lane & 31, hi = lane >> 5;
    {
        bf16x8v qa[2][4]; f32x4 wq[2][4];
#pragma unroll
        for (int rt = 0; rt < 2; ++rt) {
#pragma unroll
            for (int ks = 0; ks < 4; ++ks) qa[rt][ks] = *(const bf16x8v*)(QI + (rowbase + 8 * rt + (c32 >> 2)) * 256 + (c32 & 3) * 64 + 16 * ks + 8 * hi);
#pragma unroll
            for (int gq = 0; gq < 4; ++gq) wq[rt][gq] = *(const f32x4*)(WI + (rowbase + 8 * rt + 2 * gq + hi) * 4);
        }
        const bf16_t* kbase = KI + ((size_t)b * SEQ + c32) * 64 + 8 * hi;
        bf16x8v kb[4], kn[4];
        int kt = wave;
        if (kt < nkt) {
#pragma unroll
            for (int ks = 0; ks < 4; ++ks) kb[ks] = *(const bf16x8v*)(kbase + (size_t)kt * 32 * 64 + 16 * ks);
        }
        for (; kt < nkt; kt += 8) {
            const int ktn = (kt + 8 < nkt) ? kt + 8 : kt;
#pragma unroll
            for (int ks = 0; ks < 4; ++ks) kn[ks] = *(const bf16x8v*)(kbase + (size_t)ktn * 32 * 64 + 16 * ks);
#pragma unroll
            for (int rt = 0; rt < 2; ++rt) {
                f32x16v c = {0.f, 0.f, 0.f, 0.f, 0.f, 0.f, 0.f, 0.f, 0.f, 0.f, 0.f, 0.f, 0.f, 0.f, 0.f, 0.f};
#pragma unroll
                for (int ks = 0; ks < 4; ++ks) c = __builtin_amdgcn_mfma_f32_32x32x16_bf16(qa[rt][ks], kb[ks], c, 0, 0, 0);
#pragma unroll
                for (int gq = 0; gq < 4; ++gq) {
                    const f32x4 w = wq[rt][gq];
                    const float sc = w[0] * fmaxf(c[4 * gq + 0], 0.f) + w[1] * fmaxf(c[4 * gq + 1], 0.f) + w[2] * fmaxf(c[4 * gq + 2], 0.f) + w[3] * fmaxf(c[4 * gq + 3], 0.f);
                    const int q = 8 * rt + 2 * gq + hi;
                    *(LAS unsigned short*)(lds + q * 8192 + (kt * 32 + c32) * 2) = (unsigned short)code16(sc);
                }
            }
#pragma unroll
            for (int ks = 0; ks < 4; ++ks) kb[ks] = kn[ks];
        }
    }
    __syncthreads();
#pragma unroll 1
    for (int qq = 0; qq < 2; ++qq) {
        const int q = 2 * wave + qq, t = t0 + q, n = t + 1;
        unsigned short* sel = SEL + (rowbase + q) * TOPK;
        if (n <= TOPK) {
#pragma unroll
            for (int i = 0; i < 4; ++i) { const int s = lane + 64 * i; if (s < n) sel[s] = (unsigned short)s; }
            continue;
        }
        const int nch = (n + 127) >> 7;
        unsigned lo[32], hi16[32];
        const LAS unsigned* row = (const LAS unsigned*)(lds + q * 8192) + lane;
#pragma unroll
        for (int c = 0; c < 32; ++c) {
            unsigned v = 0u; if (c < nch) v = row[64 * c];
            const int i0 = 128 * c + 2 * lane;
            lo[c] = (i0 <= t) ? (v & 0xffffu) : 0u; hi16[c] = (i0 + 1 <= t) ? (v >> 16) : 0u;
        }
        unsigned T = 0u;
#pragma unroll 1
        for (int bit = 15; bit >= 0; --bit) {
            const unsigned cand = T | (1u << bit); unsigned cnt = 0u;
#pragma unroll
            for (int c = 0; c < 32; ++c) if (c < nch) { cnt += (unsigned)__popcll(__ballot(lo[c] >= cand)); cnt += (unsigned)__popcll(__ballot(hi16[c] >= cand)); }
            if (cnt >= (unsigned)TOPK) T = cand;
        }
        unsigned cgt = 0u;
#pragma unroll
        for (int c = 0; c < 32; ++c) if (c < nch) { cgt += (unsigned)__popcll(__ballot(lo[c] > T)); cgt += (unsigned)__popcll(__ballot(hi16[c] > T)); }
        const unsigned need = (unsigned)TOPK - cgt;
        unsigned eqrun = 0u, selrun = 0u;
#pragma unroll
        for (int c = 0; c < 32; ++c) if (c < nch) {
            const bool elo = lo[c] == T, ehi = hi16[c] == T;
            const unsigned long long melo = __ballot(elo), mehi = __ballot(ehi);
            const unsigned rank_lo = eqrun + mbcnt64(melo) + mbcnt64(mehi), rank_hi = rank_lo + (elo ? 1u : 0u);
            const bool tlo = (lo[c] > T) || (elo && rank_lo < need), thi = (hi16[c] > T) || (ehi && rank_hi < need);
            const unsigned long long mtlo = __ballot(tlo), mthi = __ballot(thi);
            const unsigned pos_lo = selrun + mbcnt64(mtlo) + mbcnt64(mthi), pos_hi = pos_lo + (tlo ? 1u : 0u);
            if (tlo && pos_lo < (unsigned)TOPK) sel[pos_lo] = (unsigned short)(128 * c + 2 * lane);
            if (thi && pos_hi < (unsigned)TOPK) sel[pos_hi] = (unsigned short)(128 * c + 2 * lane + 1);
            eqrun += (unsigned)__popcll(melo) + (unsigned)__popcll(mehi); selrun += (unsigned)__popcll(mtlo) + (unsigned)__popcll(mthi);
        }
    }
    __syncthreads();
}
__device__ __forceinline__ void topk_phase(LAS unsigned char* lds, int G, int vcu, const bf16_t* QI, const bf16_t* KI, const float* WI, unsigned short* SEL, int tid, int lane, int wave) {
    if (G == 256) {
        const int b = vcu >> 5, i = vcu & 31;
#pragma unroll 1
        for (int k = 0; k < 8; ++k) { const int j = 64 * (k >> 1) + ((k & 1) ? 63 - i : i); topk_unit(lds, b, j, QI, KI, WI, SEL, tid, lane, wave); }
    } else {
#pragma unroll 1
        for (int u = vcu; u < BATCH * 256; u += G) topk_unit(lds, u >> 8, u & 255, QI, KI, WI, SEL, tid, lane, wave);
    }
}

__device__ __forceinline__ void wt_body(LAS unsigned char* sm, int vb, int tid, const float* __restrict__ W, int K, int N, bf16_t* WT) {
    LAS float* t = (LAS float*)sm;
    const int nbx = (N + 31) / 32; const int k0 = (vb / nbx) * 32, n0 = (vb % nbx) * 32, tx = tid & 31, ty = tid >> 5;
    for (int i = ty; i < 32; i += 8) { const int k = k0 + i, n = n0 + tx; t[i * 33 + tx] = (k < K && n < N) ? W[(size_t)k * N + n] : 0.f; }
    __syncthreads();
    for (int i = ty; i < 32; i += 8) { const int n = n0 + i, k = k0 + tx; if (n < N && k < K) WT[(size_t)n * K + k] = f2bf(t[tx * 33 + i]); }
    __syncthreads();
}
__device__ __forceinline__ void rmsnorm_bf16_row(const float* x, const float* __restrict__ g, bf16_t* out, int row, int lane) {
    const f32x4* xr = (const f32x4*)(x + (size_t)row * DM) + lane; const f32x4* gr = (const f32x4*)g + lane;
    f32x4 v[4]; float s = 0.f;
#pragma unroll
    for (int j = 0; j < 4; ++j) { v[j] = xr[64 * j]; s += (v[j].x * v[j].x + v[j].y * v[j].y) + (v[j].z * v[j].z + v[j].w * v[j].w); }
    const float rstd = 1.f / sqrtf(wave_sum(s) * (1.f / DM) + EPS);
    u32x2* o = (u32x2*)(out + (size_t)row * DM) + lane;
#pragma unroll
    for (int j = 0; j < 4; ++j) { const f32x4 gg = gr[64 * j]; u32x2 w;
        w.x = (unsigned)f2bf(v[j].x * rstd * gg.x) | ((unsigned)f2bf(v[j].y * rstd * gg.y) << 16);
        w.y = (unsigned)f2bf(v[j].z * rstd * gg.z) | ((unsigned)f2bf(v[j].w * rstd * gg.w) << 16); o[64 * j] = w; }
}
__device__ __forceinline__ void rmsnorm_f32_row(float* x, const float* __restrict__ g, int row, int lane) {
    f32x4* xr = (f32x4*)(x + (size_t)row * DM) + lane; const f32x4* gr = (const f32x4*)g + lane;
    f32x4 v[4]; float s = 0.f;
#pragma unroll
    for (int j = 0; j < 4; ++j) { v[j] = xr[64 * j]; s += (v[j].x * v[j].x + v[j].y * v[j].y) + (v[j].z * v[j].z + v[j].w * v[j].w); }
    const float rstd = 1.f / sqrtf(wave_sum(s) * (1.f / DM) + EPS);
#pragma unroll
    for (int j = 0; j < 4; ++j) { const f32x4 gg = gr[64 * j]; xr[64 * j] = v[j] * rstd * gg; }
}
__device__ __forceinline__ float rope_val(const LAS float* p, int base, int d, const LAS float* cs, const LAS float* sn) {
    if (d < 8) return p[base + d] * cs[d] - p[base + d + 8] * sn[d];
    if (d < 16) return p[base + d] * cs[d - 8] + p[base + d - 8] * sn[d - 8];
    return p[base + d];
}
__device__ __forceinline__ void split_rope_body(LAS unsigned char* sm, int row, int tid, const float* proj, const int* __restrict__ positions, bf16_t* Q, bf16_t* Kb, bf16_t* Vb, bf16_t* QI, bf16_t* KI, float* WI, bf16_t* U) {
    LAS float* p = (LAS float*)sm; LAS float* cs = p + INP; LAS float* sn = cs + 8;
    for (int c = tid; c < INP; c += 256) p[c] = proj[(size_t)row * INP + c];
    if (tid < 8) { const float freq = (float)pow(500000.0, -0.125 * (double)tid); const float ang = (float)positions[row] * freq; cs[tid] = (float)cos((double)ang); sn[tid] = (float)sin((double)ang); }
    __syncthreads();
    for (int c = tid; c < 512; c += 256) Q[(size_t)row * 512 + c] = f2bf(rope_val(p, (c >> 6) * 64, c & 63, cs, sn));
    if (tid < 64) Kb[(size_t)row * 64 + tid] = f2bf(rope_val(p, 512, tid, cs, sn));
    else if (tid < 128) Vb[(size_t)row * 64 + tid - 64] = f2bf(p[576 + tid - 64]);
    else if (tid < 192) KI[(size_t)row * 64 + tid - 128] = f2bf(rope_val(p, 896, tid - 128, cs, sn));
    else if (tid < 196) WI[(size_t)row * 4 + tid - 192] = p[960 + tid - 192] * 0.5f;
    QI[(size_t)row * 256 + tid] = f2bf(rope_val(p, 640 + (tid >> 6) * 64, tid & 63, cs, sn) * 0.125f);
    for (int c = tid; c < 512; c += 256) { const float ga = p[964 + c], gg = p[1476 + c]; U[(size_t)row * 512 + c] = f2bf(ga / (1.f + __expf(-gg))); }
    __syncthreads();
}
__device__ __forceinline__ unsigned fkey(float s) { unsigned u = __float_as_uint(s); if ((u << 1) == 0u) u = 0u; return (u & 0x80000000u) ? ~u : (u | 0x80000000u); }
__device__ __forceinline__ void topk_body(LAS unsigned char* sm, int row, int tid, const bf16_t* QI, const bf16_t* KI, const float* WI, unsigned short* SEL) {
    LAS float* qs = (LAS float*)sm; LAS unsigned* key = (LAS unsigned*)(sm + 1024); LAS unsigned* scan = (LAS unsigned*)(sm + 1024 + 16384); LAS unsigned* cntp = (LAS unsigned*)(sm + 1024 + 16384 + 1024);
    const int b = row / SEQ, t = row % SEQ, n = t + 1;
    unsigned short* sel = SEL + (size_t)row * TOPK;
    if (n <= TOPK) { if (tid < n) sel[tid] = (unsigned short)tid; return; }
    qs[tid] = bf2f(QI[(size_t)row * 256 + tid]);
    const float w0 = WI[(size_t)row * 4 + 0], w1 = WI[(size_t)row * 4 + 1], w2 = WI[(size_t)row * 4 + 2], w3 = WI[(size_t)row * 4 + 3];
    __syncthreads();
    for (int s = tid; s < n; s += 256) {
        const u32x4* kp = (const u32x4*)(KI + ((size_t)b * SEQ + s) * 64);
        float a0 = 0.f, a1 = 0.f, a2 = 0.f, a3 = 0.f;
#pragma unroll 2
        for (int c = 0; c < 8; ++c) { const u32x4 kv = kp[c];
#pragma unroll
            for (int e = 0; e < 4; ++e) { const float klo = __uint_as_float(kv[e] << 16), khi = __uint_as_float(kv[e] & 0xffff0000u); const int d = c * 8 + e * 2;
                a0 += qs[d] * klo + qs[d + 1] * khi; a1 += qs[64 + d] * klo + qs[64 + d + 1] * khi; a2 += qs[128 + d] * klo + qs[128 + d + 1] * khi; a3 += qs[192 + d] * klo + qs[192 + d + 1] * khi; } }
        const float sc = w0 * fmaxf(a0, 0.f) + w1 * fmaxf(a1, 0.f) + w2 * fmaxf(a2, 0.f) + w3 * fmaxf(a3, 0.f);
        key[s] = fkey(sc);
    }
    __syncthreads();
    unsigned prefix = 0u;
    for (int bit = 31; bit >= 0; --bit) {
        const unsigned cand = prefix | (1u << bit);
        if (tid == 0) *cntp = 0u;
        __syncthreads();
        unsigned c = 0u; for (int s = tid; s < n; s += 256) c += (key[s] >= cand) ? 1u : 0u;
        if (c) atomicAdd((unsigned*)cntp, c);
        __syncthreads();
        if (*cntp >= (unsigned)TOPK) prefix = cand;
        __syncthreads();
    }
    if (tid == 0) *cntp = 0u;
    __syncthreads();
    { unsigned c = 0u; for (int s = tid; s < n; s += 256) c += (key[s] > prefix) ? 1u : 0u; if (c) atomicAdd((unsigned*)cntp, c); }
    __syncthreads();
    const unsigned need = (unsigned)TOPK - *cntp;
    __syncthreads();
    const int s0 = tid * 16; unsigned eqc = 0u;
    for (int i = 0; i < 16; ++i) { const int s = s0 + i; if (s < n && key[s] == prefix) ++eqc; }
    scan[tid] = eqc; __syncthreads();
    for (int o = 1; o < 256; o <<= 1) { const unsigned v = (tid >= o) ? scan[tid - o] : 0u; __syncthreads(); scan[tid] += v; __syncthreads(); }
    unsigned eq_before = scan[tid] - eqc; __syncthreads();
    unsigned takec = 0u; unsigned takemask = 0u;
    for (int i = 0; i < 16; ++i) { const int s = s0 + i; if (s < n) { const unsigned k = key[s]; bool take = k > prefix; if (k == prefix) { take = eq_before < need; ++eq_before; } if (take) { ++takec; takemask |= 1u << i; } } }
    scan[tid] = takec; __syncthreads();
    for (int o = 1; o < 256; o <<= 1) { const unsigned v = (tid >= o) ? scan[tid - o] : 0u; __syncthreads(); scan[tid] += v; __syncthreads(); }
    unsigned pos = scan[tid] - takec;
    for (int i = 0; i < 16; ++i) if (takemask & (1u << i)) { if (pos < (unsigned)TOPK) sel[pos] = (unsigned short)(s0 + i); ++pos; }
    __syncthreads();
}
__device__ __forceinline__ void sparse_attn_body(LAS unsigned char* sm, int row, int tid, const bf16_t* Q, const bf16_t* Kb, const bf16_t* Vb, const unsigned short* SEL, bf16_t* MIX) {
    LAS float* qs = (LAS float*)sm; LAS float* lg = qs + 512;   LAS int* idx = (LAS int*)(lg + NH * TOPK);
    const int b = row / SEQ, t = row % SEQ, n = (t + 1 < TOPK) ? t + 1 : TOPK;
    qs[tid] = bf2f(Q[(size_t)row * 512 + tid]); qs[tid + 256] = bf2f(Q[(size_t)row * 512 + 256 + tid]);
    int myidx = 0; if (tid < n) myidx = (int)SEL[(size_t)row * TOPK + tid]; idx[tid] = myidx;
    __syncthreads();
    if (tid < n) {
        const u32x4* kp = (const u32x4*)(Kb + ((size_t)b * SEQ + myidx) * 64);
        float a[NH];
#pragma unroll
        for (int h = 0; h < NH; ++h) a[h] = 0.f;
#pragma unroll 2
        for (int c = 0; c < 8; ++c) { const u32x4 kv = kp[c];
#pragma unroll
            for (int e = 0; e < 4; ++e) { const float klo = __uint_as_float(kv[e] << 16), khi = __uint_as_float(kv[e] & 0xffff0000u); const int d = c * 8 + e * 2;
#pragma unroll
                for (int h = 0; h < NH; ++h) a[h] += qs[h * 64 + d] * klo + qs[h * 64 + d + 1] * khi; } }
#pragma unroll
        for (int h = 0; h < NH; ++h) lg[h * TOPK + tid] = a[h] * 0.125f;
    } else {
#pragma unroll
        for (int h = 0; h < NH; ++h) lg[h * TOPK + tid] = -INFINITY;
    }
    __syncthreads();
    { const int w = tid >> 6, lane = tid & 63;
      for (int hh = 0; hh < 2; ++hh) { const int h = 2 * w + hh; float v[4], m = -INFINITY;
          for (int i = 0; i < 4; ++i) { v[i] = lg[h * TOPK + lane + 64 * i]; m = fmaxf(m, v[i]); }
          m = wave_max(m); float s = 0.f;
          for (int i = 0; i < 4; ++i) { v[i] = __expf(v[i] - m); s += v[i]; }
          s = wave_sum(s); const float inv = 1.f / s;
          for (int i = 0; i < 4; ++i) lg[h * TOPK + lane + 64 * i] = v[i] * inv; } }
    __syncthreads();
    { const int h = tid >> 5, d0 = (tid & 31) * 2; float o0 = 0.f, o1 = 0.f;
      for (int j = 0; j < n; ++j) { const unsigned vv = *(const unsigned*)(Vb + ((size_t)b * SEQ + idx[j]) * 64 + d0); const float p = lg[h * TOPK + j]; o0 += p * __uint_as_float(vv << 16); o1 += p * __uint_as_float(vv & 0xffff0000u); }
      *(unsigned*)(MIX + (size_t)row * DM + h * 64 + d0) = (unsigned)f2bf(o0) | ((unsigned)f2bf(o1) << 16); }
    __syncthreads();
}
__device__ __forceinline__ void convb_body(LAS unsigned char* sm, int row, int tid, const bf16_t* U, const float* __restrict__ cw, const float* __restrict__ cb, const float* __restrict__ lg, const float* __restrict__ lb, bf16_t* MIX) {
    LAS float* red = (LAS float*)sm;
    const int t = row % SEQ;
    float y[2];
    for (int k = 0; k < 2; ++k) { const int c = tid + 256 * k; float acc = cb[c];
        for (int j = 0; j < 31; ++j) { const int tt = t - 30 + j; if (tt >= 0) acc += cw[j * 512 + c] * bf2f(U[(size_t)(row - 30 + j) * 512 + c]); }
        y[k] = acc; }
    float s = wave_sum(y[0] + y[1]); if ((tid & 63) == 0) red[tid >> 6] = s; __syncthreads();
    const float mu = (red[0] + red[1] + red[2] + red[3]) * (1.f / 512.f); __syncthreads();
    float q = wave_sum((y[0] - mu) * (y[0] - mu) + (y[1] - mu) * (y[1] - mu)); if ((tid & 63) == 0) red[4 + (tid >> 6)] = q; __syncthreads();
    const float rstd = 1.f / sqrtf((red[4] + red[5] + red[6] + red[7]) * (1.f / 512.f) + EPS);
    for (int k = 0; k < 2; ++k) { const int c = tid + 256 * k; const float v = (y[k] - mu) * rstd * lg[c] + lb[c]; MIX[(size_t)row * DM + 512 + c] = f2bf(silu_f(v)); }
    __syncthreads();
}
__device__ __forceinline__ void cross_attn_body(LAS unsigned char* sm, int row, int tid, const bf16_t* QC, const bf16_t* KC, const bf16_t* VC, bf16_t* OC) {
    LAS float* qs = (LAS float*)sm; LAS float* lg = qs + DM;
    const int b = row / SEQ;
    for (int c = tid; c < DM; c += 256) qs[c] = bf2f(QC[(size_t)row * DM + c]);
    __syncthreads();
    { const u32x4* kp = (const u32x4*)(KC + ((size_t)b * NMEM + tid) * DM);
      for (int h = 0; h < 4; ++h) { float a = 0.f;
#pragma unroll 4
          for (int c = 0; c < 32; ++c) { const u32x4 kv = kp[h * 32 + c];
#pragma unroll
              for (int e = 0; e < 4; ++e) { const int d = h * 256 + c * 8 + e * 2; a += qs[d] * __uint_as_float(kv[e] << 16) + qs[d + 1] * __uint_as_float(kv[e] & 0xffff0000u); } }
          lg[h * NMEM + tid] = a * 0.0625f; } }
    __syncthreads();
    { const int h = tid >> 6, lane = tid & 63; float v[4], m = -INFINITY;
      for (int i = 0; i < 4; ++i) { v[i] = lg[h * NMEM + lane + 64 * i]; m = fmaxf(m, v[i]); }
      m = wave_max(m); float s = 0.f;
      for (int i = 0; i < 4; ++i) { v[i] = __expf(v[i] - m); s += v[i]; }
      s = wave_sum(s); const float inv = 1.f / s;
      for (int i = 0; i < 4; ++i) lg[h * NMEM + lane + 64 * i] = v[i] * inv; }
    __syncthreads();
    { const int h = tid >> 6, d0 = h * 256 + (tid & 63) * 4; float o0 = 0.f, o1 = 0.f, o2 = 0.f, o3 = 0.f;
      for (int j = 0; j < NMEM; ++j) { const u32x2 vv = *(const u32x2*)(VC + ((size_t)b * NMEM + j) * DM + d0); const float p = lg[h * NMEM + j];
          o0 += p * __uint_as_float(vv.x << 16); o1 += p * __uint_as_float(vv.x & 0xffff0000u); o2 += p * __uint_as_float(vv.y << 16); o3 += p * __uint_as_float(vv.y & 0xffff0000u); }
      u32x2 w; w.x = (unsigned)f2bf(o0) | ((unsigned)f2bf(o1) << 16); w.y = (unsigned)f2bf(o2) | ((unsigned)f2bf(o3) << 16); *(u32x2*)(OC + (size_t)row * DM + d0) = w; }
    __syncthreads();
}

constexpr size_t MiB = 1u << 20;
constexpr int LDS_USER = 139264, LDSCTL_OFF = LDS_USER, MISC_OFF = LDSCTL_OFF + 320, LDS_BYTES = 147456;
constexpr size_t WS_CTL = 476 * MiB, CTL_ZERO_BYTES = 1 * MiB; constexpr int CW_BAR = 4096;
struct Args { const float* in[23]; float* out; unsigned char* ws; };
static_assert(sizeof(Args) == 25 * 8, "Args has no padding");

__global__ void __launch_bounds__(512, 2) mega_k(Args a) {
    extern __shared__ __attribute__((aligned(16))) unsigned char lds_raw[];
    LAS unsigned char* lds = (LAS unsigned char*)lds_raw;
    const int tid = threadIdx.x, lane = tid & 63, wave = __builtin_amdgcn_readfirstlane(tid >> 6), half = tid >> 8, htid = tid & 255;
    const int G = gridDim.x, bx = blockIdx.x; const int vcu = (G % 8 == 0) ? (bx % 8) * (G / 8) + bx / 8 : bx;
    LAS unsigned char* hsm = lds + half * 65536;
    const float* x = a.in[0]; const float* mem = a.in[1]; const int* positions = (const int*)a.in[2];
    const float* g_mix = a.in[3]; const float* w_in = a.in[4]; const float* w_out = a.in[5];
    const float* conv_b_w = a.in[6]; const float* conv_b_b = a.in[7]; const float* ln_b_g = a.in[8]; const float* ln_b_b = a.in[9];
    const float* g_cross = a.in[10]; const float* g_mem = a.in[11];
    const float* w_q = a.in[12]; const float* w_k = a.in[13]; const float* w_v = a.in[14]; const float* w_o = a.in[15];
    const float* g_ffn = a.in[16]; const float* w_gate = a.in[17]; const float* w_up = a.in[18];
    const float* ffn_cw = a.in[19]; const float* ffn_cb = a.in[20]; const float* w_down = a.in[21]; const float* g_final = a.in[22];
    float* out = a.out; unsigned char* ws = a.ws;
    bf16_t* wt_in = (bf16_t*)(ws + 0 * MiB); bf16_t* wt_out = (bf16_t*)(ws + 4 * MiB);
    bf16_t* wt_q = (bf16_t*)(ws + 6 * MiB), *wt_k = (bf16_t*)(ws + 8 * MiB), *wt_v = (bf16_t*)(ws + 10 * MiB), *wt_o = (bf16_t*)(ws + 12 * MiB);
    bf16_t* wt_gate = (bf16_t*)(ws + 14 * MiB); bf16_t* wt_up = (bf16_t*)(ws + 20 * MiB); bf16_t* wt_down = (bf16_t*)(ws + 26 * MiB);
    float* WI = (float*)(ws + 32 * MiB);
    bf16_t* MEMN = (bf16_t*)(ws + 34 * MiB), *KC = (bf16_t*)(ws + 38 * MiB), *VC = (bf16_t*)(ws + 42 * MiB);
    bf16_t* XN = (bf16_t*)(ws + 48 * MiB); float* PROJ = (float*)(ws + 112 * MiB);
    bf16_t* Qb = (bf16_t*)(ws + 368 * MiB); bf16_t* QI = (bf16_t*)(ws + 400 * MiB);
    bf16_t* Kb = (bf16_t*)(ws + 416 * MiB), *Vb = (bf16_t*)(ws + 420 * MiB), *KI = (bf16_t*)(ws + 424 * MiB);
    bf16_t* U = (bf16_t*)(ws + 428 * MiB); unsigned short* SEL = (unsigned short*)(ws + 460 * MiB);
    bf16_t* MIX = (bf16_t*)(ws + 112 * MiB); bf16_t* QC = (bf16_t*)(ws + 176 * MiB); bf16_t* OC = (bf16_t*)(ws + 240 * MiB);
    bf16_t* Gb = (bf16_t*)(ws + 112 * MiB); bf16_t* UF = (bf16_t*)(ws + 288 * MiB);
    unsigned* ctl = (unsigned*)(ws + WS_CTL);

    for (int u = tid; u < (LDS_BYTES - LDSCTL_OFF) / 4; u += 512) ((LAS unsigned*)(lds + LDSCTL_OFF))[u] = 0u;
    __syncthreads();
    XcdBarrier bar = xcd_barrier_post(ctl + CW_BAR, (volatile LAS unsigned*)(lds + MISC_OFF) + 8);
#define GRID_BAR() xcd_barrier(bar)
#define FOR_VB(nvb) for (int vb = 2 * bx + half; vb < (nvb); vb += 2 * G)
#define GEMM(Aptr, Bptr, Mv, Nv, Kv, OF, OB, RES, LDC) do { pg8::Gemm g_{Aptr, Bptr, Mv, Nv, Kv}; pg8::StaticOrder S_; S_.init(Mv, Nv, G, bx); EpiStore E_{OF, OB, RES, LDC}; \
        pg8::gemm_phase<EpiStore, pg8::StaticOrder, true, true>(lds, g_, S_, E_); } while (0)

    for (int i = bx * 512 + tid; i < (INP - INC) * DM; i += G * 512) wt_in[(size_t)INC * DM + i] = 0;
    FOR_VB(32 * 63) wt_body(hsm, vb, htid, w_in, DM, INC, wt_in);
    FOR_VB(32 * 32) wt_body(hsm, vb, htid, w_out, DM, DM, wt_out);
    FOR_VB(32 * 32) wt_body(hsm, vb, htid, w_q, DM, DM, wt_q);
    FOR_VB(32 * 32) wt_body(hsm, vb, htid, w_k, DM, DM, wt_k);
    FOR_VB(32 * 32) wt_body(hsm, vb, htid, w_v, DM, DM, wt_v);
    FOR_VB(32 * 32) wt_body(hsm, vb, htid, w_o, DM, DM, wt_o);
    FOR_VB(32 * 88) wt_body(hsm, vb, htid, w_gate, DM, DFF, wt_gate);
    FOR_VB(32 * 88) wt_body(hsm, vb, htid, w_up, DM, DFF, wt_up);
    FOR_VB(88 * 32) wt_body(hsm, vb, htid, w_down, DFF, DM, wt_down);
    for (int r = bx * 8 + wave; r < MTOK; r += G * 8) rmsnorm_bf16_row(x, g_mix, XN, r, lane);
    for (int r = bx * 8 + wave; r < MMEM; r += G * 8) rmsnorm_bf16_row(mem, g_mem, MEMN, r, lane);
    GRID_BAR();
    GEMM(XN, wt_in, MTOK, INP, DM, PROJ, (bf16_t*)nullptr, (const float*)nullptr, INP);
    GEMM(MEMN, wt_k, MMEM, DM, DM, (float*)nullptr, KC, (const float*)nullptr, DM);
    GEMM(wt_v, MEMN, DM, MMEM, DM, (float*)nullptr, VC, (const float*)nullptr, MMEM);
    GRID_BAR();
    FOR_VB(MTOK) split_rope_body(hsm, vb, htid, PROJ, positions, Qb, Kb, Vb, QI, KI, WI, U);
    GRID_BAR();
    topk_phase(lds, G, vcu, QI, KI, WI, SEL, tid, lane, wave);
    FOR_VB(MTOK) convb_body(hsm, vb, htid, U, conv_b_w, conv_b_b, ln_b_g, ln_b_b, MIX);
    GRID_BAR();
    FOR_VB(MTOK) sparse_attn_body(hsm, vb, htid, Qb, Kb, Vb, SEL, MIX);
    GRID_BAR();
    GEMM(MIX, wt_out, MTOK, DM, DM, out, (bf16_t*)nullptr, x, DM);
    GRID_BAR();
    for (int r = bx * 8 + wave; r < MTOK; r += G * 8) rmsnorm_bf16_row(out, g_cross, XN, r, lane);
    GRID_BAR();
    GEMM(XN, wt_q, MTOK, DM, DM, (float*)nullptr, QC, (const float*)nullptr, DM);
    GRID_BAR();
    { const int per = (512 + G - 1) / G; for (int i = 0; i < per; ++i) { const int u = vcu * per + i; if (u < 512) cross_attn_unit(lds, u >> 6, (u >> 4) & 3, u & 15, QC, KC, VC, OC, tid, lane, wave); } }
    GRID_BAR();
    GEMM(OC, wt_o, MTOK, DM, DM, out, (bf16_t*)nullptr, out, DM);
    GRID_BAR();
    for (int r = bx * 8 + wave; r < MTOK; r += G * 8) rmsnorm_bf16_row(out, g_ffn, XN, r, lane);
    GRID_BAR();
    GEMM(XN, wt_gate, MTOK, DFF, DM, (float*)nullptr, Gb, (const float*)nullptr, DFF);
    GEMM(XN, wt_up, MTOK, DFF, DM, (float*)nullptr, UF, (const float*)nullptr, DFF);
    GRID_BAR();
    for (size_t i = (size_t)bx * 512 + tid; i < (size_t)MTOK * DFF; i += (size_t)G * 512) {
        const int c = (int)(i % DFF); const size_t row = i / DFF; const int t = (int)(row % SEQ);
        float g = ffn_cb[c] + ffn_cw[2 * DFF + c] * bf2f(Gb[i]);
        if (t >= 1) g += ffn_cw[1 * DFF + c] * bf2f(Gb[i - DFF]);
        if (t >= 2) g += ffn_cw[0 * DFF + c] * bf2f(Gb[i - 2 * DFF]);
        UF[i] = f2bf(silu_f(g) * bf2f(UF[i]));
    }
    GRID_BAR();
    GEMM(UF, wt_down, MTOK, DM, DFF, out, (bf16_t*)nullptr, out, DM);
    GRID_BAR();
    for (int r = bx * 8 + wave; r < MTOK; r += G * 8) rmsnorm_f32_row(out, g_final, r, lane);
}

extern "C" void kernel_launch(void* const* d_in, const int* in_sizes, int n_in, void* d_out, int out_size, void* d_ws, size_t ws_size, hipStream_t stream) {
    static int grid = 0;
    if (grid == 0) {
        int dev = 0, cus = 0, per_cu = 0;
        if (hipGetDevice(&dev) != hipSuccess || hipDeviceGetAttribute(&cus, hipDeviceAttributeMultiprocessorCount, dev) != hipSuccess) { fprintf(stderr, "kernel_launch: device query failed\n"); grid = -1; return; }
        if (hipFuncSetAttribute((const void*)mega_k, hipFuncAttributeMaxDynamicSharedMemorySize, LDS_BYTES) != hipSuccess) { fprintf(stderr, "kernel_launch: hipFuncSetAttribute failed\n"); grid = -1; return; }
        if (hipOccupancyMaxActiveBlocksPerMultiprocessor(&per_cu, (const void*)mega_k, 512, LDS_BYTES) != hipSuccess || per_cu < 1) { fprintf(stderr, "kernel_launch: occupancy query says %d\n", per_cu); per_cu = 1; }
        (void)hipGetLastError();
        grid = cus * 1;
        if (n_in != 23 || ws_size < 477 * MiB) { fprintf(stderr, "kernel_launch: unexpected n_in %d / ws %zu\n", n_in, ws_size); grid = -1; return; }
    }
    if (grid < 0) return;
    (void)hipMemsetAsync((char*)d_ws + WS_CTL, 0, CTL_ZERO_BYTES, stream);
    Args a{};
    for (int i = 0; i < 23; ++i) a.in[i] = (const float*)d_in[i];
    a.out = (float*)d_out; a.ws = (unsigned char*)d_ws;
    void* params[] = {&a};
    hipError_t e = hipLaunchCooperativeKernel((const void*)mega_k, dim3(grid), dim3(512), params, LDS_BYTES, stream);
    if (e != hipSuccess) fprintf(stderr, "cooperative launch failed: %s (grid %d)\n", hipGetErrorString(e), grid);
}
```

```cpp
#include <hip/hip_runtime.h>
#include <cstdio>
#include <cstdint>
#include <cmath>
namespace pg8 {
#define PG8_LAS __attribute__((address_space(3)))
typedef unsigned short bf16_t;
typedef short bf16x8 __attribute__((ext_vector_type(8)));
typedef float f32x4 __attribute__((ext_vector_type(4)));
typedef unsigned u32x4 __attribute__((ext_vector_type(4)));
constexpr int BM = 256, BK = 64, HALF = 128, HTB = HALF * BK * 2  , STAGE_BYTES = 8 * HTB, NXCD = 8, WGM = 8;

__host__ __device__ __forceinline__ int lds_byte(int r, int c) { const int st = (r >> 4) * 2 + (c >> 5), rr = r & 15, cc = c & 31, ob = rr * 64 + cc * 2; return st * 1024 + (ob ^ (((ob >> 9) & 1) << 5)); }
__host__ __device__ __forceinline__ void stage_rc(int b, int& R, int& C) { const int st = b / 1024, sb = b % 1024, swz = sb ^ (((sb >> 9) & 1) << 5); R = (st >> 1) * 16 + swz / 64; C = (st & 1) * 32 + (swz % 64) / 2; }
__host__ __device__ __forceinline__ int perm32(int rho) { const int n = rho >> 4, i = rho & 15; return 8 * (i >> 2) + 4 * n + (i & 3); }

struct Unit { int pm, pn; };
struct Gemm { const bf16_t* A; const bf16_t* Bt; int M, N, K; };

struct StaticOrder {
    int nM, nN, nwg, G, c;
    __host__ __device__ void init(int M, int N, int G_, int c_) { nM = M / BM; nN = N / BM; nwg = nM * nN; G = G_; c = c_; }
    __host__ __device__ bool next(int i, Unit& u) const {
        const long L = (long)i * G + c; if (L >= nwg) return false;
        int wgid = (int)L; { const int q = nwg / NXCD, r = nwg % NXCD, xcd = wgid % NXCD, off = wgid / NXCD; wgid = (xcd < r ? xcd * (q + 1) : r * (q + 1) + (xcd - r) * q) + off; }
        const int nig = WGM * nN, gid = wgid / nig, fm = gid * WGM, gsz = (nM - fm) < WGM ? (nM - fm) : WGM;
        u.pm = fm + ((wgid % nig) % gsz); u.pn = (wgid % nig) / gsz; return true;
    }
    __device__ __forceinline__ void a_ready(const Unit&) const {}
    __device__ __forceinline__ void done(const Unit&) const {}
};
__device__ __forceinline__ unsigned cvt_pk_bf16(float lo, float hi) { unsigned r; asm volatile("v_cvt_pk_bf16_f32 %0, %1, %2" : "=v"(r) : "v"(lo), "v"(hi)); return r; }
template <class Epi, class Sched, bool ALIGN_EPI = false, bool SP2 = false>
__device__ __forceinline__ void gemm_phase(PG8_LAS unsigned char* lds, const Gemm g, const Sched& S, const Epi& E) {
    int tid_l = threadIdx.x; asm volatile("" : "+v"(tid_l));
    const int tid = tid_l, wid = __builtin_amdgcn_readfirstlane(tid >> 6), lane = tid & 63, wr = wid >> 2, wc = wid & 3, fr = lane & 15, fq = lane >> 4;
    const int K = g.K, nt = K / BK;
    unsigned voffA[2], voffB[2];
#pragma unroll
    for (int i = 0; i < 2; ++i) { int R, C; stage_rc(tid * 16 + i * 8192, R, C); const int Rb = Epi::PERM ? ((R & ~31) + perm32(R & 31)) : R;
        voffA[i] = (unsigned)(R * K + C) * 2u; voffB[i] = (unsigned)(Rb * K + C) * 2u; }
    const size_t kstep = (size_t)(BK * 2);
    const size_t hstep = (size_t)HALF * K * 2;
    const size_t tstep = 2 * hstep;
    const unsigned ldsw = (unsigned)wid * 1024u;
    const int aoff = lds_byte(wr * 64 + fr, fq * 8), boff = lds_byte(wc * 32 + fr, fq * 8);
#define PG8_SA(b, h) (((b) * 2 + (h)) * HTB)
#define PG8_SB(b, h) ((4 + (b) * 2 + (h)) * HTB)
#define PG8_STAGE(bufoff, gbase, voff) do { _Pragma("unroll") for (int _i = 0; _i < 2; ++_i) \
        __builtin_amdgcn_global_load_lds((const unsigned*)((const char*)(gbase) + (voff)[_i]), (PG8_LAS unsigned*)(lds + (bufoff) + ldsw + _i * 8192), 16, 0, 0); } while (0)
#define PG8_LDA(dst, b, h) do { _Pragma("unroll") for (int m = 0; m < 4; ++m) _Pragma("unroll") for (int k = 0; k < 2; ++k) dst[m][k] = *(const PG8_LAS bf16x8*)(lds + PG8_SA(b, h) + aoff + m * 2048 + k * 1024); } while (0)
#define PG8_LDB(dst, b, h) do { _Pragma("unroll") for (int n = 0; n < 2; ++n) _Pragma("unroll") for (int k = 0; k < 2; ++k) dst[n][k] = *(const PG8_LAS bf16x8*)(lds + PG8_SB(b, h) + boff + n * 2048 + k * 1024); } while (0)
#define PG8_MMA(ai, bj, At, Bt) do { __builtin_amdgcn_s_setprio(1); _Pragma("unroll") for (int m = 0; m < 4; ++m) _Pragma("unroll") for (int n = 0; n < 2; ++n) _Pragma("unroll") for (int k = 0; k < 2; ++k) \
        acc[ai][bj][m][n] = __builtin_amdgcn_mfma_f32_16x16x32_bf16(Bt[n][k], At[m][k], acc[ai][bj][m][n], 0, 0, 0); __builtin_amdgcn_s_setprio(0); } while (0)
#define PG8_WAIT_V(n) asm volatile("s_waitcnt vmcnt(" #n ")" ::: "memory")
#define PG8_WAIT_L(n) asm volatile("s_waitcnt lgkmcnt(" #n ")" ::: "memory")
#define PG8_BAR __builtin_amdgcn_s_barrier()
#define PG8_SCHED __builtin_amdgcn_sched_barrier(0)
    Unit cur, nxt; int ui = 0;
    if (!S.next(0, cur)) return;
    f32x4 acc[2][2][4][2];
#pragma unroll
    for (int a = 0; a < 2; ++a)
#pragma unroll
        for (int b = 0; b < 2; ++b)
#pragma unroll
            for (int m = 0; m < 4; ++m)
#pragma unroll
                for (int n = 0; n < 2; ++n) acc[a][b][m][n] = (f32x4){0.f, 0.f, 0.f, 0.f};
    bf16x8 At[4][2], B0[2][2], B1[2][2];
    const char* cA = (const char*)g.A + (size_t)cur.pm * tstep; const char* cB = (const char*)g.Bt + (size_t)cur.pn * tstep;
    S.a_ready(cur);
    if constexpr (SP2) {
        PG8_STAGE(PG8_SB(0, 0), cB, voffB); PG8_STAGE(PG8_SB(0, 1), cB + hstep, voffB); PG8_STAGE(PG8_SA(0, 0), cA, voffA); PG8_STAGE(PG8_SA(0, 1), cA + hstep, voffA);
        if (wr == 1) PG8_BAR;
        PG8_WAIT_V(2); PG8_BAR;
        PG8_STAGE(PG8_SB(1, 0), cB + kstep, voffB); PG8_STAGE(PG8_SA(1, 0), cA + kstep, voffA); PG8_STAGE(PG8_SB(1, 1), cB + hstep + kstep, voffB);
        PG8_WAIT_V(6); PG8_BAR;
    } else {
        PG8_STAGE(PG8_SB(0, 0), cB, voffB); PG8_STAGE(PG8_SA(0, 0), cA, voffA); PG8_STAGE(PG8_SB(0, 1), cB + hstep, voffB); PG8_STAGE(PG8_SA(0, 1), cA + hstep, voffA);
        if (wr == 1) PG8_BAR;
        PG8_WAIT_V(4); PG8_BAR;
        PG8_STAGE(PG8_SB(1, 0), cB + kstep, voffB); PG8_STAGE(PG8_SA(1, 0), cA + kstep, voffA); PG8_STAGE(PG8_SB(1, 1), cB + hstep + kstep, voffB);
        PG8_WAIT_V(6); PG8_BAR;
    }
    for (;;) {
        const bool has_next = S.next(ui + 1, nxt);
        const char* nA = has_next ? (const char*)g.A + (size_t)nxt.pm * tstep : cA; const char* nB = has_next ? (const char*)g.Bt + (size_t)nxt.pn * tstep : cB;
        for (int t = 0; t < nt; t += 2) {
            const bool last = (t == nt - 2);
            const char* a1 = cA + (size_t)(t + 1) * kstep;
            const char* a2 = last ? nA : cA + (size_t)(t + 2) * kstep; const char* b2 = last ? nB : cB + (size_t)(t + 2) * kstep;
            const char* a3 = a2 + kstep; const char* b3 = b2 + kstep;
            if (last && has_next) S.a_ready(nxt);
            if constexpr (SP2) {
            PG8_LDB(B0, 0, 0); PG8_LDB(B1, 0, 1); PG8_SCHED; PG8_LDA(At, 0, 0); PG8_STAGE(PG8_SA(1, 1), a1 + hstep, voffA);
            PG8_WAIT_V(8); PG8_WAIT_L(0); PG8_BAR; PG8_MMA(0, 0, At, B0); PG8_MMA(0, 1, At, B1); PG8_BAR; PG8_SCHED;
            PG8_LDA(At, 0, 1); PG8_STAGE(PG8_SB(0, 0), b2, voffB); PG8_STAGE(PG8_SB(0, 1), b2 + hstep, voffB); PG8_STAGE(PG8_SA(0, 0), a2, voffA);
            PG8_WAIT_V(8); PG8_WAIT_L(0); PG8_BAR; PG8_MMA(1, 0, At, B0); PG8_MMA(1, 1, At, B1); PG8_BAR; PG8_SCHED;
            PG8_LDB(B0, 1, 0); PG8_LDB(B1, 1, 1); PG8_SCHED; PG8_LDA(At, 1, 0); PG8_STAGE(PG8_SA(0, 1), a2 + hstep, voffA);
            PG8_WAIT_V(8); PG8_WAIT_L(0); PG8_BAR; PG8_MMA(0, 0, At, B0); PG8_MMA(0, 1, At, B1); PG8_BAR; PG8_SCHED;
            PG8_LDA(At, 1, 1); PG8_STAGE(PG8_SB(1, 0), b3, voffB); PG8_STAGE(PG8_SB(1, 1), b3 + hstep, voffB); PG8_STAGE(PG8_SA(1, 0), a3, voffA);
            PG8_WAIT_V(8); PG8_WAIT_L(0); PG8_BAR; PG8_MMA(1, 0, At, B0); PG8_MMA(1, 1, At, B1); PG8_BAR; PG8_SCHED;
            } else {
            PG8_LDB(B0, 0, 0); PG8_SCHED; PG8_LDA(At, 0, 0); PG8_STAGE(PG8_SA(1, 1), a1 + hstep, voffA);
            PG8_WAIT_L(8); PG8_BAR; PG8_WAIT_L(0); PG8_MMA(0, 0, At, B0); PG8_BAR; PG8_SCHED;
            PG8_LDB(B1, 0, 1); PG8_STAGE(PG8_SB(0, 0), b2, voffB);
            PG8_BAR; PG8_WAIT_L(0); PG8_MMA(0, 1, At, B1); PG8_BAR;
            PG8_LDA(At, 0, 1); PG8_STAGE(PG8_SA(0, 0), a2, voffA);
            PG8_BAR; PG8_WAIT_L(0); PG8_MMA(1, 0, At, B0); PG8_BAR; PG8_SCHED;
            PG8_STAGE(PG8_SB(0, 1), b2 + hstep, voffB);
            PG8_WAIT_V(6); PG8_BAR; PG8_MMA(1, 1, At, B1); PG8_BAR;
            PG8_LDB(B0, 1, 0); PG8_SCHED; PG8_LDA(At, 1, 0); PG8_STAGE(PG8_SA(0, 1), a2 + hstep, voffA);
            PG8_WAIT_L(8); PG8_BAR; PG8_WAIT_L(0); PG8_MMA(0, 0, At, B0); PG8_BAR; PG8_SCHED;
            PG8_LDB(B1, 1, 1); PG8_STAGE(PG8_SB(1, 0), b3, voffB);
            PG8_BAR; PG8_WAIT_L(0); PG8_MMA(0, 1, At, B1); PG8_BAR;
            PG8_LDA(At, 1, 1); PG8_STAGE(PG8_SA(1, 0), a3, voffA);
            PG8_BAR; PG8_WAIT_L(0); PG8_MMA(1, 0, At, B0); PG8_BAR; PG8_SCHED;
            PG8_STAGE(PG8_SB(1, 1), b3 + hstep, voffB);
            PG8_WAIT_V(6); PG8_BAR; PG8_MMA(1, 1, At, B1); PG8_BAR;
            }
        }
        if constexpr (ALIGN_EPI) { if (wr == 0) PG8_BAR; }
        if constexpr (!Epi::AFTER_DRAIN) { E(acc, cur, wr, wc, fr, fq); S.done(cur); }
        if (!has_next) break;
#pragma unroll
        for (int a = 0; a < 2; ++a)
#pragma unroll
            for (int b = 0; b < 2; ++b)
#pragma unroll
                for (int m = 0; m < 4; ++m)
#pragma unroll
                    for (int n = 0; n < 2; ++n) acc[a][b][m][n] = (f32x4){0.f, 0.f, 0.f, 0.f};
        cur = nxt; cA = nA; cB = nB; ++ui;
        if constexpr (ALIGN_EPI) { if (wr == 1) PG8_BAR; }
    }
    PG8_WAIT_V(0);
    if constexpr (!ALIGN_EPI) { if (wr == 0) PG8_BAR; }
    PG8_BAR;
    if constexpr (Epi::AFTER_DRAIN) { E.fused(acc, cur, wr, wc, fr, fq, lds, wid, lane); S.done(cur); }
#undef PG8_SA
#undef PG8_SB
#undef PG8_STAGE
#undef PG8_LDA
#undef PG8_LDB
#undef PG8_MMA
#undef PG8_WAIT_V
#undef PG8_WAIT_L
#undef PG8_BAR
#undef PG8_SCHED
}
}

constexpr int BATCH = 8, SEQ = 4096, DM = 1024, MTOK = BATCH * SEQ;
constexpr int NMEM = 256, MMEM = BATCH * NMEM;
constexpr int AW = 512, HD = 64, NH = 8, IH = 4, TOPK = 256;
constexpr int INC = 1988, INP = 2048;
constexpr int DFF = 2816;
constexpr float EPS = 1e-6f;
#define LAS __attribute__((address_space(3)))
typedef unsigned short bf16_t;
typedef float f32x4 __attribute__((ext_vector_type(4)));
typedef unsigned u32x4 __attribute__((ext_vector_type(4)));
typedef unsigned u32x2 __attribute__((ext_vector_type(2)));

__device__ __forceinline__ float bf2f(bf16_t v) { return __uint_as_float((unsigned)v << 16); }
__device__ __forceinline__ bf16_t f2bf(float f) { unsigned u = __float_as_uint(f); return (bf16_t)((u + 0x7fffu + ((u >> 16) & 1u)) >> 16); }
__device__ __forceinline__ float wave_sum(float v) {
#pragma unroll
    for (int o = 1; o < 64; o <<= 1) v += __shfl_xor(v, o);
    return v;
}
__device__ __forceinline__ float wave_max(float v) {
#pragma unroll
    for (int o = 1; o < 64; o <<= 1) v = fmaxf(v, __shfl_xor(v, o));
    return v;
}
__device__ __forceinline__ float silu_f(float v) { return v / (1.f + __expf(-v)); }

struct EpiStore {
    static constexpr bool PERM = false, AFTER_DRAIN = false;
    float* outf; bf16_t* outb; const float* res; int ldc;
    __device__ __forceinline__ void operator()(const pg8::f32x4 (&acc)[2][2][4][2], const pg8::Unit& u, int wr, int wc, int fr, int fq) const {
        const int col0 = u.pn * 256 + wc * 32 + 4 * fq;
#pragma unroll
        for (int ai = 0; ai < 2; ++ai)
#pragma unroll
            for (int m = 0; m < 4; ++m) {
                const size_t row = (size_t)(u.pm * 256 + ai * 128 + wr * 64 + m * 16 + fr);
#pragma unroll
                for (int bj = 0; bj < 2; ++bj)
#pragma unroll
                    for (int n = 0; n < 2; ++n) {
                        const size_t off = row * ldc + col0 + bj * 128 + n * 16;
                        pg8::f32x4 v = acc[ai][bj][m][n];
                        if (res) { const pg8::f32x4 r = *(const pg8::f32x4*)(res + off); v = v + r; }
                        if (outf) *(pg8::f32x4*)(outf + off) = v;
                        if (outb) { u32x2 w; w.x = (unsigned)f2bf(v[0]) | ((unsigned)f2bf(v[1]) << 16); w.y = (unsigned)f2bf(v[2]) | ((unsigned)f2bf(v[3]) << 16); *(u32x2*)(outb + off) = w; }
                    }
            }
    }
};
#define XB_TMO      128
#define XB_XCNT(j)  (256  + 64 * (j))
#define XB_XSUB(j)  (1280 + 64 * (j))
#define XB_XGEN(j)  (2304 + 64 * (j))
#define XB_TOP      3328
#define XB_TOPGEN   3392
#define XCD_BAR_WORDS 3456
#define XB_SPIN_CAP (1u << 18)

__device__ __forceinline__ unsigned xb_ld(unsigned* p)              { return __hip_atomic_load(p, __ATOMIC_RELAXED, __HIP_MEMORY_SCOPE_AGENT); }
__device__ __forceinline__ unsigned xb_add(unsigned* p, unsigned v) { return __hip_atomic_fetch_add(p, v, __ATOMIC_RELAXED, __HIP_MEMORY_SCOPE_AGENT); }
__device__ __forceinline__ unsigned xb_xcc_id() { return (unsigned)__builtin_amdgcn_s_getreg((3 << 11) | 20) & 0xFu; }
#define XB_SPIN(cond, bar) do { unsigned _sp = 0; while (cond) { __builtin_amdgcn_s_sleep(1); \
    if ((++_sp & 255u) == 0u) { if (xb_ld(&(bar)[XB_TMO])) break; if (_sp > XB_SPIN_CAP) { atomicAdd(&(bar)[XB_TMO], 1u); break; } } } } while (0)

struct XcdBarrier {
    unsigned* bar; unsigned x;
    volatile LAS unsigned* st;
};

__device__ __forceinline__ XcdBarrier xcd_barrier_post(unsigned* bar, volatile LAS unsigned* st) {
    XcdBarrier b; b.bar = bar; b.x = xb_xcc_id(); b.st = st;
    if (threadIdx.x == 0) (void)xb_add(&bar[XB_XCNT(b.x)], 1u);
    return b;
}
__device__ __forceinline__ void xcd_barrier_complete(unsigned* bar, unsigned x, unsigned& nloc, unsigned& nx) {
    const unsigned G = gridDim.x * gridDim.y * gridDim.z;
    unsigned sum, cnt, mine, sp = 0u;
    for (;;) {
        sum = 0u; cnt = 0u; mine = 0u;
#pragma unroll
        for (unsigned j = 0; j < 16; ++j) { const unsigned c = xb_ld(&bar[XB_XCNT(j)]); sum += c; cnt += (c > 0u) ? 1u : 0u; mine = (j == x) ? c : mine; }
        if (sum == G) break;
        __builtin_amdgcn_s_sleep(1);
        if ((++sp & 255u) == 0u) { if (xb_ld(&bar[XB_TMO])) break; if (sp > XB_SPIN_CAP) { atomicAdd(&bar[XB_TMO], 1u); break; } }
    }
    nloc = mine > 0u ? mine : 1u; nx = cnt > 0u ? cnt : 1u;
}

__device__ __forceinline__ void xcd_barrier(const XcdBarrier& b) {
    asm volatile("s_waitcnt vmcnt(0)" ::: "memory");
    __syncthreads();
    if (threadIdx.x == 0) {
        unsigned* bar = b.bar;
        __builtin_amdgcn_s_waitcnt(0);
        unsigned nloc = b.st[0], nx = b.st[1];
        if (nloc == 0u) { xcd_barrier_complete(bar, b.x, nloc, nx); b.st[0] = nloc; b.st[1] = nx; }
        const unsigned old = xb_add(&bar[XB_XSUB(b.x)], 1u);
        const unsigned gen = old / nloc;
        if (old + 1u == (gen + 1u) * nloc) {
            __builtin_amdgcn_fence(__ATOMIC_RELEASE, "agent");
            asm volatile("s_waitcnt vmcnt(0)" ::: "memory");
            const unsigned og = xb_add(&bar[XB_TOP], 1u);
            const unsigned tg = og / nx;
            if (og + 1u == (tg + 1u) * nx) xb_add(&bar[XB_TOPGEN], 1u);
            else XB_SPIN(xb_ld(&bar[XB_TOPGEN]) == tg, bar);
            __builtin_amdgcn_fence(__ATOMIC_ACQUIRE, "agent");
            xb_add(&bar[XB_XGEN(b.x)], 1u);
            asm volatile("s_waitcnt vmcnt(0)" ::: "memory");
        } else {
            XB_SPIN(xb_ld(&bar[XB_XGEN(b.x)]) == gen, bar);
            __builtin_amdgcn_fence(__ATOMIC_ACQUIRE, "agent");
            asm volatile("s_waitcnt vmcnt(0)" ::: "memory");
        }
    }
    __syncthreads();
}
typedef short bf16x8v __attribute__((ext_vector_type(8)));
constexpr int CA_STRIDE = 528;
__device__ __forceinline__ void cross_attn_unit(LAS unsigned char* lds, int b, int h, int qb, const bf16_t* QC, const bf16_t* KC, const bf16_t* VT, bf16_t* OC, int tid, int lane, int wave) {
    const int q16 = lane & 15, g = lane >> 4;
    const size_t row0 = (size_t)b * SEQ + (size_t)qb * 256 + wave * 32;
    asm volatile("" : "+v"(tid));
    { const bf16_t* src = KC + ((size_t)b * NMEM + (tid >> 5)) * DM + h * 256 + (tid & 31) * 8; LAS unsigned char* dst = lds + (tid >> 5) * CA_STRIDE + (tid & 31) * 16;
#pragma unroll
      for (int i = 0; i < 16; ++i) { const u32x4 v = *(const u32x4*)(src + (size_t)i * 16 * DM); *(LAS u32x4*)(dst + i * 16 * CA_STRIDE) = v; } }
    __syncthreads();
    f32x4 S[2][16];
#pragma unroll
    for (int st = 0; st < 2; ++st)
#pragma unroll
        for (int kt = 0; kt < 16; ++kt) S[st][kt] = (f32x4){0.f, 0.f, 0.f, 0.f};
#pragma unroll 1
    for (int kh = 0; kh < 2; ++kh) {
        bf16x8v qf[2][4];
#pragma unroll
        for (int st = 0; st < 2; ++st)
#pragma unroll
            for (int ks = 0; ks < 4; ++ks) qf[st][ks] = *(const bf16x8v*)(QC + (row0 + st * 16 + q16) * DM + h * 256 + kh * 128 + ks * 32 + g * 8);
        const LAS unsigned char* kb = lds + q16 * CA_STRIDE + kh * 256 + g * 16;
#pragma unroll
        for (int kt = 0; kt < 16; ++kt)
#pragma unroll
            for (int ks = 0; ks < 4; ++ks) { const bf16x8v a = *(const LAS bf16x8v*)(kb + kt * 16 * CA_STRIDE + ks * 64);
                S[0][kt] = __builtin_amdgcn_mfma_f32_16x16x32_bf16(a, qf[0][ks], S[0][kt], 0, 0, 0);
                S[1][kt] = __builtin_amdgcn_mfma_f32_16x16x32_bf16(a, qf[1][ks], S[1][kt], 0, 0, 0); }
    }
    const float c2 = 0.0625f * 1.4426950408889634f;
    float linv[2]; bf16x8v P[2][8];
#pragma unroll
    for (int st = 0; st < 2; ++st) {
        float m = -INFINITY;
#pragma unroll
        for (int kt = 0; kt < 16; ++kt) m = fmaxf(fmaxf(fmaxf(S[st][kt][0], S[st][kt][1]), fmaxf(S[st][kt][2], S[st][kt][3])), m);
        m = fmaxf(m, __shfl_xor(m, 16)); m = fmaxf(m, __shfl_xor(m, 32));
        const float mc = m * c2; float l = 0.f;
#pragma unroll
        for (int kt = 0; kt < 16; ++kt)
#pragma unroll
            for (int r = 0; r < 4; ++r) { const float p = __builtin_amdgcn_exp2f(S[st][kt][r] * c2 - mc); S[st][kt][r] = p; l += p; }
        l += __shfl_xor(l, 16); l += __shfl_xor(l, 32); linv[st] = 1.f / l;
#pragma unroll
        for (int c = 0; c < 8; ++c) { bf16x8v pk;
#pragma unroll
            for (int j = 0; j < 4; ++j) { pk[j] = (short)f2bf(S[st][2 * c][j]); pk[4 + j] = (short)f2bf(S[st][2 * c + 1][j]); }
            P[st][c] = pk; }
    }
    __syncthreads();
    { int tid2 = tid; asm volatile("" : "+v"(tid2));
      const bf16_t* src = VT + (size_t)(h * 256 + (tid2 >> 5)) * MMEM + b * NMEM + (tid2 & 31) * 8; LAS unsigned char* dst = lds + (tid2 >> 5) * CA_STRIDE + (tid2 & 31) * 16;
#pragma unroll
      for (int i = 0; i < 16; ++i) { const u32x4 v = *(const u32x4*)(src + (size_t)i * 16 * MMEM); *(LAS u32x4*)(dst + i * 16 * CA_STRIDE) = v; } }
    __syncthreads();
#pragma unroll 1
    for (int dh = 0; dh < 2; ++dh) {
        f32x4 O[2][8];
#pragma unroll
        for (int st = 0; st < 2; ++st)
#pragma unroll
            for (int dt = 0; dt < 8; ++dt) O[st][dt] = (f32x4){0.f, 0.f, 0.f, 0.f};
        const LAS unsigned char* pb = lds + (dh * 128 + q16) * CA_STRIDE + g * 8;
#pragma unroll
        for (int dt = 0; dt < 8; ++dt)
#pragma unroll
            for (int c = 0; c < 8; ++c) { const LAS unsigned char* p = pb + dt * 16 * CA_STRIDE + c * 64;
                const u32x2 lo = *(const LAS u32x2*)p, hi = *(const LAS u32x2*)(p + 32);
                const u32x4 av = (u32x4){lo.x, lo.y, hi.x, hi.y}; const bf16x8v a = __builtin_bit_cast(bf16x8v, av);
                O[0][dt] = __builtin_amdgcn_mfma_f32_16x16x32_bf16(a, P[0][c], O[0][dt], 0, 0, 0);
                O[1][dt] = __builtin_amdgcn_mfma_f32_16x16x32_bf16(a, P[1][c], O[1][dt], 0, 0, 0); }
#pragma unroll
        for (int st = 0; st < 2; ++st)
#pragma unroll
            for (int dt = 0; dt < 8; ++dt) { const f32x4 o = O[st][dt] * linv[st]; u32x2 w;
                w.x = (unsigned)f2bf(o[0]) | ((unsigned)f2bf(o[1]) << 16); w.y = (unsigned)f2bf(o[2]) | ((unsigned)f2bf(o[3]) << 16);
                *(u32x2*)(OC + (row0 + st * 16 + q16) * DM + h * 256 + dh * 128 + dt * 16 + g * 4) = w; }
    }
    __syncthreads();
}
typedef float f32x16v __attribute__((ext_vector_type(16)));
__device__ __forceinline__ unsigned code16(float s) {
    const _Float16 hf = (_Float16)s; unsigned u = (unsigned)__builtin_bit_cast(unsigned short, hf);
    if ((u & 0x7fffu) == 0u) u = 0u;
    return (u & 0x8000u) ? (~u & 0xffffu) : (u | 0x8000u);
}
__device__ __forceinline__ unsigned mbcnt64(unsigned long long m) { return __builtin_amdgcn_mbcnt_hi((unsigned)(m >> 32), __builtin_amdgcn_mbcnt_lo((unsigned)m, 0u)); }
__device__ __forceinline__ void topk_unit(LAS unsigned char* lds, int b, int j, const bf16_t* QI, const bf16_t* KI, const float* WI, unsigned short* SEL, int tid, int lane, int wave) {
    asm volatile("" : "+v"(tid), "+v"(lane));
    const int t0 = 16 * j, L = t0 + 16, nkt = (L + 31) >> 5;
    const size_t rowbase = (size_t)b * SEQ + t0;
    const int c32 = lane & 31, hi = lane >> 5;
    {
        bf16x8v qa[2][4]; f32x4 wq[2][4];
#pragma unroll
        for (int rt = 0; rt < 2; ++rt) {
#pragma unroll
            for (int ks = 0; ks < 4; ++ks) qa[rt][ks] = *(const bf16x8v*)(QI + (rowbase + 8 * rt + (c32 >> 2)) * 256 + (c32 & 3) * 64 + 16 * ks + 8 * hi);
#pragma unroll
            for (int gq = 0; gq < 4; ++gq) wq[rt][gq] = *(const f32x4*)(WI + (rowbase + 8 * rt + 2 * gq + hi) * 4);
        }
        const bf16_t* kbase = KI + ((size_t)b * SEQ + c32) * 64 + 8 * hi;
        bf16x8v kb[4], kn[4];
        int kt = wave;
        if (kt < nkt) {
#pragma unroll
            for (int ks = 0; ks < 4; ++ks) kb[ks] = *(const bf16x8v*)(kbase + (size_t)kt * 32 * 64 + 16 * ks);
        }
        for (; kt < nkt; kt += 8) {
            const int ktn = (kt + 8 < nkt) ? kt + 8 : kt;
#pragma unroll
            for (int ks = 0; ks < 4; ++ks) kn[ks] = *(const bf16x8v*)(kbase + (size_t)ktn * 32 * 64 + 16 * ks);
#pragma unroll
            for (int rt = 0; rt < 2; ++rt) {
                f32x16v c = {0.f, 0.f, 0.f, 0.f, 0.f, 0.f, 0.f, 0.f, 0.f, 0.f, 0.f, 0.f, 0.f, 0.f, 0.f, 0.f};
#pragma unroll
                for (int ks = 0; ks < 4; ++ks) c = __builtin_amdgcn_mfma_f32_32x32x16_bf16(qa[rt][ks], kb[ks], c, 0, 0, 0);
#pragma unroll
                for (int gq = 0; gq < 4; ++gq) {
                    const f32x4 w = wq[rt][gq];
                    const float sc = w[0] * fmaxf(c[4 * gq + 0], 0.f) + w[1] * fmaxf(c[4 * gq + 1], 0.f) + w[2] * fmaxf(c[4 * gq + 2], 0.f) + w[3] * fmaxf(c[4 * gq + 3], 0.f);
                    const int q = 8 * rt + 2 * gq + hi;
                    *(LAS unsigned short*)(lds + q * 8192 + (kt * 32 + c32) * 2) = (unsigned short)code16(sc);
                }
            }
#pragma unroll
            for (int ks = 0; ks < 4; ++ks) kb[ks] = kn[ks];
        }
    }
    __syncthreads();
#pragma unroll 1
    for (int qq = 0; qq < 2; ++qq) {
        const int q = 2 * wave + qq, t = t0 + q, n = t + 1;
        unsigned short* sel = SEL + (rowbase + q) * TOPK;
        if (n <= TOPK) {
#pragma unroll
            for (int i = 0; i < 4; ++i) { const int s = lane + 64 * i; if (s < n) sel[s] = (unsigned short)s; }
            continue;
        }
        const int nch = (n + 127) >> 7;
        unsigned lo[32], hi16[32];
        const LAS unsigned* row = (const LAS unsigned*)(lds + q * 8192) + lane;
#pragma unroll
        for (int c = 0; c < 32; ++c) {
            unsigned v = 0u; if (c < nch) v = row[64 * c];
            const int i0 = 128 * c + 2 * lane;
            lo[c] = (i0 <= t) ? (v & 0xffffu) : 0u; hi16[c] = (i0 + 1 <= t) ? (v >> 16) : 0u;
        }
        unsigned T = 0u;
#pragma unroll 1
        for (int bit = 15; bit >= 0; --bit) {
            const unsigned cand = T | (1u << bit); unsigned cnt = 0u;
#pragma unroll
            for (int c = 0; c < 32; ++c) if (c < nch) { cnt += (unsigned)__popcll(__ballot(lo[c] >= cand)); cnt += (unsigned)__popcll(__ballot(hi16[c] >= cand)); }
            if (cnt >= (unsigned)TOPK) T = cand;
        }
        unsigned cgt = 0u;
#pragma unroll
        for (int c = 0; c < 32; ++c) if (c < nch) { cgt += (unsigned)__popcll(__ballot(lo[c] > T)); cgt += (unsigned)__popcll(__ballot(hi16[c] > T)); }
        const unsigned need = (unsigned)TOPK - cgt;
        unsigned eqrun = 0u, selrun = 0u;
#pragma unroll
        for (int c = 0; c < 32; ++c) if (c < nch) {
            const bool elo = lo[c] == T, ehi = hi16[c] == T;
            const unsigned long long melo = __ballot(elo), mehi = __ballot(ehi);
            const unsigned rank_lo = eqrun + mbcnt64(melo) + mbcnt64(mehi), rank_hi = rank_lo + (elo ? 1u : 0u);
            const bool tlo = (lo[c] > T) || (elo && rank_lo < need), thi = (hi16[c] > T) || (ehi && rank_hi < need);
            const unsigned long long mtlo = __ballot(tlo), mthi = __ballot(thi);
            const unsigned pos_lo = selrun + mbcnt64(mtlo) + mbcnt64(mthi), pos_hi = pos_lo + (tlo ? 1u : 0u);
            if (tlo && pos_lo < (unsigned)TOPK) sel[pos_lo] = (unsigned short)(128 * c + 2 * lane);
            if (thi && pos_hi < (unsigned)TOPK) sel[pos_hi] = (unsigned short)(128 * c + 2 * lane + 1);
            eqrun += (unsigned)__popcll(melo) + (unsigned)__popcll(mehi); selrun += (unsigned)__popcll(mtlo) + (unsigned)__popcll(mthi);
        }
    }
    __syncthreads();
}
__device__ __forceinline__ void topk_phase(LAS unsigned char* lds, int G, int vcu, const bf16_t* QI, const bf16_t* KI, const float* WI, unsigned short* SEL, int tid, int lane, int wave) {
    if (G == 256) {
        const int b = vcu >> 5, i = vcu & 31;
#pragma unroll 1
        for (int k = 0; k < 8; ++k) { const int j = 64 * (k >> 1) + ((k & 1) ? 63 - i : i); topk_unit(lds, b, j, QI, KI, WI, SEL, tid, lane, wave); }
    } else {
#pragma unroll 1
        for (int u = vcu; u < BATCH * 256; u += G) topk_unit(lds, u >> 8, u & 255, QI, KI, WI, SEL, tid, lane, wave);
    }
}
typedef short v4i16_t __attribute__((ext_vector_type(4)));
constexpr int SV_STRIDE = 160, SV_WAVE_BYTES = 64 * SV_STRIDE;
__device__ __forceinline__ v4i16_t tr_read16(const LAS unsigned char* p) { return __builtin_amdgcn_ds_read_tr16_b64_v4i16((LAS v4i16_t*)p); }
__device__ __forceinline__ void sparse_attn_query(LAS unsigned char* wl, size_t row, int b, int t, const bf16_t* Q, const bf16_t* Kb, const bf16_t* Vb, const unsigned short* SEL, bf16_t* MIX, int lane) {
    const int n = (t + 1 < TOPK) ? t + 1 : TOPK, q16 = lane & 15, g = lane >> 4;
    const unsigned short* sel = SEL + row * TOPK;
    bf16x8v qf[2];
#pragma unroll
    for (int ks = 0; ks < 2; ++ks) { u32x4 v = (u32x4){0u, 0u, 0u, 0u}; if (q16 < 8) v = *(const u32x4*)(Q + row * 512 + q16 * 64 + ks * 32 + g * 8); qf[ks] = __builtin_bit_cast(bf16x8v, v); }
    f32x4 S[16];
    const bf16_t* kbat = Kb + (size_t)b * SEQ * 64 + g * 8;
#pragma unroll
    for (int kg = 0; kg < 4; ++kg) {
        bf16x8v kf[4][2];
#pragma unroll
        for (int i = 0; i < 4; ++i) { const int slot = 64 * kg + 16 * i + q16; unsigned idx = 0u; if (slot < n) idx = sel[slot];
#pragma unroll
            for (int ks = 0; ks < 2; ++ks) kf[i][ks] = *(const bf16x8v*)(kbat + (size_t)idx * 64 + ks * 32); }
#pragma unroll
        for (int i = 0; i < 4; ++i) { f32x4 c = (f32x4){0.f, 0.f, 0.f, 0.f};
            c = __builtin_amdgcn_mfma_f32_16x16x32_bf16(kf[i][0], qf[0], c, 0, 0, 0);
            c = __builtin_amdgcn_mfma_f32_16x16x32_bf16(kf[i][1], qf[1], c, 0, 0, 0); S[4 * kg + i] = c; }
    }
    const float c2 = 0.125f * 1.4426950408889634f;
    float m = -INFINITY;
#pragma unroll
    for (int kt = 0; kt < 16; ++kt)
#pragma unroll
        for (int r = 0; r < 4; ++r) { if (16 * kt + 4 * g + r >= n) S[kt][r] = -INFINITY; m = fmaxf(m, S[kt][r]); }
    m = fmaxf(m, __shfl_xor(m, 16)); m = fmaxf(m, __shfl_xor(m, 32));
    const float mc = m * c2; float l = 0.f;
#pragma unroll
    for (int kt = 0; kt < 16; ++kt)
#pragma unroll
        for (int r = 0; r < 4; ++r) { const float p = __builtin_amdgcn_exp2f(S[kt][r] * c2 - mc); S[kt][r] = p; l += p; }
    l += __shfl_xor(l, 16); l += __shfl_xor(l, 32);
    const float linv = 1.f / l;
    bf16x8v P[8];
#pragma unroll
    for (int c = 0; c < 8; ++c) { bf16x8v pk;
#pragma unroll
        for (int j = 0; j < 4; ++j) { pk[j] = (short)f2bf(S[2 * c][j]); pk[4 + j] = (short)f2bf(S[2 * c + 1][j]); }
        P[c] = pk; }
    f32x4 O[4];
#pragma unroll
    for (int dt = 0; dt < 4; ++dt) O[dt] = (f32x4){0.f, 0.f, 0.f, 0.f};
    const bf16_t* vbat = Vb + (size_t)b * SEQ * 64 + (lane & 7) * 8;
    LAS unsigned char* wdst = wl + (lane >> 3) * SV_STRIDE + (lane & 7) * 16;
    const LAS unsigned char* rsrc = wl + (4 * g + (q16 >> 2)) * SV_STRIDE + (q16 & 3) * 8;
#pragma unroll
    for (int cc = 0; cc < 4; ++cc) {
        u32x4 vv[8];
#pragma unroll
        for (int i = 0; i < 8; ++i) { const int slot = 64 * cc + (lane >> 3) + 8 * i; unsigned idx = 0u; if (slot < n) idx = sel[slot]; vv[i] = *(const u32x4*)(vbat + (size_t)idx * 64); }
#pragma unroll
        for (int i = 0; i < 8; ++i) *(LAS u32x4*)(wdst + i * 8 * SV_STRIDE) = vv[i];
        asm volatile("s_waitcnt lgkmcnt(0)" ::: "memory");
#pragma unroll
        for (int c2i = 0; c2i < 2; ++c2i)
#pragma unroll
            for (int dt = 0; dt < 4; ++dt) { const LAS unsigned char* p = rsrc + c2i * 32 * SV_STRIDE + dt * 32;
                const v4i16_t lo = tr_read16(p), hi = tr_read16(p + 16 * SV_STRIDE);
                const bf16x8v a = (bf16x8v){lo[0], lo[1], lo[2], lo[3], hi[0], hi[1], hi[2], hi[3]};
                O[dt] = __builtin_amdgcn_mfma_f32_16x16x32_bf16(a, P[2 * cc + c2i], O[dt], 0, 0, 0); }
        asm volatile("s_waitcnt lgkmcnt(0)" ::: "memory");
    }
    if (q16 < 8) {
#pragma unroll
        for (int dt = 0; dt < 4; ++dt) { const f32x4 o = O[dt] * linv; u32x2 w;
            w.x = (unsigned)f2bf(o[0]) | ((unsigned)f2bf(o[1]) << 16); w.y = (unsigned)f2bf(o[2]) | ((unsigned)f2bf(o[3]) << 16);
            *(u32x2*)(MIX + row * DM + q16 * 64 + dt * 16 + g * 4) = w; }
    }
}
__device__ __forceinline__ void sparse_attn_phase(LAS unsigned char* lds, int G, int vcu, const bf16_t* Q, const bf16_t* Kb, const bf16_t* Vb, const unsigned short* SEL, bf16_t* MIX, int lane, int wave) {
    asm volatile("" : "+v"(lane));
    LAS unsigned char* wl = lds + wave * SV_WAVE_BYTES;
    if (G == 256) {
        const int b = vcu >> 5, ws = (vcu & 31) * 8 + wave;
#pragma unroll 1
        for (int k = 0; k < 16; ++k) { const int t = ws + 256 * k; sparse_attn_query(wl, (size_t)b * SEQ + t, b, t, Q, Kb, Vb, SEL, MIX, lane); }
    } else {
#pragma unroll 1
        for (int r = vcu * 8 + wave; r < MTOK; r += G * 8) sparse_attn_query(wl, (size_t)r, r / SEQ, r % SEQ, Q, Kb, Vb, SEL, MIX, lane);
    }
    __syncthreads();
}

__device__ __forceinline__ void wt_body(LAS unsigned char* sm, int vb, int tid, const float* __restrict__ W, int K, int N, bf16_t* WT) {
    LAS float* t = (LAS float*)sm;
    const int nbx = (N + 31) / 32; const int k0 = (vb / nbx) * 32, n0 = (vb % nbx) * 32, tx = tid & 31, ty = tid >> 5;
    for (int i = ty; i < 32; i += 8) { const int k = k0 + i, n = n0 + tx; t[i * 33 + tx] = (k < K && n < N) ? W[(size_t)k * N + n] : 0.f; }
    __syncthreads();
    for (int i = ty; i < 32; i += 8) { const int n = n0 + i, k = k0 + tx; if (n < N && k < K) WT[(size_t)n * K + k] = f2bf(t[tx * 33 + i]); }
    __syncthreads();
}
__device__ __forceinline__ void rmsnorm_bf16_row(const float* x, const float* __restrict__ g, bf16_t* out, int row, int lane) {
    const f32x4* xr = (const f32x4*)(x + (size_t)row * DM) + lane; const f32x4* gr = (const f32x4*)g + lane;
    f32x4 v[4]; float s = 0.f;
#pragma unroll
    for (int j = 0; j < 4; ++j) { v[j] = xr[64 * j]; s += (v[j].x * v[j].x + v[j].y * v[j].y) + (v[j].z * v[j].z + v[j].w * v[j].w); }
    const float rstd = 1.f / sqrtf(wave_sum(s) * (1.f / DM) + EPS);
    u32x2* o = (u32x2*)(out + (size_t)row * DM) + lane;
#pragma unroll
    for (int j = 0; j < 4; ++j) { const f32x4 gg = gr[64 * j]; u32x2 w;
        w.x = (unsigned)f2bf(v[j].x * rstd * gg.x) | ((unsigned)f2bf(v[j].y * rstd * gg.y) << 16);
        w.y = (unsigned)f2bf(v[j].z * rstd * gg.z) | ((unsigned)f2bf(v[j].w * rstd * gg.w) << 16); o[64 * j] = w; }
}
__device__ __forceinline__ void rmsnorm_f32_row(float* x, const float* __restrict__ g, int row, int lane) {
    f32x4* xr = (f32x4*)(x + (size_t)row * DM) + lane; const f32x4* gr = (const f32x4*)g + lane;
    f32x4 v[4]; float s = 0.f;
#pragma unroll
    for (int j = 0; j < 4; ++j) { v[j] = xr[64 * j]; s += (v[j].x * v[j].x + v[j].y * v[j].y) + (v[j].z * v[j].z + v[j].w * v[j].w); }
    const float rstd = 1.f / sqrtf(wave_sum(s) * (1.f / DM) + EPS);
#pragma unroll
    for (int j = 0; j < 4; ++j) { const f32x4 gg = gr[64 * j]; xr[64 * j] = v[j] * rstd * gg; }
}
__device__ __forceinline__ float rope_val(const LAS float* p, int base, int d, const LAS float* cs, const LAS float* sn) {
    if (d < 8) return p[base + d] * cs[d] - p[base + d + 8] * sn[d];
    if (d < 16) return p[base + d] * cs[d - 8] + p[base + d - 8] * sn[d - 8];
    return p[base + d];
}
__device__ __forceinline__ void split_rope_body(LAS unsigned char* sm, int row, int tid, const float* proj, const int* __restrict__ positions, bf16_t* Q, bf16_t* Kb, bf16_t* Vb, bf16_t* QI, bf16_t* KI, float* WI, bf16_t* U) {
    LAS float* p = (LAS float*)sm; LAS float* cs = p + INP; LAS float* sn = cs + 8;
    for (int c = tid; c < INP; c += 256) p[c] = proj[(size_t)row * INP + c];
    if (tid < 8) { const float freq = (float)pow(500000.0, -0.125 * (double)tid); const float ang = (float)positions[row] * freq; cs[tid] = (float)cos((double)ang); sn[tid] = (float)sin((double)ang); }
    __syncthreads();
    for (int c = tid; c < 512; c += 256) Q[(size_t)row * 512 + c] = f2bf(rope_val(p, (c >> 6) * 64, c & 63, cs, sn));
    if (tid < 64) Kb[(size_t)row * 64 + tid] = f2bf(rope_val(p, 512, tid, cs, sn));
    else if (tid < 128) Vb[(size_t)row * 64 + tid - 64] = f2bf(p[576 + tid - 64]);
    else if (tid < 192) KI[(size_t)row * 64 + tid - 128] = f2bf(rope_val(p, 896, tid - 128, cs, sn));
    else if (tid < 196) WI[(size_t)row * 4 + tid - 192] = p[960 + tid - 192] * 0.5f;
    QI[(size_t)row * 256 + tid] = f2bf(rope_val(p, 640 + (tid >> 6) * 64, tid & 63, cs, sn) * 0.125f);
    for (int c = tid; c < 512; c += 256) { const float ga = p[964 + c], gg = p[1476 + c]; U[(size_t)row * 512 + c] = f2bf(ga / (1.f + __expf(-gg))); }
    __syncthreads();
}
__device__ __forceinline__ unsigned fkey(float s) { unsigned u = __float_as_uint(s); if ((u << 1) == 0u) u = 0u; return (u & 0x80000000u) ? ~u : (u | 0x80000000u); }
__device__ __forceinline__ void topk_body(LAS unsigned char* sm, int row, int tid, const bf16_t* QI, const bf16_t* KI, const float* WI, unsigned short* SEL) {
    LAS float* qs = (LAS float*)sm; LAS unsigned* key = (LAS unsigned*)(sm + 1024); LAS unsigned* scan = (LAS unsigned*)(sm + 1024 + 16384); LAS unsigned* cntp = (LAS unsigned*)(sm + 1024 + 16384 + 1024);
    const int b = row / SEQ, t = row % SEQ, n = t + 1;
    unsigned short* sel = SEL + (size_t)row * TOPK;
    if (n <= TOPK) { if (tid < n) sel[tid] = (unsigned short)tid; return; }
    qs[tid] = bf2f(QI[(size_t)row * 256 + tid]);
    const float w0 = WI[(size_t)row * 4 + 0], w1 = WI[(size_t)row * 4 + 1], w2 = WI[(size_t)row * 4 + 2], w3 = WI[(size_t)row * 4 + 3];
    __syncthreads();
    for (int s = tid; s < n; s += 256) {
        const u32x4* kp = (const u32x4*)(KI + ((size_t)b * SEQ + s) * 64);
        float a0 = 0.f, a1 = 0.f, a2 = 0.f, a3 = 0.f;
#pragma unroll 2
        for (int c = 0; c < 8; ++c) { const u32x4 kv = kp[c];
#pragma unroll
            for (int e = 0; e < 4; ++e) { const float klo = __uint_as_float(kv[e] << 16), khi = __uint_as_float(kv[e] & 0xffff0000u); const int d = c * 8 + e * 2;
                a0 += qs[d] * klo + qs[d + 1] * khi; a1 += qs[64 + d] * klo + qs[64 + d + 1] * khi; a2 += qs[128 + d] * klo + qs[128 + d + 1] * khi; a3 += qs[192 + d] * klo + qs[192 + d + 1] * khi; } }
        const float sc = w0 * fmaxf(a0, 0.f) + w1 * fmaxf(a1, 0.f) + w2 * fmaxf(a2, 0.f) + w3 * fmaxf(a3, 0.f);
        key[s] = fkey(sc);
    }
    __syncthreads();
    unsigned prefix = 0u;
    for (int bit = 31; bit >= 0; --bit) {
        const unsigned cand = prefix | (1u << bit);
        if (tid == 0) *cntp = 0u;
        __syncthreads();
        unsigned c = 0u; for (int s = tid; s < n; s += 256) c += (key[s] >= cand) ? 1u : 0u;
        if (c) atomicAdd((unsigned*)cntp, c);
        __syncthreads();
        if (*cntp >= (unsigned)TOPK) prefix = cand;
        __syncthreads();
    }
    if (tid == 0) *cntp = 0u;
    __syncthreads();
    { unsigned c = 0u; for (int s = tid; s < n; s += 256) c += (key[s] > prefix) ? 1u : 0u; if (c) atomicAdd((unsigned*)cntp, c); }
    __syncthreads();
    const unsigned need = (unsigned)TOPK - *cntp;
    __syncthreads();
    const int s0 = tid * 16; unsigned eqc = 0u;
    for (int i = 0; i < 16; ++i) { const int s = s0 + i; if (s < n && key[s] == prefix) ++eqc; }
    scan[tid] = eqc; __syncthreads();
    for (int o = 1; o < 256; o <<= 1) { const unsigned v = (tid >= o) ? scan[tid - o] : 0u; __syncthreads(); scan[tid] += v; __syncthreads(); }
    unsigned eq_before = scan[tid] - eqc; __syncthreads();
    unsigned takec = 0u; unsigned takemask = 0u;
    for (int i = 0; i < 16; ++i) { const int s = s0 + i; if (s < n) { const unsigned k = key[s]; bool take = k > prefix; if (k == prefix) { take = eq_before < need; ++eq_before; } if (take) { ++takec; takemask |= 1u << i; } } }
    scan[tid] = takec; __syncthreads();
    for (int o = 1; o < 256; o <<= 1) { const unsigned v = (tid >= o) ? scan[tid - o] : 0u; __syncthreads(); scan[tid] += v; __syncthreads(); }
    unsigned pos = scan[tid] - takec;
    for (int i = 0; i < 16; ++i) if (takemask & (1u << i)) { if (pos < (unsigned)TOPK) sel[pos] = (unsigned short)(s0 + i); ++pos; }
    __syncthreads();
}
__device__ __forceinline__ void sparse_attn_body(LAS unsigned char* sm, int row, int tid, const bf16_t* Q, const bf16_t* Kb, const bf16_t* Vb, const unsigned short* SEL, bf16_t* MIX) {
    LAS float* qs = (LAS float*)sm; LAS float* lg = qs + 512;   LAS int* idx = (LAS int*)(lg + NH * TOPK);
    const int b = row / SEQ, t = row % SEQ, n = (t + 1 < TOPK) ? t + 1 : TOPK;
    qs[tid] = bf2f(Q[(size_t)row * 512 + tid]); qs[tid + 256] = bf2f(Q[(size_t)row * 512 + 256 + tid]);
    int myidx = 0; if (tid < n) myidx = (int)SEL[(size_t)row * TOPK + tid]; idx[tid] = myidx;
    __syncthreads();
    if (tid < n) {
        const u32x4* kp = (const u32x4*)(Kb + ((size_t)b * SEQ + myidx) * 64);
        float a[NH];
#pragma unroll
        for (int h = 0; h < NH; ++h) a[h] = 0.f;
#pragma unroll 2
        for (int c = 0; c < 8; ++c) { const u32x4 kv = kp[c];
#pragma unroll
            for (int e = 0; e < 4; ++e) { const float klo = __uint_as_float(kv[e] << 16), khi = __uint_as_float(kv[e] & 0xffff0000u); const int d = c * 8 + e * 2;
#pragma unroll
                for (int h = 0; h < NH; ++h) a[h] += qs[h * 64 + d] * klo + qs[h * 64 + d + 1] * khi; } }
#pragma unroll
        for (int h = 0; h < NH; ++h) lg[h * TOPK + tid] = a[h] * 0.125f;
    } else {
#pragma unroll
        for (int h = 0; h < NH; ++h) lg[h * TOPK + tid] = -INFINITY;
    }
    __syncthreads();
    { const int w = tid >> 6, lane = tid & 63;
      for (int hh = 0; hh < 2; ++hh) { const int h = 2 * w + hh; float v[4], m = -INFINITY;
          for (int i = 0; i < 4; ++i) { v[i] = lg[h * TOPK + lane + 64 * i]; m = fmaxf(m, v[i]); }
          m = wave_max(m); float s = 0.f;
          for (int i = 0; i < 4; ++i) { v[i] = __expf(v[i] - m); s += v[i]; }
          s = wave_sum(s); const float inv = 1.f / s;
          for (int i = 0; i < 4; ++i) lg[h * TOPK + lane + 64 * i] = v[i] * inv; } }
    __syncthreads();
    { const int h = tid >> 5, d0 = (tid & 31) * 2; float o0 = 0.f, o1 = 0.f;
      for (int j = 0; j < n; ++j) { const unsigned vv = *(const unsigned*)(Vb + ((size_t)b * SEQ + idx[j]) * 64 + d0); const float p = lg[h * TOPK + j]; o0 += p * __uint_as_float(vv << 16); o1 += p * __uint_as_float(vv & 0xffff0000u); }
      *(unsigned*)(MIX + (size_t)row * DM + h * 64 + d0) = (unsigned)f2bf(o0) | ((unsigned)f2bf(o1) << 16); }
    __syncthreads();
}
__device__ __forceinline__ void convb_body(LAS unsigned char* sm, int row, int tid, const bf16_t* U, const float* __restrict__ cw, const float* __restrict__ cb, const float* __restrict__ lg, const float* __restrict__ lb, bf16_t* MIX) {
    LAS float* red = (LAS float*)sm;
    const int t = row % SEQ;
    float y[2];
    for (int k = 0; k < 2; ++k) { const int c = tid + 256 * k; float acc = cb[c];
        for (int j = 0; j < 31; ++j) { const int tt = t - 30 + j; if (tt >= 0) acc += cw[j * 512 + c] * bf2f(U[(size_t)(row - 30 + j) * 512 + c]); }
        y[k] = acc; }
    float s = wave_sum(y[0] + y[1]); if ((tid & 63) == 0) red[tid >> 6] = s; __syncthreads();
    const float mu = (red[0] + red[1] + red[2] + red[3]) * (1.f / 512.f); __syncthreads();
    float q = wave_sum((y[0] - mu) * (y[0] - mu) + (y[1] - mu) * (y[1] - mu)); if ((tid & 63) == 0) red[4 + (tid >> 6)] = q; __syncthreads();
    const float rstd = 1.f / sqrtf((red[4] + red[5] + red[6] + red[7]) * (1.f / 512.f) + EPS);
    for (int k = 0; k < 2; ++k) { const int c = tid + 256 * k; const float v = (y[k] - mu) * rstd * lg[c] + lb[c]; MIX[(size_t)row * DM + 512 + c] = f2bf(silu_f(v)); }
    __syncthreads();
}
__device__ __forceinline__ void cross_attn_body(LAS unsigned char* sm, int row, int tid, const bf16_t* QC, const bf16_t* KC, const bf16_t* VC, bf16_t* OC) {
    LAS float* qs = (LAS float*)sm; LAS float* lg = qs + DM;
    const int b = row / SEQ;
    for (int c = tid; c < DM; c += 256) qs[c] = bf2f(QC[(size_t)row * DM + c]);
    __syncthreads();
    { const u32x4* kp = (const u32x4*)(KC + ((size_t)b * NMEM + tid) * DM);
      for (int h = 0; h < 4; ++h) { float a = 0.f;
#pragma unroll 4
          for (int c = 0; c < 32; ++c) { const u32x4 kv = kp[h * 32 + c];
#pragma unroll
              for (int e = 0; e < 4; ++e) { const int d = h * 256 + c * 8 + e * 2; a += qs[d] * __uint_as_float(kv[e] << 16) + qs[d + 1] * __uint_as_float(kv[e] & 0xffff0000u); } }
          lg[h * NMEM + tid] = a * 0.0625f; } }
    __syncthreads();
    { const int h = tid >> 6, lane = tid & 63; float v[4], m = -INFINITY;
      for (int i = 0; i < 4; ++i) { v[i] = lg[h * NMEM + lane + 64 * i]; m = fmaxf(m, v[i]); }
      m = wave_max(m); float s = 0.f;
      for (int i = 0; i < 4; ++i) { v[i] = __expf(v[i] - m); s += v[i]; }
      s = wave_sum(s); const float inv = 1.f / s;
      for (int i = 0; i < 4; ++i) lg[h * NMEM + lane + 64 * i] = v[i] * inv; }
    __syncthreads();
    { const int h = tid >> 6, d0 = h * 256 + (tid & 63) * 4; float o0 = 0.f, o1 = 0.f, o2 = 0.f, o3 = 0.f;
      for (int j = 0; j < NMEM; ++j) { const u32x2 vv = *(const u32x2*)(VC + ((size_t)b * NMEM + j) * DM + d0); const float p = lg[h * NMEM + j];
          o0 += p * __uint_as_float(vv.x << 16); o1 += p * __uint_as_float(vv.x & 0xffff0000u); o2 += p * __uint_as_float(vv.y << 16); o3 += p * __uint_as_float(vv.y & 0xffff0000u); }
      u32x2 w; w.x = (unsigned)f2bf(o0) | ((unsigned)f2bf(o1) << 16); w.y = (unsigned)f2bf(o2) | ((unsigned)f2bf(o3) << 16); *(u32x2*)(OC + (size_t)row * DM + d0) = w; }
    __syncthreads();
}

constexpr size_t MiB = 1u << 20;
constexpr int LDS_USER = 139264, LDSCTL_OFF = LDS_USER, MISC_OFF = LDSCTL_OFF + 320, LDS_BYTES = 147456;
constexpr size_t WS_CTL = 476 * MiB, CTL_ZERO_BYTES = 1 * MiB; constexpr int CW_BAR = 4096;
struct Args { const float* in[23]; float* out; unsigned char* ws; };
static_assert(sizeof(Args) == 25 * 8, "Args has no padding");

__global__ void __launch_bounds__(512, 2) mega_k(Args a) {
    extern __shared__ __attribute__((aligned(16))) unsigned char lds_raw[];
    LAS unsigned char* lds = (LAS unsigned char*)lds_raw;
    const int tid = threadIdx.x, lane = tid & 63, wave = __builtin_amdgcn_readfirstlane(tid >> 6), half = tid >> 8, htid = tid & 255;
    const int G = gridDim.x, bx = blockIdx.x; const int vcu = (G % 8 == 0) ? (bx % 8) * (G / 8) + bx / 8 : bx;
    LAS unsigned char* hsm = lds + half * 65536;
    const float* x = a.in[0]; const float* mem = a.in[1]; const int* positions = (const int*)a.in[2];
    const float* g_mix = a.in[3]; const float* w_in = a.in[4]; const float* w_out = a.in[5];
    const float* conv_b_w = a.in[6]; const float* conv_b_b = a.in[7]; const float* ln_b_g = a.in[8]; const float* ln_b_b = a.in[9];
    const float* g_cross = a.in[10]; const float* g_mem = a.in[11];
    const float* w_q = a.in[12]; const float* w_k = a.in[13]; const float* w_v = a.in[14]; const float* w_o = a.in[15];
    const float* g_ffn = a.in[16]; const float* w_gate = a.in[17]; const float* w_up = a.in[18];
    const float* ffn_cw = a.in[19]; const float* ffn_cb = a.in[20]; const float* w_down = a.in[21]; const float* g_final = a.in[22];
    float* out = a.out; unsigned char* ws = a.ws;
    bf16_t* wt_in = (bf16_t*)(ws + 0 * MiB); bf16_t* wt_out = (bf16_t*)(ws + 4 * MiB);
    bf16_t* wt_q = (bf16_t*)(ws + 6 * MiB), *wt_k = (bf16_t*)(ws + 8 * MiB), *wt_v = (bf16_t*)(ws + 10 * MiB), *wt_o = (bf16_t*)(ws + 12 * MiB);
    bf16_t* wt_gate = (bf16_t*)(ws + 14 * MiB); bf16_t* wt_up = (bf16_t*)(ws + 20 * MiB); bf16_t* wt_down = (bf16_t*)(ws + 26 * MiB);
    float* WI = (float*)(ws + 32 * MiB);
    bf16_t* MEMN = (bf16_t*)(ws + 34 * MiB), *KC = (bf16_t*)(ws + 38 * MiB), *VC = (bf16_t*)(ws + 42 * MiB);
    bf16_t* XN = (bf16_t*)(ws + 48 * MiB); float* PROJ = (float*)(ws + 112 * MiB);
    bf16_t* Qb = (bf16_t*)(ws + 368 * MiB); bf16_t* QI = (bf16_t*)(ws + 400 * MiB);
    bf16_t* Kb = (bf16_t*)(ws + 416 * MiB), *Vb = (bf16_t*)(ws + 420 * MiB), *KI = (bf16_t*)(ws + 424 * MiB);
    bf16_t* U = (bf16_t*)(ws + 428 * MiB); unsigned short* SEL = (unsigned short*)(ws + 460 * MiB);
    bf16_t* MIX = (bf16_t*)(ws + 112 * MiB); bf16_t* QC = (bf16_t*)(ws + 176 * MiB); bf16_t* OC = (bf16_t*)(ws + 240 * MiB);
    bf16_t* Gb = (bf16_t*)(ws + 112 * MiB); bf16_t* UF = (bf16_t*)(ws + 288 * MiB);
    unsigned* ctl = (unsigned*)(ws + WS_CTL);

    for (int u = tid; u < (LDS_BYTES - LDSCTL_OFF) / 4; u += 512) ((LAS unsigned*)(lds + LDSCTL_OFF))[u] = 0u;
    __syncthreads();
    XcdBarrier bar = xcd_barrier_post(ctl + CW_BAR, (volatile LAS unsigned*)(lds + MISC_OFF) + 8);
#define GRID_BAR() xcd_barrier(bar)
#define FOR_VB(nvb) for (int vb = 2 * bx + half; vb < (nvb); vb += 2 * G)
#define GEMM(Aptr, Bptr, Mv, Nv, Kv, OF, OB, RES, LDC) do { pg8::Gemm g_{Aptr, Bptr, Mv, Nv, Kv}; pg8::StaticOrder S_; S_.init(Mv, Nv, G, bx); EpiStore E_{OF, OB, RES, LDC}; \
        pg8::gemm_phase<EpiStore, pg8::StaticOrder, true, true>(lds, g_, S_, E_); } while (0)

    for (int i = bx * 512 + tid; i < (INP - INC) * DM; i += G * 512) wt_in[(size_t)INC * DM + i] = 0;
    FOR_VB(32 * 63) wt_body(hsm, vb, htid, w_in, DM, INC, wt_in);
    FOR_VB(32 * 32) wt_body(hsm, vb, htid, w_out, DM, DM, wt_out);
    FOR_VB(32 * 32) wt_body(hsm, vb, htid, w_q, DM, DM, wt_q);
    FOR_VB(32 * 32) wt_body(hsm, vb, htid, w_k, DM, DM, wt_k);
    FOR_VB(32 * 32) wt_body(hsm, vb, htid, w_v, DM, DM, wt_v);
    FOR_VB(32 * 32) wt_body(hsm, vb, htid, w_o, DM, DM, wt_o);
    FOR_VB(32 * 88) wt_body(hsm, vb, htid, w_gate, DM, DFF, wt_gate);
    FOR_VB(32 * 88) wt_body(hsm, vb, htid, w_up, DM, DFF, wt_up);
    FOR_VB(88 * 32) wt_body(hsm, vb, htid, w_down, DFF, DM, wt_down);
    for (int r = bx * 8 + wave; r < MTOK; r += G * 8) rmsnorm_bf16_row(x, g_mix, XN, r, lane);
    for (int r = bx * 8 + wave; r < MMEM; r += G * 8) rmsnorm_bf16_row(mem, g_mem, MEMN, r, lane);
    GRID_BAR();
    GEMM(XN, wt_in, MTOK, INP, DM, PROJ, (bf16_t*)nullptr, (const float*)nullptr, INP);
    GEMM(MEMN, wt_k, MMEM, DM, DM, (float*)nullptr, KC, (const float*)nullptr, DM);
    GEMM(wt_v, MEMN, DM, MMEM, DM, (float*)nullptr, VC, (const float*)nullptr, MMEM);
    GRID_BAR();
    FOR_VB(MTOK) split_rope_body(hsm, vb, htid, PROJ, positions, Qb, Kb, Vb, QI, KI, WI, U);
    GRID_BAR();
    topk_phase(lds, G, vcu, QI, KI, WI, SEL, tid, lane, wave);
    FOR_VB(MTOK) convb_body(hsm, vb, htid, U, conv_b_w, conv_b_b, ln_b_g, ln_b_b, MIX);
    GRID_BAR();
    sparse_attn_phase(lds, G, vcu, Qb, Kb, Vb, SEL, MIX, lane, wave);
    GRID_BAR();
    GEMM(MIX, wt_out, MTOK, DM, DM, out, (bf16_t*)nullptr, x, DM);
    GRID_BAR();
    for (int r = bx * 8 + wave; r < MTOK; r += G * 8) rmsnorm_bf16_row(out, g_cross, XN, r, lane);
    GRID_BAR();
    GEMM(XN, wt_q, MTOK, DM, DM, (float*)nullptr, QC, (const float*)nullptr, DM);
    GRID_BAR();
    { const int per = (512 + G - 1) / G; for (int i = 0; i < per; ++i) { const int u = vcu * per + i; if (u < 512) cross_attn_unit(lds, u >> 6, (u >> 4) & 3, u & 15, QC, KC, VC, OC, tid, lane, wave); } }
    GRID_BAR();
    GEMM(OC, wt_o, MTOK, DM, DM, out, (bf16_t*)nullptr, out, DM);
    GRID_BAR();
    for (int r = bx * 8 + wave; r < MTOK; r += G * 8) rmsnorm_bf16_row(out, g_ffn, XN, r, lane);
    GRID_BAR();
    GEMM(XN, wt_gate, MTOK, DFF, DM, (float*)nullptr, Gb, (const float*)nullptr, DFF);
    GEMM(XN, wt_up, MTOK, DFF, DM, (float*)nullptr, UF, (const float*)nullptr, DFF);
    GRID_BAR();
    for (size_t i = (size_t)bx * 512 + tid; i < (size_t)MTOK * DFF; i += (size_t)G * 512) {
        const int c = (int)(i % DFF); const size_t row = i / DFF; const int t = (int)(row % SEQ);
        float g = ffn_cb[c] + ffn_cw[2 * DFF + c] * bf2f(Gb[i]);
        if (t >= 1) g += ffn_cw[1 * DFF + c] * bf2f(Gb[i - DFF]);
        if (t >= 2) g += ffn_cw[0 * DFF + c] * bf2f(Gb[i - 2 * DFF]);
        UF[i] = f2bf(silu_f(g) * bf2f(UF[i]));
    }
    GRID_BAR();
    GEMM(UF, wt_down, MTOK, DM, DFF, out, (bf16_t*)nullptr, out, DM);
    GRID_BAR();
    for (int r = bx * 8 + wave; r < MTOK; r += G * 8) rmsnorm_f32_row(out, g_final, r, lane);
}

extern "C" void kernel_launch(void* const* d_in, const int* in_sizes, int n_in, void* d_out, int out_size, void* d_ws, size_t ws_size, hipStream_t stream) {
    static int grid = 0;
    if (grid == 0) {
        int dev = 0, cus = 0, per_cu = 0;
        if (hipGetDevice(&dev) != hipSuccess || hipDeviceGetAttribute(&cus, hipDeviceAttributeMultiprocessorCount, dev) != hipSuccess) { fprintf(stderr, "kernel_launch: device query failed\n"); grid = -1; return; }
        if (hipFuncSetAttribute((const void*)mega_k, hipFuncAttributeMaxDynamicSharedMemorySize, LDS_BYTES) != hipSuccess) { fprintf(stderr, "kernel_launch: hipFuncSetAttribute failed\n"); grid = -1; return; }
        if (hipOccupancyMaxActiveBlocksPerMultiprocessor(&per_cu, (const void*)mega_k, 512, LDS_BYTES) != hipSuccess || per_cu < 1) { fprintf(stderr, "kernel_launch: occupancy query says %d\n", per_cu); per_cu = 1; }
        (void)hipGetLastError();
        grid = cus * 1;
        if (n_in != 23 || ws_size < 477 * MiB) { fprintf(stderr, "kernel_launch: unexpected n_in %d / ws %zu\n", n_in, ws_size); grid = -1; return; }
    }
    if (grid < 0) return;
    (void)hipMemsetAsync((char*)d_ws + WS_CTL, 0, CTL_ZERO_BYTES, stream);
    Args a{};
    for (int i = 0; i < 23; ++i) a.in[i] = (const float*)d_in[i];
    a.out = (float*)d_out; a.ws = (unsigned char*)d_ws;
    void* params[] = {&a};
    hipError_t e = hipLaunchCooperativeKernel((const void*)mega_k, dim3(grid), dim3(512), params, LDS_BYTES, stream);
    if (e != hipSuccess) fprintf(stderr, "cooperative launch failed: %s (grid %d)\n", hipGetErrorString(e), grid);
}
```

```cpp
#include <hip/hip_runtime.h>
#include <cstdio>
#include <cstdint>
#include <cmath>
namespace pg8 {
#define PG8_LAS __attribute__((address_space(3)))
typedef unsigned short bf16_t;
typedef short bf16x8 __attribute__((ext_vector_type(8)));
typedef float f32x4 __attribute__((ext_vector_type(4)));
typedef unsigned u32x4 __attribute__((ext_vector_type(4)));
constexpr int BM = 256, BK = 64, HALF = 128, HTB = HALF * BK * 2  , STAGE_BYTES = 8 * HTB, NXCD = 8, WGM = 8;

__host__ __device__ __forceinline__ int lds_byte(int r, int c) { const int st = (r >> 4) * 2 + (c >> 5), rr = r & 15, cc = c & 31, ob = rr * 64 + cc * 2; return st * 1024 + (ob ^ (((ob >> 9) & 1) << 5)); }
__host__ __device__ __forceinline__ void stage_rc(int b, int& R, int& C) { const int st = b / 1024, sb = b % 1024, swz = sb ^ (((sb >> 9) & 1) << 5); R = (st >> 1) * 16 + swz / 64; C = (st & 1) * 32 + (swz % 64) / 2; }
__host__ __device__ __forceinline__ int perm32(int rho) { const int n = rho >> 4, i = rho & 15; return 8 * (i >> 2) + 4 * n + (i & 3); }

struct Unit { int pm, pn; };
struct Gemm { const bf16_t* A; const bf16_t* Bt; int M, N, K; };

struct StaticOrder {
    int nM, nN, nwg, G, c;
    __host__ __device__ void init(int M, int N, int G_, int c_) { nM = M / BM; nN = N / BM; nwg = nM * nN; G = G_; c = c_; }
    __host__ __device__ bool next(int i, Unit& u) const {
        const long L = (long)i * G + c; if (L >= nwg) return false;
        int wgid = (int)L; { const int q = nwg / NXCD, r = nwg % NXCD, xcd = wgid % NXCD, off = wgid / NXCD; wgid = (xcd < r ? xcd * (q + 1) : r * (q + 1) + (xcd - r) * q) + off; }
        const int nig = WGM * nN, gid = wgid / nig, fm = gid * WGM, gsz = (nM - fm) < WGM ? (nM - fm) : WGM;
        u.pm = fm + ((wgid % nig) % gsz); u.pn = (wgid % nig) / gsz; return true;
    }
    __device__ __forceinline__ void a_ready(const Unit&) const {}
    __device__ __forceinline__ void done(const Unit&) const {}
};
__device__ __forceinline__ unsigned cvt_pk_bf16(float lo, float hi) { unsigned r; asm volatile("v_cvt_pk_bf16_f32 %0, %1, %2" : "=v"(r) : "v"(lo), "v"(hi)); return r; }
template <class Epi, class Sched, bool ALIGN_EPI = false, bool SP2 = false>
__device__ __forceinline__ void gemm_phase(PG8_LAS unsigned char* lds, const Gemm g, const Sched& S, const Epi& E) {
    int tid_l = threadIdx.x; asm volatile("" : "+v"(tid_l));
    const int tid = tid_l, wid = __builtin_amdgcn_readfirstlane(tid >> 6), lane = tid & 63, wr = wid >> 2, wc = wid & 3, fr = lane & 15, fq = lane >> 4;
    const int K = g.K, nt = K / BK;
    unsigned voffA[2], voffB[2];
#pragma unroll
    for (int i = 0; i < 2; ++i) { int R, C; stage_rc(tid * 16 + i * 8192, R, C); const int Rb = Epi::PERM ? ((R & ~31) + perm32(R & 31)) : R;
        voffA[i] = (unsigned)(R * K + C) * 2u; voffB[i] = (unsigned)(Rb * K + C) * 2u; }
    const size_t kstep = (size_t)(BK * 2);
    const size_t hstep = (size_t)HALF * K * 2;
    const size_t tstep = 2 * hstep;
    const unsigned ldsw = (unsigned)wid * 1024u;
    const int aoff = lds_byte(wr * 64 + fr, fq * 8), boff = lds_byte(wc * 32 + fr, fq * 8);
#define PG8_SA(b, h) (((b) * 2 + (h)) * HTB)
#define PG8_SB(b, h) ((4 + (b) * 2 + (h)) * HTB)
#define PG8_STAGE(bufoff, gbase, voff) do { _Pragma("unroll") for (int _i = 0; _i < 2; ++_i) \
        __builtin_amdgcn_global_load_lds((const unsigned*)((const char*)(gbase) + (voff)[_i]), (PG8_LAS unsigned*)(lds + (bufoff) + ldsw + _i * 8192), 16, 0, 0); } while (0)
#define PG8_LDA(dst, b, h) do { _Pragma("unroll") for (int m = 0; m < 4; ++m) _Pragma("unroll") for (int k = 0; k < 2; ++k) dst[m][k] = *(const PG8_LAS bf16x8*)(lds + PG8_SA(b, h) + aoff + m * 2048 + k * 1024); } while (0)
#define PG8_LDB(dst, b, h) do { _Pragma("unroll") for (int n = 0; n < 2; ++n) _Pragma("unroll") for (int k = 0; k < 2; ++k) dst[n][k] = *(const PG8_LAS bf16x8*)(lds + PG8_SB(b, h) + boff + n * 2048 + k * 1024); } while (0)
#define PG8_MMA(ai, bj, At, Bt) do { __builtin_amdgcn_s_setprio(1); _Pragma("unroll") for (int m = 0; m < 4; ++m) _Pragma("unroll") for (int n = 0; n < 2; ++n) _Pragma("unroll") for (int k = 0; k < 2; ++k) \
        acc[ai][bj][m][n] = __builtin_amdgcn_mfma_f32_16x16x32_bf16(Bt[n][k], At[m][k], acc[ai][bj][m][n], 0, 0, 0); __builtin_amdgcn_s_setprio(0); } while (0)
#define PG8_WAIT_V(n) asm volatile("s_waitcnt vmcnt(" #n ")" ::: "memory")
#define PG8_WAIT_L(n) asm volatile("s_waitcnt lgkmcnt(" #n ")" ::: "memory")
#define PG8_BAR __builtin_amdgcn_s_barrier()
#define PG8_SCHED __builtin_amdgcn_sched_barrier(0)
    Unit cur, nxt; int ui = 0;
    if (!S.next(0, cur)) return;
    f32x4 acc[2][2][4][2];
#pragma unroll
    for (int a = 0; a < 2; ++a)
#pragma unroll
        for (int b = 0; b < 2; ++b)
#pragma unroll
            for (int m = 0; m < 4; ++m)
#pragma unroll
                for (int n = 0; n < 2; ++n) acc[a][b][m][n] = (f32x4){0.f, 0.f, 0.f, 0.f};
    bf16x8 At[4][2], B0[2][2], B1[2][2];
    const char* cA = (const char*)g.A + (size_t)cur.pm * tstep; const char* cB = (const char*)g.Bt + (size_t)cur.pn * tstep;
    S.a_ready(cur);
    if constexpr (SP2) {
        PG8_STAGE(PG8_SB(0, 0), cB, voffB); PG8_STAGE(PG8_SB(0, 1), cB + hstep, voffB); PG8_STAGE(PG8_SA(0, 0), cA, voffA); PG8_STAGE(PG8_SA(0, 1), cA + hstep, voffA);
        if (wr == 1) PG8_BAR;
        PG8_WAIT_V(2); PG8_BAR;
        PG8_STAGE(PG8_SB(1, 0), cB + kstep, voffB); PG8_STAGE(PG8_SA(1, 0), cA + kstep, voffA); PG8_STAGE(PG8_SB(1, 1), cB + hstep + kstep, voffB);
        PG8_WAIT_V(6); PG8_BAR;
    } else {
        PG8_STAGE(PG8_SB(0, 0), cB, voffB); PG8_STAGE(PG8_SA(0, 0), cA, voffA); PG8_STAGE(PG8_SB(0, 1), cB + hstep, voffB); PG8_STAGE(PG8_SA(0, 1), cA + hstep, voffA);
        if (wr == 1) PG8_BAR;
        PG8_WAIT_V(4); PG8_BAR;
        PG8_STAGE(PG8_SB(1, 0), cB + kstep, voffB); PG8_STAGE(PG8_SA(1, 0), cA + kstep, voffA); PG8_STAGE(PG8_SB(1, 1), cB + hstep + kstep, voffB);
        PG8_WAIT_V(6); PG8_BAR;
    }
    for (;;) {
        const bool has_next = S.next(ui + 1, nxt);
        const char* nA = has_next ? (const char*)g.A + (size_t)nxt.pm * tstep : cA; const char* nB = has_next ? (const char*)g.Bt + (size_t)nxt.pn * tstep : cB;
        for (int t = 0; t < nt; t += 2) {
            const bool last = (t == nt - 2);
            const char* a1 = cA + (size_t)(t + 1) * kstep;
            const char* a2 = last ? nA : cA + (size_t)(t + 2) * kstep; const char* b2 = last ? nB : cB + (size_t)(t + 2) * kstep;
            const char* a3 = a2 + kstep; const char* b3 = b2 + kstep;
            if (last && has_next) S.a_ready(nxt);
            if constexpr (SP2) {
            PG8_LDB(B0, 0, 0); PG8_LDB(B1, 0, 1); PG8_SCHED; PG8_LDA(At, 0, 0); PG8_STAGE(PG8_SA(1, 1), a1 + hstep, voffA);
            PG8_WAIT_V(8); PG8_WAIT_L(0); PG8_BAR; PG8_MMA(0, 0, At, B0); PG8_MMA(0, 1, At, B1); PG8_BAR; PG8_SCHED;
            PG8_LDA(At, 0, 1); PG8_STAGE(PG8_SB(0, 0), b2, voffB); PG8_STAGE(PG8_SB(0, 1), b2 + hstep, voffB); PG8_STAGE(PG8_SA(0, 0), a2, voffA);
            PG8_WAIT_V(8); PG8_WAIT_L(0); PG8_BAR; PG8_MMA(1, 0, At, B0); PG8_MMA(1, 1, At, B1); PG8_BAR; PG8_SCHED;
            PG8_LDB(B0, 1, 0); PG8_LDB(B1, 1, 1); PG8_SCHED; PG8_LDA(At, 1, 0); PG8_STAGE(PG8_SA(0, 1), a2 + hstep, voffA);
            PG8_WAIT_V(8); PG8_WAIT_L(0); PG8_BAR; PG8_MMA(0, 0, At, B0); PG8_MMA(0, 1, At, B1); PG8_BAR; PG8_SCHED;
            PG8_LDA(At, 1, 1); PG8_STAGE(PG8_SB(1, 0), b3, voffB); PG8_STAGE(PG8_SB(1, 1), b3 + hstep, voffB); PG8_STAGE(PG8_SA(1, 0), a3, voffA);
            PG8_WAIT_V(8); PG8_WAIT_L(0); PG8_BAR; PG8_MMA(1, 0, At, B0); PG8_MMA(1, 1, At, B1); PG8_BAR; PG8_SCHED;
            } else {
            PG8_LDB(B0, 0, 0); PG8_SCHED; PG8_LDA(At, 0, 0); PG8_STAGE(PG8_SA(1, 1), a1 + hstep, voffA);
            PG8_WAIT_L(8); PG8_BAR; PG8_WAIT_L(0); PG8_MMA(0, 0, At, B0); PG8_BAR; PG8_SCHED;
            PG8_LDB(B1, 0, 1); PG8_STAGE(PG8_SB(0, 0), b2, voffB);
            PG8_BAR; PG8_WAIT_L(0); PG8_MMA(0, 1, At, B1); PG8_BAR;
            PG8_LDA(At, 0, 1); PG8_STAGE(PG8_SA(0, 0), a2, voffA);
            PG8_BAR; PG8_WAIT_L(0); PG8_MMA(1, 0, At, B0); PG8_BAR; PG8_SCHED;
            PG8_STAGE(PG8_SB(0, 1), b2 + hstep, voffB);
            PG8_WAIT_V(6); PG8_BAR; PG8_MMA(1, 1, At, B1); PG8_BAR;
            PG8_LDB(B0, 1, 0); PG8_SCHED; PG8_LDA(At, 1, 0); PG8_STAGE(PG8_SA(0, 1), a2 + hstep, voffA);
            PG8_WAIT_L(8); PG8_BAR; PG8_WAIT_L(0); PG8_MMA(0, 0, At, B0); PG8_BAR; PG8_SCHED;
            PG8_LDB(B1, 1, 1); PG8_STAGE(PG8_SB(1, 0), b3, voffB);
            PG8_BAR; PG8_WAIT_L(0); PG8_MMA(0, 1, At, B1); PG8_BAR;
            PG8_LDA(At, 1, 1); PG8_STAGE(PG8_SA(1, 0), a3, voffA);
            PG8_BAR; PG8_WAIT_L(0); PG8_MMA(1, 0, At, B0); PG8_BAR; PG8_SCHED;
            PG8_STAGE(PG8_SB(1, 1), b3 + hstep, voffB);
            PG8_WAIT_V(6); PG8_BAR; PG8_MMA(1, 1, At, B1); PG8_BAR;
            }
        }
        if constexpr (ALIGN_EPI) { if (wr == 0) PG8_BAR; }
        if constexpr (!Epi::AFTER_DRAIN) { E(acc, cur, wr, wc, fr, fq); S.done(cur); }
        if (!has_next) break;
#pragma unroll
        for (int a = 0; a < 2; ++a)
#pragma unroll
            for (int b = 0; b < 2; ++b)
#pragma unroll
                for (int m = 0; m < 4; ++m)
#pragma unroll
                    for (int n = 0; n < 2; ++n) acc[a][b][m][n] = (f32x4){0.f, 0.f, 0.f, 0.f};
        cur = nxt; cA = nA; cB = nB; ++ui;
        if constexpr (ALIGN_EPI) { if (wr == 1) PG8_BAR; }
    }
    PG8_WAIT_V(0);
    if constexpr (!ALIGN_EPI) { if (wr == 0) PG8_BAR; }
    PG8_BAR;
    if constexpr (Epi::AFTER_DRAIN) { E.fused(acc, cur, wr, wc, fr, fq, lds, wid, lane); S.done(cur); }
#undef PG8_SA
#undef PG8_SB
#undef PG8_STAGE
#undef PG8_LDA
#undef PG8_LDB
#undef PG8_MMA
#undef PG8_WAIT_V
#undef PG8_WAIT_L
#undef PG8_BAR
#undef PG8_SCHED
}
}

constexpr int BATCH = 8, SEQ = 4096, DM = 1024, MTOK = BATCH * SEQ;
constexpr int NMEM = 256, MMEM = BATCH * NMEM;
constexpr int AW = 512, HD = 64, NH = 8, IH = 4, TOPK = 256;
constexpr int INC = 1988, INP = 2048;
constexpr int DFF = 2816;
constexpr float EPS = 1e-6f;
#define LAS __attribute__((address_space(3)))
typedef unsigned short bf16_t;
typedef float f32x4 __attribute__((ext_vector_type(4)));
typedef unsigned u32x4 __attribute__((ext_vector_type(4)));
typedef unsigned u32x2 __attribute__((ext_vector_type(2)));

__device__ __forceinline__ float bf2f(bf16_t v) { return __uint_as_float((unsigned)v << 16); }
__device__ __forceinline__ bf16_t f2bf(float f) { unsigned u = __float_as_uint(f); return (bf16_t)((u + 0x7fffu + ((u >> 16) & 1u)) >> 16); }
__device__ __forceinline__ float wave_sum(float v) {
#pragma unroll
    for (int o = 1; o < 64; o <<= 1) v += __shfl_xor(v, o);
    return v;
}
__device__ __forceinline__ float wave_max(float v) {
#pragma unroll
    for (int o = 1; o < 64; o <<= 1) v = fmaxf(v, __shfl_xor(v, o));
    return v;
}
__device__ __forceinline__ float silu_f(float v) { return v / (1.f + __expf(-v)); }

struct EpiStore {
    static constexpr bool PERM = false, AFTER_DRAIN = false;
    float* outf; bf16_t* outb; const float* res; int ldc;
    __device__ __forceinline__ void operator()(const pg8::f32x4 (&acc)[2][2][4][2], const pg8::Unit& u, int wr, int wc, int fr, int fq) const {
        const int col0 = u.pn * 256 + wc * 32 + 4 * fq;
#pragma unroll
        for (int ai = 0; ai < 2; ++ai)
#pragma unroll
            for (int m = 0; m < 4; ++m) {
                const size_t row = (size_t)(u.pm * 256 + ai * 128 + wr * 64 + m * 16 + fr);
#pragma unroll
                for (int bj = 0; bj < 2; ++bj)
#pragma unroll
                    for (int n = 0; n < 2; ++n) {
                        const size_t off = row * ldc + col0 + bj * 128 + n * 16;
                        pg8::f32x4 v = acc[ai][bj][m][n];
                        if (res) { const pg8::f32x4 r = *(const pg8::f32x4*)(res + off); v = v + r; }
                        if (outf) *(pg8::f32x4*)(outf + off) = v;
                        if (outb) { u32x2 w; w.x = (unsigned)f2bf(v[0]) | ((unsigned)f2bf(v[1]) << 16); w.y = (unsigned)f2bf(v[2]) | ((unsigned)f2bf(v[3]) << 16); *(u32x2*)(outb + off) = w; }
                    }
            }
    }
};
#define XB_TMO      128
#define XB_XCNT(j)  (256  + 64 * (j))
#define XB_XSUB(j)  (1280 + 64 * (j))
#define XB_XGEN(j)  (2304 + 64 * (j))
#define XB_TOP      3328
#define XB_TOPGEN   3392
#define XCD_BAR_WORDS 3456
#define XB_SPIN_CAP (1u << 18)

__device__ __forceinline__ unsigned xb_ld(unsigned* p)              { return __hip_atomic_load(p, __ATOMIC_RELAXED, __HIP_MEMORY_SCOPE_AGENT); }
__device__ __forceinline__ unsigned xb_add(unsigned* p, unsigned v) { return __hip_atomic_fetch_add(p, v, __ATOMIC_RELAXED, __HIP_MEMORY_SCOPE_AGENT); }
__device__ __forceinline__ unsigned xb_xcc_id() { return (unsigned)__builtin_amdgcn_s_getreg((3 << 11) | 20) & 0xFu; }
#define XB_SPIN(cond, bar) do { unsigned _sp = 0; while (cond) { __builtin_amdgcn_s_sleep(1); \
    if ((++_sp & 255u) == 0u) { if (xb_ld(&(bar)[XB_TMO])) break; if (_sp > XB_SPIN_CAP) { atomicAdd(&(bar)[XB_TMO], 1u); break; } } } } while (0)

struct XcdBarrier {
    unsigned* bar; unsigned x;
    volatile LAS unsigned* st;
};

__device__ __forceinline__ XcdBarrier xcd_barrier_post(unsigned* bar, volatile LAS unsigned* st) {
    XcdBarrier b; b.bar = bar; b.x = xb_xcc_id(); b.st = st;
    if (threadIdx.x == 0) (void)xb_add(&bar[XB_XCNT(b.x)], 1u);
    return b;
}
__device__ __forceinline__ void xcd_barrier_complete(unsigned* bar, unsigned x, unsigned& nloc, unsigned& nx) {
    const unsigned G = gridDim.x * gridDim.y * gridDim.z;
    unsigned sum, cnt, mine, sp = 0u;
    for (;;) {
        sum = 0u; cnt = 0u; mine = 0u;
#pragma unroll
        for (unsigned j = 0; j < 16; ++j) { const unsigned c = xb_ld(&bar[XB_XCNT(j)]); sum += c; cnt += (c > 0u) ? 1u : 0u; mine = (j == x) ? c : mine; }
        if (sum == G) break;
        __builtin_amdgcn_s_sleep(1);
        if ((++sp & 255u) == 0u) { if (xb_ld(&bar[XB_TMO])) break; if (sp > XB_SPIN_CAP) { atomicAdd(&bar[XB_TMO], 1u); break; } }
    }
    nloc = mine > 0u ? mine : 1u; nx = cnt > 0u ? cnt : 1u;
}

__device__ __forceinline__ void xcd_barrier(const XcdBarrier& b) {
    asm volatile("s_waitcnt vmcnt(0)" ::: "memory");
    __syncthreads();
    if (threadIdx.x == 0) {
        unsigned* bar = b.bar;
        __builtin_amdgcn_s_waitcnt(0);
        unsigned nloc = b.st[0], nx = b.st[1];
        if (nloc == 0u) { xcd_barrier_complete(bar, b.x, nloc, nx); b.st[0] = nloc; b.st[1] = nx; }
        const unsigned old = xb_add(&bar[XB_XSUB(b.x)], 1u);
        const unsigned gen = old / nloc;
        if (old + 1u == (gen + 1u) * nloc) {
            __builtin_amdgcn_fence(__ATOMIC_RELEASE, "agent");
            asm volatile("s_waitcnt vmcnt(0)" ::: "memory");
            const unsigned og = xb_add(&bar[XB_TOP], 1u);
            const unsigned tg = og / nx;
            if (og + 1u == (tg + 1u) * nx) xb_add(&bar[XB_TOPGEN], 1u);
            else XB_SPIN(xb_ld(&bar[XB_TOPGEN]) == tg, bar);
            __builtin_amdgcn_fence(__ATOMIC_ACQUIRE, "agent");
            xb_add(&bar[XB_XGEN(b.x)], 1u);
            asm volatile("s_waitcnt vmcnt(0)" ::: "memory");
        } else {
            XB_SPIN(xb_ld(&bar[XB_XGEN(b.x)]) == gen, bar);
            __builtin_amdgcn_fence(__ATOMIC_ACQUIRE, "agent");
            asm volatile("s_waitcnt vmcnt(0)" ::: "memory");
        }
    }
    __syncthreads();
}

__device__ __forceinline__ u32x4 pack8(const pg8::f32x4 a, const pg8::f32x4 b) {
    u32x4 w; w.x = pg8::cvt_pk_bf16(a[0], a[1]); w.y = pg8::cvt_pk_bf16(a[2], a[3]); w.z = pg8::cvt_pk_bf16(b[0], b[1]); w.w = pg8::cvt_pk_bf16(b[2], b[3]); return w;
}
__device__ __forceinline__ float sigmoid_f(float v) { return 1.f / (1.f + __expf(-v)); }
__host__ __device__ __forceinline__ int dperm(int pos) { return pos < 16 ? (4 * (pos >> 3) + (pos & 3) + 8 * ((pos >> 2) & 1)) : pos; }
__host__ __device__ __forceinline__ int in_orig_col(int n) {
    if (n < 512) return (n & ~63) + dperm(n & 63);
    if (n < 576) return 512 + dperm(n - 512);
    if (n < 640) return 576 + (n - 576);
    if (n < 704) return 896 + dperm(n - 640);
    if (n < 708) return 960 + (n - 704);
    if (n < 768) return -1;
    if (n < 1024) return 640 + ((n - 768) & ~63) + dperm((n - 768) & 63);
    const int i = (n - 1024) >> 8, c = (n - 1024) & 255;
    return c < 128 ? 964 + 128 * i + c : 1476 + 128 * i + (c - 128);
}
struct EpiIn {
    static constexpr bool PERM = true, AFTER_DRAIN = false;
    const float* cs; bf16_t *Q, *K, *V, *QI, *KI, *U; float* WI;
    __device__ __forceinline__ void operator()(const pg8::f32x4 (&acc)[2][2][4][2], const pg8::Unit& u, int wr, int wc, int fr, int fq) const {
        const int pn = u.pn;
        if (pn >= 4) {
            const int ch = 128 * (pn - 4) + 32 * wc + 8 * fq;
#pragma unroll
            for (int ai = 0; ai < 2; ++ai)
#pragma unroll
                for (int m = 0; m < 4; ++m) { const size_t row = (size_t)(u.pm * 256 + ai * 128 + wr * 64 + m * 16 + fr);
                    pg8::f32x4 a0 = acc[ai][0][m][0], a1 = acc[ai][0][m][1]; const pg8::f32x4 g0 = acc[ai][1][m][0], g1 = acc[ai][1][m][1];
#pragma unroll
                    for (int k = 0; k < 4; ++k) { a0[k] *= sigmoid_f(g0[k]); a1[k] *= sigmoid_f(g1[k]); }
                    *(u32x4*)(U + row * 512 + ch) = pack8(a0, a1); }
            return;
        }
        const bool rot = (pn == 2) ? (wc == 0 && fq < 2) : ((wc & 1) == 0 && fq < 2);
#pragma unroll
        for (int ai = 0; ai < 2; ++ai)
#pragma unroll
            for (int m = 0; m < 4; ++m) { const size_t row = (size_t)(u.pm * 256 + ai * 128 + wr * 64 + m * 16 + fr);
                pg8::f32x4 cv = {1.f, 1.f, 1.f, 1.f}, sv = {0.f, 0.f, 0.f, 0.f};
                if (rot) { cv = *(const pg8::f32x4*)(cs + row * 16 + 4 * fq); sv = *(const pg8::f32x4*)(cs + row * 16 + 8 + 4 * fq); }
#pragma unroll
                for (int bj = 0; bj < 2; ++bj) {
                    const pg8::f32x4 v0 = acc[ai][bj][m][0], v1 = acc[ai][bj][m][1];
                    pg8::f32x4 n0 = v0 * cv - v1 * sv, n1 = v1 * cv + v0 * sv;
                    if (!rot) { n0 = v0; n1 = v1; }
                    const int c = 128 * bj + 32 * wc + 8 * fq;
                    if (pn < 2) *(u32x4*)(Q + row * 512 + 256 * pn + c) = pack8(n0, n1);
                    else if (pn == 3) *(u32x4*)(QI + row * 256 + c) = pack8(n0 * 0.125f, n1 * 0.125f);
                    else {
                        if (bj == 0) { if (wc < 2) *(u32x4*)(K + row * 64 + 32 * wc + 8 * fq) = pack8(n0, n1); else *(u32x4*)(V + row * 64 + 32 * (wc - 2) + 8 * fq) = pack8(v0, v1); }
                        else { if (wc < 2) *(u32x4*)(KI + row * 64 + 32 * wc + 8 * fq) = pack8(n0, n1); else if (wc == 2 && fq == 0) *(pg8::f32x4*)(WI + row * 4) = v0 * 0.5f; }
                    }
                }
            }
    }
};
struct EpiRes {
    static constexpr bool PERM = true, AFTER_DRAIN = false;
    const float* res; float* out; bf16_t* xb; float* ss;
    __device__ __forceinline__ void operator()(const pg8::f32x4 (&acc)[2][2][4][2], const pg8::Unit& u, int wr, int wc, int fr, int fq) const {
#pragma unroll
        for (int ai = 0; ai < 2; ++ai)
#pragma unroll
            for (int m = 0; m < 4; ++m) { const size_t row = (size_t)(u.pm * 256 + ai * 128 + wr * 64 + m * 16 + fr); float q = 0.f;
#pragma unroll
                for (int bj = 0; bj < 2; ++bj) { const size_t off = row * DM + u.pn * 256 + 128 * bj + 32 * wc + 8 * fq;
                    const pg8::f32x4 v0 = acc[ai][bj][m][0] + *(const pg8::f32x4*)(res + off), v1 = acc[ai][bj][m][1] + *(const pg8::f32x4*)(res + off + 4);
                    *(pg8::f32x4*)(out + off) = v0; *(pg8::f32x4*)(out + off + 4) = v1;
                    if (xb) *(u32x4*)(xb + off) = pack8(v0, v1);
                    q += (v0[0] * v0[0] + v0[1] * v0[1]) + (v0[2] * v0[2] + v0[3] * v0[3]) + (v1[0] * v1[0] + v1[1] * v1[1]) + (v1[2] * v1[2] + v1[3] * v1[3]); }
                q += __shfl_xor(q, 16); q += __shfl_xor(q, 32);
                if (fq == 0) ss[row * 16 + u.pn * 4 + wc] = q; }
    }
};
__device__ __forceinline__ float rstd_from_ss(const float* ss, size_t row) {
    const pg8::f32x4 a = *(const pg8::f32x4*)(ss + row * 16), b = *(const pg8::f32x4*)(ss + row * 16 + 4), c = *(const pg8::f32x4*)(ss + row * 16 + 8), d = *(const pg8::f32x4*)(ss + row * 16 + 12);
    const float s = ((a[0] + a[1]) + (a[2] + a[3])) + ((b[0] + b[1]) + (b[2] + b[3])) + ((c[0] + c[1]) + (c[2] + c[3])) + ((d[0] + d[1]) + (d[2] + d[3]));
    return 1.f / sqrtf(s * (1.f / DM) + EPS);
}
struct EpiScale {
    static constexpr bool PERM = true, AFTER_DRAIN = false;
    const float* ss; bf16_t* O; int ldc; float scale;
    __device__ __forceinline__ void operator()(const pg8::f32x4 (&acc)[2][2][4][2], const pg8::Unit& u, int wr, int wc, int fr, int fq) const {
#pragma unroll
        for (int ai = 0; ai < 2; ++ai)
#pragma unroll
            for (int m = 0; m < 4; ++m) { const size_t row = (size_t)(u.pm * 256 + ai * 128 + wr * 64 + m * 16 + fr); const float r = rstd_from_ss(ss, row) * scale;
#pragma unroll
                for (int bj = 0; bj < 2; ++bj) *(u32x4*)(O + row * ldc + u.pn * 256 + 128 * bj + 32 * wc + 8 * fq) = pack8(acc[ai][bj][m][0] * r, acc[ai][bj][m][1] * r); }
    }
};
struct EpiGateUp {
    static constexpr bool PERM = true, AFTER_DRAIN = false;
    const float* ss; bf16_t* Gb; bf16_t* Ub;
    __device__ __forceinline__ void operator()(const pg8::f32x4 (&acc)[2][2][4][2], const pg8::Unit& u, int wr, int wc, int fr, int fq) const {
        const int ch = 128 * u.pn + 32 * wc + 8 * fq;
#pragma unroll
        for (int ai = 0; ai < 2; ++ai)
#pragma unroll
            for (int m = 0; m < 4; ++m) { const size_t row = (size_t)(u.pm * 256 + ai * 128 + wr * 64 + m * 16 + fr); const float r = rstd_from_ss(ss, row);
                *(u32x4*)(Gb + row * DFF + ch) = pack8(acc[ai][0][m][0] * r, acc[ai][0][m][1] * r);
                *(u32x4*)(Ub + row * DFF + ch) = pack8(acc[ai][1][m][0] * r, acc[ai][1][m][1] * r); }
    }
};
typedef short bf16x8v __attribute__((ext_vector_type(8)));
constexpr int CA_STRIDE = 528;
__device__ __forceinline__ void cross_attn_unit(LAS unsigned char* lds, int b, int h, int qb, const bf16_t* QC, const bf16_t* KC, const bf16_t* VT, bf16_t* OC, int tid, int lane, int wave) {
    const int q16 = lane & 15, g = lane >> 4;
    const size_t row0 = (size_t)b * SEQ + (size_t)qb * 256 + wave * 32;
    asm volatile("" : "+v"(tid));
    { const bf16_t* src = KC + ((size_t)b * NMEM + (tid >> 5)) * DM + h * 256 + (tid & 31) * 8; LAS unsigned char* dst = lds + (tid >> 5) * CA_STRIDE + (tid & 31) * 16;
#pragma unroll
      for (int i = 0; i < 16; ++i) { const u32x4 v = *(const u32x4*)(src + (size_t)i * 16 * DM); *(LAS u32x4*)(dst + i * 16 * CA_STRIDE) = v; } }
    __syncthreads();
    f32x4 S[2][16];
#pragma unroll
    for (int st = 0; st < 2; ++st)
#pragma unroll
        for (int kt = 0; kt < 16; ++kt) S[st][kt] = (f32x4){0.f, 0.f, 0.f, 0.f};
#pragma unroll 1
    for (int kh = 0; kh < 2; ++kh) {
        bf16x8v qf[2][4];
#pragma unroll
        for (int st = 0; st < 2; ++st)
#pragma unroll
            for (int ks = 0; ks < 4; ++ks) qf[st][ks] = *(const bf16x8v*)(QC + (row0 + st * 16 + q16) * DM + h * 256 + kh * 128 + ks * 32 + g * 8);
        const LAS unsigned char* kb = lds + q16 * CA_STRIDE + kh * 256 + g * 16;
#pragma unroll
        for (int kt = 0; kt < 16; ++kt)
#pragma unroll
            for (int ks = 0; ks < 4; ++ks) { const bf16x8v a = *(const LAS bf16x8v*)(kb + kt * 16 * CA_STRIDE + ks * 64);
                S[0][kt] = __builtin_amdgcn_mfma_f32_16x16x32_bf16(a, qf[0][ks], S[0][kt], 0, 0, 0);
                S[1][kt] = __builtin_amdgcn_mfma_f32_16x16x32_bf16(a, qf[1][ks], S[1][kt], 0, 0, 0); }
    }
    const float c2 = 0.0625f * 1.4426950408889634f;
    float linv[2]; bf16x8v P[2][8];
#pragma unroll
    for (int st = 0; st < 2; ++st) {
        float m = -INFINITY;
#pragma unroll
        for (int kt = 0; kt < 16; ++kt) m = fmaxf(fmaxf(fmaxf(S[st][kt][0], S[st][kt][1]), fmaxf(S[st][kt][2], S[st][kt][3])), m);
        m = fmaxf(m, __shfl_xor(m, 16)); m = fmaxf(m, __shfl_xor(m, 32));
        const float mc = m * c2; float l = 0.f;
#pragma unroll
        for (int kt = 0; kt < 16; ++kt)
#pragma unroll
            for (int r = 0; r < 4; ++r) { const float p = __builtin_amdgcn_exp2f(S[st][kt][r] * c2 - mc); S[st][kt][r] = p; l += p; }
        l += __shfl_xor(l, 16); l += __shfl_xor(l, 32); linv[st] = 1.f / l;
#pragma unroll
        for (int c = 0; c < 8; ++c) { bf16x8v pk;
#pragma unroll
            for (int j = 0; j < 4; ++j) { pk[j] = (short)f2bf(S[st][2 * c][j]); pk[4 + j] = (short)f2bf(S[st][2 * c + 1][j]); }
            P[st][c] = pk; }
    }
    __syncthreads();
    { int tid2 = tid; asm volatile("" : "+v"(tid2));
      const bf16_t* src = VT + (size_t)(h * 256 + (tid2 >> 5)) * MMEM + b * NMEM + (tid2 & 31) * 8; LAS unsigned char* dst = lds + (tid2 >> 5) * CA_STRIDE + (tid2 & 31) * 16;
#pragma unroll
      for (int i = 0; i < 16; ++i) { const u32x4 v = *(const u32x4*)(src + (size_t)i * 16 * MMEM); *(LAS u32x4*)(dst + i * 16 * CA_STRIDE) = v; } }
    __syncthreads();
#pragma unroll 1
    for (int dh = 0; dh < 2; ++dh) {
        f32x4 O[2][8];
#pragma unroll
        for (int st = 0; st < 2; ++st)
#pragma unroll
            for (int dt = 0; dt < 8; ++dt) O[st][dt] = (f32x4){0.f, 0.f, 0.f, 0.f};
        const LAS unsigned char* pb = lds + (dh * 128 + q16) * CA_STRIDE + g * 8;
#pragma unroll
        for (int dt = 0; dt < 8; ++dt)
#pragma unroll
            for (int c = 0; c < 8; ++c) { const LAS unsigned char* p = pb + dt * 16 * CA_STRIDE + c * 64;
                const u32x2 lo = *(const LAS u32x2*)p, hi = *(const LAS u32x2*)(p + 32);
                const u32x4 av = (u32x4){lo.x, lo.y, hi.x, hi.y}; const bf16x8v a = __builtin_bit_cast(bf16x8v, av);
                O[0][dt] = __builtin_amdgcn_mfma_f32_16x16x32_bf16(a, P[0][c], O[0][dt], 0, 0, 0);
                O[1][dt] = __builtin_amdgcn_mfma_f32_16x16x32_bf16(a, P[1][c], O[1][dt], 0, 0, 0); }
#pragma unroll
        for (int st = 0; st < 2; ++st)
#pragma unroll
            for (int dt = 0; dt < 8; ++dt) { const f32x4 o = O[st][dt] * linv[st]; u32x2 w;
                w.x = (unsigned)f2bf(o[0]) | ((unsigned)f2bf(o[1]) << 16); w.y = (unsigned)f2bf(o[2]) | ((unsigned)f2bf(o[3]) << 16);
                *(u32x2*)(OC + (row0 + st * 16 + q16) * DM + h * 256 + dh * 128 + dt * 16 + g * 4) = w; }
    }
    __syncthreads();
}
typedef float f32x16v __attribute__((ext_vector_type(16)));
__device__ __forceinline__ unsigned code16(float s) {
    const _Float16 hf = (_Float16)s; unsigned u = (unsigned)__builtin_bit_cast(unsigned short, hf);
    if ((u & 0x7fffu) == 0u) u = 0u;
    return (u & 0x8000u) ? (~u & 0xffffu) : (u | 0x8000u);
}
__device__ __forceinline__ unsigned mbcnt64(unsigned long long m) { return __builtin_amdgcn_mbcnt_hi((unsigned)(m >> 32), __builtin_amdgcn_mbcnt_lo((unsigned)m, 0u)); }
__device__ __forceinline__ void topk_unit(LAS unsigned char* lds, int b, int j, const bf16_t* QI, const bf16_t* KI, const float* WI, unsigned short* SEL, int tid, int lane, int wave) {
    asm volatile("" : "+v"(tid), "+v"(lane));
    const int t0 = 16 * j, L = t0 + 16, nkt = (L + 31) >> 5;
    const size_t rowbase = (size_t)b * SEQ + t0;
    const int c32 = lane & 31, hi = lane >> 5;
    {
        bf16x8v qa[2][4]; f32x4 wq[2][4];
#pragma unroll
        for (int rt = 0; rt < 2; ++rt) {
#pragma unroll
            for (int ks = 0; ks < 4; ++ks) qa[rt][ks] = *(const bf16x8v*)(QI + (rowbase + 8 * rt + (c32 >> 2)) * 256 + (c32 & 3) * 64 + 16 * ks + 8 * hi);
#pragma unroll
            for (int gq = 0; gq < 4; ++gq) wq[rt][gq] = *(const f32x4*)(WI + (rowbase + 8 * rt + 2 * gq + hi) * 4);
        }
        const bf16_t* kbase = KI + ((size_t)b * SEQ + c32) * 64 + 8 * hi;
        bf16x8v kb[4], kn[4];
        int kt = wave;
        if (kt < nkt) {
#pragma unroll
            for (int ks = 0; ks < 4; ++ks) kb[ks] = *(const bf16x8v*)(kbase + (size_t)kt * 32 * 64 + 16 * ks);
        }
        for (; kt < nkt; kt += 8) {
            const int ktn = (kt + 8 < nkt) ? kt + 8 : kt;
#pragma unroll
            for (int ks = 0; ks < 4; ++ks) kn[ks] = *(const bf16x8v*)(kbase + (size_t)ktn * 32 * 64 + 16 * ks);
#pragma unroll
            for (int rt = 0; rt < 2; ++rt) {
                f32x16v c = {0.f, 0.f, 0.f, 0.f, 0.f, 0.f, 0.f, 0.f, 0.f, 0.f, 0.f, 0.f, 0.f, 0.f, 0.f, 0.f};
#pragma unroll
                for (int ks = 0; ks < 4; ++ks) c = __builtin_amdgcn_mfma_f32_32x32x16_bf16(qa[rt][ks], kb[ks], c, 0, 0, 0);
#pragma unroll
                for (int gq = 0; gq < 4; ++gq) {
                    const f32x4 w = wq[rt][gq];
                    const float sc = w[0] * fmaxf(c[4 * gq + 0], 0.f) + w[1] * fmaxf(c[4 * gq + 1], 0.f) + w[2] * fmaxf(c[4 * gq + 2], 0.f) + w[3] * fmaxf(c[4 * gq + 3], 0.f);
                    const int q = 8 * rt + 2 * gq + hi;
                    *(LAS unsigned short*)(lds + q * 8192 + (kt * 32 + c32) * 2) = (unsigned short)code16(sc);
                }
            }
#pragma unroll
            for (int ks = 0; ks < 4; ++ks) kb[ks] = kn[ks];
        }
    }
    __syncthreads();
#pragma unroll 1
    for (int qq = 0; qq < 2; ++qq) {
        const int q = 2 * wave + qq, t = t0 + q, n = t + 1;
        unsigned short* sel = SEL + (rowbase + q) * TOPK;
        if (n <= TOPK) {
#pragma unroll
            for (int i = 0; i < 4; ++i) { const int s = lane + 64 * i; if (s < n) sel[s] = (unsigned short)s; }
            continue;
        }
        const int nch = (n + 127) >> 7;
        unsigned lo[32], hi16[32];
        const LAS unsigned* row = (const LAS unsigned*)(lds + q * 8192) + lane;
#pragma unroll
        for (int c = 0; c < 32; ++c) {
            unsigned v = 0u; if (c < nch) v = row[64 * c];
            const int i0 = 128 * c + 2 * lane;
            lo[c] = (i0 <= t) ? (v & 0xffffu) : 0u; hi16[c] = (i0 + 1 <= t) ? (v >> 16) : 0u;
        }
        unsigned T = 0u;
#pragma unroll 1
        for (int bit = 15; bit >= 0; --bit) {
            const unsigned cand = T | (1u << bit); unsigned cnt = 0u;
#pragma unroll
            for (int c = 0; c < 32; ++c) if (c < nch) { cnt += (unsigned)__popcll(__ballot(lo[c] >= cand)); cnt += (unsigned)__popcll(__ballot(hi16[c] >= cand)); }
            if (cnt >= (unsigned)TOPK) T = cand;
        }
        unsigned cgt = 0u;
#pragma unroll
        for (int c = 0; c < 32; ++c) if (c < nch) { cgt += (unsigned)__popcll(__ballot(lo[c] > T)); cgt += (unsigned)__popcll(__ballot(hi16[c] > T)); }
        const unsigned need = (unsigned)TOPK - cgt;
        unsigned eqrun = 0u, selrun = 0u;
#pragma unroll
        for (int c = 0; c < 32; ++c) if (c < nch) {
            const bool elo = lo[c] == T, ehi = hi16[c] == T;
            const unsigned long long melo = __ballot(elo), mehi = __ballot(ehi);
            const unsigned rank_lo = eqrun + mbcnt64(melo) + mbcnt64(mehi), rank_hi = rank_lo + (elo ? 1u : 0u);
            const bool tlo = (lo[c] > T) || (elo && rank_lo < need), thi = (hi16[c] > T) || (ehi && rank_hi < need);
            const unsigned long long mtlo = __ballot(tlo), mthi = __ballot(thi);
            const unsigned pos_lo = selrun + mbcnt64(mtlo) + mbcnt64(mthi), pos_hi = pos_lo + (tlo ? 1u : 0u);
            if (tlo && pos_lo < (unsigned)TOPK) sel[pos_lo] = (unsigned short)(128 * c + 2 * lane);
            if (thi && pos_hi < (unsigned)TOPK) sel[pos_hi] = (unsigned short)(128 * c + 2 * lane + 1);
            eqrun += (unsigned)__popcll(melo) + (unsigned)__popcll(mehi); selrun += (unsigned)__popcll(mtlo) + (unsigned)__popcll(mthi);
        }
    }
    __syncthreads();
}
__device__ __forceinline__ void topk_phase(LAS unsigned char* lds, int G, int vcu, const bf16_t* QI, const bf16_t* KI, const float* WI, unsigned short* SEL, int tid, int lane, int wave) {
    if (G == 256) {
        const int b = vcu >> 5, i = vcu & 31;
#pragma unroll 1
        for (int k = 0; k < 8; ++k) { const int j = 64 * (k >> 1) + ((k & 1) ? 63 - i : i); topk_unit(lds, b, j, QI, KI, WI, SEL, tid, lane, wave); }
    } else {
#pragma unroll 1
        for (int u = vcu; u < BATCH * 256; u += G) topk_unit(lds, u >> 8, u & 255, QI, KI, WI, SEL, tid, lane, wave);
    }
}
typedef short v4i16_t __attribute__((ext_vector_type(4)));
constexpr int SV_STRIDE = 160, SV_WAVE_BYTES = 64 * SV_STRIDE;
__device__ __forceinline__ v4i16_t tr_read16(const LAS unsigned char* p) { return __builtin_amdgcn_ds_read_tr16_b64_v4i16((LAS v4i16_t*)p); }
__device__ __forceinline__ void sparse_attn_query(LAS unsigned char* wl, size_t row, int b, int t, const bf16_t* Q, const bf16_t* Kb, const bf16_t* Vb, const unsigned short* SEL, bf16_t* MIX, int lane) {
    const int n = (t + 1 < TOPK) ? t + 1 : TOPK, q16 = lane & 15, g = lane >> 4;
    const unsigned short* sel = SEL + row * TOPK;
    bf16x8v qf[2];
#pragma unroll
    for (int ks = 0; ks < 2; ++ks) { u32x4 v = (u32x4){0u, 0u, 0u, 0u}; if (q16 < 8) v = *(const u32x4*)(Q + row * 512 + q16 * 64 + ks * 32 + g * 8); qf[ks] = __builtin_bit_cast(bf16x8v, v); }
    f32x4 S[16];
    const bf16_t* kbat = Kb + (size_t)b * SEQ * 64 + g * 8;
#pragma unroll
    for (int kg = 0; kg < 4; ++kg) {
        bf16x8v kf[4][2];
#pragma unroll
        for (int i = 0; i < 4; ++i) { const int slot = 64 * kg + 16 * i + q16; unsigned idx = 0u; if (slot < n) idx = sel[slot];
#pragma unroll
            for (int ks = 0; ks < 2; ++ks) kf[i][ks] = *(const bf16x8v*)(kbat + (size_t)idx * 64 + ks * 32); }
#pragma unroll
        for (int i = 0; i < 4; ++i) { f32x4 c = (f32x4){0.f, 0.f, 0.f, 0.f};
            c = __builtin_amdgcn_mfma_f32_16x16x32_bf16(kf[i][0], qf[0], c, 0, 0, 0);
            c = __builtin_amdgcn_mfma_f32_16x16x32_bf16(kf[i][1], qf[1], c, 0, 0, 0); S[4 * kg + i] = c; }
    }
    const float c2 = 0.125f * 1.4426950408889634f;
    float m = -INFINITY;
#pragma unroll
    for (int kt = 0; kt < 16; ++kt)
#pragma unroll
        for (int r = 0; r < 4; ++r) { if (16 * kt + 4 * g + r >= n) S[kt][r] = -INFINITY; m = fmaxf(m, S[kt][r]); }
    m = fmaxf(m, __shfl_xor(m, 16)); m = fmaxf(m, __shfl_xor(m, 32));
    const float mc = m * c2; float l = 0.f;
#pragma unroll
    for (int kt = 0; kt < 16; ++kt)
#pragma unroll
        for (int r = 0; r < 4; ++r) { const float p = __builtin_amdgcn_exp2f(S[kt][r] * c2 - mc); S[kt][r] = p; l += p; }
    l += __shfl_xor(l, 16); l += __shfl_xor(l, 32);
    const float linv = 1.f / l;
    bf16x8v P[8];
#pragma unroll
    for (int c = 0; c < 8; ++c) { bf16x8v pk;
#pragma unroll
        for (int j = 0; j < 4; ++j) { pk[j] = (short)f2bf(S[2 * c][j]); pk[4 + j] = (short)f2bf(S[2 * c + 1][j]); }
        P[c] = pk; }
    f32x4 O[4];
#pragma unroll
    for (int dt = 0; dt < 4; ++dt) O[dt] = (f32x4){0.f, 0.f, 0.f, 0.f};
    const bf16_t* vbat = Vb + (size_t)b * SEQ * 64 + (lane & 7) * 8;
    LAS unsigned char* wdst = wl + (lane >> 3) * SV_STRIDE + (lane & 7) * 16;
    const LAS unsigned char* rsrc = wl + (4 * g + (q16 >> 2)) * SV_STRIDE + (q16 & 3) * 8;
#pragma unroll
    for (int cc = 0; cc < 4; ++cc) {
        u32x4 vv[8];
#pragma unroll
        for (int i = 0; i < 8; ++i) { const int slot = 64 * cc + (lane >> 3) + 8 * i; unsigned idx = 0u; if (slot < n) idx = sel[slot]; vv[i] = *(const u32x4*)(vbat + (size_t)idx * 64); }
#pragma unroll
        for (int i = 0; i < 8; ++i) *(LAS u32x4*)(wdst + i * 8 * SV_STRIDE) = vv[i];
        asm volatile("s_waitcnt lgkmcnt(0)" ::: "memory");
#pragma unroll
        for (int c2i = 0; c2i < 2; ++c2i)
#pragma unroll
            for (int dt = 0; dt < 4; ++dt) { const LAS unsigned char* p = rsrc + c2i * 32 * SV_STRIDE + dt * 32;
                const v4i16_t lo = tr_read16(p), hi = tr_read16(p + 16 * SV_STRIDE);
                const bf16x8v a = (bf16x8v){lo[0], lo[1], lo[2], lo[3], hi[0], hi[1], hi[2], hi[3]};
                O[dt] = __builtin_amdgcn_mfma_f32_16x16x32_bf16(a, P[2 * cc + c2i], O[dt], 0, 0, 0); }
        asm volatile("s_waitcnt lgkmcnt(0)" ::: "memory");
    }
    if (q16 < 8) {
#pragma unroll
        for (int dt = 0; dt < 4; ++dt) { const f32x4 o = O[dt] * linv; u32x2 w;
            w.x = (unsigned)f2bf(o[0]) | ((unsigned)f2bf(o[1]) << 16); w.y = (unsigned)f2bf(o[2]) | ((unsigned)f2bf(o[3]) << 16);
            *(u32x2*)(MIX + row * DM + q16 * 64 + dt * 16 + g * 4) = w; }
    }
}
__device__ __forceinline__ void sparse_attn_phase(LAS unsigned char* lds, int G, int vcu, const bf16_t* Q, const bf16_t* Kb, const bf16_t* Vb, const unsigned short* SEL, bf16_t* MIX, int lane, int wave) {
    asm volatile("" : "+v"(lane));
    LAS unsigned char* wl = lds + wave * SV_WAVE_BYTES;
    if (G == 256) {
        const int b = vcu >> 5, ws = (vcu & 31) * 8 + wave;
#pragma unroll 1
        for (int k = 0; k < 16; ++k) { const int t = ws + 256 * k; sparse_attn_query(wl, (size_t)b * SEQ + t, b, t, Q, Kb, Vb, SEL, MIX, lane); }
    } else {
#pragma unroll 1
        for (int r = vcu * 8 + wave; r < MTOK; r += G * 8) sparse_attn_query(wl, (size_t)r, r / SEQ, r % SEQ, Q, Kb, Vb, SEL, MIX, lane);
    }
    __syncthreads();
}

__device__ __forceinline__ int wt_dst_row(int mode, int c) {
    if (mode == 0) return c;
    if (mode == 2) return 256 * (c >> 7) + (c & 127);
    if (mode == 3) return 256 * (c >> 7) + 128 + (c & 127);
    if (c < 512) return (c & ~63) + dperm(c & 63);
    if (c < 576) return 512 + dperm(c - 512);
    if (c < 640) return c;
    if (c < 896) return 768 + ((c - 640) & ~63) + dperm((c - 640) & 63);
    if (c < 960) return 640 + dperm(c - 896);
    if (c < 964) return 704 + (c - 960);
    if (c < 1476) { const int j = c - 964; return 1024 + 256 * (j >> 7) + (j & 127); }
    { const int j = c - 1476; return 1024 + 256 * (j >> 7) + 128 + (j & 127); }
}
__device__ __forceinline__ void wt_body(LAS unsigned char* sm, int vb, int tid, const float* __restrict__ W, int K, int N, bf16_t* WT, const float* __restrict__ gain, int mode) {
    LAS float* t = (LAS float*)sm;
    const int nbx = (N + 31) / 32; const int k0 = (vb / nbx) * 32, n0 = (vb % nbx) * 32, tx = tid & 31, ty = tid >> 5;
    for (int i = ty; i < 32; i += 8) { const int k = k0 + i, n = n0 + tx; float v = 0.f; if (k < K && n < N) { v = W[(size_t)k * N + n]; if (gain) v *= gain[k]; } t[i * 33 + tx] = v; }
    __syncthreads();
    for (int i = ty; i < 32; i += 8) { const int n = n0 + i, k = k0 + tx; if (n < N && k < K) WT[(size_t)wt_dst_row(mode, n) * K + k] = f2bf(t[tx * 33 + i]); }
    __syncthreads();
}
__device__ __forceinline__ void rmsnorm_bf16_row(const float* x, const float* __restrict__ g, bf16_t* out, int row, int lane) {
    const f32x4* xr = (const f32x4*)(x + (size_t)row * DM) + lane; const f32x4* gr = (const f32x4*)g + lane;
    f32x4 v[4]; float s = 0.f;
#pragma unroll
    for (int j = 0; j < 4; ++j) { v[j] = xr[64 * j]; s += (v[j].x * v[j].x + v[j].y * v[j].y) + (v[j].z * v[j].z + v[j].w * v[j].w); }
    const float rstd = 1.f / sqrtf(wave_sum(s) * (1.f / DM) + EPS);
    u32x2* o = (u32x2*)(out + (size_t)row * DM) + lane;
#pragma unroll
    for (int j = 0; j < 4; ++j) { const f32x4 gg = gr[64 * j]; u32x2 w;
        w.x = (unsigned)f2bf(v[j].x * rstd * gg.x) | ((unsigned)f2bf(v[j].y * rstd * gg.y) << 16);
        w.y = (unsigned)f2bf(v[j].z * rstd * gg.z) | ((unsigned)f2bf(v[j].w * rstd * gg.w) << 16); o[64 * j] = w; }
}
__device__ __forceinline__ void rmsnorm_f32_row(float* x, const float* __restrict__ g, int row, int lane) {
    f32x4* xr = (f32x4*)(x + (size_t)row * DM) + lane; const f32x4* gr = (const f32x4*)g + lane;
    f32x4 v[4]; float s = 0.f;
#pragma unroll
    for (int j = 0; j < 4; ++j) { v[j] = xr[64 * j]; s += (v[j].x * v[j].x + v[j].y * v[j].y) + (v[j].z * v[j].z + v[j].w * v[j].w); }
    const float rstd = 1.f / sqrtf(wave_sum(s) * (1.f / DM) + EPS);
#pragma unroll
    for (int j = 0; j < 4; ++j) { const f32x4 gg = gr[64 * j]; xr[64 * j] = v[j] * rstd * gg; }
}
__device__ __forceinline__ float rope_val(const LAS float* p, int base, int d, const LAS float* cs, const LAS float* sn) {
    if (d < 8) return p[base + d] * cs[d] - p[base + d + 8] * sn[d];
    if (d < 16) return p[base + d] * cs[d - 8] + p[base + d - 8] * sn[d - 8];
    return p[base + d];
}
__device__ __forceinline__ void split_rope_body(LAS unsigned char* sm, int row, int tid, const float* proj, const int* __restrict__ positions, bf16_t* Q, bf16_t* Kb, bf16_t* Vb, bf16_t* QI, bf16_t* KI, float* WI, bf16_t* U) {
    LAS float* p = (LAS float*)sm; LAS float* cs = p + INP; LAS float* sn = cs + 8;
    for (int c = tid; c < INP; c += 256) p[c] = proj[(size_t)row * INP + c];
    if (tid < 8) { const float freq = (float)pow(500000.0, -0.125 * (double)tid); const float ang = (float)positions[row] * freq; cs[tid] = (float)cos((double)ang); sn[tid] = (float)sin((double)ang); }
    __syncthreads();
    for (int c = tid; c < 512; c += 256) Q[(size_t)row * 512 + c] = f2bf(rope_val(p, (c >> 6) * 64, c & 63, cs, sn));
    if (tid < 64) Kb[(size_t)row * 64 + tid] = f2bf(rope_val(p, 512, tid, cs, sn));
    else if (tid < 128) Vb[(size_t)row * 64 + tid - 64] = f2bf(p[576 + tid - 64]);
    else if (tid < 192) KI[(size_t)row * 64 + tid - 128] = f2bf(rope_val(p, 896, tid - 128, cs, sn));
    else if (tid < 196) WI[(size_t)row * 4 + tid - 192] = p[960 + tid - 192] * 0.5f;
    QI[(size_t)row * 256 + tid] = f2bf(rope_val(p, 640 + (tid >> 6) * 64, tid & 63, cs, sn) * 0.125f);
    for (int c = tid; c < 512; c += 256) { const float ga = p[964 + c], gg = p[1476 + c]; U[(size_t)row * 512 + c] = f2bf(ga / (1.f + __expf(-gg))); }
    __syncthreads();
}
__device__ __forceinline__ unsigned fkey(float s) { unsigned u = __float_as_uint(s); if ((u << 1) == 0u) u = 0u; return (u & 0x80000000u) ? ~u : (u | 0x80000000u); }
__device__ __forceinline__ void topk_body(LAS unsigned char* sm, int row, int tid, const bf16_t* QI, const bf16_t* KI, const float* WI, unsigned short* SEL) {
    LAS float* qs = (LAS float*)sm; LAS unsigned* key = (LAS unsigned*)(sm + 1024); LAS unsigned* scan = (LAS unsigned*)(sm + 1024 + 16384); LAS unsigned* cntp = (LAS unsigned*)(sm + 1024 + 16384 + 1024);
    const int b = row / SEQ, t = row % SEQ, n = t + 1;
    unsigned short* sel = SEL + (size_t)row * TOPK;
    if (n <= TOPK) { if (tid < n) sel[tid] = (unsigned short)tid; return; }
    qs[tid] = bf2f(QI[(size_t)row * 256 + tid]);
    const float w0 = WI[(size_t)row * 4 + 0], w1 = WI[(size_t)row * 4 + 1], w2 = WI[(size_t)row * 4 + 2], w3 = WI[(size_t)row * 4 + 3];
    __syncthreads();
    for (int s = tid; s < n; s += 256) {
        const u32x4* kp = (const u32x4*)(KI + ((size_t)b * SEQ + s) * 64);
        float a0 = 0.f, a1 = 0.f, a2 = 0.f, a3 = 0.f;
#pragma unroll 2
        for (int c = 0; c < 8; ++c) { const u32x4 kv = kp[c];
#pragma unroll
            for (int e = 0; e < 4; ++e) { const float klo = __uint_as_float(kv[e] << 16), khi = __uint_as_float(kv[e] & 0xffff0000u); const int d = c * 8 + e * 2;
                a0 += qs[d] * klo + qs[d + 1] * khi; a1 += qs[64 + d] * klo + qs[64 + d + 1] * khi; a2 += qs[128 + d] * klo + qs[128 + d + 1] * khi; a3 += qs[192 + d] * klo + qs[192 + d + 1] * khi; } }
        const float sc = w0 * fmaxf(a0, 0.f) + w1 * fmaxf(a1, 0.f) + w2 * fmaxf(a2, 0.f) + w3 * fmaxf(a3, 0.f);
        key[s] = fkey(sc);
    }
    __syncthreads();
    unsigned prefix = 0u;
    for (int bit = 31; bit >= 0; --bit) {
        const unsigned cand = prefix | (1u << bit);
        if (tid == 0) *cntp = 0u;
        __syncthreads();
        unsigned c = 0u; for (int s = tid; s < n; s += 256) c += (key[s] >= cand) ? 1u : 0u;
        if (c) atomicAdd((unsigned*)cntp, c);
        __syncthreads();
        if (*cntp >= (unsigned)TOPK) prefix = cand;
        __syncthreads();
    }
    if (tid == 0) *cntp = 0u;
    __syncthreads();
    { unsigned c = 0u; for (int s = tid; s < n; s += 256) c += (key[s] > prefix) ? 1u : 0u; if (c) atomicAdd((unsigned*)cntp, c); }
    __syncthreads();
    const unsigned need = (unsigned)TOPK - *cntp;
    __syncthreads();
    const int s0 = tid * 16; unsigned eqc = 0u;
    for (int i = 0; i < 16; ++i) { const int s = s0 + i; if (s < n && key[s] == prefix) ++eqc; }
    scan[tid] = eqc; __syncthreads();
    for (int o = 1; o < 256; o <<= 1) { const unsigned v = (tid >= o) ? scan[tid - o] : 0u; __syncthreads(); scan[tid] += v; __syncthreads(); }
    unsigned eq_before = scan[tid] - eqc; __syncthreads();
    unsigned takec = 0u; unsigned takemask = 0u;
    for (int i = 0; i < 16; ++i) { const int s = s0 + i; if (s < n) { const unsigned k = key[s]; bool take = k > prefix; if (k == prefix) { take = eq_before < need; ++eq_before; } if (take) { ++takec; takemask |= 1u << i; } } }
    scan[tid] = takec; __syncthreads();
    for (int o = 1; o < 256; o <<= 1) { const unsigned v = (tid >= o) ? scan[tid - o] : 0u; __syncthreads(); scan[tid] += v; __syncthreads(); }
    unsigned pos = scan[tid] - takec;
    for (int i = 0; i < 16; ++i) if (takemask & (1u << i)) { if (pos < (unsigned)TOPK) sel[pos] = (unsigned short)(s0 + i); ++pos; }
    __syncthreads();
}
__device__ __forceinline__ void sparse_attn_body(LAS unsigned char* sm, int row, int tid, const bf16_t* Q, const bf16_t* Kb, const bf16_t* Vb, const unsigned short* SEL, bf16_t* MIX) {
    LAS float* qs = (LAS float*)sm; LAS float* lg = qs + 512;   LAS int* idx = (LAS int*)(lg + NH * TOPK);
    const int b = row / SEQ, t = row % SEQ, n = (t + 1 < TOPK) ? t + 1 : TOPK;
    qs[tid] = bf2f(Q[(size_t)row * 512 + tid]); qs[tid + 256] = bf2f(Q[(size_t)row * 512 + 256 + tid]);
    int myidx = 0; if (tid < n) myidx = (int)SEL[(size_t)row * TOPK + tid]; idx[tid] = myidx;
    __syncthreads();
    if (tid < n) {
        const u32x4* kp = (const u32x4*)(Kb + ((size_t)b * SEQ + myidx) * 64);
        float a[NH];
#pragma unroll
        for (int h = 0; h < NH; ++h) a[h] = 0.f;
#pragma unroll 2
        for (int c = 0; c < 8; ++c) { const u32x4 kv = kp[c];
#pragma unroll
            for (int e = 0; e < 4; ++e) { const float klo = __uint_as_float(kv[e] << 16), khi = __uint_as_float(kv[e] & 0xffff0000u); const int d = c * 8 + e * 2;
#pragma unroll
                for (int h = 0; h < NH; ++h) a[h] += qs[h * 64 + d] * klo + qs[h * 64 + d + 1] * khi; } }
#pragma unroll
        for (int h = 0; h < NH; ++h) lg[h * TOPK + tid] = a[h] * 0.125f;
    } else {
#pragma unroll
        for (int h = 0; h < NH; ++h) lg[h * TOPK + tid] = -INFINITY;
    }
    __syncthreads();
    { const int w = tid >> 6, lane = tid & 63;
      for (int hh = 0; hh < 2; ++hh) { const int h = 2 * w + hh; float v[4], m = -INFINITY;
          for (int i = 0; i < 4; ++i) { v[i] = lg[h * TOPK + lane + 64 * i]; m = fmaxf(m, v[i]); }
          m = wave_max(m); float s = 0.f;
          for (int i = 0; i < 4; ++i) { v[i] = __expf(v[i] - m); s += v[i]; }
          s = wave_sum(s); const float inv = 1.f / s;
          for (int i = 0; i < 4; ++i) lg[h * TOPK + lane + 64 * i] = v[i] * inv; } }
    __syncthreads();
    { const int h = tid >> 5, d0 = (tid & 31) * 2; float o0 = 0.f, o1 = 0.f;
      for (int j = 0; j < n; ++j) { const unsigned vv = *(const unsigned*)(Vb + ((size_t)b * SEQ + idx[j]) * 64 + d0); const float p = lg[h * TOPK + j]; o0 += p * __uint_as_float(vv << 16); o1 += p * __uint_as_float(vv & 0xffff0000u); }
      *(unsigned*)(MIX + (size_t)row * DM + h * 64 + d0) = (unsigned)f2bf(o0) | ((unsigned)f2bf(o1) << 16); }
    __syncthreads();
}
__device__ __forceinline__ void convb_body(LAS unsigned char* sm, int row, int tid, const bf16_t* U, const float* __restrict__ cw, const float* __restrict__ cb, const float* __restrict__ lg, const float* __restrict__ lb, bf16_t* MIX) {
    LAS float* red = (LAS float*)sm;
    const int t = row % SEQ;
    float y[2];
    for (int k = 0; k < 2; ++k) { const int c = tid + 256 * k; float acc = cb[c];
        for (int j = 0; j < 31; ++j) { const int tt = t - 30 + j; if (tt >= 0) acc += cw[j * 512 + c] * bf2f(U[(size_t)(row - 30 + j) * 512 + c]); }
        y[k] = acc; }
    float s = wave_sum(y[0] + y[1]); if ((tid & 63) == 0) red[tid >> 6] = s; __syncthreads();
    const float mu = (red[0] + red[1] + red[2] + red[3]) * (1.f / 512.f); __syncthreads();
    float q = wave_sum((y[0] - mu) * (y[0] - mu) + (y[1] - mu) * (y[1] - mu)); if ((tid & 63) == 0) red[4 + (tid >> 6)] = q; __syncthreads();
    const float rstd = 1.f / sqrtf((red[4] + red[5] + red[6] + red[7]) * (1.f / 512.f) + EPS);
    for (int k = 0; k < 2; ++k) { const int c = tid + 256 * k; const float v = (y[k] - mu) * rstd * lg[c] + lb[c]; MIX[(size_t)row * DM + 512 + c] = f2bf(silu_f(v)); }
    __syncthreads();
}
__device__ __forceinline__ void cross_attn_body(LAS unsigned char* sm, int row, int tid, const bf16_t* QC, const bf16_t* KC, const bf16_t* VC, bf16_t* OC) {
    LAS float* qs = (LAS float*)sm; LAS float* lg = qs + DM;
    const int b = row / SEQ;
    for (int c = tid; c < DM; c += 256) qs[c] = bf2f(QC[(size_t)row * DM + c]);
    __syncthreads();
    { const u32x4* kp = (const u32x4*)(KC + ((size_t)b * NMEM + tid) * DM);
      for (int h = 0; h < 4; ++h) { float a = 0.f;
#pragma unroll 4
          for (int c = 0; c < 32; ++c) { const u32x4 kv = kp[h * 32 + c];
#pragma unroll
              for (int e = 0; e < 4; ++e) { const int d = h * 256 + c * 8 + e * 2; a += qs[d] * __uint_as_float(kv[e] << 16) + qs[d + 1] * __uint_as_float(kv[e] & 0xffff0000u); } }
          lg[h * NMEM + tid] = a * 0.0625f; } }
    __syncthreads();
    { const int h = tid >> 6, lane = tid & 63; float v[4], m = -INFINITY;
      for (int i = 0; i < 4; ++i) { v[i] = lg[h * NMEM + lane + 64 * i]; m = fmaxf(m, v[i]); }
      m = wave_max(m); float s = 0.f;
      for (int i = 0; i < 4; ++i) { v[i] = __expf(v[i] - m); s += v[i]; }
      s = wave_sum(s); const float inv = 1.f / s;
      for (int i = 0; i < 4; ++i) lg[h * NMEM + lane + 64 * i] = v[i] * inv; }
    __syncthreads();
    { const int h = tid >> 6, d0 = h * 256 + (tid & 63) * 4; float o0 = 0.f, o1 = 0.f, o2 = 0.f, o3 = 0.f;
      for (int j = 0; j < NMEM; ++j) { const u32x2 vv = *(const u32x2*)(VC + ((size_t)b * NMEM + j) * DM + d0); const float p = lg[h * NMEM + j];
          o0 += p * __uint_as_float(vv.x << 16); o1 += p * __uint_as_float(vv.x & 0xffff0000u); o2 += p * __uint_as_float(vv.y << 16); o3 += p * __uint_as_float(vv.y & 0xffff0000u); }
      u32x2 w; w.x = (unsigned)f2bf(o0) | ((unsigned)f2bf(o1) << 16); w.y = (unsigned)f2bf(o2) | ((unsigned)f2bf(o3) << 16); *(u32x2*)(OC + (size_t)row * DM + d0) = w; }
    __syncthreads();
}


constexpr size_t MiB = 1u << 20;
constexpr int LDS_USER = 139264, LDSCTL_OFF = LDS_USER, MISC_OFF = LDSCTL_OFF + 320, LDS_BYTES = 147456;
constexpr size_t WS_CTL = 476 * MiB, CTL_ZERO_BYTES = 1 * MiB; constexpr int CW_BAR = 4096;
constexpr int NGU = 2 * DFF;
struct Args { const float* in[23]; float* out; unsigned char* ws; };
static_assert(sizeof(Args) == 25 * 8, "Args has no padding");

__global__ void __launch_bounds__(512, 2) mega_k(Args a) {
    extern __shared__ __attribute__((aligned(16))) unsigned char lds_raw[];
    LAS unsigned char* lds = (LAS unsigned char*)lds_raw;
    const int tid = threadIdx.x, lane = tid & 63, wave = __builtin_amdgcn_readfirstlane(tid >> 6), half = tid >> 8, htid = tid & 255;
    const int G = gridDim.x, bx = blockIdx.x; const int vcu = (G % 8 == 0) ? (bx % 8) * (G / 8) + bx / 8 : bx;
    LAS unsigned char* hsm = lds + half * 65536;
    const float* x = a.in[0]; const float* mem = a.in[1]; const int* positions = (const int*)a.in[2];
    const float* g_mix = a.in[3]; const float* w_in = a.in[4]; const float* w_out = a.in[5];
    const float* conv_b_w = a.in[6]; const float* conv_b_b = a.in[7]; const float* ln_b_g = a.in[8]; const float* ln_b_b = a.in[9];
    const float* g_cross = a.in[10]; const float* g_mem = a.in[11];
    const float* w_q = a.in[12]; const float* w_k = a.in[13]; const float* w_v = a.in[14]; const float* w_o = a.in[15];
    const float* g_ffn = a.in[16]; const float* w_gate = a.in[17]; const float* w_up = a.in[18];
    const float* ffn_cw = a.in[19]; const float* ffn_cb = a.in[20]; const float* w_down = a.in[21]; const float* g_final = a.in[22];
    float* out = a.out; unsigned char* ws = a.ws;
    bf16_t* wt_in = (bf16_t*)(ws + 0 * MiB); bf16_t* wt_out = (bf16_t*)(ws + 4 * MiB);
    bf16_t* wt_q = (bf16_t*)(ws + 6 * MiB), *wt_k = (bf16_t*)(ws + 8 * MiB), *wt_v = (bf16_t*)(ws + 10 * MiB), *wt_o = (bf16_t*)(ws + 12 * MiB);
    bf16_t* wt_gu = (bf16_t*)(ws + 14 * MiB); bf16_t* wt_down = (bf16_t*)(ws + 26 * MiB);
    float* WI = (float*)(ws + 32 * MiB); float* CS = (float*)(ws + 33 * MiB);
    float* SS1 = (float*)(ws + 35 * MiB); float* SS2 = (float*)(ws + 37 * MiB); float* SS3 = (float*)(ws + 39 * MiB);
    bf16_t* MEMN = (bf16_t*)(ws + 41 * MiB), *KC = (bf16_t*)(ws + 45 * MiB), *VC = (bf16_t*)(ws + 49 * MiB);
    bf16_t* XB = (bf16_t*)(ws + 56 * MiB);
    bf16_t* Qb = (bf16_t*)(ws + 120 * MiB); bf16_t* QI = (bf16_t*)(ws + 152 * MiB);
    bf16_t* Kb = (bf16_t*)(ws + 168 * MiB), *Vb = (bf16_t*)(ws + 172 * MiB), *KI = (bf16_t*)(ws + 176 * MiB);
    bf16_t* U = (bf16_t*)(ws + 180 * MiB); unsigned short* SEL = (unsigned short*)(ws + 212 * MiB);
    bf16_t* MIX = (bf16_t*)(ws + 228 * MiB); bf16_t* QC = (bf16_t*)(ws + 292 * MiB); bf16_t* OC = (bf16_t*)(ws + 356 * MiB);
    bf16_t* Gb = (bf16_t*)(ws + 120 * MiB); bf16_t* UF = (bf16_t*)(ws + 296 * MiB);
    unsigned* ctl = (unsigned*)(ws + WS_CTL);

    for (int u = tid; u < (LDS_BYTES - LDSCTL_OFF) / 4; u += 512) ((LAS unsigned*)(lds + LDSCTL_OFF))[u] = 0u;
    __syncthreads();
    XcdBarrier bar = xcd_barrier_post(ctl + CW_BAR, (volatile LAS unsigned*)(lds + MISC_OFF) + 8);
#define GRID_BAR() xcd_barrier(bar)
#define FOR_VB(nvb) for (int vb = 2 * bx + half; vb < (nvb); vb += 2 * G)
#define GEMMX(EPI, EINIT, Aptr, Bptr, Mv, Nv, Kv) do { pg8::Gemm g_{Aptr, Bptr, Mv, Nv, Kv}; pg8::StaticOrder S_; S_.init(Mv, Nv, G, bx); EPI E_ EINIT; \
        pg8::gemm_phase<EPI, pg8::StaticOrder, true, true>(lds, g_, S_, E_); } while (0)
#define EI(...) {__VA_ARGS__}

    for (int i = bx * 512 + tid; i < 60 * DM; i += G * 512) wt_in[(size_t)708 * DM + i] = 0;
    FOR_VB(32 * 63) wt_body(hsm, vb, htid, w_in, DM, INC, wt_in, nullptr, 1);
    FOR_VB(32 * 32) wt_body(hsm, vb, htid, w_out, DM, DM, wt_out, nullptr, 0);
    FOR_VB(32 * 32) wt_body(hsm, vb, htid, w_q, DM, DM, wt_q, g_cross, 0);
    FOR_VB(32 * 32) wt_body(hsm, vb, htid, w_k, DM, DM, wt_k, nullptr, 0);
    FOR_VB(32 * 32) wt_body(hsm, vb, htid, w_v, DM, DM, wt_v, nullptr, 0);
    FOR_VB(32 * 32) wt_body(hsm, vb, htid, w_o, DM, DM, wt_o, nullptr, 0);
    FOR_VB(32 * 88) wt_body(hsm, vb, htid, w_gate, DM, DFF, wt_gu, g_ffn, 2);
    FOR_VB(32 * 88) wt_body(hsm, vb, htid, w_up, DM, DFF, wt_gu, g_ffn, 3);
    FOR_VB(88 * 32) wt_body(hsm, vb, htid, w_down, DFF, DM, wt_down, nullptr, 0);
    for (int i = bx * 512 + tid; i < MTOK * 8; i += G * 512) { const int row = i >> 3, k = i & 7;
        const float freq = (float)pow(500000.0, -0.125 * (double)k); const float ang = (float)positions[row] * freq;
        CS[(size_t)row * 16 + k] = (float)cos((double)ang); CS[(size_t)row * 16 + 8 + k] = (float)sin((double)ang); }
    for (int r = bx * 8 + wave; r < MTOK; r += G * 8) rmsnorm_bf16_row(x, g_mix, XB, r, lane);
    for (int r = bx * 8 + wave; r < MMEM; r += G * 8) rmsnorm_bf16_row(mem, g_mem, MEMN, r, lane);
    GRID_BAR();
    GEMMX(EpiIn, EI(CS, Qb, Kb, Vb, QI, KI, U, WI), XB, wt_in, MTOK, INP, DM);
    GEMMX(EpiStore, EI(nullptr, KC, nullptr, DM), MEMN, wt_k, MMEM, DM, DM);
    GEMMX(EpiStore, EI(nullptr, VC, nullptr, MMEM), wt_v, MEMN, DM, MMEM, DM);
    GRID_BAR();
    topk_phase(lds, G, vcu, QI, KI, WI, SEL, tid, lane, wave);
    FOR_VB(MTOK) convb_body(hsm, vb, htid, U, conv_b_w, conv_b_b, ln_b_g, ln_b_b, MIX);
    GRID_BAR();
    sparse_attn_phase(lds, G, vcu, Qb, Kb, Vb, SEL, MIX, lane, wave);
    GRID_BAR();
    GEMMX(EpiRes, EI(x, out, XB, SS1), MIX, wt_out, MTOK, DM, DM);
    GRID_BAR();
    GEMMX(EpiScale, EI(SS1, QC, DM, 1.0f), XB, wt_q, MTOK, DM, DM);
    GRID_BAR();
    { const int per = (512 + G - 1) / G; for (int i = 0; i < per; ++i) { const int u = vcu * per + i; if (u < 512) cross_attn_unit(lds, u >> 6, (u >> 4) & 3, u & 15, QC, KC, VC, OC, tid, lane, wave); } }
    GRID_BAR();
    GEMMX(EpiRes, EI(out, out, XB, SS2), OC, wt_o, MTOK, DM, DM);
    GRID_BAR();
    GEMMX(EpiGateUp, EI(SS2, Gb, UF), XB, wt_gu, MTOK, NGU, DM);
    GRID_BAR();
    for (int i = bx * 512 + tid; i < MTOK * (DFF / 8); i += G * 512) {
        const int row = i / (DFF / 8), c = (i - row * (DFF / 8)) * 8, t = row & (SEQ - 1); const size_t off = (size_t)row * DFF + c;
        const u32x4 g2 = *(const u32x4*)(Gb + off); u32x4 g1 = (u32x4){0u, 0u, 0u, 0u}, g0 = (u32x4){0u, 0u, 0u, 0u};
        if (t >= 1) g1 = *(const u32x4*)(Gb + off - DFF);
        if (t >= 2) g0 = *(const u32x4*)(Gb + off - 2 * DFF);
        const u32x4 uu = *(const u32x4*)(UF + off); u32x4 o;
#pragma unroll
        for (int e = 0; e < 4; ++e) { float r[2];
#pragma unroll
            for (int hh = 0; hh < 2; ++hh) { const int cc = c + 2 * e + hh;
                const float a2 = hh ? __uint_as_float(g2[e] & 0xffff0000u) : __uint_as_float(g2[e] << 16), a1 = hh ? __uint_as_float(g1[e] & 0xffff0000u) : __uint_as_float(g1[e] << 16), a0 = hh ? __uint_as_float(g0[e] & 0xffff0000u) : __uint_as_float(g0[e] << 16);
                const float uv = hh ? __uint_as_float(uu[e] & 0xffff0000u) : __uint_as_float(uu[e] << 16);
                const float gg = ffn_cb[cc] + ffn_cw[2 * DFF + cc] * a2 + ffn_cw[DFF + cc] * a1 + ffn_cw[cc] * a0;
                r[hh] = silu_f(gg) * uv; }
            o[e] = (unsigned)f2bf(r[0]) | ((unsigned)f2bf(r[1]) << 16); }
        *(u32x4*)(UF + off) = o;
    }
    GRID_BAR();
    GEMMX(EpiRes, EI(out, out, nullptr, SS3), UF, wt_down, MTOK, DM, DFF);
    GRID_BAR();
    for (int r = bx * 8 + wave; r < MTOK; r += G * 8) {
        const float rs = rstd_from_ss(SS3, (size_t)r);
        f32x4* xr = (f32x4*)(out + (size_t)r * DM) + lane; const f32x4* gr = (const f32x4*)g_final + lane;
#pragma unroll
        for (int j = 0; j < 4; ++j) xr[64 * j] = xr[64 * j] * rs * gr[64 * j];
    }
}

extern "C" void kernel_launch(void* const* d_in, const int* in_sizes, int n_in, void* d_out, int out_size, void* d_ws, size_t ws_size, hipStream_t stream) {
    static int grid = 0;
    if (grid == 0) {
        int dev = 0, cus = 0, per_cu = 0;
        if (hipGetDevice(&dev) != hipSuccess || hipDeviceGetAttribute(&cus, hipDeviceAttributeMultiprocessorCount, dev) != hipSuccess) { fprintf(stderr, "kernel_launch: device query failed\n"); grid = -1; return; }
        if (hipFuncSetAttribute((const void*)mega_k, hipFuncAttributeMaxDynamicSharedMemorySize, LDS_BYTES) != hipSuccess) { fprintf(stderr, "kernel_launch: hipFuncSetAttribute failed\n"); grid = -1; return; }
        if (hipOccupancyMaxActiveBlocksPerMultiprocessor(&per_cu, (const void*)mega_k, 512, LDS_BYTES) != hipSuccess || per_cu < 1) { fprintf(stderr, "kernel_launch: occupancy query says %d\n", per_cu); per_cu = 1; }
        (void)hipGetLastError();
        grid = cus * 1;
        if (n_in != 23 || ws_size < 477 * MiB) { fprintf(stderr, "kernel_launch: unexpected n_in %d / ws %zu\n", n_in, ws_size); grid = -1; return; }
    }
    if (grid < 0) return;
    (void)hipMemsetAsync((char*)d_ws + WS_CTL, 0, CTL_ZERO_BYTES, stream);
    Args a{};
    for (int i = 0; i < 23; ++i) a.in[i] = (const float*)d_in[i];
    a.out = (float*)d_out; a.ws = (unsigned char*)d_ws;
    void* params[] = {&a};
    hipError_t e = hipLaunchCooperativeKernel((const void*)mega_k, dim3(grid), dim3(512), params, LDS_BYTES, stream);
    if (e != hipSuccess) fprintf(stderr, "cooperative launch failed: %s (grid %d)\n", hipGetErrorString(e), grid);
}
```

```cpp
#include <hip/hip_runtime.h>
#include <cstdio>
#include <cstdint>
#include <cmath>
namespace pg8 {
#define PG8_LAS __attribute__((address_space(3)))
typedef unsigned short bf16_t;
typedef short bf16x8 __attribute__((ext_vector_type(8)));
typedef float f32x4 __attribute__((ext_vector_type(4)));
typedef unsigned u32x4 __attribute__((ext_vector_type(4)));
constexpr int BM = 256, BK = 64, HALF = 128, HTB = HALF * BK * 2  , STAGE_BYTES = 8 * HTB, NXCD = 8, WGM = 8;

__host__ __device__ __forceinline__ int lds_byte(int r, int c) { const int st = (r >> 4) * 2 + (c >> 5), rr = r & 15, cc = c & 31, ob = rr * 64 + cc * 2; return st * 1024 + (ob ^ (((ob >> 9) & 1) << 5)); }
__host__ __device__ __forceinline__ void stage_rc(int b, int& R, int& C) { const int st = b / 1024, sb = b % 1024, swz = sb ^ (((sb >> 9) & 1) << 5); R = (st >> 1) * 16 + swz / 64; C = (st & 1) * 32 + (swz % 64) / 2; }
__host__ __device__ __forceinline__ int perm32(int rho) { const int n = rho >> 4, i = rho & 15; return 8 * (i >> 2) + 4 * n + (i & 3); }

struct Unit { int pm, pn; };
struct Gemm { const bf16_t* A; const bf16_t* Bt; int M, N, K; };

struct StaticOrder {
    int nM, nN, nwg, G, c;
    __host__ __device__ void init(int M, int N, int G_, int c_) { nM = M / BM; nN = N / BM; nwg = nM * nN; G = G_; c = c_; }
    __host__ __device__ bool next(int i, Unit& u) const {
        const long L = (long)i * G + c; if (L >= nwg) return false;
        int wgid = (int)L; { const int q = nwg / NXCD, r = nwg % NXCD, xcd = wgid % NXCD, off = wgid / NXCD; wgid = (xcd < r ? xcd * (q + 1) : r * (q + 1) + (xcd - r) * q) + off; }
        const int nig = WGM * nN, gid = wgid / nig, fm = gid * WGM, gsz = (nM - fm) < WGM ? (nM - fm) : WGM;
        u.pm = fm + ((wgid % nig) % gsz); u.pn = (wgid % nig) / gsz; return true;
    }
    __device__ __forceinline__ void a_ready(const Unit&) const {}
    __device__ __forceinline__ void done(const Unit&) const {}
};
__device__ __forceinline__ unsigned cvt_pk_bf16(float lo, float hi) { unsigned r; asm volatile("v_cvt_pk_bf16_f32 %0, %1, %2" : "=v"(r) : "v"(lo), "v"(hi)); return r; }
template <class Epi, class Sched, bool ALIGN_EPI = false, bool SP2 = false>
__device__ __forceinline__ void gemm_phase(PG8_LAS unsigned char* lds, const Gemm g, const Sched& S, const Epi& E) {
    int tid_l = threadIdx.x; asm volatile("" : "+v"(tid_l));
    const int tid = tid_l, wid = __builtin_amdgcn_readfirstlane(tid >> 6), lane = tid & 63, wr = wid >> 2, wc = wid & 3, fr = lane & 15, fq = lane >> 4;
    const int K = g.K, nt = K / BK;
    unsigned voffA[2], voffB[2];
#pragma unroll
    for (int i = 0; i < 2; ++i) { int R, C; stage_rc(tid * 16 + i * 8192, R, C); const int Rb = Epi::PERM ? ((R & ~31) + perm32(R & 31)) : R;
        voffA[i] = (unsigned)(R * K + C) * 2u; voffB[i] = (unsigned)(Rb * K + C) * 2u; }
    const size_t kstep = (size_t)(BK * 2);
    const size_t hstep = (size_t)HALF * K * 2;
    const size_t tstep = 2 * hstep;
    const unsigned ldsw = (unsigned)wid * 1024u;
    const int aoff = lds_byte(wr * 64 + fr, fq * 8), boff = lds_byte(wc * 32 + fr, fq * 8);
#define PG8_SA(b, h) (((b) * 2 + (h)) * HTB)
#define PG8_SB(b, h) ((4 + (b) * 2 + (h)) * HTB)
#define PG8_STAGE(bufoff, gbase, voff) do { _Pragma("unroll") for (int _i = 0; _i < 2; ++_i) \
        __builtin_amdgcn_global_load_lds((const unsigned*)((const char*)(gbase) + (voff)[_i]), (PG8_LAS unsigned*)(lds + (bufoff) + ldsw + _i * 8192), 16, 0, 0); } while (0)
#define PG8_LDA(dst, b, h) do { _Pragma("unroll") for (int m = 0; m < 4; ++m) _Pragma("unroll") for (int k = 0; k < 2; ++k) dst[m][k] = *(const PG8_LAS bf16x8*)(lds + PG8_SA(b, h) + aoff + m * 2048 + k * 1024); } while (0)
#define PG8_LDB(dst, b, h) do { _Pragma("unroll") for (int n = 0; n < 2; ++n) _Pragma("unroll") for (int k = 0; k < 2; ++k) dst[n][k] = *(const PG8_LAS bf16x8*)(lds + PG8_SB(b, h) + boff + n * 2048 + k * 1024); } while (0)
#define PG8_MMA(ai, bj, At, Bt) do { __builtin_amdgcn_s_setprio(1); _Pragma("unroll") for (int m = 0; m < 4; ++m) _Pragma("unroll") for (int n = 0; n < 2; ++n) _Pragma("unroll") for (int k = 0; k < 2; ++k) \
        acc[ai][bj][m][n] = __builtin_amdgcn_mfma_f32_16x16x32_bf16(Bt[n][k], At[m][k], acc[ai][bj][m][n], 0, 0, 0); __builtin_amdgcn_s_setprio(0); } while (0)
#define PG8_WAIT_V(n) asm volatile("s_waitcnt vmcnt(" #n ")" ::: "memory")
#define PG8_WAIT_L(n) asm volatile("s_waitcnt lgkmcnt(" #n ")" ::: "memory")
#define PG8_BAR __builtin_amdgcn_s_barrier()
#define PG8_SCHED __builtin_amdgcn_sched_barrier(0)
    Unit cur, nxt; int ui = 0;
    if (!S.next(0, cur)) return;
    f32x4 acc[2][2][4][2];
#pragma unroll
    for (int a = 0; a < 2; ++a)
#pragma unroll
        for (int b = 0; b < 2; ++b)
#pragma unroll
            for (int m = 0; m < 4; ++m)
#pragma unroll
                for (int n = 0; n < 2; ++n) acc[a][b][m][n] = (f32x4){0.f, 0.f, 0.f, 0.f};
    bf16x8 At[4][2], B0[2][2], B1[2][2];
    const char* cA = (const char*)g.A + (size_t)cur.pm * tstep; const char* cB = (const char*)g.Bt + (size_t)cur.pn * tstep;
    S.a_ready(cur);
    if constexpr (SP2) {
        PG8_STAGE(PG8_SB(0, 0), cB, voffB); PG8_STAGE(PG8_SB(0, 1), cB + hstep, voffB); PG8_STAGE(PG8_SA(0, 0), cA, voffA); PG8_STAGE(PG8_SA(0, 1), cA + hstep, voffA);
        if (wr == 1) PG8_BAR;
        PG8_WAIT_V(2); PG8_BAR;
        PG8_STAGE(PG8_SB(1, 0), cB + kstep, voffB); PG8_STAGE(PG8_SA(1, 0), cA + kstep, voffA); PG8_STAGE(PG8_SB(1, 1), cB + hstep + kstep, voffB);
        PG8_WAIT_V(6); PG8_BAR;
    } else {
        PG8_STAGE(PG8_SB(0, 0), cB, voffB); PG8_STAGE(PG8_SA(0, 0), cA, voffA); PG8_STAGE(PG8_SB(0, 1), cB + hstep, voffB); PG8_STAGE(PG8_SA(0, 1), cA + hstep, voffA);
        if (wr == 1) PG8_BAR;
        PG8_WAIT_V(4); PG8_BAR;
        PG8_STAGE(PG8_SB(1, 0), cB + kstep, voffB); PG8_STAGE(PG8_SA(1, 0), cA + kstep, voffA); PG8_STAGE(PG8_SB(1, 1), cB + hstep + kstep, voffB);
        PG8_WAIT_V(6); PG8_BAR;
    }
    for (;;) {
        const bool has_next = S.next(ui + 1, nxt);
        const char* nA = has_next ? (const char*)g.A + (size_t)nxt.pm * tstep : cA; const char* nB = has_next ? (const char*)g.Bt + (size_t)nxt.pn * tstep : cB;
        for (int t = 0; t < nt; t += 2) {
            const bool last = (t == nt - 2);
            const char* a1 = cA + (size_t)(t + 1) * kstep;
            const char* a2 = last ? nA : cA + (size_t)(t + 2) * kstep; const char* b2 = last ? nB : cB + (size_t)(t + 2) * kstep;
            const char* a3 = a2 + kstep; const char* b3 = b2 + kstep;
            if (last && has_next) S.a_ready(nxt);
            if constexpr (SP2) {
            PG8_LDB(B0, 0, 0); PG8_LDB(B1, 0, 1); PG8_SCHED; PG8_LDA(At, 0, 0); PG8_STAGE(PG8_SA(1, 1), a1 + hstep, voffA);
            PG8_WAIT_V(8); PG8_WAIT_L(0); PG8_BAR; PG8_MMA(0, 0, At, B0); PG8_MMA(0, 1, At, B1); PG8_BAR; PG8_SCHED;
            PG8_LDA(At, 0, 1); PG8_STAGE(PG8_SB(0, 0), b2, voffB); PG8_STAGE(PG8_SB(0, 1), b2 + hstep, voffB); PG8_STAGE(PG8_SA(0, 0), a2, voffA);
            PG8_WAIT_V(8); PG8_WAIT_L(0); PG8_BAR; PG8_MMA(1, 0, At, B0); PG8_MMA(1, 1, At, B1); PG8_BAR; PG8_SCHED;
            PG8_LDB(B0, 1, 0); PG8_LDB(B1, 1, 1); PG8_SCHED; PG8_LDA(At, 1, 0); PG8_STAGE(PG8_SA(0, 1), a2 + hstep, voffA);
            PG8_WAIT_V(8); PG8_WAIT_L(0); PG8_BAR; PG8_MMA(0, 0, At, B0); PG8_MMA(0, 1, At, B1); PG8_BAR; PG8_SCHED;
            PG8_LDA(At, 1, 1); PG8_STAGE(PG8_SB(1, 0), b3, voffB); PG8_STAGE(PG8_SB(1, 1), b3 + hstep, voffB); PG8_STAGE(PG8_SA(1, 0), a3, voffA);
            PG8_WAIT_V(8); PG8_WAIT_L(0); PG8_BAR; PG8_MMA(1, 0, At, B0); PG8_MMA(1, 1, At, B1); PG8_BAR; PG8_SCHED;
            } else {
            PG8_LDB(B0, 0, 0); PG8_SCHED; PG8_LDA(At, 0, 0); PG8_STAGE(PG8_SA(1, 1), a1 + hstep, voffA);
            PG8_WAIT_L(8); PG8_BAR; PG8_WAIT_L(0); PG8_MMA(0, 0, At, B0); PG8_BAR; PG8_SCHED;
            PG8_LDB(B1, 0, 1); PG8_STAGE(PG8_SB(0, 0), b2, voffB);
            PG8_BAR; PG8_WAIT_L(0); PG8_MMA(0, 1, At, B1); PG8_BAR;
            PG8_LDA(At, 0, 1); PG8_STAGE(PG8_SA(0, 0), a2, voffA);
            PG8_BAR; PG8_WAIT_L(0); PG8_MMA(1, 0, At, B0); PG8_BAR; PG8_SCHED;
            PG8_STAGE(PG8_SB(0, 1), b2 + hstep, voffB);
            PG8_WAIT_V(6); PG8_BAR; PG8_MMA(1, 1, At, B1); PG8_BAR;
            PG8_LDB(B0, 1, 0); PG8_SCHED; PG8_LDA(At, 1, 0); PG8_STAGE(PG8_SA(0, 1), a2 + hstep, voffA);
            PG8_WAIT_L(8); PG8_BAR; PG8_WAIT_L(0); PG8_MMA(0, 0, At, B0); PG8_BAR; PG8_SCHED;
            PG8_LDB(B1, 1, 1); PG8_STAGE(PG8_SB(1, 0), b3, voffB);
            PG8_BAR; PG8_WAIT_L(0); PG8_MMA(0, 1, At, B1); PG8_BAR;
            PG8_LDA(At, 1, 1); PG8_STAGE(PG8_SA(1, 0), a3, voffA);
            PG8_BAR; PG8_WAIT_L(0); PG8_MMA(1, 0, At, B0); PG8_BAR; PG8_SCHED;
            PG8_STAGE(PG8_SB(1, 1), b3 + hstep, voffB);
            PG8_WAIT_V(6); PG8_BAR; PG8_MMA(1, 1, At, B1); PG8_BAR;
            }
        }
        if constexpr (ALIGN_EPI) { if (wr == 0) PG8_BAR; }
        if constexpr (!Epi::AFTER_DRAIN) { E(acc, cur, wr, wc, fr, fq); S.done(cur); }
        if (!has_next) break;
#pragma unroll
        for (int a = 0; a < 2; ++a)
#pragma unroll
            for (int b = 0; b < 2; ++b)
#pragma unroll
                for (int m = 0; m < 4; ++m)
#pragma unroll
                    for (int n = 0; n < 2; ++n) acc[a][b][m][n] = (f32x4){0.f, 0.f, 0.f, 0.f};
        cur = nxt; cA = nA; cB = nB; ++ui;
        if constexpr (ALIGN_EPI) { if (wr == 1) PG8_BAR; }
    }
    PG8_WAIT_V(0);
    if constexpr (!ALIGN_EPI) { if (wr == 0) PG8_BAR; }
    PG8_BAR;
    if constexpr (Epi::AFTER_DRAIN) { E.fused(acc, cur, wr, wc, fr, fq, lds, wid, lane); S.done(cur); }
#undef PG8_SA
#undef PG8_SB
#undef PG8_STAGE
#undef PG8_LDA
#undef PG8_LDB
#undef PG8_MMA
#undef PG8_WAIT_V
#undef PG8_WAIT_L
#undef PG8_BAR
#undef PG8_SCHED
}
}

constexpr int BATCH = 8, SEQ = 4096, DM = 1024, MTOK = BATCH * SEQ;
constexpr int NMEM = 256, MMEM = BATCH * NMEM;
constexpr int AW = 512, HD = 64, NH = 8, IH = 4, TOPK = 256;
constexpr int INC = 1988, INP = 2048;
constexpr int DFF = 2816;
constexpr float EPS = 1e-6f;
#define LAS __attribute__((address_space(3)))
typedef unsigned short bf16_t;
typedef float f32x4 __attribute__((ext_vector_type(4)));
typedef unsigned u32x4 __attribute__((ext_vector_type(4)));
typedef unsigned u32x2 __attribute__((ext_vector_type(2)));

__device__ __forceinline__ float bf2f(bf16_t v) { return __uint_as_float((unsigned)v << 16); }
__device__ __forceinline__ bf16_t f2bf(float f) { unsigned u = __float_as_uint(f); return (bf16_t)((u + 0x7fffu + ((u >> 16) & 1u)) >> 16); }
__device__ __forceinline__ float wave_sum(float v) {
#pragma unroll
    for (int o = 1; o < 64; o <<= 1) v += __shfl_xor(v, o);
    return v;
}
__device__ __forceinline__ float wave_max(float v) {
#pragma unroll
    for (int o = 1; o < 64; o <<= 1) v = fmaxf(v, __shfl_xor(v, o));
    return v;
}
__device__ __forceinline__ float silu_f(float v) { return v / (1.f + __expf(-v)); }

struct EpiStore {
    static constexpr bool PERM = false, AFTER_DRAIN = false;
    float* outf; bf16_t* outb; const float* res; int ldc;
    __device__ __forceinline__ void operator()(const pg8::f32x4 (&acc)[2][2][4][2], const pg8::Unit& u, int wr, int wc, int fr, int fq) const {
        const int col0 = u.pn * 256 + wc * 32 + 4 * fq;
#pragma unroll
        for (int ai = 0; ai < 2; ++ai)
#pragma unroll
            for (int m = 0; m < 4; ++m) {
                const size_t row = (size_t)(u.pm * 256 + ai * 128 + wr * 64 + m * 16 + fr);
#pragma unroll
                for (int bj = 0; bj < 2; ++bj)
#pragma unroll
                    for (int n = 0; n < 2; ++n) {
                        const size_t off = row * ldc + col0 + bj * 128 + n * 16;
                        pg8::f32x4 v = acc[ai][bj][m][n];
                        if (res) { const pg8::f32x4 r = *(const pg8::f32x4*)(res + off); v = v + r; }
                        if (outf) *(pg8::f32x4*)(outf + off) = v;
                        if (outb) { u32x2 w; w.x = (unsigned)f2bf(v[0]) | ((unsigned)f2bf(v[1]) << 16); w.y = (unsigned)f2bf(v[2]) | ((unsigned)f2bf(v[3]) << 16); *(u32x2*)(outb + off) = w; }
                    }
            }
    }
};
#define XB_TMO      128
#define XB_XCNT(j)  (256  + 64 * (j))
#define XB_XSUB(j)  (1280 + 64 * (j))
#define XB_XGEN(j)  (2304 + 64 * (j))
#define XB_TOP      3328
#define XB_TOPGEN   3392
#define XCD_BAR_WORDS 3456
#define XB_SPIN_CAP (1u << 18)

__device__ __forceinline__ unsigned xb_ld(unsigned* p)              { return __hip_atomic_load(p, __ATOMIC_RELAXED, __HIP_MEMORY_SCOPE_AGENT); }
__device__ __forceinline__ unsigned xb_add(unsigned* p, unsigned v) { return __hip_atomic_fetch_add(p, v, __ATOMIC_RELAXED, __HIP_MEMORY_SCOPE_AGENT); }
__device__ __forceinline__ unsigned xb_xcc_id() { return (unsigned)__builtin_amdgcn_s_getreg((3 << 11) | 20) & 0xFu; }
#define XB_SPIN(cond, bar) do { unsigned _sp = 0; while (cond) { __builtin_amdgcn_s_sleep(1); \
    if ((++_sp & 255u) == 0u) { if (xb_ld(&(bar)[XB_TMO])) break; if (_sp > XB_SPIN_CAP) { atomicAdd(&(bar)[XB_TMO], 1u); break; } } } } while (0)

struct XcdBarrier {
    unsigned* bar; unsigned x;
    volatile LAS unsigned* st;
};

__device__ __forceinline__ XcdBarrier xcd_barrier_post(unsigned* bar, volatile LAS unsigned* st) {
    XcdBarrier b; b.bar = bar; b.x = xb_xcc_id(); b.st = st;
    if (threadIdx.x == 0) (void)xb_add(&bar[XB_XCNT(b.x)], 1u);
    return b;
}
__device__ __forceinline__ void xcd_barrier_complete(unsigned* bar, unsigned x, unsigned& nloc, unsigned& nx) {
    const unsigned G = gridDim.x * gridDim.y * gridDim.z;
    unsigned sum, cnt, mine, sp = 0u;
    for (;;) {
        sum = 0u; cnt = 0u; mine = 0u;
#pragma unroll
        for (unsigned j = 0; j < 16; ++j) { const unsigned c = xb_ld(&bar[XB_XCNT(j)]); sum += c; cnt += (c > 0u) ? 1u : 0u; mine = (j == x) ? c : mine; }
        if (sum == G) break;
        __builtin_amdgcn_s_sleep(1);
        if ((++sp & 255u) == 0u) { if (xb_ld(&bar[XB_TMO])) break; if (sp > XB_SPIN_CAP) { atomicAdd(&bar[XB_TMO], 1u); break; } }
    }
    nloc = mine > 0u ? mine : 1u; nx = cnt > 0u ? cnt : 1u;
}

__device__ __forceinline__ void xcd_barrier(const XcdBarrier& b) {
    asm volatile("s_waitcnt vmcnt(0)" ::: "memory");
    __syncthreads();
    if (threadIdx.x == 0) {
        unsigned* bar = b.bar;
        __builtin_amdgcn_s_waitcnt(0);
        unsigned nloc = b.st[0], nx = b.st[1];
        if (nloc == 0u) { xcd_barrier_complete(bar, b.x, nloc, nx); b.st[0] = nloc; b.st[1] = nx; }
        const unsigned old = xb_add(&bar[XB_XSUB(b.x)], 1u);
        const unsigned gen = old / nloc;
        if (old + 1u == (gen + 1u) * nloc) {
            __builtin_amdgcn_fence(__ATOMIC_RELEASE, "agent");
            asm volatile("s_waitcnt vmcnt(0)" ::: "memory");
            const unsigned og = xb_add(&bar[XB_TOP], 1u);
            const unsigned tg = og / nx;
            if (og + 1u == (tg + 1u) * nx) xb_add(&bar[XB_TOPGEN], 1u);
            else XB_SPIN(xb_ld(&bar[XB_TOPGEN]) == tg, bar);
            __builtin_amdgcn_fence(__ATOMIC_ACQUIRE, "agent");
            xb_add(&bar[XB_XGEN(b.x)], 1u);
            asm volatile("s_waitcnt vmcnt(0)" ::: "memory");
        } else {
            XB_SPIN(xb_ld(&bar[XB_XGEN(b.x)]) == gen, bar);
            __builtin_amdgcn_fence(__ATOMIC_ACQUIRE, "agent");
            asm volatile("s_waitcnt vmcnt(0)" ::: "memory");
        }
    }
    __syncthreads();
}

__device__ __forceinline__ u32x4 pack8(const pg8::f32x4 a, const pg8::f32x4 b) {
    u32x4 w; w.x = pg8::cvt_pk_bf16(a[0], a[1]); w.y = pg8::cvt_pk_bf16(a[2], a[3]); w.z = pg8::cvt_pk_bf16(b[0], b[1]); w.w = pg8::cvt_pk_bf16(b[2], b[3]); return w;
}
__device__ __forceinline__ float sigmoid_f(float v) { return 1.f / (1.f + __expf(-v)); }
__host__ __device__ __forceinline__ int dperm(int pos) { return pos < 16 ? (4 * (pos >> 3) + (pos & 3) + 8 * ((pos >> 2) & 1)) : pos; }
__host__ __device__ __forceinline__ int in_orig_col(int n) {
    if (n < 512) return (n & ~63) + dperm(n & 63);
    if (n < 576) return 512 + dperm(n - 512);
    if (n < 640) return 576 + (n - 576);
    if (n < 704) return 896 + dperm(n - 640);
    if (n < 708) return 960 + (n - 704);
    if (n < 768) return -1;
    if (n < 1024) return 640 + ((n - 768) & ~63) + dperm((n - 768) & 63);
    const int i = (n - 1024) >> 8, c = (n - 1024) & 255;
    return c < 128 ? 964 + 128 * i + c : 1476 + 128 * i + (c - 128);
}
struct EpiIn {
    static constexpr bool PERM = true, AFTER_DRAIN = false;
    const float* cs; bf16_t *Q, *K, *V, *QI, *KI, *U; float* WI;
    __device__ __forceinline__ void operator()(const pg8::f32x4 (&acc)[2][2][4][2], const pg8::Unit& u, int wr, int wc, int fr, int fq) const {
        const int pn = u.pn;
        if (pn >= 4) {
            const int ch = 128 * (pn - 4) + 32 * wc + 8 * fq;
#pragma unroll
            for (int ai = 0; ai < 2; ++ai)
#pragma unroll
                for (int m = 0; m < 4; ++m) { const size_t row = (size_t)(u.pm * 256 + ai * 128 + wr * 64 + m * 16 + fr);
                    pg8::f32x4 a0 = acc[ai][0][m][0], a1 = acc[ai][0][m][1]; const pg8::f32x4 g0 = acc[ai][1][m][0], g1 = acc[ai][1][m][1];
#pragma unroll
                    for (int k = 0; k < 4; ++k) { a0[k] *= sigmoid_f(g0[k]); a1[k] *= sigmoid_f(g1[k]); }
                    *(u32x4*)(U + row * 512 + ch) = pack8(a0, a1); }
            return;
        }
        const bool rot = (pn == 2) ? (wc == 0 && fq < 2) : ((wc & 1) == 0 && fq < 2);
#pragma unroll
        for (int ai = 0; ai < 2; ++ai)
#pragma unroll
            for (int m = 0; m < 4; ++m) { const size_t row = (size_t)(u.pm * 256 + ai * 128 + wr * 64 + m * 16 + fr);
                pg8::f32x4 cv = {1.f, 1.f, 1.f, 1.f}, sv = {0.f, 0.f, 0.f, 0.f};
                if (rot) { cv = *(const pg8::f32x4*)(cs + row * 16 + 4 * fq); sv = *(const pg8::f32x4*)(cs + row * 16 + 8 + 4 * fq); }
#pragma unroll
                for (int bj = 0; bj < 2; ++bj) {
                    const pg8::f32x4 v0 = acc[ai][bj][m][0], v1 = acc[ai][bj][m][1];
                    pg8::f32x4 n0 = v0 * cv - v1 * sv, n1 = v1 * cv + v0 * sv;
                    if (!rot) { n0 = v0; n1 = v1; }
                    const int c = 128 * bj + 32 * wc + 8 * fq;
                    if (pn < 2) *(u32x4*)(Q + row * 512 + 256 * pn + c) = pack8(n0, n1);
                    else if (pn == 3) *(u32x4*)(QI + row * 256 + c) = pack8(n0 * 0.125f, n1 * 0.125f);
                    else {
                        if (bj == 0) { if (wc < 2) *(u32x4*)(K + row * 64 + 32 * wc + 8 * fq) = pack8(n0, n1); else *(u32x4*)(V + row * 64 + 32 * (wc - 2) + 8 * fq) = pack8(v0, v1); }
                        else { if (wc < 2) *(u32x4*)(KI + row * 64 + 32 * wc + 8 * fq) = pack8(n0, n1); else if (wc == 2 && fq == 0) *(pg8::f32x4*)(WI + row * 4) = v0 * 0.5f; }
                    }
                }
            }
    }
};
struct EpiRes {
    static constexpr bool PERM = true, AFTER_DRAIN = false;
    const float* res; float* out; bf16_t* xb; float* ss;
    __device__ __forceinline__ void operator()(const pg8::f32x4 (&acc)[2][2][4][2], const pg8::Unit& u, int wr, int wc, int fr, int fq) const {
#pragma unroll
        for (int ai = 0; ai < 2; ++ai)
#pragma unroll
            for (int m = 0; m < 4; ++m) { const size_t row = (size_t)(u.pm * 256 + ai * 128 + wr * 64 + m * 16 + fr); float q = 0.f;
#pragma unroll
                for (int bj = 0; bj < 2; ++bj) { const size_t off = row * DM + u.pn * 256 + 128 * bj + 32 * wc + 8 * fq;
                    const pg8::f32x4 v0 = acc[ai][bj][m][0] + *(const pg8::f32x4*)(res + off), v1 = acc[ai][bj][m][1] + *(const pg8::f32x4*)(res + off + 4);
                    *(pg8::f32x4*)(out + off) = v0; *(pg8::f32x4*)(out + off + 4) = v1;
                    if (xb) *(u32x4*)(xb + off) = pack8(v0, v1);
                    q += (v0[0] * v0[0] + v0[1] * v0[1]) + (v0[2] * v0[2] + v0[3] * v0[3]) + (v1[0] * v1[0] + v1[1] * v1[1]) + (v1[2] * v1[2] + v1[3] * v1[3]); }
                q += __shfl_xor(q, 16); q += __shfl_xor(q, 32);
                if (fq == 0) ss[row * 16 + u.pn * 4 + wc] = q; }
    }
};
__device__ __forceinline__ float rstd_from_ss(const float* ss, size_t row) {
    const pg8::f32x4 a = *(const pg8::f32x4*)(ss + row * 16), b = *(const pg8::f32x4*)(ss + row * 16 + 4), c = *(const pg8::f32x4*)(ss + row * 16 + 8), d = *(const pg8::f32x4*)(ss + row * 16 + 12);
    const float s = ((a[0] + a[1]) + (a[2] + a[3])) + ((b[0] + b[1]) + (b[2] + b[3])) + ((c[0] + c[1]) + (c[2] + c[3])) + ((d[0] + d[1]) + (d[2] + d[3]));
    return 1.f / sqrtf(s * (1.f / DM) + EPS);
}
struct EpiScale {
    static constexpr bool PERM = true, AFTER_DRAIN = false;
    const float* ss; bf16_t* O; int ldc; float scale;
    __device__ __forceinline__ void operator()(const pg8::f32x4 (&acc)[2][2][4][2], const pg8::Unit& u, int wr, int wc, int fr, int fq) const {
#pragma unroll
        for (int ai = 0; ai < 2; ++ai)
#pragma unroll
            for (int m = 0; m < 4; ++m) { const size_t row = (size_t)(u.pm * 256 + ai * 128 + wr * 64 + m * 16 + fr); const float r = rstd_from_ss(ss, row) * scale;
#pragma unroll
                for (int bj = 0; bj < 2; ++bj) *(u32x4*)(O + row * ldc + u.pn * 256 + 128 * bj + 32 * wc + 8 * fq) = pack8(acc[ai][bj][m][0] * r, acc[ai][bj][m][1] * r); }
    }
};
struct EpiGateUp {
    static constexpr bool PERM = true, AFTER_DRAIN = false;
    const float* ss; bf16_t* Gb; bf16_t* Ub;
    __device__ __forceinline__ void operator()(const pg8::f32x4 (&acc)[2][2][4][2], const pg8::Unit& u, int wr, int wc, int fr, int fq) const {
        const int ch = 128 * u.pn + 32 * wc + 8 * fq;
#pragma unroll
        for (int ai = 0; ai < 2; ++ai)
#pragma unroll
            for (int m = 0; m < 4; ++m) { const size_t row = (size_t)(u.pm * 256 + ai * 128 + wr * 64 + m * 16 + fr); const float r = rstd_from_ss(ss, row);
                *(u32x4*)(Gb + row * DFF + ch) = pack8(acc[ai][0][m][0] * r, acc[ai][0][m][1] * r);
                *(u32x4*)(Ub + row * DFF + ch) = pack8(acc[ai][1][m][0] * r, acc[ai][1][m][1] * r); }
    }
};
typedef short bf16x8v __attribute__((ext_vector_type(8)));
constexpr int CA_STRIDE = 528;
__device__ __forceinline__ void cross_attn_unit(LAS unsigned char* lds, int b, int h, int qb, const bf16_t* QC, const bf16_t* KC, const bf16_t* VT, bf16_t* OC, int tid, int lane, int wave) {
    const int q16 = lane & 15, g = lane >> 4;
    const size_t row0 = (size_t)b * SEQ + (size_t)qb * 256 + wave * 32;
    asm volatile("" : "+v"(tid));
    { const bf16_t* src = KC + ((size_t)b * NMEM + (tid >> 5)) * DM + h * 256 + (tid & 31) * 8; LAS unsigned char* dst = lds + (tid >> 5) * CA_STRIDE + (tid & 31) * 16;
#pragma unroll
      for (int i = 0; i < 16; ++i) { const u32x4 v = *(const u32x4*)(src + (size_t)i * 16 * DM); *(LAS u32x4*)(dst + i * 16 * CA_STRIDE) = v; } }
    __syncthreads();
    f32x4 S[2][16];
#pragma unroll
    for (int st = 0; st < 2; ++st)
#pragma unroll
        for (int kt = 0; kt < 16; ++kt) S[st][kt] = (f32x4){0.f, 0.f, 0.f, 0.f};
#pragma unroll 1
    for (int kh = 0; kh < 2; ++kh) {
        bf16x8v qf[2][4];
#pragma unroll
        for (int st = 0; st < 2; ++st)
#pragma unroll
            for (int ks = 0; ks < 4; ++ks) qf[st][ks] = *(const bf16x8v*)(QC + (row0 + st * 16 + q16) * DM + h * 256 + kh * 128 + ks * 32 + g * 8);
        const LAS unsigned char* kb = lds + q16 * CA_STRIDE + kh * 256 + g * 16;
#pragma unroll
        for (int kt = 0; kt < 16; ++kt)
#pragma unroll
            for (int ks = 0; ks < 4; ++ks) { const bf16x8v a = *(const LAS bf16x8v*)(kb + kt * 16 * CA_STRIDE + ks * 64);
                S[0][kt] = __builtin_amdgcn_mfma_f32_16x16x32_bf16(a, qf[0][ks], S[0][kt], 0, 0, 0);
                S[1][kt] = __builtin_amdgcn_mfma_f32_16x16x32_bf16(a, qf[1][ks], S[1][kt], 0, 0, 0); }
    }
    const float c2 = 0.0625f * 1.4426950408889634f;
    float linv[2]; bf16x8v P[2][8];
#pragma unroll
    for (int st = 0; st < 2; ++st) {
        float m = -INFINITY;
#pragma unroll
        for (int kt = 0; kt < 16; ++kt) m = fmaxf(fmaxf(fmaxf(S[st][kt][0], S[st][kt][1]), fmaxf(S[st][kt][2], S[st][kt][3])), m);
        m = fmaxf(m, __shfl_xor(m, 16)); m = fmaxf(m, __shfl_xor(m, 32));
        const float mc = m * c2; float l = 0.f;
#pragma unroll
        for (int kt = 0; kt < 16; ++kt)
#pragma unroll
            for (int r = 0; r < 4; ++r) { const float p = __builtin_amdgcn_exp2f(S[st][kt][r] * c2 - mc); S[st][kt][r] = p; l += p; }
        l += __shfl_xor(l, 16); l += __shfl_xor(l, 32); linv[st] = 1.f / l;
#pragma unroll
        for (int c = 0; c < 8; ++c) { bf16x8v pk;
#pragma unroll
            for (int j = 0; j < 4; ++j) { pk[j] = (short)f2bf(S[st][2 * c][j]); pk[4 + j] = (short)f2bf(S[st][2 * c + 1][j]); }
            P[st][c] = pk; }
    }
    __syncthreads();
    { int tid2 = tid; asm volatile("" : "+v"(tid2));
      const bf16_t* src = VT + (size_t)(h * 256 + (tid2 >> 5)) * MMEM + b * NMEM + (tid2 & 31) * 8; LAS unsigned char* dst = lds + (tid2 >> 5) * CA_STRIDE + (tid2 & 31) * 16;
#pragma unroll
      for (int i = 0; i < 16; ++i) { const u32x4 v = *(const u32x4*)(src + (size_t)i * 16 * MMEM); *(LAS u32x4*)(dst + i * 16 * CA_STRIDE) = v; } }
    __syncthreads();
#pragma unroll 1
    for (int dh = 0; dh < 2; ++dh) {
        f32x4 O[2][8];
#pragma unroll
        for (int st = 0; st < 2; ++st)
#pragma unroll
            for (int dt = 0; dt < 8; ++dt) O[st][dt] = (f32x4){0.f, 0.f, 0.f, 0.f};
        const LAS unsigned char* pb = lds + (dh * 128 + q16) * CA_STRIDE + g * 8;
#pragma unroll
        for (int dt = 0; dt < 8; ++dt)
#pragma unroll
            for (int c = 0; c < 8; ++c) { const LAS unsigned char* p = pb + dt * 16 * CA_STRIDE + c * 64;
                const u32x2 lo = *(const LAS u32x2*)p, hi = *(const LAS u32x2*)(p + 32);
                const u32x4 av = (u32x4){lo.x, lo.y, hi.x, hi.y}; const bf16x8v a = __builtin_bit_cast(bf16x8v, av);
                O[0][dt] = __builtin_amdgcn_mfma_f32_16x16x32_bf16(a, P[0][c], O[0][dt], 0, 0, 0);
                O[1][dt] = __builtin_amdgcn_mfma_f32_16x16x32_bf16(a, P[1][c], O[1][dt], 0, 0, 0); }
#pragma unroll
        for (int st = 0; st < 2; ++st)
#pragma unroll
            for (int dt = 0; dt < 8; ++dt) { const f32x4 o = O[st][dt] * linv[st]; u32x2 w;
                w.x = (unsigned)f2bf(o[0]) | ((unsigned)f2bf(o[1]) << 16); w.y = (unsigned)f2bf(o[2]) | ((unsigned)f2bf(o[3]) << 16);
                *(u32x2*)(OC + (row0 + st * 16 + q16) * DM + h * 256 + dh * 128 + dt * 16 + g * 4) = w; }
    }
    __syncthreads();
}
typedef float f32x16v __attribute__((ext_vector_type(16)));
__device__ __forceinline__ unsigned code16(float s) {
    const _Float16 hf = (_Float16)s; unsigned u = (unsigned)__builtin_bit_cast(unsigned short, hf);
    if ((u & 0x7fffu) == 0u) u = 0u;
    return (u & 0x8000u) ? (~u & 0xffffu) : (u | 0x8000u);
}
__device__ __forceinline__ unsigned mbcnt64(unsigned long long m) { return __builtin_amdgcn_mbcnt_hi((unsigned)(m >> 32), __builtin_amdgcn_mbcnt_lo((unsigned)m, 0u)); }
__device__ __forceinline__ void topk_unit(LAS unsigned char* lds, int b, int j, const bf16_t* QI, const bf16_t* KI, const float* WI, unsigned short* SEL, int tid, int lane, int wave) {
    asm volatile("" : "+v"(tid), "+v"(lane));
    const int t0 = 16 * j, L = t0 + 16, nkt = (L + 31) >> 5;
    const size_t rowbase = (size_t)b * SEQ + t0;
    const int c32 = lane & 31, hi = lane >> 5;
    {
        bf16x8v qa[2][4]; f32x4 wq[2][4];
#pragma unroll
        for (int rt = 0; rt < 2; ++rt) {
#pragma unroll
            for (int ks = 0; ks < 4; ++ks) qa[rt][ks] = *(const bf16x8v*)(QI + (rowbase + 8 * rt + (c32 >> 2)) * 256 + (c32 & 3) * 64 + 16 * ks + 8 * hi);
#pragma unroll
            for (int gq = 0; gq < 4; ++gq) wq[rt][gq] = *(const f32x4*)(WI + (rowbase + 8 * rt + 2 * gq + hi) * 4);
        }
        const bf16_t* kbase = KI + ((size_t)b * SEQ + c32) * 64 + 8 * hi;
        bf16x8v kb[4], kn[4];
        int kt = wave;
        if (kt < nkt) {
#pragma unroll
            for (int ks = 0; ks < 4; ++ks) kb[ks] = *(const bf16x8v*)(kbase + (size_t)kt * 32 * 64 + 16 * ks);
        }
        for (; kt < nkt; kt += 8) {
            const int ktn = (kt + 8 < nkt) ? kt + 8 : kt;
#pragma unroll
            for (int ks = 0; ks < 4; ++ks) kn[ks] = *(const bf16x8v*)(kbase + (size_t)ktn * 32 * 64 + 16 * ks);
#pragma unroll
            for (int rt = 0; rt < 2; ++rt) {
                f32x16v c = {0.f, 0.f, 0.f, 0.f, 0.f, 0.f, 0.f, 0.f, 0.f, 0.f, 0.f, 0.f, 0.f, 0.f, 0.f, 0.f};
#pragma unroll
                for (int ks = 0; ks < 4; ++ks) c = __builtin_amdgcn_mfma_f32_32x32x16_bf16(qa[rt][ks], kb[ks], c, 0, 0, 0);
#pragma unroll
                for (int gq = 0; gq < 4; ++gq) {
                    const f32x4 w = wq[rt][gq];
                    const float sc = w[0] * fmaxf(c[4 * gq + 0], 0.f) + w[1] * fmaxf(c[4 * gq + 1], 0.f) + w[2] * fmaxf(c[4 * gq + 2], 0.f) + w[3] * fmaxf(c[4 * gq + 3], 0.f);
                    const int q = 8 * rt + 2 * gq + hi;
                    *(LAS unsigned short*)(lds + q * 8192 + (kt * 32 + c32) * 2) = (unsigned short)code16(sc);
                }
            }
#pragma unroll
            for (int ks = 0; ks < 4; ++ks) kb[ks] = kn[ks];
        }
    }
    __syncthreads();
#pragma unroll 1
    for (int qq = 0; qq < 2; ++qq) {
        const int q = 2 * wave + qq, t = t0 + q, n = t + 1;
        unsigned short* sel = SEL + (rowbase + q) * TOPK;
        if (n <= TOPK) {
#pragma unroll
            for (int i = 0; i < 4; ++i) { const int s = lane + 64 * i; if (s < n) sel[s] = (unsigned short)s; }
            continue;
        }
        const int nch = (n + 127) >> 7;
        unsigned lo[32], hi16[32];
        const LAS unsigned* row = (const LAS unsigned*)(lds + q * 8192) + lane;
#pragma unroll
        for (int c = 0; c < 32; ++c) {
            unsigned v = 0u; if (c < nch) v = row[64 * c];
            const int i0 = 128 * c + 2 * lane;
            lo[c] = (i0 <= t) ? (v & 0xffffu) : 0u; hi16[c] = (i0 + 1 <= t) ? (v >> 16) : 0u;
        }
#define TK_COUNT(CMP, RES) do { unsigned cl_ = 0u; \
            _Pragma("unroll") for (int c = 0; c < 8; ++c) { cl_ += (lo[c] CMP) ? 1u : 0u; cl_ += (hi16[c] CMP) ? 1u : 0u; } \
            if (nch > 8)  { _Pragma("unroll") for (int c = 8; c < 16; ++c)  { cl_ += (lo[c] CMP) ? 1u : 0u; cl_ += (hi16[c] CMP) ? 1u : 0u; } } \
            if (nch > 16) { _Pragma("unroll") for (int c = 16; c < 24; ++c) { cl_ += (lo[c] CMP) ? 1u : 0u; cl_ += (hi16[c] CMP) ? 1u : 0u; } } \
            if (nch > 24) { _Pragma("unroll") for (int c = 24; c < 32; ++c) { cl_ += (lo[c] CMP) ? 1u : 0u; cl_ += (hi16[c] CMP) ? 1u : 0u; } } \
            unsigned tot_ = 0u; _Pragma("unroll") for (int bb = 0; bb < 7; ++bb) tot_ += (unsigned)__popcll(__ballot((cl_ >> bb) & 1u)) << bb; RES = tot_; } while (0)
        unsigned T = 0u;
#pragma unroll 1
        for (int bit = 15; bit >= 0; --bit) {
            const unsigned cand = T | (1u << bit); unsigned cnt;
            TK_COUNT(>= cand, cnt);
            if (cnt >= (unsigned)TOPK) T = cand;
        }
        unsigned cgt;
        TK_COUNT(> T, cgt);
#undef TK_COUNT
        const unsigned need = (unsigned)TOPK - cgt;
        unsigned eqrun = 0u, selrun = 0u;
#pragma unroll
        for (int c = 0; c < 32; ++c) if (c < nch) {
            const bool elo = lo[c] == T, ehi = hi16[c] == T;
            const unsigned long long melo = __ballot(elo), mehi = __ballot(ehi);
            const unsigned rank_lo = eqrun + mbcnt64(melo) + mbcnt64(mehi), rank_hi = rank_lo + (elo ? 1u : 0u);
            const bool tlo = (lo[c] > T) || (elo && rank_lo < need), thi = (hi16[c] > T) || (ehi && rank_hi < need);
            const unsigned long long mtlo = __ballot(tlo), mthi = __ballot(thi);
            const unsigned pos_lo = selrun + mbcnt64(mtlo) + mbcnt64(mthi), pos_hi = pos_lo + (tlo ? 1u : 0u);
            if (tlo && pos_lo < (unsigned)TOPK) sel[pos_lo] = (unsigned short)(128 * c + 2 * lane);
            if (thi && pos_hi < (unsigned)TOPK) sel[pos_hi] = (unsigned short)(128 * c + 2 * lane + 1);
            eqrun += (unsigned)__popcll(melo) + (unsigned)__popcll(mehi); selrun += (unsigned)__popcll(mtlo) + (unsigned)__popcll(mthi);
        }
    }
    __syncthreads();
}
__device__ __forceinline__ void topk_phase(LAS unsigned char* lds, int G, int vcu, const bf16_t* QI, const bf16_t* KI, const float* WI, unsigned short* SEL, int tid, int lane, int wave) {
    if (G == 256) {
        const int b = vcu >> 5, i = vcu & 31;
#pragma unroll 1
        for (int k = 0; k < 8; ++k) { const int j = 64 * (k >> 1) + ((k & 1) ? 63 - i : i); topk_unit(lds, b, j, QI, KI, WI, SEL, tid, lane, wave); }
    } else {
#pragma unroll 1
        for (int u = vcu; u < BATCH * 256; u += G) topk_unit(lds, u >> 8, u & 255, QI, KI, WI, SEL, tid, lane, wave);
    }
}
typedef short v4i16_t __attribute__((ext_vector_type(4)));
constexpr int SV_STRIDE = 160, SV_WAVE_BYTES = 64 * SV_STRIDE;
__device__ __forceinline__ v4i16_t tr_read16(const LAS unsigned char* p) { return __builtin_amdgcn_ds_read_tr16_b64_v4i16((LAS v4i16_t*)p); }
__device__ __forceinline__ void sparse_attn_query(LAS unsigned char* wl, size_t row, int b, int t, const bf16_t* Q, const bf16_t* Kb, const bf16_t* Vb, const unsigned short* SEL, bf16_t* MIX, int lane) {
    const int n = (t + 1 < TOPK) ? t + 1 : TOPK, q16 = lane & 15, g = lane >> 4;
    const unsigned short* sel = SEL + row * TOPK;
    bf16x8v qf[2];
#pragma unroll
    for (int ks = 0; ks < 2; ++ks) { u32x4 v = (u32x4){0u, 0u, 0u, 0u}; if (q16 < 8) v = *(const u32x4*)(Q + row * 512 + q16 * 64 + ks * 32 + g * 8); qf[ks] = __builtin_bit_cast(bf16x8v, v); }
    f32x4 S[16];
    const bf16_t* kbat = Kb + (size_t)b * SEQ * 64 + g * 8;
#pragma unroll
    for (int kg = 0; kg < 4; ++kg) {
        bf16x8v kf[4][2];
#pragma unroll
        for (int i = 0; i < 4; ++i) { const int slot = 64 * kg + 16 * i + q16; unsigned idx = 0u; if (slot < n) idx = sel[slot];
#pragma unroll
            for (int ks = 0; ks < 2; ++ks) kf[i][ks] = *(const bf16x8v*)(kbat + (size_t)idx * 64 + ks * 32); }
#pragma unroll
        for (int i = 0; i < 4; ++i) { f32x4 c = (f32x4){0.f, 0.f, 0.f, 0.f};
            c = __builtin_amdgcn_mfma_f32_16x16x32_bf16(kf[i][0], qf[0], c, 0, 0, 0);
            c = __builtin_amdgcn_mfma_f32_16x16x32_bf16(kf[i][1], qf[1], c, 0, 0, 0); S[4 * kg + i] = c; }
    }
    const float c2 = 0.125f * 1.4426950408889634f;
    float m = -INFINITY;
#pragma unroll
    for (int kt = 0; kt < 16; ++kt)
#pragma unroll
        for (int r = 0; r < 4; ++r) { if (16 * kt + 4 * g + r >= n) S[kt][r] = -INFINITY; m = fmaxf(m, S[kt][r]); }
    m = fmaxf(m, __shfl_xor(m, 16)); m = fmaxf(m, __shfl_xor(m, 32));
    const float mc = m * c2; float l = 0.f;
#pragma unroll
    for (int kt = 0; kt < 16; ++kt)
#pragma unroll
        for (int r = 0; r < 4; ++r) { const float p = __builtin_amdgcn_exp2f(S[kt][r] * c2 - mc); S[kt][r] = p; l += p; }
    l += __shfl_xor(l, 16); l += __shfl_xor(l, 32);
    const float linv = 1.f / l;
    bf16x8v P[8];
#pragma unroll
    for (int c = 0; c < 8; ++c) { bf16x8v pk;
#pragma unroll
        for (int j = 0; j < 4; ++j) { pk[j] = (short)f2bf(S[2 * c][j]); pk[4 + j] = (short)f2bf(S[2 * c + 1][j]); }
        P[c] = pk; }
    f32x4 O[4];
#pragma unroll
    for (int dt = 0; dt < 4; ++dt) O[dt] = (f32x4){0.f, 0.f, 0.f, 0.f};
    const bf16_t* vbat = Vb + (size_t)b * SEQ * 64 + (lane & 7) * 8;
    LAS unsigned char* wdst = wl + (lane >> 3) * SV_STRIDE + (lane & 7) * 16;
    const LAS unsigned char* rsrc = wl + (4 * g + (q16 >> 2)) * SV_STRIDE + (q16 & 3) * 8;
#pragma unroll
    for (int cc = 0; cc < 4; ++cc) {
        u32x4 vv[8];
#pragma unroll
        for (int i = 0; i < 8; ++i) { const int slot = 64 * cc + (lane >> 3) + 8 * i; unsigned idx = 0u; if (slot < n) idx = sel[slot]; vv[i] = *(const u32x4*)(vbat + (size_t)idx * 64); }
#pragma unroll
        for (int i = 0; i < 8; ++i) *(LAS u32x4*)(wdst + i * 8 * SV_STRIDE) = vv[i];
        asm volatile("s_waitcnt lgkmcnt(0)" ::: "memory");
#pragma unroll
        for (int c2i = 0; c2i < 2; ++c2i)
#pragma unroll
            for (int dt = 0; dt < 4; ++dt) { const LAS unsigned char* p = rsrc + c2i * 32 * SV_STRIDE + dt * 32;
                const v4i16_t lo = tr_read16(p), hi = tr_read16(p + 16 * SV_STRIDE);
                const bf16x8v a = (bf16x8v){lo[0], lo[1], lo[2], lo[3], hi[0], hi[1], hi[2], hi[3]};
                O[dt] = __builtin_amdgcn_mfma_f32_16x16x32_bf16(a, P[2 * cc + c2i], O[dt], 0, 0, 0); }
        asm volatile("s_waitcnt lgkmcnt(0)" ::: "memory");
    }
    if (q16 < 8) {
#pragma unroll
        for (int dt = 0; dt < 4; ++dt) { const f32x4 o = O[dt] * linv; u32x2 w;
            w.x = (unsigned)f2bf(o[0]) | ((unsigned)f2bf(o[1]) << 16); w.y = (unsigned)f2bf(o[2]) | ((unsigned)f2bf(o[3]) << 16);
            *(u32x2*)(MIX + row * DM + q16 * 64 + dt * 16 + g * 4) = w; }
    }
}
__device__ __forceinline__ void sparse_attn_phase(LAS unsigned char* lds, int G, int vcu, const bf16_t* Q, const bf16_t* Kb, const bf16_t* Vb, const unsigned short* SEL, bf16_t* MIX, int lane, int wave) {
    asm volatile("" : "+v"(lane));
    LAS unsigned char* wl = lds + wave * SV_WAVE_BYTES;
    if (G == 256) {
        const int b = vcu >> 5, ws = (vcu & 31) * 8 + wave;
#pragma unroll 1
        for (int k = 0; k < 16; ++k) { const int t = ws + 256 * k; sparse_attn_query(wl, (size_t)b * SEQ + t, b, t, Q, Kb, Vb, SEL, MIX, lane); }
    } else {
#pragma unroll 1
        for (int r = vcu * 8 + wave; r < MTOK; r += G * 8) sparse_attn_query(wl, (size_t)r, r / SEQ, r % SEQ, Q, Kb, Vb, SEL, MIX, lane);
    }
    __syncthreads();
}
__device__ __forceinline__ void convb_phase(LAS unsigned char* lds, int G, int vcu, const bf16_t* U, const float* __restrict__ cw, const float* __restrict__ cb, const float* __restrict__ lng, const float* __restrict__ lnb, bf16_t* MIX, int tid, int lane, int wave) {
    asm volatile("" : "+v"(tid), "+v"(lane));
    typedef float f32x2v __attribute__((ext_vector_type(2)));
    const int cp = tid & 255, th = tid >> 8;
    f32x2v w[31];
#pragma unroll
    for (int j = 0; j < 31; ++j) w[j] = *(const f32x2v*)(cw + j * 512 + 2 * cp);
    const f32x2v bias = *(const f32x2v*)(cb + 2 * cp), gam = *(const f32x2v*)(lng + 2 * cp), bet = *(const f32x2v*)(lnb + 2 * cp);
    LAS float* red = (LAS float*)(lds + 65536);
#pragma unroll 1
    for (int tile = vcu; tile < MTOK / 32; tile += G) {
        const int row0 = tile * 32, t0 = row0 & (SEQ - 1);
        for (int i = tid; i < 62 * 64; i += 512) { const int r = i >> 6, ch = i & 63; u32x4 v = (u32x4){0u, 0u, 0u, 0u};
            if (t0 - 30 + r >= 0) v = *(const u32x4*)(U + (size_t)(row0 - 30 + r) * 512 + ch * 8);
            *(LAS u32x4*)(lds + r * 1024 + ch * 16) = v; }
        __syncthreads();
        f32x2v y[2][8];
#pragma unroll
        for (int k = 0; k < 2; ++k) {
            const int tg = th + 2 * k;
            f32x2v acc[8];
#pragma unroll
            for (int o = 0; o < 8; ++o) acc[o] = bias;
            const LAS unsigned* wp = (const LAS unsigned*)(lds + tg * 8 * 1024) + cp;
#pragma unroll
            for (int j = 0; j < 38; ++j) { const unsigned uu = wp[j * 256]; const f32x2v uv = (f32x2v){__uint_as_float(uu << 16), __uint_as_float(uu & 0xffff0000u)};
#pragma unroll
                for (int o = 0; o < 8; ++o) { const int tap = j - o; if (tap >= 0 && tap < 31) acc[o] += w[tap] * uv; } }
#pragma unroll
            for (int o = 0; o < 8; ++o) { y[k][o] = acc[o];
                float s = acc[o].x + acc[o].y, q = acc[o].x * acc[o].x + acc[o].y * acc[o].y;
                s = wave_sum(s); q = wave_sum(q);
                if (lane == 0) { red[((tg * 8 + o) * 4 + (wave & 3)) * 2] = s; red[((tg * 8 + o) * 4 + (wave & 3)) * 2 + 1] = q; } }
        }
        __syncthreads();
#pragma unroll
        for (int k = 0; k < 2; ++k) {
            const int tg = th + 2 * k;
#pragma unroll
            for (int o = 0; o < 8; ++o) { const int tl = tg * 8 + o;
                const f32x4 ra = *(const LAS f32x4*)(red + tl * 8), rb = *(const LAS f32x4*)(red + tl * 8 + 4);
                const float mu = ((ra[0] + ra[2]) + (rb[0] + rb[2])) * (1.f / 512.f), ex2 = ((ra[1] + ra[3]) + (rb[1] + rb[3])) * (1.f / 512.f);
                const float rstd = 1.f / sqrtf(fmaxf(ex2 - mu * mu, 0.f) + EPS);
                const float v0 = (y[k][o].x - mu) * rstd * gam.x + bet.x, v1 = (y[k][o].y - mu) * rstd * gam.y + bet.y;
                *(unsigned*)(MIX + (size_t)(row0 + tl) * DM + 512 + 2 * cp) = (unsigned)f2bf(silu_f(v0)) | ((unsigned)f2bf(silu_f(v1)) << 16); }
        }
        __syncthreads();
    }
}

__device__ __forceinline__ int wt_dst_row(int mode, int c) {
    if (mode == 0) return c;
    if (mode == 2) return 256 * (c >> 7) + (c & 127);
    if (mode == 3) return 256 * (c >> 7) + 128 + (c & 127);
    if (c < 512) return (c & ~63) + dperm(c & 63);
    if (c < 576) return 512 + dperm(c - 512);
    if (c < 640) return c;
    if (c < 896) return 768 + ((c - 640) & ~63) + dperm((c - 640) & 63);
    if (c < 960) return 640 + dperm(c - 896);
    if (c < 964) return 704 + (c - 960);
    if (c < 1476) { const int j = c - 964; return 1024 + 256 * (j >> 7) + (j & 127); }
    { const int j = c - 1476; return 1024 + 256 * (j >> 7) + 128 + (j & 127); }
}
__device__ __forceinline__ void wt_body(LAS unsigned char* sm, int vb, int tid, const float* __restrict__ W, int K, int N, bf16_t* WT, const float* __restrict__ gain, int mode) {
    LAS float* t = (LAS float*)sm;
    const int nbx = (N + 31) / 32; const int k0 = (vb / nbx) * 32, n0 = (vb % nbx) * 32, tx = tid & 31, ty = tid >> 5;
    for (int i = ty; i < 32; i += 8) { const int k = k0 + i, n = n0 + tx; float v = 0.f; if (k < K && n < N) { v = W[(size_t)k * N + n]; if (gain) v *= gain[k]; } t[i * 33 + tx] = v; }
    __syncthreads();
    for (int i = ty; i < 32; i += 8) { const int n = n0 + i, k = k0 + tx; if (n < N && k < K) WT[(size_t)wt_dst_row(mode, n) * K + k] = f2bf(t[tx * 33 + i]); }
    __syncthreads();
}
__device__ __forceinline__ void rmsnorm_bf16_row(const float* x, const float* __restrict__ g, bf16_t* out, int row, int lane) {
    const f32x4* xr = (const f32x4*)(x + (size_t)row * DM) + lane; const f32x4* gr = (const f32x4*)g + lane;
    f32x4 v[4]; float s = 0.f;
#pragma unroll
    for (int j = 0; j < 4; ++j) { v[j] = xr[64 * j]; s += (v[j].x * v[j].x + v[j].y * v[j].y) + (v[j].z * v[j].z + v[j].w * v[j].w); }
    const float rstd = 1.f / sqrtf(wave_sum(s) * (1.f / DM) + EPS);
    u32x2* o = (u32x2*)(out + (size_t)row * DM) + lane;
#pragma unroll
    for (int j = 0; j < 4; ++j) { const f32x4 gg = gr[64 * j]; u32x2 w;
        w.x = (unsigned)f2bf(v[j].x * rstd * gg.x) | ((unsigned)f2bf(v[j].y * rstd * gg.y) << 16);
        w.y = (unsigned)f2bf(v[j].z * rstd * gg.z) | ((unsigned)f2bf(v[j].w * rstd * gg.w) << 16); o[64 * j] = w; }
}
__device__ __forceinline__ void rmsnorm_f32_row(float* x, const float* __restrict__ g, int row, int lane) {
    f32x4* xr = (f32x4*)(x + (size_t)row * DM) + lane; const f32x4* gr = (const f32x4*)g + lane;
    f32x4 v[4]; float s = 0.f;
#pragma unroll
    for (int j = 0; j < 4; ++j) { v[j] = xr[64 * j]; s += (v[j].x * v[j].x + v[j].y * v[j].y) + (v[j].z * v[j].z + v[j].w * v[j].w); }
    const float rstd = 1.f / sqrtf(wave_sum(s) * (1.f / DM) + EPS);
#pragma unroll
    for (int j = 0; j < 4; ++j) { const f32x4 gg = gr[64 * j]; xr[64 * j] = v[j] * rstd * gg; }
}
__device__ __forceinline__ float rope_val(const LAS float* p, int base, int d, const LAS float* cs, const LAS float* sn) {
    if (d < 8) return p[base + d] * cs[d] - p[base + d + 8] * sn[d];
    if (d < 16) return p[base + d] * cs[d - 8] + p[base + d - 8] * sn[d - 8];
    return p[base + d];
}
__device__ __forceinline__ void split_rope_body(LAS unsigned char* sm, int row, int tid, const float* proj, const int* __restrict__ positions, bf16_t* Q, bf16_t* Kb, bf16_t* Vb, bf16_t* QI, bf16_t* KI, float* WI, bf16_t* U) {
    LAS float* p = (LAS float*)sm; LAS float* cs = p + INP; LAS float* sn = cs + 8;
    for (int c = tid; c < INP; c += 256) p[c] = proj[(size_t)row * INP + c];
    if (tid < 8) { const float freq = (float)pow(500000.0, -0.125 * (double)tid); const float ang = (float)positions[row] * freq; cs[tid] = (float)cos((double)ang); sn[tid] = (float)sin((double)ang); }
    __syncthreads();
    for (int c = tid; c < 512; c += 256) Q[(size_t)row * 512 + c] = f2bf(rope_val(p, (c >> 6) * 64, c & 63, cs, sn));
    if (tid < 64) Kb[(size_t)row * 64 + tid] = f2bf(rope_val(p, 512, tid, cs, sn));
    else if (tid < 128) Vb[(size_t)row * 64 + tid - 64] = f2bf(p[576 + tid - 64]);
    else if (tid < 192) KI[(size_t)row * 64 + tid - 128] = f2bf(rope_val(p, 896, tid - 128, cs, sn));
    else if (tid < 196) WI[(size_t)row * 4 + tid - 192] = p[960 + tid - 192] * 0.5f;
    QI[(size_t)row * 256 + tid] = f2bf(rope_val(p, 640 + (tid >> 6) * 64, tid & 63, cs, sn) * 0.125f);
    for (int c = tid; c < 512; c += 256) { const float ga = p[964 + c], gg = p[1476 + c]; U[(size_t)row * 512 + c] = f2bf(ga / (1.f + __expf(-gg))); }
    __syncthreads();
}
__device__ __forceinline__ unsigned fkey(float s) { unsigned u = __float_as_uint(s); if ((u << 1) == 0u) u = 0u; return (u & 0x80000000u) ? ~u : (u | 0x80000000u); }
__device__ __forceinline__ void topk_body(LAS unsigned char* sm, int row, int tid, const bf16_t* QI, const bf16_t* KI, const float* WI, unsigned short* SEL) {
    LAS float* qs = (LAS float*)sm; LAS unsigned* key = (LAS unsigned*)(sm + 1024); LAS unsigned* scan = (LAS unsigned*)(sm + 1024 + 16384); LAS unsigned* cntp = (LAS unsigned*)(sm + 1024 + 16384 + 1024);
    const int b = row / SEQ, t = row % SEQ, n = t + 1;
    unsigned short* sel = SEL + (size_t)row * TOPK;
    if (n <= TOPK) { if (tid < n) sel[tid] = (unsigned short)tid; return; }
    qs[tid] = bf2f(QI[(size_t)row * 256 + tid]);
    const float w0 = WI[(size_t)row * 4 + 0], w1 = WI[(size_t)row * 4 + 1], w2 = WI[(size_t)row * 4 + 2], w3 = WI[(size_t)row * 4 + 3];
    __syncthreads();
    for (int s = tid; s < n; s += 256) {
        const u32x4* kp = (const u32x4*)(KI + ((size_t)b * SEQ + s) * 64);
        float a0 = 0.f, a1 = 0.f, a2 = 0.f, a3 = 0.f;
#pragma unroll 2
        for (int c = 0; c < 8; ++c) { const u32x4 kv = kp[c];
#pragma unroll
            for (int e = 0; e < 4; ++e) { const float klo = __uint_as_float(kv[e] << 16), khi = __uint_as_float(kv[e] & 0xffff0000u); const int d = c * 8 + e * 2;
                a0 += qs[d] * klo + qs[d + 1] * khi; a1 += qs[64 + d] * klo + qs[64 + d + 1] * khi; a2 += qs[128 + d] * klo + qs[128 + d + 1] * khi; a3 += qs[192 + d] * klo + qs[192 + d + 1] * khi; } }
        const float sc = w0 * fmaxf(a0, 0.f) + w1 * fmaxf(a1, 0.f) + w2 * fmaxf(a2, 0.f) + w3 * fmaxf(a3, 0.f);
        key[s] = fkey(sc);
    }
    __syncthreads();
    unsigned prefix = 0u;
    for (int bit = 31; bit >= 0; --bit) {
        const unsigned cand = prefix | (1u << bit);
        if (tid == 0) *cntp = 0u;
        __syncthreads();
        unsigned c = 0u; for (int s = tid; s < n; s += 256) c += (key[s] >= cand) ? 1u : 0u;
        if (c) atomicAdd((unsigned*)cntp, c);
        __syncthreads();
        if (*cntp >= (unsigned)TOPK) prefix = cand;
        __syncthreads();
    }
    if (tid == 0) *cntp = 0u;
    __syncthreads();
    { unsigned c = 0u; for (int s = tid; s < n; s += 256) c += (key[s] > prefix) ? 1u : 0u; if (c) atomicAdd((unsigned*)cntp, c); }
    __syncthreads();
    const unsigned need = (unsigned)TOPK - *cntp;
    __syncthreads();
    const int s0 = tid * 16; unsigned eqc = 0u;
    for (int i = 0; i < 16; ++i) { const int s = s0 + i; if (s < n && key[s] == prefix) ++eqc; }
    scan[tid] = eqc; __syncthreads();
    for (int o = 1; o < 256; o <<= 1) { const unsigned v = (tid >= o) ? scan[tid - o] : 0u; __syncthreads(); scan[tid] += v; __syncthreads(); }
    unsigned eq_before = scan[tid] - eqc; __syncthreads();
    unsigned takec = 0u; unsigned takemask = 0u;
    for (int i = 0; i < 16; ++i) { const int s = s0 + i; if (s < n) { const unsigned k = key[s]; bool take = k > prefix; if (k == prefix) { take = eq_before < need; ++eq_before; } if (take) { ++takec; takemask |= 1u << i; } } }
    scan[tid] = takec; __syncthreads();
    for (int o = 1; o < 256; o <<= 1) { const unsigned v = (tid >= o) ? scan[tid - o] : 0u; __syncthreads(); scan[tid] += v; __syncthreads(); }
    unsigned pos = scan[tid] - takec;
    for (int i = 0; i < 16; ++i) if (takemask & (1u << i)) { if (pos < (unsigned)TOPK) sel[pos] = (unsigned short)(s0 + i); ++pos; }
    __syncthreads();
}
__device__ __forceinline__ void sparse_attn_body(LAS unsigned char* sm, int row, int tid, const bf16_t* Q, const bf16_t* Kb, const bf16_t* Vb, const unsigned short* SEL, bf16_t* MIX) {
    LAS float* qs = (LAS float*)sm; LAS float* lg = qs + 512;   LAS int* idx = (LAS int*)(lg + NH * TOPK);
    const int b = row / SEQ, t = row % SEQ, n = (t + 1 < TOPK) ? t + 1 : TOPK;
    qs[tid] = bf2f(Q[(size_t)row * 512 + tid]); qs[tid + 256] = bf2f(Q[(size_t)row * 512 + 256 + tid]);
    int myidx = 0; if (tid < n) myidx = (int)SEL[(size_t)row * TOPK + tid]; idx[tid] = myidx;
    __syncthreads();
    if (tid < n) {
        const u32x4* kp = (const u32x4*)(Kb + ((size_t)b * SEQ + myidx) * 64);
        float a[NH];
#pragma unroll
        for (int h = 0; h < NH; ++h) a[h] = 0.f;
#pragma unroll 2
        for (int c = 0; c < 8; ++c) { const u32x4 kv = kp[c];
#pragma unroll
            for (int e = 0; e < 4; ++e) { const float klo = __uint_as_float(kv[e] << 16), khi = __uint_as_float(kv[e] & 0xffff0000u); const int d = c * 8 + e * 2;
#pragma unroll
                for (int h = 0; h < NH; ++h) a[h] += qs[h * 64 + d] * klo + qs[h * 64 + d + 1] * khi; } }
#pragma unroll
        for (int h = 0; h < NH; ++h) lg[h * TOPK + tid] = a[h] * 0.125f;
    } else {
#pragma unroll
        for (int h = 0; h < NH; ++h) lg[h * TOPK + tid] = -INFINITY;
    }
    __syncthreads();
    { const int w = tid >> 6, lane = tid & 63;
      for (int hh = 0; hh < 2; ++hh) { const int h = 2 * w + hh; float v[4], m = -INFINITY;
          for (int i = 0; i < 4; ++i) { v[i] = lg[h * TOPK + lane + 64 * i]; m = fmaxf(m, v[i]); }
          m = wave_max(m); float s = 0.f;
          for (int i = 0; i < 4; ++i) { v[i] = __expf(v[i] - m); s += v[i]; }
          s = wave_sum(s); const float inv = 1.f / s;
          for (int i = 0; i < 4; ++i) lg[h * TOPK + lane + 64 * i] = v[i] * inv; } }
    __syncthreads();
    { const int h = tid >> 5, d0 = (tid & 31) * 2; float o0 = 0.f, o1 = 0.f;
      for (int j = 0; j < n; ++j) { const unsigned vv = *(const unsigned*)(Vb + ((size_t)b * SEQ + idx[j]) * 64 + d0); const float p = lg[h * TOPK + j]; o0 += p * __uint_as_float(vv << 16); o1 += p * __uint_as_float(vv & 0xffff0000u); }
      *(unsigned*)(MIX + (size_t)row * DM + h * 64 + d0) = (unsigned)f2bf(o0) | ((unsigned)f2bf(o1) << 16); }
    __syncthreads();
}
__device__ __forceinline__ void convb_body(LAS unsigned char* sm, int row, int tid, const bf16_t* U, const float* __restrict__ cw, const float* __restrict__ cb, const float* __restrict__ lg, const float* __restrict__ lb, bf16_t* MIX) {
    LAS float* red = (LAS float*)sm;
    const int t = row % SEQ;
    float y[2];
    for (int k = 0; k < 2; ++k) { const int c = tid + 256 * k; float acc = cb[c];
        for (int j = 0; j < 31; ++j) { const int tt = t - 30 + j; if (tt >= 0) acc += cw[j * 512 + c] * bf2f(U[(size_t)(row - 30 + j) * 512 + c]); }
        y[k] = acc; }
    float s = wave_sum(y[0] + y[1]); if ((tid & 63) == 0) red[tid >> 6] = s; __syncthreads();
    const float mu = (red[0] + red[1] + red[2] + red[3]) * (1.f / 512.f); __syncthreads();
    float q = wave_sum((y[0] - mu) * (y[0] - mu) + (y[1] - mu) * (y[1] - mu)); if ((tid & 63) == 0) red[4 + (tid >> 6)] = q; __syncthreads();
    const float rstd = 1.f / sqrtf((red[4] + red[5] + red[6] + red[7]) * (1.f / 512.f) + EPS);
    for (int k = 0; k < 2; ++k) { const int c = tid + 256 * k; const float v = (y[k] - mu) * rstd * lg[c] + lb[c]; MIX[(size_t)row * DM + 512 + c] = f2bf(silu_f(v)); }
    __syncthreads();
}
__device__ __forceinline__ void cross_attn_body(LAS unsigned char* sm, int row, int tid, const bf16_t* QC, const bf16_t* KC, const bf16_t* VC, bf16_t* OC) {
    LAS float* qs = (LAS float*)sm; LAS float* lg = qs + DM;
    const int b = row / SEQ;
    for (int c = tid; c < DM; c += 256) qs[c] = bf2f(QC[(size_t)row * DM + c]);
    __syncthreads();
    { const u32x4* kp = (const u32x4*)(KC + ((size_t)b * NMEM + tid) * DM);
      for (int h = 0; h < 4; ++h) { float a = 0.f;
#pragma unroll 4
          for (int c = 0; c < 32; ++c) { const u32x4 kv = kp[h * 32 + c];
#pragma unroll
              for (int e = 0; e < 4; ++e) { const int d = h * 256 + c * 8 + e * 2; a += qs[d] * __uint_as_float(kv[e] << 16) + qs[d + 1] * __uint_as_float(kv[e] & 0xffff0000u); } }
          lg[h * NMEM + tid] = a * 0.0625f; } }
    __syncthreads();
    { const int h = tid >> 6, lane = tid & 63; float v[4], m = -INFINITY;
      for (int i = 0; i < 4; ++i) { v[i] = lg[h * NMEM + lane + 64 * i]; m = fmaxf(m, v[i]); }
      m = wave_max(m); float s = 0.f;
      for (int i = 0; i < 4; ++i) { v[i] = __expf(v[i] - m); s += v[i]; }
      s = wave_sum(s); const float inv = 1.f / s;
      for (int i = 0; i < 4; ++i) lg[h * NMEM + lane + 64 * i] = v[i] * inv; }
    __syncthreads();
    { const int h = tid >> 6, d0 = h * 256 + (tid & 63) * 4; float o0 = 0.f, o1 = 0.f, o2 = 0.f, o3 = 0.f;
      for (int j = 0; j < NMEM; ++j) { const u32x2 vv = *(const u32x2*)(VC + ((size_t)b * NMEM + j) * DM + d0); const float p = lg[h * NMEM + j];
          o0 += p * __uint_as_float(vv.x << 16); o1 += p * __uint_as_float(vv.x & 0xffff0000u); o2 += p * __uint_as_float(vv.y << 16); o3 += p * __uint_as_float(vv.y & 0xffff0000u); }
      u32x2 w; w.x = (unsigned)f2bf(o0) | ((unsigned)f2bf(o1) << 16); w.y = (unsigned)f2bf(o2) | ((unsigned)f2bf(o3) << 16); *(u32x2*)(OC + (size_t)row * DM + d0) = w; }
    __syncthreads();
}


constexpr size_t MiB = 1u << 20;
constexpr int LDS_USER = 139264, LDSCTL_OFF = LDS_USER, MISC_OFF = LDSCTL_OFF + 320, LDS_BYTES = 147456;
constexpr size_t WS_CTL = 476 * MiB, CTL_ZERO_BYTES = 1 * MiB; constexpr int CW_BAR = 4096;
constexpr int NGU = 2 * DFF;
struct Args { const float* in[23]; float* out; unsigned char* ws; };
static_assert(sizeof(Args) == 25 * 8, "Args has no padding");

__global__ void __launch_bounds__(512, 2) mega_k(Args a) {
    extern __shared__ __attribute__((aligned(16))) unsigned char lds_raw[];
    LAS unsigned char* lds = (LAS unsigned char*)lds_raw;
    const int tid = threadIdx.x, lane = tid & 63, wave = __builtin_amdgcn_readfirstlane(tid >> 6), half = tid >> 8, htid = tid & 255;
    const int G = gridDim.x, bx = blockIdx.x; const int vcu = (G % 8 == 0) ? (bx % 8) * (G / 8) + bx / 8 : bx;
    LAS unsigned char* hsm = lds + half * 65536;
    const float* x = a.in[0]; const float* mem = a.in[1]; const int* positions = (const int*)a.in[2];
    const float* g_mix = a.in[3]; const float* w_in = a.in[4]; const float* w_out = a.in[5];
    const float* conv_b_w = a.in[6]; const float* conv_b_b = a.in[7]; const float* ln_b_g = a.in[8]; const float* ln_b_b = a.in[9];
    const float* g_cross = a.in[10]; const float* g_mem = a.in[11];
    const float* w_q = a.in[12]; const float* w_k = a.in[13]; const float* w_v = a.in[14]; const float* w_o = a.in[15];
    const float* g_ffn = a.in[16]; const float* w_gate = a.in[17]; const float* w_up = a.in[18];
    const float* ffn_cw = a.in[19]; const float* ffn_cb = a.in[20]; const float* w_down = a.in[21]; const float* g_final = a.in[22];
    float* out = a.out; unsigned char* ws = a.ws;
    bf16_t* wt_in = (bf16_t*)(ws + 0 * MiB); bf16_t* wt_out = (bf16_t*)(ws + 4 * MiB);
    bf16_t* wt_q = (bf16_t*)(ws + 6 * MiB), *wt_k = (bf16_t*)(ws + 8 * MiB), *wt_v = (bf16_t*)(ws + 10 * MiB), *wt_o = (bf16_t*)(ws + 12 * MiB);
    bf16_t* wt_gu = (bf16_t*)(ws + 14 * MiB); bf16_t* wt_down = (bf16_t*)(ws + 26 * MiB);
    float* WI = (float*)(ws + 32 * MiB); float* CS = (float*)(ws + 33 * MiB);
    float* SS1 = (float*)(ws + 35 * MiB); float* SS2 = (float*)(ws + 37 * MiB); float* SS3 = (float*)(ws + 39 * MiB);
    bf16_t* MEMN = (bf16_t*)(ws + 41 * MiB), *KC = (bf16_t*)(ws + 45 * MiB), *VC = (bf16_t*)(ws + 49 * MiB);
    bf16_t* XB = (bf16_t*)(ws + 56 * MiB);
    bf16_t* Qb = (bf16_t*)(ws + 120 * MiB); bf16_t* QI = (bf16_t*)(ws + 152 * MiB);
    bf16_t* Kb = (bf16_t*)(ws + 168 * MiB), *Vb = (bf16_t*)(ws + 172 * MiB), *KI = (bf16_t*)(ws + 176 * MiB);
    bf16_t* U = (bf16_t*)(ws + 180 * MiB); unsigned short* SEL = (unsigned short*)(ws + 212 * MiB);
    bf16_t* MIX = (bf16_t*)(ws + 228 * MiB); bf16_t* QC = (bf16_t*)(ws + 292 * MiB); bf16_t* OC = (bf16_t*)(ws + 356 * MiB);
    bf16_t* Gb = (bf16_t*)(ws + 120 * MiB); bf16_t* UF = (bf16_t*)(ws + 296 * MiB);
    unsigned* ctl = (unsigned*)(ws + WS_CTL);

    for (int u = tid; u < (LDS_BYTES - LDSCTL_OFF) / 4; u += 512) ((LAS unsigned*)(lds + LDSCTL_OFF))[u] = 0u;
    __syncthreads();
    XcdBarrier bar = xcd_barrier_post(ctl + CW_BAR, (volatile LAS unsigned*)(lds + MISC_OFF) + 8);
#define GRID_BAR() xcd_barrier(bar)
#define FOR_VB(nvb) for (int vb = 2 * bx + half; vb < (nvb); vb += 2 * G)
#define GEMMX(EPI, EINIT, Aptr, Bptr, Mv, Nv, Kv) do { pg8::Gemm g_{Aptr, Bptr, Mv, Nv, Kv}; pg8::StaticOrder S_; S_.init(Mv, Nv, G, bx); EPI E_ EINIT; \
        pg8::gemm_phase<EPI, pg8::StaticOrder, true, true>(lds, g_, S_, E_); } while (0)
#define EI(...) {__VA_ARGS__}

    for (int i = bx * 512 + tid; i < 60 * DM; i += G * 512) wt_in[(size_t)708 * DM + i] = 0;
    FOR_VB(32 * 63) wt_body(hsm, vb, htid, w_in, DM, INC, wt_in, nullptr, 1);
    FOR_VB(32 * 32) wt_body(hsm, vb, htid, w_out, DM, DM, wt_out, nullptr, 0);
    FOR_VB(32 * 32) wt_body(hsm, vb, htid, w_q, DM, DM, wt_q, g_cross, 0);
    FOR_VB(32 * 32) wt_body(hsm, vb, htid, w_k, DM, DM, wt_k, nullptr, 0);
    FOR_VB(32 * 32) wt_body(hsm, vb, htid, w_v, DM, DM, wt_v, nullptr, 0);
    FOR_VB(32 * 32) wt_body(hsm, vb, htid, w_o, DM, DM, wt_o, nullptr, 0);
    FOR_VB(32 * 88) wt_body(hsm, vb, htid, w_gate, DM, DFF, wt_gu, g_ffn, 2);
    FOR_VB(32 * 88) wt_body(hsm, vb, htid, w_up, DM, DFF, wt_gu, g_ffn, 3);
    FOR_VB(88 * 32) wt_body(hsm, vb, htid, w_down, DFF, DM, wt_down, nullptr, 0);
    for (int i = bx * 512 + tid; i < MTOK * 8; i += G * 512) { const int row = i >> 3, k = i & 7;
        const float freq = (float)pow(500000.0, -0.125 * (double)k); const float ang = (float)positions[row] * freq;
        CS[(size_t)row * 16 + k] = (float)cos((double)ang); CS[(size_t)row * 16 + 8 + k] = (float)sin((double)ang); }
    for (int r = bx * 8 + wave; r < MTOK; r += G * 8) rmsnorm_bf16_row(x, g_mix, XB, r, lane);
    for (int r = bx * 8 + wave; r < MMEM; r += G * 8) rmsnorm_bf16_row(mem, g_mem, MEMN, r, lane);
    GRID_BAR();
    GEMMX(EpiIn, EI(CS, Qb, Kb, Vb, QI, KI, U, WI), XB, wt_in, MTOK, INP, DM);
    GEMMX(EpiStore, EI(nullptr, KC, nullptr, DM), MEMN, wt_k, MMEM, DM, DM);
    GEMMX(EpiStore, EI(nullptr, VC, nullptr, MMEM), wt_v, MEMN, DM, MMEM, DM);
    GRID_BAR();
    topk_phase(lds, G, vcu, QI, KI, WI, SEL, tid, lane, wave);
    convb_phase(lds, G, vcu, U, conv_b_w, conv_b_b, ln_b_g, ln_b_b, MIX, tid, lane, wave);
    GRID_BAR();
    sparse_attn_phase(lds, G, vcu, Qb, Kb, Vb, SEL, MIX, lane, wave);
    GRID_BAR();
    GEMMX(EpiRes, EI(x, out, XB, SS1), MIX, wt_out, MTOK, DM, DM);
    GRID_BAR();
    GEMMX(EpiScale, EI(SS1, QC, DM, 1.0f), XB, wt_q, MTOK, DM, DM);
    GRID_BAR();
    { const int per = (512 + G - 1) / G; for (int i = 0; i < per; ++i) { const int u = vcu * per + i; if (u < 512) cross_attn_unit(lds, u >> 6, (u >> 4) & 3, u & 15, QC, KC, VC, OC, tid, lane, wave); } }
    GRID_BAR();
    GEMMX(EpiRes, EI(out, out, XB, SS2), OC, wt_o, MTOK, DM, DM);
    GRID_BAR();
    GEMMX(EpiGateUp, EI(SS2, Gb, UF), XB, wt_gu, MTOK, NGU, DM);
    GRID_BAR();
    for (int i = bx * 512 + tid; i < MTOK * (DFF / 8); i += G * 512) {
        const int row = i / (DFF / 8), c = (i - row * (DFF / 8)) * 8, t = row & (SEQ - 1); const size_t off = (size_t)row * DFF + c;
        const u32x4 g2 = *(const u32x4*)(Gb + off); u32x4 g1 = (u32x4){0u, 0u, 0u, 0u}, g0 = (u32x4){0u, 0u, 0u, 0u};
        if (t >= 1) g1 = *(const u32x4*)(Gb + off - DFF);
        if (t >= 2) g0 = *(const u32x4*)(Gb + off - 2 * DFF);
        const u32x4 uu = *(const u32x4*)(UF + off); u32x4 o;
#pragma unroll
        for (int e = 0; e < 4; ++e) { float r[2];
#pragma unroll
            for (int hh = 0; hh < 2; ++hh) { const int cc = c + 2 * e + hh;
                const float a2 = hh ? __uint_as_float(g2[e] & 0xffff0000u) : __uint_as_float(g2[e] << 16), a1 = hh ? __uint_as_float(g1[e] & 0xffff0000u) : __uint_as_float(g1[e] << 16), a0 = hh ? __uint_as_float(g0[e] & 0xffff0000u) : __uint_as_float(g0[e] << 16);
                const float uv = hh ? __uint_as_float(uu[e] & 0xffff0000u) : __uint_as_float(uu[e] << 16);
                const float gg = ffn_cb[cc] + ffn_cw[2 * DFF + cc] * a2 + ffn_cw[DFF + cc] * a1 + ffn_cw[cc] * a0;
                r[hh] = silu_f(gg) * uv; }
            o[e] = (unsigned)f2bf(r[0]) | ((unsigned)f2bf(r[1]) << 16); }
        *(u32x4*)(UF + off) = o;
    }
    GRID_BAR();
    GEMMX(EpiRes, EI(out, out, nullptr, SS3), UF, wt_down, MTOK, DM, DFF);
    GRID_BAR();
    for (int r = bx * 8 + wave; r < MTOK; r += G * 8) {
        const float rs = rstd_from_ss(SS3, (size_t)r);
        f32x4* xr = (f32x4*)(out + (size_t)r * DM) + lane; const f32x4* gr = (const f32x4*)g_final + lane;
#pragma unroll
        for (int j = 0; j < 4; ++j) xr[64 * j] = xr[64 * j] * rs * gr[64 * j];
    }
}

extern "C" void kernel_launch(void* const* d_in, const int* in_sizes, int n_in, void* d_out, int out_size, void* d_ws, size_t ws_size, hipStream_t stream) {
    static int grid = 0;
    if (grid == 0) {
        int dev = 0, cus = 0, per_cu = 0;
        if (hipGetDevice(&dev) != hipSuccess || hipDeviceGetAttribute(&cus, hipDeviceAttributeMultiprocessorCount, dev) != hipSuccess) { fprintf(stderr, "kernel_launch: device query failed\n"); grid = -1; return; }
        if (hipFuncSetAttribute((const void*)mega_k, hipFuncAttributeMaxDynamicSharedMemorySize, LDS_BYTES) != hipSuccess) { fprintf(stderr, "kernel_launch: hipFuncSetAttribute failed\n"); grid = -1; return; }
        if (hipOccupancyMaxActiveBlocksPerMultiprocessor(&per_cu, (const void*)mega_k, 512, LDS_BYTES) != hipSuccess || per_cu < 1) { fprintf(stderr, "kernel_launch: occupancy query says %d\n", per_cu); per_cu = 1; }
        (void)hipGetLastError();
        grid = cus * 1;
        if (n_in != 23 || ws_size < 477 * MiB) { fprintf(stderr, "kernel_launch: unexpected n_in %d / ws %zu\n", n_in, ws_size); grid = -1; return; }
    }
    if (grid < 0) return;
    (void)hipMemsetAsync((char*)d_ws + WS_CTL, 0, CTL_ZERO_BYTES, stream);
    Args a{};
    for (int i = 0; i < 23; ++i) a.in[i] = (const float*)d_in[i];
    a.out = (float*)d_out; a.ws = (unsigned char*)d_ws;
    void* params[] = {&a};
    hipError_t e = hipLaunchCooperativeKernel((const void*)mega_k, dim3(grid), dim3(512), params, LDS_BYTES, stream);
    if (e != hipSuccess) fprintf(stderr, "cooperative launch failed: %s (grid %d)\n", hipGetErrorString(e), grid);
}
```

```cpp
#include <hip/hip_runtime.h>
#include <cstdio>
#include <cstdint>
#include <cmath>
namespace pg8 {
#define PG8_LAS __attribute__((address_space(3)))
typedef unsigned short bf16_t;
typedef short bf16x8 __attribute__((ext_vector_type(8)));
typedef float f32x4 __attribute__((ext_vector_type(4)));
typedef unsigned u32x4 __attribute__((ext_vector_type(4)));
constexpr int BM = 256, BK = 64, HALF = 128, HTB = HALF * BK * 2  , STAGE_BYTES = 8 * HTB, NXCD = 8, WGM = 8;

__host__ __device__ __forceinline__ int lds_byte(int r, int c) { const int st = (r >> 4) * 2 + (c >> 5), rr = r & 15, cc = c & 31, ob = rr * 64 + cc * 2; return st * 1024 + (ob ^ (((ob >> 9) & 1) << 5)); }
__host__ __device__ __forceinline__ void stage_rc(int b, int& R, int& C) { const int st = b / 1024, sb = b % 1024, swz = sb ^ (((sb >> 9) & 1) << 5); R = (st >> 1) * 16 + swz / 64; C = (st & 1) * 32 + (swz % 64) / 2; }
__host__ __device__ __forceinline__ int perm32(int rho) { const int n = rho >> 4, i = rho & 15; return 8 * (i >> 2) + 4 * n + (i & 3); }

struct Unit { int pm, pn; };
struct Gemm { const bf16_t* A; const bf16_t* Bt; int M, N, K; };

struct StaticOrder {
    int nM, nN, nwg, G, c;
    __host__ __device__ void init(int M, int N, int G_, int c_) { nM = M / BM; nN = N / BM; nwg = nM * nN; G = G_; c = c_; }
    __host__ __device__ bool next(int i, Unit& u) const {
        const long L = (long)i * G + c; if (L >= nwg) return false;
        int wgid = (int)L; { const int q = nwg / NXCD, r = nwg % NXCD, xcd = wgid % NXCD, off = wgid / NXCD; wgid = (xcd < r ? xcd * (q + 1) : r * (q + 1) + (xcd - r) * q) + off; }
        const int nig = WGM * nN, gid = wgid / nig, fm = gid * WGM, gsz = (nM - fm) < WGM ? (nM - fm) : WGM;
        u.pm = fm + ((wgid % nig) % gsz); u.pn = (wgid % nig) / gsz; return true;
    }
    __device__ __forceinline__ void a_ready(const Unit&) const {}
    __device__ __forceinline__ void done(const Unit&) const {}
};
__device__ __forceinline__ unsigned cvt_pk_bf16(float lo, float hi) { unsigned r; asm volatile("v_cvt_pk_bf16_f32 %0, %1, %2" : "=v"(r) : "v"(lo), "v"(hi)); return r; }
template <class Epi, class Sched, bool ALIGN_EPI = false, bool SP2 = false>
__device__ __forceinline__ void gemm_phase(PG8_LAS unsigned char* lds, const Gemm g, const Sched& S, const Epi& E, int tid_in) {
    int tid_l = tid_in; asm volatile("" : "+v"(tid_l));
    const int tid = tid_l, wid = __builtin_amdgcn_readfirstlane(tid >> 6), lane = tid & 63, wr = wid >> 2, wc = wid & 3, fr = lane & 15, fq = lane >> 4;
    const int K = g.K, nt = K / BK;
    unsigned voffA[2], voffB[2];
#pragma unroll
    for (int i = 0; i < 2; ++i) { int R, C; stage_rc(tid * 16 + i * 8192, R, C); const int Rb = Epi::PERM ? ((R & ~31) + perm32(R & 31)) : R;
        voffA[i] = (unsigned)(R * K + C) * 2u; voffB[i] = (unsigned)(Rb * K + C) * 2u; }
    const size_t kstep = (size_t)(BK * 2);
    const size_t hstep = (size_t)HALF * K * 2;
    const size_t tstep = 2 * hstep;
    const unsigned ldsw = (unsigned)wid * 1024u;
    const int aoff = lds_byte(wr * 64 + fr, fq * 8), boff = lds_byte(wc * 32 + fr, fq * 8);
#define PG8_SA(b, h) (((b) * 2 + (h)) * HTB)
#define PG8_SB(b, h) ((4 + (b) * 2 + (h)) * HTB)
#define PG8_STAGE(bufoff, gbase, voff) do { _Pragma("unroll") for (int _i = 0; _i < 2; ++_i) \
        __builtin_amdgcn_global_load_lds((const unsigned*)((const char*)(gbase) + (voff)[_i]), (PG8_LAS unsigned*)(lds + (bufoff) + ldsw + _i * 8192), 16, 0, 0); } while (0)
#define PG8_LDA(dst, b, h) do { _Pragma("unroll") for (int m = 0; m < 4; ++m) _Pragma("unroll") for (int k = 0; k < 2; ++k) dst[m][k] = *(const PG8_LAS bf16x8*)(lds + PG8_SA(b, h) + aoff + m * 2048 + k * 1024); } while (0)
#define PG8_LDB(dst, b, h) do { _Pragma("unroll") for (int n = 0; n < 2; ++n) _Pragma("unroll") for (int k = 0; k < 2; ++k) dst[n][k] = *(const PG8_LAS bf16x8*)(lds + PG8_SB(b, h) + boff + n * 2048 + k * 1024); } while (0)
#define PG8_MMA(ai, bj, At, Bt) do { __builtin_amdgcn_s_setprio(1); _Pragma("unroll") for (int m = 0; m < 4; ++m) _Pragma("unroll") for (int n = 0; n < 2; ++n) _Pragma("unroll") for (int k = 0; k < 2; ++k) \
        acc[ai][bj][m][n] = __builtin_amdgcn_mfma_f32_16x16x32_bf16(Bt[n][k], At[m][k], acc[ai][bj][m][n], 0, 0, 0); __builtin_amdgcn_s_setprio(0); } while (0)
#define PG8_WAIT_V(n) asm volatile("s_waitcnt vmcnt(" #n ")" ::: "memory")
#define PG8_WAIT_L(n) asm volatile("s_waitcnt lgkmcnt(" #n ")" ::: "memory")
#define PG8_BAR __builtin_amdgcn_s_barrier()
#define PG8_SCHED __builtin_amdgcn_sched_barrier(0)
    Unit cur, nxt; int ui = 0;
    if (!S.next(0, cur)) return;
    f32x4 acc[2][2][4][2];
#pragma unroll
    for (int a = 0; a < 2; ++a)
#pragma unroll
        for (int b = 0; b < 2; ++b)
#pragma unroll
            for (int m = 0; m < 4; ++m)
#pragma unroll
                for (int n = 0; n < 2; ++n) acc[a][b][m][n] = (f32x4){0.f, 0.f, 0.f, 0.f};
    bf16x8 At[4][2], B0[2][2], B1[2][2];
    const char* cA = (const char*)g.A + (size_t)cur.pm * tstep; const char* cB = (const char*)g.Bt + (size_t)cur.pn * tstep;
    S.a_ready(cur);
    if constexpr (SP2) {
        PG8_STAGE(PG8_SB(0, 0), cB, voffB); PG8_STAGE(PG8_SB(0, 1), cB + hstep, voffB); PG8_STAGE(PG8_SA(0, 0), cA, voffA); PG8_STAGE(PG8_SA(0, 1), cA + hstep, voffA);
        if (wr == 1) PG8_BAR;
        PG8_WAIT_V(2); PG8_BAR;
        PG8_STAGE(PG8_SB(1, 0), cB + kstep, voffB); PG8_STAGE(PG8_SA(1, 0), cA + kstep, voffA); PG8_STAGE(PG8_SB(1, 1), cB + hstep + kstep, voffB);
        PG8_WAIT_V(6); PG8_BAR;
    } else {
        PG8_STAGE(PG8_SB(0, 0), cB, voffB); PG8_STAGE(PG8_SA(0, 0), cA, voffA); PG8_STAGE(PG8_SB(0, 1), cB + hstep, voffB); PG8_STAGE(PG8_SA(0, 1), cA + hstep, voffA);
        if (wr == 1) PG8_BAR;
        PG8_WAIT_V(4); PG8_BAR;
        PG8_STAGE(PG8_SB(1, 0), cB + kstep, voffB); PG8_STAGE(PG8_SA(1, 0), cA + kstep, voffA); PG8_STAGE(PG8_SB(1, 1), cB + hstep + kstep, voffB);
        PG8_WAIT_V(6); PG8_BAR;
    }
    for (;;) {
        const bool has_next = S.next(ui + 1, nxt);
        const char* nA = has_next ? (const char*)g.A + (size_t)nxt.pm * tstep : cA; const char* nB = has_next ? (const char*)g.Bt + (size_t)nxt.pn * tstep : cB;
        for (int t = 0; t < nt; t += 2) {
            const bool last = (t == nt - 2);
            const char* a1 = cA + (size_t)(t + 1) * kstep;
            const char* a2 = last ? nA : cA + (size_t)(t + 2) * kstep; const char* b2 = last ? nB : cB + (size_t)(t + 2) * kstep;
            const char* a3 = a2 + kstep; const char* b3 = b2 + kstep;
            if (last && has_next) S.a_ready(nxt);
            if constexpr (SP2) {
            PG8_LDB(B0, 0, 0); PG8_LDB(B1, 0, 1); PG8_SCHED; PG8_LDA(At, 0, 0); PG8_STAGE(PG8_SA(1, 1), a1 + hstep, voffA);
            PG8_WAIT_V(8); PG8_WAIT_L(0); PG8_BAR; PG8_MMA(0, 0, At, B0); PG8_MMA(0, 1, At, B1); PG8_BAR; PG8_SCHED;
            PG8_LDA(At, 0, 1); PG8_STAGE(PG8_SB(0, 0), b2, voffB); PG8_STAGE(PG8_SB(0, 1), b2 + hstep, voffB); PG8_STAGE(PG8_SA(0, 0), a2, voffA);
            PG8_WAIT_V(8); PG8_WAIT_L(0); PG8_BAR; PG8_MMA(1, 0, At, B0); PG8_MMA(1, 1, At, B1); PG8_BAR; PG8_SCHED;
            PG8_LDB(B0, 1, 0); PG8_LDB(B1, 1, 1); PG8_SCHED; PG8_LDA(At, 1, 0); PG8_STAGE(PG8_SA(0, 1), a2 + hstep, voffA);
            PG8_WAIT_V(8); PG8_WAIT_L(0); PG8_BAR; PG8_MMA(0, 0, At, B0); PG8_MMA(0, 1, At, B1); PG8_BAR; PG8_SCHED;
            PG8_LDA(At, 1, 1); PG8_STAGE(PG8_SB(1, 0), b3, voffB); PG8_STAGE(PG8_SB(1, 1), b3 + hstep, voffB); PG8_STAGE(PG8_SA(1, 0), a3, voffA);
            PG8_WAIT_V(8); PG8_WAIT_L(0); PG8_BAR; PG8_MMA(1, 0, At, B0); PG8_MMA(1, 1, At, B1); PG8_BAR; PG8_SCHED;
            } else {
            PG8_LDB(B0, 0, 0); PG8_SCHED; PG8_LDA(At, 0, 0); PG8_STAGE(PG8_SA(1, 1), a1 + hstep, voffA);
            PG8_WAIT_L(8); PG8_BAR; PG8_WAIT_L(0); PG8_MMA(0, 0, At, B0); PG8_BAR; PG8_SCHED;
            PG8_LDB(B1, 0, 1); PG8_STAGE(PG8_SB(0, 0), b2, voffB);
            PG8_BAR; PG8_WAIT_L(0); PG8_MMA(0, 1, At, B1); PG8_BAR;
            PG8_LDA(At, 0, 1); PG8_STAGE(PG8_SA(0, 0), a2, voffA);
            PG8_BAR; PG8_WAIT_L(0); PG8_MMA(1, 0, At, B0); PG8_BAR; PG8_SCHED;
            PG8_STAGE(PG8_SB(0, 1), b2 + hstep, voffB);
            PG8_WAIT_V(6); PG8_BAR; PG8_MMA(1, 1, At, B1); PG8_BAR;
            PG8_LDB(B0, 1, 0); PG8_SCHED; PG8_LDA(At, 1, 0); PG8_STAGE(PG8_SA(0, 1), a2 + hstep, voffA);
            PG8_WAIT_L(8); PG8_BAR; PG8_WAIT_L(0); PG8_MMA(0, 0, At, B0); PG8_BAR; PG8_SCHED;
            PG8_LDB(B1, 1, 1); PG8_STAGE(PG8_SB(1, 0), b3, voffB);
            PG8_BAR; PG8_WAIT_L(0); PG8_MMA(0, 1, At, B1); PG8_BAR;
            PG8_LDA(At, 1, 1); PG8_STAGE(PG8_SA(1, 0), a3, voffA);
            PG8_BAR; PG8_WAIT_L(0); PG8_MMA(1, 0, At, B0); PG8_BAR; PG8_SCHED;
            PG8_STAGE(PG8_SB(1, 1), b3 + hstep, voffB);
            PG8_WAIT_V(6); PG8_BAR; PG8_MMA(1, 1, At, B1); PG8_BAR;
            }
        }
        if constexpr (ALIGN_EPI) { if (wr == 0) PG8_BAR; }
        if constexpr (!Epi::AFTER_DRAIN) { E(acc, cur, wr, wc, fr, fq); S.done(cur); }
        if (!has_next) break;
#pragma unroll
        for (int a = 0; a < 2; ++a)
#pragma unroll
            for (int b = 0; b < 2; ++b)
#pragma unroll
                for (int m = 0; m < 4; ++m)
#pragma unroll
                    for (int n = 0; n < 2; ++n) acc[a][b][m][n] = (f32x4){0.f, 0.f, 0.f, 0.f};
        cur = nxt; cA = nA; cB = nB; ++ui;
        if constexpr (ALIGN_EPI) { if (wr == 1) PG8_BAR; }
    }
    PG8_WAIT_V(0);
    if constexpr (!ALIGN_EPI) { if (wr == 0) PG8_BAR; }
    PG8_BAR;
    if constexpr (Epi::AFTER_DRAIN) { E.fused(acc, cur, wr, wc, fr, fq, lds, wid, lane); S.done(cur); }
#undef PG8_SA
#undef PG8_SB
#undef PG8_STAGE
#undef PG8_LDA
#undef PG8_LDB
#undef PG8_MMA
#undef PG8_WAIT_V
#undef PG8_WAIT_L
#undef PG8_BAR
#undef PG8_SCHED
}
}

constexpr int BATCH = 8, SEQ = 4096, DM = 1024, MTOK = BATCH * SEQ;
constexpr int NMEM = 256, MMEM = BATCH * NMEM;
constexpr int AW = 512, HD = 64, NH = 8, IH = 4, TOPK = 256;
constexpr int INC = 1988, INP = 2048;
constexpr int DFF = 2816;
constexpr float EPS = 1e-6f;
#define LAS __attribute__((address_space(3)))
typedef unsigned short bf16_t;
typedef float f32x4 __attribute__((ext_vector_type(4)));
typedef unsigned u32x4 __attribute__((ext_vector_type(4)));
typedef unsigned u32x2 __attribute__((ext_vector_type(2)));

__device__ __forceinline__ float bf2f(bf16_t v) { return __uint_as_float((unsigned)v << 16); }
__device__ __forceinline__ bf16_t f2bf(float f) { unsigned u = __float_as_uint(f); return (bf16_t)((u + 0x7fffu + ((u >> 16) & 1u)) >> 16); }
__device__ __forceinline__ float shx(float v, int lane, int o) { return __uint_as_float((unsigned)__builtin_amdgcn_ds_bpermute((lane ^ o) << 2, (int)__float_as_uint(v))); }
__device__ __forceinline__ float wave_sum_l(float v, int lane) {
#pragma unroll
    for (int o = 1; o < 64; o <<= 1) v += shx(v, lane, o);
    return v;
}
__device__ __forceinline__ float wave_sum(float v) {
#pragma unroll
    for (int o = 1; o < 64; o <<= 1) v += __shfl_xor(v, o);
    return v;
}
__device__ __forceinline__ float wave_max(float v) {
#pragma unroll
    for (int o = 1; o < 64; o <<= 1) v = fmaxf(v, __shfl_xor(v, o));
    return v;
}
__device__ __forceinline__ float silu_f(float v) { return v / (1.f + __expf(-v)); }

struct EpiStore {
    static constexpr bool PERM = false, AFTER_DRAIN = false;
    float* outf; bf16_t* outb; const float* res; int ldc;
    __device__ __forceinline__ void operator()(const pg8::f32x4 (&acc)[2][2][4][2], const pg8::Unit& u, int wr, int wc, int fr, int fq) const {
        const int col0 = u.pn * 256 + wc * 32 + 4 * fq;
#pragma unroll
        for (int ai = 0; ai < 2; ++ai)
#pragma unroll
            for (int m = 0; m < 4; ++m) {
                const size_t row = (size_t)(u.pm * 256 + ai * 128 + wr * 64 + m * 16 + fr);
#pragma unroll
                for (int bj = 0; bj < 2; ++bj)
#pragma unroll
                    for (int n = 0; n < 2; ++n) {
                        const size_t off = row * ldc + col0 + bj * 128 + n * 16;
                        pg8::f32x4 v = acc[ai][bj][m][n];
                        if (res) { const pg8::f32x4 r = *(const pg8::f32x4*)(res + off); v = v + r; }
                        if (outf) *(pg8::f32x4*)(outf + off) = v;
                        if (outb) { u32x2 w; w.x = (unsigned)f2bf(v[0]) | ((unsigned)f2bf(v[1]) << 16); w.y = (unsigned)f2bf(v[2]) | ((unsigned)f2bf(v[3]) << 16); *(u32x2*)(outb + off) = w; }
                    }
            }
    }
};
#define XB_TMO      128
#define XB_XCNT(j)  (256  + 64 * (j))
#define XB_XSUB(j)  (1280 + 64 * (j))
#define XB_XGEN(j)  (2304 + 64 * (j))
#define XB_TOP      3328
#define XB_TOPGEN   3392
#define XCD_BAR_WORDS 3456
#define XB_SPIN_CAP (1u << 18)

__device__ __forceinline__ unsigned xb_ld(unsigned* p)              { return __hip_atomic_load(p, __ATOMIC_RELAXED, __HIP_MEMORY_SCOPE_AGENT); }
__device__ __forceinline__ unsigned xb_add(unsigned* p, unsigned v) { return __hip_atomic_fetch_add(p, v, __ATOMIC_RELAXED, __HIP_MEMORY_SCOPE_AGENT); }
__device__ __forceinline__ unsigned xb_xcc_id() { return (unsigned)__builtin_amdgcn_s_getreg((3 << 11) | 20) & 0xFu; }
#define XB_SPIN(cond, bar) do { unsigned _sp = 0; while (cond) { __builtin_amdgcn_s_sleep(1); \
    if ((++_sp & 255u) == 0u) { if (xb_ld(&(bar)[XB_TMO])) break; if (_sp > XB_SPIN_CAP) { atomicAdd(&(bar)[XB_TMO], 1u); break; } } } } while (0)

struct XcdBarrier {
    unsigned* bar; unsigned x;
    volatile LAS unsigned* st;
};

__device__ __forceinline__ XcdBarrier xcd_barrier_post(unsigned* bar, volatile LAS unsigned* st) {
    XcdBarrier b; b.bar = bar; b.x = xb_xcc_id(); b.st = st;
    if (threadIdx.x == 0) (void)xb_add(&bar[XB_XCNT(b.x)], 1u);
    return b;
}
__device__ __forceinline__ void xcd_barrier_complete(unsigned* bar, unsigned x, unsigned& nloc, unsigned& nx) {
    const unsigned G = gridDim.x * gridDim.y * gridDim.z;
    unsigned sum, cnt, mine, sp = 0u;
    for (;;) {
        sum = 0u; cnt = 0u; mine = 0u;
#pragma unroll
        for (unsigned j = 0; j < 16; ++j) { const unsigned c = xb_ld(&bar[XB_XCNT(j)]); sum += c; cnt += (c > 0u) ? 1u : 0u; mine = (j == x) ? c : mine; }
        if (sum == G) break;
        __builtin_amdgcn_s_sleep(1);
        if ((++sp & 255u) == 0u) { if (xb_ld(&bar[XB_TMO])) break; if (sp > XB_SPIN_CAP) { atomicAdd(&bar[XB_TMO], 1u); break; } }
    }
    nloc = mine > 0u ? mine : 1u; nx = cnt > 0u ? cnt : 1u;
}

__device__ __forceinline__ void xcd_barrier(const XcdBarrier& b) {
    asm volatile("s_waitcnt vmcnt(0)" ::: "memory");
    __syncthreads();
    if (threadIdx.x == 0) {
        unsigned* bar = b.bar;
        __builtin_amdgcn_s_waitcnt(0);
        unsigned nloc = b.st[0], nx = b.st[1];
        if (nloc == 0u) { xcd_barrier_complete(bar, b.x, nloc, nx); b.st[0] = nloc; b.st[1] = nx; }
        const unsigned old = xb_add(&bar[XB_XSUB(b.x)], 1u);
        const unsigned gen = old / nloc;
        if (old + 1u == (gen + 1u) * nloc) {
            __builtin_amdgcn_fence(__ATOMIC_RELEASE, "agent");
            asm volatile("s_waitcnt vmcnt(0)" ::: "memory");
            const unsigned og = xb_add(&bar[XB_TOP], 1u);
            const unsigned tg = og / nx;
            if (og + 1u == (tg + 1u) * nx) xb_add(&bar[XB_TOPGEN], 1u);
            else XB_SPIN(xb_ld(&bar[XB_TOPGEN]) == tg, bar);
            __builtin_amdgcn_fence(__ATOMIC_ACQUIRE, "agent");
            xb_add(&bar[XB_XGEN(b.x)], 1u);
            asm volatile("s_waitcnt vmcnt(0)" ::: "memory");
        } else {
            XB_SPIN(xb_ld(&bar[XB_XGEN(b.x)]) == gen, bar);
            __builtin_amdgcn_fence(__ATOMIC_ACQUIRE, "agent");
            asm volatile("s_waitcnt vmcnt(0)" ::: "memory");
        }
    }
    __syncthreads();
}

__device__ __forceinline__ u32x4 pack8(const pg8::f32x4 a, const pg8::f32x4 b) {
    u32x4 w; w.x = pg8::cvt_pk_bf16(a[0], a[1]); w.y = pg8::cvt_pk_bf16(a[2], a[3]); w.z = pg8::cvt_pk_bf16(b[0], b[1]); w.w = pg8::cvt_pk_bf16(b[2], b[3]); return w;
}
__device__ __forceinline__ float sigmoid_f(float v) { return 1.f / (1.f + __expf(-v)); }
__host__ __device__ __forceinline__ int dperm(int pos) { return pos < 16 ? (4 * (pos >> 3) + (pos & 3) + 8 * ((pos >> 2) & 1)) : pos; }
__host__ __device__ __forceinline__ int in_orig_col(int n) {
    if (n < 512) return (n & ~63) + dperm(n & 63);
    if (n < 576) return 512 + dperm(n - 512);
    if (n < 640) return 576 + (n - 576);
    if (n < 704) return 896 + dperm(n - 640);
    if (n < 708) return 960 + (n - 704);
    if (n < 768) return -1;
    if (n < 1024) return 640 + ((n - 768) & ~63) + dperm((n - 768) & 63);
    const int i = (n - 1024) >> 8, c = (n - 1024) & 255;
    return c < 128 ? 964 + 128 * i + c : 1476 + 128 * i + (c - 128);
}
struct EpiIn {
    static constexpr bool PERM = true, AFTER_DRAIN = false;
    const float* cs; bf16_t *Q, *K, *V, *QI, *KI, *U; float* WI;
    __device__ __forceinline__ void operator()(const pg8::f32x4 (&acc)[2][2][4][2], const pg8::Unit& u, int wr, int wc, int fr, int fq) const {
        const int pn = u.pn;
        if (pn >= 4) {
            const int ch = 128 * (pn - 4) + 32 * wc + 8 * fq;
#pragma unroll
            for (int ai = 0; ai < 2; ++ai)
#pragma unroll
                for (int m = 0; m < 4; ++m) { const size_t row = (size_t)(u.pm * 256 + ai * 128 + wr * 64 + m * 16 + fr);
                    pg8::f32x4 a0 = acc[ai][0][m][0], a1 = acc[ai][0][m][1]; const pg8::f32x4 g0 = acc[ai][1][m][0], g1 = acc[ai][1][m][1];
#pragma unroll
                    for (int k = 0; k < 4; ++k) { a0[k] *= sigmoid_f(g0[k]); a1[k] *= sigmoid_f(g1[k]); }
                    *(u32x4*)(U + row * 512 + ch) = pack8(a0, a1); }
            return;
        }
        const bool rot = (pn == 2) ? (wc == 0 && fq < 2) : ((wc & 1) == 0 && fq < 2);
#pragma unroll
        for (int ai = 0; ai < 2; ++ai)
#pragma unroll
            for (int m = 0; m < 4; ++m) { const size_t row = (size_t)(u.pm * 256 + ai * 128 + wr * 64 + m * 16 + fr);
                pg8::f32x4 cv = {1.f, 1.f, 1.f, 1.f}, sv = {0.f, 0.f, 0.f, 0.f};
                if (rot) { cv = *(const pg8::f32x4*)(cs + row * 16 + 4 * fq); sv = *(const pg8::f32x4*)(cs + row * 16 + 8 + 4 * fq); }
#pragma unroll
                for (int bj = 0; bj < 2; ++bj) {
                    const pg8::f32x4 v0 = acc[ai][bj][m][0], v1 = acc[ai][bj][m][1];
                    pg8::f32x4 n0 = v0 * cv - v1 * sv, n1 = v1 * cv + v0 * sv;
                    if (!rot) { n0 = v0; n1 = v1; }
                    const int c = 128 * bj + 32 * wc + 8 * fq;
                    if (pn < 2) *(u32x4*)(Q + row * 512 + 256 * pn + c) = pack8(n0, n1);
                    else if (pn == 3) *(u32x4*)(QI + row * 256 + c) = pack8(n0 * 0.125f, n1 * 0.125f);
                    else {
                        if (bj == 0) { if (wc < 2) *(u32x4*)(K + row * 64 + 32 * wc + 8 * fq) = pack8(n0, n1); else *(u32x4*)(V + row * 64 + 32 * (wc - 2) + 8 * fq) = pack8(v0, v1); }
                        else { if (wc < 2) *(u32x4*)(KI + row * 64 + 32 * wc + 8 * fq) = pack8(n0, n1); else if (wc == 2 && fq == 0) *(pg8::f32x4*)(WI + row * 4) = v0 * 0.5f; }
                    }
                }
            }
    }
};
struct EpiRes {
    static constexpr bool PERM = true, AFTER_DRAIN = false;
    const float* res; float* out; bf16_t* xb; float* ss;
    __device__ __forceinline__ void operator()(const pg8::f32x4 (&acc)[2][2][4][2], const pg8::Unit& u, int wr, int wc, int fr, int fq) const {
#pragma unroll
        for (int ai = 0; ai < 2; ++ai)
#pragma unroll
            for (int m = 0; m < 4; ++m) { const size_t row = (size_t)(u.pm * 256 + ai * 128 + wr * 64 + m * 16 + fr); float q = 0.f;
#pragma unroll
                for (int bj = 0; bj < 2; ++bj) { const size_t off = row * DM + u.pn * 256 + 128 * bj + 32 * wc + 8 * fq;
                    const pg8::f32x4 v0 = acc[ai][bj][m][0] + *(const pg8::f32x4*)(res + off), v1 = acc[ai][bj][m][1] + *(const pg8::f32x4*)(res + off + 4);
                    *(pg8::f32x4*)(out + off) = v0; *(pg8::f32x4*)(out + off + 4) = v1;
                    if (xb) *(u32x4*)(xb + off) = pack8(v0, v1);
                    q += (v0[0] * v0[0] + v0[1] * v0[1]) + (v0[2] * v0[2] + v0[3] * v0[3]) + (v1[0] * v1[0] + v1[1] * v1[1]) + (v1[2] * v1[2] + v1[3] * v1[3]); }
                { const int lane_ = fq * 16 + fr; q += shx(q, lane_, 16); q += shx(q, lane_, 32); }
                if (fq == 0) ss[row * 16 + u.pn * 4 + wc] = q; }
    }
};
__device__ __forceinline__ float rstd_from_ss(const float* ss, size_t row) {
    const pg8::f32x4 a = *(const pg8::f32x4*)(ss + row * 16), b = *(const pg8::f32x4*)(ss + row * 16 + 4), c = *(const pg8::f32x4*)(ss + row * 16 + 8), d = *(const pg8::f32x4*)(ss + row * 16 + 12);
    const float s = ((a[0] + a[1]) + (a[2] + a[3])) + ((b[0] + b[1]) + (b[2] + b[3])) + ((c[0] + c[1]) + (c[2] + c[3])) + ((d[0] + d[1]) + (d[2] + d[3]));
    return 1.f / sqrtf(s * (1.f / DM) + EPS);
}
struct EpiScale {
    static constexpr bool PERM = true, AFTER_DRAIN = false;
    const float* ss; bf16_t* O; int ldc; float scale;
    __device__ __forceinline__ void operator()(const pg8::f32x4 (&acc)[2][2][4][2], const pg8::Unit& u, int wr, int wc, int fr, int fq) const {
#pragma unroll
        for (int ai = 0; ai < 2; ++ai)
#pragma unroll
            for (int m = 0; m < 4; ++m) { const size_t row = (size_t)(u.pm * 256 + ai * 128 + wr * 64 + m * 16 + fr); const float r = rstd_from_ss(ss, row) * scale;
#pragma unroll
                for (int bj = 0; bj < 2; ++bj) *(u32x4*)(O + row * ldc + u.pn * 256 + 128 * bj + 32 * wc + 8 * fq) = pack8(acc[ai][bj][m][0] * r, acc[ai][bj][m][1] * r); }
    }
};
struct EpiGateUp {
    static constexpr bool PERM = true, AFTER_DRAIN = false;
    const float* ss; bf16_t* Gb; bf16_t* Ub;
    __device__ __forceinline__ void operator()(const pg8::f32x4 (&acc)[2][2][4][2], const pg8::Unit& u, int wr, int wc, int fr, int fq) const {
        const int ch = 128 * u.pn + 32 * wc + 8 * fq;
#pragma unroll
        for (int ai = 0; ai < 2; ++ai)
#pragma unroll
            for (int m = 0; m < 4; ++m) { const size_t row = (size_t)(u.pm * 256 + ai * 128 + wr * 64 + m * 16 + fr); const float r = rstd_from_ss(ss, row);
                *(u32x4*)(Gb + row * DFF + ch) = pack8(acc[ai][0][m][0] * r, acc[ai][0][m][1] * r);
                *(u32x4*)(Ub + row * DFF + ch) = pack8(acc[ai][1][m][0] * r, acc[ai][1][m][1] * r); }
    }
};
typedef short bf16x8v __attribute__((ext_vector_type(8)));
constexpr int CA_STRIDE = 528;
__device__ __forceinline__ void cross_attn_unit(LAS unsigned char* lds, int b, int h, int qb, const bf16_t* QC, const bf16_t* KC, const bf16_t* VT, bf16_t* OC, int tid, int lane, int wave) {
    const int q16 = lane & 15, g = lane >> 4;
    const size_t row0 = (size_t)b * SEQ + (size_t)qb * 256 + wave * 32;
    asm volatile("" : "+v"(tid));
    { const bf16_t* src = KC + ((size_t)b * NMEM + (tid >> 5)) * DM + h * 256 + (tid & 31) * 8; LAS unsigned char* dst = lds + (tid >> 5) * CA_STRIDE + (tid & 31) * 16;
#pragma unroll
      for (int i = 0; i < 16; ++i) { const u32x4 v = *(const u32x4*)(src + (size_t)i * 16 * DM); *(LAS u32x4*)(dst + i * 16 * CA_STRIDE) = v; } }
    __syncthreads();
    f32x4 S[2][16];
#pragma unroll
    for (int st = 0; st < 2; ++st)
#pragma unroll
        for (int kt = 0; kt < 16; ++kt) S[st][kt] = (f32x4){0.f, 0.f, 0.f, 0.f};
#pragma unroll 1
    for (int kh = 0; kh < 2; ++kh) {
        bf16x8v qf[2][4];
#pragma unroll
        for (int st = 0; st < 2; ++st)
#pragma unroll
            for (int ks = 0; ks < 4; ++ks) qf[st][ks] = *(const bf16x8v*)(QC + (row0 + st * 16 + q16) * DM + h * 256 + kh * 128 + ks * 32 + g * 8);
        const LAS unsigned char* kb = lds + q16 * CA_STRIDE + kh * 256 + g * 16;
#pragma unroll
        for (int kt = 0; kt < 16; ++kt)
#pragma unroll
            for (int ks = 0; ks < 4; ++ks) { const bf16x8v a = *(const LAS bf16x8v*)(kb + kt * 16 * CA_STRIDE + ks * 64);
                S[0][kt] = __builtin_amdgcn_mfma_f32_16x16x32_bf16(a, qf[0][ks], S[0][kt], 0, 0, 0);
                S[1][kt] = __builtin_amdgcn_mfma_f32_16x16x32_bf16(a, qf[1][ks], S[1][kt], 0, 0, 0); }
    }
    const float c2 = 0.0625f * 1.4426950408889634f;
    float linv[2]; bf16x8v P[2][8];
#pragma unroll
    for (int st = 0; st < 2; ++st) {
        float m = -INFINITY;
#pragma unroll
        for (int kt = 0; kt < 16; ++kt) m = fmaxf(fmaxf(fmaxf(S[st][kt][0], S[st][kt][1]), fmaxf(S[st][kt][2], S[st][kt][3])), m);
        m = fmaxf(m, shx(m, lane, 16)); m = fmaxf(m, shx(m, lane, 32));
        const float mc = m * c2; float l = 0.f;
#pragma unroll
        for (int kt = 0; kt < 16; ++kt)
#pragma unroll
            for (int r = 0; r < 4; ++r) { const float p = __builtin_amdgcn_exp2f(S[st][kt][r] * c2 - mc); S[st][kt][r] = p; l += p; }
        l += shx(l, lane, 16); l += shx(l, lane, 32); linv[st] = 1.f / l;
#pragma unroll
        for (int c = 0; c < 8; ++c) { bf16x8v pk;
#pragma unroll
            for (int j = 0; j < 4; ++j) { pk[j] = (short)f2bf(S[st][2 * c][j]); pk[4 + j] = (short)f2bf(S[st][2 * c + 1][j]); }
            P[st][c] = pk; }
    }
    __syncthreads();
    { int tid2 = tid; asm volatile("" : "+v"(tid2));
      const bf16_t* src = VT + (size_t)(h * 256 + (tid2 >> 5)) * MMEM + b * NMEM + (tid2 & 31) * 8; LAS unsigned char* dst = lds + (tid2 >> 5) * CA_STRIDE + (tid2 & 31) * 16;
#pragma unroll
      for (int i = 0; i < 16; ++i) { const u32x4 v = *(const u32x4*)(src + (size_t)i * 16 * MMEM); *(LAS u32x4*)(dst + i * 16 * CA_STRIDE) = v; } }
    __syncthreads();
#pragma unroll 1
    for (int dh = 0; dh < 2; ++dh) {
        f32x4 O[2][8];
#pragma unroll
        for (int st = 0; st < 2; ++st)
#pragma unroll
            for (int dt = 0; dt < 8; ++dt) O[st][dt] = (f32x4){0.f, 0.f, 0.f, 0.f};
        const LAS unsigned char* pb = lds + (dh * 128 + q16) * CA_STRIDE + g * 8;
#pragma unroll
        for (int dt = 0; dt < 8; ++dt)
#pragma unroll
            for (int c = 0; c < 8; ++c) { const LAS unsigned char* p = pb + dt * 16 * CA_STRIDE + c * 64;
                const u32x2 lo = *(const LAS u32x2*)p, hi = *(const LAS u32x2*)(p + 32);
                const u32x4 av = (u32x4){lo.x, lo.y, hi.x, hi.y}; const bf16x8v a = __builtin_bit_cast(bf16x8v, av);
                O[0][dt] = __builtin_amdgcn_mfma_f32_16x16x32_bf16(a, P[0][c], O[0][dt], 0, 0, 0);
                O[1][dt] = __builtin_amdgcn_mfma_f32_16x16x32_bf16(a, P[1][c], O[1][dt], 0, 0, 0); }
#pragma unroll
        for (int st = 0; st < 2; ++st)
#pragma unroll
            for (int dt = 0; dt < 8; ++dt) { const f32x4 o = O[st][dt] * linv[st]; u32x2 w;
                w.x = (unsigned)f2bf(o[0]) | ((unsigned)f2bf(o[1]) << 16); w.y = (unsigned)f2bf(o[2]) | ((unsigned)f2bf(o[3]) << 16);
                *(u32x2*)(OC + (row0 + st * 16 + q16) * DM + h * 256 + dh * 128 + dt * 16 + g * 4) = w; }
    }
    __syncthreads();
}
typedef float f32x16v __attribute__((ext_vector_type(16)));
__device__ __forceinline__ unsigned code16(float s) {
    const _Float16 hf = (_Float16)s; unsigned u = (unsigned)__builtin_bit_cast(unsigned short, hf);
    if ((u & 0x7fffu) == 0u) u = 0u;
    return (u & 0x8000u) ? (~u & 0xffffu) : (u | 0x8000u);
}
__device__ __forceinline__ unsigned mbcnt64(unsigned long long m) { return __builtin_amdgcn_mbcnt_hi((unsigned)(m >> 32), __builtin_amdgcn_mbcnt_lo((unsigned)m, 0u)); }
__device__ __forceinline__ void topk_unit(LAS unsigned char* lds, int b, int j, const bf16_t* QI, const bf16_t* KI, const float* WI, unsigned short* SEL, int tid, int lane, int wave) {
    asm volatile("" : "+v"(tid), "+v"(lane));
    const int t0 = 16 * j, L = t0 + 16, nkt = (L + 31) >> 5;
    const size_t rowbase = (size_t)b * SEQ + t0;
    const int c32 = lane & 31, hi = lane >> 5;
    {
        bf16x8v qa[2][4]; f32x4 wq[2][4];
#pragma unroll
        for (int rt = 0; rt < 2; ++rt) {
#pragma unroll
            for (int ks = 0; ks < 4; ++ks) qa[rt][ks] = *(const bf16x8v*)(QI + (rowbase + 8 * rt + (c32 >> 2)) * 256 + (c32 & 3) * 64 + 16 * ks + 8 * hi);
#pragma unroll
            for (int gq = 0; gq < 4; ++gq) wq[rt][gq] = *(const f32x4*)(WI + (rowbase + 8 * rt + 2 * gq + hi) * 4);
        }
        const bf16_t* kbase = KI + ((size_t)b * SEQ + c32) * 64 + 8 * hi;
        bf16x8v kb[4], kn[4];
        int kt = wave;
        if (kt < nkt) {
#pragma unroll
            for (int ks = 0; ks < 4; ++ks) kb[ks] = *(const bf16x8v*)(kbase + (size_t)kt * 32 * 64 + 16 * ks);
        }
        for (; kt < nkt; kt += 8) {
            const int ktn = (kt + 8 < nkt) ? kt + 8 : kt;
#pragma unroll
            for (int ks = 0; ks < 4; ++ks) kn[ks] = *(const bf16x8v*)(kbase + (size_t)ktn * 32 * 64 + 16 * ks);
#pragma unroll
            for (int rt = 0; rt < 2; ++rt) {
                f32x16v c = {0.f, 0.f, 0.f, 0.f, 0.f, 0.f, 0.f, 0.f, 0.f, 0.f, 0.f, 0.f, 0.f, 0.f, 0.f, 0.f};
#pragma unroll
                for (int ks = 0; ks < 4; ++ks) c = __builtin_amdgcn_mfma_f32_32x32x16_bf16(qa[rt][ks], kb[ks], c, 0, 0, 0);
#pragma unroll
                for (int gq = 0; gq < 4; ++gq) {
                    const f32x4 w = wq[rt][gq];
                    const float sc = w[0] * fmaxf(c[4 * gq + 0], 0.f) + w[1] * fmaxf(c[4 * gq + 1], 0.f) + w[2] * fmaxf(c[4 * gq + 2], 0.f) + w[3] * fmaxf(c[4 * gq + 3], 0.f);
                    const int q = 8 * rt + 2 * gq + hi;
                    *(LAS unsigned short*)(lds + q * 8192 + (kt * 32 + c32) * 2) = (unsigned short)code16(sc);
                }
            }
#pragma unroll
            for (int ks = 0; ks < 4; ++ks) kb[ks] = kn[ks];
        }
    }
    __syncthreads();
#pragma unroll 1
    for (int qq = 0; qq < 2; ++qq) {
        const int q = 2 * wave + qq, t = t0 + q, n = t + 1;
        unsigned short* sel = SEL + (rowbase + q) * TOPK;
        if (n <= TOPK) {
#pragma unroll
            for (int i = 0; i < 4; ++i) { const int s = lane + 64 * i; if (s < n) sel[s] = (unsigned short)s; }
            continue;
        }
        const int nch = (n + 127) >> 7;
        unsigned lo[32], hi16[32];
        const LAS unsigned* row = (const LAS unsigned*)(lds + q * 8192) + lane;
#pragma unroll
        for (int c = 0; c < 32; ++c) {
            unsigned v = 0u; if (c < nch) v = row[64 * c];
            const int i0 = 128 * c + 2 * lane;
            lo[c] = (i0 <= t) ? (v & 0xffffu) : 0u; hi16[c] = (i0 + 1 <= t) ? (v >> 16) : 0u;
        }
#define TK_COUNT(CMP, RES) do { unsigned cl_ = 0u; \
            _Pragma("unroll") for (int c = 0; c < 8; ++c) { cl_ += (lo[c] CMP) ? 1u : 0u; cl_ += (hi16[c] CMP) ? 1u : 0u; } \
            if (nch > 8)  { _Pragma("unroll") for (int c = 8; c < 16; ++c)  { cl_ += (lo[c] CMP) ? 1u : 0u; cl_ += (hi16[c] CMP) ? 1u : 0u; } } \
            if (nch > 16) { _Pragma("unroll") for (int c = 16; c < 24; ++c) { cl_ += (lo[c] CMP) ? 1u : 0u; cl_ += (hi16[c] CMP) ? 1u : 0u; } } \
            if (nch > 24) { _Pragma("unroll") for (int c = 24; c < 32; ++c) { cl_ += (lo[c] CMP) ? 1u : 0u; cl_ += (hi16[c] CMP) ? 1u : 0u; } } \
            unsigned tot_ = 0u; _Pragma("unroll") for (int bb = 0; bb < 7; ++bb) tot_ += (unsigned)__popcll(__ballot((cl_ >> bb) & 1u)) << bb; RES = tot_; } while (0)
        unsigned T = 0u;
#pragma unroll 1
        for (int bit = 15; bit >= 0; --bit) {
            const unsigned cand = T | (1u << bit); unsigned cnt;
            TK_COUNT(>= cand, cnt);
            if (cnt >= (unsigned)TOPK) T = cand;
        }
        unsigned cgt;
        TK_COUNT(> T, cgt);
#undef TK_COUNT
        const unsigned need = (unsigned)TOPK - cgt;
        unsigned eqrun = 0u, selrun = 0u;
#pragma unroll
        for (int c = 0; c < 32; ++c) if (c < nch) {
            const bool elo = lo[c] == T, ehi = hi16[c] == T;
            const unsigned long long melo = __ballot(elo), mehi = __ballot(ehi);
            const unsigned rank_lo = eqrun + mbcnt64(melo) + mbcnt64(mehi), rank_hi = rank_lo + (elo ? 1u : 0u);
            const bool tlo = (lo[c] > T) || (elo && rank_lo < need), thi = (hi16[c] > T) || (ehi && rank_hi < need);
            const unsigned long long mtlo = __ballot(tlo), mthi = __ballot(thi);
            const unsigned pos_lo = selrun + mbcnt64(mtlo) + mbcnt64(mthi), pos_hi = pos_lo + (tlo ? 1u : 0u);
            if (tlo && pos_lo < (unsigned)TOPK) sel[pos_lo] = (unsigned short)(128 * c + 2 * lane);
            if (thi && pos_hi < (unsigned)TOPK) sel[pos_hi] = (unsigned short)(128 * c + 2 * lane + 1);
            eqrun += (unsigned)__popcll(melo) + (unsigned)__popcll(mehi); selrun += (unsigned)__popcll(mtlo) + (unsigned)__popcll(mthi);
        }
    }
    __syncthreads();
}
__device__ __forceinline__ void topk_phase(LAS unsigned char* lds, int G, int vcu, const bf16_t* QI, const bf16_t* KI, const float* WI, unsigned short* SEL, int tid, int lane, int wave) {
    if (G == 256) {
        const int b = vcu >> 5, i = vcu & 31;
#pragma unroll 1
        for (int k = 0; k < 8; ++k) { const int j = 64 * (k >> 1) + ((k & 1) ? 63 - i : i); topk_unit(lds, b, j, QI, KI, WI, SEL, tid, lane, wave); }
    } else {
#pragma unroll 1
        for (int u = vcu; u < BATCH * 256; u += G) topk_unit(lds, u >> 8, u & 255, QI, KI, WI, SEL, tid, lane, wave);
    }
}
typedef short v4i16_t __attribute__((ext_vector_type(4)));
constexpr int SV_STRIDE = 160, SV_TILE_BYTES = 64 * SV_STRIDE, SV_WAVE_BYTES = SV_TILE_BYTES + 1024;
__device__ __forceinline__ v4i16_t tr_read16(const LAS unsigned char* p) { return __builtin_amdgcn_ds_read_tr16_b64_v4i16((LAS v4i16_t*)p); }
#define SP_FENCE() asm volatile("" ::: "memory")
__device__ __forceinline__ void sparse_attn_phase(LAS unsigned char* lds, int G, int vcu, const bf16_t* Q, const bf16_t* Kb, const bf16_t* Vb, const unsigned short* SEL, bf16_t* MIX, int lane, int wave) {
    asm volatile("" : "+v"(lane));
    LAS unsigned char* wl = lds + wave * SV_WAVE_BYTES;
    const int q16 = lane & 15, g = lane >> 4;
    const int nq = (G == 256) ? 16 : (MTOK - (vcu * 8 + wave) + G * 8 - 1) / (G * 8);
    const int r_first = (G == 256) ? (vcu >> 5) * SEQ + (vcu & 31) * 8 + wave : vcu * 8 + wave, r_step = (G == 256) ? 256 : G * 8;
    u32x2 selv = (u32x2){0u, 0u};
    if (nq > 0) selv = *(const u32x2*)(SEL + (size_t)r_first * TOPK + 4 * lane);
    LAS unsigned char* wdst = wl + (lane >> 3) * SV_STRIDE + (lane & 7) * 16;
    const LAS unsigned char* rsrc = wl + (4 * g + (q16 >> 2)) * SV_STRIDE + (q16 & 3) * 8;
    const float c2 = 0.125f * 1.4426950408889634f;
#pragma unroll 1
    for (int k = 0; k < nq; ++k) {
        const size_t row = (size_t)r_first + (size_t)k * r_step; const int b = (int)(row / SEQ), t = (int)(row % SEQ);
        const int n = (t + 1 < TOPK) ? t + 1 : TOPK;
        LAS unsigned char* ib = wl + SV_TILE_BYTES + (k & 1) * 512;
        *(LAS u32x2*)(ib + lane * 8) = selv;
        if (k + 1 < nq) selv = *(const u32x2*)(SEL + (row + r_step) * TOPK + 4 * lane);
        bf16x8v qf[2];
#pragma unroll
        for (int ks = 0; ks < 2; ++ks) { u32x4 v = (u32x4){0u, 0u, 0u, 0u}; if (q16 < 8) v = *(const u32x4*)(Q + row * 512 + q16 * 64 + ks * 32 + g * 8); qf[ks] = __builtin_bit_cast(bf16x8v, v); }
        f32x4 S[16];
        const bf16_t* kbat = Kb + (size_t)b * SEQ * 64 + g * 8;
        const bf16_t* vbat = Vb + (size_t)b * SEQ * 64 + (lane & 7) * 8;
#pragma unroll
        for (int kh = 0; kh < 2; ++kh) {
            bf16x8v kf[8][2];
#pragma unroll
            for (int i = 0; i < 8; ++i) { const int slot = 128 * kh + 16 * i + q16; unsigned idx = *(const LAS unsigned short*)(ib + slot * 2); if (slot >= n) idx = 0u;
#pragma unroll
                for (int ks = 0; ks < 2; ++ks) kf[i][ks] = *(const bf16x8v*)(kbat + (size_t)idx * 64 + ks * 32); }
            SP_FENCE();
#pragma unroll
            for (int i = 0; i < 8; ++i) { f32x4 c = (f32x4){0.f, 0.f, 0.f, 0.f};
                c = __builtin_amdgcn_mfma_f32_16x16x32_bf16(kf[i][0], qf[0], c, 0, 0, 0);
                c = __builtin_amdgcn_mfma_f32_16x16x32_bf16(kf[i][1], qf[1], c, 0, 0, 0); S[8 * kh + i] = c; }
            SP_FENCE();
        }
        u32x4 vv[8];
#pragma unroll
        for (int i = 0; i < 8; ++i) { const int slot = (lane >> 3) + 8 * i; unsigned idx = *(const LAS unsigned short*)(ib + slot * 2); if (slot >= n) idx = 0u; vv[i] = *(const u32x4*)(vbat + (size_t)idx * 64); }
        SP_FENCE();
        float m = -INFINITY;
#pragma unroll
        for (int kt = 0; kt < 16; ++kt)
#pragma unroll
            for (int r = 0; r < 4; ++r) { if (16 * kt + 4 * g + r >= n) S[kt][r] = -INFINITY; m = fmaxf(m, S[kt][r]); }
        m = fmaxf(m, shx(m, lane, 16)); m = fmaxf(m, shx(m, lane, 32));
        const float mc = m * c2; float l = 0.f;
#pragma unroll
        for (int kt = 0; kt < 16; ++kt)
#pragma unroll
            for (int r = 0; r < 4; ++r) { const float p = __builtin_amdgcn_exp2f(S[kt][r] * c2 - mc); S[kt][r] = p; l += p; }
        l += shx(l, lane, 16); l += shx(l, lane, 32);
        const float linv = 1.f / l;
        bf16x8v P[8];
#pragma unroll
        for (int c = 0; c < 8; ++c) { u32x4 pk; pk.x = pg8::cvt_pk_bf16(S[2 * c][0], S[2 * c][1]); pk.y = pg8::cvt_pk_bf16(S[2 * c][2], S[2 * c][3]); pk.z = pg8::cvt_pk_bf16(S[2 * c + 1][0], S[2 * c + 1][1]); pk.w = pg8::cvt_pk_bf16(S[2 * c + 1][2], S[2 * c + 1][3]);
            P[c] = __builtin_bit_cast(bf16x8v, pk); }
        f32x4 O[4];
#pragma unroll
        for (int dt = 0; dt < 4; ++dt) O[dt] = (f32x4){0.f, 0.f, 0.f, 0.f};
#pragma unroll
        for (int cc = 0; cc < 4; ++cc) {
#pragma unroll
            for (int i = 0; i < 8; ++i) *(LAS u32x4*)(wdst + i * 8 * SV_STRIDE) = vv[i];
            SP_FENCE();
            if (cc < 3) {
#pragma unroll
                for (int i = 0; i < 8; ++i) { const int slot = 64 * (cc + 1) + (lane >> 3) + 8 * i; unsigned idx = *(const LAS unsigned short*)(ib + slot * 2); if (slot >= n) idx = 0u; vv[i] = *(const u32x4*)(vbat + (size_t)idx * 64); }
            }
            asm volatile("s_waitcnt lgkmcnt(0)" ::: "memory");
#pragma unroll
            for (int c2i = 0; c2i < 2; ++c2i)
#pragma unroll
                for (int dt = 0; dt < 4; ++dt) { const LAS unsigned char* p = rsrc + c2i * 32 * SV_STRIDE + dt * 32;
                    const v4i16_t lo = tr_read16(p), hi = tr_read16(p + 16 * SV_STRIDE);
                    const bf16x8v a = (bf16x8v){lo[0], lo[1], lo[2], lo[3], hi[0], hi[1], hi[2], hi[3]};
                    O[dt] = __builtin_amdgcn_mfma_f32_16x16x32_bf16(a, P[2 * cc + c2i], O[dt], 0, 0, 0); }
            asm volatile("s_waitcnt lgkmcnt(0)" ::: "memory");
        }
        if (q16 < 8) {
#pragma unroll
            for (int dt = 0; dt < 4; ++dt) { const f32x4 o = O[dt] * linv; u32x2 w;
                w.x = pg8::cvt_pk_bf16(o[0], o[1]); w.y = pg8::cvt_pk_bf16(o[2], o[3]);
                *(u32x2*)(MIX + row * DM + q16 * 64 + dt * 16 + g * 4) = w; }
        }
    }
    __syncthreads();
}
__device__ __forceinline__ void convb_phase(LAS unsigned char* lds, int G, int vcu, const bf16_t* U, const float* __restrict__ cw, const float* __restrict__ cb, const float* __restrict__ lng, const float* __restrict__ lnb, bf16_t* MIX, int tid, int lane, int wave) {
    asm volatile("" : "+v"(tid), "+v"(lane));
    typedef float f32x2v __attribute__((ext_vector_type(2)));
    const int cp = tid & 255, th = tid >> 8;
    f32x2v w[31];
#pragma unroll
    for (int j = 0; j < 31; ++j) w[j] = *(const f32x2v*)(cw + j * 512 + 2 * cp);
    const f32x2v bias = *(const f32x2v*)(cb + 2 * cp), gam = *(const f32x2v*)(lng + 2 * cp), bet = *(const f32x2v*)(lnb + 2 * cp);
    LAS float* red = (LAS float*)(lds + 65536);
#pragma unroll 1
    for (int tile = vcu; tile < MTOK / 32; tile += G) {
        const int row0 = tile * 32, t0 = row0 & (SEQ - 1);
        for (int i = tid; i < 62 * 64; i += 512) { const int r = i >> 6, ch = i & 63; u32x4 v = (u32x4){0u, 0u, 0u, 0u};
            if (t0 - 30 + r >= 0) v = *(const u32x4*)(U + (size_t)(row0 - 30 + r) * 512 + ch * 8);
            *(LAS u32x4*)(lds + r * 1024 + ch * 16) = v; }
        __syncthreads();
        f32x2v y[2][8];
#pragma unroll
        for (int k = 0; k < 2; ++k) {
            const int tg = th + 2 * k;
            f32x2v acc[8];
#pragma unroll
            for (int o = 0; o < 8; ++o) acc[o] = bias;
            const LAS unsigned* wp = (const LAS unsigned*)(lds + tg * 8 * 1024) + cp;
#pragma unroll
            for (int j = 0; j < 38; ++j) { const unsigned uu = wp[j * 256]; const f32x2v uv = (f32x2v){__uint_as_float(uu << 16), __uint_as_float(uu & 0xffff0000u)};
#pragma unroll
                for (int o = 0; o < 8; ++o) { const int tap = j - o; if (tap >= 0 && tap < 31) acc[o] += w[tap] * uv; } }
#pragma unroll
            for (int o = 0; o < 8; ++o) { y[k][o] = acc[o];
                float s = acc[o].x + acc[o].y, q = acc[o].x * acc[o].x + acc[o].y * acc[o].y;
                s = wave_sum_l(s, lane); q = wave_sum_l(q, lane);
                if (lane == 0) { red[((tg * 8 + o) * 4 + (wave & 3)) * 2] = s; red[((tg * 8 + o) * 4 + (wave & 3)) * 2 + 1] = q; } }
        }
        __syncthreads();
#pragma unroll
        for (int k = 0; k < 2; ++k) {
            const int tg = th + 2 * k;
#pragma unroll
            for (int o = 0; o < 8; ++o) { const int tl = tg * 8 + o;
                const f32x4 ra = *(const LAS f32x4*)(red + tl * 8), rb = *(const LAS f32x4*)(red + tl * 8 + 4);
                const float mu = ((ra[0] + ra[2]) + (rb[0] + rb[2])) * (1.f / 512.f), ex2 = ((ra[1] + ra[3]) + (rb[1] + rb[3])) * (1.f / 512.f);
                const float rstd = 1.f / sqrtf(fmaxf(ex2 - mu * mu, 0.f) + EPS);
                const float v0 = (y[k][o].x - mu) * rstd * gam.x + bet.x, v1 = (y[k][o].y - mu) * rstd * gam.y + bet.y;
                *(unsigned*)(MIX + (size_t)(row0 + tl) * DM + 512 + 2 * cp) = (unsigned)f2bf(silu_f(v0)) | ((unsigned)f2bf(silu_f(v1)) << 16); }
        }
        __syncthreads();
    }
}

__device__ __forceinline__ int wt_dst_row(int mode, int c) {
    if (mode == 0) return c;
    if (mode == 2) return 256 * (c >> 7) + (c & 127);
    if (mode == 3) return 256 * (c >> 7) + 128 + (c & 127);
    if (c < 512) return (c & ~63) + dperm(c & 63);
    if (c < 576) return 512 + dperm(c - 512);
    if (c < 640) return c;
    if (c < 896) return 768 + ((c - 640) & ~63) + dperm((c - 640) & 63);
    if (c < 960) return 640 + dperm(c - 896);
    if (c < 964) return 704 + (c - 960);
    if (c < 1476) { const int j = c - 964; return 1024 + 256 * (j >> 7) + (j & 127); }
    { const int j = c - 1476; return 1024 + 256 * (j >> 7) + 128 + (j & 127); }
}
__device__ __forceinline__ void wt_body(LAS unsigned char* sm, int vb, int tid, const float* __restrict__ W, int K, int N, bf16_t* WT, const float* __restrict__ gain, int mode) {
    LAS float* t = (LAS float*)sm;
    const int nbx = (N + 31) / 32; const int k0 = (vb / nbx) * 32, n0 = (vb % nbx) * 32, tx = tid & 31, ty = tid >> 5;
    for (int i = ty; i < 32; i += 8) { const int k = k0 + i, n = n0 + tx; float v = 0.f; if (k < K && n < N) { v = W[(size_t)k * N + n]; if (gain) v *= gain[k]; } t[i * 33 + tx] = v; }
    __syncthreads();
    for (int i = ty; i < 32; i += 8) { const int n = n0 + i, k = k0 + tx; if (n < N && k < K) WT[(size_t)wt_dst_row(mode, n) * K + k] = f2bf(t[tx * 33 + i]); }
    __syncthreads();
}
__device__ __forceinline__ void rmsnorm_bf16_row(const float* x, const float* __restrict__ g, bf16_t* out, int row, int lane) {
    const f32x4* xr = (const f32x4*)(x + (size_t)row * DM) + lane; const f32x4* gr = (const f32x4*)g + lane;
    f32x4 v[4]; float s = 0.f;
#pragma unroll
    for (int j = 0; j < 4; ++j) { v[j] = xr[64 * j]; s += (v[j].x * v[j].x + v[j].y * v[j].y) + (v[j].z * v[j].z + v[j].w * v[j].w); }
    const float rstd = 1.f / sqrtf(wave_sum_l(s, lane) * (1.f / DM) + EPS);
    u32x2* o = (u32x2*)(out + (size_t)row * DM) + lane;
#pragma unroll
    for (int j = 0; j < 4; ++j) { const f32x4 gg = gr[64 * j]; u32x2 w;
        w.x = (unsigned)f2bf(v[j].x * rstd * gg.x) | ((unsigned)f2bf(v[j].y * rstd * gg.y) << 16);
        w.y = (unsigned)f2bf(v[j].z * rstd * gg.z) | ((unsigned)f2bf(v[j].w * rstd * gg.w) << 16); o[64 * j] = w; }
}
__device__ __forceinline__ void rmsnorm_f32_row(float* x, const float* __restrict__ g, int row, int lane) {
    f32x4* xr = (f32x4*)(x + (size_t)row * DM) + lane; const f32x4* gr = (const f32x4*)g + lane;
    f32x4 v[4]; float s = 0.f;
#pragma unroll
    for (int j = 0; j < 4; ++j) { v[j] = xr[64 * j]; s += (v[j].x * v[j].x + v[j].y * v[j].y) + (v[j].z * v[j].z + v[j].w * v[j].w); }
    const float rstd = 1.f / sqrtf(wave_sum_l(s, lane) * (1.f / DM) + EPS);
#pragma unroll
    for (int j = 0; j < 4; ++j) { const f32x4 gg = gr[64 * j]; xr[64 * j] = v[j] * rstd * gg; }
}

constexpr size_t MiB = 1u << 20;
constexpr int LDS_USER = 139264, LDSCTL_OFF = LDS_USER, MISC_OFF = LDSCTL_OFF + 320, LDS_BYTES = 147456;
constexpr size_t WS_CTL = 476 * MiB, CTL_ZERO_BYTES = 1 * MiB; constexpr int CW_BAR = 4096;
constexpr int NGU = 2 * DFF;
struct Args { const float* in[23]; float* out; unsigned char* ws; };
static_assert(sizeof(Args) == 25 * 8, "Args has no padding");

__global__ void __launch_bounds__(512, 2) mega_k(Args a) {
    extern __shared__ __attribute__((aligned(16))) unsigned char lds_raw[];
    LAS unsigned char* lds = (LAS unsigned char*)lds_raw;
    const int wave = __builtin_amdgcn_readfirstlane(threadIdx.x >> 6);
#define PH_IDS() int lane; asm volatile("v_mbcnt_lo_u32_b32 %0, -1, 0\n\tv_mbcnt_hi_u32_b32 %0, -1, %0" : "=v"(lane)); const int tid = wave * 64 + lane, half = wave >> 2, htid = tid & 255; LAS unsigned char* hsm = lds + half * 65536; (void)htid; (void)hsm
    const int G = gridDim.x, bx = blockIdx.x; const int vcu = (G % 8 == 0) ? (bx % 8) * (G / 8) + bx / 8 : bx;
    const float* x = a.in[0]; const float* mem = a.in[1]; const int* positions = (const int*)a.in[2];
    const float* g_mix = a.in[3]; const float* w_in = a.in[4]; const float* w_out = a.in[5];
    const float* conv_b_w = a.in[6]; const float* conv_b_b = a.in[7]; const float* ln_b_g = a.in[8]; const float* ln_b_b = a.in[9];
    const float* g_cross = a.in[10]; const float* g_mem = a.in[11];
    const float* w_q = a.in[12]; const float* w_k = a.in[13]; const float* w_v = a.in[14]; const float* w_o = a.in[15];
    const float* g_ffn = a.in[16]; const float* w_gate = a.in[17]; const float* w_up = a.in[18];
    const float* ffn_cw = a.in[19]; const float* ffn_cb = a.in[20]; const float* w_down = a.in[21]; const float* g_final = a.in[22];
    float* out = a.out; unsigned char* ws = a.ws;
    bf16_t* wt_in = (bf16_t*)(ws + 0 * MiB); bf16_t* wt_out = (bf16_t*)(ws + 4 * MiB);
    bf16_t* wt_q = (bf16_t*)(ws + 6 * MiB), *wt_k = (bf16_t*)(ws + 8 * MiB), *wt_v = (bf16_t*)(ws + 10 * MiB), *wt_o = (bf16_t*)(ws + 12 * MiB);
    bf16_t* wt_gu = (bf16_t*)(ws + 14 * MiB); bf16_t* wt_down = (bf16_t*)(ws + 26 * MiB);
    float* WI = (float*)(ws + 32 * MiB); float* CS = (float*)(ws + 33 * MiB);
    float* SS1 = (float*)(ws + 35 * MiB); float* SS2 = (float*)(ws + 37 * MiB); float* SS3 = (float*)(ws + 39 * MiB);
    bf16_t* MEMN = (bf16_t*)(ws + 41 * MiB), *KC = (bf16_t*)(ws + 45 * MiB), *VC = (bf16_t*)(ws + 49 * MiB);
    bf16_t* XB = (bf16_t*)(ws + 56 * MiB);
    bf16_t* Qb = (bf16_t*)(ws + 120 * MiB); bf16_t* QI = (bf16_t*)(ws + 152 * MiB);
    bf16_t* Kb = (bf16_t*)(ws + 168 * MiB), *Vb = (bf16_t*)(ws + 172 * MiB), *KI = (bf16_t*)(ws + 176 * MiB);
    bf16_t* U = (bf16_t*)(ws + 180 * MiB); unsigned short* SEL = (unsigned short*)(ws + 212 * MiB);
    bf16_t* MIX = (bf16_t*)(ws + 228 * MiB); bf16_t* QC = (bf16_t*)(ws + 292 * MiB); bf16_t* OC = (bf16_t*)(ws + 356 * MiB);
    bf16_t* Gb = (bf16_t*)(ws + 120 * MiB); bf16_t* UF = (bf16_t*)(ws + 296 * MiB);
    unsigned* ctl = (unsigned*)(ws + WS_CTL);

    { PH_IDS(); for (int u = tid; u < (LDS_BYTES - LDSCTL_OFF) / 4; u += 512) ((LAS unsigned*)(lds + LDSCTL_OFF))[u] = 0u; }
    __syncthreads();
    XcdBarrier bar = xcd_barrier_post(ctl + CW_BAR, (volatile LAS unsigned*)(lds + MISC_OFF) + 8);
#define GRID_BAR() xcd_barrier(bar)
#define FOR_VB(nvb) for (int vb = 2 * bx + half; vb < (nvb); vb += 2 * G)
#define GEMMX(EPI, EINIT, Aptr, Bptr, Mv, Nv, Kv) do { pg8::Gemm g_{Aptr, Bptr, Mv, Nv, Kv}; pg8::StaticOrder S_; S_.init(Mv, Nv, G, bx); EPI E_ EINIT; \
        PH_IDS(); pg8::gemm_phase<EPI, pg8::StaticOrder, true, true>(lds, g_, S_, E_, tid); } while (0)
#define EI(...) {__VA_ARGS__}

    { PH_IDS();
    for (int i = bx * 512 + tid; i < 60 * DM; i += G * 512) wt_in[(size_t)708 * DM + i] = 0;
    FOR_VB(32 * 63) wt_body(hsm, vb, htid, w_in, DM, INC, wt_in, nullptr, 1);
    FOR_VB(32 * 32) wt_body(hsm, vb, htid, w_out, DM, DM, wt_out, nullptr, 0);
    FOR_VB(32 * 32) wt_body(hsm, vb, htid, w_q, DM, DM, wt_q, g_cross, 0);
    FOR_VB(32 * 32) wt_body(hsm, vb, htid, w_k, DM, DM, wt_k, nullptr, 0);
    FOR_VB(32 * 32) wt_body(hsm, vb, htid, w_v, DM, DM, wt_v, nullptr, 0);
    FOR_VB(32 * 32) wt_body(hsm, vb, htid, w_o, DM, DM, wt_o, nullptr, 0);
    FOR_VB(32 * 88) wt_body(hsm, vb, htid, w_gate, DM, DFF, wt_gu, g_ffn, 2);
    FOR_VB(32 * 88) wt_body(hsm, vb, htid, w_up, DM, DFF, wt_gu, g_ffn, 3);
    FOR_VB(88 * 32) wt_body(hsm, vb, htid, w_down, DFF, DM, wt_down, nullptr, 0);
    for (int i = bx * 512 + tid; i < MTOK * 8; i += G * 512) { const int row = i >> 3, k = i & 7;
        const float freq = (float)pow(500000.0, -0.125 * (double)k); const float ang = (float)positions[row] * freq;
        CS[(size_t)row * 16 + k] = (float)cos((double)ang); CS[(size_t)row * 16 + 8 + k] = (float)sin((double)ang); }
    for (int r = bx * 8 + wave; r < MTOK; r += G * 8) rmsnorm_bf16_row(x, g_mix, XB, r, lane);
    for (int r = bx * 8 + wave; r < MMEM; r += G * 8) rmsnorm_bf16_row(mem, g_mem, MEMN, r, lane);
    }
    GRID_BAR();
    GEMMX(EpiIn, EI(CS, Qb, Kb, Vb, QI, KI, U, WI), XB, wt_in, MTOK, INP, DM);
    GEMMX(EpiStore, EI(nullptr, KC, nullptr, DM), MEMN, wt_k, MMEM, DM, DM);
    GEMMX(EpiStore, EI(nullptr, VC, nullptr, MMEM), wt_v, MEMN, DM, MMEM, DM);
    GRID_BAR();
    { PH_IDS(); topk_phase(lds, G, vcu, QI, KI, WI, SEL, tid, lane, wave); }
    { PH_IDS(); convb_phase(lds, G, vcu, U, conv_b_w, conv_b_b, ln_b_g, ln_b_b, MIX, tid, lane, wave); }
    GRID_BAR();
    { PH_IDS(); sparse_attn_phase(lds, G, vcu, Qb, Kb, Vb, SEL, MIX, lane, wave); }
    GRID_BAR();
    GEMMX(EpiRes, EI(x, out, XB, SS1), MIX, wt_out, MTOK, DM, DM);
    GRID_BAR();
    GEMMX(EpiScale, EI(SS1, QC, DM, 1.0f), XB, wt_q, MTOK, DM, DM);
    GRID_BAR();
    { PH_IDS(); const int per = (512 + G - 1) / G; for (int i = 0; i < per; ++i) { const int u = vcu * per + i; if (u < 512) cross_attn_unit(lds, u >> 6, (u >> 4) & 3, u & 15, QC, KC, VC, OC, tid, lane, wave); } }
    GRID_BAR();
    GEMMX(EpiRes, EI(out, out, XB, SS2), OC, wt_o, MTOK, DM, DM);
    GRID_BAR();
    GEMMX(EpiGateUp, EI(SS2, Gb, UF), XB, wt_gu, MTOK, NGU, DM);
    GRID_BAR();
    { PH_IDS();
    for (int i = bx * 512 + tid; i < MTOK * (DFF / 8); i += G * 512) {
        const int row = i / (DFF / 8), c = (i - row * (DFF / 8)) * 8, t = row & (SEQ - 1); const size_t off = (size_t)row * DFF + c;
        const u32x4 g2 = *(const u32x4*)(Gb + off); u32x4 g1 = (u32x4){0u, 0u, 0u, 0u}, g0 = (u32x4){0u, 0u, 0u, 0u};
        if (t >= 1) g1 = *(const u32x4*)(Gb + off - DFF);
        if (t >= 2) g0 = *(const u32x4*)(Gb + off - 2 * DFF);
        const u32x4 uu = *(const u32x4*)(UF + off); u32x4 o;
#pragma unroll
        for (int e = 0; e < 4; ++e) { float r[2];
#pragma unroll
            for (int hh = 0; hh < 2; ++hh) { const int cc = c + 2 * e + hh;
                const float a2 = hh ? __uint_as_float(g2[e] & 0xffff0000u) : __uint_as_float(g2[e] << 16), a1 = hh ? __uint_as_float(g1[e] & 0xffff0000u) : __uint_as_float(g1[e] << 16), a0 = hh ? __uint_as_float(g0[e] & 0xffff0000u) : __uint_as_float(g0[e] << 16);
                const float uv = hh ? __uint_as_float(uu[e] & 0xffff0000u) : __uint_as_float(uu[e] << 16);
                const float gg = ffn_cb[cc] + ffn_cw[2 * DFF + cc] * a2 + ffn_cw[DFF + cc] * a1 + ffn_cw[cc] * a0;
                r[hh] = silu_f(gg) * uv; }
            o[e] = (unsigned)f2bf(r[0]) | ((unsigned)f2bf(r[1]) << 16); }
        *(u32x4*)(UF + off) = o;
    }
    }
    GRID_BAR();
    GEMMX(EpiRes, EI(out, out, nullptr, SS3), UF, wt_down, MTOK, DM, DFF);
    GRID_BAR();
    { PH_IDS();
    for (int r = bx * 8 + wave; r < MTOK; r += G * 8) {
        const float rs = rstd_from_ss(SS3, (size_t)r);
        f32x4* xr = (f32x4*)(out + (size_t)r * DM) + lane; const f32x4* gr = (const f32x4*)g_final + lane;
#pragma unroll
        for (int j = 0; j < 4; ++j) xr[64 * j] = xr[64 * j] * rs * gr[64 * j];
    }
    }
}

extern "C" void kernel_launch(void* const* d_in, const int* in_sizes, int n_in, void* d_out, int out_size, void* d_ws, size_t ws_size, hipStream_t stream) {
    static int grid = 0;
    if (grid == 0) {
        int dev = 0, cus = 0, per_cu = 0;
        if (hipGetDevice(&dev) != hipSuccess || hipDeviceGetAttribute(&cus, hipDeviceAttributeMultiprocessorCount, dev) != hipSuccess) { fprintf(stderr, "kernel_launch: device query failed\n"); grid = -1; return; }
        if (hipFuncSetAttribute((const void*)mega_k, hipFuncAttributeMaxDynamicSharedMemorySize, LDS_BYTES) != hipSuccess) { fprintf(stderr, "kernel_launch: hipFuncSetAttribute failed\n"); grid = -1; return; }
        if (hipOccupancyMaxActiveBlocksPerMultiprocessor(&per_cu, (const void*)mega_k, 512, LDS_BYTES) != hipSuccess || per_cu < 1) { fprintf(stderr, "kernel_launch: occupancy query says %d\n", per_cu); per_cu = 1; }
        (void)hipGetLastError();
        grid = cus * 1;
        if (n_in != 23 || ws_size < 477 * MiB) { fprintf(stderr, "kernel_launch: unexpected n_in %d / ws %zu\n", n_in, ws_size); grid = -1; return; }
    }
    if (grid < 0) return;
    (void)hipMemsetAsync((char*)d_ws + WS_CTL, 0, CTL_ZERO_BYTES, stream);
    Args a{};
    for (int i = 0; i < 23; ++i) a.in[i] = (const float*)d_in[i];
    a.out = (float*)d_out; a.ws = (unsigned char*)d_ws;
    void* params[] = {&a};
    hipError_t e = hipLaunchCooperativeKernel((const void*)mega_k, dim3(grid), dim3(512), params, LDS_BYTES, stream);
    if (e != hipSuccess) fprintf(stderr, "cooperative launch failed: %s (grid %d)\n", hipGetErrorString(e), grid);
}
```

```cpp
#include <hip/hip_runtime.h>
#include <cstdio>
#include <cstdint>
#include <cmath>
namespace pg8 {
#define PG8_LAS __attribute__((address_space(3)))
typedef unsigned short bf16_t;
typedef short bf16x8 __attribute__((ext_vector_type(8)));
typedef float f32x4 __attribute__((ext_vector_type(4)));
typedef unsigned u32x4 __attribute__((ext_vector_type(4)));
constexpr int BM = 256, BK = 64, HALF = 128, HTB = HALF * BK * 2  , STAGE_BYTES = 8 * HTB, NXCD = 8, WGM = 8;

__host__ __device__ __forceinline__ int lds_byte(int r, int c) { const int st = (r >> 4) * 2 + (c >> 5), rr = r & 15, cc = c & 31, ob = rr * 64 + cc * 2; return st * 1024 + (ob ^ (((ob >> 9) & 1) << 5)); }
__host__ __device__ __forceinline__ void stage_rc(int b, int& R, int& C) { const int st = b / 1024, sb = b % 1024, swz = sb ^ (((sb >> 9) & 1) << 5); R = (st >> 1) * 16 + swz / 64; C = (st & 1) * 32 + (swz % 64) / 2; }
__host__ __device__ __forceinline__ int perm32(int rho) { const int n = rho >> 4, i = rho & 15; return 8 * (i >> 2) + 4 * n + (i & 3); }

struct Unit { int pm, pn; };
struct Gemm { const bf16_t* A; const bf16_t* Bt; int M, N, K; };

struct StaticOrder {
    int nM, nN, nwg, G, c;
    __host__ __device__ void init(int M, int N, int G_, int c_) { nM = M / BM; nN = N / BM; nwg = nM * nN; G = G_; c = c_; }
    __host__ __device__ bool next(int i, Unit& u) const {
        const long L = (long)i * G + c; if (L >= nwg) return false;
        int wgid = (int)L; { const int q = nwg / NXCD, r = nwg % NXCD, xcd = wgid % NXCD, off = wgid / NXCD; wgid = (xcd < r ? xcd * (q + 1) : r * (q + 1) + (xcd - r) * q) + off; }
        const int nig = WGM * nN, gid = wgid / nig, fm = gid * WGM, gsz = (nM - fm) < WGM ? (nM - fm) : WGM;
        u.pm = fm + ((wgid % nig) % gsz); u.pn = (wgid % nig) / gsz; return true;
    }
    __device__ __forceinline__ void a_ready(const Unit&) const {}
    __device__ __forceinline__ void done(const Unit&) const {}
};
__device__ __forceinline__ unsigned cvt_pk_bf16(float lo, float hi) { unsigned r; asm volatile("v_cvt_pk_bf16_f32 %0, %1, %2" : "=v"(r) : "v"(lo), "v"(hi)); return r; }
template <class Epi, class Sched, bool ALIGN_EPI = false, bool SP2 = false>
__device__ __forceinline__ void gemm_phase(PG8_LAS unsigned char* lds, const Gemm g, const Sched& S, const Epi& E, int tid_in) {
    int tid_l = tid_in; asm volatile("" : "+v"(tid_l));
    const int tid = tid_l, wid = __builtin_amdgcn_readfirstlane(tid >> 6), lane = tid & 63, wr = wid >> 2, wc = wid & 3, fr = lane & 15, fq = lane >> 4;
    const int K = g.K, nt = K / BK;
    unsigned voffA[2], voffB[2];
#pragma unroll
    for (int i = 0; i < 2; ++i) { int R, C; stage_rc(tid * 16 + i * 8192, R, C); const int Rb = Epi::PERM ? ((R & ~31) + perm32(R & 31)) : R;
        voffA[i] = (unsigned)(R * K + C) * 2u; voffB[i] = (unsigned)(Rb * K + C) * 2u; }
    const size_t kstep = (size_t)(BK * 2);
    const size_t hstep = (size_t)HALF * K * 2;
    const size_t tstep = 2 * hstep;
    const unsigned ldsw = (unsigned)wid * 1024u;
    const int aoff = lds_byte(wr * 64 + fr, fq * 8), boff = lds_byte(wc * 32 + fr, fq * 8);
#define PG8_SA(b, h) (((b) * 2 + (h)) * HTB)
#define PG8_SB(b, h) ((4 + (b) * 2 + (h)) * HTB)
#define PG8_STAGE(bufoff, gbase, voff) do { _Pragma("unroll") for (int _i = 0; _i < 2; ++_i) \
        __builtin_amdgcn_global_load_lds((const unsigned*)((const char*)(gbase) + (voff)[_i]), (PG8_LAS unsigned*)(lds + (bufoff) + ldsw + _i * 8192), 16, 0, 0); } while (0)
#define PG8_LDA(dst, b, h) do { _Pragma("unroll") for (int m = 0; m < 4; ++m) _Pragma("unroll") for (int k = 0; k < 2; ++k) dst[m][k] = *(const PG8_LAS bf16x8*)(lds + PG8_SA(b, h) + aoff + m * 2048 + k * 1024); } while (0)
#define PG8_LDB(dst, b, h) do { _Pragma("unroll") for (int n = 0; n < 2; ++n) _Pragma("unroll") for (int k = 0; k < 2; ++k) dst[n][k] = *(const PG8_LAS bf16x8*)(lds + PG8_SB(b, h) + boff + n * 2048 + k * 1024); } while (0)
#define PG8_MMA(ai, bj, At, Bt) do { __builtin_amdgcn_s_setprio(1); _Pragma("unroll") for (int m = 0; m < 4; ++m) _Pragma("unroll") for (int n = 0; n < 2; ++n) _Pragma("unroll") for (int k = 0; k < 2; ++k) \
        acc[ai][bj][m][n] = __builtin_amdgcn_mfma_f32_16x16x32_bf16(Bt[n][k], At[m][k], acc[ai][bj][m][n], 0, 0, 0); __builtin_amdgcn_s_setprio(0); } while (0)
#define PG8_WAIT_V(n) asm volatile("s_waitcnt vmcnt(" #n ")" ::: "memory")
#define PG8_WAIT_L(n) asm volatile("s_waitcnt lgkmcnt(" #n ")" ::: "memory")
#define PG8_BAR __builtin_amdgcn_s_barrier()
#define PG8_SCHED __builtin_amdgcn_sched_barrier(0)
    Unit cur, nxt; int ui = 0;
    if (!S.next(0, cur)) return;
    f32x4 acc[2][2][4][2];
#pragma unroll
    for (int a = 0; a < 2; ++a)
#pragma unroll
        for (int b = 0; b < 2; ++b)
#pragma unroll
            for (int m = 0; m < 4; ++m)
#pragma unroll
                for (int n = 0; n < 2; ++n) acc[a][b][m][n] = (f32x4){0.f, 0.f, 0.f, 0.f};
    bf16x8 At[4][2], B0[2][2], B1[2][2];
    const char* cA = (const char*)g.A + (size_t)cur.pm * tstep; const char* cB = (const char*)g.Bt + (size_t)cur.pn * tstep;
    S.a_ready(cur);
    if constexpr (SP2) {
        PG8_STAGE(PG8_SB(0, 0), cB, voffB); PG8_STAGE(PG8_SB(0, 1), cB + hstep, voffB); PG8_STAGE(PG8_SA(0, 0), cA, voffA); PG8_STAGE(PG8_SA(0, 1), cA + hstep, voffA);
        if (wr == 1) PG8_BAR;
        PG8_WAIT_V(2); PG8_BAR;
        PG8_STAGE(PG8_SB(1, 0), cB + kstep, voffB); PG8_STAGE(PG8_SA(1, 0), cA + kstep, voffA); PG8_STAGE(PG8_SB(1, 1), cB + hstep + kstep, voffB);
        PG8_WAIT_V(6); PG8_BAR;
    } else {
        PG8_STAGE(PG8_SB(0, 0), cB, voffB); PG8_STAGE(PG8_SA(0, 0), cA, voffA); PG8_STAGE(PG8_SB(0, 1), cB + hstep, voffB); PG8_STAGE(PG8_SA(0, 1), cA + hstep, voffA);
        if (wr == 1) PG8_BAR;
        PG8_WAIT_V(4); PG8_BAR;
        PG8_STAGE(PG8_SB(1, 0), cB + kstep, voffB); PG8_STAGE(PG8_SA(1, 0), cA + kstep, voffA); PG8_STAGE(PG8_SB(1, 1), cB + hstep + kstep, voffB);
        PG8_WAIT_V(6); PG8_BAR;
    }
    for (;;) {
        const bool has_next = S.next(ui + 1, nxt);
        const char* nA = has_next ? (const char*)g.A + (size_t)nxt.pm * tstep : cA; const char* nB = has_next ? (const char*)g.Bt + (size_t)nxt.pn * tstep : cB;
        for (int t = 0; t < nt; t += 2) {
            const bool last = (t == nt - 2);
            const char* a1 = cA + (size_t)(t + 1) * kstep;
            const char* a2 = last ? nA : cA + (size_t)(t + 2) * kstep; const char* b2 = last ? nB : cB + (size_t)(t + 2) * kstep;
            const char* a3 = a2 + kstep; const char* b3 = b2 + kstep;
            if (last && has_next) S.a_ready(nxt);
            if constexpr (SP2) {
            PG8_LDB(B0, 0, 0); PG8_LDB(B1, 0, 1); PG8_SCHED; PG8_LDA(At, 0, 0); PG8_STAGE(PG8_SA(1, 1), a1 + hstep, voffA);
            PG8_WAIT_V(8); PG8_WAIT_L(0); PG8_BAR; PG8_MMA(0, 0, At, B0); PG8_MMA(0, 1, At, B1); PG8_BAR; PG8_SCHED;
            PG8_LDA(At, 0, 1); PG8_STAGE(PG8_SB(0, 0), b2, voffB); PG8_STAGE(PG8_SB(0, 1), b2 + hstep, voffB); PG8_STAGE(PG8_SA(0, 0), a2, voffA);
            PG8_WAIT_V(8); PG8_WAIT_L(0); PG8_BAR; PG8_MMA(1, 0, At, B0); PG8_MMA(1, 1, At, B1); PG8_BAR; PG8_SCHED;
            PG8_LDB(B0, 1, 0); PG8_LDB(B1, 1, 1); PG8_SCHED; PG8_LDA(At, 1, 0); PG8_STAGE(PG8_SA(0, 1), a2 + hstep, voffA);
            PG8_WAIT_V(8); PG8_WAIT_L(0); PG8_BAR; PG8_MMA(0, 0, At, B0); PG8_MMA(0, 1, At, B1); PG8_BAR; PG8_SCHED;
            PG8_LDA(At, 1, 1); PG8_STAGE(PG8_SB(1, 0), b3, voffB); PG8_STAGE(PG8_SB(1, 1), b3 + hstep, voffB); PG8_STAGE(PG8_SA(1, 0), a3, voffA);
            PG8_WAIT_V(8); PG8_WAIT_L(0); PG8_BAR; PG8_MMA(1, 0, At, B0); PG8_MMA(1, 1, At, B1); PG8_BAR; PG8_SCHED;
            } else {
            PG8_LDB(B0, 0, 0); PG8_SCHED; PG8_LDA(At, 0, 0); PG8_STAGE(PG8_SA(1, 1), a1 + hstep, voffA);
            PG8_WAIT_L(8); PG8_BAR; PG8_WAIT_L(0); PG8_MMA(0, 0, At, B0); PG8_BAR; PG8_SCHED;
            PG8_LDB(B1, 0, 1); PG8_STAGE(PG8_SB(0, 0), b2, voffB);
            PG8_BAR; PG8_WAIT_L(0); PG8_MMA(0, 1, At, B1); PG8_BAR;
            PG8_LDA(At, 0, 1); PG8_STAGE(PG8_SA(0, 0), a2, voffA);
            PG8_BAR; PG8_WAIT_L(0); PG8_MMA(1, 0, At, B0); PG8_BAR; PG8_SCHED;
            PG8_STAGE(PG8_SB(0, 1), b2 + hstep, voffB);
            PG8_WAIT_V(6); PG8_BAR; PG8_MMA(1, 1, At, B1); PG8_BAR;
            PG8_LDB(B0, 1, 0); PG8_SCHED; PG8_LDA(At, 1, 0); PG8_STAGE(PG8_SA(0, 1), a2 + hstep, voffA);
            PG8_WAIT_L(8); PG8_BAR; PG8_WAIT_L(0); PG8_MMA(0, 0, At, B0); PG8_BAR; PG8_SCHED;
            PG8_LDB(B1, 1, 1); PG8_STAGE(PG8_SB(1, 0), b3, voffB);
            PG8_BAR; PG8_WAIT_L(0); PG8_MMA(0, 1, At, B1); PG8_BAR;
            PG8_LDA(At, 1, 1); PG8_STAGE(PG8_SA(1, 0), a3, voffA);
            PG8_BAR; PG8_WAIT_L(0); PG8_MMA(1, 0, At, B0); PG8_BAR; PG8_SCHED;
            PG8_STAGE(PG8_SB(1, 1), b3 + hstep, voffB);
            PG8_WAIT_V(6); PG8_BAR; PG8_MMA(1, 1, At, B1); PG8_BAR;
            }
        }
        if constexpr (ALIGN_EPI) { if (wr == 0) PG8_BAR; }
        if constexpr (!Epi::AFTER_DRAIN) { E(acc, cur, wr, wc, fr, fq); S.done(cur); }
        if (!has_next) break;
#pragma unroll
        for (int a = 0; a < 2; ++a)
#pragma unroll
            for (int b = 0; b < 2; ++b)
#pragma unroll
                for (int m = 0; m < 4; ++m)
#pragma unroll
                    for (int n = 0; n < 2; ++n) acc[a][b][m][n] = (f32x4){0.f, 0.f, 0.f, 0.f};
        cur = nxt; cA = nA; cB = nB; ++ui;
        if constexpr (ALIGN_EPI) { if (wr == 1) PG8_BAR; }
    }
    PG8_WAIT_V(0);
    if constexpr (!ALIGN_EPI) { if (wr == 0) PG8_BAR; }
    PG8_BAR;
    if constexpr (Epi::AFTER_DRAIN) { E.fused(acc, cur, wr, wc, fr, fq, lds, wid, lane); S.done(cur); }
#undef PG8_SA
#undef PG8_SB
#undef PG8_STAGE
#undef PG8_LDA
#undef PG8_LDB
#undef PG8_MMA
#undef PG8_WAIT_V
#undef PG8_WAIT_L
#undef PG8_BAR
#undef PG8_SCHED
}
}

constexpr int BATCH = 8, SEQ = 4096, DM = 1024, MTOK = BATCH * SEQ;
constexpr int NMEM = 256, MMEM = BATCH * NMEM;
constexpr int AW = 512, HD = 64, NH = 8, IH = 4, TOPK = 256;
constexpr int INC = 1988, INP = 2048;
constexpr int DFF = 2816;
constexpr float EPS = 1e-6f;
#define LAS __attribute__((address_space(3)))
typedef unsigned short bf16_t;
typedef float f32x4 __attribute__((ext_vector_type(4)));
typedef unsigned u32x4 __attribute__((ext_vector_type(4)));
typedef unsigned u32x2 __attribute__((ext_vector_type(2)));

__device__ __forceinline__ float bf2f(bf16_t v) { return __uint_as_float((unsigned)v << 16); }
__device__ __forceinline__ bf16_t f2bf(float f) { unsigned u = __float_as_uint(f); return (bf16_t)((u + 0x7fffu + ((u >> 16) & 1u)) >> 16); }
__device__ __forceinline__ float shx(float v, int lane, int o) { return __uint_as_float((unsigned)__builtin_amdgcn_ds_bpermute((lane ^ o) << 2, (int)__float_as_uint(v))); }
__device__ __forceinline__ float wave_sum_l(float v, int lane) {
#pragma unroll
    for (int o = 1; o < 64; o <<= 1) v += shx(v, lane, o);
    return v;
}
__device__ __forceinline__ float wave_sum(float v) {
#pragma unroll
    for (int o = 1; o < 64; o <<= 1) v += __shfl_xor(v, o);
    return v;
}
__device__ __forceinline__ float wave_max(float v) {
#pragma unroll
    for (int o = 1; o < 64; o <<= 1) v = fmaxf(v, __shfl_xor(v, o));
    return v;
}
__device__ __forceinline__ float silu_f(float v) { return v / (1.f + __expf(-v)); }

struct EpiStore {
    static constexpr bool PERM = false, AFTER_DRAIN = false;
    float* outf; bf16_t* outb; const float* res; int ldc;
    __device__ __forceinline__ void operator()(const pg8::f32x4 (&acc)[2][2][4][2], const pg8::Unit& u, int wr, int wc, int fr, int fq) const {
        const int col0 = u.pn * 256 + wc * 32 + 4 * fq;
#pragma unroll
        for (int ai = 0; ai < 2; ++ai)
#pragma unroll
            for (int m = 0; m < 4; ++m) {
                const size_t row = (size_t)(u.pm * 256 + ai * 128 + wr * 64 + m * 16 + fr);
#pragma unroll
                for (int bj = 0; bj < 2; ++bj)
#pragma unroll
                    for (int n = 0; n < 2; ++n) {
                        const size_t off = row * ldc + col0 + bj * 128 + n * 16;
                        pg8::f32x4 v = acc[ai][bj][m][n];
                        if (res) { const pg8::f32x4 r = *(const pg8::f32x4*)(res + off); v = v + r; }
                        if (outf) *(pg8::f32x4*)(outf + off) = v;
                        if (outb) { u32x2 w; w.x = (unsigned)f2bf(v[0]) | ((unsigned)f2bf(v[1]) << 16); w.y = (unsigned)f2bf(v[2]) | ((unsigned)f2bf(v[3]) << 16); *(u32x2*)(outb + off) = w; }
                    }
            }
    }
};
#define XB_TMO      128
#define XB_XCNT(j)  (256  + 64 * (j))
#define XB_XSUB(j)  (1280 + 64 * (j))
#define XB_XGEN(j)  (2304 + 64 * (j))
#define XB_TOP      3328
#define XB_TOPGEN   3392
#define XCD_BAR_WORDS 3456
#define XB_SPIN_CAP (1u << 18)

__device__ __forceinline__ unsigned xb_ld(unsigned* p)              { return __hip_atomic_load(p, __ATOMIC_RELAXED, __HIP_MEMORY_SCOPE_AGENT); }
__device__ __forceinline__ unsigned xb_add(unsigned* p, unsigned v) { return __hip_atomic_fetch_add(p, v, __ATOMIC_RELAXED, __HIP_MEMORY_SCOPE_AGENT); }
__device__ __forceinline__ unsigned xb_xcc_id() { return (unsigned)__builtin_amdgcn_s_getreg((3 << 11) | 20) & 0xFu; }
#define XB_SPIN(cond, bar) do { unsigned _sp = 0; while (cond) { __builtin_amdgcn_s_sleep(1); \
    if ((++_sp & 255u) == 0u) { if (xb_ld(&(bar)[XB_TMO])) break; if (_sp > XB_SPIN_CAP) { atomicAdd(&(bar)[XB_TMO], 1u); break; } } } } while (0)

struct XcdBarrier {
    unsigned* bar; unsigned x;
    volatile LAS unsigned* st;
};

__device__ __forceinline__ XcdBarrier xcd_barrier_post(unsigned* bar, volatile LAS unsigned* st) {
    XcdBarrier b; b.bar = bar; b.x = xb_xcc_id(); b.st = st;
    if (threadIdx.x == 0) (void)xb_add(&bar[XB_XCNT(b.x)], 1u);
    return b;
}
__device__ __forceinline__ void xcd_barrier_complete(unsigned* bar, unsigned x, unsigned& nloc, unsigned& nx) {
    const unsigned G = gridDim.x * gridDim.y * gridDim.z;
    unsigned sum, cnt, mine, sp = 0u;
    for (;;) {
        sum = 0u; cnt = 0u; mine = 0u;
#pragma unroll
        for (unsigned j = 0; j < 16; ++j) { const unsigned c = xb_ld(&bar[XB_XCNT(j)]); sum += c; cnt += (c > 0u) ? 1u : 0u; mine = (j == x) ? c : mine; }
        if (sum == G) break;
        __builtin_amdgcn_s_sleep(1);
        if ((++sp & 255u) == 0u) { if (xb_ld(&bar[XB_TMO])) break; if (sp > XB_SPIN_CAP) { atomicAdd(&bar[XB_TMO], 1u); break; } }
    }
    nloc = mine > 0u ? mine : 1u; nx = cnt > 0u ? cnt : 1u;
}

__device__ __forceinline__ void xcd_barrier(const XcdBarrier& b) {
    asm volatile("s_waitcnt vmcnt(0)" ::: "memory");
    __syncthreads();
    if (threadIdx.x == 0) {
        unsigned* bar = b.bar;
        __builtin_amdgcn_s_waitcnt(0);
        unsigned nloc = b.st[0], nx = b.st[1];
        if (nloc == 0u) { xcd_barrier_complete(bar, b.x, nloc, nx); b.st[0] = nloc; b.st[1] = nx; }
        const unsigned old = xb_add(&bar[XB_XSUB(b.x)], 1u);
        const unsigned gen = old / nloc;
        if (old + 1u == (gen + 1u) * nloc) {
            __builtin_amdgcn_fence(__ATOMIC_RELEASE, "agent");
            asm volatile("s_waitcnt vmcnt(0)" ::: "memory");
            const unsigned og = xb_add(&bar[XB_TOP], 1u);
            const unsigned tg = og / nx;
            if (og + 1u == (tg + 1u) * nx) xb_add(&bar[XB_TOPGEN], 1u);
            else XB_SPIN(xb_ld(&bar[XB_TOPGEN]) == tg, bar);
            __builtin_amdgcn_fence(__ATOMIC_ACQUIRE, "agent");
            xb_add(&bar[XB_XGEN(b.x)], 1u);
            asm volatile("s_waitcnt vmcnt(0)" ::: "memory");
        } else {
            XB_SPIN(xb_ld(&bar[XB_XGEN(b.x)]) == gen, bar);
            __builtin_amdgcn_fence(__ATOMIC_ACQUIRE, "agent");
            asm volatile("s_waitcnt vmcnt(0)" ::: "memory");
        }
    }
    __syncthreads();
}

__device__ __forceinline__ u32x4 pack8(const pg8::f32x4 a, const pg8::f32x4 b) {
    u32x4 w; w.x = pg8::cvt_pk_bf16(a[0], a[1]); w.y = pg8::cvt_pk_bf16(a[2], a[3]); w.z = pg8::cvt_pk_bf16(b[0], b[1]); w.w = pg8::cvt_pk_bf16(b[2], b[3]); return w;
}
__device__ __forceinline__ float sigmoid_f(float v) { return 1.f / (1.f + __expf(-v)); }
__host__ __device__ __forceinline__ int dperm(int pos) { return pos < 16 ? (4 * (pos >> 3) + (pos & 3) + 8 * ((pos >> 2) & 1)) : pos; }
__host__ __device__ __forceinline__ int in_orig_col(int n) {
    if (n < 512) return (n & ~63) + dperm(n & 63);
    if (n < 576) return 512 + dperm(n - 512);
    if (n < 640) return 576 + (n - 576);
    if (n < 704) return 896 + dperm(n - 640);
    if (n < 708) return 960 + (n - 704);
    if (n < 768) return -1;
    if (n < 1024) return 640 + ((n - 768) & ~63) + dperm((n - 768) & 63);
    const int i = (n - 1024) >> 8, c = (n - 1024) & 255;
    return c < 128 ? 964 + 128 * i + c : 1476 + 128 * i + (c - 128);
}
struct EpiIn {
    static constexpr bool PERM = true, AFTER_DRAIN = false;
    const float* cs; bf16_t *Q, *K, *V, *QI, *KI, *U; float* WI;
    __device__ __forceinline__ void operator()(const pg8::f32x4 (&acc)[2][2][4][2], const pg8::Unit& u, int wr, int wc, int fr, int fq) const {
        const int pn = u.pn;
        if (pn >= 4) {
            const int ch = 128 * (pn - 4) + 32 * wc + 8 * fq;
#pragma unroll
            for (int ai = 0; ai < 2; ++ai)
#pragma unroll
                for (int m = 0; m < 4; ++m) { const size_t row = (size_t)(u.pm * 256 + ai * 128 + wr * 64 + m * 16 + fr);
                    pg8::f32x4 a0 = acc[ai][0][m][0], a1 = acc[ai][0][m][1]; const pg8::f32x4 g0 = acc[ai][1][m][0], g1 = acc[ai][1][m][1];
#pragma unroll
                    for (int k = 0; k < 4; ++k) { a0[k] *= sigmoid_f(g0[k]); a1[k] *= sigmoid_f(g1[k]); }
                    *(u32x4*)(U + row * 512 + ch) = pack8(a0, a1); }
            return;
        }
        const bool rot = (pn == 2) ? (wc == 0 && fq < 2) : ((wc & 1) == 0 && fq < 2);
#pragma unroll
        for (int ai = 0; ai < 2; ++ai)
#pragma unroll
            for (int m = 0; m < 4; ++m) { const size_t row = (size_t)(u.pm * 256 + ai * 128 + wr * 64 + m * 16 + fr);
                pg8::f32x4 cv = {1.f, 1.f, 1.f, 1.f}, sv = {0.f, 0.f, 0.f, 0.f};
                if (rot) { cv = *(const pg8::f32x4*)(cs + row * 16 + 4 * fq); sv = *(const pg8::f32x4*)(cs + row * 16 + 8 + 4 * fq); }
#pragma unroll
                for (int bj = 0; bj < 2; ++bj) {
                    const pg8::f32x4 v0 = acc[ai][bj][m][0], v1 = acc[ai][bj][m][1];
                    pg8::f32x4 n0 = v0 * cv - v1 * sv, n1 = v1 * cv + v0 * sv;
                    if (!rot) { n0 = v0; n1 = v1; }
                    const int c = 128 * bj + 32 * wc + 8 * fq;
                    if (pn < 2) *(u32x4*)(Q + row * 512 + 256 * pn + c) = pack8(n0, n1);
                    else if (pn == 3) *(u32x4*)(QI + row * 256 + c) = pack8(n0 * 0.125f, n1 * 0.125f);
                    else {
                        if (bj == 0) { if (wc < 2) *(u32x4*)(K + row * 64 + 32 * wc + 8 * fq) = pack8(n0, n1); else *(u32x4*)(V + row * 64 + 32 * (wc - 2) + 8 * fq) = pack8(v0, v1); }
                        else { if (wc < 2) *(u32x4*)(KI + row * 64 + 32 * wc + 8 * fq) = pack8(n0, n1); else if (wc == 2 && fq == 0) *(pg8::f32x4*)(WI + row * 4) = v0 * 0.5f; }
                    }
                }
            }
    }
};
struct EpiRes {
    static constexpr bool PERM = true, AFTER_DRAIN = false;
    const float* res; float* out; bf16_t* xb; float* ss;
    __device__ __forceinline__ void operator()(const pg8::f32x4 (&acc)[2][2][4][2], const pg8::Unit& u, int wr, int wc, int fr, int fq) const {
#pragma unroll
        for (int ai = 0; ai < 2; ++ai)
#pragma unroll
            for (int m = 0; m < 4; ++m) { const size_t row = (size_t)(u.pm * 256 + ai * 128 + wr * 64 + m * 16 + fr); float q = 0.f;
#pragma unroll
                for (int bj = 0; bj < 2; ++bj) { const size_t off = row * DM + u.pn * 256 + 128 * bj + 32 * wc + 8 * fq;
                    const pg8::f32x4 v0 = acc[ai][bj][m][0] + *(const pg8::f32x4*)(res + off), v1 = acc[ai][bj][m][1] + *(const pg8::f32x4*)(res + off + 4);
                    *(pg8::f32x4*)(out + off) = v0; *(pg8::f32x4*)(out + off + 4) = v1;
                    if (xb) *(u32x4*)(xb + off) = pack8(v0, v1);
                    q += (v0[0] * v0[0] + v0[1] * v0[1]) + (v0[2] * v0[2] + v0[3] * v0[3]) + (v1[0] * v1[0] + v1[1] * v1[1]) + (v1[2] * v1[2] + v1[3] * v1[3]); }
                { const int lane_ = fq * 16 + fr; q += shx(q, lane_, 16); q += shx(q, lane_, 32); }
                if (fq == 0) ss[row * 16 + u.pn * 4 + wc] = q; }
    }
};
__device__ __forceinline__ float rstd_from_ss(const float* ss, size_t row) {
    const pg8::f32x4 a = *(const pg8::f32x4*)(ss + row * 16), b = *(const pg8::f32x4*)(ss + row * 16 + 4), c = *(const pg8::f32x4*)(ss + row * 16 + 8), d = *(const pg8::f32x4*)(ss + row * 16 + 12);
    const float s = ((a[0] + a[1]) + (a[2] + a[3])) + ((b[0] + b[1]) + (b[2] + b[3])) + ((c[0] + c[1]) + (c[2] + c[3])) + ((d[0] + d[1]) + (d[2] + d[3]));
    return 1.f / sqrtf(s * (1.f / DM) + EPS);
}
struct EpiScale {
    static constexpr bool PERM = true, AFTER_DRAIN = false;
    const float* ss; bf16_t* O; int ldc; float scale;
    __device__ __forceinline__ void operator()(const pg8::f32x4 (&acc)[2][2][4][2], const pg8::Unit& u, int wr, int wc, int fr, int fq) const {
#pragma unroll
        for (int ai = 0; ai < 2; ++ai)
#pragma unroll
            for (int m = 0; m < 4; ++m) { const size_t row = (size_t)(u.pm * 256 + ai * 128 + wr * 64 + m * 16 + fr); const float r = rstd_from_ss(ss, row) * scale;
#pragma unroll
                for (int bj = 0; bj < 2; ++bj) *(u32x4*)(O + row * ldc + u.pn * 256 + 128 * bj + 32 * wc + 8 * fq) = pack8(acc[ai][bj][m][0] * r, acc[ai][bj][m][1] * r); }
    }
};
struct EpiGateUp {
    static constexpr bool PERM = true, AFTER_DRAIN = false;
    const float* ss; bf16_t* Gb; bf16_t* Ub;
    __device__ __forceinline__ void operator()(const pg8::f32x4 (&acc)[2][2][4][2], const pg8::Unit& u, int wr, int wc, int fr, int fq) const {
        const int ch = 128 * u.pn + 32 * wc + 8 * fq;
#pragma unroll
        for (int ai = 0; ai < 2; ++ai)
#pragma unroll
            for (int m = 0; m < 4; ++m) { const size_t row = (size_t)(u.pm * 256 + ai * 128 + wr * 64 + m * 16 + fr); const float r = rstd_from_ss(ss, row);
                *(u32x4*)(Gb + row * DFF + ch) = pack8(acc[ai][0][m][0] * r, acc[ai][0][m][1] * r);
                *(u32x4*)(Ub + row * DFF + ch) = pack8(acc[ai][1][m][0] * r, acc[ai][1][m][1] * r); }
    }
};
typedef short bf16x8v __attribute__((ext_vector_type(8)));
constexpr int CA_STRIDE = 528;
__device__ __forceinline__ void cross_attn_unit(LAS unsigned char* lds, int b, int h, int qb, const bf16_t* QC, const bf16_t* KC, const bf16_t* VT, bf16_t* OC, int tid, int lane, int wave) {
    const int q16 = lane & 15, g = lane >> 4;
    const size_t row0 = (size_t)b * SEQ + (size_t)qb * 256 + wave * 32;
    asm volatile("" : "+v"(tid));
    { const bf16_t* src = KC + ((size_t)b * NMEM + (tid >> 5)) * DM + h * 256 + (tid & 31) * 8; LAS unsigned char* dst = lds + (tid >> 5) * CA_STRIDE + (tid & 31) * 16;
#pragma unroll
      for (int i = 0; i < 16; ++i) { const u32x4 v = *(const u32x4*)(src + (size_t)i * 16 * DM); *(LAS u32x4*)(dst + i * 16 * CA_STRIDE) = v; } }
    __syncthreads();
    f32x4 S[2][16];
#pragma unroll
    for (int st = 0; st < 2; ++st)
#pragma unroll
        for (int kt = 0; kt < 16; ++kt) S[st][kt] = (f32x4){0.f, 0.f, 0.f, 0.f};
#pragma unroll 1
    for (int kh = 0; kh < 2; ++kh) {
        bf16x8v qf[2][4];
#pragma unroll
        for (int st = 0; st < 2; ++st)
#pragma unroll
            for (int ks = 0; ks < 4; ++ks) qf[st][ks] = *(const bf16x8v*)(QC + (row0 + st * 16 + q16) * DM + h * 256 + kh * 128 + ks * 32 + g * 8);
        const LAS unsigned char* kb = lds + q16 * CA_STRIDE + kh * 256 + g * 16;
#pragma unroll
        for (int kt = 0; kt < 16; ++kt)
#pragma unroll
            for (int ks = 0; ks < 4; ++ks) { const bf16x8v a = *(const LAS bf16x8v*)(kb + kt * 16 * CA_STRIDE + ks * 64);
                S[0][kt] = __builtin_amdgcn_mfma_f32_16x16x32_bf16(a, qf[0][ks], S[0][kt], 0, 0, 0);
                S[1][kt] = __builtin_amdgcn_mfma_f32_16x16x32_bf16(a, qf[1][ks], S[1][kt], 0, 0, 0); }
    }
    const float c2 = 0.0625f * 1.4426950408889634f;
    float linv[2]; bf16x8v P[2][8];
#pragma unroll
    for (int st = 0; st < 2; ++st) {
        float m = -INFINITY;
#pragma unroll
        for (int kt = 0; kt < 16; ++kt) m = fmaxf(fmaxf(fmaxf(S[st][kt][0], S[st][kt][1]), fmaxf(S[st][kt][2], S[st][kt][3])), m);
        m = fmaxf(m, shx(m, lane, 16)); m = fmaxf(m, shx(m, lane, 32));
        const float mc = m * c2; float l = 0.f;
#pragma unroll
        for (int kt = 0; kt < 16; ++kt)
#pragma unroll
            for (int r = 0; r < 4; ++r) { const float p = __builtin_amdgcn_exp2f(S[st][kt][r] * c2 - mc); S[st][kt][r] = p; l += p; }
        l += shx(l, lane, 16); l += shx(l, lane, 32); linv[st] = 1.f / l;
#pragma unroll
        for (int c = 0; c < 8; ++c) { bf16x8v pk;
#pragma unroll
            for (int j = 0; j < 4; ++j) { pk[j] = (short)f2bf(S[st][2 * c][j]); pk[4 + j] = (short)f2bf(S[st][2 * c + 1][j]); }
            P[st][c] = pk; }
    }
    __syncthreads();
    { int tid2 = tid; asm volatile("" : "+v"(tid2));
      const bf16_t* src = VT + (size_t)(h * 256 + (tid2 >> 5)) * MMEM + b * NMEM + (tid2 & 31) * 8; LAS unsigned char* dst = lds + (tid2 >> 5) * CA_STRIDE + (tid2 & 31) * 16;
#pragma unroll
      for (int i = 0; i < 16; ++i) { const u32x4 v = *(const u32x4*)(src + (size_t)i * 16 * MMEM); *(LAS u32x4*)(dst + i * 16 * CA_STRIDE) = v; } }
    __syncthreads();
#pragma unroll 1
    for (int dh = 0; dh < 2; ++dh) {
        f32x4 O[2][8];
#pragma unroll
        for (int st = 0; st < 2; ++st)
#pragma unroll
            for (int dt = 0; dt < 8; ++dt) O[st][dt] = (f32x4){0.f, 0.f, 0.f, 0.f};
        const LAS unsigned char* pb = lds + (dh * 128 + q16) * CA_STRIDE + g * 8;
#pragma unroll
        for (int dt = 0; dt < 8; ++dt)
#pragma unroll
            for (int c = 0; c < 8; ++c) { const LAS unsigned char* p = pb + dt * 16 * CA_STRIDE + c * 64;
                const u32x2 lo = *(const LAS u32x2*)p, hi = *(const LAS u32x2*)(p + 32);
                const u32x4 av = (u32x4){lo.x, lo.y, hi.x, hi.y}; const bf16x8v a = __builtin_bit_cast(bf16x8v, av);
                O[0][dt] = __builtin_amdgcn_mfma_f32_16x16x32_bf16(a, P[0][c], O[0][dt], 0, 0, 0);
                O[1][dt] = __builtin_amdgcn_mfma_f32_16x16x32_bf16(a, P[1][c], O[1][dt], 0, 0, 0); }
#pragma unroll
        for (int st = 0; st < 2; ++st)
#pragma unroll
            for (int dt = 0; dt < 8; ++dt) { const f32x4 o = O[st][dt] * linv[st]; u32x2 w;
                w.x = (unsigned)f2bf(o[0]) | ((unsigned)f2bf(o[1]) << 16); w.y = (unsigned)f2bf(o[2]) | ((unsigned)f2bf(o[3]) << 16);
                *(u32x2*)(OC + (row0 + st * 16 + q16) * DM + h * 256 + dh * 128 + dt * 16 + g * 4) = w; }
    }
    __syncthreads();
}
typedef float f32x16v __attribute__((ext_vector_type(16)));
__device__ __forceinline__ unsigned code16(float s) {
    const _Float16 hf = (_Float16)s; unsigned u = (unsigned)__builtin_bit_cast(unsigned short, hf);
    if ((u & 0x7fffu) == 0u) u = 0u;
    return (u & 0x8000u) ? (~u & 0xffffu) : (u | 0x8000u);
}
__device__ __forceinline__ unsigned mbcnt64(unsigned long long m) { return __builtin_amdgcn_mbcnt_hi((unsigned)(m >> 32), __builtin_amdgcn_mbcnt_lo((unsigned)m, 0u)); }
__device__ __forceinline__ void topk_unit(LAS unsigned char* lds, int b, int j, const bf16_t* QI, const bf16_t* KI, const float* WI, unsigned short* SEL, int tid, int lane, int wave) {
    asm volatile("" : "+v"(tid), "+v"(lane));
    const int t0 = 16 * j, L = t0 + 16, nkt = (L + 31) >> 5;
    const size_t rowbase = (size_t)b * SEQ + t0;
    const int c32 = lane & 31, hi = lane >> 5;
    {
        bf16x8v qa[2][4]; f32x4 wq[2][4];
#pragma unroll
        for (int rt = 0; rt < 2; ++rt) {
#pragma unroll
            for (int ks = 0; ks < 4; ++ks) qa[rt][ks] = *(const bf16x8v*)(QI + (rowbase + 8 * rt + (c32 >> 2)) * 256 + (c32 & 3) * 64 + 16 * ks + 8 * hi);
#pragma unroll
            for (int gq = 0; gq < 4; ++gq) wq[rt][gq] = *(const f32x4*)(WI + (rowbase + 8 * rt + 2 * gq + hi) * 4);
        }
        const bf16_t* kbase = KI + ((size_t)b * SEQ + c32) * 64 + 8 * hi;
        bf16x8v kb[4], kn[4];
        int kt = wave;
        if (kt < nkt) {
#pragma unroll
            for (int ks = 0; ks < 4; ++ks) kb[ks] = *(const bf16x8v*)(kbase + (size_t)kt * 32 * 64 + 16 * ks);
        }
        for (; kt < nkt; kt += 8) {
            const int ktn = (kt + 8 < nkt) ? kt + 8 : kt;
#pragma unroll
            for (int ks = 0; ks < 4; ++ks) kn[ks] = *(const bf16x8v*)(kbase + (size_t)ktn * 32 * 64 + 16 * ks);
#pragma unroll
            for (int rt = 0; rt < 2; ++rt) {
                f32x16v c = {0.f, 0.f, 0.f, 0.f, 0.f, 0.f, 0.f, 0.f, 0.f, 0.f, 0.f, 0.f, 0.f, 0.f, 0.f, 0.f};
#pragma unroll
                for (int ks = 0; ks < 4; ++ks) c = __builtin_amdgcn_mfma_f32_32x32x16_bf16(qa[rt][ks], kb[ks], c, 0, 0, 0);
#pragma unroll
                for (int gq = 0; gq < 4; ++gq) {
                    const f32x4 w = wq[rt][gq];
                    const float sc = w[0] * fmaxf(c[4 * gq + 0], 0.f) + w[1] * fmaxf(c[4 * gq + 1], 0.f) + w[2] * fmaxf(c[4 * gq + 2], 0.f) + w[3] * fmaxf(c[4 * gq + 3], 0.f);
                    const int q = 8 * rt + 2 * gq + hi;
                    *(LAS unsigned short*)(lds + q * 8192 + (kt * 32 + c32) * 2) = (unsigned short)code16(sc);
                }
            }
#pragma unroll
            for (int ks = 0; ks < 4; ++ks) kb[ks] = kn[ks];
        }
    }
    __syncthreads();
#pragma unroll 1
    for (int qq = 0; qq < 2; ++qq) {
        const int q = 2 * wave + qq, t = t0 + q, n = t + 1;
        unsigned short* sel = SEL + (rowbase + q) * TOPK;
        if (n <= TOPK) {
#pragma unroll
            for (int i = 0; i < 4; ++i) { const int s = lane + 64 * i; if (s < n) sel[s] = (unsigned short)s; }
            continue;
        }
        const int nch = (n + 127) >> 7;
        unsigned lo[32], hi16[32];
        const LAS unsigned* row = (const LAS unsigned*)(lds + q * 8192) + lane;
#pragma unroll
        for (int c = 0; c < 32; ++c) {
            unsigned v = 0u; if (c < nch) v = row[64 * c];
            const int i0 = 128 * c + 2 * lane;
            lo[c] = (i0 <= t) ? (v & 0xffffu) : 0u; hi16[c] = (i0 + 1 <= t) ? (v >> 16) : 0u;
        }
#define TK_CMP8(OP, X0, X1, X2, X3, X4, X5, X6, X7, CAND, ACC) do { unsigned long long m0_, m1_, m2_, m3_, m4_, m5_, m6_, m7_; \
            asm volatile(OP " %0, %8, %16\n\t" OP " %1, %9, %16\n\t" OP " %2, %10, %16\n\t" OP " %3, %11, %16\n\t" OP " %4, %12, %16\n\t" OP " %5, %13, %16\n\t" OP " %6, %14, %16\n\t" OP " %7, %15, %16" \
                : "=&s"(m0_), "=&s"(m1_), "=&s"(m2_), "=&s"(m3_), "=&s"(m4_), "=&s"(m5_), "=&s"(m6_), "=&s"(m7_) \
                : "v"(X0), "v"(X1), "v"(X2), "v"(X3), "v"(X4), "v"(X5), "v"(X6), "v"(X7), "s"(CAND)); \
            ACC += (unsigned)(__builtin_popcountll(m0_) + __builtin_popcountll(m1_)) + (unsigned)(__builtin_popcountll(m2_) + __builtin_popcountll(m3_)) \
                 + (unsigned)(__builtin_popcountll(m4_) + __builtin_popcountll(m5_)) + (unsigned)(__builtin_popcountll(m6_) + __builtin_popcountll(m7_)); } while (0)
#define TK_GRP(OP, G8, CAND, ACC) do { TK_CMP8(OP, lo[G8], hi16[G8], lo[G8 + 1], hi16[G8 + 1], lo[G8 + 2], hi16[G8 + 2], lo[G8 + 3], hi16[G8 + 3], CAND, ACC); \
            TK_CMP8(OP, lo[G8 + 4], hi16[G8 + 4], lo[G8 + 5], hi16[G8 + 5], lo[G8 + 6], hi16[G8 + 6], lo[G8 + 7], hi16[G8 + 7], CAND, ACC); } while (0)
#define TK_COUNT(OP, CAND, RES) do { unsigned tot_ = 0u; const unsigned cs_ = (unsigned)__builtin_amdgcn_readfirstlane((int)(CAND)); \
            TK_GRP(OP, 0, cs_, tot_); if (nch > 8) TK_GRP(OP, 8, cs_, tot_); if (nch > 16) TK_GRP(OP, 16, cs_, tot_); if (nch > 24) TK_GRP(OP, 24, cs_, tot_); RES = tot_; } while (0)
        unsigned T = 0u;
#pragma unroll 1
        for (int bit = 15; bit >= 0; --bit) {
            const unsigned cand = T | (1u << bit); unsigned cnt;
            TK_COUNT("v_cmp_ge_u32_e64", cand, cnt);
            if (cnt >= (unsigned)TOPK) T = cand;
        }
        unsigned cgt;
        TK_COUNT("v_cmp_gt_u32_e64", T, cgt);
#undef TK_COUNT
#undef TK_GRP
#undef TK_CMP8
        const unsigned need = (unsigned)TOPK - cgt;
        unsigned eqrun = 0u, selrun = 0u;
#pragma unroll
        for (int c = 0; c < 32; ++c) if (c < nch) {
            const bool elo = lo[c] == T, ehi = hi16[c] == T;
            const unsigned long long melo = __ballot(elo), mehi = __ballot(ehi);
            const unsigned rank_lo = eqrun + mbcnt64(melo) + mbcnt64(mehi), rank_hi = rank_lo + (elo ? 1u : 0u);
            const bool tlo = (lo[c] > T) || (elo && rank_lo < need), thi = (hi16[c] > T) || (ehi && rank_hi < need);
            const unsigned long long mtlo = __ballot(tlo), mthi = __ballot(thi);
            const unsigned pos_lo = selrun + mbcnt64(mtlo) + mbcnt64(mthi), pos_hi = pos_lo + (tlo ? 1u : 0u);
            if (tlo && pos_lo < (unsigned)TOPK) sel[pos_lo] = (unsigned short)(128 * c + 2 * lane);
            if (thi && pos_hi < (unsigned)TOPK) sel[pos_hi] = (unsigned short)(128 * c + 2 * lane + 1);
            eqrun += (unsigned)__popcll(melo) + (unsigned)__popcll(mehi); selrun += (unsigned)__popcll(mtlo) + (unsigned)__popcll(mthi);
        }
    }
    __syncthreads();
}
__device__ __forceinline__ void topk_phase(LAS unsigned char* lds, int G, int vcu, const bf16_t* QI, const bf16_t* KI, const float* WI, unsigned short* SEL, int tid, int lane, int wave) {
    if (G == 256) {
        const int b = vcu >> 5, i = vcu & 31;
#pragma unroll 1
        for (int k = 0; k < 8; ++k) { const int j = 64 * (k >> 1) + ((k & 1) ? 63 - i : i); topk_unit(lds, b, j, QI, KI, WI, SEL, tid, lane, wave); }
    } else {
#pragma unroll 1
        for (int u = vcu; u < BATCH * 256; u += G) topk_unit(lds, u >> 8, u & 255, QI, KI, WI, SEL, tid, lane, wave);
    }
}
typedef short v4i16_t __attribute__((ext_vector_type(4)));
constexpr int SV_STRIDE = 160, SV_TILE_BYTES = 64 * SV_STRIDE, SV_WAVE_BYTES = SV_TILE_BYTES + 1024;
__device__ __forceinline__ v4i16_t tr_read16(const LAS unsigned char* p) { return __builtin_amdgcn_ds_read_tr16_b64_v4i16((LAS v4i16_t*)p); }
#define SP_FENCE() asm volatile("" ::: "memory")
__device__ __forceinline__ void sparse_attn_phase(LAS unsigned char* lds, int G, int vcu, const bf16_t* Q, const bf16_t* Kb, const bf16_t* Vb, const unsigned short* SEL, bf16_t* MIX, int lane, int wave) {
    asm volatile("" : "+v"(lane));
    LAS unsigned char* wl = lds + wave * SV_WAVE_BYTES;
    const int q16 = lane & 15, g = lane >> 4;
    const int nq = (G == 256) ? 16 : (MTOK - (vcu * 8 + wave) + G * 8 - 1) / (G * 8);
    const int r_first = (G == 256) ? (vcu >> 5) * SEQ + (vcu & 31) * 8 + wave : vcu * 8 + wave, r_step = (G == 256) ? 256 : G * 8;
    u32x2 selv = (u32x2){0u, 0u};
    if (nq > 0) selv = *(const u32x2*)(SEL + (size_t)r_first * TOPK + 4 * lane);
    LAS unsigned char* wdst = wl + (lane >> 3) * SV_STRIDE + (lane & 7) * 16;
    const LAS unsigned char* rsrc = wl + (4 * g + (q16 >> 2)) * SV_STRIDE + (q16 & 3) * 8;
    const float c2 = 0.125f * 1.4426950408889634f;
#pragma unroll 1
    for (int k = 0; k < nq; ++k) {
        const size_t row = (size_t)r_first + (size_t)k * r_step; const int b = (int)(row / SEQ), t = (int)(row % SEQ);
        const int n = (t + 1 < TOPK) ? t + 1 : TOPK;
        LAS unsigned char* ib = wl + SV_TILE_BYTES + (k & 1) * 512;
        *(LAS u32x2*)(ib + lane * 8) = selv;
        if (k + 1 < nq) selv = *(const u32x2*)(SEL + (row + r_step) * TOPK + 4 * lane);
        bf16x8v qf[2];
#pragma unroll
        for (int ks = 0; ks < 2; ++ks) { u32x4 v = (u32x4){0u, 0u, 0u, 0u}; if (q16 < 8) v = *(const u32x4*)(Q + row * 512 + q16 * 64 + ks * 32 + g * 8); qf[ks] = __builtin_bit_cast(bf16x8v, v); }
        f32x4 S[16];
        const bf16_t* kbat = Kb + (size_t)b * SEQ * 64 + g * 8;
        const bf16_t* vbat = Vb + (size_t)b * SEQ * 64 + (lane & 7) * 8;
#pragma unroll
        for (int kh = 0; kh < 2; ++kh) {
            bf16x8v kf[8][2];
#pragma unroll
            for (int i = 0; i < 8; ++i) { const int slot = 128 * kh + 16 * i + q16; unsigned idx = *(const LAS unsigned short*)(ib + slot * 2); if (slot >= n) idx = 0u;
#pragma unroll
                for (int ks = 0; ks < 2; ++ks) kf[i][ks] = *(const bf16x8v*)(kbat + (size_t)idx * 64 + ks * 32); }
            SP_FENCE();
#pragma unroll
            for (int i = 0; i < 8; ++i) { f32x4 c = (f32x4){0.f, 0.f, 0.f, 0.f};
                c = __builtin_amdgcn_mfma_f32_16x16x32_bf16(kf[i][0], qf[0], c, 0, 0, 0);
                c = __builtin_amdgcn_mfma_f32_16x16x32_bf16(kf[i][1], qf[1], c, 0, 0, 0); S[8 * kh + i] = c; }
            SP_FENCE();
        }
        u32x4 vv[8];
#pragma unroll
        for (int i = 0; i < 8; ++i) { const int slot = (lane >> 3) + 8 * i; unsigned idx = *(const LAS unsigned short*)(ib + slot * 2); if (slot >= n) idx = 0u; vv[i] = *(const u32x4*)(vbat + (size_t)idx * 64); }
        SP_FENCE();
        float m = -INFINITY;
#pragma unroll
        for (int kt = 0; kt < 16; ++kt)
#pragma unroll
            for (int r = 0; r < 4; ++r) { if (16 * kt + 4 * g + r >= n) S[kt][r] = -INFINITY; m = fmaxf(m, S[kt][r]); }
        m = fmaxf(m, shx(m, lane, 16)); m = fmaxf(m, shx(m, lane, 32));
        const float mc = m * c2; float l = 0.f;
#pragma unroll
        for (int kt = 0; kt < 16; ++kt)
#pragma unroll
            for (int r = 0; r < 4; ++r) { const float p = __builtin_amdgcn_exp2f(S[kt][r] * c2 - mc); S[kt][r] = p; l += p; }
        l += shx(l, lane, 16); l += shx(l, lane, 32);
        const float linv = 1.f / l;
        bf16x8v P[8];
#pragma unroll
        for (int c = 0; c < 8; ++c) { u32x4 pk; pk.x = pg8::cvt_pk_bf16(S[2 * c][0], S[2 * c][1]); pk.y = pg8::cvt_pk_bf16(S[2 * c][2], S[2 * c][3]); pk.z = pg8::cvt_pk_bf16(S[2 * c + 1][0], S[2 * c + 1][1]); pk.w = pg8::cvt_pk_bf16(S[2 * c + 1][2], S[2 * c + 1][3]);
            P[c] = __builtin_bit_cast(bf16x8v, pk); }
        f32x4 O[4];
#pragma unroll
        for (int dt = 0; dt < 4; ++dt) O[dt] = (f32x4){0.f, 0.f, 0.f, 0.f};
#pragma unroll
        for (int cc = 0; cc < 4; ++cc) {
#pragma unroll
            for (int i = 0; i < 8; ++i) *(LAS u32x4*)(wdst + i * 8 * SV_STRIDE) = vv[i];
            SP_FENCE();
            if (cc < 3) {
#pragma unroll
                for (int i = 0; i < 8; ++i) { const int slot = 64 * (cc + 1) + (lane >> 3) + 8 * i; unsigned idx = *(const LAS unsigned short*)(ib + slot * 2); if (slot >= n) idx = 0u; vv[i] = *(const u32x4*)(vbat + (size_t)idx * 64); }
            }
            asm volatile("s_waitcnt lgkmcnt(0)" ::: "memory");
#pragma unroll
            for (int c2i = 0; c2i < 2; ++c2i)
#pragma unroll
                for (int dt = 0; dt < 4; ++dt) { const LAS unsigned char* p = rsrc + c2i * 32 * SV_STRIDE + dt * 32;
                    const v4i16_t lo = tr_read16(p), hi = tr_read16(p + 16 * SV_STRIDE);
                    const bf16x8v a = (bf16x8v){lo[0], lo[1], lo[2], lo[3], hi[0], hi[1], hi[2], hi[3]};
                    O[dt] = __builtin_amdgcn_mfma_f32_16x16x32_bf16(a, P[2 * cc + c2i], O[dt], 0, 0, 0); }
            asm volatile("s_waitcnt lgkmcnt(0)" ::: "memory");
        }
        if (q16 < 8) {
#pragma unroll
            for (int dt = 0; dt < 4; ++dt) { const f32x4 o = O[dt] * linv; u32x2 w;
                w.x = pg8::cvt_pk_bf16(o[0], o[1]); w.y = pg8::cvt_pk_bf16(o[2], o[3]);
                *(u32x2*)(MIX + row * DM + q16 * 64 + dt * 16 + g * 4) = w; }
        }
    }
    __syncthreads();
}
__device__ __forceinline__ void convb_phase(LAS unsigned char* lds, int G, int vcu, const bf16_t* U, const float* __restrict__ cw, const float* __restrict__ cb, const float* __restrict__ lng, const float* __restrict__ lnb, bf16_t* MIX, int tid, int lane, int wave) {
    asm volatile("" : "+v"(tid), "+v"(lane));
    typedef float f32x2v __attribute__((ext_vector_type(2)));
    const int cp = tid & 255, th = tid >> 8;
    f32x2v w[31];
#pragma unroll
    for (int j = 0; j < 31; ++j) w[j] = *(const f32x2v*)(cw + j * 512 + 2 * cp);
    const f32x2v bias = *(const f32x2v*)(cb + 2 * cp), gam = *(const f32x2v*)(lng + 2 * cp), bet = *(const f32x2v*)(lnb + 2 * cp);
    LAS float* red = (LAS float*)(lds + 65536);
#pragma unroll 1
    for (int tile = vcu; tile < MTOK / 32; tile += G) {
        const int row0 = tile * 32, t0 = row0 & (SEQ - 1);
        for (int i = tid; i < 62 * 64; i += 512) { const int r = i >> 6, ch = i & 63; u32x4 v = (u32x4){0u, 0u, 0u, 0u};
            if (t0 - 30 + r >= 0) v = *(const u32x4*)(U + (size_t)(row0 - 30 + r) * 512 + ch * 8);
            *(LAS u32x4*)(lds + r * 1024 + ch * 16) = v; }
        __syncthreads();
        f32x2v y[2][8];
#pragma unroll
        for (int k = 0; k < 2; ++k) {
            const int tg = th + 2 * k;
            f32x2v acc[8];
#pragma unroll
            for (int o = 0; o < 8; ++o) acc[o] = bias;
            const LAS unsigned* wp = (const LAS unsigned*)(lds + tg * 8 * 1024) + cp;
#pragma unroll
            for (int j = 0; j < 38; ++j) { const unsigned uu = wp[j * 256]; const f32x2v uv = (f32x2v){__uint_as_float(uu << 16), __uint_as_float(uu & 0xffff0000u)};
#pragma unroll
                for (int o = 0; o < 8; ++o) { const int tap = j - o; if (tap >= 0 && tap < 31) acc[o] += w[tap] * uv; } }
#pragma unroll
            for (int o = 0; o < 8; ++o) { y[k][o] = acc[o];
                float s = acc[o].x + acc[o].y, q = acc[o].x * acc[o].x + acc[o].y * acc[o].y;
                s = wave_sum_l(s, lane); q = wave_sum_l(q, lane);
                if (lane == 0) { red[((tg * 8 + o) * 4 + (wave & 3)) * 2] = s; red[((tg * 8 + o) * 4 + (wave & 3)) * 2 + 1] = q; } }
        }
        __syncthreads();
#pragma unroll
        for (int k = 0; k < 2; ++k) {
            const int tg = th + 2 * k;
#pragma unroll
            for (int o = 0; o < 8; ++o) { const int tl = tg * 8 + o;
                const f32x4 ra = *(const LAS f32x4*)(red + tl * 8), rb = *(const LAS f32x4*)(red + tl * 8 + 4);
                const float mu = ((ra[0] + ra[2]) + (rb[0] + rb[2])) * (1.f / 512.f), ex2 = ((ra[1] + ra[3]) + (rb[1] + rb[3])) * (1.f / 512.f);
                const float rstd = 1.f / sqrtf(fmaxf(ex2 - mu * mu, 0.f) + EPS);
                const float v0 = (y[k][o].x - mu) * rstd * gam.x + bet.x, v1 = (y[k][o].y - mu) * rstd * gam.y + bet.y;
                *(unsigned*)(MIX + (size_t)(row0 + tl) * DM + 512 + 2 * cp) = (unsigned)f2bf(silu_f(v0)) | ((unsigned)f2bf(silu_f(v1)) << 16); }
        }
        __syncthreads();
    }
}

__device__ __forceinline__ int wt_dst_row(int mode, int c) {
    if (mode == 0) return c;
    if (mode == 2) return 256 * (c >> 7) + (c & 127);
    if (mode == 3) return 256 * (c >> 7) + 128 + (c & 127);
    if (c < 512) return (c & ~63) + dperm(c & 63);
    if (c < 576) return 512 + dperm(c - 512);
    if (c < 640) return c;
    if (c < 896) return 768 + ((c - 640) & ~63) + dperm((c - 640) & 63);
    if (c < 960) return 640 + dperm(c - 896);
    if (c < 964) return 704 + (c - 960);
    if (c < 1476) { const int j = c - 964; return 1024 + 256 * (j >> 7) + (j & 127); }
    { const int j = c - 1476; return 1024 + 256 * (j >> 7) + 128 + (j & 127); }
}
__device__ __forceinline__ void wt_body(LAS unsigned char* sm, int vb, int tid, const float* __restrict__ W, int K, int N, bf16_t* WT, const float* __restrict__ gain, int mode) {
    LAS float* t = (LAS float*)sm;
    const int nbx = (N + 31) / 32; const int k0 = (vb / nbx) * 32, n0 = (vb % nbx) * 32, tx = tid & 31, ty = tid >> 5;
    for (int i = ty; i < 32; i += 8) { const int k = k0 + i, n = n0 + tx; float v = 0.f; if (k < K && n < N) { v = W[(size_t)k * N + n]; if (gain) v *= gain[k]; } t[i * 33 + tx] = v; }
    __syncthreads();
    for (int i = ty; i < 32; i += 8) { const int n = n0 + i, k = k0 + tx; if (n < N && k < K) WT[(size_t)wt_dst_row(mode, n) * K + k] = f2bf(t[tx * 33 + i]); }
    __syncthreads();
}
__device__ __forceinline__ void rmsnorm_bf16_row(const float* x, const float* __restrict__ g, bf16_t* out, int row, int lane) {
    const f32x4* xr = (const f32x4*)(x + (size_t)row * DM) + lane; const f32x4* gr = (const f32x4*)g + lane;
    f32x4 v[4]; float s = 0.f;
#pragma unroll
    for (int j = 0; j < 4; ++j) { v[j] = xr[64 * j]; s += (v[j].x * v[j].x + v[j].y * v[j].y) + (v[j].z * v[j].z + v[j].w * v[j].w); }
    const float rstd = 1.f / sqrtf(wave_sum_l(s, lane) * (1.f / DM) + EPS);
    u32x2* o = (u32x2*)(out + (size_t)row * DM) + lane;
#pragma unroll
    for (int j = 0; j < 4; ++j) { const f32x4 gg = gr[64 * j]; u32x2 w;
        w.x = (unsigned)f2bf(v[j].x * rstd * gg.x) | ((unsigned)f2bf(v[j].y * rstd * gg.y) << 16);
        w.y = (unsigned)f2bf(v[j].z * rstd * gg.z) | ((unsigned)f2bf(v[j].w * rstd * gg.w) << 16); o[64 * j] = w; }
}
__device__ __forceinline__ void rmsnorm_f32_row(float* x, const float* __restrict__ g, int row, int lane) {
    f32x4* xr = (f32x4*)(x + (size_t)row * DM) + lane; const f32x4* gr = (const f32x4*)g + lane;
    f32x4 v[4]; float s = 0.f;
#pragma unroll
    for (int j = 0; j < 4; ++j) { v[j] = xr[64 * j]; s += (v[j].x * v[j].x + v[j].y * v[j].y) + (v[j].z * v[j].z + v[j].w * v[j].w); }
    const float rstd = 1.f / sqrtf(wave_sum_l(s, lane) * (1.f / DM) + EPS);
#pragma unroll
    for (int j = 0; j < 4; ++j) { const f32x4 gg = gr[64 * j]; xr[64 * j] = v[j] * rstd * gg; }
}

constexpr size_t MiB = 1u << 20;
constexpr int LDS_USER = 139264, LDSCTL_OFF = LDS_USER, MISC_OFF = LDSCTL_OFF + 320, LDS_BYTES = 147456;
constexpr size_t WS_CTL = 476 * MiB, CTL_ZERO_BYTES = 1 * MiB; constexpr int CW_BAR = 4096;
constexpr int NGU = 2 * DFF;
struct Args { const float* in[23]; float* out; unsigned char* ws; };
static_assert(sizeof(Args) == 25 * 8, "Args has no padding");

__global__ void __launch_bounds__(512, 2) mega_k(Args a) {
    extern __shared__ __attribute__((aligned(16))) unsigned char lds_raw[];
    LAS unsigned char* lds = (LAS unsigned char*)lds_raw;
    const int wave = __builtin_amdgcn_readfirstlane(threadIdx.x >> 6);
#define PH_IDS() int lane; asm volatile("v_mbcnt_lo_u32_b32 %0, -1, 0\n\tv_mbcnt_hi_u32_b32 %0, -1, %0" : "=v"(lane)); const int tid = wave * 64 + lane, half = wave >> 2, htid = tid & 255; LAS unsigned char* hsm = lds + half * 65536; (void)htid; (void)hsm
    const int G = gridDim.x, bx = blockIdx.x; const int vcu = (G % 8 == 0) ? (bx % 8) * (G / 8) + bx / 8 : bx;
    const float* x = a.in[0]; const float* mem = a.in[1]; const int* positions = (const int*)a.in[2];
    const float* g_mix = a.in[3]; const float* w_in = a.in[4]; const float* w_out = a.in[5];
    const float* conv_b_w = a.in[6]; const float* conv_b_b = a.in[7]; const float* ln_b_g = a.in[8]; const float* ln_b_b = a.in[9];
    const float* g_cross = a.in[10]; const float* g_mem = a.in[11];
    const float* w_q = a.in[12]; const float* w_k = a.in[13]; const float* w_v = a.in[14]; const float* w_o = a.in[15];
    const float* g_ffn = a.in[16]; const float* w_gate = a.in[17]; const float* w_up = a.in[18];
    const float* ffn_cw = a.in[19]; const float* ffn_cb = a.in[20]; const float* w_down = a.in[21]; const float* g_final = a.in[22];
    float* out = a.out; unsigned char* ws = a.ws;
    bf16_t* wt_in = (bf16_t*)(ws + 0 * MiB); bf16_t* wt_out = (bf16_t*)(ws + 4 * MiB);
    bf16_t* wt_q = (bf16_t*)(ws + 6 * MiB), *wt_k = (bf16_t*)(ws + 8 * MiB), *wt_v = (bf16_t*)(ws + 10 * MiB), *wt_o = (bf16_t*)(ws + 12 * MiB);
    bf16_t* wt_gu = (bf16_t*)(ws + 14 * MiB); bf16_t* wt_down = (bf16_t*)(ws + 26 * MiB);
    float* WI = (float*)(ws + 32 * MiB); float* CS = (float*)(ws + 33 * MiB);
    float* SS1 = (float*)(ws + 35 * MiB); float* SS2 = (float*)(ws + 37 * MiB); float* SS3 = (float*)(ws + 39 * MiB);
    bf16_t* MEMN = (bf16_t*)(ws + 41 * MiB), *KC = (bf16_t*)(ws + 45 * MiB), *VC = (bf16_t*)(ws + 49 * MiB);
    bf16_t* XB = (bf16_t*)(ws + 56 * MiB);
    bf16_t* Qb = (bf16_t*)(ws + 120 * MiB); bf16_t* QI = (bf16_t*)(ws + 152 * MiB);
    bf16_t* Kb = (bf16_t*)(ws + 168 * MiB), *Vb = (bf16_t*)(ws + 172 * MiB), *KI = (bf16_t*)(ws + 176 * MiB);
    bf16_t* U = (bf16_t*)(ws + 180 * MiB); unsigned short* SEL = (unsigned short*)(ws + 212 * MiB);
    bf16_t* MIX = (bf16_t*)(ws + 228 * MiB); bf16_t* QC = (bf16_t*)(ws + 292 * MiB); bf16_t* OC = (bf16_t*)(ws + 356 * MiB);
    bf16_t* Gb = (bf16_t*)(ws + 120 * MiB); bf16_t* UF = (bf16_t*)(ws + 296 * MiB);
    unsigned* ctl = (unsigned*)(ws + WS_CTL);

    { PH_IDS(); for (int u = tid; u < (LDS_BYTES - LDSCTL_OFF) / 4; u += 512) ((LAS unsigned*)(lds + LDSCTL_OFF))[u] = 0u; }
    __syncthreads();
    XcdBarrier bar = xcd_barrier_post(ctl + CW_BAR, (volatile LAS unsigned*)(lds + MISC_OFF) + 8);
#define GRID_BAR() xcd_barrier(bar)
#define FOR_VB(nvb) for (int vb = 2 * bx + half; vb < (nvb); vb += 2 * G)
#define GEMMX(EPI, EINIT, Aptr, Bptr, Mv, Nv, Kv) do { pg8::Gemm g_{Aptr, Bptr, Mv, Nv, Kv}; pg8::StaticOrder S_; S_.init(Mv, Nv, G, bx); EPI E_ EINIT; \
        PH_IDS(); pg8::gemm_phase<EPI, pg8::StaticOrder, true, true>(lds, g_, S_, E_, tid); } while (0)
#define EI(...) {__VA_ARGS__}

    { PH_IDS();
    for (int i = bx * 512 + tid; i < 60 * DM; i += G * 512) wt_in[(size_t)708 * DM + i] = 0;
    FOR_VB(32 * 63) wt_body(hsm, vb, htid, w_in, DM, INC, wt_in, nullptr, 1);
    FOR_VB(32 * 32) wt_body(hsm, vb, htid, w_out, DM, DM, wt_out, nullptr, 0);
    FOR_VB(32 * 32) wt_body(hsm, vb, htid, w_q, DM, DM, wt_q, g_cross, 0);
    FOR_VB(32 * 32) wt_body(hsm, vb, htid, w_k, DM, DM, wt_k, nullptr, 0);
    FOR_VB(32 * 32) wt_body(hsm, vb, htid, w_v, DM, DM, wt_v, nullptr, 0);
    FOR_VB(32 * 32) wt_body(hsm, vb, htid, w_o, DM, DM, wt_o, nullptr, 0);
    FOR_VB(32 * 88) wt_body(hsm, vb, htid, w_gate, DM, DFF, wt_gu, g_ffn, 2);
    FOR_VB(32 * 88) wt_body(hsm, vb, htid, w_up, DM, DFF, wt_gu, g_ffn, 3);
    FOR_VB(88 * 32) wt_body(hsm, vb, htid, w_down, DFF, DM, wt_down, nullptr, 0);
    for (int i = bx * 512 + tid; i < MTOK * 8; i += G * 512) { const int row = i >> 3, k = i & 7;
        const float freq = (float)pow(500000.0, -0.125 * (double)k); const float ang = (float)positions[row] * freq;
        CS[(size_t)row * 16 + k] = (float)cos((double)ang); CS[(size_t)row * 16 + 8 + k] = (float)sin((double)ang); }
    for (int r = bx * 8 + wave; r < MTOK; r += G * 8) rmsnorm_bf16_row(x, g_mix, XB, r, lane);
    for (int r = bx * 8 + wave; r < MMEM; r += G * 8) rmsnorm_bf16_row(mem, g_mem, MEMN, r, lane);
    }
    GRID_BAR();
    GEMMX(EpiIn, EI(CS, Qb, Kb, Vb, QI, KI, U, WI), XB, wt_in, MTOK, INP, DM);
    GEMMX(EpiStore, EI(nullptr, KC, nullptr, DM), MEMN, wt_k, MMEM, DM, DM);
    GEMMX(EpiStore, EI(nullptr, VC, nullptr, MMEM), wt_v, MEMN, DM, MMEM, DM);
    GRID_BAR();
    { PH_IDS(); topk_phase(lds, G, vcu, QI, KI, WI, SEL, tid, lane, wave); }
    { PH_IDS(); convb_phase(lds, G, vcu, U, conv_b_w, conv_b_b, ln_b_g, ln_b_b, MIX, tid, lane, wave); }
    GRID_BAR();
    { PH_IDS(); sparse_attn_phase(lds, G, vcu, Qb, Kb, Vb, SEL, MIX, lane, wave); }
    GRID_BAR();
    GEMMX(EpiRes, EI(x, out, XB, SS1), MIX, wt_out, MTOK, DM, DM);
    GRID_BAR();
    GEMMX(EpiScale, EI(SS1, QC, DM, 1.0f), XB, wt_q, MTOK, DM, DM);
    GRID_BAR();
    { PH_IDS(); const int per = (512 + G - 1) / G; for (int i = 0; i < per; ++i) { const int u = vcu * per + i; if (u < 512) cross_attn_unit(lds, u >> 6, (u >> 4) & 3, u & 15, QC, KC, VC, OC, tid, lane, wave); } }
    GRID_BAR();
    GEMMX(EpiRes, EI(out, out, XB, SS2), OC, wt_o, MTOK, DM, DM);
    GRID_BAR();
    GEMMX(EpiGateUp, EI(SS2, Gb, UF), XB, wt_gu, MTOK, NGU, DM);
    GRID_BAR();
    { PH_IDS();
    for (int i = bx * 512 + tid; i < MTOK * (DFF / 8); i += G * 512) {
        const int row = i / (DFF / 8), c = (i - row * (DFF / 8)) * 8, t = row & (SEQ - 1); const size_t off = (size_t)row * DFF + c;
        const u32x4 g2 = *(const u32x4*)(Gb + off); u32x4 g1 = (u32x4){0u, 0u, 0u, 0u}, g0 = (u32x4){0u, 0u, 0u, 0u};
        if (t >= 1) g1 = *(const u32x4*)(Gb + off - DFF);
        if (t >= 2) g0 = *(const u32x4*)(Gb + off - 2 * DFF);
        const u32x4 uu = *(const u32x4*)(UF + off); u32x4 o;
#pragma unroll
        for (int e = 0; e < 4; ++e) { float r[2];
#pragma unroll
            for (int hh = 0; hh < 2; ++hh) { const int cc = c + 2 * e + hh;
                const float a2 = hh ? __uint_as_float(g2[e] & 0xffff0000u) : __uint_as_float(g2[e] << 16), a1 = hh ? __uint_as_float(g1[e] & 0xffff0000u) : __uint_as_float(g1[e] << 16), a0 = hh ? __uint_as_float(g0[e] & 0xffff0000u) : __uint_as_float(g0[e] << 16);
                const float uv = hh ? __uint_as_float(uu[e] & 0xffff0000u) : __uint_as_float(uu[e] << 16);
                const float gg = ffn_cb[cc] + ffn_cw[2 * DFF + cc] * a2 + ffn_cw[DFF + cc] * a1 + ffn_cw[cc] * a0;
                r[hh] = silu_f(gg) * uv; }
            o[e] = (unsigned)f2bf(r[0]) | ((unsigned)f2bf(r[1]) << 16); }
        *(u32x4*)(UF + off) = o;
    }
    }
    GRID_BAR();
    GEMMX(EpiRes, EI(out, out, nullptr, SS3), UF, wt_down, MTOK, DM, DFF);
    GRID_BAR();
    { PH_IDS();
    for (int r = bx * 8 + wave; r < MTOK; r += G * 8) {
        const float rs = rstd_from_ss(SS3, (size_t)r);
        f32x4* xr = (f32x4*)(out + (size_t)r * DM) + lane; const f32x4* gr = (const f32x4*)g_final + lane;
#pragma unroll
        for (int j = 0; j < 4; ++j) xr[64 * j] = xr[64 * j] * rs * gr[64 * j];
    }
    }
}

extern "C" void kernel_launch(void* const* d_in, const int* in_sizes, int n_in, void* d_out, int out_size, void* d_ws, size_t ws_size, hipStream_t stream) {
    static int grid = 0;
    if (grid == 0) {
        int dev = 0, cus = 0, per_cu = 0;
        if (hipGetDevice(&dev) != hipSuccess || hipDeviceGetAttribute(&cus, hipDeviceAttributeMultiprocessorCount, dev) != hipSuccess) { fprintf(stderr, "kernel_launch: device query failed\n"); grid = -1; return; }
        if (hipFuncSetAttribute((const void*)mega_k, hipFuncAttributeMaxDynamicSharedMemorySize, LDS_BYTES) != hipSuccess) { fprintf(stderr, "kernel_launch: hipFuncSetAttribute failed\n"); grid = -1; return; }
        if (hipOccupancyMaxActiveBlocksPerMultiprocessor(&per_cu, (const void*)mega_k, 512, LDS_BYTES) != hipSuccess || per_cu < 1) { fprintf(stderr, "kernel_launch: occupancy query says %d\n", per_cu); per_cu = 1; }
        (void)hipGetLastError();
        grid = cus * 1;
        if (n_in != 23 || ws_size < 477 * MiB) { fprintf(stderr, "kernel_launch: unexpected n_in %d / ws %zu\n", n_in, ws_size); grid = -1; return; }
    }
    if (grid < 0) return;
    (void)hipMemsetAsync((char*)d_ws + WS_CTL, 0, CTL_ZERO_BYTES, stream);
    Args a{};
    for (int i = 0; i < 23; ++i) a.in[i] = (const float*)d_in[i];
    a.out = (float*)d_out; a.ws = (unsigned char*)d_ws;
    void* params[] = {&a};
    hipError_t e = hipLaunchCooperativeKernel((const void*)mega_k, dim3(grid), dim3(512), params, LDS_BYTES, stream);
    if (e != hipSuccess) fprintf(stderr, "cooperative launch failed: %s (grid %d)\n", hipGetErrorString(e), grid);
}
```

```cpp
#include <hip/hip_runtime.h>
#include <cstdio>
#include <cstdint>
#include <cmath>
namespace pg8 {
#define PG8_LAS __attribute__((address_space(3)))
typedef unsigned short bf16_t;
typedef short bf16x8 __attribute__((ext_vector_type(8)));
typedef float f32x4 __attribute__((ext_vector_type(4)));
typedef unsigned u32x4 __attribute__((ext_vector_type(4)));
constexpr int BM = 256, BK = 64, HALF = 128, HTB = HALF * BK * 2  , STAGE_BYTES = 8 * HTB, NXCD = 8, WGM = 8;

__host__ __device__ __forceinline__ int lds_byte(int r, int c) { const int st = (r >> 4) * 2 + (c >> 5), rr = r & 15, cc = c & 31, ob = rr * 64 + cc * 2; return st * 1024 + (ob ^ (((ob >> 9) & 1) << 5)); }
__host__ __device__ __forceinline__ void stage_rc(int b, int& R, int& C) { const int st = b / 1024, sb = b % 1024, swz = sb ^ (((sb >> 9) & 1) << 5); R = (st >> 1) * 16 + swz / 64; C = (st & 1) * 32 + (swz % 64) / 2; }
__host__ __device__ __forceinline__ int perm32(int rho) { const int n = rho >> 4, i = rho & 15; return 8 * (i >> 2) + 4 * n + (i & 3); }

struct Unit { int pm, pn; };
struct Gemm { const bf16_t* A; const bf16_t* Bt; int M, N, K; };

struct StaticOrder {
    int nM, nN, nwg, G, c;
    __host__ __device__ void init(int M, int N, int G_, int c_) { nM = M / BM; nN = N / BM; nwg = nM * nN; G = G_; c = c_; }
    __host__ __device__ bool next(int i, Unit& u) const {
        const long L = (long)i * G + c; if (L >= nwg) return false;
        int wgid = (int)L; { const int q = nwg / NXCD, r = nwg % NXCD, xcd = wgid % NXCD, off = wgid / NXCD; wgid = (xcd < r ? xcd * (q + 1) : r * (q + 1) + (xcd - r) * q) + off; }
        const int nig = WGM * nN, gid = wgid / nig, fm = gid * WGM, gsz = (nM - fm) < WGM ? (nM - fm) : WGM;
        u.pm = fm + ((wgid % nig) % gsz); u.pn = (wgid % nig) / gsz; return true;
    }
    __device__ __forceinline__ void a_ready(const Unit&) const {}
    __device__ __forceinline__ void done(const Unit&) const {}
};
__device__ __forceinline__ unsigned cvt_pk_bf16(float lo, float hi) { unsigned r; asm volatile("v_cvt_pk_bf16_f32 %0, %1, %2" : "=v"(r) : "v"(lo), "v"(hi)); return r; }
template <class Epi, class Sched, bool ALIGN_EPI = false, bool SP2 = false>
__device__ __forceinline__ void gemm_phase(PG8_LAS unsigned char* lds, const Gemm g, const Sched& S, const Epi& E, int tid_in) {
    int tid_l = tid_in; asm volatile("" : "+v"(tid_l));
    const int tid = tid_l, wid = __builtin_amdgcn_readfirstlane(tid >> 6), lane = tid & 63, wr = wid >> 2, wc = wid & 3, fr = lane & 15, fq = lane >> 4;
    const int K = g.K, nt = K / BK;
    unsigned voffA[2], voffB[2];
#pragma unroll
    for (int i = 0; i < 2; ++i) { int R, C; stage_rc(tid * 16 + i * 8192, R, C); const int Rb = Epi::PERM ? ((R & ~31) + perm32(R & 31)) : R;
        voffA[i] = (unsigned)(R * K + C) * 2u; voffB[i] = (unsigned)(Rb * K + C) * 2u; }
    const size_t kstep = (size_t)(BK * 2);
    const size_t hstep = (size_t)HALF * K * 2;
    const size_t tstep = 2 * hstep;
    const unsigned ldsw = (unsigned)wid * 1024u;
    const int aoff = lds_byte(wr * 64 + fr, fq * 8), boff = lds_byte(wc * 32 + fr, fq * 8);
#define PG8_SA(b, h) (((b) * 2 + (h)) * HTB)
#define PG8_SB(b, h) ((4 + (b) * 2 + (h)) * HTB)
#define PG8_STAGE(bufoff, gbase, voff) do { _Pragma("unroll") for (int _i = 0; _i < 2; ++_i) \
        __builtin_amdgcn_global_load_lds((const unsigned*)((const char*)(gbase) + (voff)[_i]), (PG8_LAS unsigned*)(lds + (bufoff) + ldsw + _i * 8192), 16, 0, 0); } while (0)
#define PG8_LDA(dst, b, h) do { _Pragma("unroll") for (int m = 0; m < 4; ++m) _Pragma("unroll") for (int k = 0; k < 2; ++k) dst[m][k] = *(const PG8_LAS bf16x8*)(lds + PG8_SA(b, h) + aoff + m * 2048 + k * 1024); } while (0)
#define PG8_LDB(dst, b, h) do { _Pragma("unroll") for (int n = 0; n < 2; ++n) _Pragma("unroll") for (int k = 0; k < 2; ++k) dst[n][k] = *(const PG8_LAS bf16x8*)(lds + PG8_SB(b, h) + boff + n * 2048 + k * 1024); } while (0)
#define PG8_MMA(ai, bj, At, Bt) do { __builtin_amdgcn_s_setprio(1); _Pragma("unroll") for (int m = 0; m < 4; ++m) _Pragma("unroll") for (int n = 0; n < 2; ++n) _Pragma("unroll") for (int k = 0; k < 2; ++k) \
        acc[ai][bj][m][n] = __builtin_amdgcn_mfma_f32_16x16x32_bf16(Bt[n][k], At[m][k], acc[ai][bj][m][n], 0, 0, 0); __builtin_amdgcn_s_setprio(0); } while (0)
#define PG8_WAIT_V(n) asm volatile("s_waitcnt vmcnt(" #n ")" ::: "memory")
#define PG8_WAIT_L(n) asm volatile("s_waitcnt lgkmcnt(" #n ")" ::: "memory")
#define PG8_BAR __builtin_amdgcn_s_barrier()
#define PG8_SCHED __builtin_amdgcn_sched_barrier(0)
    Unit cur, nxt; int ui = 0;
    if (!S.next(0, cur)) return;
    f32x4 acc[2][2][4][2];
#pragma unroll
    for (int a = 0; a < 2; ++a)
#pragma unroll
        for (int b = 0; b < 2; ++b)
#pragma unroll
            for (int m = 0; m < 4; ++m)
#pragma unroll
                for (int n = 0; n < 2; ++n) acc[a][b][m][n] = (f32x4){0.f, 0.f, 0.f, 0.f};
    bf16x8 At[4][2], B0[2][2], B1[2][2];
    const char* cA = (const char*)g.A + (size_t)cur.pm * tstep; const char* cB = (const char*)g.Bt + (size_t)cur.pn * tstep;
    S.a_ready(cur);
    if constexpr (SP2) {
        PG8_STAGE(PG8_SB(0, 0), cB, voffB); PG8_STAGE(PG8_SB(0, 1), cB + hstep, voffB); PG8_STAGE(PG8_SA(0, 0), cA, voffA); PG8_STAGE(PG8_SA(0, 1), cA + hstep, voffA);
        if (wr == 1) PG8_BAR;
        PG8_WAIT_V(2); PG8_BAR;
        PG8_STAGE(PG8_SB(1, 0), cB + kstep, voffB); PG8_STAGE(PG8_SA(1, 0), cA + kstep, voffA); PG8_STAGE(PG8_SB(1, 1), cB + hstep + kstep, voffB);
        PG8_WAIT_V(6); PG8_BAR;
    } else {
        PG8_STAGE(PG8_SB(0, 0), cB, voffB); PG8_STAGE(PG8_SA(0, 0), cA, voffA); PG8_STAGE(PG8_SB(0, 1), cB + hstep, voffB); PG8_STAGE(PG8_SA(0, 1), cA + hstep, voffA);
        if (wr == 1) PG8_BAR;
        PG8_WAIT_V(4); PG8_BAR;
        PG8_STAGE(PG8_SB(1, 0), cB + kstep, voffB); PG8_STAGE(PG8_SA(1, 0), cA + kstep, voffA); PG8_STAGE(PG8_SB(1, 1), cB + hstep + kstep, voffB);
        PG8_WAIT_V(6); PG8_BAR;
    }
    for (;;) {
        const bool has_next = S.next(ui + 1, nxt);
        const char* nA = has_next ? (const char*)g.A + (size_t)nxt.pm * tstep : cA; const char* nB = has_next ? (const char*)g.Bt + (size_t)nxt.pn * tstep : cB;
        for (int t = 0; t < nt; t += 2) {
            const bool last = (t == nt - 2);
            const char* a1 = cA + (size_t)(t + 1) * kstep;
            const char* a2 = last ? nA : cA + (size_t)(t + 2) * kstep; const char* b2 = last ? nB : cB + (size_t)(t + 2) * kstep;
            const char* a3 = a2 + kstep; const char* b3 = b2 + kstep;
            if (last && has_next) S.a_ready(nxt);
            if constexpr (SP2) {
            PG8_LDB(B0, 0, 0); PG8_LDB(B1, 0, 1); PG8_SCHED; PG8_LDA(At, 0, 0); PG8_STAGE(PG8_SA(1, 1), a1 + hstep, voffA);
            PG8_WAIT_V(8); PG8_WAIT_L(0); PG8_BAR; PG8_MMA(0, 0, At, B0); PG8_MMA(0, 1, At, B1); PG8_BAR; PG8_SCHED;
            PG8_LDA(At, 0, 1); PG8_STAGE(PG8_SB(0, 0), b2, voffB); PG8_STAGE(PG8_SB(0, 1), b2 + hstep, voffB); PG8_STAGE(PG8_SA(0, 0), a2, voffA);
            PG8_WAIT_V(8); PG8_WAIT_L(0); PG8_BAR; PG8_MMA(1, 0, At, B0); PG8_MMA(1, 1, At, B1); PG8_BAR; PG8_SCHED;
            PG8_LDB(B0, 1, 0); PG8_LDB(B1, 1, 1); PG8_SCHED; PG8_LDA(At, 1, 0); PG8_STAGE(PG8_SA(0, 1), a2 + hstep, voffA);
            PG8_WAIT_V(8); PG8_WAIT_L(0); PG8_BAR; PG8_MMA(0, 0, At, B0); PG8_MMA(0, 1, At, B1); PG8_BAR; PG8_SCHED;
            PG8_LDA(At, 1, 1); PG8_STAGE(PG8_SB(1, 0), b3, voffB); PG8_STAGE(PG8_SB(1, 1), b3 + hstep, voffB); PG8_STAGE(PG8_SA(1, 0), a3, voffA);
            PG8_WAIT_V(8); PG8_WAIT_L(0); PG8_BAR; PG8_MMA(1, 0, At, B0); PG8_MMA(1, 1, At, B1); PG8_BAR; PG8_SCHED;
            } else {
            PG8_LDB(B0, 0, 0); PG8_SCHED; PG8_LDA(At, 0, 0); PG8_STAGE(PG8_SA(1, 1), a1 + hstep, voffA);
            PG8_WAIT_L(8); PG8_BAR; PG8_WAIT_L(0); PG8_MMA(0, 0, At, B0); PG8_BAR; PG8_SCHED;
            PG8_LDB(B1, 0, 1); PG8_STAGE(PG8_SB(0, 0), b2, voffB);
            PG8_BAR; PG8_WAIT_L(0); PG8_MMA(0, 1, At, B1); PG8_BAR;
            PG8_LDA(At, 0, 1); PG8_STAGE(PG8_SA(0, 0), a2, voffA);
            PG8_BAR; PG8_WAIT_L(0); PG8_MMA(1, 0, At, B0); PG8_BAR; PG8_SCHED;
            PG8_STAGE(PG8_SB(0, 1), b2 + hstep, voffB);
            PG8_WAIT_V(6); PG8_BAR; PG8_MMA(1, 1, At, B1); PG8_BAR;
            PG8_LDB(B0, 1, 0); PG8_SCHED; PG8_LDA(At, 1, 0); PG8_STAGE(PG8_SA(0, 1), a2 + hstep, voffA);
            PG8_WAIT_L(8); PG8_BAR; PG8_WAIT_L(0); PG8_MMA(0, 0, At, B0); PG8_BAR; PG8_SCHED;
            PG8_LDB(B1, 1, 1); PG8_STAGE(PG8_SB(1, 0), b3, voffB);
            PG8_BAR; PG8_WAIT_L(0); PG8_MMA(0, 1, At, B1); PG8_BAR;
            PG8_LDA(At, 1, 1); PG8_STAGE(PG8_SA(1, 0), a3, voffA);
            PG8_BAR; PG8_WAIT_L(0); PG8_MMA(1, 0, At, B0); PG8_BAR; PG8_SCHED;
            PG8_STAGE(PG8_SB(1, 1), b3 + hstep, voffB);
            PG8_WAIT_V(6); PG8_BAR; PG8_MMA(1, 1, At, B1); PG8_BAR;
            }
        }
        if constexpr (ALIGN_EPI) { if (wr == 0) PG8_BAR; }
        if constexpr (!Epi::AFTER_DRAIN) { E(acc, cur, wr, wc, fr, fq); S.done(cur); }
        if (!has_next) break;
#pragma unroll
        for (int a = 0; a < 2; ++a)
#pragma unroll
            for (int b = 0; b < 2; ++b)
#pragma unroll
                for (int m = 0; m < 4; ++m)
#pragma unroll
                    for (int n = 0; n < 2; ++n) acc[a][b][m][n] = (f32x4){0.f, 0.f, 0.f, 0.f};
        cur = nxt; cA = nA; cB = nB; ++ui;
        if constexpr (ALIGN_EPI) { if (wr == 1) PG8_BAR; }
    }
    PG8_WAIT_V(0);
    if constexpr (!ALIGN_EPI) { if (wr == 0) PG8_BAR; }
    PG8_BAR;
    if constexpr (Epi::AFTER_DRAIN) { E.fused(acc, cur, wr, wc, fr, fq, lds, wid, lane); S.done(cur); }
#undef PG8_SA
#undef PG8_SB
#undef PG8_STAGE
#undef PG8_LDA
#undef PG8_LDB
#undef PG8_MMA
#undef PG8_WAIT_V
#undef PG8_WAIT_L
#undef PG8_BAR
#undef PG8_SCHED
}
}

constexpr int BATCH = 8, SEQ = 4096, DM = 1024, MTOK = BATCH * SEQ;
constexpr int NMEM = 256, MMEM = BATCH * NMEM;
constexpr int AW = 512, HD = 64, NH = 8, IH = 4, TOPK = 256;
constexpr int INC = 1988, INP = 2048;
constexpr int DFF = 2816;
constexpr float EPS = 1e-6f;
#define LAS __attribute__((address_space(3)))
typedef unsigned short bf16_t;
typedef float f32x4 __attribute__((ext_vector_type(4)));
typedef unsigned u32x4 __attribute__((ext_vector_type(4)));
typedef unsigned u32x2 __attribute__((ext_vector_type(2)));

__device__ __forceinline__ float bf2f(bf16_t v) { return __uint_as_float((unsigned)v << 16); }
__device__ __forceinline__ bf16_t f2bf(float f) { unsigned u = __float_as_uint(f); return (bf16_t)((u + 0x7fffu + ((u >> 16) & 1u)) >> 16); }
__device__ __forceinline__ float shx(float v, int lane, int o) { return __uint_as_float((unsigned)__builtin_amdgcn_ds_bpermute((lane ^ o) << 2, (int)__float_as_uint(v))); }
__device__ __forceinline__ float wave_sum_l(float v, int lane) {
#pragma unroll
    for (int o = 1; o < 64; o <<= 1) v += shx(v, lane, o);
    return v;
}
__device__ __forceinline__ float wave_sum(float v) {
#pragma unroll
    for (int o = 1; o < 64; o <<= 1) v += __shfl_xor(v, o);
    return v;
}
__device__ __forceinline__ float wave_max(float v) {
#pragma unroll
    for (int o = 1; o < 64; o <<= 1) v = fmaxf(v, __shfl_xor(v, o));
    return v;
}
__device__ __forceinline__ float silu_f(float v) { return v / (1.f + __expf(-v)); }

struct EpiStore {
    static constexpr bool PERM = false, AFTER_DRAIN = false;
    float* outf; bf16_t* outb; const float* res; int ldc;
    __device__ __forceinline__ void operator()(const pg8::f32x4 (&acc)[2][2][4][2], const pg8::Unit& u, int wr, int wc, int fr, int fq) const {
        const int col0 = u.pn * 256 + wc * 32 + 4 * fq;
#pragma unroll
        for (int ai = 0; ai < 2; ++ai)
#pragma unroll
            for (int m = 0; m < 4; ++m) {
                const size_t row = (size_t)(u.pm * 256 + ai * 128 + wr * 64 + m * 16 + fr);
#pragma unroll
                for (int bj = 0; bj < 2; ++bj)
#pragma unroll
                    for (int n = 0; n < 2; ++n) {
                        const size_t off = row * ldc + col0 + bj * 128 + n * 16;
                        pg8::f32x4 v = acc[ai][bj][m][n];
                        if (res) { const pg8::f32x4 r = *(const pg8::f32x4*)(res + off); v = v + r; }
                        if (outf) *(pg8::f32x4*)(outf + off) = v;
                        if (outb) { u32x2 w; w.x = (unsigned)f2bf(v[0]) | ((unsigned)f2bf(v[1]) << 16); w.y = (unsigned)f2bf(v[2]) | ((unsigned)f2bf(v[3]) << 16); *(u32x2*)(outb + off) = w; }
                    }
            }
    }
};
#define XB_TMO      128
#define XB_XCNT(j)  (256  + 64 * (j))
#define XB_XSUB(j)  (1280 + 64 * (j))
#define XB_XGEN(j)  (2304 + 64 * (j))
#define XB_TOP      3328
#define XB_TOPGEN   3392
#define XCD_BAR_WORDS 3456
#define XB_SPIN_CAP (1u << 18)

__device__ __forceinline__ unsigned xb_ld(unsigned* p)              { return __hip_atomic_load(p, __ATOMIC_RELAXED, __HIP_MEMORY_SCOPE_AGENT); }
__device__ __forceinline__ unsigned xb_add(unsigned* p, unsigned v) { return __hip_atomic_fetch_add(p, v, __ATOMIC_RELAXED, __HIP_MEMORY_SCOPE_AGENT); }
__device__ __forceinline__ unsigned xb_xcc_id() { return (unsigned)__builtin_amdgcn_s_getreg((3 << 11) | 20) & 0xFu; }
#define XB_SPIN(cond, bar) do { unsigned _sp = 0; while (cond) { __builtin_amdgcn_s_sleep(1); \
    if ((++_sp & 255u) == 0u) { if (xb_ld(&(bar)[XB_TMO])) break; if (_sp > XB_SPIN_CAP) { atomicAdd(&(bar)[XB_TMO], 1u); break; } } } } while (0)

struct XcdBarrier {
    unsigned* bar; unsigned x;
    volatile LAS unsigned* st;
};

__device__ __forceinline__ XcdBarrier xcd_barrier_post(unsigned* bar, volatile LAS unsigned* st) {
    XcdBarrier b; b.bar = bar; b.x = xb_xcc_id(); b.st = st;
    if (threadIdx.x == 0) (void)xb_add(&bar[XB_XCNT(b.x)], 1u);
    return b;
}
__device__ __forceinline__ void xcd_barrier_complete(unsigned* bar, unsigned x, unsigned& nloc, unsigned& nx) {
    const unsigned G = gridDim.x * gridDim.y * gridDim.z;
    unsigned sum, cnt, mine, sp = 0u;
    for (;;) {
        sum = 0u; cnt = 0u; mine = 0u;
#pragma unroll
        for (unsigned j = 0; j < 16; ++j) { const unsigned c = xb_ld(&bar[XB_XCNT(j)]); sum += c; cnt += (c > 0u) ? 1u : 0u; mine = (j == x) ? c : mine; }
        if (sum == G) break;
        __builtin_amdgcn_s_sleep(1);
        if ((++sp & 255u) == 0u) { if (xb_ld(&bar[XB_TMO])) break; if (sp > XB_SPIN_CAP) { atomicAdd(&bar[XB_TMO], 1u); break; } }
    }
    nloc = mine > 0u ? mine : 1u; nx = cnt > 0u ? cnt : 1u;
}

__device__ __forceinline__ void xcd_barrier(const XcdBarrier& b) {
    asm volatile("s_waitcnt vmcnt(0)" ::: "memory");
    __syncthreads();
    if (threadIdx.x == 0) {
        unsigned* bar = b.bar;
        __builtin_amdgcn_s_waitcnt(0);
        unsigned nloc = b.st[0], nx = b.st[1];
        if (nloc == 0u) { xcd_barrier_complete(bar, b.x, nloc, nx); b.st[0] = nloc; b.st[1] = nx; }
        const unsigned old = xb_add(&bar[XB_XSUB(b.x)], 1u);
        const unsigned gen = old / nloc;
        if (old + 1u == (gen + 1u) * nloc) {
            __builtin_amdgcn_fence(__ATOMIC_RELEASE, "agent");
            asm volatile("s_waitcnt vmcnt(0)" ::: "memory");
            const unsigned og = xb_add(&bar[XB_TOP], 1u);
            const unsigned tg = og / nx;
            if (og + 1u == (tg + 1u) * nx) xb_add(&bar[XB_TOPGEN], 1u);
            else XB_SPIN(xb_ld(&bar[XB_TOPGEN]) == tg, bar);
            __builtin_amdgcn_fence(__ATOMIC_ACQUIRE, "agent");
            xb_add(&bar[XB_XGEN(b.x)], 1u);
            asm volatile("s_waitcnt vmcnt(0)" ::: "memory");
        } else {
            XB_SPIN(xb_ld(&bar[XB_XGEN(b.x)]) == gen, bar);
            __builtin_amdgcn_fence(__ATOMIC_ACQUIRE, "agent");
            asm volatile("s_waitcnt vmcnt(0)" ::: "memory");
        }
    }
    __syncthreads();
}

__device__ __forceinline__ u32x4 pack8(const pg8::f32x4 a, const pg8::f32x4 b) {
    u32x4 w; w.x = pg8::cvt_pk_bf16(a[0], a[1]); w.y = pg8::cvt_pk_bf16(a[2], a[3]); w.z = pg8::cvt_pk_bf16(b[0], b[1]); w.w = pg8::cvt_pk_bf16(b[2], b[3]); return w;
}
__device__ __forceinline__ float sigmoid_f(float v) { return 1.f / (1.f + __expf(-v)); }
__host__ __device__ __forceinline__ int dperm(int pos) { return pos < 16 ? (4 * (pos >> 3) + (pos & 3) + 8 * ((pos >> 2) & 1)) : pos; }
__host__ __device__ __forceinline__ int in_orig_col(int n) {
    if (n < 512) return (n & ~63) + dperm(n & 63);
    if (n < 576) return 512 + dperm(n - 512);
    if (n < 640) return 576 + (n - 576);
    if (n < 704) return 896 + dperm(n - 640);
    if (n < 708) return 960 + (n - 704);
    if (n < 768) return -1;
    if (n < 1024) return 640 + ((n - 768) & ~63) + dperm((n - 768) & 63);
    const int i = (n - 1024) >> 8, c = (n - 1024) & 255;
    return c < 128 ? 964 + 128 * i + c : 1476 + 128 * i + (c - 128);
}
struct EpiIn {
    static constexpr bool PERM = true, AFTER_DRAIN = false;
    const float* cs; bf16_t *Q, *K, *V, *QI, *KI, *U; float* WI;
    __device__ __forceinline__ void operator()(const pg8::f32x4 (&acc)[2][2][4][2], const pg8::Unit& u, int wr, int wc, int fr, int fq) const {
        const int pn = u.pn;
        if (pn >= 4) {
            const int ch = 128 * (pn - 4) + 32 * wc + 8 * fq;
#pragma unroll
            for (int ai = 0; ai < 2; ++ai)
#pragma unroll
                for (int m = 0; m < 4; ++m) { const size_t row = (size_t)(u.pm * 256 + ai * 128 + wr * 64 + m * 16 + fr);
                    pg8::f32x4 a0 = acc[ai][0][m][0], a1 = acc[ai][0][m][1]; const pg8::f32x4 g0 = acc[ai][1][m][0], g1 = acc[ai][1][m][1];
#pragma unroll
                    for (int k = 0; k < 4; ++k) { a0[k] *= sigmoid_f(g0[k]); a1[k] *= sigmoid_f(g1[k]); }
                    *(u32x4*)(U + row * 512 + ch) = pack8(a0, a1); }
            return;
        }
        const bool rot = (pn == 2) ? (wc == 0 && fq < 2) : ((wc & 1) == 0 && fq < 2);
#pragma unroll
        for (int ai = 0; ai < 2; ++ai)
#pragma unroll
            for (int m = 0; m < 4; ++m) { const size_t row = (size_t)(u.pm * 256 + ai * 128 + wr * 64 + m * 16 + fr);
                pg8::f32x4 cv = {1.f, 1.f, 1.f, 1.f}, sv = {0.f, 0.f, 0.f, 0.f};
                if (rot) { cv = *(const pg8::f32x4*)(cs + row * 16 + 4 * fq); sv = *(const pg8::f32x4*)(cs + row * 16 + 8 + 4 * fq); }
#pragma unroll
                for (int bj = 0; bj < 2; ++bj) {
                    const pg8::f32x4 v0 = acc[ai][bj][m][0], v1 = acc[ai][bj][m][1];
                    pg8::f32x4 n0 = v0 * cv - v1 * sv, n1 = v1 * cv + v0 * sv;
                    if (!rot) { n0 = v0; n1 = v1; }
                    const int c = 128 * bj + 32 * wc + 8 * fq;
                    if (pn < 2) *(u32x4*)(Q + row * 512 + 256 * pn + c) = pack8(n0, n1);
                    else if (pn == 3) *(u32x4*)(QI + row * 256 + c) = pack8(n0 * 0.125f, n1 * 0.125f);
                    else {
                        if (bj == 0) { if (wc < 2) *(u32x4*)(K + row * 64 + 32 * wc + 8 * fq) = pack8(n0, n1); else *(u32x4*)(V + row * 64 + 32 * (wc - 2) + 8 * fq) = pack8(v0, v1); }
                        else { if (wc < 2) *(u32x4*)(KI + row * 64 + 32 * wc + 8 * fq) = pack8(n0, n1); else if (wc == 2 && fq == 0) *(pg8::f32x4*)(WI + row * 4) = v0 * 0.5f; }
                    }
                }
            }
    }
};
struct EpiRes {
    static constexpr bool PERM = true, AFTER_DRAIN = false;
    const float* res; float* out; bf16_t* xb; float* ss;
    __device__ __forceinline__ void operator()(const pg8::f32x4 (&acc)[2][2][4][2], const pg8::Unit& u, int wr, int wc, int fr, int fq) const {
#pragma unroll
        for (int ai = 0; ai < 2; ++ai)
#pragma unroll
            for (int m = 0; m < 4; ++m) { const size_t row = (size_t)(u.pm * 256 + ai * 128 + wr * 64 + m * 16 + fr); float q = 0.f;
#pragma unroll
                for (int bj = 0; bj < 2; ++bj) { const size_t off = row * DM + u.pn * 256 + 128 * bj + 32 * wc + 8 * fq;
                    const pg8::f32x4 v0 = acc[ai][bj][m][0] + *(const pg8::f32x4*)(res + off), v1 = acc[ai][bj][m][1] + *(const pg8::f32x4*)(res + off + 4);
                    *(pg8::f32x4*)(out + off) = v0; *(pg8::f32x4*)(out + off + 4) = v1;
                    if (xb) *(u32x4*)(xb + off) = pack8(v0, v1);
                    q += (v0[0] * v0[0] + v0[1] * v0[1]) + (v0[2] * v0[2] + v0[3] * v0[3]) + (v1[0] * v1[0] + v1[1] * v1[1]) + (v1[2] * v1[2] + v1[3] * v1[3]); }
                { const int lane_ = fq * 16 + fr; q += shx(q, lane_, 16); q += shx(q, lane_, 32); }
                if (fq == 0) ss[row * 16 + u.pn * 4 + wc] = q; }
    }
};
__device__ __forceinline__ float rstd_from_ss(const float* ss, size_t row) {
    const pg8::f32x4 a = *(const pg8::f32x4*)(ss + row * 16), b = *(const pg8::f32x4*)(ss + row * 16 + 4), c = *(const pg8::f32x4*)(ss + row * 16 + 8), d = *(const pg8::f32x4*)(ss + row * 16 + 12);
    const float s = ((a[0] + a[1]) + (a[2] + a[3])) + ((b[0] + b[1]) + (b[2] + b[3])) + ((c[0] + c[1]) + (c[2] + c[3])) + ((d[0] + d[1]) + (d[2] + d[3]));
    return 1.f / sqrtf(s * (1.f / DM) + EPS);
}
struct EpiScale {
    static constexpr bool PERM = true, AFTER_DRAIN = false;
    const float* ss; bf16_t* O; int ldc; float scale;
    __device__ __forceinline__ void operator()(const pg8::f32x4 (&acc)[2][2][4][2], const pg8::Unit& u, int wr, int wc, int fr, int fq) const {
#pragma unroll
        for (int ai = 0; ai < 2; ++ai)
#pragma unroll
            for (int m = 0; m < 4; ++m) { const size_t row = (size_t)(u.pm * 256 + ai * 128 + wr * 64 + m * 16 + fr); const float r = rstd_from_ss(ss, row) * scale;
#pragma unroll
                for (int bj = 0; bj < 2; ++bj) *(u32x4*)(O + row * ldc + u.pn * 256 + 128 * bj + 32 * wc + 8 * fq) = pack8(acc[ai][bj][m][0] * r, acc[ai][bj][m][1] * r); }
    }
};
struct EpiGateUp {
    static constexpr bool PERM = true, AFTER_DRAIN = false;
    const float* ss; bf16_t* Gb; bf16_t* Ub;
    __device__ __forceinline__ void operator()(const pg8::f32x4 (&acc)[2][2][4][2], const pg8::Unit& u, int wr, int wc, int fr, int fq) const {
        const int ch = 128 * u.pn + 32 * wc + 8 * fq;
#pragma unroll
        for (int ai = 0; ai < 2; ++ai)
#pragma unroll
            for (int m = 0; m < 4; ++m) { const size_t row = (size_t)(u.pm * 256 + ai * 128 + wr * 64 + m * 16 + fr); const float r = rstd_from_ss(ss, row);
                *(u32x4*)(Gb + row * DFF + ch) = pack8(acc[ai][0][m][0] * r, acc[ai][0][m][1] * r);
                *(u32x4*)(Ub + row * DFF + ch) = pack8(acc[ai][1][m][0] * r, acc[ai][1][m][1] * r); }
    }
};
struct EpiGateUpAct {
    static constexpr bool PERM = true, AFTER_DRAIN = false;
    const float* ss; bf16_t* H; const float* cw; const float* cb; float* topg; float* topu; float* botg; LAS unsigned char* xch;
    __device__ __forceinline__ void operator()(const pg8::f32x4 (&acc)[2][2][4][2], const pg8::Unit& u, int wr, int wc, int fr, int fq) const {
        const int lane = fq * 16 + fr, chl = 32 * wc + 8 * fq, ch = 128 * u.pn + chl;
        const int l1 = (fq * 16 + ((fr + 15) & 15)) << 2, l2 = (fq * 16 + ((fr + 14) & 15)) << 2;
        (void)lane;
#pragma unroll
        for (int ai = 0; ai < 2; ++ai) { const size_t row = (size_t)(u.pm * 256 + ai * 128 + wr * 64 + 48 + fr); const float r = rstd_from_ss(ss, row);
            if (fr >= 14) { LAS float* p = (LAS float*)xch + ((2 * ai + wr) * 2 + (fr - 14)) * 128 + chl;
                *(LAS pg8::f32x4*)p = acc[ai][0][3][0] * r; *(LAS pg8::f32x4*)(p + 4) = acc[ai][0][3][1] * r; } }
        asm volatile("s_waitcnt lgkmcnt(0)" ::: "memory"); __builtin_amdgcn_s_barrier(); asm volatile("" ::: "memory");
        pg8::f32x4 wb[2], w2[2], w1[2], w0[2];
#pragma unroll
        for (int hq = 0; hq < 2; ++hq) { wb[hq] = *(const pg8::f32x4*)(cb + ch + 4 * hq); w2[hq] = *(const pg8::f32x4*)(cw + 2 * DFF + ch + 4 * hq); w1[hq] = *(const pg8::f32x4*)(cw + DFF + ch + 4 * hq); w0[hq] = *(const pg8::f32x4*)(cw + ch + 4 * hq); }
#pragma unroll
        for (int ai = 0; ai < 2; ++ai) {
            const int blk = 2 * ai + wr;
            pg8::f32x4 pv[2] = {{0.f, 0.f, 0.f, 0.f}, {0.f, 0.f, 0.f, 0.f}};
            if (blk > 0 && fr >= 14) { const LAS float* p = (const LAS float*)xch + ((blk - 1) * 2 + (fr - 14)) * 128 + chl; pv[0] = *(const LAS pg8::f32x4*)p; pv[1] = *(const LAS pg8::f32x4*)(p + 4); }
#pragma unroll
            for (int m = 0; m < 4; ++m) { const size_t row = (size_t)(u.pm * 256 + ai * 128 + wr * 64 + m * 16 + fr); const float r = rstd_from_ss(ss, row);
                pg8::f32x4 g[2], uu[2], hh[2];
#pragma unroll
                for (int hq = 0; hq < 2; ++hq) { g[hq] = acc[ai][0][m][hq] * r; uu[hq] = acc[ai][1][m][hq] * r; }
#pragma unroll
                for (int hq = 0; hq < 2; ++hq)
#pragma unroll
                    for (int k = 0; k < 4; ++k) {
                        const float x1 = (fr == 15) ? pv[hq][k] : g[hq][k], x2 = (fr >= 14) ? pv[hq][k] : g[hq][k];
                        const float p1 = __uint_as_float((unsigned)__builtin_amdgcn_ds_bpermute(l1, (int)__float_as_uint(x1)));
                        const float p2 = __uint_as_float((unsigned)__builtin_amdgcn_ds_bpermute(l2, (int)__float_as_uint(x2)));
                        const float gg = wb[hq][k] + w2[hq][k] * g[hq][k] + w1[hq][k] * p1 + w0[hq][k] * p2;
                        hh[hq][k] = gg / (1.f + __expf(-gg)) * uu[hq][k]; }
                *(u32x4*)(H + row * DFF + ch) = pack8(hh[0], hh[1]);
                if (blk == 0 && m == 0 && fr < 2) { float* tg = topg + ((size_t)u.pm * 2 + fr) * DFF + ch; float* tu = topu + ((size_t)u.pm * 2 + fr) * DFF + ch;
                    *(pg8::f32x4*)tg = g[0]; *(pg8::f32x4*)(tg + 4) = g[1]; *(pg8::f32x4*)tu = uu[0]; *(pg8::f32x4*)(tu + 4) = uu[1]; }
                if (blk == 3 && m == 3 && fr >= 14) { float* bg = botg + ((size_t)u.pm * 2 + (fr - 14)) * DFF + ch; *(pg8::f32x4*)bg = g[0]; *(pg8::f32x4*)(bg + 4) = g[1]; }
                pv[0] = g[0]; pv[1] = g[1];
            }
        }
    }
};
typedef short bf16x8v __attribute__((ext_vector_type(8)));
constexpr int CA_STRIDE = 528;
__device__ __forceinline__ void cross_attn_unit(LAS unsigned char* lds, int b, int h, int qb, const bf16_t* QC, const bf16_t* KC, const bf16_t* VT, bf16_t* OC, int tid, int lane, int wave) {
    const int q16 = lane & 15, g = lane >> 4;
    const size_t row0 = (size_t)b * SEQ + (size_t)qb * 256 + wave * 32;
    asm volatile("" : "+v"(tid));
    { const bf16_t* src = KC + ((size_t)b * NMEM + (tid >> 5)) * DM + h * 256 + (tid & 31) * 8; LAS unsigned char* dst = lds + (tid >> 5) * CA_STRIDE + (tid & 31) * 16;
#pragma unroll
      for (int i = 0; i < 16; ++i) { const u32x4 v = *(const u32x4*)(src + (size_t)i * 16 * DM); *(LAS u32x4*)(dst + i * 16 * CA_STRIDE) = v; } }
    __syncthreads();
    f32x4 S[2][16];
#pragma unroll
    for (int st = 0; st < 2; ++st)
#pragma unroll
        for (int kt = 0; kt < 16; ++kt) S[st][kt] = (f32x4){0.f, 0.f, 0.f, 0.f};
#pragma unroll 1
    for (int kh = 0; kh < 2; ++kh) {
        bf16x8v qf[2][4];
#pragma unroll
        for (int st = 0; st < 2; ++st)
#pragma unroll
            for (int ks = 0; ks < 4; ++ks) qf[st][ks] = *(const bf16x8v*)(QC + (row0 + st * 16 + q16) * DM + h * 256 + kh * 128 + ks * 32 + g * 8);
        const LAS unsigned char* kb = lds + q16 * CA_STRIDE + kh * 256 + g * 16;
#pragma unroll
        for (int kt = 0; kt < 16; ++kt)
#pragma unroll
            for (int ks = 0; ks < 4; ++ks) { const bf16x8v a = *(const LAS bf16x8v*)(kb + kt * 16 * CA_STRIDE + ks * 64);
                S[0][kt] = __builtin_amdgcn_mfma_f32_16x16x32_bf16(a, qf[0][ks], S[0][kt], 0, 0, 0);
                S[1][kt] = __builtin_amdgcn_mfma_f32_16x16x32_bf16(a, qf[1][ks], S[1][kt], 0, 0, 0); }
    }
    const float c2 = 0.0625f * 1.4426950408889634f;
    float linv[2]; bf16x8v P[2][8];
#pragma unroll
    for (int st = 0; st < 2; ++st) {
        float m = -INFINITY;
#pragma unroll
        for (int kt = 0; kt < 16; ++kt) m = fmaxf(fmaxf(fmaxf(S[st][kt][0], S[st][kt][1]), fmaxf(S[st][kt][2], S[st][kt][3])), m);
        m = fmaxf(m, shx(m, lane, 16)); m = fmaxf(m, shx(m, lane, 32));
        const float mc = m * c2; float l = 0.f;
#pragma unroll
        for (int kt = 0; kt < 16; ++kt)
#pragma unroll
            for (int r = 0; r < 4; ++r) { const float p = __builtin_amdgcn_exp2f(S[st][kt][r] * c2 - mc); S[st][kt][r] = p; l += p; }
        l += shx(l, lane, 16); l += shx(l, lane, 32); linv[st] = 1.f / l;
#pragma unroll
        for (int c = 0; c < 8; ++c) { bf16x8v pk;
#pragma unroll
            for (int j = 0; j < 4; ++j) { pk[j] = (short)f2bf(S[st][2 * c][j]); pk[4 + j] = (short)f2bf(S[st][2 * c + 1][j]); }
            P[st][c] = pk; }
    }
    __syncthreads();
    { int tid2 = tid; asm volatile("" : "+v"(tid2));
      const bf16_t* src = VT + (size_t)(h * 256 + (tid2 >> 5)) * MMEM + b * NMEM + (tid2 & 31) * 8; LAS unsigned char* dst = lds + (tid2 >> 5) * CA_STRIDE + (tid2 & 31) * 16;
#pragma unroll
      for (int i = 0; i < 16; ++i) { const u32x4 v = *(const u32x4*)(src + (size_t)i * 16 * MMEM); *(LAS u32x4*)(dst + i * 16 * CA_STRIDE) = v; } }
    __syncthreads();
#pragma unroll 1
    for (int dh = 0; dh < 2; ++dh) {
        f32x4 O[2][8];
#pragma unroll
        for (int st = 0; st < 2; ++st)
#pragma unroll
            for (int dt = 0; dt < 8; ++dt) O[st][dt] = (f32x4){0.f, 0.f, 0.f, 0.f};
        const LAS unsigned char* pb = lds + (dh * 128 + q16) * CA_STRIDE + g * 8;
#pragma unroll
        for (int dt = 0; dt < 8; ++dt)
#pragma unroll
            for (int c = 0; c < 8; ++c) { const LAS unsigned char* p = pb + dt * 16 * CA_STRIDE + c * 64;
                const u32x2 lo = *(const LAS u32x2*)p, hi = *(const LAS u32x2*)(p + 32);
                const u32x4 av = (u32x4){lo.x, lo.y, hi.x, hi.y}; const bf16x8v a = __builtin_bit_cast(bf16x8v, av);
                O[0][dt] = __builtin_amdgcn_mfma_f32_16x16x32_bf16(a, P[0][c], O[0][dt], 0, 0, 0);
                O[1][dt] = __builtin_amdgcn_mfma_f32_16x16x32_bf16(a, P[1][c], O[1][dt], 0, 0, 0); }
#pragma unroll
        for (int st = 0; st < 2; ++st)
#pragma unroll
            for (int dt = 0; dt < 8; ++dt) { const f32x4 o = O[st][dt] * linv[st]; u32x2 w;
                w.x = (unsigned)f2bf(o[0]) | ((unsigned)f2bf(o[1]) << 16); w.y = (unsigned)f2bf(o[2]) | ((unsigned)f2bf(o[3]) << 16);
                *(u32x2*)(OC + (row0 + st * 16 + q16) * DM + h * 256 + dh * 128 + dt * 16 + g * 4) = w; }
    }
    __syncthreads();
}
typedef float f32x16v __attribute__((ext_vector_type(16)));
__device__ __forceinline__ unsigned code16(float s) {
    const _Float16 hf = (_Float16)s; unsigned u = (unsigned)__builtin_bit_cast(unsigned short, hf);
    if ((u & 0x7fffu) == 0u) u = 0u;
    return (u & 0x8000u) ? (~u & 0xffffu) : (u | 0x8000u);
}
__device__ __forceinline__ unsigned mbcnt64(unsigned long long m) { return __builtin_amdgcn_mbcnt_hi((unsigned)(m >> 32), __builtin_amdgcn_mbcnt_lo((unsigned)m, 0u)); }
__device__ __forceinline__ void topk_unit(LAS unsigned char* lds, int b, int j, const bf16_t* QI, const bf16_t* KI, const float* WI, unsigned short* SEL, int tid, int lane, int wave) {
    asm volatile("" : "+v"(tid), "+v"(lane));
    const int t0 = 16 * j, L = t0 + 16, nkt = (L + 31) >> 5;
    const size_t rowbase = (size_t)b * SEQ + t0;
    const int c32 = lane & 31, hi = lane >> 5;
    {
        bf16x8v qa[2][4]; f32x4 wq[2][4];
#pragma unroll
        for (int rt = 0; rt < 2; ++rt) {
#pragma unroll
            for (int ks = 0; ks < 4; ++ks) qa[rt][ks] = *(const bf16x8v*)(QI + (rowbase + 8 * rt + (c32 >> 2)) * 256 + (c32 & 3) * 64 + 16 * ks + 8 * hi);
#pragma unroll
            for (int gq = 0; gq < 4; ++gq) wq[rt][gq] = *(const f32x4*)(WI + (rowbase + 8 * rt + 2 * gq + hi) * 4);
        }
        const bf16_t* kbase = KI + ((size_t)b * SEQ + c32) * 64 + 8 * hi;
        bf16x8v kb[4], kn[4];
        int kt = wave;
        if (kt < nkt) {
#pragma unroll
            for (int ks = 0; ks < 4; ++ks) kb[ks] = *(const bf16x8v*)(kbase + (size_t)kt * 32 * 64 + 16 * ks);
        }
        for (; kt < nkt; kt += 8) {
            const int ktn = (kt + 8 < nkt) ? kt + 8 : kt;
#pragma unroll
            for (int ks = 0; ks < 4; ++ks) kn[ks] = *(const bf16x8v*)(kbase + (size_t)ktn * 32 * 64 + 16 * ks);
#pragma unroll
            for (int rt = 0; rt < 2; ++rt) {
                f32x16v c = {0.f, 0.f, 0.f, 0.f, 0.f, 0.f, 0.f, 0.f, 0.f, 0.f, 0.f, 0.f, 0.f, 0.f, 0.f, 0.f};
#pragma unroll
                for (int ks = 0; ks < 4; ++ks) c = __builtin_amdgcn_mfma_f32_32x32x16_bf16(qa[rt][ks], kb[ks], c, 0, 0, 0);
#pragma unroll
                for (int gq = 0; gq < 4; ++gq) {
                    const f32x4 w = wq[rt][gq];
                    const float sc = w[0] * fmaxf(c[4 * gq + 0], 0.f) + w[1] * fmaxf(c[4 * gq + 1], 0.f) + w[2] * fmaxf(c[4 * gq + 2], 0.f) + w[3] * fmaxf(c[4 * gq + 3], 0.f);
                    const int q = 8 * rt + 2 * gq + hi;
                    *(LAS unsigned short*)(lds + q * 8192 + (kt * 32 + c32) * 2) = (unsigned short)code16(sc);
                }
            }
#pragma unroll
            for (int ks = 0; ks < 4; ++ks) kb[ks] = kn[ks];
        }
    }
    __syncthreads();
#pragma unroll 1
    for (int qq = 0; qq < 2; ++qq) {
        const int q = 2 * wave + qq, t = t0 + q, n = t + 1;
        unsigned short* sel = SEL + (rowbase + q) * TOPK;
        if (n <= TOPK) {
#pragma unroll
            for (int i = 0; i < 4; ++i) { const int s = lane + 64 * i; if (s < n) sel[s] = (unsigned short)s; }
            continue;
        }
        const int nch = (n + 127) >> 7;
        unsigned lo[32], hi16[32];
        const LAS unsigned* row = (const LAS unsigned*)(lds + q * 8192) + lane;
#pragma unroll
        for (int c = 0; c < 32; ++c) {
            unsigned v = 0u; if (c < nch) v = row[64 * c];
            const int i0 = 128 * c + 2 * lane;
            lo[c] = (i0 <= t) ? (v & 0xffffu) : 0u; hi16[c] = (i0 + 1 <= t) ? (v >> 16) : 0u;
        }
#define TK_CMP8(OP, X0, X1, X2, X3, X4, X5, X6, X7, CAND, ACC) do { unsigned long long m0_, m1_, m2_, m3_, m4_, m5_, m6_, m7_; \
            asm volatile(OP " %0, %8, %16\n\t" OP " %1, %9, %16\n\t" OP " %2, %10, %16\n\t" OP " %3, %11, %16\n\t" OP " %4, %12, %16\n\t" OP " %5, %13, %16\n\t" OP " %6, %14, %16\n\t" OP " %7, %15, %16" \
                : "=&s"(m0_), "=&s"(m1_), "=&s"(m2_), "=&s"(m3_), "=&s"(m4_), "=&s"(m5_), "=&s"(m6_), "=&s"(m7_) \
                : "v"(X0), "v"(X1), "v"(X2), "v"(X3), "v"(X4), "v"(X5), "v"(X6), "v"(X7), "s"(CAND)); \
            ACC += (unsigned)(__builtin_popcountll(m0_) + __builtin_popcountll(m1_)) + (unsigned)(__builtin_popcountll(m2_) + __builtin_popcountll(m3_)) \
                 + (unsigned)(__builtin_popcountll(m4_) + __builtin_popcountll(m5_)) + (unsigned)(__builtin_popcountll(m6_) + __builtin_popcountll(m7_)); } while (0)
#define TK_GRP(OP, G8, CAND, ACC) do { TK_CMP8(OP, lo[G8], hi16[G8], lo[G8 + 1], hi16[G8 + 1], lo[G8 + 2], hi16[G8 + 2], lo[G8 + 3], hi16[G8 + 3], CAND, ACC); \
            TK_CMP8(OP, lo[G8 + 4], hi16[G8 + 4], lo[G8 + 5], hi16[G8 + 5], lo[G8 + 6], hi16[G8 + 6], lo[G8 + 7], hi16[G8 + 7], CAND, ACC); } while (0)
#define TK_COUNT(OP, CAND, RES) do { unsigned tot_ = 0u; const unsigned cs_ = (unsigned)__builtin_amdgcn_readfirstlane((int)(CAND)); \
            TK_GRP(OP, 0, cs_, tot_); if (nch > 8) TK_GRP(OP, 8, cs_, tot_); if (nch > 16) TK_GRP(OP, 16, cs_, tot_); if (nch > 24) TK_GRP(OP, 24, cs_, tot_); RES = tot_; } while (0)
        unsigned T = 0u;
#pragma unroll 1
        for (int bit = 15; bit >= 0; --bit) {
            const unsigned cand = T | (1u << bit); unsigned cnt;
            TK_COUNT("v_cmp_ge_u32_e64", cand, cnt);
            if (cnt >= (unsigned)TOPK) T = cand;
        }
        unsigned cgt;
        TK_COUNT("v_cmp_gt_u32_e64", T, cgt);
#undef TK_COUNT
#undef TK_GRP
#undef TK_CMP8
        const unsigned need = (unsigned)TOPK - cgt;
        unsigned eqrun = 0u, selrun = 0u;
#pragma unroll
        for (int c = 0; c < 32; ++c) if (c < nch) {
            const bool elo = lo[c] == T, ehi = hi16[c] == T;
            const unsigned long long melo = __ballot(elo), mehi = __ballot(ehi);
            const unsigned rank_lo = eqrun + mbcnt64(melo) + mbcnt64(mehi), rank_hi = rank_lo + (elo ? 1u : 0u);
            const bool tlo = (lo[c] > T) || (elo && rank_lo < need), thi = (hi16[c] > T) || (ehi && rank_hi < need);
            const unsigned long long mtlo = __ballot(tlo), mthi = __ballot(thi);
            const unsigned pos_lo = selrun + mbcnt64(mtlo) + mbcnt64(mthi), pos_hi = pos_lo + (tlo ? 1u : 0u);
            if (tlo && pos_lo < (unsigned)TOPK) sel[pos_lo] = (unsigned short)(128 * c + 2 * lane);
            if (thi && pos_hi < (unsigned)TOPK) sel[pos_hi] = (unsigned short)(128 * c + 2 * lane + 1);
            eqrun += (unsigned)__popcll(melo) + (unsigned)__popcll(mehi); selrun += (unsigned)__popcll(mtlo) + (unsigned)__popcll(mthi);
        }
    }
    __syncthreads();
}
__device__ __forceinline__ void topk_phase(LAS unsigned char* lds, int G, int vcu, const bf16_t* QI, const bf16_t* KI, const float* WI, unsigned short* SEL, int tid, int lane, int wave) {
    if (G == 256) {
        const int b = vcu >> 5, i = vcu & 31;
#pragma unroll 1
        for (int k = 0; k < 8; ++k) { const int j = 64 * (k >> 1) + ((k & 1) ? 63 - i : i); topk_unit(lds, b, j, QI, KI, WI, SEL, tid, lane, wave); }
    } else {
#pragma unroll 1
        for (int u = vcu; u < BATCH * 256; u += G) topk_unit(lds, u >> 8, u & 255, QI, KI, WI, SEL, tid, lane, wave);
    }
}
typedef short v4i16_t __attribute__((ext_vector_type(4)));
constexpr int SV_STRIDE = 160, SV_TILE_BYTES = 64 * SV_STRIDE, SV_WAVE_BYTES = SV_TILE_BYTES + 1024;
__device__ __forceinline__ v4i16_t tr_read16(const LAS unsigned char* p) { return __builtin_amdgcn_ds_read_tr16_b64_v4i16((LAS v4i16_t*)p); }
#define SP_FENCE() asm volatile("" ::: "memory")
__device__ __forceinline__ void sparse_attn_phase(LAS unsigned char* lds, int G, int vcu, const bf16_t* Q, const bf16_t* Kb, const bf16_t* Vb, const unsigned short* SEL, bf16_t* MIX, int lane, int wave) {
    asm volatile("" : "+v"(lane));
    LAS unsigned char* wl = lds + wave * SV_WAVE_BYTES;
    const int q16 = lane & 15, g = lane >> 4;
    const int nq = (G == 256) ? 16 : (MTOK - (vcu * 8 + wave) + G * 8 - 1) / (G * 8);
    const int r_first = (G == 256) ? (vcu >> 5) * SEQ + (vcu & 31) * 8 + wave : vcu * 8 + wave, r_step = (G == 256) ? 256 : G * 8;
    u32x2 selv = (u32x2){0u, 0u};
    if (nq > 0) selv = *(const u32x2*)(SEL + (size_t)r_first * TOPK + 4 * lane);
    LAS unsigned char* wdst = wl + (lane >> 3) * SV_STRIDE + (lane & 7) * 16;
    const LAS unsigned char* rsrc = wl + (4 * g + (q16 >> 2)) * SV_STRIDE + (q16 & 3) * 8;
    const float c2 = 0.125f * 1.4426950408889634f;
#pragma unroll 1
    for (int k = 0; k < nq; ++k) {
        const size_t row = (size_t)r_first + (size_t)k * r_step; const int b = (int)(row / SEQ), t = (int)(row % SEQ);
        const int n = (t + 1 < TOPK) ? t + 1 : TOPK;
        LAS unsigned char* ib = wl + SV_TILE_BYTES + (k & 1) * 512;
        *(LAS u32x2*)(ib + lane * 8) = selv;
        if (k + 1 < nq) selv = *(const u32x2*)(SEL + (row + r_step) * TOPK + 4 * lane);
        bf16x8v qf[2];
#pragma unroll
        for (int ks = 0; ks < 2; ++ks) { u32x4 v = (u32x4){0u, 0u, 0u, 0u}; if (q16 < 8) v = *(const u32x4*)(Q + row * 512 + q16 * 64 + ks * 32 + g * 8); qf[ks] = __builtin_bit_cast(bf16x8v, v); }
        f32x4 S[16];
        const bf16_t* kbat = Kb + (size_t)b * SEQ * 64 + g * 8;
        const bf16_t* vbat = Vb + (size_t)b * SEQ * 64 + (lane & 7) * 8;
#pragma unroll
        for (int kh = 0; kh < 2; ++kh) {
            bf16x8v kf[8][2];
#pragma unroll
            for (int i = 0; i < 8; ++i) { const int slot = 128 * kh + 16 * i + q16; unsigned idx = *(const LAS unsigned short*)(ib + slot * 2); if (slot >= n) idx = 0u;
#pragma unroll
                for (int ks = 0; ks < 2; ++ks) kf[i][ks] = *(const bf16x8v*)(kbat + (size_t)idx * 64 + ks * 32); }
            SP_FENCE();
#pragma unroll
            for (int i = 0; i < 8; ++i) { f32x4 c = (f32x4){0.f, 0.f, 0.f, 0.f};
                c = __builtin_amdgcn_mfma_f32_16x16x32_bf16(kf[i][0], qf[0], c, 0, 0, 0);
                c = __builtin_amdgcn_mfma_f32_16x16x32_bf16(kf[i][1], qf[1], c, 0, 0, 0); S[8 * kh + i] = c; }
            SP_FENCE();
        }
        u32x4 vv[8];
#pragma unroll
        for (int i = 0; i < 8; ++i) { const int slot = (lane >> 3) + 8 * i; unsigned idx = *(const LAS unsigned short*)(ib + slot * 2); if (slot >= n) idx = 0u; vv[i] = *(const u32x4*)(vbat + (size_t)idx * 64); }
        SP_FENCE();
        float m = -INFINITY;
#pragma unroll
        for (int kt = 0; kt < 16; ++kt)
#pragma unroll
            for (int r = 0; r < 4; ++r) { if (16 * kt + 4 * g + r >= n) S[kt][r] = -INFINITY; m = fmaxf(m, S[kt][r]); }
        m = fmaxf(m, shx(m, lane, 16)); m = fmaxf(m, shx(m, lane, 32));
        const float mc = m * c2; float l = 0.f;
#pragma unroll
        for (int kt = 0; kt < 16; ++kt)
#pragma unroll
            for (int r = 0; r < 4; ++r) { const float p = __builtin_amdgcn_exp2f(S[kt][r] * c2 - mc); S[kt][r] = p; l += p; }
        l += shx(l, lane, 16); l += shx(l, lane, 32);
        const float linv = 1.f / l;
        bf16x8v P[8];
#pragma unroll
        for (int c = 0; c < 8; ++c) { u32x4 pk; pk.x = pg8::cvt_pk_bf16(S[2 * c][0], S[2 * c][1]); pk.y = pg8::cvt_pk_bf16(S[2 * c][2], S[2 * c][3]); pk.z = pg8::cvt_pk_bf16(S[2 * c + 1][0], S[2 * c + 1][1]); pk.w = pg8::cvt_pk_bf16(S[2 * c + 1][2], S[2 * c + 1][3]);
            P[c] = __builtin_bit_cast(bf16x8v, pk); }
        f32x4 O[4];
#pragma unroll
        for (int dt = 0; dt < 4; ++dt) O[dt] = (f32x4){0.f, 0.f, 0.f, 0.f};
#pragma unroll
        for (int cc = 0; cc < 4; ++cc) {
#pragma unroll
            for (int i = 0; i < 8; ++i) *(LAS u32x4*)(wdst + i * 8 * SV_STRIDE) = vv[i];
            SP_FENCE();
            if (cc < 3) {
#pragma unroll
                for (int i = 0; i < 8; ++i) { const int slot = 64 * (cc + 1) + (lane >> 3) + 8 * i; unsigned idx = *(const LAS unsigned short*)(ib + slot * 2); if (slot >= n) idx = 0u; vv[i] = *(const u32x4*)(vbat + (size_t)idx * 64); }
            }
            asm volatile("s_waitcnt lgkmcnt(0)" ::: "memory");
#pragma unroll
            for (int c2i = 0; c2i < 2; ++c2i)
#pragma unroll
                for (int dt = 0; dt < 4; ++dt) { const LAS unsigned char* p = rsrc + c2i * 32 * SV_STRIDE + dt * 32;
                    const v4i16_t lo = tr_read16(p), hi = tr_read16(p + 16 * SV_STRIDE);
                    const bf16x8v a = (bf16x8v){lo[0], lo[1], lo[2], lo[3], hi[0], hi[1], hi[2], hi[3]};
                    O[dt] = __builtin_amdgcn_mfma_f32_16x16x32_bf16(a, P[2 * cc + c2i], O[dt], 0, 0, 0); }
            asm volatile("s_waitcnt lgkmcnt(0)" ::: "memory");
        }
        if (q16 < 8) {
#pragma unroll
            for (int dt = 0; dt < 4; ++dt) { const f32x4 o = O[dt] * linv; u32x2 w;
                w.x = pg8::cvt_pk_bf16(o[0], o[1]); w.y = pg8::cvt_pk_bf16(o[2], o[3]);
                *(u32x2*)(MIX + row * DM + q16 * 64 + dt * 16 + g * 4) = w; }
        }
    }
    __syncthreads();
}
__device__ __forceinline__ void convb_phase(LAS unsigned char* lds, int G, int vcu, const bf16_t* U, const float* __restrict__ cw, const float* __restrict__ cb, const float* __restrict__ lng, const float* __restrict__ lnb, bf16_t* MIX, int tid, int lane, int wave) {
    asm volatile("" : "+v"(tid), "+v"(lane));
    typedef float f32x2v __attribute__((ext_vector_type(2)));
    const int cp = tid & 255, th = tid >> 8;
    f32x2v w[31];
#pragma unroll
    for (int j = 0; j < 31; ++j) w[j] = *(const f32x2v*)(cw + j * 512 + 2 * cp);
    const f32x2v bias = *(const f32x2v*)(cb + 2 * cp), gam = *(const f32x2v*)(lng + 2 * cp), bet = *(const f32x2v*)(lnb + 2 * cp);
    LAS float* red = (LAS float*)(lds + 65536);
#pragma unroll 1
    for (int tile = vcu; tile < MTOK / 32; tile += G) {
        const int row0 = tile * 32, t0 = row0 & (SEQ - 1);
        for (int i = tid; i < 62 * 64; i += 512) { const int r = i >> 6, ch = i & 63; u32x4 v = (u32x4){0u, 0u, 0u, 0u};
            if (t0 - 30 + r >= 0) v = *(const u32x4*)(U + (size_t)(row0 - 30 + r) * 512 + ch * 8);
            *(LAS u32x4*)(lds + r * 1024 + ch * 16) = v; }
        __syncthreads();
        f32x2v y[2][8];
#pragma unroll
        for (int k = 0; k < 2; ++k) {
            const int tg = th + 2 * k;
            f32x2v acc[8];
#pragma unroll
            for (int o = 0; o < 8; ++o) acc[o] = bias;
            const LAS unsigned* wp = (const LAS unsigned*)(lds + tg * 8 * 1024) + cp;
#pragma unroll
            for (int j = 0; j < 38; ++j) { const unsigned uu = wp[j * 256]; const f32x2v uv = (f32x2v){__uint_as_float(uu << 16), __uint_as_float(uu & 0xffff0000u)};
#pragma unroll
                for (int o = 0; o < 8; ++o) { const int tap = j - o; if (tap >= 0 && tap < 31) acc[o] += w[tap] * uv; } }
#pragma unroll
            for (int o = 0; o < 8; ++o) { y[k][o] = acc[o];
                float s = acc[o].x + acc[o].y, q = acc[o].x * acc[o].x + acc[o].y * acc[o].y;
                s = wave_sum_l(s, lane); q = wave_sum_l(q, lane);
                if (lane == 0) { red[((tg * 8 + o) * 4 + (wave & 3)) * 2] = s; red[((tg * 8 + o) * 4 + (wave & 3)) * 2 + 1] = q; } }
        }
        __syncthreads();
#pragma unroll
        for (int k = 0; k < 2; ++k) {
            const int tg = th + 2 * k;
#pragma unroll
            for (int o = 0; o < 8; ++o) { const int tl = tg * 8 + o;
                const f32x4 ra = *(const LAS f32x4*)(red + tl * 8), rb = *(const LAS f32x4*)(red + tl * 8 + 4);
                const float mu = ((ra[0] + ra[2]) + (rb[0] + rb[2])) * (1.f / 512.f), ex2 = ((ra[1] + ra[3]) + (rb[1] + rb[3])) * (1.f / 512.f);
                const float rstd = 1.f / sqrtf(fmaxf(ex2 - mu * mu, 0.f) + EPS);
                const float v0 = (y[k][o].x - mu) * rstd * gam.x + bet.x, v1 = (y[k][o].y - mu) * rstd * gam.y + bet.y;
                *(unsigned*)(MIX + (size_t)(row0 + tl) * DM + 512 + 2 * cp) = (unsigned)f2bf(silu_f(v0)) | ((unsigned)f2bf(silu_f(v1)) << 16); }
        }
        __syncthreads();
    }
}

__device__ __forceinline__ int wt_dst_row(int mode, int c) {
    if (mode == 0) return c;
    if (mode == 2) return 256 * (c >> 7) + (c & 127);
    if (mode == 3) return 256 * (c >> 7) + 128 + (c & 127);
    if (c < 512) return (c & ~63) + dperm(c & 63);
    if (c < 576) return 512 + dperm(c - 512);
    if (c < 640) return c;
    if (c < 896) return 768 + ((c - 640) & ~63) + dperm((c - 640) & 63);
    if (c < 960) return 640 + dperm(c - 896);
    if (c < 964) return 704 + (c - 960);
    if (c < 1476) { const int j = c - 964; return 1024 + 256 * (j >> 7) + (j & 127); }
    { const int j = c - 1476; return 1024 + 256 * (j >> 7) + 128 + (j & 127); }
}
__device__ __forceinline__ void wt_body(LAS unsigned char* sm, int vb, int tid, const float* __restrict__ W, int K, int N, bf16_t* WT, const float* __restrict__ gain, int mode) {
    LAS float* t = (LAS float*)sm;
    const int nbx = (N + 31) / 32; const int k0 = (vb / nbx) * 32, n0 = (vb % nbx) * 32, tx = tid & 31, ty = tid >> 5;
    for (int i = ty; i < 32; i += 8) { const int k = k0 + i, n = n0 + tx; float v = 0.f; if (k < K && n < N) { v = W[(size_t)k * N + n]; if (gain) v *= gain[k]; } t[i * 33 + tx] = v; }
    __syncthreads();
    for (int i = ty; i < 32; i += 8) { const int n = n0 + i, k = k0 + tx; if (n < N && k < K) WT[(size_t)wt_dst_row(mode, n) * K + k] = f2bf(t[tx * 33 + i]); }
    __syncthreads();
}
__device__ __forceinline__ void rmsnorm_bf16_row(const float* x, const float* __restrict__ g, bf16_t* out, int row, int lane) {
    const f32x4* xr = (const f32x4*)(x + (size_t)row * DM) + lane; const f32x4* gr = (const f32x4*)g + lane;
    f32x4 v[4]; float s = 0.f;
#pragma unroll
    for (int j = 0; j < 4; ++j) { v[j] = xr[64 * j]; s += (v[j].x * v[j].x + v[j].y * v[j].y) + (v[j].z * v[j].z + v[j].w * v[j].w); }
    const float rstd = 1.f / sqrtf(wave_sum_l(s, lane) * (1.f / DM) + EPS);
    u32x2* o = (u32x2*)(out + (size_t)row * DM) + lane;
#pragma unroll
    for (int j = 0; j < 4; ++j) { const f32x4 gg = gr[64 * j]; u32x2 w;
        w.x = (unsigned)f2bf(v[j].x * rstd * gg.x) | ((unsigned)f2bf(v[j].y * rstd * gg.y) << 16);
        w.y = (unsigned)f2bf(v[j].z * rstd * gg.z) | ((unsigned)f2bf(v[j].w * rstd * gg.w) << 16); o[64 * j] = w; }
}
__device__ __forceinline__ void rmsnorm_f32_row(float* x, const float* __restrict__ g, int row, int lane) {
    f32x4* xr = (f32x4*)(x + (size_t)row * DM) + lane; const f32x4* gr = (const f32x4*)g + lane;
    f32x4 v[4]; float s = 0.f;
#pragma unroll
    for (int j = 0; j < 4; ++j) { v[j] = xr[64 * j]; s += (v[j].x * v[j].x + v[j].y * v[j].y) + (v[j].z * v[j].z + v[j].w * v[j].w); }
    const float rstd = 1.f / sqrtf(wave_sum_l(s, lane) * (1.f / DM) + EPS);
#pragma unroll
    for (int j = 0; j < 4; ++j) { const f32x4 gg = gr[64 * j]; xr[64 * j] = v[j] * rstd * gg; }
}

constexpr size_t MiB = 1u << 20;
constexpr int LDS_USER = 139264, LDSCTL_OFF = LDS_USER, MISC_OFF = LDSCTL_OFF + 320, LDS_BYTES = 147456;
constexpr size_t WS_CTL = 476 * MiB, CTL_ZERO_BYTES = 1 * MiB; constexpr int CW_BAR = 4096;
constexpr int NGU = 2 * DFF;
struct Args { const float* in[23]; float* out; unsigned char* ws; };
static_assert(sizeof(Args) == 25 * 8, "Args has no padding");

__global__ void __launch_bounds__(512, 2) mega_k(Args a) {
    extern __shared__ __attribute__((aligned(16))) unsigned char lds_raw[];
    LAS unsigned char* lds = (LAS unsigned char*)lds_raw;
    const int wave = __builtin_amdgcn_readfirstlane(threadIdx.x >> 6);
#define PH_IDS() int lane; asm volatile("v_mbcnt_lo_u32_b32 %0, -1, 0\n\tv_mbcnt_hi_u32_b32 %0, -1, %0" : "=v"(lane)); const int tid = wave * 64 + lane, half = wave >> 2, htid = tid & 255; LAS unsigned char* hsm = lds + half * 65536; (void)htid; (void)hsm
    const int G = gridDim.x, bx = blockIdx.x; const int vcu = (G % 8 == 0) ? (bx % 8) * (G / 8) + bx / 8 : bx;
    const float* x = a.in[0]; const float* mem = a.in[1]; const int* positions = (const int*)a.in[2];
    const float* g_mix = a.in[3]; const float* w_in = a.in[4]; const float* w_out = a.in[5];
    const float* conv_b_w = a.in[6]; const float* conv_b_b = a.in[7]; const float* ln_b_g = a.in[8]; const float* ln_b_b = a.in[9];
    const float* g_cross = a.in[10]; const float* g_mem = a.in[11];
    const float* w_q = a.in[12]; const float* w_k = a.in[13]; const float* w_v = a.in[14]; const float* w_o = a.in[15];
    const float* g_ffn = a.in[16]; const float* w_gate = a.in[17]; const float* w_up = a.in[18];
    const float* ffn_cw = a.in[19]; const float* ffn_cb = a.in[20]; const float* w_down = a.in[21]; const float* g_final = a.in[22];
    float* out = a.out; unsigned char* ws = a.ws;
    bf16_t* wt_in = (bf16_t*)(ws + 0 * MiB); bf16_t* wt_out = (bf16_t*)(ws + 4 * MiB);
    bf16_t* wt_q = (bf16_t*)(ws + 6 * MiB), *wt_k = (bf16_t*)(ws + 8 * MiB), *wt_v = (bf16_t*)(ws + 10 * MiB), *wt_o = (bf16_t*)(ws + 12 * MiB);
    bf16_t* wt_gu = (bf16_t*)(ws + 14 * MiB); bf16_t* wt_down = (bf16_t*)(ws + 26 * MiB);
    float* WI = (float*)(ws + 32 * MiB); float* CS = (float*)(ws + 33 * MiB);
    float* SS1 = (float*)(ws + 35 * MiB); float* SS2 = (float*)(ws + 37 * MiB); float* SS3 = (float*)(ws + 39 * MiB);
    bf16_t* MEMN = (bf16_t*)(ws + 41 * MiB), *KC = (bf16_t*)(ws + 45 * MiB), *VC = (bf16_t*)(ws + 49 * MiB);
    bf16_t* XB = (bf16_t*)(ws + 56 * MiB);
    bf16_t* Qb = (bf16_t*)(ws + 120 * MiB); bf16_t* QI = (bf16_t*)(ws + 152 * MiB);
    bf16_t* Kb = (bf16_t*)(ws + 168 * MiB), *Vb = (bf16_t*)(ws + 172 * MiB), *KI = (bf16_t*)(ws + 176 * MiB);
    bf16_t* U = (bf16_t*)(ws + 180 * MiB); unsigned short* SEL = (unsigned short*)(ws + 212 * MiB);
    bf16_t* MIX = (bf16_t*)(ws + 228 * MiB); bf16_t* QC = (bf16_t*)(ws + 292 * MiB); bf16_t* OC = (bf16_t*)(ws + 356 * MiB);
    bf16_t* Hb = (bf16_t*)(ws + 120 * MiB);
    float* TOPG = (float*)(ws + 300 * MiB); float* TOPU = (float*)(ws + 304 * MiB); float* BOTG = (float*)(ws + 308 * MiB);
    unsigned* ctl = (unsigned*)(ws + WS_CTL);

    { PH_IDS(); for (int u = tid; u < (LDS_BYTES - LDSCTL_OFF) / 4; u += 512) ((LAS unsigned*)(lds + LDSCTL_OFF))[u] = 0u; }
    __syncthreads();
    XcdBarrier bar = xcd_barrier_post(ctl + CW_BAR, (volatile LAS unsigned*)(lds + MISC_OFF) + 8);
#define GRID_BAR() xcd_barrier(bar)
#define FOR_VB(nvb) for (int vb = 2 * bx + half; vb < (nvb); vb += 2 * G)
#define GEMMX(EPI, EINIT, Aptr, Bptr, Mv, Nv, Kv) do { pg8::Gemm g_{Aptr, Bptr, Mv, Nv, Kv}; pg8::StaticOrder S_; S_.init(Mv, Nv, G, bx); EPI E_ EINIT; \
        PH_IDS(); pg8::gemm_phase<EPI, pg8::StaticOrder, true, true>(lds, g_, S_, E_, tid); } while (0)
#define EI(...) {__VA_ARGS__}

    { PH_IDS();
    for (int i = bx * 512 + tid; i < 60 * DM; i += G * 512) wt_in[(size_t)708 * DM + i] = 0;
    FOR_VB(32 * 63) wt_body(hsm, vb, htid, w_in, DM, INC, wt_in, nullptr, 1);
    FOR_VB(32 * 32) wt_body(hsm, vb, htid, w_out, DM, DM, wt_out, nullptr, 0);
    FOR_VB(32 * 32) wt_body(hsm, vb, htid, w_q, DM, DM, wt_q, g_cross, 0);
    FOR_VB(32 * 32) wt_body(hsm, vb, htid, w_k, DM, DM, wt_k, nullptr, 0);
    FOR_VB(32 * 32) wt_body(hsm, vb, htid, w_v, DM, DM, wt_v, nullptr, 0);
    FOR_VB(32 * 32) wt_body(hsm, vb, htid, w_o, DM, DM, wt_o, nullptr, 0);
    FOR_VB(32 * 88) wt_body(hsm, vb, htid, w_gate, DM, DFF, wt_gu, g_ffn, 2);
    FOR_VB(32 * 88) wt_body(hsm, vb, htid, w_up, DM, DFF, wt_gu, g_ffn, 3);
    FOR_VB(88 * 32) wt_body(hsm, vb, htid, w_down, DFF, DM, wt_down, nullptr, 0);
    for (int i = bx * 512 + tid; i < MTOK * 8; i += G * 512) { const int row = i >> 3, k = i & 7;
        const float freq = (float)pow(500000.0, -0.125 * (double)k); const float ang = (float)positions[row] * freq;
        CS[(size_t)row * 16 + k] = (float)cos((double)ang); CS[(size_t)row * 16 + 8 + k] = (float)sin((double)ang); }
    for (int r = bx * 8 + wave; r < MTOK; r += G * 8) rmsnorm_bf16_row(x, g_mix, XB, r, lane);
    for (int r = bx * 8 + wave; r < MMEM; r += G * 8) rmsnorm_bf16_row(mem, g_mem, MEMN, r, lane);
    }
    GRID_BAR();
    GEMMX(EpiIn, EI(CS, Qb, Kb, Vb, QI, KI, U, WI), XB, wt_in, MTOK, INP, DM);
    GEMMX(EpiStore, EI(nullptr, KC, nullptr, DM), MEMN, wt_k, MMEM, DM, DM);
    GEMMX(EpiStore, EI(nullptr, VC, nullptr, MMEM), wt_v, MEMN, DM, MMEM, DM);
    GRID_BAR();
    { PH_IDS(); topk_phase(lds, G, vcu, QI, KI, WI, SEL, tid, lane, wave); }
    { PH_IDS(); convb_phase(lds, G, vcu, U, conv_b_w, conv_b_b, ln_b_g, ln_b_b, MIX, tid, lane, wave); }
    GRID_BAR();
    { PH_IDS(); sparse_attn_phase(lds, G, vcu, Qb, Kb, Vb, SEL, MIX, lane, wave); }
    GRID_BAR();
    GEMMX(EpiRes, EI(x, out, XB, SS1), MIX, wt_out, MTOK, DM, DM);
    GRID_BAR();
    GEMMX(EpiScale, EI(SS1, QC, DM, 1.0f), XB, wt_q, MTOK, DM, DM);
    GRID_BAR();
    { PH_IDS(); const int per = (512 + G - 1) / G; for (int i = 0; i < per; ++i) { const int u = vcu * per + i; if (u < 512) cross_attn_unit(lds, u >> 6, (u >> 4) & 3, u & 15, QC, KC, VC, OC, tid, lane, wave); } }
    GRID_BAR();
    GEMMX(EpiRes, EI(out, out, XB, SS2), OC, wt_o, MTOK, DM, DM);
    GRID_BAR();
    GEMMX(EpiGateUpAct, EI(SS2, Hb, ffn_cw, ffn_cb, TOPG, TOPU, BOTG, lds + 131072), XB, wt_gu, MTOK, NGU, DM);
    GRID_BAR();
    { PH_IDS();
    for (int i = bx * 512 + tid; i < (MTOK / 256) * 2 * DFF; i += G * 512) {
        const int pm = i / (2 * DFF), rem = i - pm * (2 * DFF), j = rem / DFF, c = rem - j * DFF;
        const bool first = (pm & 15) == 0;
        const float gm2 = first ? 0.f : BOTG[((size_t)(pm - 1) * 2 + 0) * DFF + c], gm1 = first ? 0.f : BOTG[((size_t)(pm - 1) * 2 + 1) * DFF + c];
        const float g0 = TOPG[((size_t)pm * 2 + 0) * DFF + c], g1 = TOPG[((size_t)pm * 2 + 1) * DFF + c];
        const float cur = j ? g1 : g0, p1 = j ? g0 : gm1, p2 = j ? gm1 : gm2;
        const float gg = ffn_cb[c] + ffn_cw[2 * DFF + c] * cur + ffn_cw[DFF + c] * p1 + ffn_cw[c] * p2;
        Hb[((size_t)pm * 256 + j) * DFF + c] = f2bf(silu_f(gg) * TOPU[((size_t)pm * 2 + j) * DFF + c]);
    }
    }
    GRID_BAR();
    GEMMX(EpiRes, EI(out, out, nullptr, SS3), Hb, wt_down, MTOK, DM, DFF);
    GRID_BAR();
    { PH_IDS();
    for (int r = bx * 8 + wave; r < MTOK; r += G * 8) {
        const float rs = rstd_from_ss(SS3, (size_t)r);
        f32x4* xr = (f32x4*)(out + (size_t)r * DM) + lane; const f32x4* gr = (const f32x4*)g_final + lane;
#pragma unroll
        for (int j = 0; j < 4; ++j) xr[64 * j] = xr[64 * j] * rs * gr[64 * j];
    }
    }
}

extern "C" void kernel_launch(void* const* d_in, const int* in_sizes, int n_in, void* d_out, int out_size, void* d_ws, size_t ws_size, hipStream_t stream) {
    static int grid = 0;
    if (grid == 0) {
        int dev = 0, cus = 0, per_cu = 0;
        if (hipGetDevice(&dev) != hipSuccess || hipDeviceGetAttribute(&cus, hipDeviceAttributeMultiprocessorCount, dev) != hipSuccess) { fprintf(stderr, "kernel_launch: device query failed\n"); grid = -1; return; }
        if (hipFuncSetAttribute((const void*)mega_k, hipFuncAttributeMaxDynamicSharedMemorySize, LDS_BYTES) != hipSuccess) { fprintf(stderr, "kernel_launch: hipFuncSetAttribute failed\n"); grid = -1; return; }
        if (hipOccupancyMaxActiveBlocksPerMultiprocessor(&per_cu, (const void*)mega_k, 512, LDS_BYTES) != hipSuccess || per_cu < 1) { fprintf(stderr, "kernel_launch: occupancy query says %d\n", per_cu); per_cu = 1; }
        (void)hipGetLastError();
        grid = cus * 1;
        if (n_in != 23 || ws_size < 477 * MiB) { fprintf(stderr, "kernel_launch: unexpected n_in %d / ws %zu\n", n_in, ws_size); grid = -1; return; }
    }
    if (grid < 0) return;
    (void)hipMemsetAsync((char*)d_ws + WS_CTL, 0, CTL_ZERO_BYTES, stream);
    Args a{};
    for (int i = 0; i < 23; ++i) a.in[i] = (const float*)d_in[i];
    a.out = (float*)d_out; a.ws = (unsigned char*)d_ws;
    void* params[] = {&a};
    hipError_t e = hipLaunchCooperativeKernel((const void*)mega_k, dim3(grid), dim3(512), params, LDS_BYTES, stream);
    if (e != hipSuccess) fprintf(stderr, "cooperative launch failed: %s (grid %d)\n", hipGetErrorString(e), grid);
}
```

```cpp
#include <hip/hip_runtime.h>
#include <cstdio>
#include <cstdint>
#include <cmath>
namespace pg8 {
#define PG8_LAS __attribute__((address_space(3)))
typedef unsigned short bf16_t;
typedef short bf16x8 __attribute__((ext_vector_type(8)));
typedef float f32x4 __attribute__((ext_vector_type(4)));
typedef unsigned u32x4 __attribute__((ext_vector_type(4)));
constexpr int BM = 256, BK = 64, HALF = 128, HTB = HALF * BK * 2  , STAGE_BYTES = 8 * HTB, NXCD = 8, WGM = 8;

__host__ __device__ __forceinline__ int lds_byte(int r, int c) { const int st = (r >> 4) * 2 + (c >> 5), rr = r & 15, cc = c & 31, ob = rr * 64 + cc * 2; return st * 1024 + (ob ^ (((ob >> 9) & 1) << 5)); }
__host__ __device__ __forceinline__ void stage_rc(int b, int& R, int& C) { const int st = b / 1024, sb = b % 1024, swz = sb ^ (((sb >> 9) & 1) << 5); R = (st >> 1) * 16 + swz / 64; C = (st & 1) * 32 + (swz % 64) / 2; }
__host__ __device__ __forceinline__ int perm32(int rho) { const int n = rho >> 4, i = rho & 15; return 8 * (i >> 2) + 4 * n + (i & 3); }

struct Unit { int pm, pn; };
struct Gemm { const bf16_t* A; const bf16_t* Bt; int M, N, K; };

struct StaticOrder {
    int nM, nN, nwg, G, c;
    __host__ __device__ void init(int M, int N, int G_, int c_) { nM = M / BM; nN = N / BM; nwg = nM * nN; G = G_; c = c_; }
    __host__ __device__ bool next(int i, Unit& u) const {
        const long L = (long)i * G + c; if (L >= nwg) return false;
        int wgid = (int)L; { const int q = nwg / NXCD, r = nwg % NXCD, xcd = wgid % NXCD, off = wgid / NXCD; wgid = (xcd < r ? xcd * (q + 1) : r * (q + 1) + (xcd - r) * q) + off; }
        const int nig = WGM * nN, gid = wgid / nig, fm = gid * WGM, gsz = (nM - fm) < WGM ? (nM - fm) : WGM;
        u.pm = fm + ((wgid % nig) % gsz); u.pn = (wgid % nig) / gsz; return true;
    }
    __device__ __forceinline__ void a_ready(const Unit&) const {}
    __device__ __forceinline__ void done(const Unit&) const {}
};
__device__ __forceinline__ unsigned cvt_pk_bf16(float lo, float hi) { unsigned r; asm volatile("v_cvt_pk_bf16_f32 %0, %1, %2" : "=v"(r) : "v"(lo), "v"(hi)); return r; }
template <class Epi, class Sched, bool ALIGN_EPI = false, bool SP2 = false>
__device__ __forceinline__ void gemm_phase(PG8_LAS unsigned char* lds, const Gemm g, const Sched& S, const Epi& E, int tid_in) {
    int tid_l = tid_in; asm volatile("" : "+v"(tid_l));
    const int tid = tid_l, wid = __builtin_amdgcn_readfirstlane(tid >> 6), lane = tid & 63, wr = wid >> 2, wc = wid & 3, fr = lane & 15, fq = lane >> 4;
    const int K = g.K, nt = K / BK;
    unsigned voffA[2], voffB[2];
#pragma unroll
    for (int i = 0; i < 2; ++i) { int R, C; stage_rc(tid * 16 + i * 8192, R, C); const int Rb = Epi::PERM ? ((R & ~31) + perm32(R & 31)) : R;
        voffA[i] = (unsigned)(R * K + C) * 2u; voffB[i] = (unsigned)(Rb * K + C) * 2u; }
    const size_t kstep = (size_t)(BK * 2);
    const size_t hstep = (size_t)HALF * K * 2;
    const size_t tstep = 2 * hstep;
    const unsigned ldsw = (unsigned)wid * 1024u;
    const int aoff = lds_byte(wr * 64 + fr, fq * 8), boff = lds_byte(wc * 32 + fr, fq * 8);
#define PG8_SA(b, h) (((b) * 2 + (h)) * HTB)
#define PG8_SB(b, h) ((4 + (b) * 2 + (h)) * HTB)
#define PG8_STAGE(bufoff, gbase, voff) do { _Pragma("unroll") for (int _i = 0; _i < 2; ++_i) \
        __builtin_amdgcn_global_load_lds((const unsigned*)((const char*)(gbase) + (voff)[_i]), (PG8_LAS unsigned*)(lds + (bufoff) + ldsw + _i * 8192), 16, 0, 0); } while (0)
#define PG8_LDA(dst, b, h) do { _Pragma("unroll") for (int m = 0; m < 4; ++m) _Pragma("unroll") for (int k = 0; k < 2; ++k) dst[m][k] = *(const PG8_LAS bf16x8*)(lds + PG8_SA(b, h) + aoff + m * 2048 + k * 1024); } while (0)
#define PG8_LDB(dst, b, h) do { _Pragma("unroll") for (int n = 0; n < 2; ++n) _Pragma("unroll") for (int k = 0; k < 2; ++k) dst[n][k] = *(const PG8_LAS bf16x8*)(lds + PG8_SB(b, h) + boff + n * 2048 + k * 1024); } while (0)
#define PG8_MMA(ai, bj, At, Bt) do { __builtin_amdgcn_s_setprio(1); _Pragma("unroll") for (int m = 0; m < 4; ++m) _Pragma("unroll") for (int n = 0; n < 2; ++n) _Pragma("unroll") for (int k = 0; k < 2; ++k) \
        acc[ai][bj][m][n] = __builtin_amdgcn_mfma_f32_16x16x32_bf16(Bt[n][k], At[m][k], acc[ai][bj][m][n], 0, 0, 0); __builtin_amdgcn_s_setprio(0); } while (0)
#define PG8_WAIT_V(n) asm volatile("s_waitcnt vmcnt(" #n ")" ::: "memory")
#define PG8_WAIT_L(n) asm volatile("s_waitcnt lgkmcnt(" #n ")" ::: "memory")
#define PG8_BAR __builtin_amdgcn_s_barrier()
#define PG8_SCHED __builtin_amdgcn_sched_barrier(0)
    Unit cur, nxt; int ui = 0;
    if (!S.next(0, cur)) return;
    f32x4 acc[2][2][4][2];
#pragma unroll
    for (int a = 0; a < 2; ++a)
#pragma unroll
        for (int b = 0; b < 2; ++b)
#pragma unroll
            for (int m = 0; m < 4; ++m)
#pragma unroll
                for (int n = 0; n < 2; ++n) acc[a][b][m][n] = (f32x4){0.f, 0.f, 0.f, 0.f};
    bf16x8 At[4][2], B0[2][2], B1[2][2];
    const char* cA = (const char*)g.A + (size_t)cur.pm * tstep; const char* cB = (const char*)g.Bt + (size_t)cur.pn * tstep;
    S.a_ready(cur);
    if constexpr (SP2) {
        PG8_STAGE(PG8_SB(0, 0), cB, voffB); PG8_STAGE(PG8_SB(0, 1), cB + hstep, voffB); PG8_STAGE(PG8_SA(0, 0), cA, voffA); PG8_STAGE(PG8_SA(0, 1), cA + hstep, voffA);
        if (wr == 1) PG8_BAR;
        PG8_WAIT_V(2); PG8_BAR;
        PG8_STAGE(PG8_SB(1, 0), cB + kstep, voffB); PG8_STAGE(PG8_SA(1, 0), cA + kstep, voffA); PG8_STAGE(PG8_SB(1, 1), cB + hstep + kstep, voffB);
        PG8_WAIT_V(6); PG8_BAR;
    } else {
        PG8_STAGE(PG8_SB(0, 0), cB, voffB); PG8_STAGE(PG8_SA(0, 0), cA, voffA); PG8_STAGE(PG8_SB(0, 1), cB + hstep, voffB); PG8_STAGE(PG8_SA(0, 1), cA + hstep, voffA);
        if (wr == 1) PG8_BAR;
        PG8_WAIT_V(4); PG8_BAR;
        PG8_STAGE(PG8_SB(1, 0), cB + kstep, voffB); PG8_STAGE(PG8_SA(1, 0), cA + kstep, voffA); PG8_STAGE(PG8_SB(1, 1), cB + hstep + kstep, voffB);
        PG8_WAIT_V(6); PG8_BAR;
    }
    for (;;) {
        const bool has_next = S.next(ui + 1, nxt);
        const char* nA = has_next ? (const char*)g.A + (size_t)nxt.pm * tstep : cA; const char* nB = has_next ? (const char*)g.Bt + (size_t)nxt.pn * tstep : cB;
        for (int t = 0; t < nt; t += 2) {
            const bool last = (t == nt - 2);
            const char* a1 = cA + (size_t)(t + 1) * kstep;
            const char* a2 = last ? nA : cA + (size_t)(t + 2) * kstep; const char* b2 = last ? nB : cB + (size_t)(t + 2) * kstep;
            const char* a3 = a2 + kstep; const char* b3 = b2 + kstep;
            if (last && has_next) S.a_ready(nxt);
            if constexpr (SP2) {
            PG8_LDB(B0, 0, 0); PG8_LDB(B1, 0, 1); PG8_SCHED; PG8_LDA(At, 0, 0); PG8_STAGE(PG8_SA(1, 1), a1 + hstep, voffA);
            PG8_WAIT_V(8); PG8_WAIT_L(0); PG8_BAR; PG8_MMA(0, 0, At, B0); PG8_MMA(0, 1, At, B1); PG8_BAR; PG8_SCHED;
            PG8_LDA(At, 0, 1); PG8_STAGE(PG8_SB(0, 0), b2, voffB); PG8_STAGE(PG8_SB(0, 1), b2 + hstep, voffB); PG8_STAGE(PG8_SA(0, 0), a2, voffA);
            PG8_WAIT_V(8); PG8_WAIT_L(0); PG8_BAR; PG8_MMA(1, 0, At, B0); PG8_MMA(1, 1, At, B1); PG8_BAR; PG8_SCHED;
            PG8_LDB(B0, 1, 0); PG8_LDB(B1, 1, 1); PG8_SCHED; PG8_LDA(At, 1, 0); PG8_STAGE(PG8_SA(0, 1), a2 + hstep, voffA);
            PG8_WAIT_V(8); PG8_WAIT_L(0); PG8_BAR; PG8_MMA(0, 0, At, B0); PG8_MMA(0, 1, At, B1); PG8_BAR; PG8_SCHED;
            PG8_LDA(At, 1, 1); PG8_STAGE(PG8_SB(1, 0), b3, voffB); PG8_STAGE(PG8_SB(1, 1), b3 + hstep, voffB); PG8_STAGE(PG8_SA(1, 0), a3, voffA);
            PG8_WAIT_V(8); PG8_WAIT_L(0); PG8_BAR; PG8_MMA(1, 0, At, B0); PG8_MMA(1, 1, At, B1); PG8_BAR; PG8_SCHED;
            } else {
            PG8_LDB(B0, 0, 0); PG8_SCHED; PG8_LDA(At, 0, 0); PG8_STAGE(PG8_SA(1, 1), a1 + hstep, voffA);
            PG8_WAIT_L(8); PG8_BAR; PG8_WAIT_L(0); PG8_MMA(0, 0, At, B0); PG8_BAR; PG8_SCHED;
            PG8_LDB(B1, 0, 1); PG8_STAGE(PG8_SB(0, 0), b2, voffB);
            PG8_BAR; PG8_WAIT_L(0); PG8_MMA(0, 1, At, B1); PG8_BAR;
            PG8_LDA(At, 0, 1); PG8_STAGE(PG8_SA(0, 0), a2, voffA);
            PG8_BAR; PG8_WAIT_L(0); PG8_MMA(1, 0, At, B0); PG8_BAR; PG8_SCHED;
            PG8_STAGE(PG8_SB(0, 1), b2 + hstep, voffB);
            PG8_WAIT_V(6); PG8_BAR; PG8_MMA(1, 1, At, B1); PG8_BAR;
            PG8_LDB(B0, 1, 0); PG8_SCHED; PG8_LDA(At, 1, 0); PG8_STAGE(PG8_SA(0, 1), a2 + hstep, voffA);
            PG8_WAIT_L(8); PG8_BAR; PG8_WAIT_L(0); PG8_MMA(0, 0, At, B0); PG8_BAR; PG8_SCHED;
            PG8_LDB(B1, 1, 1); PG8_STAGE(PG8_SB(1, 0), b3, voffB);
            PG8_BAR; PG8_WAIT_L(0); PG8_MMA(0, 1, At, B1); PG8_BAR;
            PG8_LDA(At, 1, 1); PG8_STAGE(PG8_SA(1, 0), a3, voffA);
            PG8_BAR; PG8_WAIT_L(0); PG8_MMA(1, 0, At, B0); PG8_BAR; PG8_SCHED;
            PG8_STAGE(PG8_SB(1, 1), b3 + hstep, voffB);
            PG8_WAIT_V(6); PG8_BAR; PG8_MMA(1, 1, At, B1); PG8_BAR;
            }
        }
        if constexpr (ALIGN_EPI) { if (wr == 0) PG8_BAR; }
        if constexpr (!Epi::AFTER_DRAIN) { E(acc, cur, wr, wc, fr, fq); S.done(cur); }
        if (!has_next) break;
#pragma unroll
        for (int a = 0; a < 2; ++a)
#pragma unroll
            for (int b = 0; b < 2; ++b)
#pragma unroll
                for (int m = 0; m < 4; ++m)
#pragma unroll
                    for (int n = 0; n < 2; ++n) acc[a][b][m][n] = (f32x4){0.f, 0.f, 0.f, 0.f};
        cur = nxt; cA = nA; cB = nB; ++ui;
        if constexpr (ALIGN_EPI) { if (wr == 1) PG8_BAR; }
    }
    PG8_WAIT_V(0);
    if constexpr (!ALIGN_EPI) { if (wr == 0) PG8_BAR; }
    PG8_BAR;
    if constexpr (Epi::AFTER_DRAIN) { E.fused(acc, cur, wr, wc, fr, fq, lds, wid, lane); S.done(cur); }
#undef PG8_SA
#undef PG8_SB
#undef PG8_STAGE
#undef PG8_LDA
#undef PG8_LDB
#undef PG8_MMA
#undef PG8_WAIT_V
#undef PG8_WAIT_L
#undef PG8_BAR
#undef PG8_SCHED
}
}

constexpr int BATCH = 8, SEQ = 4096, DM = 1024, MTOK = BATCH * SEQ;
constexpr int NMEM = 256, MMEM = BATCH * NMEM;
constexpr int AW = 512, HD = 64, NH = 8, IH = 4, TOPK = 256;
constexpr int INC = 1988, INP = 2048;
constexpr int DFF = 2816;
constexpr float EPS = 1e-6f;
#define LAS __attribute__((address_space(3)))
typedef unsigned short bf16_t;
typedef float f32x4 __attribute__((ext_vector_type(4)));
typedef unsigned u32x4 __attribute__((ext_vector_type(4)));
typedef unsigned u32x2 __attribute__((ext_vector_type(2)));

__device__ __forceinline__ float bf2f(bf16_t v) { return __uint_as_float((unsigned)v << 16); }
__device__ __forceinline__ bf16_t f2bf(float f) { unsigned u = __float_as_uint(f); return (bf16_t)((u + 0x7fffu + ((u >> 16) & 1u)) >> 16); }
__device__ __forceinline__ float shx(float v, int lane, int o) { return __uint_as_float((unsigned)__builtin_amdgcn_ds_bpermute((lane ^ o) << 2, (int)__float_as_uint(v))); }
__device__ __forceinline__ float wave_sum_l(float v, int lane) {
#pragma unroll
    for (int o = 1; o < 64; o <<= 1) v += shx(v, lane, o);
    return v;
}
__device__ __forceinline__ float wave_sum(float v) {
#pragma unroll
    for (int o = 1; o < 64; o <<= 1) v += __shfl_xor(v, o);
    return v;
}
__device__ __forceinline__ float wave_max(float v) {
#pragma unroll
    for (int o = 1; o < 64; o <<= 1) v = fmaxf(v, __shfl_xor(v, o));
    return v;
}
__device__ __forceinline__ float silu_f(float v) { return v / (1.f + __expf(-v)); }

struct EpiStore {
    static constexpr bool PERM = false, AFTER_DRAIN = false;
    float* outf; bf16_t* outb; const float* res; int ldc;
    __device__ __forceinline__ void operator()(const pg8::f32x4 (&acc)[2][2][4][2], const pg8::Unit& u, int wr, int wc, int fr, int fq) const {
        const int col0 = u.pn * 256 + wc * 32 + 4 * fq;
#pragma unroll
        for (int ai = 0; ai < 2; ++ai)
#pragma unroll
            for (int m = 0; m < 4; ++m) {
                const size_t row = (size_t)(u.pm * 256 + ai * 128 + wr * 64 + m * 16 + fr);
#pragma unroll
                for (int bj = 0; bj < 2; ++bj)
#pragma unroll
                    for (int n = 0; n < 2; ++n) {
                        const size_t off = row * ldc + col0 + bj * 128 + n * 16;
                        pg8::f32x4 v = acc[ai][bj][m][n];
                        if (res) { const pg8::f32x4 r = *(const pg8::f32x4*)(res + off); v = v + r; }
                        if (outf) *(pg8::f32x4*)(outf + off) = v;
                        if (outb) { u32x2 w; w.x = (unsigned)f2bf(v[0]) | ((unsigned)f2bf(v[1]) << 16); w.y = (unsigned)f2bf(v[2]) | ((unsigned)f2bf(v[3]) << 16); *(u32x2*)(outb + off) = w; }
                    }
            }
    }
};
#define XB_TMO      128
#define XB_XCNT(j)  (256  + 64 * (j))
#define XB_XSUB(j)  (1280 + 64 * (j))
#define XB_XGEN(j)  (2304 + 64 * (j))
#define XB_TOP      3328
#define XB_TOPGEN   3392
#define XCD_BAR_WORDS 3456
#define XB_SPIN_CAP (1u << 18)

__device__ __forceinline__ unsigned xb_ld(unsigned* p)              { return __hip_atomic_load(p, __ATOMIC_RELAXED, __HIP_MEMORY_SCOPE_AGENT); }
__device__ __forceinline__ unsigned xb_add(unsigned* p, unsigned v) { return __hip_atomic_fetch_add(p, v, __ATOMIC_RELAXED, __HIP_MEMORY_SCOPE_AGENT); }
__device__ __forceinline__ unsigned xb_xcc_id() { return (unsigned)__builtin_amdgcn_s_getreg((3 << 11) | 20) & 0xFu; }
#define XB_SPIN(cond, bar) do { unsigned _sp = 0; while (cond) { __builtin_amdgcn_s_sleep(1); \
    if ((++_sp & 255u) == 0u) { if (xb_ld(&(bar)[XB_TMO])) break; if (_sp > XB_SPIN_CAP) { atomicAdd(&(bar)[XB_TMO], 1u); break; } } } } while (0)

struct XcdBarrier {
    unsigned* bar; unsigned x;
    volatile LAS unsigned* st;
};

__device__ __forceinline__ XcdBarrier xcd_barrier_post(unsigned* bar, volatile LAS unsigned* st) {
    XcdBarrier b; b.bar = bar; b.x = xb_xcc_id(); b.st = st;
    if (threadIdx.x == 0) (void)xb_add(&bar[XB_XCNT(b.x)], 1u);
    return b;
}
__device__ __forceinline__ void xcd_barrier_complete(unsigned* bar, unsigned x, unsigned& nloc, unsigned& nx) {
    const unsigned G = gridDim.x * gridDim.y * gridDim.z;
    unsigned sum, cnt, mine, sp = 0u;
    for (;;) {
        sum = 0u; cnt = 0u; mine = 0u;
#pragma unroll
        for (unsigned j = 0; j < 16; ++j) { const unsigned c = xb_ld(&bar[XB_XCNT(j)]); sum += c; cnt += (c > 0u) ? 1u : 0u; mine = (j == x) ? c : mine; }
        if (sum == G) break;
        __builtin_amdgcn_s_sleep(1);
        if ((++sp & 255u) == 0u) { if (xb_ld(&bar[XB_TMO])) break; if (sp > XB_SPIN_CAP) { atomicAdd(&bar[XB_TMO], 1u); break; } }
    }
    nloc = mine > 0u ? mine : 1u; nx = cnt > 0u ? cnt : 1u;
}

__device__ __forceinline__ void xcd_barrier(const XcdBarrier& b) {
    asm volatile("s_waitcnt vmcnt(0)" ::: "memory");
    __syncthreads();
    if (threadIdx.x == 0) {
        unsigned* bar = b.bar;
        __builtin_amdgcn_s_waitcnt(0);
        unsigned nloc = b.st[0], nx = b.st[1];
        if (nloc == 0u) { xcd_barrier_complete(bar, b.x, nloc, nx); b.st[0] = nloc; b.st[1] = nx; }
        const unsigned old = xb_add(&bar[XB_XSUB(b.x)], 1u);
        const unsigned gen = old / nloc;
        if (old + 1u == (gen + 1u) * nloc) {
            __builtin_amdgcn_fence(__ATOMIC_RELEASE, "agent");
            asm volatile("s_waitcnt vmcnt(0)" ::: "memory");
            const unsigned og = xb_add(&bar[XB_TOP], 1u);
            const unsigned tg = og / nx;
            if (og + 1u == (tg + 1u) * nx) xb_add(&bar[XB_TOPGEN], 1u);
            else XB_SPIN(xb_ld(&bar[XB_TOPGEN]) == tg, bar);
            __builtin_amdgcn_fence(__ATOMIC_ACQUIRE, "agent");
            xb_add(&bar[XB_XGEN(b.x)], 1u);
            asm volatile("s_waitcnt vmcnt(0)" ::: "memory");
        } else {
            XB_SPIN(xb_ld(&bar[XB_XGEN(b.x)]) == gen, bar);
            __builtin_amdgcn_fence(__ATOMIC_ACQUIRE, "agent");
            asm volatile("s_waitcnt vmcnt(0)" ::: "memory");
        }
    }
    __syncthreads();
}

__device__ __forceinline__ u32x4 pack8(const pg8::f32x4 a, const pg8::f32x4 b) {
    u32x4 w; w.x = pg8::cvt_pk_bf16(a[0], a[1]); w.y = pg8::cvt_pk_bf16(a[2], a[3]); w.z = pg8::cvt_pk_bf16(b[0], b[1]); w.w = pg8::cvt_pk_bf16(b[2], b[3]); return w;
}
__device__ __forceinline__ float sigmoid_f(float v) { return 1.f / (1.f + __expf(-v)); }
__host__ __device__ __forceinline__ int dperm(int pos) { return pos < 16 ? (4 * (pos >> 3) + (pos & 3) + 8 * ((pos >> 2) & 1)) : pos; }
__host__ __device__ __forceinline__ int in_orig_col(int n) {
    if (n < 512) return (n & ~63) + dperm(n & 63);
    if (n < 576) return 512 + dperm(n - 512);
    if (n < 640) return 576 + (n - 576);
    if (n < 704) return 896 + dperm(n - 640);
    if (n < 708) return 960 + (n - 704);
    if (n < 768) return -1;
    if (n < 1024) return 640 + ((n - 768) & ~63) + dperm((n - 768) & 63);
    const int i = (n - 1024) >> 8, c = (n - 1024) & 255;
    return c < 128 ? 964 + 128 * i + c : 1476 + 128 * i + (c - 128);
}
struct EpiIn {
    static constexpr bool PERM = true, AFTER_DRAIN = false;
    const float* cs; bf16_t *Q, *K, *V, *QI, *KI, *U; float* WI;
    __device__ __forceinline__ void operator()(const pg8::f32x4 (&acc)[2][2][4][2], const pg8::Unit& u, int wr, int wc, int fr, int fq) const {
        const int pn = u.pn;
        if (pn >= 4) {
            const int ch = 128 * (pn - 4) + 32 * wc + 8 * fq;
#pragma unroll
            for (int ai = 0; ai < 2; ++ai)
#pragma unroll
                for (int m = 0; m < 4; ++m) { const size_t row = (size_t)(u.pm * 256 + ai * 128 + wr * 64 + m * 16 + fr);
                    pg8::f32x4 a0 = acc[ai][0][m][0], a1 = acc[ai][0][m][1]; const pg8::f32x4 g0 = acc[ai][1][m][0], g1 = acc[ai][1][m][1];
#pragma unroll
                    for (int k = 0; k < 4; ++k) { a0[k] *= sigmoid_f(g0[k]); a1[k] *= sigmoid_f(g1[k]); }
                    *(u32x4*)(U + row * 512 + ch) = pack8(a0, a1); }
            return;
        }
        const bool rot = (pn == 2) ? (wc == 0 && fq < 2) : ((wc & 1) == 0 && fq < 2);
#pragma unroll
        for (int ai = 0; ai < 2; ++ai)
#pragma unroll
            for (int m = 0; m < 4; ++m) { const size_t row = (size_t)(u.pm * 256 + ai * 128 + wr * 64 + m * 16 + fr);
                pg8::f32x4 cv = {1.f, 1.f, 1.f, 1.f}, sv = {0.f, 0.f, 0.f, 0.f};
                if (rot) { cv = *(const pg8::f32x4*)(cs + row * 16 + 4 * fq); sv = *(const pg8::f32x4*)(cs + row * 16 + 8 + 4 * fq); }
#pragma unroll
                for (int bj = 0; bj < 2; ++bj) {
                    const pg8::f32x4 v0 = acc[ai][bj][m][0], v1 = acc[ai][bj][m][1];
                    pg8::f32x4 n0 = v0 * cv - v1 * sv, n1 = v1 * cv + v0 * sv;
                    if (!rot) { n0 = v0; n1 = v1; }
                    const int c = 128 * bj + 32 * wc + 8 * fq;
                    if (pn < 2) *(u32x4*)(Q + row * 512 + 256 * pn + c) = pack8(n0, n1);
                    else if (pn == 3) *(u32x4*)(QI + row * 256 + c) = pack8(n0 * 0.125f, n1 * 0.125f);
                    else {
                        if (bj == 0) { if (wc < 2) *(u32x4*)(K + row * 64 + 32 * wc + 8 * fq) = pack8(n0, n1); else *(u32x4*)(V + row * 64 + 32 * (wc - 2) + 8 * fq) = pack8(v0, v1); }
                        else { if (wc < 2) *(u32x4*)(KI + row * 64 + 32 * wc + 8 * fq) = pack8(n0, n1); else if (wc == 2 && fq == 0) *(pg8::f32x4*)(WI + row * 4) = v0 * 0.5f; }
                    }
                }
            }
    }
};
struct EpiRes {
    static constexpr bool PERM = true, AFTER_DRAIN = false;
    const float* res; float* out; bf16_t* xb; float* ss;
    __device__ __forceinline__ void operator()(const pg8::f32x4 (&acc)[2][2][4][2], const pg8::Unit& u, int wr, int wc, int fr, int fq) const {
#pragma unroll
        for (int ai = 0; ai < 2; ++ai)
#pragma unroll
            for (int m = 0; m < 4; ++m) { const size_t row = (size_t)(u.pm * 256 + ai * 128 + wr * 64 + m * 16 + fr); float q = 0.f;
#pragma unroll
                for (int bj = 0; bj < 2; ++bj) { const size_t off = row * DM + u.pn * 256 + 128 * bj + 32 * wc + 8 * fq;
                    const pg8::f32x4 v0 = acc[ai][bj][m][0] + *(const pg8::f32x4*)(res + off), v1 = acc[ai][bj][m][1] + *(const pg8::f32x4*)(res + off + 4);
                    *(pg8::f32x4*)(out + off) = v0; *(pg8::f32x4*)(out + off + 4) = v1;
                    if (xb) *(u32x4*)(xb + off) = pack8(v0, v1);
                    q += (v0[0] * v0[0] + v0[1] * v0[1]) + (v0[2] * v0[2] + v0[3] * v0[3]) + (v1[0] * v1[0] + v1[1] * v1[1]) + (v1[2] * v1[2] + v1[3] * v1[3]); }
                { const int lane_ = fq * 16 + fr; q += shx(q, lane_, 16); q += shx(q, lane_, 32); }
                if (fq == 0) ss[row * 16 + u.pn * 4 + wc] = q; }
    }
};
__device__ __forceinline__ float rstd_from_ss(const float* ss, size_t row) {
    const pg8::f32x4 a = *(const pg8::f32x4*)(ss + row * 16), b = *(const pg8::f32x4*)(ss + row * 16 + 4), c = *(const pg8::f32x4*)(ss + row * 16 + 8), d = *(const pg8::f32x4*)(ss + row * 16 + 12);
    const float s = ((a[0] + a[1]) + (a[2] + a[3])) + ((b[0] + b[1]) + (b[2] + b[3])) + ((c[0] + c[1]) + (c[2] + c[3])) + ((d[0] + d[1]) + (d[2] + d[3]));
    return 1.f / sqrtf(s * (1.f / DM) + EPS);
}
struct EpiScale {
    static constexpr bool PERM = true, AFTER_DRAIN = false;
    const float* ss; bf16_t* O; int ldc; float scale;
    __device__ __forceinline__ void operator()(const pg8::f32x4 (&acc)[2][2][4][2], const pg8::Unit& u, int wr, int wc, int fr, int fq) const {
#pragma unroll
        for (int ai = 0; ai < 2; ++ai)
#pragma unroll
            for (int m = 0; m < 4; ++m) { const size_t row = (size_t)(u.pm * 256 + ai * 128 + wr * 64 + m * 16 + fr); const float r = rstd_from_ss(ss, row) * scale;
#pragma unroll
                for (int bj = 0; bj < 2; ++bj) *(u32x4*)(O + row * ldc + u.pn * 256 + 128 * bj + 32 * wc + 8 * fq) = pack8(acc[ai][bj][m][0] * r, acc[ai][bj][m][1] * r); }
    }
};
struct EpiGateUp {
    static constexpr bool PERM = true, AFTER_DRAIN = false;
    const float* ss; bf16_t* Gb; bf16_t* Ub;
    __device__ __forceinline__ void operator()(const pg8::f32x4 (&acc)[2][2][4][2], const pg8::Unit& u, int wr, int wc, int fr, int fq) const {
        const int ch = 128 * u.pn + 32 * wc + 8 * fq;
#pragma unroll
        for (int ai = 0; ai < 2; ++ai)
#pragma unroll
            for (int m = 0; m < 4; ++m) { const size_t row = (size_t)(u.pm * 256 + ai * 128 + wr * 64 + m * 16 + fr); const float r = rstd_from_ss(ss, row);
                *(u32x4*)(Gb + row * DFF + ch) = pack8(acc[ai][0][m][0] * r, acc[ai][0][m][1] * r);
                *(u32x4*)(Ub + row * DFF + ch) = pack8(acc[ai][1][m][0] * r, acc[ai][1][m][1] * r); }
    }
};
struct EpiGateUpAct {
    static constexpr bool PERM = true, AFTER_DRAIN = false;
    const float* ss; bf16_t* H; const float* cw; const float* cb; float* topg; float* topu; float* botg; LAS unsigned char* xch;
    __device__ __forceinline__ void operator()(const pg8::f32x4 (&acc)[2][2][4][2], const pg8::Unit& u, int wr, int wc, int fr, int fq) const {
        const int lane = fq * 16 + fr, chl = 32 * wc + 8 * fq, ch = 128 * u.pn + chl;
        const int l1 = (fq * 16 + ((fr + 15) & 15)) << 2, l2 = (fq * 16 + ((fr + 14) & 15)) << 2;
        (void)lane;
#pragma unroll
        for (int ai = 0; ai < 2; ++ai) { const size_t row = (size_t)(u.pm * 256 + ai * 128 + wr * 64 + 48 + fr); const float r = rstd_from_ss(ss, row);
            if (fr >= 14) { LAS float* p = (LAS float*)xch + ((2 * ai + wr) * 2 + (fr - 14)) * 128 + chl;
                *(LAS pg8::f32x4*)p = acc[ai][0][3][0] * r; *(LAS pg8::f32x4*)(p + 4) = acc[ai][0][3][1] * r; } }
        asm volatile("s_waitcnt lgkmcnt(0)" ::: "memory"); __builtin_amdgcn_s_barrier(); asm volatile("" ::: "memory");
        pg8::f32x4 wb[2], w2[2], w1[2], w0[2];
#pragma unroll
        for (int hq = 0; hq < 2; ++hq) { wb[hq] = *(const pg8::f32x4*)(cb + ch + 4 * hq); w2[hq] = *(const pg8::f32x4*)(cw + 2 * DFF + ch + 4 * hq); w1[hq] = *(const pg8::f32x4*)(cw + DFF + ch + 4 * hq); w0[hq] = *(const pg8::f32x4*)(cw + ch + 4 * hq); }
#pragma unroll
        for (int ai = 0; ai < 2; ++ai) {
            const int blk = 2 * ai + wr;
            pg8::f32x4 pv[2] = {{0.f, 0.f, 0.f, 0.f}, {0.f, 0.f, 0.f, 0.f}};
            if (blk > 0 && fr >= 14) { const LAS float* p = (const LAS float*)xch + ((blk - 1) * 2 + (fr - 14)) * 128 + chl; pv[0] = *(const LAS pg8::f32x4*)p; pv[1] = *(const LAS pg8::f32x4*)(p + 4); }
#pragma unroll
            for (int m = 0; m < 4; ++m) { const size_t row = (size_t)(u.pm * 256 + ai * 128 + wr * 64 + m * 16 + fr); const float r = rstd_from_ss(ss, row);
                pg8::f32x4 g[2], uu[2], hh[2];
#pragma unroll
                for (int hq = 0; hq < 2; ++hq) { g[hq] = acc[ai][0][m][hq] * r; uu[hq] = acc[ai][1][m][hq] * r; }
#pragma unroll
                for (int hq = 0; hq < 2; ++hq)
#pragma unroll
                    for (int k = 0; k < 4; ++k) {
                        const float x1 = (fr == 15) ? pv[hq][k] : g[hq][k], x2 = (fr >= 14) ? pv[hq][k] : g[hq][k];
                        const float p1 = __uint_as_float((unsigned)__builtin_amdgcn_ds_bpermute(l1, (int)__float_as_uint(x1)));
                        const float p2 = __uint_as_float((unsigned)__builtin_amdgcn_ds_bpermute(l2, (int)__float_as_uint(x2)));
                        const float gg = wb[hq][k] + w2[hq][k] * g[hq][k] + w1[hq][k] * p1 + w0[hq][k] * p2;
                        hh[hq][k] = gg / (1.f + __expf(-gg)) * uu[hq][k]; }
                *(u32x4*)(H + row * DFF + ch) = pack8(hh[0], hh[1]);
                if (blk == 0 && m == 0 && fr < 2) { float* tg = topg + ((size_t)u.pm * 2 + fr) * DFF + ch; float* tu = topu + ((size_t)u.pm * 2 + fr) * DFF + ch;
                    *(pg8::f32x4*)tg = g[0]; *(pg8::f32x4*)(tg + 4) = g[1]; *(pg8::f32x4*)tu = uu[0]; *(pg8::f32x4*)(tu + 4) = uu[1]; }
                if (blk == 3 && m == 3 && fr >= 14) { float* bg = botg + ((size_t)u.pm * 2 + (fr - 14)) * DFF + ch; *(pg8::f32x4*)bg = g[0]; *(pg8::f32x4*)(bg + 4) = g[1]; }
                pv[0] = g[0]; pv[1] = g[1];
            }
        }
    }
};
typedef short bf16x8v __attribute__((ext_vector_type(8)));
constexpr int CA_STRIDE = 528;
__device__ __forceinline__ void cross_attn_unit(LAS unsigned char* lds, int b, int h, int qb, const bf16_t* QC, const bf16_t* KC, const bf16_t* VT, bf16_t* OC, int tid, int lane, int wave) {
    const int q16 = lane & 15, g = lane >> 4;
    const size_t row0 = (size_t)b * SEQ + (size_t)qb * 256 + wave * 32;
    asm volatile("" : "+v"(tid));
    { const bf16_t* src = KC + ((size_t)b * NMEM + (tid >> 5)) * DM + h * 256 + (tid & 31) * 8; LAS unsigned char* dst = lds + (tid >> 5) * CA_STRIDE + (tid & 31) * 16;
#pragma unroll
      for (int i = 0; i < 16; ++i) { const u32x4 v = *(const u32x4*)(src + (size_t)i * 16 * DM); *(LAS u32x4*)(dst + i * 16 * CA_STRIDE) = v; } }
    __syncthreads();
    f32x4 S[2][16];
#pragma unroll
    for (int st = 0; st < 2; ++st)
#pragma unroll
        for (int kt = 0; kt < 16; ++kt) S[st][kt] = (f32x4){0.f, 0.f, 0.f, 0.f};
#pragma unroll 1
    for (int kh = 0; kh < 2; ++kh) {
        bf16x8v qf[2][4];
#pragma unroll
        for (int st = 0; st < 2; ++st)
#pragma unroll
            for (int ks = 0; ks < 4; ++ks) qf[st][ks] = *(const bf16x8v*)(QC + (row0 + st * 16 + q16) * DM + h * 256 + kh * 128 + ks * 32 + g * 8);
        const LAS unsigned char* kb = lds + q16 * CA_STRIDE + kh * 256 + g * 16;
#pragma unroll
        for (int kt = 0; kt < 16; ++kt)
#pragma unroll
            for (int ks = 0; ks < 4; ++ks) { const bf16x8v a = *(const LAS bf16x8v*)(kb + kt * 16 * CA_STRIDE + ks * 64);
                S[0][kt] = __builtin_amdgcn_mfma_f32_16x16x32_bf16(a, qf[0][ks], S[0][kt], 0, 0, 0);
                S[1][kt] = __builtin_amdgcn_mfma_f32_16x16x32_bf16(a, qf[1][ks], S[1][kt], 0, 0, 0); }
    }
    const float c2 = 0.0625f * 1.4426950408889634f;
    float linv[2]; bf16x8v P[2][8];
#pragma unroll
    for (int st = 0; st < 2; ++st) {
        float m = -INFINITY;
#pragma unroll
        for (int kt = 0; kt < 16; ++kt) m = fmaxf(fmaxf(fmaxf(S[st][kt][0], S[st][kt][1]), fmaxf(S[st][kt][2], S[st][kt][3])), m);
        m = fmaxf(m, shx(m, lane, 16)); m = fmaxf(m, shx(m, lane, 32));
        const float mc = m * c2; float l = 0.f;
#pragma unroll
        for (int kt = 0; kt < 16; ++kt)
#pragma unroll
            for (int r = 0; r < 4; ++r) { const float p = __builtin_amdgcn_exp2f(S[st][kt][r] * c2 - mc); S[st][kt][r] = p; l += p; }
        l += shx(l, lane, 16); l += shx(l, lane, 32); linv[st] = 1.f / l;
#pragma unroll
        for (int c = 0; c < 8; ++c) { bf16x8v pk;
#pragma unroll
            for (int j = 0; j < 4; ++j) { pk[j] = (short)f2bf(S[st][2 * c][j]); pk[4 + j] = (short)f2bf(S[st][2 * c + 1][j]); }
            P[st][c] = pk; }
    }
    __syncthreads();
    { int tid2 = tid; asm volatile("" : "+v"(tid2));
      const bf16_t* src = VT + (size_t)(h * 256 + (tid2 >> 5)) * MMEM + b * NMEM + (tid2 & 31) * 8; LAS unsigned char* dst = lds + (tid2 >> 5) * CA_STRIDE + (tid2 & 31) * 16;
#pragma unroll
      for (int i = 0; i < 16; ++i) { const u32x4 v = *(const u32x4*)(src + (size_t)i * 16 * MMEM); *(LAS u32x4*)(dst + i * 16 * CA_STRIDE) = v; } }
    __syncthreads();
#pragma unroll 1
    for (int dh = 0; dh < 2; ++dh) {
        f32x4 O[2][8];
#pragma unroll
        for (int st = 0; st < 2; ++st)
#pragma unroll
            for (int dt = 0; dt < 8; ++dt) O[st][dt] = (f32x4){0.f, 0.f, 0.f, 0.f};
        const LAS unsigned char* pb = lds + (dh * 128 + q16) * CA_STRIDE + g * 8;
#pragma unroll
        for (int dt = 0; dt < 8; ++dt)
#pragma unroll
            for (int c = 0; c < 8; ++c) { const LAS unsigned char* p = pb + dt * 16 * CA_STRIDE + c * 64;
                const u32x2 lo = *(const LAS u32x2*)p, hi = *(const LAS u32x2*)(p + 32);
                const u32x4 av = (u32x4){lo.x, lo.y, hi.x, hi.y}; const bf16x8v a = __builtin_bit_cast(bf16x8v, av);
                O[0][dt] = __builtin_amdgcn_mfma_f32_16x16x32_bf16(a, P[0][c], O[0][dt], 0, 0, 0);
                O[1][dt] = __builtin_amdgcn_mfma_f32_16x16x32_bf16(a, P[1][c], O[1][dt], 0, 0, 0); }
#pragma unroll
        for (int st = 0; st < 2; ++st)
#pragma unroll
            for (int dt = 0; dt < 8; ++dt) { const f32x4 o = O[st][dt] * linv[st]; u32x2 w;
                w.x = (unsigned)f2bf(o[0]) | ((unsigned)f2bf(o[1]) << 16); w.y = (unsigned)f2bf(o[2]) | ((unsigned)f2bf(o[3]) << 16);
                *(u32x2*)(OC + (row0 + st * 16 + q16) * DM + h * 256 + dh * 128 + dt * 16 + g * 4) = w; }
    }
    __syncthreads();
}
typedef float f32x16v __attribute__((ext_vector_type(16)));
constexpr int TK_HIST_OFF = 131072;
__device__ __forceinline__ unsigned code16(float s) {
    const _Float16 hf = (_Float16)s; unsigned u = (unsigned)__builtin_bit_cast(unsigned short, hf);
    if ((u & 0x7fffu) == 0u) u = 0u;
    return (u & 0x8000u) ? (~u & 0xffffu) : (u | 0x8000u);
}
__device__ __forceinline__ unsigned mbcnt64(unsigned long long m) { return __builtin_amdgcn_mbcnt_hi((unsigned)(m >> 32), __builtin_amdgcn_mbcnt_lo((unsigned)m, 0u)); }
__device__ __forceinline__ void lds_hist_add(LAS unsigned char* hrow, unsigned bin) {
    __hip_atomic_fetch_add((LAS unsigned*)(hrow + ((bin >> 1) << 2)), (bin & 1u) ? 0x10000u : 1u, __ATOMIC_RELAXED, __HIP_MEMORY_SCOPE_WORKGROUP);
}
__device__ __forceinline__ void hist_select(const LAS unsigned char* hrow, unsigned target, int lane, unsigned& B, unsigned& above) {
    const u32x2 hv = *(const LAS u32x2*)(hrow + lane * 8);
    const unsigned h0 = hv.x & 0xffffu, h1 = hv.x >> 16, h2 = hv.y & 0xffffu, h3 = hv.y >> 16;
    const unsigned s = (h0 + h1) + (h2 + h3); unsigned S = s;
#pragma unroll
    for (int o = 1; o < 64; o <<= 1) { const unsigned v = (unsigned)__builtin_amdgcn_ds_bpermute(((lane + o) & 63) << 2, (int)S); if (lane + o < 64) S += v; }
    const unsigned long long mk = __ballot(S >= target);
    const int lb = 63 - __builtin_clzll(mk);
    const unsigned A = S - s, c3 = A + h3, c2 = c3 + h2, c1 = c2 + h1;
    const unsigned bsel = (c3 >= target) ? 3u : (c2 >= target) ? 2u : (c1 >= target) ? 1u : 0u;
    const unsigned asel = (c3 >= target) ? A : (c2 >= target) ? c3 : (c1 >= target) ? c2 : c1;
    B = 4u * (unsigned)lb + (unsigned)__builtin_amdgcn_readlane((int)bsel, lb);
    above = (unsigned)__builtin_amdgcn_readlane((int)asel, lb);
}
__device__ __forceinline__ void topk_unit(LAS unsigned char* lds, int b, int j, const bf16_t* QI, const bf16_t* KI, const float* WI, unsigned short* SEL, int tid, int lane, int wave) {
    asm volatile("" : "+v"(tid), "+v"(lane));
    const int t0 = 16 * j, L = t0 + 16, nkt = (L + 31) >> 5;
    const size_t rowbase = (size_t)b * SEQ + t0;
    const int c32 = lane & 31, hi = lane >> 5;
    *(LAS u32x4*)(lds + TK_HIST_OFF + tid * 16) = (u32x4){0u, 0u, 0u, 0u};
    __syncthreads();
    {
        bf16x8v qa[2][4]; f32x4 wq[2][4];
#pragma unroll
        for (int rt = 0; rt < 2; ++rt) {
#pragma unroll
            for (int ks = 0; ks < 4; ++ks) qa[rt][ks] = *(const bf16x8v*)(QI + (rowbase + 8 * rt + (c32 >> 2)) * 256 + (c32 & 3) * 64 + 16 * ks + 8 * hi);
#pragma unroll
            for (int gq = 0; gq < 4; ++gq) wq[rt][gq] = *(const f32x4*)(WI + (rowbase + 8 * rt + 2 * gq + hi) * 4);
        }
        const bf16_t* kbase = KI + ((size_t)b * SEQ + c32) * 64 + 8 * hi;
        bf16x8v kb[4], kn[4];
        int kt = wave;
        if (kt < nkt) {
#pragma unroll
            for (int ks = 0; ks < 4; ++ks) kb[ks] = *(const bf16x8v*)(kbase + (size_t)kt * 32 * 64 + 16 * ks);
        }
        for (; kt < nkt; kt += 8) {
            const int ktn = (kt + 8 < nkt) ? kt + 8 : kt;
#pragma unroll
            for (int ks = 0; ks < 4; ++ks) kn[ks] = *(const bf16x8v*)(kbase + (size_t)ktn * 32 * 64 + 16 * ks);
            const int key = kt * 32 + c32;
#pragma unroll
            for (int rt = 0; rt < 2; ++rt) {
                f32x16v c = {0.f, 0.f, 0.f, 0.f, 0.f, 0.f, 0.f, 0.f, 0.f, 0.f, 0.f, 0.f, 0.f, 0.f, 0.f, 0.f};
#pragma unroll
                for (int ks = 0; ks < 4; ++ks) c = __builtin_amdgcn_mfma_f32_32x32x16_bf16(qa[rt][ks], kb[ks], c, 0, 0, 0);
#pragma unroll
                for (int gq = 0; gq < 4; ++gq) {
                    const f32x4 w = wq[rt][gq];
                    const float sc = w[0] * fmaxf(c[4 * gq + 0], 0.f) + w[1] * fmaxf(c[4 * gq + 1], 0.f) + w[2] * fmaxf(c[4 * gq + 2], 0.f) + w[3] * fmaxf(c[4 * gq + 3], 0.f);
                    const int q = 8 * rt + 2 * gq + hi; const unsigned code = code16(sc);
                    *(LAS unsigned short*)(lds + q * 8192 + key * 2) = (unsigned short)code;
                    if (key <= t0 + q) lds_hist_add(lds + TK_HIST_OFF + q * 512, code >> 8);
                }
            }
#pragma unroll
            for (int ks = 0; ks < 4; ++ks) kb[ks] = kn[ks];
        }
    }
    __syncthreads();
#pragma unroll 1
    for (int qq = 0; qq < 2; ++qq) {
        const int q = 2 * wave + qq, t = t0 + q, n = t + 1;
        unsigned short* sel = SEL + (rowbase + q) * TOPK;
        if (n <= TOPK) {
#pragma unroll
            for (int i = 0; i < 4; ++i) { const int s = lane + 64 * i; if (s < n) sel[s] = (unsigned short)s; }
            continue;
        }
        const int nch = (n + 127) >> 7;
        LAS unsigned char* hrow = lds + TK_HIST_OFF + q * 512;
        const LAS unsigned* row = (const LAS unsigned*)(lds + q * 8192) + lane;
        unsigned B, above;
        hist_select(hrow, (unsigned)TOPK, lane, B, above);
        *(LAS u32x2*)(hrow + lane * 8) = (u32x2){0u, 0u};
        asm volatile("s_waitcnt lgkmcnt(0)" ::: "memory");
#pragma unroll 4
        for (int c = 0; c < nch; ++c) { const unsigned v = row[64 * c]; const int i0 = 128 * c + 2 * lane;
            const unsigned lo = v & 0xffffu, hi16 = v >> 16;
            if (i0 <= t && (lo >> 8) == B) lds_hist_add(hrow, lo & 255u);
            if (i0 + 1 <= t && (hi16 >> 8) == B) lds_hist_add(hrow, hi16 & 255u); }
        asm volatile("s_waitcnt lgkmcnt(0)" ::: "memory");
        unsigned b2, above2;
        hist_select(hrow, (unsigned)TOPK - above, lane, b2, above2);
        const unsigned T = (B << 8) | b2, cgt = above + above2, need = (unsigned)TOPK - cgt;
        unsigned eqrun = 0u, selrun = 0u;
#pragma unroll 2
        for (int c = 0; c < nch; ++c) { const unsigned v = row[64 * c]; const int i0 = 128 * c + 2 * lane;
            const unsigned lo = (i0 <= t) ? (v & 0xffffu) : 0u, hi16 = (i0 + 1 <= t) ? (v >> 16) : 0u;
            const bool glo = lo > T, ghi = hi16 > T;
            const unsigned long long mglo = __ballot(glo), mghi = __ballot(ghi);
            const unsigned plo = selrun + mbcnt64(mglo), phi = selrun + (unsigned)__popcll(mglo) + mbcnt64(mghi);
            if (glo) sel[plo] = (unsigned short)i0;
            if (ghi) sel[phi] = (unsigned short)(i0 + 1);
            selrun += (unsigned)__popcll(mglo) + (unsigned)__popcll(mghi);
            const bool elo = lo == T, ehi = hi16 == T;
            const unsigned long long melo = __ballot(elo), mehi = __ballot(ehi);
            if ((melo | mehi) != 0ull) {
                const unsigned rlo = eqrun + mbcnt64(melo) + mbcnt64(mehi), rhi = rlo + (elo ? 1u : 0u);
                if (elo && rlo < need) sel[cgt + rlo] = (unsigned short)i0;
                if (ehi && rhi < need) sel[cgt + rhi] = (unsigned short)(i0 + 1);
                eqrun += (unsigned)__popcll(melo) + (unsigned)__popcll(mehi);
            }
        }
    }
    __syncthreads();
}
__device__ __forceinline__ void topk_phase(LAS unsigned char* lds, int G, int vcu, const bf16_t* QI, const bf16_t* KI, const float* WI, unsigned short* SEL, int tid, int lane, int wave) {
    if (G == 256) {
        const int b = vcu >> 5, i = vcu & 31;
#pragma unroll 1
        for (int k = 0; k < 8; ++k) { const int j = 64 * (k >> 1) + ((k & 1) ? 63 - i : i); topk_unit(lds, b, j, QI, KI, WI, SEL, tid, lane, wave); }
    } else {
#pragma unroll 1
        for (int u = vcu; u < BATCH * 256; u += G) topk_unit(lds, u >> 8, u & 255, QI, KI, WI, SEL, tid, lane, wave);
    }
}
typedef short v4i16_t __attribute__((ext_vector_type(4)));
constexpr int SV_STRIDE = 160, SV_TILE_BYTES = 64 * SV_STRIDE, SV_WAVE_BYTES = SV_TILE_BYTES + 1024;
__device__ __forceinline__ v4i16_t tr_read16(const LAS unsigned char* p) { return __builtin_amdgcn_ds_read_tr16_b64_v4i16((LAS v4i16_t*)p); }
#define SP_FENCE() asm volatile("" ::: "memory")
__device__ __forceinline__ void sparse_attn_phase(LAS unsigned char* lds, int G, int vcu, const bf16_t* Q, const bf16_t* Kb, const bf16_t* Vb, const unsigned short* SEL, bf16_t* MIX, int lane, int wave) {
    asm volatile("" : "+v"(lane));
    LAS unsigned char* wl = lds + wave * SV_WAVE_BYTES;
    const int q16 = lane & 15, g = lane >> 4;
    const int nq = (G == 256) ? 16 : (MTOK - (vcu * 8 + wave) + G * 8 - 1) / (G * 8);
    const int r_first = (G == 256) ? (vcu >> 5) * SEQ + (vcu & 31) * 8 + wave : vcu * 8 + wave, r_step = (G == 256) ? 256 : G * 8;
    u32x2 selv = (u32x2){0u, 0u};
    if (nq > 0) selv = *(const u32x2*)(SEL + (size_t)r_first * TOPK + 4 * lane);
    LAS unsigned char* wdst = wl + (lane >> 3) * SV_STRIDE + (lane & 7) * 16;
    const LAS unsigned char* rsrc = wl + (4 * g + (q16 >> 2)) * SV_STRIDE + (q16 & 3) * 8;
    const float c2 = 0.125f * 1.4426950408889634f;
#pragma unroll 1
    for (int k = 0; k < nq; ++k) {
        const size_t row = (size_t)r_first + (size_t)k * r_step; const int b = (int)(row / SEQ), t = (int)(row % SEQ);
        const int n = (t + 1 < TOPK) ? t + 1 : TOPK;
        LAS unsigned char* ib = wl + SV_TILE_BYTES + (k & 1) * 512;
        *(LAS u32x2*)(ib + lane * 8) = selv;
        if (k + 1 < nq) selv = *(const u32x2*)(SEL + (row + r_step) * TOPK + 4 * lane);
        bf16x8v qf[2];
#pragma unroll
        for (int ks = 0; ks < 2; ++ks) { u32x4 v = (u32x4){0u, 0u, 0u, 0u}; if (q16 < 8) v = *(const u32x4*)(Q + row * 512 + q16 * 64 + ks * 32 + g * 8); qf[ks] = __builtin_bit_cast(bf16x8v, v); }
        f32x4 S[16];
        const bf16_t* kbat = Kb + (size_t)b * SEQ * 64 + g * 8;
        const bf16_t* vbat = Vb + (size_t)b * SEQ * 64 + (lane & 7) * 8;
#pragma unroll
        for (int kh = 0; kh < 2; ++kh) {
            bf16x8v kf[8][2];
#pragma unroll
            for (int i = 0; i < 8; ++i) { const int slot = 128 * kh + 16 * i + q16; unsigned idx = *(const LAS unsigned short*)(ib + slot * 2); if (slot >= n) idx = 0u;
#pragma unroll
                for (int ks = 0; ks < 2; ++ks) kf[i][ks] = *(const bf16x8v*)(kbat + (size_t)idx * 64 + ks * 32); }
            SP_FENCE();
#pragma unroll
            for (int i = 0; i < 8; ++i) { f32x4 c = (f32x4){0.f, 0.f, 0.f, 0.f};
                c = __builtin_amdgcn_mfma_f32_16x16x32_bf16(kf[i][0], qf[0], c, 0, 0, 0);
                c = __builtin_amdgcn_mfma_f32_16x16x32_bf16(kf[i][1], qf[1], c, 0, 0, 0); S[8 * kh + i] = c; }
            SP_FENCE();
        }
        u32x4 vv[8];
#pragma unroll
        for (int i = 0; i < 8; ++i) { const int slot = (lane >> 3) + 8 * i; unsigned idx = *(const LAS unsigned short*)(ib + slot * 2); if (slot >= n) idx = 0u; vv[i] = *(const u32x4*)(vbat + (size_t)idx * 64); }
        SP_FENCE();
        float m = -INFINITY;
#pragma unroll
        for (int kt = 0; kt < 16; ++kt)
#pragma unroll
            for (int r = 0; r < 4; ++r) { if (16 * kt + 4 * g + r >= n) S[kt][r] = -INFINITY; m = fmaxf(m, S[kt][r]); }
        m = fmaxf(m, shx(m, lane, 16)); m = fmaxf(m, shx(m, lane, 32));
        const float mc = m * c2; float l = 0.f;
#pragma unroll
        for (int kt = 0; kt < 16; ++kt)
#pragma unroll
            for (int r = 0; r < 4; ++r) { const float p = __builtin_amdgcn_exp2f(S[kt][r] * c2 - mc); S[kt][r] = p; l += p; }
        l += shx(l, lane, 16); l += shx(l, lane, 32);
        const float linv = 1.f / l;
        bf16x8v P[8];
#pragma unroll
        for (int c = 0; c < 8; ++c) { u32x4 pk; pk.x = pg8::cvt_pk_bf16(S[2 * c][0], S[2 * c][1]); pk.y = pg8::cvt_pk_bf16(S[2 * c][2], S[2 * c][3]); pk.z = pg8::cvt_pk_bf16(S[2 * c + 1][0], S[2 * c + 1][1]); pk.w = pg8::cvt_pk_bf16(S[2 * c + 1][2], S[2 * c + 1][3]);
            P[c] = __builtin_bit_cast(bf16x8v, pk); }
        f32x4 O[4];
#pragma unroll
        for (int dt = 0; dt < 4; ++dt) O[dt] = (f32x4){0.f, 0.f, 0.f, 0.f};
#pragma unroll
        for (int cc = 0; cc < 4; ++cc) {
#pragma unroll
            for (int i = 0; i < 8; ++i) *(LAS u32x4*)(wdst + i * 8 * SV_STRIDE) = vv[i];
            SP_FENCE();
            if (cc < 3) {
#pragma unroll
                for (int i = 0; i < 8; ++i) { const int slot = 64 * (cc + 1) + (lane >> 3) + 8 * i; unsigned idx = *(const LAS unsigned short*)(ib + slot * 2); if (slot >= n) idx = 0u; vv[i] = *(const u32x4*)(vbat + (size_t)idx * 64); }
            }
            asm volatile("s_waitcnt lgkmcnt(0)" ::: "memory");
#pragma unroll
            for (int c2i = 0; c2i < 2; ++c2i)
#pragma unroll
                for (int dt = 0; dt < 4; ++dt) { const LAS unsigned char* p = rsrc + c2i * 32 * SV_STRIDE + dt * 32;
                    const v4i16_t lo = tr_read16(p), hi = tr_read16(p + 16 * SV_STRIDE);
                    const bf16x8v a = (bf16x8v){lo[0], lo[1], lo[2], lo[3], hi[0], hi[1], hi[2], hi[3]};
                    O[dt] = __builtin_amdgcn_mfma_f32_16x16x32_bf16(a, P[2 * cc + c2i], O[dt], 0, 0, 0); }
            asm volatile("s_waitcnt lgkmcnt(0)" ::: "memory");
        }
        if (q16 < 8) {
#pragma unroll
            for (int dt = 0; dt < 4; ++dt) { const f32x4 o = O[dt] * linv; u32x2 w;
                w.x = pg8::cvt_pk_bf16(o[0], o[1]); w.y = pg8::cvt_pk_bf16(o[2], o[3]);
                *(u32x2*)(MIX + row * DM + q16 * 64 + dt * 16 + g * 4) = w; }
        }
    }
    __syncthreads();
}
__device__ __forceinline__ void convb_phase(LAS unsigned char* lds, int G, int vcu, const bf16_t* U, const float* __restrict__ cw, const float* __restrict__ cb, const float* __restrict__ lng, const float* __restrict__ lnb, bf16_t* MIX, int tid, int lane, int wave) {
    asm volatile("" : "+v"(tid), "+v"(lane));
    typedef float f32x2v __attribute__((ext_vector_type(2)));
    const int cp = tid & 255, th = tid >> 8;
    f32x2v w[31];
#pragma unroll
    for (int j = 0; j < 31; ++j) w[j] = *(const f32x2v*)(cw + j * 512 + 2 * cp);
    const f32x2v bias = *(const f32x2v*)(cb + 2 * cp), gam = *(const f32x2v*)(lng + 2 * cp), bet = *(const f32x2v*)(lnb + 2 * cp);
    LAS float* red = (LAS float*)(lds + 65536);
#pragma unroll 1
    for (int tile = vcu; tile < MTOK / 32; tile += G) {
        const int row0 = tile * 32, t0 = row0 & (SEQ - 1);
        for (int i = tid; i < 62 * 64; i += 512) { const int r = i >> 6, ch = i & 63; u32x4 v = (u32x4){0u, 0u, 0u, 0u};
            if (t0 - 30 + r >= 0) v = *(const u32x4*)(U + (size_t)(row0 - 30 + r) * 512 + ch * 8);
            *(LAS u32x4*)(lds + r * 1024 + ch * 16) = v; }
        __syncthreads();
        f32x2v y[2][8];
#pragma unroll
        for (int k = 0; k < 2; ++k) {
            const int tg = th + 2 * k;
            f32x2v acc[8];
#pragma unroll
            for (int o = 0; o < 8; ++o) acc[o] = bias;
            const LAS unsigned* wp = (const LAS unsigned*)(lds + tg * 8 * 1024) + cp;
#pragma unroll
            for (int j = 0; j < 38; ++j) { const unsigned uu = wp[j * 256]; const f32x2v uv = (f32x2v){__uint_as_float(uu << 16), __uint_as_float(uu & 0xffff0000u)};
#pragma unroll
                for (int o = 0; o < 8; ++o) { const int tap = j - o; if (tap >= 0 && tap < 31) acc[o] += w[tap] * uv; } }
#pragma unroll
            for (int o = 0; o < 8; ++o) { y[k][o] = acc[o];
                float s = acc[o].x + acc[o].y, q = acc[o].x * acc[o].x + acc[o].y * acc[o].y;
                s = wave_sum_l(s, lane); q = wave_sum_l(q, lane);
                if (lane == 0) { red[((tg * 8 + o) * 4 + (wave & 3)) * 2] = s; red[((tg * 8 + o) * 4 + (wave & 3)) * 2 + 1] = q; } }
        }
        __syncthreads();
#pragma unroll
        for (int k = 0; k < 2; ++k) {
            const int tg = th + 2 * k;
#pragma unroll
            for (int o = 0; o < 8; ++o) { const int tl = tg * 8 + o;
                const f32x4 ra = *(const LAS f32x4*)(red + tl * 8), rb = *(const LAS f32x4*)(red + tl * 8 + 4);
                const float mu = ((ra[0] + ra[2]) + (rb[0] + rb[2])) * (1.f / 512.f), ex2 = ((ra[1] + ra[3]) + (rb[1] + rb[3])) * (1.f / 512.f);
                const float rstd = 1.f / sqrtf(fmaxf(ex2 - mu * mu, 0.f) + EPS);
                const float v0 = (y[k][o].x - mu) * rstd * gam.x + bet.x, v1 = (y[k][o].y - mu) * rstd * gam.y + bet.y;
                *(unsigned*)(MIX + (size_t)(row0 + tl) * DM + 512 + 2 * cp) = (unsigned)f2bf(silu_f(v0)) | ((unsigned)f2bf(silu_f(v1)) << 16); }
        }
        __syncthreads();
    }
}

__device__ __forceinline__ int wt_dst_row(int mode, int c) {
    if (mode == 0) return c;
    if (mode == 2) return 256 * (c >> 7) + (c & 127);
    if (mode == 3) return 256 * (c >> 7) + 128 + (c & 127);
    if (c < 512) return (c & ~63) + dperm(c & 63);
    if (c < 576) return 512 + dperm(c - 512);
    if (c < 640) return c;
    if (c < 896) return 768 + ((c - 640) & ~63) + dperm((c - 640) & 63);
    if (c < 960) return 640 + dperm(c - 896);
    if (c < 964) return 704 + (c - 960);
    if (c < 1476) { const int j = c - 964; return 1024 + 256 * (j >> 7) + (j & 127); }
    { const int j = c - 1476; return 1024 + 256 * (j >> 7) + 128 + (j & 127); }
}
__device__ __forceinline__ void wt_body(LAS unsigned char* sm, int vb, int tid, const float* __restrict__ W, int K, int N, bf16_t* WT, const float* __restrict__ gain, int mode) {
    LAS float* t = (LAS float*)sm;
    const int nbx = (N + 31) / 32; const int k0 = (vb / nbx) * 32, n0 = (vb % nbx) * 32, tx = tid & 31, ty = tid >> 5;
    for (int i = ty; i < 32; i += 8) { const int k = k0 + i, n = n0 + tx; float v = 0.f; if (k < K && n < N) { v = W[(size_t)k * N + n]; if (gain) v *= gain[k]; } t[i * 33 + tx] = v; }
    __syncthreads();
    for (int i = ty; i < 32; i += 8) { const int n = n0 + i, k = k0 + tx; if (n < N && k < K) WT[(size_t)wt_dst_row(mode, n) * K + k] = f2bf(t[tx * 33 + i]); }
    __syncthreads();
}
__device__ __forceinline__ void rmsnorm_bf16_row(const float* x, const float* __restrict__ g, bf16_t* out, int row, int lane) {
    const f32x4* xr = (const f32x4*)(x + (size_t)row * DM) + lane; const f32x4* gr = (const f32x4*)g + lane;
    f32x4 v[4]; float s = 0.f;
#pragma unroll
    for (int j = 0; j < 4; ++j) { v[j] = xr[64 * j]; s += (v[j].x * v[j].x + v[j].y * v[j].y) + (v[j].z * v[j].z + v[j].w * v[j].w); }
    const float rstd = 1.f / sqrtf(wave_sum_l(s, lane) * (1.f / DM) + EPS);
    u32x2* o = (u32x2*)(out + (size_t)row * DM) + lane;
#pragma unroll
    for (int j = 0; j < 4; ++j) { const f32x4 gg = gr[64 * j]; u32x2 w;
        w.x = (unsigned)f2bf(v[j].x * rstd * gg.x) | ((unsigned)f2bf(v[j].y * rstd * gg.y) << 16);
        w.y = (unsigned)f2bf(v[j].z * rstd * gg.z) | ((unsigned)f2bf(v[j].w * rstd * gg.w) << 16); o[64 * j] = w; }
}
__device__ __forceinline__ void rmsnorm_f32_row(float* x, const float* __restrict__ g, int row, int lane) {
    f32x4* xr = (f32x4*)(x + (size_t)row * DM) + lane; const f32x4* gr = (const f32x4*)g + lane;
    f32x4 v[4]; float s = 0.f;
#pragma unroll
    for (int j = 0; j < 4; ++j) { v[j] = xr[64 * j]; s += (v[j].x * v[j].x + v[j].y * v[j].y) + (v[j].z * v[j].z + v[j].w * v[j].w); }
    const float rstd = 1.f / sqrtf(wave_sum_l(s, lane) * (1.f / DM) + EPS);
#pragma unroll
    for (int j = 0; j < 4; ++j) { const f32x4 gg = gr[64 * j]; xr[64 * j] = v[j] * rstd * gg; }
}

constexpr size_t MiB = 1u << 20;
constexpr int LDS_USER = 139264, LDSCTL_OFF = LDS_USER, MISC_OFF = LDSCTL_OFF + 320, LDS_BYTES = 147456;
constexpr size_t WS_CTL = 476 * MiB, CTL_ZERO_BYTES = 1 * MiB; constexpr int CW_BAR = 4096;
constexpr int NGU = 2 * DFF;
struct Args { const float* in[23]; float* out; unsigned char* ws; };
static_assert(sizeof(Args) == 25 * 8, "Args has no padding");

__global__ void __launch_bounds__(512, 2) mega_k(Args a) {
    extern __shared__ __attribute__((aligned(16))) unsigned char lds_raw[];
    LAS unsigned char* lds = (LAS unsigned char*)lds_raw;
    const int wave = __builtin_amdgcn_readfirstlane(threadIdx.x >> 6);
#define PH_IDS() int lane; asm volatile("v_mbcnt_lo_u32_b32 %0, -1, 0\n\tv_mbcnt_hi_u32_b32 %0, -1, %0" : "=v"(lane)); const int tid = wave * 64 + lane, half = wave >> 2, htid = tid & 255; LAS unsigned char* hsm = lds + half * 65536; (void)htid; (void)hsm
    const int G = gridDim.x, bx = blockIdx.x; const int vcu = (G % 8 == 0) ? (bx % 8) * (G / 8) + bx / 8 : bx;
    const float* x = a.in[0]; const float* mem = a.in[1]; const int* positions = (const int*)a.in[2];
    const float* g_mix = a.in[3]; const float* w_in = a.in[4]; const float* w_out = a.in[5];
    const float* conv_b_w = a.in[6]; const float* conv_b_b = a.in[7]; const float* ln_b_g = a.in[8]; const float* ln_b_b = a.in[9];
    const float* g_cross = a.in[10]; const float* g_mem = a.in[11];
    const float* w_q = a.in[12]; const float* w_k = a.in[13]; const float* w_v = a.in[14]; const float* w_o = a.in[15];
    const float* g_ffn = a.in[16]; const float* w_gate = a.in[17]; const float* w_up = a.in[18];
    const float* ffn_cw = a.in[19]; const float* ffn_cb = a.in[20]; const float* w_down = a.in[21]; const float* g_final = a.in[22];
    float* out = a.out; unsigned char* ws = a.ws;
    bf16_t* wt_in = (bf16_t*)(ws + 0 * MiB); bf16_t* wt_out = (bf16_t*)(ws + 4 * MiB);
    bf16_t* wt_q = (bf16_t*)(ws + 6 * MiB), *wt_k = (bf16_t*)(ws + 8 * MiB), *wt_v = (bf16_t*)(ws + 10 * MiB), *wt_o = (bf16_t*)(ws + 12 * MiB);
    bf16_t* wt_gu = (bf16_t*)(ws + 14 * MiB); bf16_t* wt_down = (bf16_t*)(ws + 26 * MiB);
    float* WI = (float*)(ws + 32 * MiB); float* CS = (float*)(ws + 33 * MiB);
    float* SS1 = (float*)(ws + 35 * MiB); float* SS2 = (float*)(ws + 37 * MiB); float* SS3 = (float*)(ws + 39 * MiB);
    bf16_t* MEMN = (bf16_t*)(ws + 41 * MiB), *KC = (bf16_t*)(ws + 45 * MiB), *VC = (bf16_t*)(ws + 49 * MiB);
    bf16_t* XB = (bf16_t*)(ws + 56 * MiB);
    bf16_t* Qb = (bf16_t*)(ws + 120 * MiB); bf16_t* QI = (bf16_t*)(ws + 152 * MiB);
    bf16_t* Kb = (bf16_t*)(ws + 168 * MiB), *Vb = (bf16_t*)(ws + 172 * MiB), *KI = (bf16_t*)(ws + 176 * MiB);
    bf16_t* U = (bf16_t*)(ws + 180 * MiB); unsigned short* SEL = (unsigned short*)(ws + 212 * MiB);
    bf16_t* MIX = (bf16_t*)(ws + 228 * MiB); bf16_t* QC = (bf16_t*)(ws + 292 * MiB); bf16_t* OC = (bf16_t*)(ws + 356 * MiB);
    bf16_t* Hb = (bf16_t*)(ws + 120 * MiB);
    float* TOPG = (float*)(ws + 300 * MiB); float* TOPU = (float*)(ws + 304 * MiB); float* BOTG = (float*)(ws + 308 * MiB);
    unsigned* ctl = (unsigned*)(ws + WS_CTL);

    { PH_IDS(); for (int u = tid; u < (LDS_BYTES - LDSCTL_OFF) / 4; u += 512) ((LAS unsigned*)(lds + LDSCTL_OFF))[u] = 0u; }
    __syncthreads();
    XcdBarrier bar = xcd_barrier_post(ctl + CW_BAR, (volatile LAS unsigned*)(lds + MISC_OFF) + 8);
#define GRID_BAR() xcd_barrier(bar)
#define FOR_VB(nvb) for (int vb = 2 * bx + half; vb < (nvb); vb += 2 * G)
#define GEMMX(EPI, EINIT, Aptr, Bptr, Mv, Nv, Kv) do { pg8::Gemm g_{Aptr, Bptr, Mv, Nv, Kv}; pg8::StaticOrder S_; S_.init(Mv, Nv, G, bx); EPI E_ EINIT; \
        PH_IDS(); pg8::gemm_phase<EPI, pg8::StaticOrder, true, true>(lds, g_, S_, E_, tid); } while (0)
#define EI(...) {__VA_ARGS__}

    { PH_IDS();
    for (int i = bx * 512 + tid; i < 60 * DM; i += G * 512) wt_in[(size_t)708 * DM + i] = 0;
    FOR_VB(32 * 63) wt_body(hsm, vb, htid, w_in, DM, INC, wt_in, nullptr, 1);
    FOR_VB(32 * 32) wt_body(hsm, vb, htid, w_out, DM, DM, wt_out, nullptr, 0);
    FOR_VB(32 * 32) wt_body(hsm, vb, htid, w_q, DM, DM, wt_q, g_cross, 0);
    FOR_VB(32 * 32) wt_body(hsm, vb, htid, w_k, DM, DM, wt_k, nullptr, 0);
    FOR_VB(32 * 32) wt_body(hsm, vb, htid, w_v, DM, DM, wt_v, nullptr, 0);
    FOR_VB(32 * 32) wt_body(hsm, vb, htid, w_o, DM, DM, wt_o, nullptr, 0);
    FOR_VB(32 * 88) wt_body(hsm, vb, htid, w_gate, DM, DFF, wt_gu, g_ffn, 2);
    FOR_VB(32 * 88) wt_body(hsm, vb, htid, w_up, DM, DFF, wt_gu, g_ffn, 3);
    FOR_VB(88 * 32) wt_body(hsm, vb, htid, w_down, DFF, DM, wt_down, nullptr, 0);
    for (int i = bx * 512 + tid; i < MTOK * 8; i += G * 512) { const int row = i >> 3, k = i & 7;
        const float freq = (float)pow(500000.0, -0.125 * (double)k); const float ang = (float)positions[row] * freq;
        CS[(size_t)row * 16 + k] = (float)cos((double)ang); CS[(size_t)row * 16 + 8 + k] = (float)sin((double)ang); }
    for (int r = bx * 8 + wave; r < MTOK; r += G * 8) rmsnorm_bf16_row(x, g_mix, XB, r, lane);
    for (int r = bx * 8 + wave; r < MMEM; r += G * 8) rmsnorm_bf16_row(mem, g_mem, MEMN, r, lane);
    }
    GRID_BAR();
    GEMMX(EpiIn, EI(CS, Qb, Kb, Vb, QI, KI, U, WI), XB, wt_in, MTOK, INP, DM);
    GEMMX(EpiStore, EI(nullptr, KC, nullptr, DM), MEMN, wt_k, MMEM, DM, DM);
    GEMMX(EpiStore, EI(nullptr, VC, nullptr, MMEM), wt_v, MEMN, DM, MMEM, DM);
    GRID_BAR();
    { PH_IDS(); topk_phase(lds, G, vcu, QI, KI, WI, SEL, tid, lane, wave); }
    { PH_IDS(); convb_phase(lds, G, vcu, U, conv_b_w, conv_b_b, ln_b_g, ln_b_b, MIX, tid, lane, wave); }
    GRID_BAR();
    { PH_IDS(); sparse_attn_phase(lds, G, vcu, Qb, Kb, Vb, SEL, MIX, lane, wave); }
    GRID_BAR();
    GEMMX(EpiRes, EI(x, out, XB, SS1), MIX, wt_out, MTOK, DM, DM);
    GRID_BAR();
    GEMMX(EpiScale, EI(SS1, QC, DM, 1.0f), XB, wt_q, MTOK, DM, DM);
    GRID_BAR();
    { PH_IDS(); const int per = (512 + G - 1) / G; for (int i = 0; i < per; ++i) { const int u = vcu * per + i; if (u < 512) cross_attn_unit(lds, u >> 6, (u >> 4) & 3, u & 15, QC, KC, VC, OC, tid, lane, wave); } }
    GRID_BAR();
    GEMMX(EpiRes, EI(out, out, XB, SS2), OC, wt_o, MTOK, DM, DM);
    GRID_BAR();
    GEMMX(EpiGateUpAct, EI(SS2, Hb, ffn_cw, ffn_cb, TOPG, TOPU, BOTG, lds + 131072), XB, wt_gu, MTOK, NGU, DM);
    GRID_BAR();
    { PH_IDS();
    for (int i = bx * 512 + tid; i < (MTOK / 256) * 2 * DFF; i += G * 512) {
        const int pm = i / (2 * DFF), rem = i - pm * (2 * DFF), j = rem / DFF, c = rem - j * DFF;
        const bool first = (pm & 15) == 0;
        const float gm2 = first ? 0.f : BOTG[((size_t)(pm - 1) * 2 + 0) * DFF + c], gm1 = first ? 0.f : BOTG[((size_t)(pm - 1) * 2 + 1) * DFF + c];
        const float g0 = TOPG[((size_t)pm * 2 + 0) * DFF + c], g1 = TOPG[((size_t)pm * 2 + 1) * DFF + c];
        const float cur = j ? g1 : g0, p1 = j ? g0 : gm1, p2 = j ? gm1 : gm2;
        const float gg = ffn_cb[c] + ffn_cw[2 * DFF + c] * cur + ffn_cw[DFF + c] * p1 + ffn_cw[c] * p2;
        Hb[((size_t)pm * 256 + j) * DFF + c] = f2bf(silu_f(gg) * TOPU[((size_t)pm * 2 + j) * DFF + c]);
    }
    }
    GRID_BAR();
    GEMMX(EpiRes, EI(out, out, nullptr, SS3), Hb, wt_down, MTOK, DM, DFF);
    GRID_BAR();
    { PH_IDS();
    for (int r = bx * 8 + wave; r < MTOK; r += G * 8) {
        const float rs = rstd_from_ss(SS3, (size_t)r);
        f32x4* xr = (f32x4*)(out + (size_t)r * DM) + lane; const f32x4* gr = (const f32x4*)g_final + lane;
#pragma unroll
        for (int j = 0; j < 4; ++j) xr[64 * j] = xr[64 * j] * rs * gr[64 * j];
    }
    }
}

extern "C" void kernel_launch(void* const* d_in, const int* in_sizes, int n_in, void* d_out, int out_size, void* d_ws, size_t ws_size, hipStream_t stream) {
    static int grid = 0;
    if (grid == 0) {
        int dev = 0, cus = 0, per_cu = 0;
        if (hipGetDevice(&dev) != hipSuccess || hipDeviceGetAttribute(&cus, hipDeviceAttributeMultiprocessorCount, dev) != hipSuccess) { fprintf(stderr, "kernel_launch: device query failed\n"); grid = -1; return; }
        if (hipFuncSetAttribute((const void*)mega_k, hipFuncAttributeMaxDynamicSharedMemorySize, LDS_BYTES) != hipSuccess) { fprintf(stderr, "kernel_launch: hipFuncSetAttribute failed\n"); grid = -1; return; }
        if (hipOccupancyMaxActiveBlocksPerMultiprocessor(&per_cu, (const void*)mega_k, 512, LDS_BYTES) != hipSuccess || per_cu < 1) { fprintf(stderr, "kernel_launch: occupancy query says %d\n", per_cu); per_cu = 1; }
        (void)hipGetLastError();
        grid = cus * 1;
        if (n_in != 23 || ws_size < 477 * MiB) { fprintf(stderr, "kernel_launch: unexpected n_in %d / ws %zu\n", n_in, ws_size); grid = -1; return; }
    }
    if (grid < 0) return;
    (void)hipMemsetAsync((char*)d_ws + WS_CTL, 0, CTL_ZERO_BYTES, stream);
    Args a{};
    for (int i = 0; i < 23; ++i) a.in[i] = (const float*)d_in[i];
    a.out = (float*)d_out; a.ws = (unsigned char*)d_ws;
    void* params[] = {&a};
    hipError_t e = hipLaunchCooperativeKernel((const void*)mega_k, dim3(grid), dim3(512), params, LDS_BYTES, stream);
    if (e != hipSuccess) fprintf(stderr, "cooperative launch failed: %s (grid %d)\n", hipGetErrorString(e), grid);
}
```

```cpp
#include <hip/hip_runtime.h>
#include <cstdio>
#include <cstdint>
#include <cmath>
namespace pg8 {
#define PG8_LAS __attribute__((address_space(3)))
typedef unsigned short bf16_t;
typedef short bf16x8 __attribute__((ext_vector_type(8)));
typedef float f32x4 __attribute__((ext_vector_type(4)));
typedef unsigned u32x4 __attribute__((ext_vector_type(4)));
constexpr int BM = 256, BK = 64, HALF = 128, HTB = HALF * BK * 2  , STAGE_BYTES = 8 * HTB, NXCD = 8, WGM = 8;

__host__ __device__ __forceinline__ int lds_byte(int r, int c) { const int st = (r >> 4) * 2 + (c >> 5), rr = r & 15, cc = c & 31, ob = rr * 64 + cc * 2; return st * 1024 + (ob ^ (((ob >> 9) & 1) << 5)); }
__host__ __device__ __forceinline__ void stage_rc(int b, int& R, int& C) { const int st = b / 1024, sb = b % 1024, swz = sb ^ (((sb >> 9) & 1) << 5); R = (st >> 1) * 16 + swz / 64; C = (st & 1) * 32 + (swz % 64) / 2; }
__host__ __device__ __forceinline__ int perm32(int rho) { const int n = rho >> 4, i = rho & 15; return 8 * (i >> 2) + 4 * n + (i & 3); }

struct Unit { int pm, pn; };
struct Gemm { const bf16_t* A; const bf16_t* Bt; int M, N, K; };

struct StaticOrder {
    int nM, nN, nwg, G, c;
    __host__ __device__ void init(int M, int N, int G_, int c_) { nM = M / BM; nN = N / BM; nwg = nM * nN; G = G_; c = c_; }
    __host__ __device__ bool next(int i, Unit& u) const {
        const long L = (long)i * G + c; if (L >= nwg) return false;
        int wgid = (int)L; { const int q = nwg / NXCD, r = nwg % NXCD, xcd = wgid % NXCD, off = wgid / NXCD; wgid = (xcd < r ? xcd * (q + 1) : r * (q + 1) + (xcd - r) * q) + off; }
        const int nig = WGM * nN, gid = wgid / nig, fm = gid * WGM, gsz = (nM - fm) < WGM ? (nM - fm) : WGM;
        u.pm = fm + ((wgid % nig) % gsz); u.pn = (wgid % nig) / gsz; return true;
    }
    __device__ __forceinline__ void a_ready(const Unit&) const {}
    __device__ __forceinline__ void done(const Unit&) const {}
};
__device__ __forceinline__ unsigned cvt_pk_bf16(float lo, float hi) { unsigned r; asm volatile("v_cvt_pk_bf16_f32 %0, %1, %2" : "=v"(r) : "v"(lo), "v"(hi)); return r; }
template <class Epi, class Sched, bool ALIGN_EPI = false, bool SP2 = false>
__device__ __forceinline__ void gemm_phase(PG8_LAS unsigned char* lds, const Gemm g, const Sched& S, const Epi& E, int tid_in) {
    int tid_l = tid_in; asm volatile("" : "+v"(tid_l));
    const int tid = tid_l, wid = __builtin_amdgcn_readfirstlane(tid >> 6), lane = tid & 63, wr = wid >> 2, wc = wid & 3, fr = lane & 15, fq = lane >> 4;
    const int K = g.K, nt = K / BK;
    unsigned voffA[2], voffB[2];
#pragma unroll
    for (int i = 0; i < 2; ++i) { int R, C; stage_rc(tid * 16 + i * 8192, R, C); const int Rb = Epi::PERM ? ((R & ~31) + perm32(R & 31)) : R;
        voffA[i] = (unsigned)(R * K + C) * 2u; voffB[i] = (unsigned)(Rb * K + C) * 2u; }
    const size_t kstep = (size_t)(BK * 2);
    const size_t hstep = (size_t)HALF * K * 2;
    const size_t tstep = 2 * hstep;
    const unsigned ldsw = (unsigned)wid * 1024u;
    const int aoff = lds_byte(wr * 64 + fr, fq * 8), boff = lds_byte(wc * 32 + fr, fq * 8);
#define PG8_SA(b, h) (((b) * 2 + (h)) * HTB)
#define PG8_SB(b, h) ((4 + (b) * 2 + (h)) * HTB)
#define PG8_STAGE(bufoff, gbase, voff) do { _Pragma("unroll") for (int _i = 0; _i < 2; ++_i) \
        __builtin_amdgcn_global_load_lds((const unsigned*)((const char*)(gbase) + (voff)[_i]), (PG8_LAS unsigned*)(lds + (bufoff) + ldsw + _i * 8192), 16, 0, 0); } while (0)
#define PG8_LDA(dst, b, h) do { _Pragma("unroll") for (int m = 0; m < 4; ++m) _Pragma("unroll") for (int k = 0; k < 2; ++k) dst[m][k] = *(const PG8_LAS bf16x8*)(lds + PG8_SA(b, h) + aoff + m * 2048 + k * 1024); } while (0)
#define PG8_LDB(dst, b, h) do { _Pragma("unroll") for (int n = 0; n < 2; ++n) _Pragma("unroll") for (int k = 0; k < 2; ++k) dst[n][k] = *(const PG8_LAS bf16x8*)(lds + PG8_SB(b, h) + boff + n * 2048 + k * 1024); } while (0)
#define PG8_MMA(ai, bj, At, Bt) do { __builtin_amdgcn_s_setprio(1); _Pragma("unroll") for (int m = 0; m < 4; ++m) _Pragma("unroll") for (int n = 0; n < 2; ++n) _Pragma("unroll") for (int k = 0; k < 2; ++k) \
        acc[ai][bj][m][n] = __builtin_amdgcn_mfma_f32_16x16x32_bf16(Bt[n][k], At[m][k], acc[ai][bj][m][n], 0, 0, 0); __builtin_amdgcn_s_setprio(0); } while (0)
#define PG8_WAIT_V(n) asm volatile("s_waitcnt vmcnt(" #n ")" ::: "memory")
#define PG8_WAIT_L(n) asm volatile("s_waitcnt lgkmcnt(" #n ")" ::: "memory")
#define PG8_BAR __builtin_amdgcn_s_barrier()
#define PG8_SCHED __builtin_amdgcn_sched_barrier(0)
    Unit cur, nxt; int ui = 0;
    if (!S.next(0, cur)) return;
    f32x4 acc[2][2][4][2];
#pragma unroll
    for (int a = 0; a < 2; ++a)
#pragma unroll
        for (int b = 0; b < 2; ++b)
#pragma unroll
            for (int m = 0; m < 4; ++m)
#pragma unroll
                for (int n = 0; n < 2; ++n) acc[a][b][m][n] = (f32x4){0.f, 0.f, 0.f, 0.f};
    bf16x8 At[4][2], B0[2][2], B1[2][2];
    const char* cA = (const char*)g.A + (size_t)cur.pm * tstep; const char* cB = (const char*)g.Bt + (size_t)cur.pn * tstep;
    S.a_ready(cur);
    if constexpr (SP2) {
        PG8_STAGE(PG8_SB(0, 0), cB, voffB); PG8_STAGE(PG8_SB(0, 1), cB + hstep, voffB); PG8_STAGE(PG8_SA(0, 0), cA, voffA); PG8_STAGE(PG8_SA(0, 1), cA + hstep, voffA);
        if (wr == 1) PG8_BAR;
        PG8_WAIT_V(2); PG8_BAR;
        PG8_STAGE(PG8_SB(1, 0), cB + kstep, voffB); PG8_STAGE(PG8_SA(1, 0), cA + kstep, voffA); PG8_STAGE(PG8_SB(1, 1), cB + hstep + kstep, voffB);
        PG8_WAIT_V(6); PG8_BAR;
    } else {
        PG8_STAGE(PG8_SB(0, 0), cB, voffB); PG8_STAGE(PG8_SA(0, 0), cA, voffA); PG8_STAGE(PG8_SB(0, 1), cB + hstep, voffB); PG8_STAGE(PG8_SA(0, 1), cA + hstep, voffA);
        if (wr == 1) PG8_BAR;
        PG8_WAIT_V(4); PG8_BAR;
        PG8_STAGE(PG8_SB(1, 0), cB + kstep, voffB); PG8_STAGE(PG8_SA(1, 0), cA + kstep, voffA); PG8_STAGE(PG8_SB(1, 1), cB + hstep + kstep, voffB);
        PG8_WAIT_V(6); PG8_BAR;
    }
    for (;;) {
        const bool has_next = S.next(ui + 1, nxt);
        const char* nA = has_next ? (const char*)g.A + (size_t)nxt.pm * tstep : cA; const char* nB = has_next ? (const char*)g.Bt + (size_t)nxt.pn * tstep : cB;
        for (int t = 0; t < nt; t += 2) {
            const bool last = (t == nt - 2);
            const char* a1 = cA + (size_t)(t + 1) * kstep;
            const char* a2 = last ? nA : cA + (size_t)(t + 2) * kstep; const char* b2 = last ? nB : cB + (size_t)(t + 2) * kstep;
            const char* a3 = a2 + kstep; const char* b3 = b2 + kstep;
            if (last && has_next) S.a_ready(nxt);
            if constexpr (SP2) {
            PG8_LDB(B0, 0, 0); PG8_LDB(B1, 0, 1); PG8_SCHED; PG8_LDA(At, 0, 0); PG8_STAGE(PG8_SA(1, 1), a1 + hstep, voffA);
            PG8_WAIT_V(8); PG8_WAIT_L(0); PG8_BAR; PG8_MMA(0, 0, At, B0); PG8_MMA(0, 1, At, B1); PG8_BAR; PG8_SCHED;
            PG8_LDA(At, 0, 1); PG8_STAGE(PG8_SB(0, 0), b2, voffB); PG8_STAGE(PG8_SB(0, 1), b2 + hstep, voffB); PG8_STAGE(PG8_SA(0, 0), a2, voffA);
            PG8_WAIT_V(8); PG8_WAIT_L(0); PG8_BAR; PG8_MMA(1, 0, At, B0); PG8_MMA(1, 1, At, B1); PG8_BAR; PG8_SCHED;
            PG8_LDB(B0, 1, 0); PG8_LDB(B1, 1, 1); PG8_SCHED; PG8_LDA(At, 1, 0); PG8_STAGE(PG8_SA(0, 1), a2 + hstep, voffA);
            PG8_WAIT_V(8); PG8_WAIT_L(0); PG8_BAR; PG8_MMA(0, 0, At, B0); PG8_MMA(0, 1, At, B1); PG8_BAR; PG8_SCHED;
            PG8_LDA(At, 1, 1); PG8_STAGE(PG8_SB(1, 0), b3, voffB); PG8_STAGE(PG8_SB(1, 1), b3 + hstep, voffB); PG8_STAGE(PG8_SA(1, 0), a3, voffA);
            PG8_WAIT_V(8); PG8_WAIT_L(0); PG8_BAR; PG8_MMA(1, 0, At, B0); PG8_MMA(1, 1, At, B1); PG8_BAR; PG8_SCHED;
            } else {
            PG8_LDB(B0, 0, 0); PG8_SCHED; PG8_LDA(At, 0, 0); PG8_STAGE(PG8_SA(1, 1), a1 + hstep, voffA);
            PG8_WAIT_L(8); PG8_BAR; PG8_WAIT_L(0); PG8_MMA(0, 0, At, B0); PG8_BAR; PG8_SCHED;
            PG8_LDB(B1, 0, 1); PG8_STAGE(PG8_SB(0, 0), b2, voffB);
            PG8_BAR; PG8_WAIT_L(0); PG8_MMA(0, 1, At, B1); PG8_BAR;
            PG8_LDA(At, 0, 1); PG8_STAGE(PG8_SA(0, 0), a2, voffA);
            PG8_BAR; PG8_WAIT_L(0); PG8_MMA(1, 0, At, B0); PG8_BAR; PG8_SCHED;
            PG8_STAGE(PG8_SB(0, 1), b2 + hstep, voffB);
            PG8_WAIT_V(6); PG8_BAR; PG8_MMA(1, 1, At, B1); PG8_BAR;
            PG8_LDB(B0, 1, 0); PG8_SCHED; PG8_LDA(At, 1, 0); PG8_STAGE(PG8_SA(0, 1), a2 + hstep, voffA);
            PG8_WAIT_L(8); PG8_BAR; PG8_WAIT_L(0); PG8_MMA(0, 0, At, B0); PG8_BAR; PG8_SCHED;
            PG8_LDB(B1, 1, 1); PG8_STAGE(PG8_SB(1, 0), b3, voffB);
            PG8_BAR; PG8_WAIT_L(0); PG8_MMA(0, 1, At, B1); PG8_BAR;
            PG8_LDA(At, 1, 1); PG8_STAGE(PG8_SA(1, 0), a3, voffA);
            PG8_BAR; PG8_WAIT_L(0); PG8_MMA(1, 0, At, B0); PG8_BAR; PG8_SCHED;
            PG8_STAGE(PG8_SB(1, 1), b3 + hstep, voffB);
            PG8_WAIT_V(6); PG8_BAR; PG8_MMA(1, 1, At, B1); PG8_BAR;
            }
        }
        if constexpr (ALIGN_EPI) { if (wr == 0) PG8_BAR; }
        if constexpr (!Epi::AFTER_DRAIN) { E(acc, cur, wr, wc, fr, fq); S.done(cur); }
        if (!has_next) break;
#pragma unroll
        for (int a = 0; a < 2; ++a)
#pragma unroll
            for (int b = 0; b < 2; ++b)
#pragma unroll
                for (int m = 0; m < 4; ++m)
#pragma unroll
                    for (int n = 0; n < 2; ++n) acc[a][b][m][n] = (f32x4){0.f, 0.f, 0.f, 0.f};
        cur = nxt; cA = nA; cB = nB; ++ui;
        if constexpr (ALIGN_EPI) { if (wr == 1) PG8_BAR; }
    }
    PG8_WAIT_V(0);
    if constexpr (!ALIGN_EPI) { if (wr == 0) PG8_BAR; }
    PG8_BAR;
    if constexpr (Epi::AFTER_DRAIN) { E.fused(acc, cur, wr, wc, fr, fq, lds, wid, lane); S.done(cur); }
#undef PG8_SA
#undef PG8_SB
#undef PG8_STAGE
#undef PG8_LDA
#undef PG8_LDB
#undef PG8_MMA
#undef PG8_WAIT_V
#undef PG8_WAIT_L
#undef PG8_BAR
#undef PG8_SCHED
}
}

constexpr int BATCH = 8, SEQ = 4096, DM = 1024, MTOK = BATCH * SEQ;
constexpr int NMEM = 256, MMEM = BATCH * NMEM;
constexpr int AW = 512, HD = 64, NH = 8, IH = 4, TOPK = 256;
constexpr int INC = 1988, INP = 2048;
constexpr int DFF = 2816;
constexpr float EPS = 1e-6f;
#define LAS __attribute__((address_space(3)))
typedef unsigned short bf16_t;
typedef float f32x4 __attribute__((ext_vector_type(4)));
typedef unsigned u32x4 __attribute__((ext_vector_type(4)));
typedef unsigned u32x2 __attribute__((ext_vector_type(2)));

__device__ __forceinline__ float bf2f(bf16_t v) { return __uint_as_float((unsigned)v << 16); }
__device__ __forceinline__ bf16_t f2bf(float f) { unsigned u = __float_as_uint(f); return (bf16_t)((u + 0x7fffu + ((u >> 16) & 1u)) >> 16); }
__device__ __forceinline__ float shx(float v, int lane, int o) { return __uint_as_float((unsigned)__builtin_amdgcn_ds_bpermute((lane ^ o) << 2, (int)__float_as_uint(v))); }
__device__ __forceinline__ float wave_sum_l(float v, int lane) {
#pragma unroll
    for (int o = 1; o < 64; o <<= 1) v += shx(v, lane, o);
    return v;
}
__device__ __forceinline__ float wave_sum(float v) {
#pragma unroll
    for (int o = 1; o < 64; o <<= 1) v += __shfl_xor(v, o);
    return v;
}
__device__ __forceinline__ float wave_max(float v) {
#pragma unroll
    for (int o = 1; o < 64; o <<= 1) v = fmaxf(v, __shfl_xor(v, o));
    return v;
}
__device__ __forceinline__ float silu_f(float v) { return v / (1.f + __expf(-v)); }

struct EpiStore {
    static constexpr bool PERM = false, AFTER_DRAIN = false;
    float* outf; bf16_t* outb; const float* res; int ldc;
    __device__ __forceinline__ void operator()(const pg8::f32x4 (&acc)[2][2][4][2], const pg8::Unit& u, int wr, int wc, int fr, int fq) const {
        const int col0 = u.pn * 256 + wc * 32 + 4 * fq;
#pragma unroll
        for (int ai = 0; ai < 2; ++ai)
#pragma unroll
            for (int m = 0; m < 4; ++m) {
                const size_t row = (size_t)(u.pm * 256 + ai * 128 + wr * 64 + m * 16 + fr);
#pragma unroll
                for (int bj = 0; bj < 2; ++bj)
#pragma unroll
                    for (int n = 0; n < 2; ++n) {
                        const size_t off = row * ldc + col0 + bj * 128 + n * 16;
                        pg8::f32x4 v = acc[ai][bj][m][n];
                        if (res) { const pg8::f32x4 r = *(const pg8::f32x4*)(res + off); v = v + r; }
                        if (outf) *(pg8::f32x4*)(outf + off) = v;
                        if (outb) { u32x2 w; w.x = (unsigned)f2bf(v[0]) | ((unsigned)f2bf(v[1]) << 16); w.y = (unsigned)f2bf(v[2]) | ((unsigned)f2bf(v[3]) << 16); *(u32x2*)(outb + off) = w; }
                    }
            }
    }
};
#define XB_TMO      128
#define XB_XCNT(j)  (256  + 64 * (j))
#define XB_XSUB(j)  (1280 + 64 * (j))
#define XB_XGEN(j)  (2304 + 64 * (j))
#define XB_TOP      3328
#define XB_TOPGEN   3392
#define XCD_BAR_WORDS 3456
#define XB_SPIN_CAP (1u << 18)

__device__ __forceinline__ unsigned xb_ld(unsigned* p)              { return __hip_atomic_load(p, __ATOMIC_RELAXED, __HIP_MEMORY_SCOPE_AGENT); }
__device__ __forceinline__ unsigned xb_add(unsigned* p, unsigned v) { return __hip_atomic_fetch_add(p, v, __ATOMIC_RELAXED, __HIP_MEMORY_SCOPE_AGENT); }
__device__ __forceinline__ unsigned xb_xcc_id() { return (unsigned)__builtin_amdgcn_s_getreg((3 << 11) | 20) & 0xFu; }
#define XB_SPIN(cond, bar) do { unsigned _sp = 0; while (cond) { __builtin_amdgcn_s_sleep(1); \
    if ((++_sp & 255u) == 0u) { if (xb_ld(&(bar)[XB_TMO])) break; if (_sp > XB_SPIN_CAP) { atomicAdd(&(bar)[XB_TMO], 1u); break; } } } } while (0)

struct XcdBarrier {
    unsigned* bar; unsigned x;
    volatile LAS unsigned* st;
};

__device__ __forceinline__ XcdBarrier xcd_barrier_post(unsigned* bar, volatile LAS unsigned* st) {
    XcdBarrier b; b.bar = bar; b.x = xb_xcc_id(); b.st = st;
    if (threadIdx.x == 0) (void)xb_add(&bar[XB_XCNT(b.x)], 1u);
    return b;
}
__device__ __forceinline__ void xcd_barrier_complete(unsigned* bar, unsigned x, unsigned& nloc, unsigned& nx) {
    const unsigned G = gridDim.x * gridDim.y * gridDim.z;
    unsigned sum, cnt, mine, sp = 0u;
    for (;;) {
        sum = 0u; cnt = 0u; mine = 0u;
#pragma unroll
        for (unsigned j = 0; j < 16; ++j) { const unsigned c = xb_ld(&bar[XB_XCNT(j)]); sum += c; cnt += (c > 0u) ? 1u : 0u; mine = (j == x) ? c : mine; }
        if (sum == G) break;
        __builtin_amdgcn_s_sleep(1);
        if ((++sp & 255u) == 0u) { if (xb_ld(&bar[XB_TMO])) break; if (sp > XB_SPIN_CAP) { atomicAdd(&bar[XB_TMO], 1u); break; } }
    }
    nloc = mine > 0u ? mine : 1u; nx = cnt > 0u ? cnt : 1u;
}

__device__ __forceinline__ void xcd_barrier(const XcdBarrier& b) {
    asm volatile("s_waitcnt vmcnt(0)" ::: "memory");
    __syncthreads();
    if (threadIdx.x == 0) {
        unsigned* bar = b.bar;
        __builtin_amdgcn_s_waitcnt(0);
        unsigned nloc = b.st[0], nx = b.st[1];
        if (nloc == 0u) { xcd_barrier_complete(bar, b.x, nloc, nx); b.st[0] = nloc; b.st[1] = nx; }
        const unsigned old = xb_add(&bar[XB_XSUB(b.x)], 1u);
        const unsigned gen = old / nloc;
        if (old + 1u == (gen + 1u) * nloc) {
            __builtin_amdgcn_fence(__ATOMIC_RELEASE, "agent");
            asm volatile("s_waitcnt vmcnt(0)" ::: "memory");
            const unsigned og = xb_add(&bar[XB_TOP], 1u);
            const unsigned tg = og / nx;
            if (og + 1u == (tg + 1u) * nx) xb_add(&bar[XB_TOPGEN], 1u);
            else XB_SPIN(xb_ld(&bar[XB_TOPGEN]) == tg, bar);
            __builtin_amdgcn_fence(__ATOMIC_ACQUIRE, "agent");
            xb_add(&bar[XB_XGEN(b.x)], 1u);
            asm volatile("s_waitcnt vmcnt(0)" ::: "memory");
        } else {
            XB_SPIN(xb_ld(&bar[XB_XGEN(b.x)]) == gen, bar);
            __builtin_amdgcn_fence(__ATOMIC_ACQUIRE, "agent");
            asm volatile("s_waitcnt vmcnt(0)" ::: "memory");
        }
    }
    __syncthreads();
}

__device__ __forceinline__ u32x4 pack8(const pg8::f32x4 a, const pg8::f32x4 b) {
    u32x4 w; w.x = pg8::cvt_pk_bf16(a[0], a[1]); w.y = pg8::cvt_pk_bf16(a[2], a[3]); w.z = pg8::cvt_pk_bf16(b[0], b[1]); w.w = pg8::cvt_pk_bf16(b[2], b[3]); return w;
}
__device__ __forceinline__ float sigmoid_f(float v) { return 1.f / (1.f + __expf(-v)); }
__host__ __device__ __forceinline__ int dperm(int pos) { return pos < 16 ? (4 * (pos >> 3) + (pos & 3) + 8 * ((pos >> 2) & 1)) : pos; }
__host__ __device__ __forceinline__ int in_orig_col(int n) {
    if (n < 512) return (n & ~63) + dperm(n & 63);
    if (n < 576) return 512 + dperm(n - 512);
    if (n < 640) return 576 + (n - 576);
    if (n < 704) return 896 + dperm(n - 640);
    if (n < 708) return 960 + (n - 704);
    if (n < 768) return -1;
    if (n < 1024) return 640 + ((n - 768) & ~63) + dperm((n - 768) & 63);
    const int i = (n - 1024) >> 8, c = (n - 1024) & 255;
    return c < 128 ? 964 + 128 * i + c : 1476 + 128 * i + (c - 128);
}
struct EpiIn {
    static constexpr bool PERM = true, AFTER_DRAIN = false;
    const float* cs; bf16_t *Q, *K, *V, *QI, *KI, *U; float* WI;
    __device__ __forceinline__ void operator()(const pg8::f32x4 (&acc)[2][2][4][2], const pg8::Unit& u, int wr, int wc, int fr, int fq) const {
        const int pn = u.pn;
        if (pn >= 4) {
            const int ch = 128 * (pn - 4) + 32 * wc + 8 * fq;
#pragma unroll
            for (int ai = 0; ai < 2; ++ai)
#pragma unroll
                for (int m = 0; m < 4; ++m) { const size_t row = (size_t)(u.pm * 256 + ai * 128 + wr * 64 + m * 16 + fr);
                    pg8::f32x4 a0 = acc[ai][0][m][0], a1 = acc[ai][0][m][1]; const pg8::f32x4 g0 = acc[ai][1][m][0], g1 = acc[ai][1][m][1];
#pragma unroll
                    for (int k = 0; k < 4; ++k) { a0[k] *= sigmoid_f(g0[k]); a1[k] *= sigmoid_f(g1[k]); }
                    *(u32x4*)(U + row * 512 + ch) = pack8(a0, a1); }
            return;
        }
        const bool rot = (pn == 2) ? (wc == 0 && fq < 2) : ((wc & 1) == 0 && fq < 2);
#pragma unroll
        for (int ai = 0; ai < 2; ++ai)
#pragma unroll
            for (int m = 0; m < 4; ++m) { const size_t row = (size_t)(u.pm * 256 + ai * 128 + wr * 64 + m * 16 + fr);
                pg8::f32x4 cv = {1.f, 1.f, 1.f, 1.f}, sv = {0.f, 0.f, 0.f, 0.f};
                if (rot) { cv = *(const pg8::f32x4*)(cs + row * 16 + 4 * fq); sv = *(const pg8::f32x4*)(cs + row * 16 + 8 + 4 * fq); }
#pragma unroll
                for (int bj = 0; bj < 2; ++bj) {
                    const pg8::f32x4 v0 = acc[ai][bj][m][0], v1 = acc[ai][bj][m][1];
                    pg8::f32x4 n0 = v0 * cv - v1 * sv, n1 = v1 * cv + v0 * sv;
                    if (!rot) { n0 = v0; n1 = v1; }
                    const int c = 128 * bj + 32 * wc + 8 * fq;
                    if (pn < 2) *(u32x4*)(Q + row * 512 + 256 * pn + c) = pack8(n0, n1);
                    else if (pn == 3) *(u32x4*)(QI + row * 256 + c) = pack8(n0 * 0.125f, n1 * 0.125f);
                    else {
                        if (bj == 0) { if (wc < 2) *(u32x4*)(K + row * 64 + 32 * wc + 8 * fq) = pack8(n0, n1); else *(u32x4*)(V + row * 64 + 32 * (wc - 2) + 8 * fq) = pack8(v0, v1); }
                        else { if (wc < 2) *(u32x4*)(KI + row * 64 + 32 * wc + 8 * fq) = pack8(n0, n1); else if (wc == 2 && fq == 0) *(pg8::f32x4*)(WI + row * 4) = v0 * 0.5f; }
                    }
                }
            }
    }
};
struct EpiRes {
    static constexpr bool PERM = true, AFTER_DRAIN = false;
    const float* resf; const bf16_t* resb; float* outf; bf16_t* xb; float* ss;
    __device__ __forceinline__ void operator()(const pg8::f32x4 (&acc)[2][2][4][2], const pg8::Unit& u, int wr, int wc, int fr, int fq) const {
#pragma unroll
        for (int ai = 0; ai < 2; ++ai)
#pragma unroll
            for (int m = 0; m < 4; ++m) { const size_t row = (size_t)(u.pm * 256 + ai * 128 + wr * 64 + m * 16 + fr); float q = 0.f;
#pragma unroll
                for (int bj = 0; bj < 2; ++bj) { const size_t off = row * DM + u.pn * 256 + 128 * bj + 32 * wc + 8 * fq;
                    pg8::f32x4 r0, r1;
                    if (resf) { r0 = *(const pg8::f32x4*)(resf + off); r1 = *(const pg8::f32x4*)(resf + off + 4); }
                    else { const u32x4 rb = *(const u32x4*)(resb + off);
                        r0 = (pg8::f32x4){__uint_as_float(rb.x << 16), __uint_as_float(rb.x & 0xffff0000u), __uint_as_float(rb.y << 16), __uint_as_float(rb.y & 0xffff0000u)};
                        r1 = (pg8::f32x4){__uint_as_float(rb.z << 16), __uint_as_float(rb.z & 0xffff0000u), __uint_as_float(rb.w << 16), __uint_as_float(rb.w & 0xffff0000u)}; }
                    const pg8::f32x4 v0 = acc[ai][bj][m][0] + r0, v1 = acc[ai][bj][m][1] + r1;
                    if (outf) { *(pg8::f32x4*)(outf + off) = v0; *(pg8::f32x4*)(outf + off + 4) = v1; }
                    if (xb) *(u32x4*)(xb + off) = pack8(v0, v1);
                    q += (v0[0] * v0[0] + v0[1] * v0[1]) + (v0[2] * v0[2] + v0[3] * v0[3]) + (v1[0] * v1[0] + v1[1] * v1[1]) + (v1[2] * v1[2] + v1[3] * v1[3]); }
                { const int lane_ = fq * 16 + fr; q += shx(q, lane_, 16); q += shx(q, lane_, 32); }
                if (fq == 0) ss[row * 16 + u.pn * 4 + wc] = q; }
    }
};
__device__ __forceinline__ float rstd_from_ss(const float* ss, size_t row) {
    const pg8::f32x4 a = *(const pg8::f32x4*)(ss + row * 16), b = *(const pg8::f32x4*)(ss + row * 16 + 4), c = *(const pg8::f32x4*)(ss + row * 16 + 8), d = *(const pg8::f32x4*)(ss + row * 16 + 12);
    const float s = ((a[0] + a[1]) + (a[2] + a[3])) + ((b[0] + b[1]) + (b[2] + b[3])) + ((c[0] + c[1]) + (c[2] + c[3])) + ((d[0] + d[1]) + (d[2] + d[3]));
    return 1.f / sqrtf(s * (1.f / DM) + EPS);
}
struct EpiScale {
    static constexpr bool PERM = true, AFTER_DRAIN = false;
    const float* ss; bf16_t* O; int ldc; float scale;
    __device__ __forceinline__ void operator()(const pg8::f32x4 (&acc)[2][2][4][2], const pg8::Unit& u, int wr, int wc, int fr, int fq) const {
#pragma unroll
        for (int ai = 0; ai < 2; ++ai)
#pragma unroll
            for (int m = 0; m < 4; ++m) { const size_t row = (size_t)(u.pm * 256 + ai * 128 + wr * 64 + m * 16 + fr); const float r = rstd_from_ss(ss, row) * scale;
#pragma unroll
                for (int bj = 0; bj < 2; ++bj) *(u32x4*)(O + row * ldc + u.pn * 256 + 128 * bj + 32 * wc + 8 * fq) = pack8(acc[ai][bj][m][0] * r, acc[ai][bj][m][1] * r); }
    }
};
struct EpiGateUp {
    static constexpr bool PERM = true, AFTER_DRAIN = false;
    const float* ss; bf16_t* Gb; bf16_t* Ub;
    __device__ __forceinline__ void operator()(const pg8::f32x4 (&acc)[2][2][4][2], const pg8::Unit& u, int wr, int wc, int fr, int fq) const {
        const int ch = 128 * u.pn + 32 * wc + 8 * fq;
#pragma unroll
        for (int ai = 0; ai < 2; ++ai)
#pragma unroll
            for (int m = 0; m < 4; ++m) { const size_t row = (size_t)(u.pm * 256 + ai * 128 + wr * 64 + m * 16 + fr); const float r = rstd_from_ss(ss, row);
                *(u32x4*)(Gb + row * DFF + ch) = pack8(acc[ai][0][m][0] * r, acc[ai][0][m][1] * r);
                *(u32x4*)(Ub + row * DFF + ch) = pack8(acc[ai][1][m][0] * r, acc[ai][1][m][1] * r); }
    }
};
struct EpiGateUpAct {
    static constexpr bool PERM = true, AFTER_DRAIN = false;
    const float* ss; bf16_t* H; const float* cw; const float* cb; float* topg; float* topu; float* botg; LAS unsigned char* xch;
    __device__ __forceinline__ void operator()(const pg8::f32x4 (&acc)[2][2][4][2], const pg8::Unit& u, int wr, int wc, int fr, int fq) const {
        const int lane = fq * 16 + fr, chl = 32 * wc + 8 * fq, ch = 128 * u.pn + chl;
        const int l1 = (fq * 16 + ((fr + 15) & 15)) << 2, l2 = (fq * 16 + ((fr + 14) & 15)) << 2;
        (void)lane;
#pragma unroll
        for (int ai = 0; ai < 2; ++ai) { const size_t row = (size_t)(u.pm * 256 + ai * 128 + wr * 64 + 48 + fr); const float r = rstd_from_ss(ss, row);
            if (fr >= 14) { LAS float* p = (LAS float*)xch + ((2 * ai + wr) * 2 + (fr - 14)) * 128 + chl;
                *(LAS pg8::f32x4*)p = acc[ai][0][3][0] * r; *(LAS pg8::f32x4*)(p + 4) = acc[ai][0][3][1] * r; } }
        asm volatile("s_waitcnt lgkmcnt(0)" ::: "memory"); __builtin_amdgcn_s_barrier(); asm volatile("" ::: "memory");
        pg8::f32x4 wb[2], w2[2], w1[2], w0[2];
#pragma unroll
        for (int hq = 0; hq < 2; ++hq) { wb[hq] = *(const pg8::f32x4*)(cb + ch + 4 * hq); w2[hq] = *(const pg8::f32x4*)(cw + 2 * DFF + ch + 4 * hq); w1[hq] = *(const pg8::f32x4*)(cw + DFF + ch + 4 * hq); w0[hq] = *(const pg8::f32x4*)(cw + ch + 4 * hq); }
#pragma unroll
        for (int ai = 0; ai < 2; ++ai) {
            const int blk = 2 * ai + wr;
            pg8::f32x4 pv[2] = {{0.f, 0.f, 0.f, 0.f}, {0.f, 0.f, 0.f, 0.f}};
            if (blk > 0 && fr >= 14) { const LAS float* p = (const LAS float*)xch + ((blk - 1) * 2 + (fr - 14)) * 128 + chl; pv[0] = *(const LAS pg8::f32x4*)p; pv[1] = *(const LAS pg8::f32x4*)(p + 4); }
#pragma unroll
            for (int m = 0; m < 4; ++m) { const size_t row = (size_t)(u.pm * 256 + ai * 128 + wr * 64 + m * 16 + fr); const float r = rstd_from_ss(ss, row);
                pg8::f32x4 g[2], uu[2], hh[2];
#pragma unroll
                for (int hq = 0; hq < 2; ++hq) { g[hq] = acc[ai][0][m][hq] * r; uu[hq] = acc[ai][1][m][hq] * r; }
#pragma unroll
                for (int hq = 0; hq < 2; ++hq)
#pragma unroll
                    for (int k = 0; k < 4; ++k) {
                        const float x1 = (fr == 15) ? pv[hq][k] : g[hq][k], x2 = (fr >= 14) ? pv[hq][k] : g[hq][k];
                        const float p1 = __uint_as_float((unsigned)__builtin_amdgcn_ds_bpermute(l1, (int)__float_as_uint(x1)));
                        const float p2 = __uint_as_float((unsigned)__builtin_amdgcn_ds_bpermute(l2, (int)__float_as_uint(x2)));
                        const float gg = wb[hq][k] + w2[hq][k] * g[hq][k] + w1[hq][k] * p1 + w0[hq][k] * p2;
                        hh[hq][k] = gg / (1.f + __expf(-gg)) * uu[hq][k]; }
                *(u32x4*)(H + row * DFF + ch) = pack8(hh[0], hh[1]);
                if (blk == 0 && m == 0 && fr < 2) { float* tg = topg + ((size_t)u.pm * 2 + fr) * DFF + ch; float* tu = topu + ((size_t)u.pm * 2 + fr) * DFF + ch;
                    *(pg8::f32x4*)tg = g[0]; *(pg8::f32x4*)(tg + 4) = g[1]; *(pg8::f32x4*)tu = uu[0]; *(pg8::f32x4*)(tu + 4) = uu[1]; }
                if (blk == 3 && m == 3 && fr >= 14) { float* bg = botg + ((size_t)u.pm * 2 + (fr - 14)) * DFF + ch; *(pg8::f32x4*)bg = g[0]; *(pg8::f32x4*)(bg + 4) = g[1]; }
                pv[0] = g[0]; pv[1] = g[1];
            }
        }
    }
};
typedef short bf16x8v __attribute__((ext_vector_type(8)));
constexpr int CA_STRIDE = 528;
__device__ __forceinline__ void cross_attn_unit(LAS unsigned char* lds, int b, int h, int qb, const bf16_t* QC, const bf16_t* KC, const bf16_t* VT, bf16_t* OC, int tid, int lane, int wave) {
    const int q16 = lane & 15, g = lane >> 4;
    const size_t row0 = (size_t)b * SEQ + (size_t)qb * 256 + wave * 32;
    asm volatile("" : "+v"(tid));
    { const bf16_t* src = KC + ((size_t)b * NMEM + (tid >> 5)) * DM + h * 256 + (tid & 31) * 8; LAS unsigned char* dst = lds + (tid >> 5) * CA_STRIDE + (tid & 31) * 16;
#pragma unroll
      for (int i = 0; i < 16; ++i) { const u32x4 v = *(const u32x4*)(src + (size_t)i * 16 * DM); *(LAS u32x4*)(dst + i * 16 * CA_STRIDE) = v; } }
    __syncthreads();
    f32x4 S[2][16];
#pragma unroll
    for (int st = 0; st < 2; ++st)
#pragma unroll
        for (int kt = 0; kt < 16; ++kt) S[st][kt] = (f32x4){0.f, 0.f, 0.f, 0.f};
#pragma unroll 1
    for (int kh = 0; kh < 2; ++kh) {
        bf16x8v qf[2][4];
#pragma unroll
        for (int st = 0; st < 2; ++st)
#pragma unroll
            for (int ks = 0; ks < 4; ++ks) qf[st][ks] = *(const bf16x8v*)(QC + (row0 + st * 16 + q16) * DM + h * 256 + kh * 128 + ks * 32 + g * 8);
        const LAS unsigned char* kb = lds + q16 * CA_STRIDE + kh * 256 + g * 16;
#pragma unroll
        for (int kt = 0; kt < 16; ++kt)
#pragma unroll
            for (int ks = 0; ks < 4; ++ks) { const bf16x8v a = *(const LAS bf16x8v*)(kb + kt * 16 * CA_STRIDE + ks * 64);
                S[0][kt] = __builtin_amdgcn_mfma_f32_16x16x32_bf16(a, qf[0][ks], S[0][kt], 0, 0, 0);
                S[1][kt] = __builtin_amdgcn_mfma_f32_16x16x32_bf16(a, qf[1][ks], S[1][kt], 0, 0, 0); }
    }
    const float c2 = 0.0625f * 1.4426950408889634f;
    float linv[2]; bf16x8v P[2][8];
#pragma unroll
    for (int st = 0; st < 2; ++st) {
        float m = -INFINITY;
#pragma unroll
        for (int kt = 0; kt < 16; ++kt) m = fmaxf(fmaxf(fmaxf(S[st][kt][0], S[st][kt][1]), fmaxf(S[st][kt][2], S[st][kt][3])), m);
        m = fmaxf(m, shx(m, lane, 16)); m = fmaxf(m, shx(m, lane, 32));
        const float mc = m * c2; float l = 0.f;
#pragma unroll
        for (int kt = 0; kt < 16; ++kt)
#pragma unroll
            for (int r = 0; r < 4; ++r) { const float p = __builtin_amdgcn_exp2f(S[st][kt][r] * c2 - mc); S[st][kt][r] = p; l += p; }
        l += shx(l, lane, 16); l += shx(l, lane, 32); linv[st] = 1.f / l;
#pragma unroll
        for (int c = 0; c < 8; ++c) { bf16x8v pk;
#pragma unroll
            for (int j = 0; j < 4; ++j) { pk[j] = (short)f2bf(S[st][2 * c][j]); pk[4 + j] = (short)f2bf(S[st][2 * c + 1][j]); }
            P[st][c] = pk; }
    }
    __syncthreads();
    { int tid2 = tid; asm volatile("" : "+v"(tid2));
      const bf16_t* src = VT + (size_t)(h * 256 + (tid2 >> 5)) * MMEM + b * NMEM + (tid2 & 31) * 8; LAS unsigned char* dst = lds + (tid2 >> 5) * CA_STRIDE + (tid2 & 31) * 16;
#pragma unroll
      for (int i = 0; i < 16; ++i) { const u32x4 v = *(const u32x4*)(src + (size_t)i * 16 * MMEM); *(LAS u32x4*)(dst + i * 16 * CA_STRIDE) = v; } }
    __syncthreads();
#pragma unroll 1
    for (int dh = 0; dh < 2; ++dh) {
        f32x4 O[2][8];
#pragma unroll
        for (int st = 0; st < 2; ++st)
#pragma unroll
            for (int dt = 0; dt < 8; ++dt) O[st][dt] = (f32x4){0.f, 0.f, 0.f, 0.f};
        const LAS unsigned char* pb = lds + (dh * 128 + q16) * CA_STRIDE + g * 8;
#pragma unroll
        for (int dt = 0; dt < 8; ++dt)
#pragma unroll
            for (int c = 0; c < 8; ++c) { const LAS unsigned char* p = pb + dt * 16 * CA_STRIDE + c * 64;
                const u32x2 lo = *(const LAS u32x2*)p, hi = *(const LAS u32x2*)(p + 32);
                const u32x4 av = (u32x4){lo.x, lo.y, hi.x, hi.y}; const bf16x8v a = __builtin_bit_cast(bf16x8v, av);
                O[0][dt] = __builtin_amdgcn_mfma_f32_16x16x32_bf16(a, P[0][c], O[0][dt], 0, 0, 0);
                O[1][dt] = __builtin_amdgcn_mfma_f32_16x16x32_bf16(a, P[1][c], O[1][dt], 0, 0, 0); }
#pragma unroll
        for (int st = 0; st < 2; ++st)
#pragma unroll
            for (int dt = 0; dt < 8; ++dt) { const f32x4 o = O[st][dt] * linv[st]; u32x2 w;
                w.x = (unsigned)f2bf(o[0]) | ((unsigned)f2bf(o[1]) << 16); w.y = (unsigned)f2bf(o[2]) | ((unsigned)f2bf(o[3]) << 16);
                *(u32x2*)(OC + (row0 + st * 16 + q16) * DM + h * 256 + dh * 128 + dt * 16 + g * 4) = w; }
    }
    __syncthreads();
}
typedef float f32x16v __attribute__((ext_vector_type(16)));
constexpr int TK_HIST_OFF = 131072;
__device__ __forceinline__ unsigned code16(float s) {
    const _Float16 hf = (_Float16)s; unsigned u = (unsigned)__builtin_bit_cast(unsigned short, hf);
    if ((u & 0x7fffu) == 0u) u = 0u;
    return (u & 0x8000u) ? (~u & 0xffffu) : (u | 0x8000u);
}
__device__ __forceinline__ unsigned mbcnt64(unsigned long long m) { return __builtin_amdgcn_mbcnt_hi((unsigned)(m >> 32), __builtin_amdgcn_mbcnt_lo((unsigned)m, 0u)); }
__device__ __forceinline__ void lds_hist_add(LAS unsigned char* hrow, unsigned bin) {
    __hip_atomic_fetch_add((LAS unsigned*)(hrow + ((bin & 127u) << 2)), (bin & 128u) ? 0x10000u : 1u, __ATOMIC_RELAXED, __HIP_MEMORY_SCOPE_WORKGROUP);
}
__device__ __forceinline__ void hist_select(const LAS unsigned char* hrow, unsigned target, int lane, unsigned& B, unsigned& above) {
    const u32x4 hv = *(const LAS u32x4*)(hrow + (lane & 31) * 16);
    const unsigned sh = (lane & 32) ? 16u : 0u;
    const unsigned h0 = (hv.x >> sh) & 0xffffu, h1 = (hv.y >> sh) & 0xffffu, h2 = (hv.z >> sh) & 0xffffu, h3 = (hv.w >> sh) & 0xffffu;
    const unsigned s = (h0 + h1) + (h2 + h3); unsigned S = s;
#pragma unroll
    for (int o = 1; o < 64; o <<= 1) { const unsigned v = (unsigned)__builtin_amdgcn_ds_bpermute(((lane + o) & 63) << 2, (int)S); if (lane + o < 64) S += v; }
    const unsigned long long mk = __ballot(S >= target);
    const int lb = 63 - __builtin_clzll(mk);
    const unsigned A = S - s, c3 = A + h3, c2 = c3 + h2, c1 = c2 + h1;
    const unsigned bsel = (c3 >= target) ? 3u : (c2 >= target) ? 2u : (c1 >= target) ? 1u : 0u;
    const unsigned asel = (c3 >= target) ? A : (c2 >= target) ? c3 : (c1 >= target) ? c2 : c1;
    B = 4u * (unsigned)lb + (unsigned)__builtin_amdgcn_readlane((int)bsel, lb);
    above = (unsigned)__builtin_amdgcn_readlane((int)asel, lb);
}
__device__ __forceinline__ void topk_unit(LAS unsigned char* lds, int b, int j, const bf16_t* QI, const bf16_t* KI, const float* WI, unsigned short* SEL, int tid, int lane, int wave) {
    asm volatile("" : "+v"(tid), "+v"(lane));
    const int t0 = 16 * j, L = t0 + 16, nkt = (L + 31) >> 5;
    const size_t rowbase = (size_t)b * SEQ + t0;
    const int c32 = lane & 31, hi = lane >> 5;
    *(LAS u32x4*)(lds + TK_HIST_OFF + tid * 16) = (u32x4){0u, 0u, 0u, 0u};
    __syncthreads();
    {
        bf16x8v qa[2][4]; f32x4 wq[2][4];
#pragma unroll
        for (int rt = 0; rt < 2; ++rt) {
#pragma unroll
            for (int ks = 0; ks < 4; ++ks) qa[rt][ks] = *(const bf16x8v*)(QI + (rowbase + 8 * rt + (c32 >> 2)) * 256 + (c32 & 3) * 64 + 16 * ks + 8 * hi);
#pragma unroll
            for (int gq = 0; gq < 4; ++gq) wq[rt][gq] = *(const f32x4*)(WI + (rowbase + 8 * rt + 2 * gq + hi) * 4);
        }
        const bf16_t* kbase = KI + ((size_t)b * SEQ + c32) * 64 + 8 * hi;
        bf16x8v kb[4], kn[4];
        int kt = wave;
        if (kt < nkt) {
#pragma unroll
            for (int ks = 0; ks < 4; ++ks) kb[ks] = *(const bf16x8v*)(kbase + (size_t)kt * 32 * 64 + 16 * ks);
        }
        for (; kt < nkt; kt += 8) {
            const int ktn = (kt + 8 < nkt) ? kt + 8 : kt;
#pragma unroll
            for (int ks = 0; ks < 4; ++ks) kn[ks] = *(const bf16x8v*)(kbase + (size_t)ktn * 32 * 64 + 16 * ks);
            const int key = kt * 32 + c32;
#pragma unroll
            for (int rt = 0; rt < 2; ++rt) {
                f32x16v c = {0.f, 0.f, 0.f, 0.f, 0.f, 0.f, 0.f, 0.f, 0.f, 0.f, 0.f, 0.f, 0.f, 0.f, 0.f, 0.f};
#pragma unroll
                for (int ks = 0; ks < 4; ++ks) c = __builtin_amdgcn_mfma_f32_32x32x16_bf16(qa[rt][ks], kb[ks], c, 0, 0, 0);
#pragma unroll
                for (int gq = 0; gq < 4; ++gq) {
                    const f32x4 w = wq[rt][gq];
                    const float sc = w[0] * fmaxf(c[4 * gq + 0], 0.f) + w[1] * fmaxf(c[4 * gq + 1], 0.f) + w[2] * fmaxf(c[4 * gq + 2], 0.f) + w[3] * fmaxf(c[4 * gq + 3], 0.f);
                    const int q = 8 * rt + 2 * gq + hi; const unsigned code = code16(sc);
                    *(LAS unsigned short*)(lds + q * 8192 + key * 2) = (unsigned short)code;
                    if (key <= t0 + q) lds_hist_add(lds + TK_HIST_OFF + q * 512, code >> 8);
                }
            }
#pragma unroll
            for (int ks = 0; ks < 4; ++ks) kb[ks] = kn[ks];
        }
    }
    __syncthreads();
#pragma unroll 1
    for (int qq = 0; qq < 2; ++qq) {
        const int q = 2 * wave + qq, t = t0 + q, n = t + 1;
        unsigned short* sel = SEL + (rowbase + q) * TOPK;
        if (n <= TOPK) {
#pragma unroll
            for (int i = 0; i < 4; ++i) { const int s = lane + 64 * i; if (s < n) sel[s] = (unsigned short)s; }
            continue;
        }
        const int nch = (n + 127) >> 7;
        LAS unsigned char* hrow = lds + TK_HIST_OFF + q * 512;
        const LAS unsigned* row = (const LAS unsigned*)(lds + q * 8192) + lane;
        unsigned B, above;
        hist_select(hrow, (unsigned)TOPK, lane, B, above);
        *(LAS u32x2*)(hrow + lane * 8) = (u32x2){0u, 0u};
        asm volatile("s_waitcnt lgkmcnt(0)" ::: "memory");
#pragma unroll 4
        for (int c = 0; c < nch; ++c) { const unsigned v = row[64 * c]; const int i0 = 128 * c + 2 * lane;
            const unsigned lo = v & 0xffffu, hi16 = v >> 16;
            if (i0 <= t && (lo >> 8) == B) lds_hist_add(hrow, lo & 255u);
            if (i0 + 1 <= t && (hi16 >> 8) == B) lds_hist_add(hrow, hi16 & 255u); }
        asm volatile("s_waitcnt lgkmcnt(0)" ::: "memory");
        unsigned b2, above2;
        hist_select(hrow, (unsigned)TOPK - above, lane, b2, above2);
        const unsigned T = (B << 8) | b2, cgt = above + above2, need = (unsigned)TOPK - cgt;
        unsigned eqrun = 0u, selrun = 0u;
#pragma unroll 2
        for (int c = 0; c < nch; ++c) { const unsigned v = row[64 * c]; const int i0 = 128 * c + 2 * lane;
            const unsigned lo = (i0 <= t) ? (v & 0xffffu) : 0u, hi16 = (i0 + 1 <= t) ? (v >> 16) : 0u;
            const bool glo = lo > T, ghi = hi16 > T;
            const unsigned long long mglo = __ballot(glo), mghi = __ballot(ghi);
            const unsigned plo = selrun + mbcnt64(mglo), phi = selrun + (unsigned)__popcll(mglo) + mbcnt64(mghi);
            if (glo) sel[plo] = (unsigned short)i0;
            if (ghi) sel[phi] = (unsigned short)(i0 + 1);
            selrun += (unsigned)__popcll(mglo) + (unsigned)__popcll(mghi);
            const bool elo = lo == T, ehi = hi16 == T;
            const unsigned long long melo = __ballot(elo), mehi = __ballot(ehi);
            if ((melo | mehi) != 0ull) {
                const unsigned rlo = eqrun + mbcnt64(melo) + mbcnt64(mehi), rhi = rlo + (elo ? 1u : 0u);
                if (elo && rlo < need) sel[cgt + rlo] = (unsigned short)i0;
                if (ehi && rhi < need) sel[cgt + rhi] = (unsigned short)(i0 + 1);
                eqrun += (unsigned)__popcll(melo) + (unsigned)__popcll(mehi);
            }
        }
    }
    __syncthreads();
}
__device__ __forceinline__ void topk_phase(LAS unsigned char* lds, int G, int vcu, const bf16_t* QI, const bf16_t* KI, const float* WI, unsigned short* SEL, int tid, int lane, int wave) {
    if (G == 256) {
        const int b = vcu >> 5, i = vcu & 31;
#pragma unroll 1
        for (int k = 0; k < 8; ++k) { const int j = 64 * (k >> 1) + ((k & 1) ? 63 - i : i); topk_unit(lds, b, j, QI, KI, WI, SEL, tid, lane, wave); }
    } else {
#pragma unroll 1
        for (int u = vcu; u < BATCH * 256; u += G) topk_unit(lds, u >> 8, u & 255, QI, KI, WI, SEL, tid, lane, wave);
    }
}
typedef short v4i16_t __attribute__((ext_vector_type(4)));
constexpr int SV_STRIDE = 160, SV_TILE_BYTES = 64 * SV_STRIDE, SV_WAVE_BYTES = SV_TILE_BYTES + 1024;
__device__ __forceinline__ v4i16_t tr_read16(const LAS unsigned char* p) { return __builtin_amdgcn_ds_read_tr16_b64_v4i16((LAS v4i16_t*)p); }
#define SP_FENCE() asm volatile("" ::: "memory")
__device__ __forceinline__ void sparse_attn_phase(LAS unsigned char* lds, int G, int vcu, const bf16_t* Q, const bf16_t* Kb, const bf16_t* Vb, const unsigned short* SEL, bf16_t* MIX, int lane, int wave) {
    asm volatile("" : "+v"(lane));
    LAS unsigned char* wl = lds + wave * SV_WAVE_BYTES;
    const int q16 = lane & 15, g = lane >> 4;
    const int nq = (G == 256) ? 16 : (MTOK - (vcu * 8 + wave) + G * 8 - 1) / (G * 8);
    const int r_first = (G == 256) ? (vcu >> 5) * SEQ + (vcu & 31) * 8 + wave : vcu * 8 + wave, r_step = (G == 256) ? 256 : G * 8;
    u32x2 selv = (u32x2){0u, 0u};
    if (nq > 0) selv = *(const u32x2*)(SEL + (size_t)r_first * TOPK + 4 * lane);
    LAS unsigned char* wdst = wl + (lane >> 3) * SV_STRIDE + (lane & 7) * 16;
    const LAS unsigned char* rsrc = wl + (4 * g + (q16 >> 2)) * SV_STRIDE + (q16 & 3) * 8;
    const float c2 = 0.125f * 1.4426950408889634f;
#pragma unroll 1
    for (int k = 0; k < nq; ++k) {
        const size_t row = (size_t)r_first + (size_t)k * r_step; const int b = (int)(row / SEQ), t = (int)(row % SEQ);
        const int n = (t + 1 < TOPK) ? t + 1 : TOPK;
        LAS unsigned char* ib = wl + SV_TILE_BYTES + (k & 1) * 512;
        *(LAS u32x2*)(ib + lane * 8) = selv;
        if (k + 1 < nq) selv = *(const u32x2*)(SEL + (row + r_step) * TOPK + 4 * lane);
        bf16x8v qf[2];
#pragma unroll
        for (int ks = 0; ks < 2; ++ks) { u32x4 v = (u32x4){0u, 0u, 0u, 0u}; if (q16 < 8) v = *(const u32x4*)(Q + row * 512 + q16 * 64 + ks * 32 + g * 8); qf[ks] = __builtin_bit_cast(bf16x8v, v); }
        f32x4 S[16];
        const bf16_t* kbat = Kb + (size_t)b * SEQ * 64 + g * 8;
        const bf16_t* vbat = Vb + (size_t)b * SEQ * 64 + (lane & 7) * 8;
#pragma unroll
        for (int kh = 0; kh < 2; ++kh) {
            bf16x8v kf[8][2];
#pragma unroll
            for (int i = 0; i < 8; ++i) { const int slot = 128 * kh + 16 * i + q16; unsigned idx = *(const LAS unsigned short*)(ib + slot * 2); if (slot >= n) idx = 0u;
#pragma unroll
                for (int ks = 0; ks < 2; ++ks) kf[i][ks] = *(const bf16x8v*)(kbat + (size_t)idx * 64 + ks * 32); }
            SP_FENCE();
#pragma unroll
            for (int i = 0; i < 8; ++i) { f32x4 c = (f32x4){0.f, 0.f, 0.f, 0.f};
                c = __builtin_amdgcn_mfma_f32_16x16x32_bf16(kf[i][0], qf[0], c, 0, 0, 0);
                c = __builtin_amdgcn_mfma_f32_16x16x32_bf16(kf[i][1], qf[1], c, 0, 0, 0); S[8 * kh + i] = c; }
            SP_FENCE();
        }
        u32x4 vv[8];
#pragma unroll
        for (int i = 0; i < 8; ++i) { const int slot = (lane >> 3) + 8 * i; unsigned idx = *(const LAS unsigned short*)(ib + slot * 2); if (slot >= n) idx = 0u; vv[i] = *(const u32x4*)(vbat + (size_t)idx * 64); }
        SP_FENCE();
        float m = -INFINITY;
#pragma unroll
        for (int kt = 0; kt < 16; ++kt)
#pragma unroll
            for (int r = 0; r < 4; ++r) { if (16 * kt + 4 * g + r >= n) S[kt][r] = -INFINITY; m = fmaxf(m, S[kt][r]); }
        m = fmaxf(m, shx(m, lane, 16)); m = fmaxf(m, shx(m, lane, 32));
        const float mc = m * c2; float l = 0.f;
#pragma unroll
        for (int kt = 0; kt < 16; ++kt)
#pragma unroll
            for (int r = 0; r < 4; ++r) { const float p = __builtin_amdgcn_exp2f(S[kt][r] * c2 - mc); S[kt][r] = p; l += p; }
        l += shx(l, lane, 16); l += shx(l, lane, 32);
        const float linv = 1.f / l;
        bf16x8v P[8];
#pragma unroll
        for (int c = 0; c < 8; ++c) { u32x4 pk; pk.x = pg8::cvt_pk_bf16(S[2 * c][0], S[2 * c][1]); pk.y = pg8::cvt_pk_bf16(S[2 * c][2], S[2 * c][3]); pk.z = pg8::cvt_pk_bf16(S[2 * c + 1][0], S[2 * c + 1][1]); pk.w = pg8::cvt_pk_bf16(S[2 * c + 1][2], S[2 * c + 1][3]);
            P[c] = __builtin_bit_cast(bf16x8v, pk); }
        f32x4 O[4];
#pragma unroll
        for (int dt = 0; dt < 4; ++dt) O[dt] = (f32x4){0.f, 0.f, 0.f, 0.f};
#pragma unroll
        for (int cc = 0; cc < 4; ++cc) {
#pragma unroll
            for (int i = 0; i < 8; ++i) *(LAS u32x4*)(wdst + i * 8 * SV_STRIDE) = vv[i];
            SP_FENCE();
            if (cc < 3) {
#pragma unroll
                for (int i = 0; i < 8; ++i) { const int slot = 64 * (cc + 1) + (lane >> 3) + 8 * i; unsigned idx = *(const LAS unsigned short*)(ib + slot * 2); if (slot >= n) idx = 0u; vv[i] = *(const u32x4*)(vbat + (size_t)idx * 64); }
            }
            asm volatile("s_waitcnt lgkmcnt(0)" ::: "memory");
#pragma unroll
            for (int c2i = 0; c2i < 2; ++c2i)
#pragma unroll
                for (int dt = 0; dt < 4; ++dt) { const LAS unsigned char* p = rsrc + c2i * 32 * SV_STRIDE + dt * 32;
                    const v4i16_t lo = tr_read16(p), hi = tr_read16(p + 16 * SV_STRIDE);
                    const bf16x8v a = (bf16x8v){lo[0], lo[1], lo[2], lo[3], hi[0], hi[1], hi[2], hi[3]};
                    O[dt] = __builtin_amdgcn_mfma_f32_16x16x32_bf16(a, P[2 * cc + c2i], O[dt], 0, 0, 0); }
            asm volatile("s_waitcnt lgkmcnt(0)" ::: "memory");
        }
        if (q16 < 8) {
#pragma unroll
            for (int dt = 0; dt < 4; ++dt) { const f32x4 o = O[dt] * linv; u32x2 w;
                w.x = pg8::cvt_pk_bf16(o[0], o[1]); w.y = pg8::cvt_pk_bf16(o[2], o[3]);
                *(u32x2*)(MIX + row * DM + q16 * 64 + dt * 16 + g * 4) = w; }
        }
    }
    __syncthreads();
}
__device__ __forceinline__ void convb_phase(LAS unsigned char* lds, int G, int vcu, const bf16_t* U, const float* __restrict__ cw, const float* __restrict__ cb, const float* __restrict__ lng, const float* __restrict__ lnb, bf16_t* MIX, int tid, int lane, int wave) {
    asm volatile("" : "+v"(tid), "+v"(lane));
    typedef float f32x2v __attribute__((ext_vector_type(2)));
    const int cp = tid & 255, th = tid >> 8;
    f32x2v w[31];
#pragma unroll
    for (int j = 0; j < 31; ++j) w[j] = *(const f32x2v*)(cw + j * 512 + 2 * cp);
    const f32x2v bias = *(const f32x2v*)(cb + 2 * cp), gam = *(const f32x2v*)(lng + 2 * cp), bet = *(const f32x2v*)(lnb + 2 * cp);
    LAS float* red = (LAS float*)(lds + 65536);
#pragma unroll 1
    for (int tile = vcu; tile < MTOK / 32; tile += G) {
        const int row0 = tile * 32, t0 = row0 & (SEQ - 1);
        for (int i = tid; i < 62 * 64; i += 512) { const int r = i >> 6, ch = i & 63; u32x4 v = (u32x4){0u, 0u, 0u, 0u};
            if (t0 - 30 + r >= 0) v = *(const u32x4*)(U + (size_t)(row0 - 30 + r) * 512 + ch * 8);
            *(LAS u32x4*)(lds + r * 1024 + ch * 16) = v; }
        __syncthreads();
        f32x2v y[2][8];
#pragma unroll
        for (int k = 0; k < 2; ++k) {
            const int tg = th + 2 * k;
            f32x2v acc[8];
#pragma unroll
            for (int o = 0; o < 8; ++o) acc[o] = bias;
            const LAS unsigned* wp = (const LAS unsigned*)(lds + tg * 8 * 1024) + cp;
#pragma unroll
            for (int j = 0; j < 38; ++j) { const unsigned uu = wp[j * 256]; const f32x2v uv = (f32x2v){__uint_as_float(uu << 16), __uint_as_float(uu & 0xffff0000u)};
#pragma unroll
                for (int o = 0; o < 8; ++o) { const int tap = j - o; if (tap >= 0 && tap < 31) acc[o] += w[tap] * uv; } }
#pragma unroll
            for (int o = 0; o < 8; ++o) { y[k][o] = acc[o];
                float s = acc[o].x + acc[o].y, q = acc[o].x * acc[o].x + acc[o].y * acc[o].y;
                s = wave_sum_l(s, lane); q = wave_sum_l(q, lane);
                if (lane == 0) { red[((tg * 8 + o) * 4 + (wave & 3)) * 2] = s; red[((tg * 8 + o) * 4 + (wave & 3)) * 2 + 1] = q; } }
        }
        __syncthreads();
#pragma unroll
        for (int k = 0; k < 2; ++k) {
            const int tg = th + 2 * k;
#pragma unroll
            for (int o = 0; o < 8; ++o) { const int tl = tg * 8 + o;
                const f32x4 ra = *(const LAS f32x4*)(red + tl * 8), rb = *(const LAS f32x4*)(red + tl * 8 + 4);
                const float mu = ((ra[0] + ra[2]) + (rb[0] + rb[2])) * (1.f / 512.f), ex2 = ((ra[1] + ra[3]) + (rb[1] + rb[3])) * (1.f / 512.f);
                const float rstd = 1.f / sqrtf(fmaxf(ex2 - mu * mu, 0.f) + EPS);
                const float v0 = (y[k][o].x - mu) * rstd * gam.x + bet.x, v1 = (y[k][o].y - mu) * rstd * gam.y + bet.y;
                *(unsigned*)(MIX + (size_t)(row0 + tl) * DM + 512 + 2 * cp) = (unsigned)f2bf(silu_f(v0)) | ((unsigned)f2bf(silu_f(v1)) << 16); }
        }
        __syncthreads();
    }
}

__device__ __forceinline__ int wt_dst_row(int mode, int c) {
    if (mode == 0) return c;
    if (mode == 2) return 256 * (c >> 7) + (c & 127);
    if (mode == 3) return 256 * (c >> 7) + 128 + (c & 127);
    if (c < 512) return (c & ~63) + dperm(c & 63);
    if (c < 576) return 512 + dperm(c - 512);
    if (c < 640) return c;
    if (c < 896) return 768 + ((c - 640) & ~63) + dperm((c - 640) & 63);
    if (c < 960) return 640 + dperm(c - 896);
    if (c < 964) return 704 + (c - 960);
    if (c < 1476) { const int j = c - 964; return 1024 + 256 * (j >> 7) + (j & 127); }
    { const int j = c - 1476; return 1024 + 256 * (j >> 7) + 128 + (j & 127); }
}
__device__ __forceinline__ void wt_body(LAS unsigned char* sm, int vb, int tid, const float* __restrict__ W, int K, int N, bf16_t* WT, const float* __restrict__ gain, int mode) {
    LAS float* t = (LAS float*)sm;
    const int nbx = (N + 31) / 32; const int k0 = (vb / nbx) * 32, n0 = (vb % nbx) * 32, tx = tid & 31, ty = tid >> 5;
    for (int i = ty; i < 32; i += 8) { const int k = k0 + i, n = n0 + tx; float v = 0.f; if (k < K && n < N) { v = W[(size_t)k * N + n]; if (gain) v *= gain[k]; } t[i * 33 + tx] = v; }
    __syncthreads();
    for (int i = ty; i < 32; i += 8) { const int n = n0 + i, k = k0 + tx; if (n < N && k < K) WT[(size_t)wt_dst_row(mode, n) * K + k] = f2bf(t[tx * 33 + i]); }
    __syncthreads();
}
__device__ __forceinline__ void rmsnorm_bf16_row(const float* x, const float* __restrict__ g, bf16_t* out, int row, int lane) {
    const f32x4* xr = (const f32x4*)(x + (size_t)row * DM) + lane; const f32x4* gr = (const f32x4*)g + lane;
    f32x4 v[4]; float s = 0.f;
#pragma unroll
    for (int j = 0; j < 4; ++j) { v[j] = xr[64 * j]; s += (v[j].x * v[j].x + v[j].y * v[j].y) + (v[j].z * v[j].z + v[j].w * v[j].w); }
    const float rstd = 1.f / sqrtf(wave_sum_l(s, lane) * (1.f / DM) + EPS);
    u32x2* o = (u32x2*)(out + (size_t)row * DM) + lane;
#pragma unroll
    for (int j = 0; j < 4; ++j) { const f32x4 gg = gr[64 * j]; u32x2 w;
        w.x = (unsigned)f2bf(v[j].x * rstd * gg.x) | ((unsigned)f2bf(v[j].y * rstd * gg.y) << 16);
        w.y = (unsigned)f2bf(v[j].z * rstd * gg.z) | ((unsigned)f2bf(v[j].w * rstd * gg.w) << 16); o[64 * j] = w; }
}
__device__ __forceinline__ void rmsnorm_f32_row(float* x, const float* __restrict__ g, int row, int lane) {
    f32x4* xr = (f32x4*)(x + (size_t)row * DM) + lane; const f32x4* gr = (const f32x4*)g + lane;
    f32x4 v[4]; float s = 0.f;
#pragma unroll
    for (int j = 0; j < 4; ++j) { v[j] = xr[64 * j]; s += (v[j].x * v[j].x + v[j].y * v[j].y) + (v[j].z * v[j].z + v[j].w * v[j].w); }
    const float rstd = 1.f / sqrtf(wave_sum_l(s, lane) * (1.f / DM) + EPS);
#pragma unroll
    for (int j = 0; j < 4; ++j) { const f32x4 gg = gr[64 * j]; xr[64 * j] = v[j] * rstd * gg; }
}

constexpr size_t MiB = 1u << 20;
constexpr int LDS_USER = 139264, LDSCTL_OFF = LDS_USER, MISC_OFF = LDSCTL_OFF + 320, LDS_BYTES = 147456;
constexpr size_t WS_CTL = 476 * MiB, CTL_ZERO_BYTES = 1 * MiB; constexpr int CW_BAR = 4096;
constexpr int NGU = 2 * DFF;
struct Args { const float* in[23]; float* out; unsigned char* ws; };
static_assert(sizeof(Args) == 25 * 8, "Args has no padding");

__global__ void __launch_bounds__(512, 2) mega_k(Args a) {
    extern __shared__ __attribute__((aligned(16))) unsigned char lds_raw[];
    LAS unsigned char* lds = (LAS unsigned char*)lds_raw;
    const int wave = __builtin_amdgcn_readfirstlane(threadIdx.x >> 6);
#define PH_IDS() int lane; asm volatile("v_mbcnt_lo_u32_b32 %0, -1, 0\n\tv_mbcnt_hi_u32_b32 %0, -1, %0" : "=v"(lane)); const int tid = wave * 64 + lane, half = wave >> 2, htid = tid & 255; LAS unsigned char* hsm = lds + half * 65536; (void)htid; (void)hsm
    const int G = gridDim.x, bx = blockIdx.x; const int vcu = (G % 8 == 0) ? (bx % 8) * (G / 8) + bx / 8 : bx;
    const float* x = a.in[0]; const float* mem = a.in[1]; const int* positions = (const int*)a.in[2];
    const float* g_mix = a.in[3]; const float* w_in = a.in[4]; const float* w_out = a.in[5];
    const float* conv_b_w = a.in[6]; const float* conv_b_b = a.in[7]; const float* ln_b_g = a.in[8]; const float* ln_b_b = a.in[9];
    const float* g_cross = a.in[10]; const float* g_mem = a.in[11];
    const float* w_q = a.in[12]; const float* w_k = a.in[13]; const float* w_v = a.in[14]; const float* w_o = a.in[15];
    const float* g_ffn = a.in[16]; const float* w_gate = a.in[17]; const float* w_up = a.in[18];
    const float* ffn_cw = a.in[19]; const float* ffn_cb = a.in[20]; const float* w_down = a.in[21]; const float* g_final = a.in[22];
    float* out = a.out; unsigned char* ws = a.ws;
    bf16_t* wt_in = (bf16_t*)(ws + 0 * MiB); bf16_t* wt_out = (bf16_t*)(ws + 4 * MiB);
    bf16_t* wt_q = (bf16_t*)(ws + 6 * MiB), *wt_k = (bf16_t*)(ws + 8 * MiB), *wt_v = (bf16_t*)(ws + 10 * MiB), *wt_o = (bf16_t*)(ws + 12 * MiB);
    bf16_t* wt_gu = (bf16_t*)(ws + 14 * MiB); bf16_t* wt_down = (bf16_t*)(ws + 26 * MiB);
    float* WI = (float*)(ws + 32 * MiB); float* CS = (float*)(ws + 33 * MiB);
    float* SS1 = (float*)(ws + 35 * MiB); float* SS2 = (float*)(ws + 37 * MiB); float* SS3 = (float*)(ws + 39 * MiB);
    bf16_t* MEMN = (bf16_t*)(ws + 41 * MiB), *KC = (bf16_t*)(ws + 45 * MiB), *VC = (bf16_t*)(ws + 49 * MiB);
    bf16_t* XB = (bf16_t*)(ws + 56 * MiB);
    bf16_t* Qb = (bf16_t*)(ws + 120 * MiB); bf16_t* QI = (bf16_t*)(ws + 152 * MiB);
    bf16_t* Kb = (bf16_t*)(ws + 168 * MiB), *Vb = (bf16_t*)(ws + 172 * MiB), *KI = (bf16_t*)(ws + 176 * MiB);
    bf16_t* U = (bf16_t*)(ws + 180 * MiB); unsigned short* SEL = (unsigned short*)(ws + 212 * MiB);
    bf16_t* MIX = (bf16_t*)(ws + 228 * MiB); bf16_t* QC = (bf16_t*)(ws + 292 * MiB); bf16_t* OC = (bf16_t*)(ws + 356 * MiB);
    bf16_t* Hb = (bf16_t*)(ws + 120 * MiB);
    float* TOPG = (float*)(ws + 300 * MiB); float* TOPU = (float*)(ws + 304 * MiB); float* BOTG = (float*)(ws + 308 * MiB);
    unsigned* ctl = (unsigned*)(ws + WS_CTL);

    { PH_IDS(); for (int u = tid; u < (LDS_BYTES - LDSCTL_OFF) / 4; u += 512) ((LAS unsigned*)(lds + LDSCTL_OFF))[u] = 0u; }
    __syncthreads();
    XcdBarrier bar = xcd_barrier_post(ctl + CW_BAR, (volatile LAS unsigned*)(lds + MISC_OFF) + 8);
#define GRID_BAR() xcd_barrier(bar)
#define FOR_VB(nvb) for (int vb = 2 * bx + half; vb < (nvb); vb += 2 * G)
#define GEMMX(EPI, EINIT, Aptr, Bptr, Mv, Nv, Kv) do { pg8::Gemm g_{Aptr, Bptr, Mv, Nv, Kv}; pg8::StaticOrder S_; S_.init(Mv, Nv, G, bx); EPI E_ EINIT; \
        PH_IDS(); pg8::gemm_phase<EPI, pg8::StaticOrder, true, true>(lds, g_, S_, E_, tid); } while (0)
#define EI(...) {__VA_ARGS__}

    { PH_IDS();
    for (int i = bx * 512 + tid; i < 60 * DM; i += G * 512) wt_in[(size_t)708 * DM + i] = 0;
    FOR_VB(32 * 63) wt_body(hsm, vb, htid, w_in, DM, INC, wt_in, nullptr, 1);
    FOR_VB(32 * 32) wt_body(hsm, vb, htid, w_out, DM, DM, wt_out, nullptr, 0);
    FOR_VB(32 * 32) wt_body(hsm, vb, htid, w_q, DM, DM, wt_q, g_cross, 0);
    FOR_VB(32 * 32) wt_body(hsm, vb, htid, w_k, DM, DM, wt_k, nullptr, 0);
    FOR_VB(32 * 32) wt_body(hsm, vb, htid, w_v, DM, DM, wt_v, nullptr, 0);
    FOR_VB(32 * 32) wt_body(hsm, vb, htid, w_o, DM, DM, wt_o, nullptr, 0);
    FOR_VB(32 * 88) wt_body(hsm, vb, htid, w_gate, DM, DFF, wt_gu, g_ffn, 2);
    FOR_VB(32 * 88) wt_body(hsm, vb, htid, w_up, DM, DFF, wt_gu, g_ffn, 3);
    FOR_VB(88 * 32) wt_body(hsm, vb, htid, w_down, DFF, DM, wt_down, nullptr, 0);
    for (int i = bx * 512 + tid; i < MTOK * 8; i += G * 512) { const int row = i >> 3, k = i & 7;
        const float freq = (float)pow(500000.0, -0.125 * (double)k); const float ang = (float)positions[row] * freq;
        CS[(size_t)row * 16 + k] = (float)cos((double)ang); CS[(size_t)row * 16 + 8 + k] = (float)sin((double)ang); }
    for (int r = bx * 8 + wave; r < MTOK; r += G * 8) rmsnorm_bf16_row(x, g_mix, XB, r, lane);
    for (int r = bx * 8 + wave; r < MMEM; r += G * 8) rmsnorm_bf16_row(mem, g_mem, MEMN, r, lane);
    }
    GRID_BAR();
    GEMMX(EpiIn, EI(CS, Qb, Kb, Vb, QI, KI, U, WI), XB, wt_in, MTOK, INP, DM);
    GEMMX(EpiStore, EI(nullptr, KC, nullptr, DM), MEMN, wt_k, MMEM, DM, DM);
    GEMMX(EpiStore, EI(nullptr, VC, nullptr, MMEM), wt_v, MEMN, DM, MMEM, DM);
    GRID_BAR();
    { PH_IDS(); topk_phase(lds, G, vcu, QI, KI, WI, SEL, tid, lane, wave); }
    { PH_IDS(); convb_phase(lds, G, vcu, U, conv_b_w, conv_b_b, ln_b_g, ln_b_b, MIX, tid, lane, wave); }
    GRID_BAR();
    { PH_IDS(); sparse_attn_phase(lds, G, vcu, Qb, Kb, Vb, SEL, MIX, lane, wave); }
    GRID_BAR();
    GEMMX(EpiRes, EI(x, nullptr, nullptr, XB, SS1), MIX, wt_out, MTOK, DM, DM);
    GRID_BAR();
    GEMMX(EpiScale, EI(SS1, QC, DM, 1.0f), XB, wt_q, MTOK, DM, DM);
    GRID_BAR();
    { PH_IDS(); const int per = (512 + G - 1) / G; for (int i = 0; i < per; ++i) { const int u = vcu * per + i; if (u < 512) cross_attn_unit(lds, u >> 6, (u >> 4) & 3, u & 15, QC, KC, VC, OC, tid, lane, wave); } }
    GRID_BAR();
    GEMMX(EpiRes, EI(nullptr, XB, nullptr, XB, SS2), OC, wt_o, MTOK, DM, DM);
    GRID_BAR();
    GEMMX(EpiGateUpAct, EI(SS2, Hb, ffn_cw, ffn_cb, TOPG, TOPU, BOTG, lds + 131072), XB, wt_gu, MTOK, NGU, DM);
    GRID_BAR();
    { PH_IDS();
    for (int i = bx * 512 + tid; i < (MTOK / 256) * 2 * DFF; i += G * 512) {
        const int pm = i / (2 * DFF), rem = i - pm * (2 * DFF), j = rem / DFF, c = rem - j * DFF;
        const bool first = (pm & 15) == 0;
        const float gm2 = first ? 0.f : BOTG[((size_t)(pm - 1) * 2 + 0) * DFF + c], gm1 = first ? 0.f : BOTG[((size_t)(pm - 1) * 2 + 1) * DFF + c];
        const float g0 = TOPG[((size_t)pm * 2 + 0) * DFF + c], g1 = TOPG[((size_t)pm * 2 + 1) * DFF + c];
        const float cur = j ? g1 : g0, p1 = j ? g0 : gm1, p2 = j ? gm1 : gm2;
        const float gg = ffn_cb[c] + ffn_cw[2 * DFF + c] * cur + ffn_cw[DFF + c] * p1 + ffn_cw[c] * p2;
        Hb[((size_t)pm * 256 + j) * DFF + c] = f2bf(silu_f(gg) * TOPU[((size_t)pm * 2 + j) * DFF + c]);
    }
    }
    GRID_BAR();
    GEMMX(EpiRes, EI(nullptr, XB, out, nullptr, SS3), Hb, wt_down, MTOK, DM, DFF);
    GRID_BAR();
    { PH_IDS();
    for (int r = bx * 8 + wave; r < MTOK; r += G * 8) {
        const float rs = rstd_from_ss(SS3, (size_t)r);
        f32x4* xr = (f32x4*)(out + (size_t)r * DM) + lane; const f32x4* gr = (const f32x4*)g_final + lane;
#pragma unroll
        for (int j = 0; j < 4; ++j) xr[64 * j] = xr[64 * j] * rs * gr[64 * j];
    }
    }
}

extern "C" void kernel_launch(void* const* d_in, const int* in_sizes, int n_in, void* d_out, int out_size, void* d_ws, size_t ws_size, hipStream_t stream) {
    static int grid = 0;
    if (grid == 0) {
        int dev = 0, cus = 0, per_cu = 0;
        if (hipGetDevice(&dev) != hipSuccess || hipDeviceGetAttribute(&cus, hipDeviceAttributeMultiprocessorCount, dev) != hipSuccess) { fprintf(stderr, "kernel_launch: device query failed\n"); grid = -1; return; }
        if (hipFuncSetAttribute((const void*)mega_k, hipFuncAttributeMaxDynamicSharedMemorySize, LDS_BYTES) != hipSuccess) { fprintf(stderr, "kernel_launch: hipFuncSetAttribute failed\n"); grid = -1; return; }
        if (hipOccupancyMaxActiveBlocksPerMultiprocessor(&per_cu, (const void*)mega_k, 512, LDS_BYTES) != hipSuccess || per_cu < 1) { fprintf(stderr, "kernel_launch: occupancy query says %d\n", per_cu); per_cu = 1; }
        (void)hipGetLastError();
        grid = cus * 1;
        if (n_in != 23 || ws_size < 477 * MiB) { fprintf(stderr, "kernel_launch: unexpected n_in %d / ws %zu\n", n_in, ws_size); grid = -1; return; }
    }
    if (grid < 0) return;
    (void)hipMemsetAsync((char*)d_ws + WS_CTL, 0, CTL_ZERO_BYTES, stream);
    Args a{};
    for (int i = 0; i < 23; ++i) a.in[i] = (const float*)d_in[i];
    a.out = (float*)d_out; a.ws = (unsigned char*)d_ws;
    void* params[] = {&a};
    hipError_t e = hipLaunchCooperativeKernel((const void*)mega_k, dim3(grid), dim3(512), params, LDS_BYTES, stream);
    if (e != hipSuccess) fprintf(stderr, "cooperative launch failed: %s (grid %d)\n", hipGetErrorString(e), grid);
}
```

```cpp
#include <hip/hip_runtime.h>
#include <cstdio>
#include <cstdint>
#include <cmath>
namespace pg8 {
#define PG8_LAS __attribute__((address_space(3)))
typedef unsigned short bf16_t;
typedef short bf16x8 __attribute__((ext_vector_type(8)));
typedef float f32x4 __attribute__((ext_vector_type(4)));
typedef unsigned u32x4 __attribute__((ext_vector_type(4)));
constexpr int BM = 256, BK = 64, HALF = 128, HTB = HALF * BK * 2  , STAGE_BYTES = 8 * HTB, NXCD = 8, WGM = 8;

__host__ __device__ __forceinline__ int lds_byte(int r, int c) { const int st = (r >> 4) * 2 + (c >> 5), rr = r & 15, cc = c & 31, ob = rr * 64 + cc * 2; return st * 1024 + (ob ^ (((ob >> 9) & 1) << 5)); }
__host__ __device__ __forceinline__ void stage_rc(int b, int& R, int& C) { const int st = b / 1024, sb = b % 1024, swz = sb ^ (((sb >> 9) & 1) << 5); R = (st >> 1) * 16 + swz / 64; C = (st & 1) * 32 + (swz % 64) / 2; }
__host__ __device__ __forceinline__ int perm32(int rho) { const int n = rho >> 4, i = rho & 15; return 8 * (i >> 2) + 4 * n + (i & 3); }

struct Unit { int pm, pn; };
struct Gemm { const bf16_t* A; const bf16_t* Bt; int M, N, K; };

struct StaticOrder {
    int nM, nN, nwg, G, c;
    __host__ __device__ void init(int M, int N, int G_, int c_) { nM = M / BM; nN = N / BM; nwg = nM * nN; G = G_; c = c_; }
    __host__ __device__ bool next(int i, Unit& u) const {
        const long L = (long)i * G + c; if (L >= nwg) return false;
        int wgid = (int)L; { const int q = nwg / NXCD, r = nwg % NXCD, xcd = wgid % NXCD, off = wgid / NXCD; wgid = (xcd < r ? xcd * (q + 1) : r * (q + 1) + (xcd - r) * q) + off; }
        const int nig = WGM * nN, gid = wgid / nig, fm = gid * WGM, gsz = (nM - fm) < WGM ? (nM - fm) : WGM;
        u.pm = fm + ((wgid % nig) % gsz); u.pn = (wgid % nig) / gsz; return true;
    }
    __device__ __forceinline__ void a_ready(const Unit&) const {}
    __device__ __forceinline__ void done(const Unit&) const {}
};
__device__ __forceinline__ unsigned cvt_pk_bf16(float lo, float hi) { unsigned r; asm volatile("v_cvt_pk_bf16_f32 %0, %1, %2" : "=v"(r) : "v"(lo), "v"(hi)); return r; }
template <class Epi, class Sched, bool ALIGN_EPI = false, bool SP2 = false>
__device__ __forceinline__ void gemm_phase(PG8_LAS unsigned char* lds, const Gemm g, const Sched& S, const Epi& E, int tid_in) {
    int tid_l = tid_in; asm volatile("" : "+v"(tid_l));
    const int tid = tid_l, wid = __builtin_amdgcn_readfirstlane(tid >> 6), lane = tid & 63, wr = wid >> 2, wc = wid & 3, fr = lane & 15, fq = lane >> 4;
    const int K = g.K, nt = K / BK;
    unsigned voffA[2], voffB[2];
#pragma unroll
    for (int i = 0; i < 2; ++i) { int R, C; stage_rc(tid * 16 + i * 8192, R, C); const int Rb = Epi::PERM ? ((R & ~31) + perm32(R & 31)) : R;
        voffA[i] = (unsigned)(R * K + C) * 2u; voffB[i] = (unsigned)(Rb * K + C) * 2u; }
    const size_t kstep = (size_t)(BK * 2);
    const size_t hstep = (size_t)HALF * K * 2;
    const size_t tstep = 2 * hstep;
    const unsigned ldsw = (unsigned)wid * 1024u;
    const int aoff = lds_byte(wr * 64 + fr, fq * 8), boff = lds_byte(wc * 32 + fr, fq * 8);
#define PG8_SA(b, h) (((b) * 2 + (h)) * HTB)
#define PG8_SB(b, h) ((4 + (b) * 2 + (h)) * HTB)
#define PG8_STAGE(bufoff, gbase, voff) do { _Pragma("unroll") for (int _i = 0; _i < 2; ++_i) \
        __builtin_amdgcn_global_load_lds((const unsigned*)((const char*)(gbase) + (voff)[_i]), (PG8_LAS unsigned*)(lds + (bufoff) + ldsw + _i * 8192), 16, 0, 0); } while (0)
#define PG8_LDA(dst, b, h) do { _Pragma("unroll") for (int m = 0; m < 4; ++m) _Pragma("unroll") for (int k = 0; k < 2; ++k) dst[m][k] = *(const PG8_LAS bf16x8*)(lds + PG8_SA(b, h) + aoff + m * 2048 + k * 1024); } while (0)
#define PG8_LDB(dst, b, h) do { _Pragma("unroll") for (int n = 0; n < 2; ++n) _Pragma("unroll") for (int k = 0; k < 2; ++k) dst[n][k] = *(const PG8_LAS bf16x8*)(lds + PG8_SB(b, h) + boff + n * 2048 + k * 1024); } while (0)
#define PG8_MMA(ai, bj, At, Bt) do { __builtin_amdgcn_s_setprio(1); _Pragma("unroll") for (int m = 0; m < 4; ++m) _Pragma("unroll") for (int n = 0; n < 2; ++n) _Pragma("unroll") for (int k = 0; k < 2; ++k) \
        acc[ai][bj][m][n] = __builtin_amdgcn_mfma_f32_16x16x32_bf16(Bt[n][k], At[m][k], acc[ai][bj][m][n], 0, 0, 0); __builtin_amdgcn_s_setprio(0); } while (0)
#define PG8_WAIT_V(n) asm volatile("s_waitcnt vmcnt(" #n ")" ::: "memory")
#define PG8_WAIT_L(n) asm volatile("s_waitcnt lgkmcnt(" #n ")" ::: "memory")
#define PG8_BAR __builtin_amdgcn_s_barrier()
#define PG8_SCHED __builtin_amdgcn_sched_barrier(0)
    Unit cur, nxt; int ui = 0;
    if (!S.next(0, cur)) return;
    f32x4 acc[2][2][4][2];
#pragma unroll
    for (int a = 0; a < 2; ++a)
#pragma unroll
        for (int b = 0; b < 2; ++b)
#pragma unroll
            for (int m = 0; m < 4; ++m)
#pragma unroll
                for (int n = 0; n < 2; ++n) acc[a][b][m][n] = (f32x4){0.f, 0.f, 0.f, 0.f};
    bf16x8 At[4][2], B0[2][2], B1[2][2];
    const char* cA = (const char*)g.A + (size_t)cur.pm * tstep; const char* cB = (const char*)g.Bt + (size_t)cur.pn * tstep;
    S.a_ready(cur);
    if constexpr (SP2) {
        PG8_STAGE(PG8_SB(0, 0), cB, voffB); PG8_STAGE(PG8_SB(0, 1), cB + hstep, voffB); PG8_STAGE(PG8_SA(0, 0), cA, voffA); PG8_STAGE(PG8_SA(0, 1), cA + hstep, voffA);
        if (wr == 1) PG8_BAR;
        PG8_WAIT_V(2); PG8_BAR;
        PG8_STAGE(PG8_SB(1, 0), cB + kstep, voffB); PG8_STAGE(PG8_SA(1, 0), cA + kstep, voffA); PG8_STAGE(PG8_SB(1, 1), cB + hstep + kstep, voffB);
        PG8_WAIT_V(6); PG8_BAR;
    } else {
        PG8_STAGE(PG8_SB(0, 0), cB, voffB); PG8_STAGE(PG8_SA(0, 0), cA, voffA); PG8_STAGE(PG8_SB(0, 1), cB + hstep, voffB); PG8_STAGE(PG8_SA(0, 1), cA + hstep, voffA);
        if (wr == 1) PG8_BAR;
        PG8_WAIT_V(4); PG8_BAR;
        PG8_STAGE(PG8_SB(1, 0), cB + kstep, voffB); PG8_STAGE(PG8_SA(1, 0), cA + kstep, voffA); PG8_STAGE(PG8_SB(1, 1), cB + hstep + kstep, voffB);
        PG8_WAIT_V(6); PG8_BAR;
    }
    for (;;) {
        const bool has_next = S.next(ui + 1, nxt);
        const char* nA = has_next ? (const char*)g.A + (size_t)nxt.pm * tstep : cA; const char* nB = has_next ? (const char*)g.Bt + (size_t)nxt.pn * tstep : cB;
        for (int t = 0; t < nt; t += 2) {
            const bool last = (t == nt - 2);
            const char* a1 = cA + (size_t)(t + 1) * kstep;
            const char* a2 = last ? nA : cA + (size_t)(t + 2) * kstep; const char* b2 = last ? nB : cB + (size_t)(t + 2) * kstep;
            const char* a3 = a2 + kstep; const char* b3 = b2 + kstep;
            if (last && has_next) S.a_ready(nxt);
            if constexpr (SP2) {
            PG8_LDB(B0, 0, 0); PG8_LDB(B1, 0, 1); PG8_SCHED; PG8_LDA(At, 0, 0); PG8_STAGE(PG8_SA(1, 1), a1 + hstep, voffA);
            PG8_WAIT_V(8); PG8_WAIT_L(0); PG8_BAR; PG8_MMA(0, 0, At, B0); PG8_MMA(0, 1, At, B1); PG8_BAR; PG8_SCHED;
            PG8_LDA(At, 0, 1); PG8_STAGE(PG8_SB(0, 0), b2, voffB); PG8_STAGE(PG8_SB(0, 1), b2 + hstep, voffB); PG8_STAGE(PG8_SA(0, 0), a2, voffA);
            PG8_WAIT_V(8); PG8_WAIT_L(0); PG8_BAR; PG8_MMA(1, 0, At, B0); PG8_MMA(1, 1, At, B1); PG8_BAR; PG8_SCHED;
            PG8_LDB(B0, 1, 0); PG8_LDB(B1, 1, 1); PG8_SCHED; PG8_LDA(At, 1, 0); PG8_STAGE(PG8_SA(0, 1), a2 + hstep, voffA);
            PG8_WAIT_V(8); PG8_WAIT_L(0); PG8_BAR; PG8_MMA(0, 0, At, B0); PG8_MMA(0, 1, At, B1); PG8_BAR; PG8_SCHED;
            PG8_LDA(At, 1, 1); PG8_STAGE(PG8_SB(1, 0), b3, voffB); PG8_STAGE(PG8_SB(1, 1), b3 + hstep, voffB); PG8_STAGE(PG8_SA(1, 0), a3, voffA);
            PG8_WAIT_V(8); PG8_WAIT_L(0); PG8_BAR; PG8_MMA(1, 0, At, B0); PG8_MMA(1, 1, At, B1); PG8_BAR; PG8_SCHED;
            } else {
            PG8_LDB(B0, 0, 0); PG8_SCHED; PG8_LDA(At, 0, 0); PG8_STAGE(PG8_SA(1, 1), a1 + hstep, voffA);
            PG8_WAIT_L(8); PG8_BAR; PG8_WAIT_L(0); PG8_MMA(0, 0, At, B0); PG8_BAR; PG8_SCHED;
            PG8_LDB(B1, 0, 1); PG8_STAGE(PG8_SB(0, 0), b2, voffB);
            PG8_BAR; PG8_WAIT_L(0); PG8_MMA(0, 1, At, B1); PG8_BAR;
            PG8_LDA(At, 0, 1); PG8_STAGE(PG8_SA(0, 0), a2, voffA);
            PG8_BAR; PG8_WAIT_L(0); PG8_MMA(1, 0, At, B0); PG8_BAR; PG8_SCHED;
            PG8_STAGE(PG8_SB(0, 1), b2 + hstep, voffB);
            PG8_WAIT_V(6); PG8_BAR; PG8_MMA(1, 1, At, B1); PG8_BAR;
            PG8_LDB(B0, 1, 0); PG8_SCHED; PG8_LDA(At, 1, 0); PG8_STAGE(PG8_SA(0, 1), a2 + hstep, voffA);
            PG8_WAIT_L(8); PG8_BAR; PG8_WAIT_L(0); PG8_MMA(0, 0, At, B0); PG8_BAR; PG8_SCHED;
            PG8_LDB(B1, 1, 1); PG8_STAGE(PG8_SB(1, 0), b3, voffB);
            PG8_BAR; PG8_WAIT_L(0); PG8_MMA(0, 1, At, B1); PG8_BAR;
            PG8_LDA(At, 1, 1); PG8_STAGE(PG8_SA(1, 0), a3, voffA);
            PG8_BAR; PG8_WAIT_L(0); PG8_MMA(1, 0, At, B0); PG8_BAR; PG8_SCHED;
            PG8_STAGE(PG8_SB(1, 1), b3 + hstep, voffB);
            PG8_WAIT_V(6); PG8_BAR; PG8_MMA(1, 1, At, B1); PG8_BAR;
            }
        }
        if constexpr (ALIGN_EPI) { if (wr == 0) PG8_BAR; }
        if constexpr (!Epi::AFTER_DRAIN) { E(acc, cur, wr, wc, fr, fq); S.done(cur); }
        if (!has_next) break;
#pragma unroll
        for (int a = 0; a < 2; ++a)
#pragma unroll
            for (int b = 0; b < 2; ++b)
#pragma unroll
                for (int m = 0; m < 4; ++m)
#pragma unroll
                    for (int n = 0; n < 2; ++n) acc[a][b][m][n] = (f32x4){0.f, 0.f, 0.f, 0.f};
        cur = nxt; cA = nA; cB = nB; ++ui;
        if constexpr (ALIGN_EPI) { if (wr == 1) PG8_BAR; }
    }
    PG8_WAIT_V(0);
    if constexpr (!ALIGN_EPI) { if (wr == 0) PG8_BAR; }
    PG8_BAR;
    if constexpr (Epi::AFTER_DRAIN) { E.fused(acc, cur, wr, wc, fr, fq, lds, wid, lane); S.done(cur); }
#undef PG8_SA
#undef PG8_SB
#undef PG8_STAGE
#undef PG8_LDA
#undef PG8_LDB
#undef PG8_MMA
#undef PG8_WAIT_V
#undef PG8_WAIT_L
#undef PG8_BAR
#undef PG8_SCHED
}
}

constexpr int BATCH = 8, SEQ = 4096, DM = 1024, MTOK = BATCH * SEQ;
constexpr int NMEM = 256, MMEM = BATCH * NMEM;
constexpr int AW = 512, HD = 64, NH = 8, IH = 4, TOPK = 256;
constexpr int INC = 1988, INP = 2048;
constexpr int DFF = 2816;
constexpr float EPS = 1e-6f;
#define LAS __attribute__((address_space(3)))
typedef unsigned short bf16_t;
typedef float f32x4 __attribute__((ext_vector_type(4)));
typedef unsigned u32x4 __attribute__((ext_vector_type(4)));
typedef unsigned u32x2 __attribute__((ext_vector_type(2)));

__device__ __forceinline__ float bf2f(bf16_t v) { return __uint_as_float((unsigned)v << 16); }
__device__ __forceinline__ bf16_t f2bf(float f) { unsigned u = __float_as_uint(f); return (bf16_t)((u + 0x7fffu + ((u >> 16) & 1u)) >> 16); }
__device__ __forceinline__ float shx(float v, int lane, int o) { return __uint_as_float((unsigned)__builtin_amdgcn_ds_bpermute((lane ^ o) << 2, (int)__float_as_uint(v))); }
__device__ __forceinline__ float wave_sum_l(float v, int lane) {
#pragma unroll
    for (int o = 1; o < 64; o <<= 1) v += shx(v, lane, o);
    return v;
}
__device__ __forceinline__ float wave_sum(float v) {
#pragma unroll
    for (int o = 1; o < 64; o <<= 1) v += __shfl_xor(v, o);
    return v;
}
__device__ __forceinline__ float wave_max(float v) {
#pragma unroll
    for (int o = 1; o < 64; o <<= 1) v = fmaxf(v, __shfl_xor(v, o));
    return v;
}
__device__ __forceinline__ float silu_f(float v) { return v / (1.f + __expf(-v)); }

struct EpiStore {
    static constexpr bool PERM = false, AFTER_DRAIN = false;
    float* outf; bf16_t* outb; const float* res; int ldc;
    __device__ __forceinline__ void operator()(const pg8::f32x4 (&acc)[2][2][4][2], const pg8::Unit& u, int wr, int wc, int fr, int fq) const {
        const int col0 = u.pn * 256 + wc * 32 + 4 * fq;
#pragma unroll
        for (int ai = 0; ai < 2; ++ai)
#pragma unroll
            for (int m = 0; m < 4; ++m) {
                const size_t row = (size_t)(u.pm * 256 + ai * 128 + wr * 64 + m * 16 + fr);
#pragma unroll
                for (int bj = 0; bj < 2; ++bj)
#pragma unroll
                    for (int n = 0; n < 2; ++n) {
                        const size_t off = row * ldc + col0 + bj * 128 + n * 16;
                        pg8::f32x4 v = acc[ai][bj][m][n];
                        if (res) { const pg8::f32x4 r = *(const pg8::f32x4*)(res + off); v = v + r; }
                        if (outf) *(pg8::f32x4*)(outf + off) = v;
                        if (outb) { u32x2 w; w.x = (unsigned)f2bf(v[0]) | ((unsigned)f2bf(v[1]) << 16); w.y = (unsigned)f2bf(v[2]) | ((unsigned)f2bf(v[3]) << 16); *(u32x2*)(outb + off) = w; }
                    }
            }
    }
};
#define XB_TMO      128
#define XB_XCNT(j)  (256  + 64 * (j))
#define XB_XSUB(j)  (1280 + 64 * (j))
#define XB_XGEN(j)  (2304 + 64 * (j))
#define XB_TOP      3328
#define XB_TOPGEN   3392
#define XCD_BAR_WORDS 3456
#define XB_SPIN_CAP (1u << 18)

__device__ __forceinline__ unsigned xb_ld(unsigned* p)              { return __hip_atomic_load(p, __ATOMIC_RELAXED, __HIP_MEMORY_SCOPE_AGENT); }
__device__ __forceinline__ unsigned xb_add(unsigned* p, unsigned v) { return __hip_atomic_fetch_add(p, v, __ATOMIC_RELAXED, __HIP_MEMORY_SCOPE_AGENT); }
__device__ __forceinline__ unsigned xb_xcc_id() { return (unsigned)__builtin_amdgcn_s_getreg((3 << 11) | 20) & 0xFu; }
#define XB_SPIN(cond, bar) do { unsigned _sp = 0; while (cond) { __builtin_amdgcn_s_sleep(1); \
    if ((++_sp & 255u) == 0u) { if (xb_ld(&(bar)[XB_TMO])) break; if (_sp > XB_SPIN_CAP) { atomicAdd(&(bar)[XB_TMO], 1u); break; } } } } while (0)

struct XcdBarrier {
    unsigned* bar; unsigned x;
    volatile LAS unsigned* st;
};

__device__ __forceinline__ XcdBarrier xcd_barrier_post(unsigned* bar, volatile LAS unsigned* st) {
    XcdBarrier b; b.bar = bar; b.x = xb_xcc_id(); b.st = st;
    if (threadIdx.x == 0) (void)xb_add(&bar[XB_XCNT(b.x)], 1u);
    return b;
}
__device__ __forceinline__ void xcd_barrier_complete(unsigned* bar, unsigned x, unsigned& nloc, unsigned& nx) {
    const unsigned G = gridDim.x * gridDim.y * gridDim.z;
    unsigned sum, cnt, mine, sp = 0u;
    for (;;) {
        sum = 0u; cnt = 0u; mine = 0u;
#pragma unroll
        for (unsigned j = 0; j < 16; ++j) { const unsigned c = xb_ld(&bar[XB_XCNT(j)]); sum += c; cnt += (c > 0u) ? 1u : 0u; mine = (j == x) ? c : mine; }
        if (sum == G) break;
        __builtin_amdgcn_s_sleep(1);
        if ((++sp & 255u) == 0u) { if (xb_ld(&bar[XB_TMO])) break; if (sp > XB_SPIN_CAP) { atomicAdd(&bar[XB_TMO], 1u); break; } }
    }
    nloc = mine > 0u ? mine : 1u; nx = cnt > 0u ? cnt : 1u;
}

__device__ __forceinline__ void xcd_barrier(const XcdBarrier& b) {
    asm volatile("s_waitcnt vmcnt(0)" ::: "memory");
    __syncthreads();
    if (threadIdx.x == 0) {
        unsigned* bar = b.bar;
        __builtin_amdgcn_s_waitcnt(0);
        unsigned nloc = b.st[0], nx = b.st[1];
        if (nloc == 0u) { xcd_barrier_complete(bar, b.x, nloc, nx); b.st[0] = nloc; b.st[1] = nx; }
        const unsigned old = xb_add(&bar[XB_XSUB(b.x)], 1u);
        const unsigned gen = old / nloc;
        if (old + 1u == (gen + 1u) * nloc) {
            __builtin_amdgcn_fence(__ATOMIC_RELEASE, "agent");
            asm volatile("s_waitcnt vmcnt(0)" ::: "memory");
            const unsigned og = xb_add(&bar[XB_TOP], 1u);
            const unsigned tg = og / nx;
            if (og + 1u == (tg + 1u) * nx) xb_add(&bar[XB_TOPGEN], 1u);
            else XB_SPIN(xb_ld(&bar[XB_TOPGEN]) == tg, bar);
            __builtin_amdgcn_fence(__ATOMIC_ACQUIRE, "agent");
            xb_add(&bar[XB_XGEN(b.x)], 1u);
            asm volatile("s_waitcnt vmcnt(0)" ::: "memory");
        } else {
            XB_SPIN(xb_ld(&bar[XB_XGEN(b.x)]) == gen, bar);
            __builtin_amdgcn_fence(__ATOMIC_ACQUIRE, "agent");
            asm volatile("s_waitcnt vmcnt(0)" ::: "memory");
        }
    }
    __syncthreads();
}

__device__ __forceinline__ u32x4 pack8(const pg8::f32x4 a, const pg8::f32x4 b) {
    u32x4 w; w.x = pg8::cvt_pk_bf16(a[0], a[1]); w.y = pg8::cvt_pk_bf16(a[2], a[3]); w.z = pg8::cvt_pk_bf16(b[0], b[1]); w.w = pg8::cvt_pk_bf16(b[2], b[3]); return w;
}
__device__ __forceinline__ float sigmoid_f(float v) { return 1.f / (1.f + __expf(-v)); }
__host__ __device__ __forceinline__ int dperm(int pos) { return pos < 16 ? (4 * (pos >> 3) + (pos & 3) + 8 * ((pos >> 2) & 1)) : pos; }
__host__ __device__ __forceinline__ int in_orig_col(int n) {
    if (n < 512) return (n & ~63) + dperm(n & 63);
    if (n < 576) return 512 + dperm(n - 512);
    if (n < 640) return 576 + (n - 576);
    if (n < 704) return 896 + dperm(n - 640);
    if (n < 708) return 960 + (n - 704);
    if (n < 768) return -1;
    if (n < 1024) return 640 + ((n - 768) & ~63) + dperm((n - 768) & 63);
    const int i = (n - 1024) >> 8, c = (n - 1024) & 255;
    return c < 128 ? 964 + 128 * i + c : 1476 + 128 * i + (c - 128);
}
struct EpiIn {
    static constexpr bool PERM = true, AFTER_DRAIN = false;
    const float* cs; bf16_t *Q, *K, *V, *QI, *KI, *U; float* WI;
    __device__ __forceinline__ void operator()(const pg8::f32x4 (&acc)[2][2][4][2], const pg8::Unit& u, int wr, int wc, int fr, int fq) const {
        const int pn = u.pn;
        if (pn >= 4) {
            const int ch = 128 * (pn - 4) + 32 * wc + 8 * fq;
#pragma unroll
            for (int ai = 0; ai < 2; ++ai)
#pragma unroll
                for (int m = 0; m < 4; ++m) { const size_t row = (size_t)(u.pm * 256 + ai * 128 + wr * 64 + m * 16 + fr);
                    pg8::f32x4 a0 = acc[ai][0][m][0], a1 = acc[ai][0][m][1]; const pg8::f32x4 g0 = acc[ai][1][m][0], g1 = acc[ai][1][m][1];
#pragma unroll
                    for (int k = 0; k < 4; ++k) { a0[k] *= sigmoid_f(g0[k]); a1[k] *= sigmoid_f(g1[k]); }
                    *(u32x4*)(U + row * 512 + ch) = pack8(a0, a1); }
            return;
        }
        const bool rot = (pn == 2) ? (wc == 0 && fq < 2) : ((wc & 1) == 0 && fq < 2);
#pragma unroll
        for (int ai = 0; ai < 2; ++ai)
#pragma unroll
            for (int m = 0; m < 4; ++m) { const size_t row = (size_t)(u.pm * 256 + ai * 128 + wr * 64 + m * 16 + fr);
                pg8::f32x4 cv = {1.f, 1.f, 1.f, 1.f}, sv = {0.f, 0.f, 0.f, 0.f};
                if (rot) { cv = *(const pg8::f32x4*)(cs + row * 16 + 4 * fq); sv = *(const pg8::f32x4*)(cs + row * 16 + 8 + 4 * fq); }
#pragma unroll
                for (int bj = 0; bj < 2; ++bj) {
                    const pg8::f32x4 v0 = acc[ai][bj][m][0], v1 = acc[ai][bj][m][1];
                    pg8::f32x4 n0 = v0 * cv - v1 * sv, n1 = v1 * cv + v0 * sv;
                    if (!rot) { n0 = v0; n1 = v1; }
                    const int c = 128 * bj + 32 * wc + 8 * fq;
                    if (pn < 2) *(u32x4*)(Q + row * 512 + 256 * pn + c) = pack8(n0, n1);
                    else if (pn == 3) *(u32x4*)(QI + row * 256 + c) = pack8(n0 * 0.125f, n1 * 0.125f);
                    else {
                        if (bj == 0) { if (wc < 2) *(u32x4*)(K + row * 64 + 32 * wc + 8 * fq) = pack8(n0, n1); else *(u32x4*)(V + row * 64 + 32 * (wc - 2) + 8 * fq) = pack8(v0, v1); }
                        else { if (wc < 2) *(u32x4*)(KI + row * 64 + 32 * wc + 8 * fq) = pack8(n0, n1); else if (wc == 2 && fq == 0) *(pg8::f32x4*)(WI + row * 4) = v0 * 0.5f; }
                    }
                }
            }
    }
};
struct EpiRes {
    static constexpr bool PERM = true, AFTER_DRAIN = false;
    const float* resf; const bf16_t* resb; float* outf; bf16_t* xb; float* ss;
    __device__ __forceinline__ void operator()(const pg8::f32x4 (&acc)[2][2][4][2], const pg8::Unit& u, int wr, int wc, int fr, int fq) const {
#pragma unroll
        for (int ai = 0; ai < 2; ++ai)
#pragma unroll
            for (int m = 0; m < 4; ++m) { const size_t row = (size_t)(u.pm * 256 + ai * 128 + wr * 64 + m * 16 + fr); float q = 0.f;
#pragma unroll
                for (int bj = 0; bj < 2; ++bj) { const size_t off = row * DM + u.pn * 256 + 128 * bj + 32 * wc + 8 * fq;
                    pg8::f32x4 r0, r1;
                    if (resf) { r0 = *(const pg8::f32x4*)(resf + off); r1 = *(const pg8::f32x4*)(resf + off + 4); }
                    else { const u32x4 rb = *(const u32x4*)(resb + off);
                        r0 = (pg8::f32x4){__uint_as_float(rb.x << 16), __uint_as_float(rb.x & 0xffff0000u), __uint_as_float(rb.y << 16), __uint_as_float(rb.y & 0xffff0000u)};
                        r1 = (pg8::f32x4){__uint_as_float(rb.z << 16), __uint_as_float(rb.z & 0xffff0000u), __uint_as_float(rb.w << 16), __uint_as_float(rb.w & 0xffff0000u)}; }
                    const pg8::f32x4 v0 = acc[ai][bj][m][0] + r0, v1 = acc[ai][bj][m][1] + r1;
                    if (outf) { *(pg8::f32x4*)(outf + off) = v0; *(pg8::f32x4*)(outf + off + 4) = v1; }
                    if (xb) *(u32x4*)(xb + off) = pack8(v0, v1);
                    q += (v0[0] * v0[0] + v0[1] * v0[1]) + (v0[2] * v0[2] + v0[3] * v0[3]) + (v1[0] * v1[0] + v1[1] * v1[1]) + (v1[2] * v1[2] + v1[3] * v1[3]); }
                { const int lane_ = fq * 16 + fr; q += shx(q, lane_, 16); q += shx(q, lane_, 32); }
                if (fq == 0) ss[row * 16 + u.pn * 4 + wc] = q; }
    }
};
__device__ __forceinline__ float rstd_from_ss(const float* ss, size_t row) {
    const pg8::f32x4 a = *(const pg8::f32x4*)(ss + row * 16), b = *(const pg8::f32x4*)(ss + row * 16 + 4), c = *(const pg8::f32x4*)(ss + row * 16 + 8), d = *(const pg8::f32x4*)(ss + row * 16 + 12);
    const float s = ((a[0] + a[1]) + (a[2] + a[3])) + ((b[0] + b[1]) + (b[2] + b[3])) + ((c[0] + c[1]) + (c[2] + c[3])) + ((d[0] + d[1]) + (d[2] + d[3]));
    return 1.f / sqrtf(s * (1.f / DM) + EPS);
}
struct EpiScale {
    static constexpr bool PERM = true, AFTER_DRAIN = false;
    const float* ss; bf16_t* O; int ldc; float scale;
    __device__ __forceinline__ void operator()(const pg8::f32x4 (&acc)[2][2][4][2], const pg8::Unit& u, int wr, int wc, int fr, int fq) const {
#pragma unroll
        for (int ai = 0; ai < 2; ++ai)
#pragma unroll
            for (int m = 0; m < 4; ++m) { const size_t row = (size_t)(u.pm * 256 + ai * 128 + wr * 64 + m * 16 + fr); const float r = rstd_from_ss(ss, row) * scale;
#pragma unroll
                for (int bj = 0; bj < 2; ++bj) *(u32x4*)(O + row * ldc + u.pn * 256 + 128 * bj + 32 * wc + 8 * fq) = pack8(acc[ai][bj][m][0] * r, acc[ai][bj][m][1] * r); }
    }
};
struct EpiGateUp {
    static constexpr bool PERM = true, AFTER_DRAIN = false;
    const float* ss; bf16_t* Gb; bf16_t* Ub;
    __device__ __forceinline__ void operator()(const pg8::f32x4 (&acc)[2][2][4][2], const pg8::Unit& u, int wr, int wc, int fr, int fq) const {
        const int ch = 128 * u.pn + 32 * wc + 8 * fq;
#pragma unroll
        for (int ai = 0; ai < 2; ++ai)
#pragma unroll
            for (int m = 0; m < 4; ++m) { const size_t row = (size_t)(u.pm * 256 + ai * 128 + wr * 64 + m * 16 + fr); const float r = rstd_from_ss(ss, row);
                *(u32x4*)(Gb + row * DFF + ch) = pack8(acc[ai][0][m][0] * r, acc[ai][0][m][1] * r);
                *(u32x4*)(Ub + row * DFF + ch) = pack8(acc[ai][1][m][0] * r, acc[ai][1][m][1] * r); }
    }
};
struct EpiGateUpAct {
    static constexpr bool PERM = true, AFTER_DRAIN = false;
    const float* ss; bf16_t* H; const float* cw; const float* cb; float* topg; float* topu; float* botg; LAS unsigned char* xch;
    __device__ __forceinline__ void operator()(const pg8::f32x4 (&acc)[2][2][4][2], const pg8::Unit& u, int wr, int wc, int fr, int fq) const {
        const int lane = fq * 16 + fr, chl = 32 * wc + 8 * fq, ch = 128 * u.pn + chl;
        const int l1 = (fq * 16 + ((fr + 15) & 15)) << 2, l2 = (fq * 16 + ((fr + 14) & 15)) << 2;
        (void)lane;
#pragma unroll
        for (int ai = 0; ai < 2; ++ai) { const size_t row = (size_t)(u.pm * 256 + ai * 128 + wr * 64 + 48 + fr); const float r = rstd_from_ss(ss, row);
            if (fr >= 14) { LAS float* p = (LAS float*)xch + ((2 * ai + wr) * 2 + (fr - 14)) * 128 + chl;
                *(LAS pg8::f32x4*)p = acc[ai][0][3][0] * r; *(LAS pg8::f32x4*)(p + 4) = acc[ai][0][3][1] * r; } }
        asm volatile("s_waitcnt lgkmcnt(0)" ::: "memory"); __builtin_amdgcn_s_barrier(); asm volatile("" ::: "memory");
        pg8::f32x4 wb[2], w2[2], w1[2], w0[2];
#pragma unroll
        for (int hq = 0; hq < 2; ++hq) { wb[hq] = *(const pg8::f32x4*)(cb + ch + 4 * hq); w2[hq] = *(const pg8::f32x4*)(cw + 2 * DFF + ch + 4 * hq); w1[hq] = *(const pg8::f32x4*)(cw + DFF + ch + 4 * hq); w0[hq] = *(const pg8::f32x4*)(cw + ch + 4 * hq); }
#pragma unroll
        for (int ai = 0; ai < 2; ++ai) {
            const int blk = 2 * ai + wr;
            pg8::f32x4 pv[2] = {{0.f, 0.f, 0.f, 0.f}, {0.f, 0.f, 0.f, 0.f}};
            if (blk > 0 && fr >= 14) { const LAS float* p = (const LAS float*)xch + ((blk - 1) * 2 + (fr - 14)) * 128 + chl; pv[0] = *(const LAS pg8::f32x4*)p; pv[1] = *(const LAS pg8::f32x4*)(p + 4); }
#pragma unroll
            for (int m = 0; m < 4; ++m) { const size_t row = (size_t)(u.pm * 256 + ai * 128 + wr * 64 + m * 16 + fr); const float r = rstd_from_ss(ss, row);
                pg8::f32x4 g[2], uu[2], hh[2];
#pragma unroll
                for (int hq = 0; hq < 2; ++hq) { g[hq] = acc[ai][0][m][hq] * r; uu[hq] = acc[ai][1][m][hq] * r; }
#pragma unroll
                for (int hq = 0; hq < 2; ++hq)
#pragma unroll
                    for (int k = 0; k < 4; ++k) {
                        const float x1 = (fr == 15) ? pv[hq][k] : g[hq][k], x2 = (fr >= 14) ? pv[hq][k] : g[hq][k];
                        const float p1 = __uint_as_float((unsigned)__builtin_amdgcn_ds_bpermute(l1, (int)__float_as_uint(x1)));
                        const float p2 = __uint_as_float((unsigned)__builtin_amdgcn_ds_bpermute(l2, (int)__float_as_uint(x2)));
                        const float gg = wb[hq][k] + w2[hq][k] * g[hq][k] + w1[hq][k] * p1 + w0[hq][k] * p2;
                        hh[hq][k] = gg / (1.f + __expf(-gg)) * uu[hq][k]; }
                *(u32x4*)(H + row * DFF + ch) = pack8(hh[0], hh[1]);
                if (blk == 0 && m == 0 && fr < 2) { float* tg = topg + ((size_t)u.pm * 2 + fr) * DFF + ch; float* tu = topu + ((size_t)u.pm * 2 + fr) * DFF + ch;
                    *(pg8::f32x4*)tg = g[0]; *(pg8::f32x4*)(tg + 4) = g[1]; *(pg8::f32x4*)tu = uu[0]; *(pg8::f32x4*)(tu + 4) = uu[1]; }
                if (blk == 3 && m == 3 && fr >= 14) { float* bg = botg + ((size_t)u.pm * 2 + (fr - 14)) * DFF + ch; *(pg8::f32x4*)bg = g[0]; *(pg8::f32x4*)(bg + 4) = g[1]; }
                pv[0] = g[0]; pv[1] = g[1];
            }
        }
    }
};
typedef short bf16x8v __attribute__((ext_vector_type(8)));
constexpr int CA_STRIDE = 528;
__device__ __forceinline__ void cross_attn_unit(LAS unsigned char* lds, int b, int h, int qb, const bf16_t* QC, const bf16_t* KC, const bf16_t* VT, bf16_t* OC, int tid, int lane, int wave) {
    const int q16 = lane & 15, g = lane >> 4;
    const size_t row0 = (size_t)b * SEQ + (size_t)qb * 256 + wave * 32;
    asm volatile("" : "+v"(tid));
    { const bf16_t* src = KC + ((size_t)b * NMEM + (tid >> 5)) * DM + h * 256 + (tid & 31) * 8; LAS unsigned char* dst = lds + (tid >> 5) * CA_STRIDE + (tid & 31) * 16;
#pragma unroll
      for (int i = 0; i < 16; ++i) { const u32x4 v = *(const u32x4*)(src + (size_t)i * 16 * DM); *(LAS u32x4*)(dst + i * 16 * CA_STRIDE) = v; } }
    __syncthreads();
    f32x4 S[2][16];
#pragma unroll
    for (int st = 0; st < 2; ++st)
#pragma unroll
        for (int kt = 0; kt < 16; ++kt) S[st][kt] = (f32x4){0.f, 0.f, 0.f, 0.f};
#pragma unroll 1
    for (int kh = 0; kh < 2; ++kh) {
        bf16x8v qf[2][4];
#pragma unroll
        for (int st = 0; st < 2; ++st)
#pragma unroll
            for (int ks = 0; ks < 4; ++ks) qf[st][ks] = *(const bf16x8v*)(QC + (row0 + st * 16 + q16) * DM + h * 256 + kh * 128 + ks * 32 + g * 8);
        const LAS unsigned char* kb = lds + q16 * CA_STRIDE + kh * 256 + g * 16;
#pragma unroll
        for (int kt = 0; kt < 16; ++kt)
#pragma unroll
            for (int ks = 0; ks < 4; ++ks) { const bf16x8v a = *(const LAS bf16x8v*)(kb + kt * 16 * CA_STRIDE + ks * 64);
                S[0][kt] = __builtin_amdgcn_mfma_f32_16x16x32_bf16(a, qf[0][ks], S[0][kt], 0, 0, 0);
                S[1][kt] = __builtin_amdgcn_mfma_f32_16x16x32_bf16(a, qf[1][ks], S[1][kt], 0, 0, 0); }
    }
    const float c2 = 0.0625f * 1.4426950408889634f;
    float linv[2]; bf16x8v P[2][8];
#pragma unroll
    for (int st = 0; st < 2; ++st) {
        float m = -INFINITY;
#pragma unroll
        for (int kt = 0; kt < 16; ++kt) m = fmaxf(fmaxf(fmaxf(S[st][kt][0], S[st][kt][1]), fmaxf(S[st][kt][2], S[st][kt][3])), m);
        m = fmaxf(m, shx(m, lane, 16)); m = fmaxf(m, shx(m, lane, 32));
        const float mc = m * c2; float l = 0.f;
#pragma unroll
        for (int kt = 0; kt < 16; ++kt)
#pragma unroll
            for (int r = 0; r < 4; ++r) { const float p = __builtin_amdgcn_exp2f(S[st][kt][r] * c2 - mc); S[st][kt][r] = p; l += p; }
        l += shx(l, lane, 16); l += shx(l, lane, 32); linv[st] = 1.f / l;
#pragma unroll
        for (int c = 0; c < 8; ++c) { bf16x8v pk;
#pragma unroll
            for (int j = 0; j < 4; ++j) { pk[j] = (short)f2bf(S[st][2 * c][j]); pk[4 + j] = (short)f2bf(S[st][2 * c + 1][j]); }
            P[st][c] = pk; }
    }
    __syncthreads();
    { int tid2 = tid; asm volatile("" : "+v"(tid2));
      const bf16_t* src = VT + (size_t)(h * 256 + (tid2 >> 5)) * MMEM + b * NMEM + (tid2 & 31) * 8; LAS unsigned char* dst = lds + (tid2 >> 5) * CA_STRIDE + (tid2 & 31) * 16;
#pragma unroll
      for (int i = 0; i < 16; ++i) { const u32x4 v = *(const u32x4*)(src + (size_t)i * 16 * MMEM); *(LAS u32x4*)(dst + i * 16 * CA_STRIDE) = v; } }
    __syncthreads();
#pragma unroll 1
    for (int dh = 0; dh < 2; ++dh) {
        f32x4 O[2][8];
#pragma unroll
        for (int st = 0; st < 2; ++st)
#pragma unroll
            for (int dt = 0; dt < 8; ++dt) O[st][dt] = (f32x4){0.f, 0.f, 0.f, 0.f};
        const LAS unsigned char* pb = lds + (dh * 128 + q16) * CA_STRIDE + g * 8;
#pragma unroll
        for (int dt = 0; dt < 8; ++dt)
#pragma unroll
            for (int c = 0; c < 8; ++c) { const LAS unsigned char* p = pb + dt * 16 * CA_STRIDE + c * 64;
                const u32x2 lo = *(const LAS u32x2*)p, hi = *(const LAS u32x2*)(p + 32);
                const u32x4 av = (u32x4){lo.x, lo.y, hi.x, hi.y}; const bf16x8v a = __builtin_bit_cast(bf16x8v, av);
                O[0][dt] = __builtin_amdgcn_mfma_f32_16x16x32_bf16(a, P[0][c], O[0][dt], 0, 0, 0);
                O[1][dt] = __builtin_amdgcn_mfma_f32_16x16x32_bf16(a, P[1][c], O[1][dt], 0, 0, 0); }
#pragma unroll
        for (int st = 0; st < 2; ++st)
#pragma unroll
            for (int dt = 0; dt < 8; ++dt) { const f32x4 o = O[st][dt] * linv[st]; u32x2 w;
                w.x = (unsigned)f2bf(o[0]) | ((unsigned)f2bf(o[1]) << 16); w.y = (unsigned)f2bf(o[2]) | ((unsigned)f2bf(o[3]) << 16);
                *(u32x2*)(OC + (row0 + st * 16 + q16) * DM + h * 256 + dh * 128 + dt * 16 + g * 4) = w; }
    }
    __syncthreads();
}
typedef float f32x16v __attribute__((ext_vector_type(16)));
constexpr int TK_HIST_OFF = 131072;
__device__ __forceinline__ unsigned code16(float s) {
    const _Float16 hf = (_Float16)s; unsigned u = (unsigned)__builtin_bit_cast(unsigned short, hf);
    if ((u & 0x7fffu) == 0u) u = 0u;
    return (u & 0x8000u) ? (~u & 0xffffu) : (u | 0x8000u);
}
__device__ __forceinline__ unsigned mbcnt64(unsigned long long m) { return __builtin_amdgcn_mbcnt_hi((unsigned)(m >> 32), __builtin_amdgcn_mbcnt_lo((unsigned)m, 0u)); }
__device__ __forceinline__ void lds_hist_add(LAS unsigned char* hrow, unsigned bin) {
    __hip_atomic_fetch_add((LAS unsigned*)(hrow + ((bin & 127u) << 2)), (bin & 128u) ? 0x10000u : 1u, __ATOMIC_RELAXED, __HIP_MEMORY_SCOPE_WORKGROUP);
}
__device__ __forceinline__ void hist_select(const LAS unsigned char* hrow, unsigned target, int lane, unsigned& B, unsigned& above) {
    const u32x4 hv = *(const LAS u32x4*)(hrow + (lane & 31) * 16);
    const unsigned sh = (lane & 32) ? 16u : 0u;
    const unsigned h0 = (hv.x >> sh) & 0xffffu, h1 = (hv.y >> sh) & 0xffffu, h2 = (hv.z >> sh) & 0xffffu, h3 = (hv.w >> sh) & 0xffffu;
    const unsigned s = (h0 + h1) + (h2 + h3); unsigned S = s;
#pragma unroll
    for (int o = 1; o < 64; o <<= 1) { const unsigned v = (unsigned)__builtin_amdgcn_ds_bpermute(((lane + o) & 63) << 2, (int)S); if (lane + o < 64) S += v; }
    const unsigned long long mk = __ballot(S >= target);
    const int lb = 63 - __builtin_clzll(mk);
    const unsigned A = S - s, c3 = A + h3, c2 = c3 + h2, c1 = c2 + h1;
    const unsigned bsel = (c3 >= target) ? 3u : (c2 >= target) ? 2u : (c1 >= target) ? 1u : 0u;
    const unsigned asel = (c3 >= target) ? A : (c2 >= target) ? c3 : (c1 >= target) ? c2 : c1;
    B = 4u * (unsigned)lb + (unsigned)__builtin_amdgcn_readlane((int)bsel, lb);
    above = (unsigned)__builtin_amdgcn_readlane((int)asel, lb);
}
__device__ __forceinline__ void topk_unit(LAS unsigned char* lds, int b, int j, const bf16_t* QI, const bf16_t* KI, const float* WI, unsigned short* SEL, int tid, int lane, int wave) {
    asm volatile("" : "+v"(tid), "+v"(lane));
    const int t0 = 16 * j, L = t0 + 16, nkt = (L + 31) >> 5;
    const size_t rowbase = (size_t)b * SEQ + t0;
    const int c32 = lane & 31, hi = lane >> 5;
    *(LAS u32x4*)(lds + TK_HIST_OFF + tid * 16) = (u32x4){0u, 0u, 0u, 0u};
    __syncthreads();
    {
        bf16x8v qa[2][4]; f32x4 wq[2][4];
#pragma unroll
        for (int rt = 0; rt < 2; ++rt) {
#pragma unroll
            for (int ks = 0; ks < 4; ++ks) qa[rt][ks] = *(const bf16x8v*)(QI + (rowbase + 8 * rt + (c32 >> 2)) * 256 + (c32 & 3) * 64 + 16 * ks + 8 * hi);
#pragma unroll
            for (int gq = 0; gq < 4; ++gq) wq[rt][gq] = *(const f32x4*)(WI + (rowbase + 8 * rt + 2 * gq + hi) * 4);
        }
        const bf16_t* kbase = KI + ((size_t)b * SEQ + c32) * 64 + 8 * hi;
        bf16x8v kb[4], kn[4];
        int kt = wave;
        if (kt < nkt) {
#pragma unroll
            for (int ks = 0; ks < 4; ++ks) kb[ks] = *(const bf16x8v*)(kbase + (size_t)kt * 32 * 64 + 16 * ks);
        }
        for (; kt < nkt; kt += 8) {
            const int ktn = (kt + 8 < nkt) ? kt + 8 : kt;
#pragma unroll
            for (int ks = 0; ks < 4; ++ks) kn[ks] = *(const bf16x8v*)(kbase + (size_t)ktn * 32 * 64 + 16 * ks);
            const int key = kt * 32 + c32;
#pragma unroll
            for (int rt = 0; rt < 2; ++rt) {
                f32x16v c = {0.f, 0.f, 0.f, 0.f, 0.f, 0.f, 0.f, 0.f, 0.f, 0.f, 0.f, 0.f, 0.f, 0.f, 0.f, 0.f};
#pragma unroll
                for (int ks = 0; ks < 4; ++ks) c = __builtin_amdgcn_mfma_f32_32x32x16_bf16(qa[rt][ks], kb[ks], c, 0, 0, 0);
#pragma unroll
                for (int gq = 0; gq < 4; ++gq) {
                    const f32x4 w = wq[rt][gq];
                    const float sc = w[0] * fmaxf(c[4 * gq + 0], 0.f) + w[1] * fmaxf(c[4 * gq + 1], 0.f) + w[2] * fmaxf(c[4 * gq + 2], 0.f) + w[3] * fmaxf(c[4 * gq + 3], 0.f);
                    const int q = 8 * rt + 2 * gq + hi; const unsigned code = code16(sc);
                    *(LAS unsigned short*)(lds + q * 8192 + key * 2) = (unsigned short)code;
                    if (key <= t0 + q) lds_hist_add(lds + TK_HIST_OFF + q * 512, code >> 8);
                }
            }
#pragma unroll
            for (int ks = 0; ks < 4; ++ks) kb[ks] = kn[ks];
        }
    }
    __syncthreads();
#pragma unroll 1
    for (int qq = 0; qq < 2; ++qq) {
        const int q = 2 * wave + qq, t = t0 + q, n = t + 1;
        unsigned short* sel = SEL + (rowbase + q) * TOPK;
        if (n <= TOPK) {
#pragma unroll
            for (int i = 0; i < 4; ++i) { const int s = lane + 64 * i; if (s < n) sel[s] = (unsigned short)s; }
            continue;
        }
        const int nch = (n + 127) >> 7;
        LAS unsigned char* hrow = lds + TK_HIST_OFF + q * 512;
        const LAS unsigned* row = (const LAS unsigned*)(lds + q * 8192) + lane;
        unsigned B, above;
        hist_select(hrow, (unsigned)TOPK, lane, B, above);
        *(LAS u32x2*)(hrow + lane * 8) = (u32x2){0u, 0u};
        asm volatile("s_waitcnt lgkmcnt(0)" ::: "memory");
#pragma unroll 4
        for (int c = 0; c < nch; ++c) { const unsigned v = row[64 * c]; const int i0 = 128 * c + 2 * lane;
            const unsigned lo = v & 0xffffu, hi16 = v >> 16;
            if (i0 <= t && (lo >> 8) == B) lds_hist_add(hrow, lo & 255u);
            if (i0 + 1 <= t && (hi16 >> 8) == B) lds_hist_add(hrow, hi16 & 255u); }
        asm volatile("s_waitcnt lgkmcnt(0)" ::: "memory");
        unsigned b2, above2;
        hist_select(hrow, (unsigned)TOPK - above, lane, b2, above2);
        const unsigned T = (B << 8) | b2, cgt = above + above2, need = (unsigned)TOPK - cgt;
        unsigned eqrun = 0u, selrun = 0u;
#pragma unroll 2
        for (int c = 0; c < nch; ++c) { const unsigned v = row[64 * c]; const int i0 = 128 * c + 2 * lane;
            const unsigned lo = (i0 <= t) ? (v & 0xffffu) : 0u, hi16 = (i0 + 1 <= t) ? (v >> 16) : 0u;
            const bool glo = lo > T, ghi = hi16 > T;
            const unsigned long long mglo = __ballot(glo), mghi = __ballot(ghi);
            const unsigned plo = selrun + mbcnt64(mglo), phi = selrun + (unsigned)__popcll(mglo) + mbcnt64(mghi);
            if (glo) sel[plo] = (unsigned short)i0;
            if (ghi) sel[phi] = (unsigned short)(i0 + 1);
            selrun += (unsigned)__popcll(mglo) + (unsigned)__popcll(mghi);
            const bool elo = lo == T, ehi = hi16 == T;
            const unsigned long long melo = __ballot(elo), mehi = __ballot(ehi);
            if ((melo | mehi) != 0ull) {
                const unsigned rlo = eqrun + mbcnt64(melo) + mbcnt64(mehi), rhi = rlo + (elo ? 1u : 0u);
                if (elo && rlo < need) sel[cgt + rlo] = (unsigned short)i0;
                if (ehi && rhi < need) sel[cgt + rhi] = (unsigned short)(i0 + 1);
                eqrun += (unsigned)__popcll(melo) + (unsigned)__popcll(mehi);
            }
        }
    }
    __syncthreads();
}
__device__ __forceinline__ void topk_phase(LAS unsigned char* lds, int G, int vcu, const bf16_t* QI, const bf16_t* KI, const float* WI, unsigned short* SEL, int tid, int lane, int wave) {
    if (G == 256) {
        const int b = vcu >> 5, i = vcu & 31;
#pragma unroll 1
        for (int k = 0; k < 8; ++k) { const int j = 64 * (k >> 1) + ((k & 1) ? 63 - i : i); topk_unit(lds, b, j, QI, KI, WI, SEL, tid, lane, wave); }
    } else {
#pragma unroll 1
        for (int u = vcu; u < BATCH * 256; u += G) topk_unit(lds, u >> 8, u & 255, QI, KI, WI, SEL, tid, lane, wave);
    }
}
typedef short v4i16_t __attribute__((ext_vector_type(4)));
constexpr int SV_STRIDE = 160, SV_TILE_BYTES = 64 * SV_STRIDE, SV_WAVE_BYTES = SV_TILE_BYTES + 1024;
__device__ __forceinline__ v4i16_t tr_read16(const LAS unsigned char* p) { return __builtin_amdgcn_ds_read_tr16_b64_v4i16((LAS v4i16_t*)p); }
#define SP_FENCE() asm volatile("" ::: "memory")
__device__ __forceinline__ void sparse_attn_phase(LAS unsigned char* lds, int G, int vcu, const bf16_t* Q, const bf16_t* Kb, const bf16_t* Vb, const unsigned short* SEL, bf16_t* MIX, int lane, int wave) {
    asm volatile("" : "+v"(lane));
    LAS unsigned char* wl = lds + wave * SV_WAVE_BYTES;
    const int q16 = lane & 15, g = lane >> 4;
    const int nq = (G == 256) ? 16 : (MTOK - (vcu * 8 + wave) + G * 8 - 1) / (G * 8);
    const int r_first = (G == 256) ? (vcu >> 5) * SEQ + (vcu & 31) * 8 + wave : vcu * 8 + wave, r_step = (G == 256) ? 256 : G * 8;
    u32x2 selv = (u32x2){0u, 0u};
    if (nq > 0) selv = *(const u32x2*)(SEL + (size_t)r_first * TOPK + 4 * lane);
    LAS unsigned char* wdst = wl + (lane >> 3) * SV_STRIDE + (lane & 7) * 16;
    const LAS unsigned char* rsrc = wl + (4 * g + (q16 >> 2)) * SV_STRIDE + (q16 & 3) * 8;
    const float c2 = 0.125f * 1.4426950408889634f;
#pragma unroll 1
    for (int k = 0; k < nq; ++k) {
        const size_t row = (size_t)r_first + (size_t)k * r_step; const int b = (int)(row / SEQ), t = (int)(row % SEQ);
        const int n = (t + 1 < TOPK) ? t + 1 : TOPK;
        LAS unsigned char* ib = wl + SV_TILE_BYTES + (k & 1) * 512;
        *(LAS u32x2*)(ib + lane * 8) = selv;
        if (k + 1 < nq) selv = *(const u32x2*)(SEL + (row + r_step) * TOPK + 4 * lane);
        bf16x8v qf[2];
#pragma unroll
        for (int ks = 0; ks < 2; ++ks) { u32x4 v = (u32x4){0u, 0u, 0u, 0u}; if (q16 < 8) v = *(const u32x4*)(Q + row * 512 + q16 * 64 + ks * 32 + g * 8); qf[ks] = __builtin_bit_cast(bf16x8v, v); }
        f32x4 S[16];
        const bf16_t* kbat = Kb + (size_t)b * SEQ * 64 + g * 8;
        const bf16_t* vbat = Vb + (size_t)b * SEQ * 64 + (lane & 7) * 8;
#pragma unroll
        for (int kh = 0; kh < 2; ++kh) {
            bf16x8v kf[8][2];
#pragma unroll
            for (int i = 0; i < 8; ++i) { const int slot = 128 * kh + 16 * i + q16; unsigned idx = *(const LAS unsigned short*)(ib + slot * 2); if (slot >= n) idx = 0u;
#pragma unroll
                for (int ks = 0; ks < 2; ++ks) kf[i][ks] = *(const bf16x8v*)(kbat + (size_t)idx * 64 + ks * 32); }
            SP_FENCE();
#pragma unroll
            for (int i = 0; i < 8; ++i) { f32x4 c = (f32x4){0.f, 0.f, 0.f, 0.f};
                c = __builtin_amdgcn_mfma_f32_16x16x32_bf16(kf[i][0], qf[0], c, 0, 0, 0);
                c = __builtin_amdgcn_mfma_f32_16x16x32_bf16(kf[i][1], qf[1], c, 0, 0, 0); S[8 * kh + i] = c; }
            SP_FENCE();
        }
        u32x4 vv[8];
#pragma unroll
        for (int i = 0; i < 8; ++i) { const int slot = (lane >> 3) + 8 * i; unsigned idx = *(const LAS unsigned short*)(ib + slot * 2); if (slot >= n) idx = 0u; vv[i] = *(const u32x4*)(vbat + (size_t)idx * 64); }
        SP_FENCE();
        float m = -INFINITY;
#pragma unroll
        for (int kt = 0; kt < 16; ++kt)
#pragma unroll
            for (int r = 0; r < 4; ++r) { if (16 * kt + 4 * g + r >= n) S[kt][r] = -INFINITY; m = fmaxf(m, S[kt][r]); }
        m = fmaxf(m, shx(m, lane, 16)); m = fmaxf(m, shx(m, lane, 32));
        const float mc = m * c2; float l = 0.f;
#pragma unroll
        for (int kt = 0; kt < 16; ++kt)
#pragma unroll
            for (int r = 0; r < 4; ++r) { const float p = __builtin_amdgcn_exp2f(S[kt][r] * c2 - mc); S[kt][r] = p; l += p; }
        l += shx(l, lane, 16); l += shx(l, lane, 32);
        const float linv = 1.f / l;
        bf16x8v P[8];
#pragma unroll
        for (int c = 0; c < 8; ++c) { u32x4 pk; pk.x = pg8::cvt_pk_bf16(S[2 * c][0], S[2 * c][1]); pk.y = pg8::cvt_pk_bf16(S[2 * c][2], S[2 * c][3]); pk.z = pg8::cvt_pk_bf16(S[2 * c + 1][0], S[2 * c + 1][1]); pk.w = pg8::cvt_pk_bf16(S[2 * c + 1][2], S[2 * c + 1][3]);
            P[c] = __builtin_bit_cast(bf16x8v, pk); }
        f32x4 O[4];
#pragma unroll
        for (int dt = 0; dt < 4; ++dt) O[dt] = (f32x4){0.f, 0.f, 0.f, 0.f};
#pragma unroll
        for (int cc = 0; cc < 4; ++cc) {
#pragma unroll
            for (int i = 0; i < 8; ++i) *(LAS u32x4*)(wdst + i * 8 * SV_STRIDE) = vv[i];
            SP_FENCE();
            if (cc < 3) {
#pragma unroll
                for (int i = 0; i < 8; ++i) { const int slot = 64 * (cc + 1) + (lane >> 3) + 8 * i; unsigned idx = *(const LAS unsigned short*)(ib + slot * 2); if (slot >= n) idx = 0u; vv[i] = *(const u32x4*)(vbat + (size_t)idx * 64); }
            }
            asm volatile("s_waitcnt lgkmcnt(0)" ::: "memory");
#pragma unroll
            for (int c2i = 0; c2i < 2; ++c2i)
#pragma unroll
                for (int dt = 0; dt < 4; ++dt) { const LAS unsigned char* p = rsrc + c2i * 32 * SV_STRIDE + dt * 32;
                    const v4i16_t lo = tr_read16(p), hi = tr_read16(p + 16 * SV_STRIDE);
                    const bf16x8v a = (bf16x8v){lo[0], lo[1], lo[2], lo[3], hi[0], hi[1], hi[2], hi[3]};
                    O[dt] = __builtin_amdgcn_mfma_f32_16x16x32_bf16(a, P[2 * cc + c2i], O[dt], 0, 0, 0); }
            asm volatile("s_waitcnt lgkmcnt(0)" ::: "memory");
        }
        if (q16 < 8) {
#pragma unroll
            for (int dt = 0; dt < 4; ++dt) { const f32x4 o = O[dt] * linv; u32x2 w;
                w.x = pg8::cvt_pk_bf16(o[0], o[1]); w.y = pg8::cvt_pk_bf16(o[2], o[3]);
                *(u32x2*)(MIX + row * DM + q16 * 64 + dt * 16 + g * 4) = w; }
        }
    }
    __syncthreads();
}
__device__ __forceinline__ void convb_phase(LAS unsigned char* lds, int G, int vcu, const bf16_t* U, const float* __restrict__ cw, const float* __restrict__ cb, const float* __restrict__ lng, const float* __restrict__ lnb, bf16_t* MIX, int tid, int lane, int wave) {
    asm volatile("" : "+v"(tid), "+v"(lane));
    typedef float f32x2v __attribute__((ext_vector_type(2)));
    const int cp = tid & 255, th = tid >> 8;
    f32x2v w[31];
#pragma unroll
    for (int j = 0; j < 31; ++j) w[j] = *(const f32x2v*)(cw + j * 512 + 2 * cp);
    const f32x2v bias = *(const f32x2v*)(cb + 2 * cp), gam = *(const f32x2v*)(lng + 2 * cp), bet = *(const f32x2v*)(lnb + 2 * cp);
    LAS float* red = (LAS float*)(lds + 65536);
#pragma unroll 1
    for (int tile = vcu; tile < MTOK / 32; tile += G) {
        const int row0 = tile * 32, t0 = row0 & (SEQ - 1);
        for (int i = tid; i < 62 * 64; i += 512) { const int r = i >> 6, ch = i & 63; u32x4 v = (u32x4){0u, 0u, 0u, 0u};
            if (t0 - 30 + r >= 0) v = *(const u32x4*)(U + (size_t)(row0 - 30 + r) * 512 + ch * 8);
            *(LAS u32x4*)(lds + r * 1024 + ch * 16) = v; }
        __syncthreads();
        f32x2v y[2][8];
#pragma unroll
        for (int k = 0; k < 2; ++k) {
            const int tg = th + 2 * k;
            f32x2v acc[8];
#pragma unroll
            for (int o = 0; o < 8; ++o) acc[o] = bias;
            const LAS unsigned* wp = (const LAS unsigned*)(lds + tg * 8 * 1024) + cp;
#pragma unroll
            for (int j = 0; j < 38; ++j) { const unsigned uu = wp[j * 256]; const f32x2v uv = (f32x2v){__uint_as_float(uu << 16), __uint_as_float(uu & 0xffff0000u)};
#pragma unroll
                for (int o = 0; o < 8; ++o) { const int tap = j - o; if (tap >= 0 && tap < 31) acc[o] += w[tap] * uv; } }
#pragma unroll
            for (int o = 0; o < 8; ++o) { y[k][o] = acc[o];
                float s = acc[o].x + acc[o].y, q = acc[o].x * acc[o].x + acc[o].y * acc[o].y;
                s = wave_sum_l(s, lane); q = wave_sum_l(q, lane);
                if (lane == 0) { red[((tg * 8 + o) * 4 + (wave & 3)) * 2] = s; red[((tg * 8 + o) * 4 + (wave & 3)) * 2 + 1] = q; } }
        }
        __syncthreads();
#pragma unroll
        for (int k = 0; k < 2; ++k) {
            const int tg = th + 2 * k;
#pragma unroll
            for (int o = 0; o < 8; ++o) { const int tl = tg * 8 + o;
                const f32x4 ra = *(const LAS f32x4*)(red + tl * 8), rb = *(const LAS f32x4*)(red + tl * 8 + 4);
                const float mu = ((ra[0] + ra[2]) + (rb[0] + rb[2])) * (1.f / 512.f), ex2 = ((ra[1] + ra[3]) + (rb[1] + rb[3])) * (1.f / 512.f);
                const float rstd = 1.f / sqrtf(fmaxf(ex2 - mu * mu, 0.f) + EPS);
                const float v0 = (y[k][o].x - mu) * rstd * gam.x + bet.x, v1 = (y[k][o].y - mu) * rstd * gam.y + bet.y;
                *(unsigned*)(MIX + (size_t)(row0 + tl) * DM + 512 + 2 * cp) = (unsigned)f2bf(silu_f(v0)) | ((unsigned)f2bf(silu_f(v1)) << 16); }
        }
        __syncthreads();
    }
}

__device__ __forceinline__ int wt_dst_row(int mode, int c) {
    if (mode == 0) return c;
    if (mode == 2) return 256 * (c >> 7) + (c & 127);
    if (mode == 3) return 256 * (c >> 7) + 128 + (c & 127);
    if (c < 512) return (c & ~63) + dperm(c & 63);
    if (c < 576) return 512 + dperm(c - 512);
    if (c < 640) return c;
    if (c < 896) return 768 + ((c - 640) & ~63) + dperm((c - 640) & 63);
    if (c < 960) return 640 + dperm(c - 896);
    if (c < 964) return 704 + (c - 960);
    if (c < 1476) { const int j = c - 964; return 1024 + 256 * (j >> 7) + (j & 127); }
    { const int j = c - 1476; return 1024 + 256 * (j >> 7) + 128 + (j & 127); }
}
__device__ __forceinline__ void wt_body(LAS unsigned char* sm, int vb, int tid, const float* __restrict__ W, int K, int N, bf16_t* WT, const float* __restrict__ gain, int mode) {
    LAS float* t = (LAS float*)sm;
    const int nbx = (N + 31) / 32; const int k0 = (vb / nbx) * 32, n0 = (vb % nbx) * 32, tx = tid & 31, ty = tid >> 5;
    for (int i = ty; i < 32; i += 8) { const int k = k0 + i, n = n0 + tx; float v = 0.f; if (k < K && n < N) { v = W[(size_t)k * N + n]; if (gain) v *= gain[k]; } t[i * 33 + tx] = v; }
    __syncthreads();
    for (int i = ty; i < 32; i += 8) { const int n = n0 + i, k = k0 + tx; if (n < N && k < K) WT[(size_t)wt_dst_row(mode, n) * K + k] = f2bf(t[tx * 33 + i]); }
    __syncthreads();
}
__device__ __forceinline__ void rmsnorm_bf16_row(const float* x, const float* __restrict__ g, bf16_t* out, int row, int lane) {
    const f32x4* xr = (const f32x4*)(x + (size_t)row * DM) + lane; const f32x4* gr = (const f32x4*)g + lane;
    f32x4 v[4]; float s = 0.f;
#pragma unroll
    for (int j = 0; j < 4; ++j) { v[j] = xr[64 * j]; s += (v[j].x * v[j].x + v[j].y * v[j].y) + (v[j].z * v[j].z + v[j].w * v[j].w); }
    const float rstd = 1.f / sqrtf(wave_sum_l(s, lane) * (1.f / DM) + EPS);
    u32x2* o = (u32x2*)(out + (size_t)row * DM) + lane;
#pragma unroll
    for (int j = 0; j < 4; ++j) { const f32x4 gg = gr[64 * j]; u32x2 w;
        w.x = (unsigned)f2bf(v[j].x * rstd * gg.x) | ((unsigned)f2bf(v[j].y * rstd * gg.y) << 16);
        w.y = (unsigned)f2bf(v[j].z * rstd * gg.z) | ((unsigned)f2bf(v[j].w * rstd * gg.w) << 16); o[64 * j] = w; }
}
__device__ __forceinline__ void rmsnorm_f32_row(float* x, const float* __restrict__ g, int row, int lane) {
    f32x4* xr = (f32x4*)(x + (size_t)row * DM) + lane; const f32x4* gr = (const f32x4*)g + lane;
    f32x4 v[4]; float s = 0.f;
#pragma unroll
    for (int j = 0; j < 4; ++j) { v[j] = xr[64 * j]; s += (v[j].x * v[j].x + v[j].y * v[j].y) + (v[j].z * v[j].z + v[j].w * v[j].w); }
    const float rstd = 1.f / sqrtf(wave_sum_l(s, lane) * (1.f / DM) + EPS);
#pragma unroll
    for (int j = 0; j < 4; ++j) { const f32x4 gg = gr[64 * j]; xr[64 * j] = v[j] * rstd * gg; }
}

__device__ __forceinline__ void wt_item(const float* __restrict__ W, int K, int N, bf16_t* WT, const float* __restrict__ gain, int mode, LAS float* scr, int item, int lane) {
    const int nblk = (N + 31) / 32, kb = item / nblk, nb = item - kb * nblk, k0 = 64 * kb, n0 = 32 * nb;
    const int nn = n0 + (lane & 31);
    float wv[32];
#pragma unroll
    for (int i = 0; i < 32; ++i) { const int kk = 2 * i + (lane >> 5); wv[i] = 0.f; if (nn < N) wv[i] = W[(size_t)(k0 + kk) * N + nn]; }
#pragma unroll
    for (int i = 0; i < 32; ++i) { const int kk = 2 * i + (lane >> 5); float v = wv[i]; if (gain) v *= gain[k0 + kk]; scr[kk * 33 + (lane & 31)] = v; }
    asm volatile("s_waitcnt lgkmcnt(0)" ::: "memory");
    const int c = lane & 7;
#pragma unroll
    for (int j = 0; j < 4; ++j) { const int n = (lane >> 3) + 8 * j; const LAS float* s = scr + (8 * c) * 33 + n;
        u32x4 o; o.x = pg8::cvt_pk_bf16(s[0 * 33], s[1 * 33]); o.y = pg8::cvt_pk_bf16(s[2 * 33], s[3 * 33]); o.z = pg8::cvt_pk_bf16(s[4 * 33], s[5 * 33]); o.w = pg8::cvt_pk_bf16(s[6 * 33], s[7 * 33]);
        if (n0 + n < N) *(u32x4*)(WT + (size_t)wt_dst_row(mode, n0 + n) * K + k0 + 8 * c) = o; }
    asm volatile("s_waitcnt lgkmcnt(0)" ::: "memory");
}

__device__ __forceinline__ void rmsnorm_bf16_2rows(const float* x, const float* __restrict__ g, bf16_t* out, int row, int lane) {
    const f32x4* xr = (const f32x4*)(x + (size_t)row * DM) + lane; const f32x4* gr = (const f32x4*)g + lane;
    f32x4 v[2][4]; float s[2] = {0.f, 0.f};
#pragma unroll
    for (int r = 0; r < 2; ++r)
#pragma unroll
        for (int j = 0; j < 4; ++j) v[r][j] = xr[r * (DM / 4) + 64 * j];
#pragma unroll
    for (int r = 0; r < 2; ++r)
#pragma unroll
        for (int j = 0; j < 4; ++j) s[r] += (v[r][j].x * v[r][j].x + v[r][j].y * v[r][j].y) + (v[r][j].z * v[r][j].z + v[r][j].w * v[r][j].w);
#pragma unroll
    for (int r = 0; r < 2; ++r) { const float rstd = 1.f / sqrtf(wave_sum_l(s[r], lane) * (1.f / DM) + EPS);
        u32x2* o = (u32x2*)(out + (size_t)(row + r) * DM) + lane;
#pragma unroll
        for (int j = 0; j < 4; ++j) { const f32x4 gg = gr[64 * j]; u32x2 w;
            w.x = pg8::cvt_pk_bf16(v[r][j].x * rstd * gg.x, v[r][j].y * rstd * gg.y); w.y = pg8::cvt_pk_bf16(v[r][j].z * rstd * gg.z, v[r][j].w * rstd * gg.w); o[64 * j] = w; } }
}

constexpr size_t MiB = 1u << 20;
constexpr int LDS_USER = 139264, LDSCTL_OFF = LDS_USER, MISC_OFF = LDSCTL_OFF + 320, LDS_BYTES = 147456;
constexpr size_t WS_CTL = 476 * MiB, CTL_ZERO_BYTES = 1 * MiB; constexpr int CW_BAR = 4096;
constexpr int NGU = 2 * DFF;
struct Args { const float* in[23]; float* out; unsigned char* ws; };
static_assert(sizeof(Args) == 25 * 8, "Args has no padding");

__global__ void __launch_bounds__(512, 2) mega_k(Args a) {
    extern __shared__ __attribute__((aligned(16))) unsigned char lds_raw[];
    LAS unsigned char* lds = (LAS unsigned char*)lds_raw;
    const int wave = __builtin_amdgcn_readfirstlane(threadIdx.x >> 6);
#define PH_IDS() int lane; asm volatile("v_mbcnt_lo_u32_b32 %0, -1, 0\n\tv_mbcnt_hi_u32_b32 %0, -1, %0" : "=v"(lane)); const int tid = wave * 64 + lane, half = wave >> 2, htid = tid & 255; LAS unsigned char* hsm = lds + half * 65536; (void)htid; (void)hsm
    const int G = gridDim.x, bx = blockIdx.x; const int vcu = (G % 8 == 0) ? (bx % 8) * (G / 8) + bx / 8 : bx;
    const float* x = a.in[0]; const float* mem = a.in[1]; const int* positions = (const int*)a.in[2];
    const float* g_mix = a.in[3]; const float* w_in = a.in[4]; const float* w_out = a.in[5];
    const float* conv_b_w = a.in[6]; const float* conv_b_b = a.in[7]; const float* ln_b_g = a.in[8]; const float* ln_b_b = a.in[9];
    const float* g_cross = a.in[10]; const float* g_mem = a.in[11];
    const float* w_q = a.in[12]; const float* w_k = a.in[13]; const float* w_v = a.in[14]; const float* w_o = a.in[15];
    const float* g_ffn = a.in[16]; const float* w_gate = a.in[17]; const float* w_up = a.in[18];
    const float* ffn_cw = a.in[19]; const float* ffn_cb = a.in[20]; const float* w_down = a.in[21]; const float* g_final = a.in[22];
    float* out = a.out; unsigned char* ws = a.ws;
    bf16_t* wt_in = (bf16_t*)(ws + 0 * MiB); bf16_t* wt_out = (bf16_t*)(ws + 4 * MiB);
    bf16_t* wt_q = (bf16_t*)(ws + 6 * MiB), *wt_k = (bf16_t*)(ws + 8 * MiB), *wt_v = (bf16_t*)(ws + 10 * MiB), *wt_o = (bf16_t*)(ws + 12 * MiB);
    bf16_t* wt_gu = (bf16_t*)(ws + 14 * MiB); bf16_t* wt_down = (bf16_t*)(ws + 26 * MiB);
    float* WI = (float*)(ws + 32 * MiB); float* CS = (float*)(ws + 33 * MiB);
    float* SS1 = (float*)(ws + 35 * MiB); float* SS2 = (float*)(ws + 37 * MiB); float* SS3 = (float*)(ws + 39 * MiB);
    bf16_t* MEMN = (bf16_t*)(ws + 41 * MiB), *KC = (bf16_t*)(ws + 45 * MiB), *VC = (bf16_t*)(ws + 49 * MiB);
    bf16_t* XB = (bf16_t*)(ws + 56 * MiB);
    bf16_t* Qb = (bf16_t*)(ws + 120 * MiB); bf16_t* QI = (bf16_t*)(ws + 152 * MiB);
    bf16_t* Kb = (bf16_t*)(ws + 168 * MiB), *Vb = (bf16_t*)(ws + 172 * MiB), *KI = (bf16_t*)(ws + 176 * MiB);
    bf16_t* U = (bf16_t*)(ws + 180 * MiB); unsigned short* SEL = (unsigned short*)(ws + 212 * MiB);
    bf16_t* MIX = (bf16_t*)(ws + 228 * MiB); bf16_t* QC = (bf16_t*)(ws + 292 * MiB); bf16_t* OC = (bf16_t*)(ws + 356 * MiB);
    bf16_t* Hb = (bf16_t*)(ws + 120 * MiB);
    float* TOPG = (float*)(ws + 300 * MiB); float* TOPU = (float*)(ws + 304 * MiB); float* BOTG = (float*)(ws + 308 * MiB);
    unsigned* ctl = (unsigned*)(ws + WS_CTL);

    { PH_IDS(); for (int u = tid; u < (LDS_BYTES - LDSCTL_OFF) / 4; u += 512) ((LAS unsigned*)(lds + LDSCTL_OFF))[u] = 0u; }
    __syncthreads();
    XcdBarrier bar = xcd_barrier_post(ctl + CW_BAR, (volatile LAS unsigned*)(lds + MISC_OFF) + 8);
#define GRID_BAR() xcd_barrier(bar)
#define FOR_VB(nvb) for (int vb = 2 * bx + half; vb < (nvb); vb += 2 * G)
#define GEMMX(EPI, EINIT, Aptr, Bptr, Mv, Nv, Kv) do { pg8::Gemm g_{Aptr, Bptr, Mv, Nv, Kv}; pg8::StaticOrder S_; S_.init(Mv, Nv, G, bx); EPI E_ EINIT; \
        PH_IDS(); pg8::gemm_phase<EPI, pg8::StaticOrder, true, true>(lds, g_, S_, E_, tid); } while (0)
#define EI(...) {__VA_ARGS__}

    { PH_IDS();
    for (int i = bx * 512 + tid; i < 60 * DM; i += G * 512) wt_in[(size_t)708 * DM + i] = 0;
    { LAS float* scr = (LAS float*)(lds + wave * 8704); const int gw = vcu * 8 + wave, NGW = G * 8;
      constexpr int I_IN = 16 * 63, I_SQ = 16 * 32, I_FF = 16 * 88, I_DN = 44 * 32, NIT = I_IN + 5 * I_SQ + 2 * I_FF + I_DN;
#pragma unroll 1
      for (int it = gw; it < NIT; it += NGW) { int r = it;
          if (r < I_IN) { wt_item(w_in, DM, INC, wt_in, nullptr, 1, scr, r, lane); continue; } r -= I_IN;
          if (r < I_SQ) { wt_item(w_out, DM, DM, wt_out, nullptr, 0, scr, r, lane); continue; } r -= I_SQ;
          if (r < I_SQ) { wt_item(w_q, DM, DM, wt_q, g_cross, 0, scr, r, lane); continue; } r -= I_SQ;
          if (r < I_SQ) { wt_item(w_k, DM, DM, wt_k, nullptr, 0, scr, r, lane); continue; } r -= I_SQ;
          if (r < I_SQ) { wt_item(w_v, DM, DM, wt_v, nullptr, 0, scr, r, lane); continue; } r -= I_SQ;
          if (r < I_SQ) { wt_item(w_o, DM, DM, wt_o, nullptr, 0, scr, r, lane); continue; } r -= I_SQ;
          if (r < I_FF) { wt_item(w_gate, DM, DFF, wt_gu, g_ffn, 2, scr, r, lane); continue; } r -= I_FF;
          if (r < I_FF) { wt_item(w_up, DM, DFF, wt_gu, g_ffn, 3, scr, r, lane); continue; } r -= I_FF;
          wt_item(w_down, DFF, DM, wt_down, nullptr, 0, scr, r, lane); } }
    for (int i = bx * 512 + tid; i < MTOK * 8; i += G * 512) { const int row = i >> 3, k = i & 7;
        const float fr8[8] = {1.000000000e+00f, 1.939227432e-01f, 3.760603070e-02f, 7.292664610e-03f, 1.414213562e-03f, 2.742481884e-04f, 5.318295734e-05f, 1.031338525e-05f};
        float freq = fr8[0];
#pragma unroll
        for (int kk = 1; kk < 8; ++kk) freq = (k == kk) ? fr8[kk] : freq;
        const float ang = (float)positions[row] * freq;
        CS[(size_t)row * 16 + k] = (float)cos((double)ang); CS[(size_t)row * 16 + 8 + k] = (float)sin((double)ang); }
    for (int r = 2 * (bx * 8 + wave); r < MTOK; r += G * 16) rmsnorm_bf16_2rows(x, g_mix, XB, r, lane);
    for (int r = bx * 8 + wave; r < MMEM; r += G * 8) rmsnorm_bf16_row(mem, g_mem, MEMN, r, lane);
    }
    GRID_BAR();
    GEMMX(EpiIn, EI(CS, Qb, Kb, Vb, QI, KI, U, WI), XB, wt_in, MTOK, INP, DM);
    GEMMX(EpiStore, EI(nullptr, KC, nullptr, DM), MEMN, wt_k, MMEM, DM, DM);
    GEMMX(EpiStore, EI(nullptr, VC, nullptr, MMEM), wt_v, MEMN, DM, MMEM, DM);
    GRID_BAR();
    { PH_IDS(); topk_phase(lds, G, vcu, QI, KI, WI, SEL, tid, lane, wave); }
    { PH_IDS(); convb_phase(lds, G, vcu, U, conv_b_w, conv_b_b, ln_b_g, ln_b_b, MIX, tid, lane, wave); }
    GRID_BAR();
    { PH_IDS(); sparse_attn_phase(lds, G, vcu, Qb, Kb, Vb, SEL, MIX, lane, wave); }
    GRID_BAR();
    GEMMX(EpiRes, EI(x, nullptr, nullptr, XB, SS1), MIX, wt_out, MTOK, DM, DM);
    GRID_BAR();
    GEMMX(EpiScale, EI(SS1, QC, DM, 1.0f), XB, wt_q, MTOK, DM, DM);
    GRID_BAR();
    { PH_IDS(); const int per = (512 + G - 1) / G; for (int i = 0; i < per; ++i) { const int u = vcu * per + i; if (u < 512) cross_attn_unit(lds, u >> 6, (u >> 4) & 3, u & 15, QC, KC, VC, OC, tid, lane, wave); } }
    GRID_BAR();
    GEMMX(EpiRes, EI(nullptr, XB, nullptr, XB, SS2), OC, wt_o, MTOK, DM, DM);
    GRID_BAR();
    GEMMX(EpiGateUpAct, EI(SS2, Hb, ffn_cw, ffn_cb, TOPG, TOPU, BOTG, lds + 131072), XB, wt_gu, MTOK, NGU, DM);
    GRID_BAR();
    { PH_IDS();
    for (int i = bx * 512 + tid; i < (MTOK / 256) * 2 * DFF; i += G * 512) {
        const int pm = i / (2 * DFF), rem = i - pm * (2 * DFF), j = rem / DFF, c = rem - j * DFF;
        const bool first = (pm & 15) == 0;
        const float gm2 = first ? 0.f : BOTG[((size_t)(pm - 1) * 2 + 0) * DFF + c], gm1 = first ? 0.f : BOTG[((size_t)(pm - 1) * 2 + 1) * DFF + c];
        const float g0 = TOPG[((size_t)pm * 2 + 0) * DFF + c], g1 = TOPG[((size_t)pm * 2 + 1) * DFF + c];
        const float cur = j ? g1 : g0, p1 = j ? g0 : gm1, p2 = j ? gm1 : gm2;
        const float gg = ffn_cb[c] + ffn_cw[2 * DFF + c] * cur + ffn_cw[DFF + c] * p1 + ffn_cw[c] * p2;
        Hb[((size_t)pm * 256 + j) * DFF + c] = f2bf(silu_f(gg) * TOPU[((size_t)pm * 2 + j) * DFF + c]);
    }
    }
    GRID_BAR();
    GEMMX(EpiRes, EI(nullptr, XB, out, nullptr, SS3), Hb, wt_down, MTOK, DM, DFF);
    GRID_BAR();
    { PH_IDS();
    for (int r = bx * 8 + wave; r < MTOK; r += G * 8) {
        const float rs = rstd_from_ss(SS3, (size_t)r);
        f32x4* xr = (f32x4*)(out + (size_t)r * DM) + lane; const f32x4* gr = (const f32x4*)g_final + lane;
#pragma unroll
        for (int j = 0; j < 4; ++j) xr[64 * j] = xr[64 * j] * rs * gr[64 * j];
    }
    }
}

extern "C" void kernel_launch(void* const* d_in, const int* in_sizes, int n_in, void* d_out, int out_size, void* d_ws, size_t ws_size, hipStream_t stream) {
    static int grid = 0;
    if (grid == 0) {
        int dev = 0, cus = 0, per_cu = 0;
        if (hipGetDevice(&dev) != hipSuccess || hipDeviceGetAttribute(&cus, hipDeviceAttributeMultiprocessorCount, dev) != hipSuccess) { fprintf(stderr, "kernel_launch: device query failed\n"); grid = -1; return; }
        if (hipFuncSetAttribute((const void*)mega_k, hipFuncAttributeMaxDynamicSharedMemorySize, LDS_BYTES) != hipSuccess) { fprintf(stderr, "kernel_launch: hipFuncSetAttribute failed\n"); grid = -1; return; }
        if (hipOccupancyMaxActiveBlocksPerMultiprocessor(&per_cu, (const void*)mega_k, 512, LDS_BYTES) != hipSuccess || per_cu < 1) { fprintf(stderr, "kernel_launch: occupancy query says %d\n", per_cu); per_cu = 1; }
        (void)hipGetLastError();
        grid = cus * 1;
        if (n_in != 23 || ws_size < 477 * MiB) { fprintf(stderr, "kernel_launch: unexpected n_in %d / ws %zu\n", n_in, ws_size); grid = -1; return; }
    }
    if (grid < 0) return;
    (void)hipMemsetAsync((char*)d_ws + WS_CTL, 0, CTL_ZERO_BYTES, stream);
    Args a{};
    for (int i = 0; i < 23; ++i) a.in[i] = (const float*)d_in[i];
    a.out = (float*)d_out; a.ws = (unsigned char*)d_ws;
    void* params[] = {&a};
    hipError_t e = hipLaunchCooperativeKernel((const void*)mega_k, dim3(grid), dim3(512), params, LDS_BYTES, stream);
    if (e != hipSuccess) fprintf(stderr, "cooperative launch failed: %s (grid %d)\n", hipGetErrorString(e), grid);
}
```

```cpp
#include <hip/hip_runtime.h>
#include <cstdio>
#include <cstdint>
#include <cmath>
namespace pg8 {
#define PG8_LAS __attribute__((address_space(3)))
typedef unsigned short bf16_t;
typedef short bf16x8 __attribute__((ext_vector_type(8)));
typedef float f32x4 __attribute__((ext_vector_type(4)));
typedef unsigned u32x4 __attribute__((ext_vector_type(4)));
constexpr int BM = 256, BK = 64, HALF = 128, HTB = HALF * BK * 2  , STAGE_BYTES = 8 * HTB, NXCD = 8, WGM = 8;

__host__ __device__ __forceinline__ int lds_byte(int r, int c) { const int st = (r >> 4) * 2 + (c >> 5), rr = r & 15, cc = c & 31, ob = rr * 64 + cc * 2; return st * 1024 + (ob ^ (((ob >> 9) & 1) << 5)); }
__host__ __device__ __forceinline__ void stage_rc(int b, int& R, int& C) { const int st = b / 1024, sb = b % 1024, swz = sb ^ (((sb >> 9) & 1) << 5); R = (st >> 1) * 16 + swz / 64; C = (st & 1) * 32 + (swz % 64) / 2; }
__host__ __device__ __forceinline__ int perm32(int rho) { const int n = rho >> 4, i = rho & 15; return 8 * (i >> 2) + 4 * n + (i & 3); }

struct Unit { int pm, pn; };
struct Gemm { const bf16_t* A; const bf16_t* Bt; int M, N, K; };

struct StaticOrder {
    int nM, nN, nwg, G, c;
    __host__ __device__ void init(int M, int N, int G_, int c_) { nM = M / BM; nN = N / BM; nwg = nM * nN; G = G_; c = c_; }
    __host__ __device__ bool next(int i, Unit& u) const {
        const long L = (long)i * G + c; if (L >= nwg) return false;
        int wgid = (int)L; { const int q = nwg / NXCD, r = nwg % NXCD, xcd = wgid % NXCD, off = wgid / NXCD; wgid = (xcd < r ? xcd * (q + 1) : r * (q + 1) + (xcd - r) * q) + off; }
        const int nig = WGM * nN, gid = wgid / nig, fm = gid * WGM, gsz = (nM - fm) < WGM ? (nM - fm) : WGM;
        u.pm = fm + ((wgid % nig) % gsz); u.pn = (wgid % nig) / gsz; return true;
    }
    __device__ __forceinline__ void a_ready(const Unit&) const {}
    __device__ __forceinline__ void done(const Unit&) const {}
};
__device__ __forceinline__ unsigned cvt_pk_bf16(float lo, float hi) { unsigned r; asm volatile("v_cvt_pk_bf16_f32 %0, %1, %2" : "=v"(r) : "v"(lo), "v"(hi)); return r; }
template <class Epi, class Sched, bool ALIGN_EPI = false, bool SP2 = false>
__device__ __forceinline__ void gemm_phase(PG8_LAS unsigned char* lds, const Gemm g, const Sched& S, const Epi& E, int tid_in) {
    int tid_l = tid_in; asm volatile("" : "+v"(tid_l));
    const int tid = tid_l, wid = __builtin_amdgcn_readfirstlane(tid >> 6), lane = tid & 63, wr = wid >> 2, wc = wid & 3, fr = lane & 15, fq = lane >> 4;
    const int K = g.K, nt = K / BK;
    unsigned voffA[2], voffB[2];
#pragma unroll
    for (int i = 0; i < 2; ++i) { int R, C; stage_rc(tid * 16 + i * 8192, R, C); const int Rb = Epi::PERM ? ((R & ~31) + perm32(R & 31)) : R;
        voffA[i] = (unsigned)(R * K + C) * 2u; voffB[i] = (unsigned)(Rb * K + C) * 2u; }
    const size_t kstep = (size_t)(BK * 2);
    const size_t hstep = (size_t)HALF * K * 2;
    const size_t tstep = 2 * hstep;
    const unsigned ldsw = (unsigned)wid * 1024u;
    const int aoff = lds_byte(wr * 64 + fr, fq * 8), boff = lds_byte(wc * 32 + fr, fq * 8);
#define PG8_SA(b, h) (((b) * 2 + (h)) * HTB)
#define PG8_SB(b, h) ((4 + (b) * 2 + (h)) * HTB)
#define PG8_STAGE(bufoff, gbase, voff) do { _Pragma("unroll") for (int _i = 0; _i < 2; ++_i) \
        __builtin_amdgcn_global_load_lds((const unsigned*)((const char*)(gbase) + (voff)[_i]), (PG8_LAS unsigned*)(lds + (bufoff) + ldsw + _i * 8192), 16, 0, 0); } while (0)
#define PG8_LDA(dst, b, h) do { _Pragma("unroll") for (int m = 0; m < 4; ++m) _Pragma("unroll") for (int k = 0; k < 2; ++k) dst[m][k] = *(const PG8_LAS bf16x8*)(lds + PG8_SA(b, h) + aoff + m * 2048 + k * 1024); } while (0)
#define PG8_LDB(dst, b, h) do { _Pragma("unroll") for (int n = 0; n < 2; ++n) _Pragma("unroll") for (int k = 0; k < 2; ++k) dst[n][k] = *(const PG8_LAS bf16x8*)(lds + PG8_SB(b, h) + boff + n * 2048 + k * 1024); } while (0)
#define PG8_MMA(ai, bj, At, Bt) do { __builtin_amdgcn_s_setprio(1); _Pragma("unroll") for (int m = 0; m < 4; ++m) _Pragma("unroll") for (int n = 0; n < 2; ++n) _Pragma("unroll") for (int k = 0; k < 2; ++k) \
        acc[ai][bj][m][n] = __builtin_amdgcn_mfma_f32_16x16x32_bf16(Bt[n][k], At[m][k], acc[ai][bj][m][n], 0, 0, 0); __builtin_amdgcn_s_setprio(0); } while (0)
#define PG8_WAIT_V(n) asm volatile("s_waitcnt vmcnt(" #n ")" ::: "memory")
#define PG8_WAIT_L(n) asm volatile("s_waitcnt lgkmcnt(" #n ")" ::: "memory")
#define PG8_BAR __builtin_amdgcn_s_barrier()
#define PG8_SCHED __builtin_amdgcn_sched_barrier(0)
    Unit cur, nxt; int ui = 0;
    if (!S.next(0, cur)) return;
    f32x4 acc[2][2][4][2];
#pragma unroll
    for (int a = 0; a < 2; ++a)
#pragma unroll
        for (int b = 0; b < 2; ++b)
#pragma unroll
            for (int m = 0; m < 4; ++m)
#pragma unroll
                for (int n = 0; n < 2; ++n) acc[a][b][m][n] = (f32x4){0.f, 0.f, 0.f, 0.f};
    bf16x8 At[4][2], B0[2][2], B1[2][2];
    const char* cA = (const char*)g.A + (size_t)cur.pm * tstep; const char* cB = (const char*)g.Bt + (size_t)cur.pn * tstep;
    S.a_ready(cur);
    if constexpr (SP2) {
        PG8_STAGE(PG8_SB(0, 0), cB, voffB); PG8_STAGE(PG8_SB(0, 1), cB + hstep, voffB); PG8_STAGE(PG8_SA(0, 0), cA, voffA); PG8_STAGE(PG8_SA(0, 1), cA + hstep, voffA);
        if (wr == 1) PG8_BAR;
        PG8_WAIT_V(2); PG8_BAR;
        PG8_STAGE(PG8_SB(1, 0), cB + kstep, voffB); PG8_STAGE(PG8_SA(1, 0), cA + kstep, voffA); PG8_STAGE(PG8_SB(1, 1), cB + hstep + kstep, voffB);
        PG8_WAIT_V(6); PG8_BAR;
    } else {
        PG8_STAGE(PG8_SB(0, 0), cB, voffB); PG8_STAGE(PG8_SA(0, 0), cA, voffA); PG8_STAGE(PG8_SB(0, 1), cB + hstep, voffB); PG8_STAGE(PG8_SA(0, 1), cA + hstep, voffA);
        if (wr == 1) PG8_BAR;
        PG8_WAIT_V(4); PG8_BAR;
        PG8_STAGE(PG8_SB(1, 0), cB + kstep, voffB); PG8_STAGE(PG8_SA(1, 0), cA + kstep, voffA); PG8_STAGE(PG8_SB(1, 1), cB + hstep + kstep, voffB);
        PG8_WAIT_V(6); PG8_BAR;
    }
    for (;;) {
        const bool has_next = S.next(ui + 1, nxt);
        const char* nA = has_next ? (const char*)g.A + (size_t)nxt.pm * tstep : cA; const char* nB = has_next ? (const char*)g.Bt + (size_t)nxt.pn * tstep : cB;
        for (int t = 0; t < nt; t += 2) {
            const bool last = (t == nt - 2);
            const char* a1 = cA + (size_t)(t + 1) * kstep;
            const char* a2 = last ? nA : cA + (size_t)(t + 2) * kstep; const char* b2 = last ? nB : cB + (size_t)(t + 2) * kstep;
            const char* a3 = a2 + kstep; const char* b3 = b2 + kstep;
            if (last && has_next) S.a_ready(nxt);
            if constexpr (SP2) {
            PG8_LDB(B0, 0, 0); PG8_LDB(B1, 0, 1); PG8_SCHED; PG8_LDA(At, 0, 0); PG8_STAGE(PG8_SA(1, 1), a1 + hstep, voffA);
            PG8_WAIT_V(8); PG8_WAIT_L(0); PG8_BAR; PG8_MMA(0, 0, At, B0); PG8_MMA(0, 1, At, B1); PG8_BAR; PG8_SCHED;
            PG8_LDA(At, 0, 1); PG8_STAGE(PG8_SB(0, 0), b2, voffB); PG8_STAGE(PG8_SB(0, 1), b2 + hstep, voffB); PG8_STAGE(PG8_SA(0, 0), a2, voffA);
            PG8_WAIT_V(8); PG8_WAIT_L(0); PG8_BAR; PG8_MMA(1, 0, At, B0); PG8_MMA(1, 1, At, B1); PG8_BAR; PG8_SCHED;
            PG8_LDB(B0, 1, 0); PG8_LDB(B1, 1, 1); PG8_SCHED; PG8_LDA(At, 1, 0); PG8_STAGE(PG8_SA(0, 1), a2 + hstep, voffA);
            PG8_WAIT_V(8); PG8_WAIT_L(0); PG8_BAR; PG8_MMA(0, 0, At, B0); PG8_MMA(0, 1, At, B1); PG8_BAR; PG8_SCHED;
            PG8_LDA(At, 1, 1); PG8_STAGE(PG8_SB(1, 0), b3, voffB); PG8_STAGE(PG8_SB(1, 1), b3 + hstep, voffB); PG8_STAGE(PG8_SA(1, 0), a3, voffA);
            PG8_WAIT_V(8); PG8_WAIT_L(0); PG8_BAR; PG8_MMA(1, 0, At, B0); PG8_MMA(1, 1, At, B1); PG8_BAR; PG8_SCHED;
            } else {
            PG8_LDB(B0, 0, 0); PG8_SCHED; PG8_LDA(At, 0, 0); PG8_STAGE(PG8_SA(1, 1), a1 + hstep, voffA);
            PG8_WAIT_L(8); PG8_BAR; PG8_WAIT_L(0); PG8_MMA(0, 0, At, B0); PG8_BAR; PG8_SCHED;
            PG8_LDB(B1, 0, 1); PG8_STAGE(PG8_SB(0, 0), b2, voffB);
            PG8_BAR; PG8_WAIT_L(0); PG8_MMA(0, 1, At, B1); PG8_BAR;
            PG8_LDA(At, 0, 1); PG8_STAGE(PG8_SA(0, 0), a2, voffA);
            PG8_BAR; PG8_WAIT_L(0); PG8_MMA(1, 0, At, B0); PG8_BAR; PG8_SCHED;
            PG8_STAGE(PG8_SB(0, 1), b2 + hstep, voffB);
            PG8_WAIT_V(6); PG8_BAR; PG8_MMA(1, 1, At, B1); PG8_BAR;
            PG8_LDB(B0, 1, 0); PG8_SCHED; PG8_LDA(At, 1, 0); PG8_STAGE(PG8_SA(0, 1), a2 + hstep, voffA);
            PG8_WAIT_L(8); PG8_BAR; PG8_WAIT_L(0); PG8_MMA(0, 0, At, B0); PG8_BAR; PG8_SCHED;
            PG8_LDB(B1, 1, 1); PG8_STAGE(PG8_SB(1, 0), b3, voffB);
            PG8_BAR; PG8_WAIT_L(0); PG8_MMA(0, 1, At, B1); PG8_BAR;
            PG8_LDA(At, 1, 1); PG8_STAGE(PG8_SA(1, 0), a3, voffA);
            PG8_BAR; PG8_WAIT_L(0); PG8_MMA(1, 0, At, B0); PG8_BAR; PG8_SCHED;
            PG8_STAGE(PG8_SB(1, 1), b3 + hstep, voffB);
            PG8_WAIT_V(6); PG8_BAR; PG8_MMA(1, 1, At, B1); PG8_BAR;
            }
        }
        if constexpr (ALIGN_EPI) { if (wr == 0) PG8_BAR; }
        if constexpr (!Epi::AFTER_DRAIN) { E(acc, cur, wr, wc, fr, fq); S.done(cur); }
        if (!has_next) break;
#pragma unroll
        for (int a = 0; a < 2; ++a)
#pragma unroll
            for (int b = 0; b < 2; ++b)
#pragma unroll
                for (int m = 0; m < 4; ++m)
#pragma unroll
                    for (int n = 0; n < 2; ++n) acc[a][b][m][n] = (f32x4){0.f, 0.f, 0.f, 0.f};
        cur = nxt; cA = nA; cB = nB; ++ui;
        if constexpr (ALIGN_EPI) { if (wr == 1) PG8_BAR; }
    }
    PG8_WAIT_V(0);
    if constexpr (!ALIGN_EPI) { if (wr == 0) PG8_BAR; }
    PG8_BAR;
    if constexpr (Epi::AFTER_DRAIN) { E.fused(acc, cur, wr, wc, fr, fq, lds, wid, lane); S.done(cur); }
#undef PG8_SA
#undef PG8_SB
#undef PG8_STAGE
#undef PG8_LDA
#undef PG8_LDB
#undef PG8_MMA
#undef PG8_WAIT_V
#undef PG8_WAIT_L
#undef PG8_BAR
#undef PG8_SCHED
}
}

constexpr int BATCH = 8, SEQ = 4096, DM = 1024, MTOK = BATCH * SEQ;
constexpr int NMEM = 256, MMEM = BATCH * NMEM;
constexpr int AW = 512, HD = 64, NH = 8, IH = 4, TOPK = 256;
constexpr int INC = 1988, INP = 2048;
constexpr int DFF = 2816;
constexpr float EPS = 1e-6f;
#define LAS __attribute__((address_space(3)))
typedef unsigned short bf16_t;
typedef float f32x4 __attribute__((ext_vector_type(4)));
typedef unsigned u32x4 __attribute__((ext_vector_type(4)));
typedef unsigned u32x2 __attribute__((ext_vector_type(2)));

__device__ __forceinline__ float bf2f(bf16_t v) { return __uint_as_float((unsigned)v << 16); }
__device__ __forceinline__ bf16_t f2bf(float f) { unsigned u = __float_as_uint(f); return (bf16_t)((u + 0x7fffu + ((u >> 16) & 1u)) >> 16); }
__device__ __forceinline__ float shx(float v, int lane, int o) { return __uint_as_float((unsigned)__builtin_amdgcn_ds_bpermute((lane ^ o) << 2, (int)__float_as_uint(v))); }
__device__ __forceinline__ float wave_sum_l(float v, int lane) {
#pragma unroll
    for (int o = 1; o < 64; o <<= 1) v += shx(v, lane, o);
    return v;
}
__device__ __forceinline__ float wave_sum(float v) {
#pragma unroll
    for (int o = 1; o < 64; o <<= 1) v += __shfl_xor(v, o);
    return v;
}
__device__ __forceinline__ float wave_max(float v) {
#pragma unroll
    for (int o = 1; o < 64; o <<= 1) v = fmaxf(v, __shfl_xor(v, o));
    return v;
}
__device__ __forceinline__ float silu_f(float v) { return v * __builtin_amdgcn_rcpf(1.f + __expf(-v)); }

struct EpiStore {
    static constexpr bool PERM = false, AFTER_DRAIN = false;
    float* outf; bf16_t* outb; const float* res; int ldc;
    __device__ __forceinline__ void operator()(const pg8::f32x4 (&acc)[2][2][4][2], const pg8::Unit& u, int wr, int wc, int fr, int fq) const {
        const int col0 = u.pn * 256 + wc * 32 + 4 * fq;
#pragma unroll
        for (int ai = 0; ai < 2; ++ai)
#pragma unroll
            for (int m = 0; m < 4; ++m) {
                const size_t row = (size_t)(u.pm * 256 + ai * 128 + wr * 64 + m * 16 + fr);
#pragma unroll
                for (int bj = 0; bj < 2; ++bj)
#pragma unroll
                    for (int n = 0; n < 2; ++n) {
                        const size_t off = row * ldc + col0 + bj * 128 + n * 16;
                        pg8::f32x4 v = acc[ai][bj][m][n];
                        if (res) { const pg8::f32x4 r = *(const pg8::f32x4*)(res + off); v = v + r; }
                        if (outf) *(pg8::f32x4*)(outf + off) = v;
                        if (outb) { u32x2 w; w.x = (unsigned)f2bf(v[0]) | ((unsigned)f2bf(v[1]) << 16); w.y = (unsigned)f2bf(v[2]) | ((unsigned)f2bf(v[3]) << 16); *(u32x2*)(outb + off) = w; }
                    }
            }
    }
};
#define XB_TMO      128
#define XB_XCNT(j)  (256  + 64 * (j))
#define XB_XSUB(j)  (1280 + 64 * (j))
#define XB_XGEN(j)  (2304 + 64 * (j))
#define XB_TOP      3328
#define XB_TOPGEN   3392
#define XCD_BAR_WORDS 3456
#define XB_SPIN_CAP (1u << 18)

__device__ __forceinline__ unsigned xb_ld(unsigned* p)              { return __hip_atomic_load(p, __ATOMIC_RELAXED, __HIP_MEMORY_SCOPE_AGENT); }
__device__ __forceinline__ unsigned xb_add(unsigned* p, unsigned v) { return __hip_atomic_fetch_add(p, v, __ATOMIC_RELAXED, __HIP_MEMORY_SCOPE_AGENT); }
__device__ __forceinline__ unsigned xb_xcc_id() { return (unsigned)__builtin_amdgcn_s_getreg((3 << 11) | 20) & 0xFu; }
#define XB_SPIN(cond, bar) do { unsigned _sp = 0; while (cond) { __builtin_amdgcn_s_sleep(1); \
    if ((++_sp & 255u) == 0u) { if (xb_ld(&(bar)[XB_TMO])) break; if (_sp > XB_SPIN_CAP) { atomicAdd(&(bar)[XB_TMO], 1u); break; } } } } while (0)

struct XcdBarrier {
    unsigned* bar; unsigned x;
    volatile LAS unsigned* st;
};

__device__ __forceinline__ XcdBarrier xcd_barrier_post(unsigned* bar, volatile LAS unsigned* st) {
    XcdBarrier b; b.bar = bar; b.x = xb_xcc_id(); b.st = st;
    if (threadIdx.x == 0) (void)xb_add(&bar[XB_XCNT(b.x)], 1u);
    return b;
}
__device__ __forceinline__ void xcd_barrier_complete(unsigned* bar, unsigned x, unsigned& nloc, unsigned& nx) {
    const unsigned G = gridDim.x * gridDim.y * gridDim.z;
    unsigned sum, cnt, mine, sp = 0u;
    for (;;) {
        sum = 0u; cnt = 0u; mine = 0u;
#pragma unroll
        for (unsigned j = 0; j < 16; ++j) { const unsigned c = xb_ld(&bar[XB_XCNT(j)]); sum += c; cnt += (c > 0u) ? 1u : 0u; mine = (j == x) ? c : mine; }
        if (sum == G) break;
        __builtin_amdgcn_s_sleep(1);
        if ((++sp & 255u) == 0u) { if (xb_ld(&bar[XB_TMO])) break; if (sp > XB_SPIN_CAP) { atomicAdd(&bar[XB_TMO], 1u); break; } }
    }
    nloc = mine > 0u ? mine : 1u; nx = cnt > 0u ? cnt : 1u;
}

__device__ __forceinline__ void xcd_barrier(const XcdBarrier& b) {
    asm volatile("s_waitcnt vmcnt(0)" ::: "memory");
    __syncthreads();
    if (threadIdx.x == 0) {
        unsigned* bar = b.bar;
        __builtin_amdgcn_s_waitcnt(0);
        unsigned nloc = b.st[0], nx = b.st[1];
        if (nloc == 0u) { xcd_barrier_complete(bar, b.x, nloc, nx); b.st[0] = nloc; b.st[1] = nx; }
        const unsigned old = xb_add(&bar[XB_XSUB(b.x)], 1u);
        const unsigned gen = old / nloc;
        if (old + 1u == (gen + 1u) * nloc) {
            __builtin_amdgcn_fence(__ATOMIC_RELEASE, "agent");
            asm volatile("s_waitcnt vmcnt(0)" ::: "memory");
            const unsigned og = xb_add(&bar[XB_TOP], 1u);
            const unsigned tg = og / nx;
            if (og + 1u == (tg + 1u) * nx) xb_add(&bar[XB_TOPGEN], 1u);
            else XB_SPIN(xb_ld(&bar[XB_TOPGEN]) == tg, bar);
            __builtin_amdgcn_fence(__ATOMIC_ACQUIRE, "agent");
            xb_add(&bar[XB_XGEN(b.x)], 1u);
            asm volatile("s_waitcnt vmcnt(0)" ::: "memory");
        } else {
            XB_SPIN(xb_ld(&bar[XB_XGEN(b.x)]) == gen, bar);
            __builtin_amdgcn_fence(__ATOMIC_ACQUIRE, "agent");
            asm volatile("s_waitcnt vmcnt(0)" ::: "memory");
        }
    }
    __syncthreads();
}

__device__ __forceinline__ u32x4 pack8(const pg8::f32x4 a, const pg8::f32x4 b) {
    u32x4 w; w.x = pg8::cvt_pk_bf16(a[0], a[1]); w.y = pg8::cvt_pk_bf16(a[2], a[3]); w.z = pg8::cvt_pk_bf16(b[0], b[1]); w.w = pg8::cvt_pk_bf16(b[2], b[3]); return w;
}
__device__ __forceinline__ float sigmoid_f(float v) { return __builtin_amdgcn_rcpf(1.f + __expf(-v)); }
__host__ __device__ __forceinline__ int dperm(int pos) { return pos < 16 ? (4 * (pos >> 3) + (pos & 3) + 8 * ((pos >> 2) & 1)) : pos; }
__host__ __device__ __forceinline__ int in_orig_col(int n) {
    if (n < 512) return (n & ~63) + dperm(n & 63);
    if (n < 576) return 512 + dperm(n - 512);
    if (n < 640) return 576 + (n - 576);
    if (n < 704) return 896 + dperm(n - 640);
    if (n < 708) return 960 + (n - 704);
    if (n < 768) return -1;
    if (n < 1024) return 640 + ((n - 768) & ~63) + dperm((n - 768) & 63);
    const int i = (n - 1024) >> 8, c = (n - 1024) & 255;
    return c < 128 ? 964 + 128 * i + c : 1476 + 128 * i + (c - 128);
}
struct EpiIn {
    static constexpr bool PERM = true, AFTER_DRAIN = false;
    const float* cs; bf16_t *Q, *K, *V, *QI, *KI, *U; float* WI;
    __device__ __forceinline__ void operator()(const pg8::f32x4 (&acc)[2][2][4][2], const pg8::Unit& u, int wr, int wc, int fr, int fq) const {
        const int pn = u.pn;
        if (pn >= 4) {
            const int ch = 128 * (pn - 4) + 32 * wc + 8 * fq;
#pragma unroll
            for (int ai = 0; ai < 2; ++ai)
#pragma unroll
                for (int m = 0; m < 4; ++m) { const size_t row = (size_t)(u.pm * 256 + ai * 128 + wr * 64 + m * 16 + fr);
                    pg8::f32x4 a0 = acc[ai][0][m][0], a1 = acc[ai][0][m][1]; const pg8::f32x4 g0 = acc[ai][1][m][0], g1 = acc[ai][1][m][1];
#pragma unroll
                    for (int k = 0; k < 4; ++k) { a0[k] *= sigmoid_f(g0[k]); a1[k] *= sigmoid_f(g1[k]); }
                    *(u32x4*)(U + row * 512 + ch) = pack8(a0, a1); }
            return;
        }
        const bool rot = (pn == 2) ? (wc == 0 && fq < 2) : ((wc & 1) == 0 && fq < 2);
#pragma unroll
        for (int ai = 0; ai < 2; ++ai)
#pragma unroll
            for (int m = 0; m < 4; ++m) { const size_t row = (size_t)(u.pm * 256 + ai * 128 + wr * 64 + m * 16 + fr);
                pg8::f32x4 cv = {1.f, 1.f, 1.f, 1.f}, sv = {0.f, 0.f, 0.f, 0.f};
                if (rot) { cv = *(const pg8::f32x4*)(cs + row * 16 + 4 * fq); sv = *(const pg8::f32x4*)(cs + row * 16 + 8 + 4 * fq); }
#pragma unroll
                for (int bj = 0; bj < 2; ++bj) {
                    const pg8::f32x4 v0 = acc[ai][bj][m][0], v1 = acc[ai][bj][m][1];
                    pg8::f32x4 n0 = v0 * cv - v1 * sv, n1 = v1 * cv + v0 * sv;
                    if (!rot) { n0 = v0; n1 = v1; }
                    const int c = 128 * bj + 32 * wc + 8 * fq;
                    if (pn < 2) *(u32x4*)(Q + row * 512 + 256 * pn + c) = pack8(n0, n1);
                    else if (pn == 3) *(u32x4*)(QI + row * 256 + c) = pack8(n0 * 0.125f, n1 * 0.125f);
                    else {
                        if (bj == 0) { if (wc < 2) *(u32x4*)(K + row * 64 + 32 * wc + 8 * fq) = pack8(n0, n1); else *(u32x4*)(V + row * 64 + 32 * (wc - 2) + 8 * fq) = pack8(v0, v1); }
                        else { if (wc < 2) *(u32x4*)(KI + row * 64 + 32 * wc + 8 * fq) = pack8(n0, n1); else if (wc == 2 && fq == 0) *(pg8::f32x4*)(WI + row * 4) = v0 * 0.5f; }
                    }
                }
            }
    }
};
struct EpiRes {
    static constexpr bool PERM = true, AFTER_DRAIN = false;
    const float* resf; const bf16_t* resb; float* outf; bf16_t* xb; float* ss;
    __device__ __forceinline__ void operator()(const pg8::f32x4 (&acc)[2][2][4][2], const pg8::Unit& u, int wr, int wc, int fr, int fq) const {
#pragma unroll
        for (int ai = 0; ai < 2; ++ai)
#pragma unroll
            for (int m = 0; m < 4; ++m) { const size_t row = (size_t)(u.pm * 256 + ai * 128 + wr * 64 + m * 16 + fr); float q = 0.f;
#pragma unroll
                for (int bj = 0; bj < 2; ++bj) { const size_t off = row * DM + u.pn * 256 + 128 * bj + 32 * wc + 8 * fq;
                    pg8::f32x4 r0, r1;
                    if (resf) { r0 = *(const pg8::f32x4*)(resf + off); r1 = *(const pg8::f32x4*)(resf + off + 4); }
                    else { const u32x4 rb = *(const u32x4*)(resb + off);
                        r0 = (pg8::f32x4){__uint_as_float(rb.x << 16), __uint_as_float(rb.x & 0xffff0000u), __uint_as_float(rb.y << 16), __uint_as_float(rb.y & 0xffff0000u)};
                        r1 = (pg8::f32x4){__uint_as_float(rb.z << 16), __uint_as_float(rb.z & 0xffff0000u), __uint_as_float(rb.w << 16), __uint_as_float(rb.w & 0xffff0000u)}; }
                    const pg8::f32x4 v0 = acc[ai][bj][m][0] + r0, v1 = acc[ai][bj][m][1] + r1;
                    if (outf) { *(pg8::f32x4*)(outf + off) = v0; *(pg8::f32x4*)(outf + off + 4) = v1; }
                    if (xb) *(u32x4*)(xb + off) = pack8(v0, v1);
                    q += (v0[0] * v0[0] + v0[1] * v0[1]) + (v0[2] * v0[2] + v0[3] * v0[3]) + (v1[0] * v1[0] + v1[1] * v1[1]) + (v1[2] * v1[2] + v1[3] * v1[3]); }
                { const int lane_ = fq * 16 + fr; q += shx(q, lane_, 16); q += shx(q, lane_, 32); }
                if (fq == 0) ss[row * 16 + u.pn * 4 + wc] = q; }
    }
};
__device__ __forceinline__ float rstd_from_ss(const float* ss, size_t row) {
    const pg8::f32x4 a = *(const pg8::f32x4*)(ss + row * 16), b = *(const pg8::f32x4*)(ss + row * 16 + 4), c = *(const pg8::f32x4*)(ss + row * 16 + 8), d = *(const pg8::f32x4*)(ss + row * 16 + 12);
    const float s = ((a[0] + a[1]) + (a[2] + a[3])) + ((b[0] + b[1]) + (b[2] + b[3])) + ((c[0] + c[1]) + (c[2] + c[3])) + ((d[0] + d[1]) + (d[2] + d[3]));
    return __builtin_amdgcn_rsqf(s * (1.f / DM) + EPS);
}
struct EpiScale {
    static constexpr bool PERM = true, AFTER_DRAIN = false;
    const float* ss; bf16_t* O; int ldc; float scale;
    __device__ __forceinline__ void operator()(const pg8::f32x4 (&acc)[2][2][4][2], const pg8::Unit& u, int wr, int wc, int fr, int fq) const {
#pragma unroll
        for (int ai = 0; ai < 2; ++ai)
#pragma unroll
            for (int m = 0; m < 4; ++m) { const size_t row = (size_t)(u.pm * 256 + ai * 128 + wr * 64 + m * 16 + fr); const float r = rstd_from_ss(ss, row) * scale;
#pragma unroll
                for (int bj = 0; bj < 2; ++bj) *(u32x4*)(O + row * ldc + u.pn * 256 + 128 * bj + 32 * wc + 8 * fq) = pack8(acc[ai][bj][m][0] * r, acc[ai][bj][m][1] * r); }
    }
};
struct EpiGateUp {
    static constexpr bool PERM = true, AFTER_DRAIN = false;
    const float* ss; bf16_t* Gb; bf16_t* Ub;
    __device__ __forceinline__ void operator()(const pg8::f32x4 (&acc)[2][2][4][2], const pg8::Unit& u, int wr, int wc, int fr, int fq) const {
        const int ch = 128 * u.pn + 32 * wc + 8 * fq;
#pragma unroll
        for (int ai = 0; ai < 2; ++ai)
#pragma unroll
            for (int m = 0; m < 4; ++m) { const size_t row = (size_t)(u.pm * 256 + ai * 128 + wr * 64 + m * 16 + fr); const float r = rstd_from_ss(ss, row);
                *(u32x4*)(Gb + row * DFF + ch) = pack8(acc[ai][0][m][0] * r, acc[ai][0][m][1] * r);
                *(u32x4*)(Ub + row * DFF + ch) = pack8(acc[ai][1][m][0] * r, acc[ai][1][m][1] * r); }
    }
};
struct EpiGateUpAct {
    static constexpr bool PERM = true, AFTER_DRAIN = false;
    const float* ss; bf16_t* H; const float* cw; const float* cb; float* topg; float* topu; float* botg; LAS unsigned char* xch;
    __device__ __forceinline__ void operator()(const pg8::f32x4 (&acc)[2][2][4][2], const pg8::Unit& u, int wr, int wc, int fr, int fq) const {
        const int lane = fq * 16 + fr, chl = 32 * wc + 8 * fq, ch = 128 * u.pn + chl;
        const int l1 = (fq * 16 + ((fr + 15) & 15)) << 2, l2 = (fq * 16 + ((fr + 14) & 15)) << 2;
        (void)lane;
#pragma unroll
        for (int ai = 0; ai < 2; ++ai) { const size_t row = (size_t)(u.pm * 256 + ai * 128 + wr * 64 + 48 + fr); const float r = rstd_from_ss(ss, row);
            if (fr >= 14) { LAS float* p = (LAS float*)xch + ((2 * ai + wr) * 2 + (fr - 14)) * 128 + chl;
                *(LAS pg8::f32x4*)p = acc[ai][0][3][0] * r; *(LAS pg8::f32x4*)(p + 4) = acc[ai][0][3][1] * r; } }
        asm volatile("s_waitcnt lgkmcnt(0)" ::: "memory"); __builtin_amdgcn_s_barrier(); asm volatile("" ::: "memory");
        pg8::f32x4 wb[2], w2[2], w1[2], w0[2];
#pragma unroll
        for (int hq = 0; hq < 2; ++hq) { wb[hq] = *(const pg8::f32x4*)(cb + ch + 4 * hq); w2[hq] = *(const pg8::f32x4*)(cw + 2 * DFF + ch + 4 * hq); w1[hq] = *(const pg8::f32x4*)(cw + DFF + ch + 4 * hq); w0[hq] = *(const pg8::f32x4*)(cw + ch + 4 * hq); }
#pragma unroll
        for (int ai = 0; ai < 2; ++ai) {
            const int blk = 2 * ai + wr;
            pg8::f32x4 pv[2] = {{0.f, 0.f, 0.f, 0.f}, {0.f, 0.f, 0.f, 0.f}};
            if (blk > 0 && fr >= 14) { const LAS float* p = (const LAS float*)xch + ((blk - 1) * 2 + (fr - 14)) * 128 + chl; pv[0] = *(const LAS pg8::f32x4*)p; pv[1] = *(const LAS pg8::f32x4*)(p + 4); }
#pragma unroll
            for (int m = 0; m < 4; ++m) { const size_t row = (size_t)(u.pm * 256 + ai * 128 + wr * 64 + m * 16 + fr); const float r = rstd_from_ss(ss, row);
                pg8::f32x4 g[2], uu[2], hh[2];
#pragma unroll
                for (int hq = 0; hq < 2; ++hq) { g[hq] = acc[ai][0][m][hq] * r; uu[hq] = acc[ai][1][m][hq] * r; }
#pragma unroll
                for (int hq = 0; hq < 2; ++hq)
#pragma unroll
                    for (int k = 0; k < 4; ++k) {
                        const float x1 = (fr == 15) ? pv[hq][k] : g[hq][k], x2 = (fr >= 14) ? pv[hq][k] : g[hq][k];
                        const float p1 = __uint_as_float((unsigned)__builtin_amdgcn_ds_bpermute(l1, (int)__float_as_uint(x1)));
                        const float p2 = __uint_as_float((unsigned)__builtin_amdgcn_ds_bpermute(l2, (int)__float_as_uint(x2)));
                        const float gg = wb[hq][k] + w2[hq][k] * g[hq][k] + w1[hq][k] * p1 + w0[hq][k] * p2;
                        hh[hq][k] = gg * __builtin_amdgcn_rcpf(1.f + __expf(-gg)) * uu[hq][k]; }
                *(u32x4*)(H + row * DFF + ch) = pack8(hh[0], hh[1]);
                if (blk == 0 && m == 0 && fr < 2) { float* tg = topg + ((size_t)u.pm * 2 + fr) * DFF + ch; float* tu = topu + ((size_t)u.pm * 2 + fr) * DFF + ch;
                    *(pg8::f32x4*)tg = g[0]; *(pg8::f32x4*)(tg + 4) = g[1]; *(pg8::f32x4*)tu = uu[0]; *(pg8::f32x4*)(tu + 4) = uu[1]; }
                if (blk == 3 && m == 3 && fr >= 14) { float* bg = botg + ((size_t)u.pm * 2 + (fr - 14)) * DFF + ch; *(pg8::f32x4*)bg = g[0]; *(pg8::f32x4*)(bg + 4) = g[1]; }
                pv[0] = g[0]; pv[1] = g[1];
            }
        }
    }
};
typedef short bf16x8v __attribute__((ext_vector_type(8)));
constexpr int CA_STRIDE = 528;
__device__ __forceinline__ void cross_attn_unit(LAS unsigned char* lds, int b, int h, int qb, const bf16_t* QC, const bf16_t* KC, const bf16_t* VT, bf16_t* OC, int tid, int lane, int wave) {
    const int q16 = lane & 15, g = lane >> 4;
    const size_t row0 = (size_t)b * SEQ + (size_t)qb * 256 + wave * 32;
    asm volatile("" : "+v"(tid));
    { const bf16_t* src = KC + ((size_t)b * NMEM + (tid >> 5)) * DM + h * 256 + (tid & 31) * 8; LAS unsigned char* dst = lds + (tid >> 5) * CA_STRIDE + (tid & 31) * 16;
#pragma unroll
      for (int i = 0; i < 16; ++i) { const u32x4 v = *(const u32x4*)(src + (size_t)i * 16 * DM); *(LAS u32x4*)(dst + i * 16 * CA_STRIDE) = v; } }
    __syncthreads();
    f32x4 S[2][16];
#pragma unroll
    for (int st = 0; st < 2; ++st)
#pragma unroll
        for (int kt = 0; kt < 16; ++kt) S[st][kt] = (f32x4){0.f, 0.f, 0.f, 0.f};
#pragma unroll 1
    for (int kh = 0; kh < 2; ++kh) {
        bf16x8v qf[2][4];
#pragma unroll
        for (int st = 0; st < 2; ++st)
#pragma unroll
            for (int ks = 0; ks < 4; ++ks) qf[st][ks] = *(const bf16x8v*)(QC + (row0 + st * 16 + q16) * DM + h * 256 + kh * 128 + ks * 32 + g * 8);
        const LAS unsigned char* kb = lds + q16 * CA_STRIDE + kh * 256 + g * 16;
#pragma unroll
        for (int kt = 0; kt < 16; ++kt)
#pragma unroll
            for (int ks = 0; ks < 4; ++ks) { const bf16x8v a = *(const LAS bf16x8v*)(kb + kt * 16 * CA_STRIDE + ks * 64);
                S[0][kt] = __builtin_amdgcn_mfma_f32_16x16x32_bf16(a, qf[0][ks], S[0][kt], 0, 0, 0);
                S[1][kt] = __builtin_amdgcn_mfma_f32_16x16x32_bf16(a, qf[1][ks], S[1][kt], 0, 0, 0); }
    }
    const float c2 = 0.0625f * 1.4426950408889634f;
    float linv[2]; bf16x8v P[2][8];
#pragma unroll
    for (int st = 0; st < 2; ++st) {
        float m = -INFINITY;
#pragma unroll
        for (int kt = 0; kt < 16; ++kt) m = fmaxf(fmaxf(fmaxf(S[st][kt][0], S[st][kt][1]), fmaxf(S[st][kt][2], S[st][kt][3])), m);
        m = fmaxf(m, shx(m, lane, 16)); m = fmaxf(m, shx(m, lane, 32));
        const float mc = m * c2; float l = 0.f;
#pragma unroll
        for (int kt = 0; kt < 16; ++kt)
#pragma unroll
            for (int r = 0; r < 4; ++r) { const float p = __builtin_amdgcn_exp2f(S[st][kt][r] * c2 - mc); S[st][kt][r] = p; l += p; }
        l += shx(l, lane, 16); l += shx(l, lane, 32); linv[st] = 1.f / l;
#pragma unroll
        for (int c = 0; c < 8; ++c) { bf16x8v pk;
#pragma unroll
            for (int j = 0; j < 4; ++j) { pk[j] = (short)f2bf(S[st][2 * c][j]); pk[4 + j] = (short)f2bf(S[st][2 * c + 1][j]); }
            P[st][c] = pk; }
    }
    __syncthreads();
    { int tid2 = tid; asm volatile("" : "+v"(tid2));
      const bf16_t* src = VT + (size_t)(h * 256 + (tid2 >> 5)) * MMEM + b * NMEM + (tid2 & 31) * 8; LAS unsigned char* dst = lds + (tid2 >> 5) * CA_STRIDE + (tid2 & 31) * 16;
#pragma unroll
      for (int i = 0; i < 16; ++i) { const u32x4 v = *(const u32x4*)(src + (size_t)i * 16 * MMEM); *(LAS u32x4*)(dst + i * 16 * CA_STRIDE) = v; } }
    __syncthreads();
#pragma unroll 1
    for (int dh = 0; dh < 2; ++dh) {
        f32x4 O[2][8];
#pragma unroll
        for (int st = 0; st < 2; ++st)
#pragma unroll
            for (int dt = 0; dt < 8; ++dt) O[st][dt] = (f32x4){0.f, 0.f, 0.f, 0.f};
        const LAS unsigned char* pb = lds + (dh * 128 + q16) * CA_STRIDE + g * 8;
#pragma unroll
        for (int dt = 0; dt < 8; ++dt)
#pragma unroll
            for (int c = 0; c < 8; ++c) { const LAS unsigned char* p = pb + dt * 16 * CA_STRIDE + c * 64;
                const u32x2 lo = *(const LAS u32x2*)p, hi = *(const LAS u32x2*)(p + 32);
                const u32x4 av = (u32x4){lo.x, lo.y, hi.x, hi.y}; const bf16x8v a = __builtin_bit_cast(bf16x8v, av);
                O[0][dt] = __builtin_amdgcn_mfma_f32_16x16x32_bf16(a, P[0][c], O[0][dt], 0, 0, 0);
                O[1][dt] = __builtin_amdgcn_mfma_f32_16x16x32_bf16(a, P[1][c], O[1][dt], 0, 0, 0); }
#pragma unroll
        for (int st = 0; st < 2; ++st)
#pragma unroll
            for (int dt = 0; dt < 8; ++dt) { const f32x4 o = O[st][dt] * linv[st]; u32x2 w;
                w.x = (unsigned)f2bf(o[0]) | ((unsigned)f2bf(o[1]) << 16); w.y = (unsigned)f2bf(o[2]) | ((unsigned)f2bf(o[3]) << 16);
                *(u32x2*)(OC + (row0 + st * 16 + q16) * DM + h * 256 + dh * 128 + dt * 16 + g * 4) = w; }
    }
    __syncthreads();
}
typedef float f32x16v __attribute__((ext_vector_type(16)));
constexpr int TK_HIST_OFF = 131072;
__device__ __forceinline__ unsigned code16(float s) {
    const _Float16 hf = (_Float16)s; unsigned u = (unsigned)__builtin_bit_cast(unsigned short, hf);
    if ((u & 0x7fffu) == 0u) u = 0u;
    return (u & 0x8000u) ? (~u & 0xffffu) : (u | 0x8000u);
}
__device__ __forceinline__ unsigned mbcnt64(unsigned long long m) { return __builtin_amdgcn_mbcnt_hi((unsigned)(m >> 32), __builtin_amdgcn_mbcnt_lo((unsigned)m, 0u)); }
__device__ __forceinline__ void lds_hist_add(LAS unsigned char* hrow, unsigned bin) {
    __hip_atomic_fetch_add((LAS unsigned*)(hrow + ((bin & 127u) << 2)), (bin & 128u) ? 0x10000u : 1u, __ATOMIC_RELAXED, __HIP_MEMORY_SCOPE_WORKGROUP);
}
__device__ __forceinline__ void hist_select(const LAS unsigned char* hrow, unsigned target, int lane, unsigned& B, unsigned& above) {
    const u32x4 hv = *(const LAS u32x4*)(hrow + (lane & 31) * 16);
    const unsigned sh = (lane & 32) ? 16u : 0u;
    const unsigned h0 = (hv.x >> sh) & 0xffffu, h1 = (hv.y >> sh) & 0xffffu, h2 = (hv.z >> sh) & 0xffffu, h3 = (hv.w >> sh) & 0xffffu;
    const unsigned s = (h0 + h1) + (h2 + h3); unsigned S = s;
#pragma unroll
    for (int o = 1; o < 64; o <<= 1) { const unsigned v = (unsigned)__builtin_amdgcn_ds_bpermute(((lane + o) & 63) << 2, (int)S); if (lane + o < 64) S += v; }
    const unsigned long long mk = __ballot(S >= target);
    const int lb = 63 - __builtin_clzll(mk);
    const unsigned A = S - s, c3 = A + h3, c2 = c3 + h2, c1 = c2 + h1;
    const unsigned bsel = (c3 >= target) ? 3u : (c2 >= target) ? 2u : (c1 >= target) ? 1u : 0u;
    const unsigned asel = (c3 >= target) ? A : (c2 >= target) ? c3 : (c1 >= target) ? c2 : c1;
    B = 4u * (unsigned)lb + (unsigned)__builtin_amdgcn_readlane((int)bsel, lb);
    above = (unsigned)__builtin_amdgcn_readlane((int)asel, lb);
}
__device__ __forceinline__ void topk_unit(LAS unsigned char* lds, int b, int j, const bf16_t* QI, const bf16_t* KI, const float* WI, unsigned short* SEL, int tid, int lane, int wave) {
    asm volatile("" : "+v"(tid), "+v"(lane));
    const int t0 = 16 * j, L = t0 + 16, nkt = (L + 31) >> 5;
    const size_t rowbase = (size_t)b * SEQ + t0;
    const int c32 = lane & 31, hi = lane >> 5;
    *(LAS u32x4*)(lds + TK_HIST_OFF + tid * 16) = (u32x4){0u, 0u, 0u, 0u};
    __syncthreads();
    {
        bf16x8v qa[2][4]; f32x4 wq[2][4];
#pragma unroll
        for (int rt = 0; rt < 2; ++rt) {
#pragma unroll
            for (int ks = 0; ks < 4; ++ks) qa[rt][ks] = *(const bf16x8v*)(QI + (rowbase + 8 * rt + (c32 >> 2)) * 256 + (c32 & 3) * 64 + 16 * ks + 8 * hi);
#pragma unroll
            for (int gq = 0; gq < 4; ++gq) wq[rt][gq] = *(const f32x4*)(WI + (rowbase + 8 * rt + 2 * gq + hi) * 4);
        }
        const bf16_t* kbase = KI + ((size_t)b * SEQ + c32) * 64 + 8 * hi;
        bf16x8v kb[4], kn[4];
        int kt = wave;
        if (kt < nkt) {
#pragma unroll
            for (int ks = 0; ks < 4; ++ks) kb[ks] = *(const bf16x8v*)(kbase + (size_t)kt * 32 * 64 + 16 * ks);
        }
        for (; kt < nkt; kt += 8) {
            const int ktn = (kt + 8 < nkt) ? kt + 8 : kt;
#pragma unroll
            for (int ks = 0; ks < 4; ++ks) kn[ks] = *(const bf16x8v*)(kbase + (size_t)ktn * 32 * 64 + 16 * ks);
            const int key = kt * 32 + c32;
#pragma unroll
            for (int rt = 0; rt < 2; ++rt) {
                f32x16v c = {0.f, 0.f, 0.f, 0.f, 0.f, 0.f, 0.f, 0.f, 0.f, 0.f, 0.f, 0.f, 0.f, 0.f, 0.f, 0.f};
#pragma unroll
                for (int ks = 0; ks < 4; ++ks) c = __builtin_amdgcn_mfma_f32_32x32x16_bf16(qa[rt][ks], kb[ks], c, 0, 0, 0);
#pragma unroll
                for (int gq = 0; gq < 4; ++gq) {
                    const f32x4 w = wq[rt][gq];
                    const float sc = w[0] * fmaxf(c[4 * gq + 0], 0.f) + w[1] * fmaxf(c[4 * gq + 1], 0.f) + w[2] * fmaxf(c[4 * gq + 2], 0.f) + w[3] * fmaxf(c[4 * gq + 3], 0.f);
                    const int q = 8 * rt + 2 * gq + hi; const unsigned code = code16(sc);
                    *(LAS unsigned short*)(lds + q * 8192 + key * 2) = (unsigned short)code;
                    if (key <= t0 + q) lds_hist_add(lds + TK_HIST_OFF + q * 512, code >> 8);
                }
            }
#pragma unroll
            for (int ks = 0; ks < 4; ++ks) kb[ks] = kn[ks];
        }
    }
    __syncthreads();
#pragma unroll 1
    for (int qq = 0; qq < 2; ++qq) {
        const int q = 2 * wave + qq, t = t0 + q, n = t + 1;
        unsigned short* sel = SEL + (rowbase + q) * TOPK;
        if (n <= TOPK) {
#pragma unroll
            for (int i = 0; i < 4; ++i) { const int s = lane + 64 * i; if (s < n) sel[s] = (unsigned short)s; }
            continue;
        }
        const int nch = (n + 127) >> 7;
        LAS unsigned char* hrow = lds + TK_HIST_OFF + q * 512;
        const LAS unsigned* row = (const LAS unsigned*)(lds + q * 8192) + lane;
        unsigned B, above;
        hist_select(hrow, (unsigned)TOPK, lane, B, above);
        *(LAS u32x2*)(hrow + lane * 8) = (u32x2){0u, 0u};
        asm volatile("s_waitcnt lgkmcnt(0)" ::: "memory");
#pragma unroll 4
        for (int c = 0; c < nch; ++c) { const unsigned v = row[64 * c]; const int i0 = 128 * c + 2 * lane;
            const unsigned lo = v & 0xffffu, hi16 = v >> 16;
            if (i0 <= t && (lo >> 8) == B) lds_hist_add(hrow, lo & 255u);
            if (i0 + 1 <= t && (hi16 >> 8) == B) lds_hist_add(hrow, hi16 & 255u); }
        asm volatile("s_waitcnt lgkmcnt(0)" ::: "memory");
        unsigned b2, above2;
        hist_select(hrow, (unsigned)TOPK - above, lane, b2, above2);
        const unsigned T = (B << 8) | b2, cgt = above + above2, need = (unsigned)TOPK - cgt;
        unsigned eqrun = 0u, selrun = 0u;
#pragma unroll 2
        for (int c = 0; c < nch; ++c) { const unsigned v = row[64 * c]; const int i0 = 128 * c + 2 * lane;
            const unsigned lo = (i0 <= t) ? (v & 0xffffu) : 0u, hi16 = (i0 + 1 <= t) ? (v >> 16) : 0u;
            const bool glo = lo > T, ghi = hi16 > T;
            const unsigned long long mglo = __ballot(glo), mghi = __ballot(ghi);
            const unsigned plo = selrun + mbcnt64(mglo), phi = selrun + (unsigned)__popcll(mglo) + mbcnt64(mghi);
            if (glo) sel[plo] = (unsigned short)i0;
            if (ghi) sel[phi] = (unsigned short)(i0 + 1);
            selrun += (unsigned)__popcll(mglo) + (unsigned)__popcll(mghi);
            const bool elo = lo == T, ehi = hi16 == T;
            const unsigned long long melo = __ballot(elo), mehi = __ballot(ehi);
            if ((melo | mehi) != 0ull) {
                const unsigned rlo = eqrun + mbcnt64(melo) + mbcnt64(mehi), rhi = rlo + (elo ? 1u : 0u);
                if (elo && rlo < need) sel[cgt + rlo] = (unsigned short)i0;
                if (ehi && rhi < need) sel[cgt + rhi] = (unsigned short)(i0 + 1);
                eqrun += (unsigned)__popcll(melo) + (unsigned)__popcll(mehi);
            }
        }
    }
    __syncthreads();
}
__device__ __forceinline__ void topk_phase(LAS unsigned char* lds, int G, int vcu, const bf16_t* QI, const bf16_t* KI, const float* WI, unsigned short* SEL, int tid, int lane, int wave) {
    if (G == 256) {
        const int b = vcu >> 5, i = vcu & 31;
#pragma unroll 1
        for (int k = 0; k < 8; ++k) { const int j = 64 * (k >> 1) + ((k & 1) ? 63 - i : i); topk_unit(lds, b, j, QI, KI, WI, SEL, tid, lane, wave); }
    } else {
#pragma unroll 1
        for (int u = vcu; u < BATCH * 256; u += G) topk_unit(lds, u >> 8, u & 255, QI, KI, WI, SEL, tid, lane, wave);
    }
}
typedef short v4i16_t __attribute__((ext_vector_type(4)));
constexpr int SV_STRIDE = 160, SV_TILE_BYTES = 64 * SV_STRIDE, SV_WAVE_BYTES = SV_TILE_BYTES + 1024;
__device__ __forceinline__ v4i16_t tr_read16(const LAS unsigned char* p) { return __builtin_amdgcn_ds_read_tr16_b64_v4i16((LAS v4i16_t*)p); }
#define SP_FENCE() asm volatile("" ::: "memory")
__device__ __forceinline__ void sparse_attn_phase(LAS unsigned char* lds, int G, int vcu, const bf16_t* Q, const bf16_t* Kb, const bf16_t* Vb, const unsigned short* SEL, bf16_t* MIX, int lane, int wave) {
    asm volatile("" : "+v"(lane));
    LAS unsigned char* wl = lds + wave * SV_WAVE_BYTES;
    const int q16 = lane & 15, g = lane >> 4;
    const int nq = (G == 256) ? 16 : (MTOK - (vcu * 8 + wave) + G * 8 - 1) / (G * 8);
    const int r_first = (G == 256) ? (vcu >> 5) * SEQ + (vcu & 31) * 8 + wave : vcu * 8 + wave, r_step = (G == 256) ? 256 : G * 8;
    u32x2 selv = (u32x2){0u, 0u};
    if (nq > 0) selv = *(const u32x2*)(SEL + (size_t)r_first * TOPK + 4 * lane);
    LAS unsigned char* wdst = wl + (lane >> 3) * SV_STRIDE + (lane & 7) * 16;
    const LAS unsigned char* rsrc = wl + (4 * g + (q16 >> 2)) * SV_STRIDE + (q16 & 3) * 8;
    const float c2 = 0.125f * 1.4426950408889634f;
#pragma unroll 1
    for (int k = 0; k < nq; ++k) {
        const size_t row = (size_t)r_first + (size_t)k * r_step; const int b = (int)(row / SEQ), t = (int)(row % SEQ);
        const int n = (t + 1 < TOPK) ? t + 1 : TOPK;
        LAS unsigned char* ib = wl + SV_TILE_BYTES + (k & 1) * 512;
        *(LAS u32x2*)(ib + lane * 8) = selv;
        if (k + 1 < nq) selv = *(const u32x2*)(SEL + (row + r_step) * TOPK + 4 * lane);
        bf16x8v qf[2];
#pragma unroll
        for (int ks = 0; ks < 2; ++ks) { u32x4 v = (u32x4){0u, 0u, 0u, 0u}; if (q16 < 8) v = *(const u32x4*)(Q + row * 512 + q16 * 64 + ks * 32 + g * 8); qf[ks] = __builtin_bit_cast(bf16x8v, v); }
        f32x4 S[16];
        const bf16_t* kbat = Kb + (size_t)b * SEQ * 64 + g * 8;
        const bf16_t* vbat = Vb + (size_t)b * SEQ * 64 + (lane & 7) * 8;
#pragma unroll
        for (int kh = 0; kh < 2; ++kh) {
            bf16x8v kf[8][2];
#pragma unroll
            for (int i = 0; i < 8; ++i) { const int slot = 128 * kh + 16 * i + q16; unsigned idx = *(const LAS unsigned short*)(ib + slot * 2); if (slot >= n) idx = 0u;
#pragma unroll
                for (int ks = 0; ks < 2; ++ks) kf[i][ks] = *(const bf16x8v*)(kbat + (size_t)idx * 64 + ks * 32); }
            SP_FENCE();
#pragma unroll
            for (int i = 0; i < 8; ++i) { f32x4 c = (f32x4){0.f, 0.f, 0.f, 0.f};
                c = __builtin_amdgcn_mfma_f32_16x16x32_bf16(kf[i][0], qf[0], c, 0, 0, 0);
                c = __builtin_amdgcn_mfma_f32_16x16x32_bf16(kf[i][1], qf[1], c, 0, 0, 0); S[8 * kh + i] = c; }
            SP_FENCE();
        }
        u32x4 vv[8];
#pragma unroll
        for (int i = 0; i < 8; ++i) { const int slot = (lane >> 3) + 8 * i; unsigned idx = *(const LAS unsigned short*)(ib + slot * 2); if (slot >= n) idx = 0u; vv[i] = *(const u32x4*)(vbat + (size_t)idx * 64); }
        SP_FENCE();
        float m = -INFINITY;
#pragma unroll
        for (int kt = 0; kt < 16; ++kt)
#pragma unroll
            for (int r = 0; r < 4; ++r) { if (16 * kt + 4 * g + r >= n) S[kt][r] = -INFINITY; m = fmaxf(m, S[kt][r]); }
        m = fmaxf(m, shx(m, lane, 16)); m = fmaxf(m, shx(m, lane, 32));
        const float mc = m * c2; float l = 0.f;
#pragma unroll
        for (int kt = 0; kt < 16; ++kt)
#pragma unroll
            for (int r = 0; r < 4; ++r) { const float p = __builtin_amdgcn_exp2f(S[kt][r] * c2 - mc); S[kt][r] = p; l += p; }
        l += shx(l, lane, 16); l += shx(l, lane, 32);
        const float linv = 1.f / l;
        bf16x8v P[8];
#pragma unroll
        for (int c = 0; c < 8; ++c) { u32x4 pk; pk.x = pg8::cvt_pk_bf16(S[2 * c][0], S[2 * c][1]); pk.y = pg8::cvt_pk_bf16(S[2 * c][2], S[2 * c][3]); pk.z = pg8::cvt_pk_bf16(S[2 * c + 1][0], S[2 * c + 1][1]); pk.w = pg8::cvt_pk_bf16(S[2 * c + 1][2], S[2 * c + 1][3]);
            P[c] = __builtin_bit_cast(bf16x8v, pk); }
        f32x4 O[4];
#pragma unroll
        for (int dt = 0; dt < 4; ++dt) O[dt] = (f32x4){0.f, 0.f, 0.f, 0.f};
#pragma unroll
        for (int cc = 0; cc < 4; ++cc) {
#pragma unroll
            for (int i = 0; i < 8; ++i) *(LAS u32x4*)(wdst + i * 8 * SV_STRIDE) = vv[i];
            SP_FENCE();
            if (cc < 3) {
#pragma unroll
                for (int i = 0; i < 8; ++i) { const int slot = 64 * (cc + 1) + (lane >> 3) + 8 * i; unsigned idx = *(const LAS unsigned short*)(ib + slot * 2); if (slot >= n) idx = 0u; vv[i] = *(const u32x4*)(vbat + (size_t)idx * 64); }
            }
            asm volatile("s_waitcnt lgkmcnt(0)" ::: "memory");
#pragma unroll
            for (int c2i = 0; c2i < 2; ++c2i)
#pragma unroll
                for (int dt = 0; dt < 4; ++dt) { const LAS unsigned char* p = rsrc + c2i * 32 * SV_STRIDE + dt * 32;
                    const v4i16_t lo = tr_read16(p), hi = tr_read16(p + 16 * SV_STRIDE);
                    const bf16x8v a = (bf16x8v){lo[0], lo[1], lo[2], lo[3], hi[0], hi[1], hi[2], hi[3]};
                    O[dt] = __builtin_amdgcn_mfma_f32_16x16x32_bf16(a, P[2 * cc + c2i], O[dt], 0, 0, 0); }
            asm volatile("s_waitcnt lgkmcnt(0)" ::: "memory");
        }
        if (q16 < 8) {
#pragma unroll
            for (int dt = 0; dt < 4; ++dt) { const f32x4 o = O[dt] * linv; u32x2 w;
                w.x = pg8::cvt_pk_bf16(o[0], o[1]); w.y = pg8::cvt_pk_bf16(o[2], o[3]);
                *(u32x2*)(MIX + row * DM + q16 * 64 + dt * 16 + g * 4) = w; }
        }
    }
    __syncthreads();
}
__device__ __forceinline__ void convb_phase(LAS unsigned char* lds, int G, int vcu, const bf16_t* U, const float* __restrict__ cw, const float* __restrict__ cb, const float* __restrict__ lng, const float* __restrict__ lnb, bf16_t* MIX, int tid, int lane, int wave) {
    asm volatile("" : "+v"(tid), "+v"(lane));
    typedef float f32x2v __attribute__((ext_vector_type(2)));
    const int cp = tid & 255, th = tid >> 8;
    f32x2v w[31];
#pragma unroll
    for (int j = 0; j < 31; ++j) w[j] = *(const f32x2v*)(cw + j * 512 + 2 * cp);
    const f32x2v bias = *(const f32x2v*)(cb + 2 * cp), gam = *(const f32x2v*)(lng + 2 * cp), bet = *(const f32x2v*)(lnb + 2 * cp);
    LAS float* red = (LAS float*)(lds + 65536);
#pragma unroll 1
    for (int tile = vcu; tile < MTOK / 32; tile += G) {
        const int row0 = tile * 32, t0 = row0 & (SEQ - 1);
        for (int i = tid; i < 62 * 64; i += 512) { const int r = i >> 6, ch = i & 63; u32x4 v = (u32x4){0u, 0u, 0u, 0u};
            if (t0 - 30 + r >= 0) v = *(const u32x4*)(U + (size_t)(row0 - 30 + r) * 512 + ch * 8);
            *(LAS u32x4*)(lds + r * 1024 + ch * 16) = v; }
        __syncthreads();
        f32x2v y[2][8];
#pragma unroll
        for (int k = 0; k < 2; ++k) {
            const int tg = th + 2 * k;
            f32x2v acc[8];
#pragma unroll
            for (int o = 0; o < 8; ++o) acc[o] = bias;
            const LAS unsigned* wp = (const LAS unsigned*)(lds + tg * 8 * 1024) + cp;
#pragma unroll
            for (int j = 0; j < 38; ++j) { const unsigned uu = wp[j * 256]; const f32x2v uv = (f32x2v){__uint_as_float(uu << 16), __uint_as_float(uu & 0xffff0000u)};
#pragma unroll
                for (int o = 0; o < 8; ++o) { const int tap = j - o; if (tap >= 0 && tap < 31) acc[o] += w[tap] * uv; } }
#pragma unroll
            for (int o = 0; o < 8; ++o) { y[k][o] = acc[o];
                float s = acc[o].x + acc[o].y, q = acc[o].x * acc[o].x + acc[o].y * acc[o].y;
                s = wave_sum_l(s, lane); q = wave_sum_l(q, lane);
                if (lane == 0) { red[((tg * 8 + o) * 4 + (wave & 3)) * 2] = s; red[((tg * 8 + o) * 4 + (wave & 3)) * 2 + 1] = q; } }
        }
        __syncthreads();
#pragma unroll
        for (int k = 0; k < 2; ++k) {
            const int tg = th + 2 * k;
#pragma unroll
            for (int o = 0; o < 8; ++o) { const int tl = tg * 8 + o;
                const f32x4 ra = *(const LAS f32x4*)(red + tl * 8), rb = *(const LAS f32x4*)(red + tl * 8 + 4);
                const float mu = ((ra[0] + ra[2]) + (rb[0] + rb[2])) * (1.f / 512.f), ex2 = ((ra[1] + ra[3]) + (rb[1] + rb[3])) * (1.f / 512.f);
                const float rstd = 1.f / sqrtf(fmaxf(ex2 - mu * mu, 0.f) + EPS);
                const float v0 = (y[k][o].x - mu) * rstd * gam.x + bet.x, v1 = (y[k][o].y - mu) * rstd * gam.y + bet.y;
                *(unsigned*)(MIX + (size_t)(row0 + tl) * DM + 512 + 2 * cp) = (unsigned)f2bf(silu_f(v0)) | ((unsigned)f2bf(silu_f(v1)) << 16); }
        }
        __syncthreads();
    }
}

__device__ __forceinline__ int wt_dst_row(int mode, int c) {
    if (mode == 0) return c;
    if (mode == 2) return 256 * (c >> 7) + (c & 127);
    if (mode == 3) return 256 * (c >> 7) + 128 + (c & 127);
    if (c < 512) return (c & ~63) + dperm(c & 63);
    if (c < 576) return 512 + dperm(c - 512);
    if (c < 640) return c;
    if (c < 896) return 768 + ((c - 640) & ~63) + dperm((c - 640) & 63);
    if (c < 960) return 640 + dperm(c - 896);
    if (c < 964) return 704 + (c - 960);
    if (c < 1476) { const int j = c - 964; return 1024 + 256 * (j >> 7) + (j & 127); }
    { const int j = c - 1476; return 1024 + 256 * (j >> 7) + 128 + (j & 127); }
}
__device__ __forceinline__ void wt_body(LAS unsigned char* sm, int vb, int tid, const float* __restrict__ W, int K, int N, bf16_t* WT, const float* __restrict__ gain, int mode) {
    LAS float* t = (LAS float*)sm;
    const int nbx = (N + 31) / 32; const int k0 = (vb / nbx) * 32, n0 = (vb % nbx) * 32, tx = tid & 31, ty = tid >> 5;
    for (int i = ty; i < 32; i += 8) { const int k = k0 + i, n = n0 + tx; float v = 0.f; if (k < K && n < N) { v = W[(size_t)k * N + n]; if (gain) v *= gain[k]; } t[i * 33 + tx] = v; }
    __syncthreads();
    for (int i = ty; i < 32; i += 8) { const int n = n0 + i, k = k0 + tx; if (n < N && k < K) WT[(size_t)wt_dst_row(mode, n) * K + k] = f2bf(t[tx * 33 + i]); }
    __syncthreads();
}
__device__ __forceinline__ void rmsnorm_bf16_row(const float* x, const float* __restrict__ g, bf16_t* out, int row, int lane) {
    const f32x4* xr = (const f32x4*)(x + (size_t)row * DM) + lane; const f32x4* gr = (const f32x4*)g + lane;
    f32x4 v[4]; float s = 0.f;
#pragma unroll
    for (int j = 0; j < 4; ++j) { v[j] = xr[64 * j]; s += (v[j].x * v[j].x + v[j].y * v[j].y) + (v[j].z * v[j].z + v[j].w * v[j].w); }
    const float rstd = 1.f / sqrtf(wave_sum_l(s, lane) * (1.f / DM) + EPS);
    u32x2* o = (u32x2*)(out + (size_t)row * DM) + lane;
#pragma unroll
    for (int j = 0; j < 4; ++j) { const f32x4 gg = gr[64 * j]; u32x2 w;
        w.x = (unsigned)f2bf(v[j].x * rstd * gg.x) | ((unsigned)f2bf(v[j].y * rstd * gg.y) << 16);
        w.y = (unsigned)f2bf(v[j].z * rstd * gg.z) | ((unsigned)f2bf(v[j].w * rstd * gg.w) << 16); o[64 * j] = w; }
}
__device__ __forceinline__ void rmsnorm_f32_row(float* x, const float* __restrict__ g, int row, int lane) {
    f32x4* xr = (f32x4*)(x + (size_t)row * DM) + lane; const f32x4* gr = (const f32x4*)g + lane;
    f32x4 v[4]; float s = 0.f;
#pragma unroll
    for (int j = 0; j < 4; ++j) { v[j] = xr[64 * j]; s += (v[j].x * v[j].x + v[j].y * v[j].y) + (v[j].z * v[j].z + v[j].w * v[j].w); }
    const float rstd = 1.f / sqrtf(wave_sum_l(s, lane) * (1.f / DM) + EPS);
#pragma unroll
    for (int j = 0; j < 4; ++j) { const f32x4 gg = gr[64 * j]; xr[64 * j] = v[j] * rstd * gg; }
}

__device__ __forceinline__ void wt_item(const float* __restrict__ W, int K, int N, bf16_t* WT, const float* __restrict__ gain, int mode, LAS float* scr, int item, int lane) {
    const int nblk = (N + 31) / 32, kb = item / nblk, nb = item - kb * nblk, k0 = 64 * kb, n0 = 32 * nb;
    const int nn = n0 + (lane & 31);
    float wv[32];
#pragma unroll
    for (int i = 0; i < 32; ++i) { const int kk = 2 * i + (lane >> 5); wv[i] = 0.f; if (nn < N) wv[i] = W[(size_t)(k0 + kk) * N + nn]; }
#pragma unroll
    for (int i = 0; i < 32; ++i) { const int kk = 2 * i + (lane >> 5); float v = wv[i]; if (gain) v *= gain[k0 + kk]; scr[kk * 33 + (lane & 31)] = v; }
    asm volatile("s_waitcnt lgkmcnt(0)" ::: "memory");
    const int c = lane & 7;
#pragma unroll
    for (int j = 0; j < 4; ++j) { const int n = (lane >> 3) + 8 * j; const LAS float* s = scr + (8 * c) * 33 + n;
        u32x4 o; o.x = pg8::cvt_pk_bf16(s[0 * 33], s[1 * 33]); o.y = pg8::cvt_pk_bf16(s[2 * 33], s[3 * 33]); o.z = pg8::cvt_pk_bf16(s[4 * 33], s[5 * 33]); o.w = pg8::cvt_pk_bf16(s[6 * 33], s[7 * 33]);
        if (n0 + n < N) *(u32x4*)(WT + (size_t)wt_dst_row(mode, n0 + n) * K + k0 + 8 * c) = o; }
    asm volatile("s_waitcnt lgkmcnt(0)" ::: "memory");
}

__device__ __forceinline__ void rmsnorm_bf16_2rows(const float* x, const float* __restrict__ g, bf16_t* out, int row, int lane) {
    const f32x4* xr = (const f32x4*)(x + (size_t)row * DM) + lane; const f32x4* gr = (const f32x4*)g + lane;
    f32x4 v[2][4]; float s[2] = {0.f, 0.f};
#pragma unroll
    for (int r = 0; r < 2; ++r)
#pragma unroll
        for (int j = 0; j < 4; ++j) v[r][j] = xr[r * (DM / 4) + 64 * j];
#pragma unroll
    for (int r = 0; r < 2; ++r)
#pragma unroll
        for (int j = 0; j < 4; ++j) s[r] += (v[r][j].x * v[r][j].x + v[r][j].y * v[r][j].y) + (v[r][j].z * v[r][j].z + v[r][j].w * v[r][j].w);
#pragma unroll
    for (int r = 0; r < 2; ++r) { const float rstd = 1.f / sqrtf(wave_sum_l(s[r], lane) * (1.f / DM) + EPS);
        u32x2* o = (u32x2*)(out + (size_t)(row + r) * DM) + lane;
#pragma unroll
        for (int j = 0; j < 4; ++j) { const f32x4 gg = gr[64 * j]; u32x2 w;
            w.x = pg8::cvt_pk_bf16(v[r][j].x * rstd * gg.x, v[r][j].y * rstd * gg.y); w.y = pg8::cvt_pk_bf16(v[r][j].z * rstd * gg.z, v[r][j].w * rstd * gg.w); o[64 * j] = w; } }
}

constexpr size_t MiB = 1u << 20;
constexpr int LDS_USER = 139264, LDSCTL_OFF = LDS_USER, MISC_OFF = LDSCTL_OFF + 320, LDS_BYTES = 147456;
constexpr size_t WS_CTL = 476 * MiB, CTL_ZERO_BYTES = 1 * MiB; constexpr int CW_BAR = 4096;
constexpr int NGU = 2 * DFF;
struct Args { const float* in[23]; float* out; unsigned char* ws; };
static_assert(sizeof(Args) == 25 * 8, "Args has no padding");

__global__ void __launch_bounds__(512, 2) mega_k(Args a) {
    extern __shared__ __attribute__((aligned(16))) unsigned char lds_raw[];
    LAS unsigned char* lds = (LAS unsigned char*)lds_raw;
    const int wave = __builtin_amdgcn_readfirstlane(threadIdx.x >> 6);
#define PH_IDS() int lane; asm volatile("v_mbcnt_lo_u32_b32 %0, -1, 0\n\tv_mbcnt_hi_u32_b32 %0, -1, %0" : "=v"(lane)); const int tid = wave * 64 + lane, half = wave >> 2, htid = tid & 255; LAS unsigned char* hsm = lds + half * 65536; (void)htid; (void)hsm
    const int G = gridDim.x, bx = blockIdx.x; const int vcu = (G % 8 == 0) ? (bx % 8) * (G / 8) + bx / 8 : bx;
    const float* x = a.in[0]; const float* mem = a.in[1]; const int* positions = (const int*)a.in[2];
    const float* g_mix = a.in[3]; const float* w_in = a.in[4]; const float* w_out = a.in[5];
    const float* conv_b_w = a.in[6]; const float* conv_b_b = a.in[7]; const float* ln_b_g = a.in[8]; const float* ln_b_b = a.in[9];
    const float* g_cross = a.in[10]; const float* g_mem = a.in[11];
    const float* w_q = a.in[12]; const float* w_k = a.in[13]; const float* w_v = a.in[14]; const float* w_o = a.in[15];
    const float* g_ffn = a.in[16]; const float* w_gate = a.in[17]; const float* w_up = a.in[18];
    const float* ffn_cw = a.in[19]; const float* ffn_cb = a.in[20]; const float* w_down = a.in[21]; const float* g_final = a.in[22];
    float* out = a.out; unsigned char* ws = a.ws;
    bf16_t* wt_in = (bf16_t*)(ws + 0 * MiB); bf16_t* wt_out = (bf16_t*)(ws + 4 * MiB);
    bf16_t* wt_q = (bf16_t*)(ws + 6 * MiB), *wt_k = (bf16_t*)(ws + 8 * MiB), *wt_v = (bf16_t*)(ws + 10 * MiB), *wt_o = (bf16_t*)(ws + 12 * MiB);
    bf16_t* wt_gu = (bf16_t*)(ws + 14 * MiB); bf16_t* wt_down = (bf16_t*)(ws + 26 * MiB);
    float* WI = (float*)(ws + 32 * MiB); float* CS = (float*)(ws + 33 * MiB);
    float* SS1 = (float*)(ws + 35 * MiB); float* SS2 = (float*)(ws + 37 * MiB); float* SS3 = (float*)(ws + 39 * MiB);
    bf16_t* MEMN = (bf16_t*)(ws + 41 * MiB), *KC = (bf16_t*)(ws + 45 * MiB), *VC = (bf16_t*)(ws + 49 * MiB);
    bf16_t* XB = (bf16_t*)(ws + 56 * MiB);
    bf16_t* Qb = (bf16_t*)(ws + 120 * MiB); bf16_t* QI = (bf16_t*)(ws + 152 * MiB);
    bf16_t* Kb = (bf16_t*)(ws + 168 * MiB), *Vb = (bf16_t*)(ws + 172 * MiB), *KI = (bf16_t*)(ws + 176 * MiB);
    bf16_t* U = (bf16_t*)(ws + 180 * MiB); unsigned short* SEL = (unsigned short*)(ws + 212 * MiB);
    bf16_t* MIX = (bf16_t*)(ws + 228 * MiB); bf16_t* QC = (bf16_t*)(ws + 292 * MiB); bf16_t* OC = (bf16_t*)(ws + 356 * MiB);
    bf16_t* Hb = (bf16_t*)(ws + 120 * MiB);
    float* TOPG = (float*)(ws + 300 * MiB); float* TOPU = (float*)(ws + 304 * MiB); float* BOTG = (float*)(ws + 308 * MiB);
    unsigned* ctl = (unsigned*)(ws + WS_CTL);

    { PH_IDS(); for (int u = tid; u < (LDS_BYTES - LDSCTL_OFF) / 4; u += 512) ((LAS unsigned*)(lds + LDSCTL_OFF))[u] = 0u; }
    __syncthreads();
    XcdBarrier bar = xcd_barrier_post(ctl + CW_BAR, (volatile LAS unsigned*)(lds + MISC_OFF) + 8);
#define GRID_BAR() xcd_barrier(bar)
#define FOR_VB(nvb) for (int vb = 2 * bx + half; vb < (nvb); vb += 2 * G)
#define GEMMX(EPI, EINIT, Aptr, Bptr, Mv, Nv, Kv) do { pg8::Gemm g_{Aptr, Bptr, Mv, Nv, Kv}; pg8::StaticOrder S_; S_.init(Mv, Nv, G, bx); EPI E_ EINIT; \
        PH_IDS(); pg8::gemm_phase<EPI, pg8::StaticOrder, true, true>(lds, g_, S_, E_, tid); } while (0)
#define EI(...) {__VA_ARGS__}

    { PH_IDS();
    for (int i = bx * 512 + tid; i < 60 * DM; i += G * 512) wt_in[(size_t)708 * DM + i] = 0;
    { LAS float* scr = (LAS float*)(lds + wave * 8704); const int gw = vcu * 8 + wave, NGW = G * 8;
      constexpr int I_IN = 16 * 63, I_SQ = 16 * 32, I_FF = 16 * 88, I_DN = 44 * 32, NIT = I_IN + 5 * I_SQ + 2 * I_FF + I_DN;
#pragma unroll 1
      for (int it = gw; it < NIT; it += NGW) { int r = it;
          if (r < I_IN) { wt_item(w_in, DM, INC, wt_in, nullptr, 1, scr, r, lane); continue; } r -= I_IN;
          if (r < I_SQ) { wt_item(w_out, DM, DM, wt_out, nullptr, 0, scr, r, lane); continue; } r -= I_SQ;
          if (r < I_SQ) { wt_item(w_q, DM, DM, wt_q, g_cross, 0, scr, r, lane); continue; } r -= I_SQ;
          if (r < I_SQ) { wt_item(w_k, DM, DM, wt_k, nullptr, 0, scr, r, lane); continue; } r -= I_SQ;
          if (r < I_SQ) { wt_item(w_v, DM, DM, wt_v, nullptr, 0, scr, r, lane); continue; } r -= I_SQ;
          if (r < I_SQ) { wt_item(w_o, DM, DM, wt_o, nullptr, 0, scr, r, lane); continue; } r -= I_SQ;
          if (r < I_FF) { wt_item(w_gate, DM, DFF, wt_gu, g_ffn, 2, scr, r, lane); continue; } r -= I_FF;
          if (r < I_FF) { wt_item(w_up, DM, DFF, wt_gu, g_ffn, 3, scr, r, lane); continue; } r -= I_FF;
          wt_item(w_down, DFF, DM, wt_down, nullptr, 0, scr, r, lane); } }
    for (int i = bx * 512 + tid; i < MTOK * 8; i += G * 512) { const int row = i >> 3, k = i & 7;
        const float fr8[8] = {1.000000000e+00f, 1.939227432e-01f, 3.760603070e-02f, 7.292664610e-03f, 1.414213562e-03f, 2.742481884e-04f, 5.318295734e-05f, 1.031338525e-05f};
        float freq = fr8[0];
#pragma unroll
        for (int kk = 1; kk < 8; ++kk) freq = (k == kk) ? fr8[kk] : freq;
        const float ang = (float)positions[row] * freq;
        CS[(size_t)row * 16 + k] = (float)cos((double)ang); CS[(size_t)row * 16 + 8 + k] = (float)sin((double)ang); }
    for (int r = 2 * (bx * 8 + wave); r < MTOK; r += G * 16) rmsnorm_bf16_2rows(x, g_mix, XB, r, lane);
    for (int r = bx * 8 + wave; r < MMEM; r += G * 8) rmsnorm_bf16_row(mem, g_mem, MEMN, r, lane);
    }
    GRID_BAR();
    GEMMX(EpiIn, EI(CS, Qb, Kb, Vb, QI, KI, U, WI), XB, wt_in, MTOK, INP, DM);
    GEMMX(EpiStore, EI(nullptr, KC, nullptr, DM), MEMN, wt_k, MMEM, DM, DM);
    GEMMX(EpiStore, EI(nullptr, VC, nullptr, MMEM), wt_v, MEMN, DM, MMEM, DM);
    GRID_BAR();
    { PH_IDS(); topk_phase(lds, G, vcu, QI, KI, WI, SEL, tid, lane, wave); }
    { PH_IDS(); convb_phase(lds, G, vcu, U, conv_b_w, conv_b_b, ln_b_g, ln_b_b, MIX, tid, lane, wave); }
    GRID_BAR();
    { PH_IDS(); sparse_attn_phase(lds, G, vcu, Qb, Kb, Vb, SEL, MIX, lane, wave); }
    GRID_BAR();
    GEMMX(EpiRes, EI(x, nullptr, nullptr, XB, SS1), MIX, wt_out, MTOK, DM, DM);
    GRID_BAR();
    GEMMX(EpiScale, EI(SS1, QC, DM, 1.0f), XB, wt_q, MTOK, DM, DM);
    GRID_BAR();
    { PH_IDS(); const int per = (512 + G - 1) / G; for (int i = 0; i < per; ++i) { const int u = vcu * per + i; if (u < 512) cross_attn_unit(lds, u >> 6, (u >> 4) & 3, u & 15, QC, KC, VC, OC, tid, lane, wave); } }
    GRID_BAR();
    GEMMX(EpiRes, EI(nullptr, XB, nullptr, XB, SS2), OC, wt_o, MTOK, DM, DM);
    GRID_BAR();
    GEMMX(EpiGateUpAct, EI(SS2, Hb, ffn_cw, ffn_cb, TOPG, TOPU, BOTG, lds + 131072), XB, wt_gu, MTOK, NGU, DM);
    GRID_BAR();
    { PH_IDS();
    for (int i = bx * 512 + tid; i < (MTOK / 256) * 2 * DFF; i += G * 512) {
        const int pm = i / (2 * DFF), rem = i - pm * (2 * DFF), j = rem / DFF, c = rem - j * DFF;
        const bool first = (pm & 15) == 0;
        const float gm2 = first ? 0.f : BOTG[((size_t)(pm - 1) * 2 + 0) * DFF + c], gm1 = first ? 0.f : BOTG[((size_t)(pm - 1) * 2 + 1) * DFF + c];
        const float g0 = TOPG[((size_t)pm * 2 + 0) * DFF + c], g1 = TOPG[((size_t)pm * 2 + 1) * DFF + c];
        const float cur = j ? g1 : g0, p1 = j ? g0 : gm1, p2 = j ? gm1 : gm2;
        const float gg = ffn_cb[c] + ffn_cw[2 * DFF + c] * cur + ffn_cw[DFF + c] * p1 + ffn_cw[c] * p2;
        Hb[((size_t)pm * 256 + j) * DFF + c] = f2bf(silu_f(gg) * TOPU[((size_t)pm * 2 + j) * DFF + c]);
    }
    }
    GRID_BAR();
    GEMMX(EpiRes, EI(nullptr, XB, nullptr, XB, SS3), Hb, wt_down, MTOK, DM, DFF);
    GRID_BAR();
    { PH_IDS();
    for (int r = bx * 8 + wave; r < MTOK; r += G * 8) {
        const float rs = rstd_from_ss(SS3, (size_t)r);
        const u32x4* xr = (const u32x4*)(XB + (size_t)r * DM) + lane; f32x4* orow = (f32x4*)(out + (size_t)r * DM); const f32x4* gr = (const f32x4*)g_final;
#pragma unroll
        for (int j = 0; j < 2; ++j) { const u32x4 v = xr[64 * j]; const int c4 = (64 * j + lane) * 2;
            const f32x4 a = (f32x4){__uint_as_float(v.x << 16), __uint_as_float(v.x & 0xffff0000u), __uint_as_float(v.y << 16), __uint_as_float(v.y & 0xffff0000u)};
            const f32x4 bq = (f32x4){__uint_as_float(v.z << 16), __uint_as_float(v.z & 0xffff0000u), __uint_as_float(v.w << 16), __uint_as_float(v.w & 0xffff0000u)};
            orow[c4] = a * rs * gr[c4]; orow[c4 + 1] = bq * rs * gr[c4 + 1]; }
    }
    }
}

extern "C" void kernel_launch(void* const* d_in, const int* in_sizes, int n_in, void* d_out, int out_size, void* d_ws, size_t ws_size, hipStream_t stream) {
    static int grid = 0;
    if (grid == 0) {
        int dev = 0, cus = 0, per_cu = 0;
        if (hipGetDevice(&dev) != hipSuccess || hipDeviceGetAttribute(&cus, hipDeviceAttributeMultiprocessorCount, dev) != hipSuccess) { fprintf(stderr, "kernel_launch: device query failed\n"); grid = -1; return; }
        if (hipFuncSetAttribute((const void*)mega_k, hipFuncAttributeMaxDynamicSharedMemorySize, LDS_BYTES) != hipSuccess) { fprintf(stderr, "kernel_launch: hipFuncSetAttribute failed\n"); grid = -1; return; }
        if (hipOccupancyMaxActiveBlocksPerMultiprocessor(&per_cu, (const void*)mega_k, 512, LDS_BYTES) != hipSuccess || per_cu < 1) { fprintf(stderr, "kernel_launch: occupancy query says %d\n", per_cu); per_cu = 1; }
        (void)hipGetLastError();
        grid = cus * 1;
        if (n_in != 23 || ws_size < 477 * MiB) { fprintf(stderr, "kernel_launch: unexpected n_in %d / ws %zu\n", n_in, ws_size); grid = -1; return; }
    }
    if (grid < 0) return;
    (void)hipMemsetAsync((char*)d_ws + WS_CTL, 0, CTL_ZERO_BYTES, stream);
    Args a{};
    for (int i = 0; i < 23; ++i) a.in[i] = (const float*)d_in[i];
    a.out = (float*)d_out; a.ws = (unsigned char*)d_ws;
    void* params[] = {&a};
    hipError_t e = hipLaunchCooperativeKernel((const void*)mega_k, dim3(grid), dim3(512), params, LDS_BYTES, stream);
    if (e != hipSuccess) fprintf(stderr, "cooperative launch failed: %s (grid %d)\n", hipGetErrorString(e), grid);
}
```

```cpp
#include <hip/hip_runtime.h>
#include <cstdio>
#include <cstdint>
#include <cmath>
namespace pg8 {
#define PG8_LAS __attribute__((address_space(3)))
typedef unsigned short bf16_t;
typedef short bf16x8 __attribute__((ext_vector_type(8)));
typedef float f32x4 __attribute__((ext_vector_type(4)));
typedef unsigned u32x4 __attribute__((ext_vector_type(4)));
constexpr int BM = 256, BK = 64, HALF = 128, HTB = HALF * BK * 2  , STAGE_BYTES = 8 * HTB, NXCD = 8, WGM = 8;

__host__ __device__ __forceinline__ int lds_byte(int r, int c) { const int st = (r >> 4) * 2 + (c >> 5), rr = r & 15, cc = c & 31, ob = rr * 64 + cc * 2; return st * 1024 + (ob ^ (((ob >> 9) & 1) << 5)); }
__host__ __device__ __forceinline__ void stage_rc(int b, int& R, int& C) { const int st = b / 1024, sb = b % 1024, swz = sb ^ (((sb >> 9) & 1) << 5); R = (st >> 1) * 16 + swz / 64; C = (st & 1) * 32 + (swz % 64) / 2; }
__host__ __device__ __forceinline__ int perm32(int rho) { const int n = rho >> 4, i = rho & 15; return 8 * (i >> 2) + 4 * n + (i & 3); }

struct Unit { int pm, pn; };
struct Gemm { const bf16_t* A; const bf16_t* Bt; int M, N, K; };

struct StaticOrder {
    int nM, nN, nwg, G, c;
    __host__ __device__ void init(int M, int N, int G_, int c_) { nM = M / BM; nN = N / BM; nwg = nM * nN; G = G_; c = c_; }
    __host__ __device__ bool next(int i, Unit& u) const {
        const long L = (long)i * G + c; if (L >= nwg) return false;
        int wgid = (int)L; { const int q = nwg / NXCD, r = nwg % NXCD, xcd = wgid % NXCD, off = wgid / NXCD; wgid = (xcd < r ? xcd * (q + 1) : r * (q + 1) + (xcd - r) * q) + off; }
        const int nig = WGM * nN, gid = wgid / nig, fm = gid * WGM, gsz = (nM - fm) < WGM ? (nM - fm) : WGM;
        u.pm = fm + ((wgid % nig) % gsz); u.pn = (wgid % nig) / gsz; return true;
    }
    __device__ __forceinline__ void a_ready(const Unit&) const {}
    __device__ __forceinline__ void done(const Unit&) const {}
};
__device__ __forceinline__ unsigned cvt_pk_bf16(float lo, float hi) { unsigned r; asm volatile("v_cvt_pk_bf16_f32 %0, %1, %2" : "=v"(r) : "v"(lo), "v"(hi)); return r; }
template <class Epi, class Sched, bool ALIGN_EPI = false, bool SP2 = false>
__device__ __forceinline__ void gemm_phase(PG8_LAS unsigned char* lds, const Gemm g, const Sched& S, const Epi& E, int tid_in) {
    int tid_l = tid_in; asm volatile("" : "+v"(tid_l));
    const int tid = tid_l, wid = __builtin_amdgcn_readfirstlane(tid >> 6), lane = tid & 63, wr = wid >> 2, wc = wid & 3, fr = lane & 15, fq = lane >> 4;
    const int K = g.K, nt = K / BK;
    unsigned voffA[2], voffB[2];
#pragma unroll
    for (int i = 0; i < 2; ++i) { int R, C; stage_rc(tid * 16 + i * 8192, R, C); const int Rb = Epi::PERM ? ((R & ~31) + perm32(R & 31)) : R;
        voffA[i] = (unsigned)(R * K + C) * 2u; voffB[i] = (unsigned)(Rb * K + C) * 2u; }
    const size_t kstep = (size_t)(BK * 2);
    const size_t hstep = (size_t)HALF * K * 2;
    const size_t tstep = 2 * hstep;
    const unsigned ldsw = (unsigned)wid * 1024u;
    const int aoff = lds_byte(wr * 64 + fr, fq * 8), boff = lds_byte(wc * 32 + fr, fq * 8);
#define PG8_SA(b, h) (((b) * 2 + (h)) * HTB)
#define PG8_SB(b, h) ((4 + (b) * 2 + (h)) * HTB)
#define PG8_STAGE(bufoff, gbase, voff) do { _Pragma("unroll") for (int _i = 0; _i < 2; ++_i) \
        __builtin_amdgcn_global_load_lds((const unsigned*)((const char*)(gbase) + (voff)[_i]), (PG8_LAS unsigned*)(lds + (bufoff) + ldsw + _i * 8192), 16, 0, 0); } while (0)
#define PG8_LDA(dst, b, h) do { _Pragma("unroll") for (int m = 0; m < 4; ++m) _Pragma("unroll") for (int k = 0; k < 2; ++k) dst[m][k] = *(const PG8_LAS bf16x8*)(lds + PG8_SA(b, h) + aoff + m * 2048 + k * 1024); } while (0)
#define PG8_LDB(dst, b, h) do { _Pragma("unroll") for (int n = 0; n < 2; ++n) _Pragma("unroll") for (int k = 0; k < 2; ++k) dst[n][k] = *(const PG8_LAS bf16x8*)(lds + PG8_SB(b, h) + boff + n * 2048 + k * 1024); } while (0)
#define PG8_MMA(ai, bj, At, Bt) do { __builtin_amdgcn_s_setprio(1); _Pragma("unroll") for (int m = 0; m < 4; ++m) _Pragma("unroll") for (int n = 0; n < 2; ++n) _Pragma("unroll") for (int k = 0; k < 2; ++k) \
        acc[ai][bj][m][n] = __builtin_amdgcn_mfma_f32_16x16x32_bf16(Bt[n][k], At[m][k], acc[ai][bj][m][n], 0, 0, 0); __builtin_amdgcn_s_setprio(0); } while (0)
#define PG8_WAIT_V(n) asm volatile("s_waitcnt vmcnt(" #n ")" ::: "memory")
#define PG8_WAIT_L(n) asm volatile("s_waitcnt lgkmcnt(" #n ")" ::: "memory")
#define PG8_BAR __builtin_amdgcn_s_barrier()
#define PG8_SCHED __builtin_amdgcn_sched_barrier(0)
    Unit cur, nxt; int ui = 0;
    if (!S.next(0, cur)) return;
    f32x4 acc[2][2][4][2];
#pragma unroll
    for (int a = 0; a < 2; ++a)
#pragma unroll
        for (int b = 0; b < 2; ++b)
#pragma unroll
            for (int m = 0; m < 4; ++m)
#pragma unroll
                for (int n = 0; n < 2; ++n) acc[a][b][m][n] = (f32x4){0.f, 0.f, 0.f, 0.f};
    bf16x8 At[4][2], B0[2][2], B1[2][2];
    const char* cA = (const char*)g.A + (size_t)cur.pm * tstep; const char* cB = (const char*)g.Bt + (size_t)cur.pn * tstep;
    S.a_ready(cur);
    if constexpr (SP2) {
        PG8_STAGE(PG8_SB(0, 0), cB, voffB); PG8_STAGE(PG8_SB(0, 1), cB + hstep, voffB); PG8_STAGE(PG8_SA(0, 0), cA, voffA); PG8_STAGE(PG8_SA(0, 1), cA + hstep, voffA);
        if (wr == 1) PG8_BAR;
        PG8_WAIT_V(2); PG8_BAR;
        PG8_STAGE(PG8_SB(1, 0), cB + kstep, voffB); PG8_STAGE(PG8_SA(1, 0), cA + kstep, voffA); PG8_STAGE(PG8_SB(1, 1), cB + hstep + kstep, voffB);
        PG8_WAIT_V(6); PG8_BAR;
    } else {
        PG8_STAGE(PG8_SB(0, 0), cB, voffB); PG8_STAGE(PG8_SA(0, 0), cA, voffA); PG8_STAGE(PG8_SB(0, 1), cB + hstep, voffB); PG8_STAGE(PG8_SA(0, 1), cA + hstep, voffA);
        if (wr == 1) PG8_BAR;
        PG8_WAIT_V(4); PG8_BAR;
        PG8_STAGE(PG8_SB(1, 0), cB + kstep, voffB); PG8_STAGE(PG8_SA(1, 0), cA + kstep, voffA); PG8_STAGE(PG8_SB(1, 1), cB + hstep + kstep, voffB);
        PG8_WAIT_V(6); PG8_BAR;
    }
    for (;;) {
        const bool has_next = S.next(ui + 1, nxt);
        const char* nA = has_next ? (const char*)g.A + (size_t)nxt.pm * tstep : cA; const char* nB = has_next ? (const char*)g.Bt + (size_t)nxt.pn * tstep : cB;
        for (int t = 0; t < nt; t += 2) {
            const bool last = (t == nt - 2);
            const char* a1 = cA + (size_t)(t + 1) * kstep;
            const char* a2 = last ? nA : cA + (size_t)(t + 2) * kstep; const char* b2 = last ? nB : cB + (size_t)(t + 2) * kstep;
            const char* a3 = a2 + kstep; const char* b3 = b2 + kstep;
            if (last && has_next) S.a_ready(nxt);
            if constexpr (SP2) {
            PG8_LDB(B0, 0, 0); PG8_LDB(B1, 0, 1); PG8_SCHED; PG8_LDA(At, 0, 0); PG8_STAGE(PG8_SA(1, 1), a1 + hstep, voffA);
            PG8_WAIT_V(8); PG8_WAIT_L(0); PG8_BAR; PG8_MMA(0, 0, At, B0); PG8_MMA(0, 1, At, B1); PG8_BAR; PG8_SCHED;
            PG8_LDA(At, 0, 1); PG8_STAGE(PG8_SB(0, 0), b2, voffB); PG8_STAGE(PG8_SB(0, 1), b2 + hstep, voffB); PG8_STAGE(PG8_SA(0, 0), a2, voffA);
            PG8_WAIT_V(8); PG8_WAIT_L(0); PG8_BAR; PG8_MMA(1, 0, At, B0); PG8_MMA(1, 1, At, B1); PG8_BAR; PG8_SCHED;
            PG8_LDB(B0, 1, 0); PG8_LDB(B1, 1, 1); PG8_SCHED; PG8_LDA(At, 1, 0); PG8_STAGE(PG8_SA(0, 1), a2 + hstep, voffA);
            PG8_WAIT_V(8); PG8_WAIT_L(0); PG8_BAR; PG8_MMA(0, 0, At, B0); PG8_MMA(0, 1, At, B1); PG8_BAR; PG8_SCHED;
            PG8_LDA(At, 1, 1); PG8_STAGE(PG8_SB(1, 0), b3, voffB); PG8_STAGE(PG8_SB(1, 1), b3 + hstep, voffB); PG8_STAGE(PG8_SA(1, 0), a3, voffA);
            PG8_WAIT_V(8); PG8_WAIT_L(0); PG8_BAR; PG8_MMA(1, 0, At, B0); PG8_MMA(1, 1, At, B1); PG8_BAR; PG8_SCHED;
            } else {
            PG8_LDB(B0, 0, 0); PG8_SCHED; PG8_LDA(At, 0, 0); PG8_STAGE(PG8_SA(1, 1), a1 + hstep, voffA);
            PG8_WAIT_L(8); PG8_BAR; PG8_WAIT_L(0); PG8_MMA(0, 0, At, B0); PG8_BAR; PG8_SCHED;
            PG8_LDB(B1, 0, 1); PG8_STAGE(PG8_SB(0, 0), b2, voffB);
            PG8_BAR; PG8_WAIT_L(0); PG8_MMA(0, 1, At, B1); PG8_BAR;
            PG8_LDA(At, 0, 1); PG8_STAGE(PG8_SA(0, 0), a2, voffA);
            PG8_BAR; PG8_WAIT_L(0); PG8_MMA(1, 0, At, B0); PG8_BAR; PG8_SCHED;
            PG8_STAGE(PG8_SB(0, 1), b2 + hstep, voffB);
            PG8_WAIT_V(6); PG8_BAR; PG8_MMA(1, 1, At, B1); PG8_BAR;
            PG8_LDB(B0, 1, 0); PG8_SCHED; PG8_LDA(At, 1, 0); PG8_STAGE(PG8_SA(0, 1), a2 + hstep, voffA);
            PG8_WAIT_L(8); PG8_BAR; PG8_WAIT_L(0); PG8_MMA(0, 0, At, B0); PG8_BAR; PG8_SCHED;
            PG8_LDB(B1, 1, 1); PG8_STAGE(PG8_SB(1, 0), b3, voffB);
            PG8_BAR; PG8_WAIT_L(0); PG8_MMA(0, 1, At, B1); PG8_BAR;
            PG8_LDA(At, 1, 1); PG8_STAGE(PG8_SA(1, 0), a3, voffA);
            PG8_BAR; PG8_WAIT_L(0); PG8_MMA(1, 0, At, B0); PG8_BAR; PG8_SCHED;
            PG8_STAGE(PG8_SB(1, 1), b3 + hstep, voffB);
            PG8_WAIT_V(6); PG8_BAR; PG8_MMA(1, 1, At, B1); PG8_BAR;
            }
        }
        if constexpr (ALIGN_EPI) { if (wr == 0) PG8_BAR; }
        if constexpr (!Epi::AFTER_DRAIN) { E(acc, cur, wr, wc, fr, fq); S.done(cur); }
        if (!has_next) break;
#pragma unroll
        for (int a = 0; a < 2; ++a)
#pragma unroll
            for (int b = 0; b < 2; ++b)
#pragma unroll
                for (int m = 0; m < 4; ++m)
#pragma unroll
                    for (int n = 0; n < 2; ++n) acc[a][b][m][n] = (f32x4){0.f, 0.f, 0.f, 0.f};
        cur = nxt; cA = nA; cB = nB; ++ui;
        if constexpr (ALIGN_EPI) { if (wr == 1) PG8_BAR; }
    }
    PG8_WAIT_V(0);
    if constexpr (!ALIGN_EPI) { if (wr == 0) PG8_BAR; }
    PG8_BAR;
    if constexpr (Epi::AFTER_DRAIN) { E.fused(acc, cur, wr, wc, fr, fq, lds, wid, lane); S.done(cur); }
#undef PG8_SA
#undef PG8_SB
#undef PG8_STAGE
#undef PG8_LDA
#undef PG8_LDB
#undef PG8_MMA
#undef PG8_WAIT_V
#undef PG8_WAIT_L
#undef PG8_BAR
#undef PG8_SCHED
}
}

constexpr int BATCH = 8, SEQ = 4096, DM = 1024, MTOK = BATCH * SEQ;
constexpr int NMEM = 256, MMEM = BATCH * NMEM;
constexpr int AW = 512, HD = 64, NH = 8, IH = 4, TOPK = 256;
constexpr int INC = 1988, INP = 2048;
constexpr int DFF = 2816;
constexpr float EPS = 1e-6f;
#define LAS __attribute__((address_space(3)))
typedef unsigned short bf16_t;
typedef float f32x4 __attribute__((ext_vector_type(4)));
typedef unsigned u32x4 __attribute__((ext_vector_type(4)));
typedef unsigned u32x2 __attribute__((ext_vector_type(2)));

__device__ __forceinline__ float bf2f(bf16_t v) { return __uint_as_float((unsigned)v << 16); }
__device__ __forceinline__ bf16_t f2bf(float f) { unsigned u = __float_as_uint(f); return (bf16_t)((u + 0x7fffu + ((u >> 16) & 1u)) >> 16); }
__device__ __forceinline__ float shx(float v, int lane, int o) { return __uint_as_float((unsigned)__builtin_amdgcn_ds_bpermute((lane ^ o) << 2, (int)__float_as_uint(v))); }
__device__ __forceinline__ float wave_sum_l(float v, int lane) {
#pragma unroll
    for (int o = 1; o < 64; o <<= 1) v += shx(v, lane, o);
    return v;
}
__device__ __forceinline__ float wave_sum(float v) {
#pragma unroll
    for (int o = 1; o < 64; o <<= 1) v += __shfl_xor(v, o);
    return v;
}
__device__ __forceinline__ float wave_max(float v) {
#pragma unroll
    for (int o = 1; o < 64; o <<= 1) v = fmaxf(v, __shfl_xor(v, o));
    return v;
}
__device__ __forceinline__ float silu_f(float v) { return v * __builtin_amdgcn_rcpf(1.f + __expf(-v)); }

struct EpiStore {
    static constexpr bool PERM = false, AFTER_DRAIN = false;
    float* outf; bf16_t* outb; const float* res; int ldc;
    __device__ __forceinline__ void operator()(const pg8::f32x4 (&acc)[2][2][4][2], const pg8::Unit& u, int wr, int wc, int fr, int fq) const {
        const int col0 = u.pn * 256 + wc * 32 + 4 * fq;
#pragma unroll
        for (int ai = 0; ai < 2; ++ai)
#pragma unroll
            for (int m = 0; m < 4; ++m) {
                const size_t row = (size_t)(u.pm * 256 + ai * 128 + wr * 64 + m * 16 + fr);
#pragma unroll
                for (int bj = 0; bj < 2; ++bj)
#pragma unroll
                    for (int n = 0; n < 2; ++n) {
                        const size_t off = row * ldc + col0 + bj * 128 + n * 16;
                        pg8::f32x4 v = acc[ai][bj][m][n];
                        if (res) { const pg8::f32x4 r = *(const pg8::f32x4*)(res + off); v = v + r; }
                        if (outf) *(pg8::f32x4*)(outf + off) = v;
                        if (outb) { u32x2 w; w.x = (unsigned)f2bf(v[0]) | ((unsigned)f2bf(v[1]) << 16); w.y = (unsigned)f2bf(v[2]) | ((unsigned)f2bf(v[3]) << 16); *(u32x2*)(outb + off) = w; }
                    }
            }
    }
};
#define XB_TMO      128
#define XB_XCNT(j)  (256  + 64 * (j))
#define XB_XSUB(j)  (1280 + 64 * (j))
#define XB_XGEN(j)  (2304 + 64 * (j))
#define XB_TOP      3328
#define XB_TOPGEN   3392
#define XCD_BAR_WORDS 3456
#define XB_SPIN_CAP (1u << 18)

__device__ __forceinline__ unsigned xb_ld(unsigned* p)              { return __hip_atomic_load(p, __ATOMIC_RELAXED, __HIP_MEMORY_SCOPE_AGENT); }
__device__ __forceinline__ unsigned xb_add(unsigned* p, unsigned v) { return __hip_atomic_fetch_add(p, v, __ATOMIC_RELAXED, __HIP_MEMORY_SCOPE_AGENT); }
__device__ __forceinline__ unsigned xb_xcc_id() { return (unsigned)__builtin_amdgcn_s_getreg((3 << 11) | 20) & 0xFu; }
#define XB_SPIN(cond, bar) do { unsigned _sp = 0; while (cond) { __builtin_amdgcn_s_sleep(1); \
    if ((++_sp & 255u) == 0u) { if (xb_ld(&(bar)[XB_TMO])) break; if (_sp > XB_SPIN_CAP) { atomicAdd(&(bar)[XB_TMO], 1u); break; } } } } while (0)

struct XcdBarrier {
    unsigned* bar; unsigned x;
    volatile LAS unsigned* st;
};

__device__ __forceinline__ XcdBarrier xcd_barrier_post(unsigned* bar, volatile LAS unsigned* st) {
    XcdBarrier b; b.bar = bar; b.x = xb_xcc_id(); b.st = st;
    if (threadIdx.x == 0) (void)xb_add(&bar[XB_XCNT(b.x)], 1u);
    return b;
}
__device__ __forceinline__ void xcd_barrier_complete(unsigned* bar, unsigned x, unsigned& nloc, unsigned& nx) {
    const unsigned G = gridDim.x * gridDim.y * gridDim.z;
    unsigned sum, cnt, mine, sp = 0u;
    for (;;) {
        sum = 0u; cnt = 0u; mine = 0u;
#pragma unroll
        for (unsigned j = 0; j < 16; ++j) { const unsigned c = xb_ld(&bar[XB_XCNT(j)]); sum += c; cnt += (c > 0u) ? 1u : 0u; mine = (j == x) ? c : mine; }
        if (sum == G) break;
        __builtin_amdgcn_s_sleep(1);
        if ((++sp & 255u) == 0u) { if (xb_ld(&bar[XB_TMO])) break; if (sp > XB_SPIN_CAP) { atomicAdd(&bar[XB_TMO], 1u); break; } }
    }
    nloc = mine > 0u ? mine : 1u; nx = cnt > 0u ? cnt : 1u;
}

__device__ __forceinline__ void xcd_barrier(const XcdBarrier& b) {
    asm volatile("s_waitcnt vmcnt(0)" ::: "memory");
    __syncthreads();
    if (threadIdx.x == 0) {
        unsigned* bar = b.bar;
        __builtin_amdgcn_s_waitcnt(0);
        unsigned nloc = b.st[0], nx = b.st[1];
        if (nloc == 0u) { xcd_barrier_complete(bar, b.x, nloc, nx); b.st[0] = nloc; b.st[1] = nx; }
        const unsigned old = xb_add(&bar[XB_XSUB(b.x)], 1u);
        const unsigned gen = old / nloc;
        if (old + 1u == (gen + 1u) * nloc) {
            __builtin_amdgcn_fence(__ATOMIC_RELEASE, "agent");
            asm volatile("s_waitcnt vmcnt(0)" ::: "memory");
            const unsigned og = xb_add(&bar[XB_TOP], 1u);
            const unsigned tg = og / nx;
            if (og + 1u == (tg + 1u) * nx) xb_add(&bar[XB_TOPGEN], 1u);
            else XB_SPIN(xb_ld(&bar[XB_TOPGEN]) == tg, bar);
            __builtin_amdgcn_fence(__ATOMIC_ACQUIRE, "agent");
            xb_add(&bar[XB_XGEN(b.x)], 1u);
            asm volatile("s_waitcnt vmcnt(0)" ::: "memory");
        } else {
            XB_SPIN(xb_ld(&bar[XB_XGEN(b.x)]) == gen, bar);
            __builtin_amdgcn_fence(__ATOMIC_ACQUIRE, "agent");
            asm volatile("s_waitcnt vmcnt(0)" ::: "memory");
        }
    }
    __syncthreads();
}

__device__ __forceinline__ u32x4 pack8(const pg8::f32x4 a, const pg8::f32x4 b) {
    u32x4 w; w.x = pg8::cvt_pk_bf16(a[0], a[1]); w.y = pg8::cvt_pk_bf16(a[2], a[3]); w.z = pg8::cvt_pk_bf16(b[0], b[1]); w.w = pg8::cvt_pk_bf16(b[2], b[3]); return w;
}
__device__ __forceinline__ u32x2 pack8_fp8(const pg8::f32x4 a, const pg8::f32x4 b) {
    int lo = __builtin_amdgcn_cvt_pk_fp8_f32(a[0], a[1], 0, false); lo = __builtin_amdgcn_cvt_pk_fp8_f32(a[2], a[3], lo, true);
    int hi = __builtin_amdgcn_cvt_pk_fp8_f32(b[0], b[1], 0, false); hi = __builtin_amdgcn_cvt_pk_fp8_f32(b[2], b[3], hi, true);
    return (u32x2){(unsigned)lo, (unsigned)hi};
}
__device__ __forceinline__ float sigmoid_f(float v) { return __builtin_amdgcn_rcpf(1.f + __expf(-v)); }
__host__ __device__ __forceinline__ int dperm(int pos) { return pos < 16 ? (4 * (pos >> 3) + (pos & 3) + 8 * ((pos >> 2) & 1)) : pos; }
__host__ __device__ __forceinline__ int in_orig_col(int n) {
    if (n < 512) return (n & ~63) + dperm(n & 63);
    if (n < 576) return 512 + dperm(n - 512);
    if (n < 640) return 576 + (n - 576);
    if (n < 704) return 896 + dperm(n - 640);
    if (n < 708) return 960 + (n - 704);
    if (n < 768) return -1;
    if (n < 1024) return 640 + ((n - 768) & ~63) + dperm((n - 768) & 63);
    const int i = (n - 1024) >> 8, c = (n - 1024) & 255;
    return c < 128 ? 964 + 128 * i + c : 1476 + 128 * i + (c - 128);
}
struct EpiIn {
    static constexpr bool PERM = true, AFTER_DRAIN = false;
    const float* cs; bf16_t *Q, *K, *V, *QI, *KI, *U; float* WI;
    __device__ __forceinline__ void operator()(const pg8::f32x4 (&acc)[2][2][4][2], const pg8::Unit& u, int wr, int wc, int fr, int fq) const {
        const int pn = u.pn;
        if (pn >= 4) {
            const int ch = 128 * (pn - 4) + 32 * wc + 8 * fq;
#pragma unroll
            for (int ai = 0; ai < 2; ++ai)
#pragma unroll
                for (int m = 0; m < 4; ++m) { const size_t row = (size_t)(u.pm * 256 + ai * 128 + wr * 64 + m * 16 + fr);
                    pg8::f32x4 a0 = acc[ai][0][m][0], a1 = acc[ai][0][m][1]; const pg8::f32x4 g0 = acc[ai][1][m][0], g1 = acc[ai][1][m][1];
#pragma unroll
                    for (int k = 0; k < 4; ++k) { a0[k] *= sigmoid_f(g0[k]); a1[k] *= sigmoid_f(g1[k]); }
                    *(u32x4*)(U + row * 512 + ch) = pack8(a0, a1); }
            return;
        }
        const bool rot = (pn == 2) ? (wc == 0 && fq < 2) : ((wc & 1) == 0 && fq < 2);
#pragma unroll
        for (int ai = 0; ai < 2; ++ai)
#pragma unroll
            for (int m = 0; m < 4; ++m) { const size_t row = (size_t)(u.pm * 256 + ai * 128 + wr * 64 + m * 16 + fr);
                pg8::f32x4 cv = {1.f, 1.f, 1.f, 1.f}, sv = {0.f, 0.f, 0.f, 0.f};
                if (rot) { cv = *(const pg8::f32x4*)(cs + row * 16 + 4 * fq); sv = *(const pg8::f32x4*)(cs + row * 16 + 8 + 4 * fq); }
#pragma unroll
                for (int bj = 0; bj < 2; ++bj) {
                    const pg8::f32x4 v0 = acc[ai][bj][m][0], v1 = acc[ai][bj][m][1];
                    pg8::f32x4 n0 = v0 * cv - v1 * sv, n1 = v1 * cv + v0 * sv;
                    if (!rot) { n0 = v0; n1 = v1; }
                    const int c = 128 * bj + 32 * wc + 8 * fq;
                    if (pn < 2) *(u32x4*)(Q + row * 512 + 256 * pn + c) = pack8(n0, n1);
                    else if (pn == 3) *(u32x4*)(QI + row * 256 + c) = pack8(n0 * 0.125f, n1 * 0.125f);
                    else {
                        if (bj == 0) {
                            if (wc < 2) *(u32x2*)((unsigned char*)K + row * 64 + 16 * fq + 8 * wc) = pack8_fp8(n0, n1); else *(u32x2*)((unsigned char*)V + row * 64 + 32 * (wc - 2) + 8 * fq) = pack8_fp8(v0, v1); }
                        else { if (wc < 2) *(u32x4*)(KI + row * 64 + 32 * wc + 8 * fq) = pack8(n0, n1); else if (wc == 2 && fq == 0) *(pg8::f32x4*)(WI + row * 4) = v0 * 0.5f; }
                    }
                }
            }
    }
};
struct EpiRes {
    static constexpr bool PERM = true, AFTER_DRAIN = false;
    const float* resf; const bf16_t* resb; float* outf; bf16_t* xb; float* ss;
    __device__ __forceinline__ void operator()(const pg8::f32x4 (&acc)[2][2][4][2], const pg8::Unit& u, int wr, int wc, int fr, int fq) const {
#pragma unroll
        for (int ai = 0; ai < 2; ++ai)
#pragma unroll
            for (int m = 0; m < 4; ++m) { const size_t row = (size_t)(u.pm * 256 + ai * 128 + wr * 64 + m * 16 + fr); float q = 0.f;
#pragma unroll
                for (int bj = 0; bj < 2; ++bj) { const size_t off = row * DM + u.pn * 256 + 128 * bj + 32 * wc + 8 * fq;
                    pg8::f32x4 r0, r1;
                    if (resf) { r0 = *(const pg8::f32x4*)(resf + off); r1 = *(const pg8::f32x4*)(resf + off + 4); }
                    else { const u32x4 rb = *(const u32x4*)(resb + off);
                        r0 = (pg8::f32x4){__uint_as_float(rb.x << 16), __uint_as_float(rb.x & 0xffff0000u), __uint_as_float(rb.y << 16), __uint_as_float(rb.y & 0xffff0000u)};
                        r1 = (pg8::f32x4){__uint_as_float(rb.z << 16), __uint_as_float(rb.z & 0xffff0000u), __uint_as_float(rb.w << 16), __uint_as_float(rb.w & 0xffff0000u)}; }
                    const pg8::f32x4 v0 = acc[ai][bj][m][0] + r0, v1 = acc[ai][bj][m][1] + r1;
                    if (outf) { *(pg8::f32x4*)(outf + off) = v0; *(pg8::f32x4*)(outf + off + 4) = v1; }
                    if (xb) *(u32x4*)(xb + off) = pack8(v0, v1);
                    q += (v0[0] * v0[0] + v0[1] * v0[1]) + (v0[2] * v0[2] + v0[3] * v0[3]) + (v1[0] * v1[0] + v1[1] * v1[1]) + (v1[2] * v1[2] + v1[3] * v1[3]); }
                { const int lane_ = fq * 16 + fr; q += shx(q, lane_, 16); q += shx(q, lane_, 32); }
                if (fq == 0) ss[row * 16 + u.pn * 4 + wc] = q; }
    }
};
__device__ __forceinline__ float rstd_from_ss(const float* ss, size_t row) {
    const pg8::f32x4 a = *(const pg8::f32x4*)(ss + row * 16), b = *(const pg8::f32x4*)(ss + row * 16 + 4), c = *(const pg8::f32x4*)(ss + row * 16 + 8), d = *(const pg8::f32x4*)(ss + row * 16 + 12);
    const float s = ((a[0] + a[1]) + (a[2] + a[3])) + ((b[0] + b[1]) + (b[2] + b[3])) + ((c[0] + c[1]) + (c[2] + c[3])) + ((d[0] + d[1]) + (d[2] + d[3]));
    return __builtin_amdgcn_rsqf(s * (1.f / DM) + EPS);
}
struct EpiScale {
    static constexpr bool PERM = true, AFTER_DRAIN = false;
    const float* ss; bf16_t* O; int ldc; float scale;
    __device__ __forceinline__ void operator()(const pg8::f32x4 (&acc)[2][2][4][2], const pg8::Unit& u, int wr, int wc, int fr, int fq) const {
#pragma unroll
        for (int ai = 0; ai < 2; ++ai)
#pragma unroll
            for (int m = 0; m < 4; ++m) { const size_t row = (size_t)(u.pm * 256 + ai * 128 + wr * 64 + m * 16 + fr); const float r = rstd_from_ss(ss, row) * scale;
#pragma unroll
                for (int bj = 0; bj < 2; ++bj) *(u32x4*)(O + row * ldc + u.pn * 256 + 128 * bj + 32 * wc + 8 * fq) = pack8(acc[ai][bj][m][0] * r, acc[ai][bj][m][1] * r); }
    }
};
struct EpiGateUp {
    static constexpr bool PERM = true, AFTER_DRAIN = false;
    const float* ss; bf16_t* Gb; bf16_t* Ub;
    __device__ __forceinline__ void operator()(const pg8::f32x4 (&acc)[2][2][4][2], const pg8::Unit& u, int wr, int wc, int fr, int fq) const {
        const int ch = 128 * u.pn + 32 * wc + 8 * fq;
#pragma unroll
        for (int ai = 0; ai < 2; ++ai)
#pragma unroll
            for (int m = 0; m < 4; ++m) { const size_t row = (size_t)(u.pm * 256 + ai * 128 + wr * 64 + m * 16 + fr); const float r = rstd_from_ss(ss, row);
                *(u32x4*)(Gb + row * DFF + ch) = pack8(acc[ai][0][m][0] * r, acc[ai][0][m][1] * r);
                *(u32x4*)(Ub + row * DFF + ch) = pack8(acc[ai][1][m][0] * r, acc[ai][1][m][1] * r); }
    }
};
struct EpiGateUpAct {
    static constexpr bool PERM = true, AFTER_DRAIN = false;
    const float* ss; bf16_t* H; const float* cw; const float* cb; float* topg; float* topu; float* botg; LAS unsigned char* xch;
    __device__ __forceinline__ void operator()(const pg8::f32x4 (&acc)[2][2][4][2], const pg8::Unit& u, int wr, int wc, int fr, int fq) const {
        const int lane = fq * 16 + fr, chl = 32 * wc + 8 * fq, ch = 128 * u.pn + chl;
        const int l1 = (fq * 16 + ((fr + 15) & 15)) << 2, l2 = (fq * 16 + ((fr + 14) & 15)) << 2;
        (void)lane;
#pragma unroll
        for (int ai = 0; ai < 2; ++ai) { const size_t row = (size_t)(u.pm * 256 + ai * 128 + wr * 64 + 48 + fr); const float r = rstd_from_ss(ss, row);
            if (fr >= 14) { LAS float* p = (LAS float*)xch + ((2 * ai + wr) * 2 + (fr - 14)) * 128 + chl;
                *(LAS pg8::f32x4*)p = acc[ai][0][3][0] * r; *(LAS pg8::f32x4*)(p + 4) = acc[ai][0][3][1] * r; } }
        asm volatile("s_waitcnt lgkmcnt(0)" ::: "memory"); __builtin_amdgcn_s_barrier(); asm volatile("" ::: "memory");
        pg8::f32x4 wb[2], w2[2], w1[2], w0[2];
#pragma unroll
        for (int hq = 0; hq < 2; ++hq) { wb[hq] = *(const pg8::f32x4*)(cb + ch + 4 * hq); w2[hq] = *(const pg8::f32x4*)(cw + 2 * DFF + ch + 4 * hq); w1[hq] = *(const pg8::f32x4*)(cw + DFF + ch + 4 * hq); w0[hq] = *(const pg8::f32x4*)(cw + ch + 4 * hq); }
#pragma unroll
        for (int ai = 0; ai < 2; ++ai) {
            const int blk = 2 * ai + wr;
            pg8::f32x4 pv[2] = {{0.f, 0.f, 0.f, 0.f}, {0.f, 0.f, 0.f, 0.f}};
            if (blk > 0 && fr >= 14) { const LAS float* p = (const LAS float*)xch + ((blk - 1) * 2 + (fr - 14)) * 128 + chl; pv[0] = *(const LAS pg8::f32x4*)p; pv[1] = *(const LAS pg8::f32x4*)(p + 4); }
#pragma unroll
            for (int m = 0; m < 4; ++m) { const size_t row = (size_t)(u.pm * 256 + ai * 128 + wr * 64 + m * 16 + fr); const float r = rstd_from_ss(ss, row);
                pg8::f32x4 g[2], uu[2], hh[2];
#pragma unroll
                for (int hq = 0; hq < 2; ++hq) { g[hq] = acc[ai][0][m][hq] * r; uu[hq] = acc[ai][1][m][hq] * r; }
#pragma unroll
                for (int hq = 0; hq < 2; ++hq)
#pragma unroll
                    for (int k = 0; k < 4; ++k) {
                        const float x1 = (fr == 15) ? pv[hq][k] : g[hq][k], x2 = (fr >= 14) ? pv[hq][k] : g[hq][k];
                        const float p1 = __uint_as_float((unsigned)__builtin_amdgcn_ds_bpermute(l1, (int)__float_as_uint(x1)));
                        const float p2 = __uint_as_float((unsigned)__builtin_amdgcn_ds_bpermute(l2, (int)__float_as_uint(x2)));
                        const float gg = wb[hq][k] + w2[hq][k] * g[hq][k] + w1[hq][k] * p1 + w0[hq][k] * p2;
                        hh[hq][k] = gg * __builtin_amdgcn_rcpf(1.f + __expf(-gg)) * uu[hq][k]; }
                *(u32x4*)(H + row * DFF + ch) = pack8(hh[0], hh[1]);
                if (blk == 0 && m == 0 && fr < 2) { float* tg = topg + ((size_t)u.pm * 2 + fr) * DFF + ch; float* tu = topu + ((size_t)u.pm * 2 + fr) * DFF + ch;
                    *(pg8::f32x4*)tg = g[0]; *(pg8::f32x4*)(tg + 4) = g[1]; *(pg8::f32x4*)tu = uu[0]; *(pg8::f32x4*)(tu + 4) = uu[1]; }
                if (blk == 3 && m == 3 && fr >= 14) { float* bg = botg + ((size_t)u.pm * 2 + (fr - 14)) * DFF + ch; *(pg8::f32x4*)bg = g[0]; *(pg8::f32x4*)(bg + 4) = g[1]; }
                pv[0] = g[0]; pv[1] = g[1];
            }
        }
    }
};
typedef short bf16x8v __attribute__((ext_vector_type(8)));
constexpr int CA_STRIDE = 528;
__device__ __forceinline__ void cross_attn_unit(LAS unsigned char* lds, int b, int h, int qb, const bf16_t* QC, const bf16_t* KC, const bf16_t* VT, bf16_t* OC, int tid, int lane, int wave) {
    const int q16 = lane & 15, g = lane >> 4;
    const size_t row0 = (size_t)b * SEQ + (size_t)qb * 256 + wave * 32;
    asm volatile("" : "+v"(tid));
    { const bf16_t* src = KC + ((size_t)b * NMEM + (tid >> 5)) * DM + h * 256 + (tid & 31) * 8; LAS unsigned char* dst = lds + (tid >> 5) * CA_STRIDE + (tid & 31) * 16;
#pragma unroll
      for (int i = 0; i < 16; ++i) { const u32x4 v = *(const u32x4*)(src + (size_t)i * 16 * DM); *(LAS u32x4*)(dst + i * 16 * CA_STRIDE) = v; } }
    __syncthreads();
    f32x4 S[2][16];
#pragma unroll
    for (int st = 0; st < 2; ++st)
#pragma unroll
        for (int kt = 0; kt < 16; ++kt) S[st][kt] = (f32x4){0.f, 0.f, 0.f, 0.f};
#pragma unroll 1
    for (int kh = 0; kh < 2; ++kh) {
        bf16x8v qf[2][4];
#pragma unroll
        for (int st = 0; st < 2; ++st)
#pragma unroll
            for (int ks = 0; ks < 4; ++ks) qf[st][ks] = *(const bf16x8v*)(QC + (row0 + st * 16 + q16) * DM + h * 256 + kh * 128 + ks * 32 + g * 8);
        const LAS unsigned char* kb = lds + q16 * CA_STRIDE + kh * 256 + g * 16;
#pragma unroll
        for (int kt = 0; kt < 16; ++kt)
#pragma unroll
            for (int ks = 0; ks < 4; ++ks) { const bf16x8v a = *(const LAS bf16x8v*)(kb + kt * 16 * CA_STRIDE + ks * 64);
                S[0][kt] = __builtin_amdgcn_mfma_f32_16x16x32_bf16(a, qf[0][ks], S[0][kt], 0, 0, 0);
                S[1][kt] = __builtin_amdgcn_mfma_f32_16x16x32_bf16(a, qf[1][ks], S[1][kt], 0, 0, 0); }
    }
    const float c2 = 0.0625f * 1.4426950408889634f;
    float linv[2]; bf16x8v P[2][8];
#pragma unroll
    for (int st = 0; st < 2; ++st) {
        float m = -INFINITY;
#pragma unroll
        for (int kt = 0; kt < 16; ++kt) m = fmaxf(fmaxf(fmaxf(S[st][kt][0], S[st][kt][1]), fmaxf(S[st][kt][2], S[st][kt][3])), m);
        m = fmaxf(m, shx(m, lane, 16)); m = fmaxf(m, shx(m, lane, 32));
        const float mc = m * c2; float l = 0.f;
#pragma unroll
        for (int kt = 0; kt < 16; ++kt)
#pragma unroll
            for (int r = 0; r < 4; ++r) { const float p = __builtin_amdgcn_exp2f(S[st][kt][r] * c2 - mc); S[st][kt][r] = p; l += p; }
        l += shx(l, lane, 16); l += shx(l, lane, 32); linv[st] = 1.f / l;
#pragma unroll
        for (int c = 0; c < 8; ++c) { bf16x8v pk;
#pragma unroll
            for (int j = 0; j < 4; ++j) { pk[j] = (short)f2bf(S[st][2 * c][j]); pk[4 + j] = (short)f2bf(S[st][2 * c + 1][j]); }
            P[st][c] = pk; }
    }
    __syncthreads();
    { int tid2 = tid; asm volatile("" : "+v"(tid2));
      const bf16_t* src = VT + (size_t)(h * 256 + (tid2 >> 5)) * MMEM + b * NMEM + (tid2 & 31) * 8; LAS unsigned char* dst = lds + (tid2 >> 5) * CA_STRIDE + (tid2 & 31) * 16;
#pragma unroll
      for (int i = 0; i < 16; ++i) { const u32x4 v = *(const u32x4*)(src + (size_t)i * 16 * MMEM); *(LAS u32x4*)(dst + i * 16 * CA_STRIDE) = v; } }
    __syncthreads();
#pragma unroll 1
    for (int dh = 0; dh < 2; ++dh) {
        f32x4 O[2][8];
#pragma unroll
        for (int st = 0; st < 2; ++st)
#pragma unroll
            for (int dt = 0; dt < 8; ++dt) O[st][dt] = (f32x4){0.f, 0.f, 0.f, 0.f};
        const LAS unsigned char* pb = lds + (dh * 128 + q16) * CA_STRIDE + g * 8;
#pragma unroll
        for (int dt = 0; dt < 8; ++dt)
#pragma unroll
            for (int c = 0; c < 8; ++c) { const LAS unsigned char* p = pb + dt * 16 * CA_STRIDE + c * 64;
                const u32x2 lo = *(const LAS u32x2*)p, hi = *(const LAS u32x2*)(p + 32);
                const u32x4 av = (u32x4){lo.x, lo.y, hi.x, hi.y}; const bf16x8v a = __builtin_bit_cast(bf16x8v, av);
                O[0][dt] = __builtin_amdgcn_mfma_f32_16x16x32_bf16(a, P[0][c], O[0][dt], 0, 0, 0);
                O[1][dt] = __builtin_amdgcn_mfma_f32_16x16x32_bf16(a, P[1][c], O[1][dt], 0, 0, 0); }
#pragma unroll
        for (int st = 0; st < 2; ++st)
#pragma unroll
            for (int dt = 0; dt < 8; ++dt) { const f32x4 o = O[st][dt] * linv[st]; u32x2 w;
                w.x = (unsigned)f2bf(o[0]) | ((unsigned)f2bf(o[1]) << 16); w.y = (unsigned)f2bf(o[2]) | ((unsigned)f2bf(o[3]) << 16);
                *(u32x2*)(OC + (row0 + st * 16 + q16) * DM + h * 256 + dh * 128 + dt * 16 + g * 4) = w; }
    }
    __syncthreads();
}
typedef float f32x16v __attribute__((ext_vector_type(16)));
constexpr int TK_HIST_OFF = 131072;
__device__ __forceinline__ unsigned code16(float s) {
    const _Float16 hf = (_Float16)s; unsigned u = (unsigned)__builtin_bit_cast(unsigned short, hf);
    if ((u & 0x7fffu) == 0u) u = 0u;
    return (u & 0x8000u) ? (~u & 0xffffu) : (u | 0x8000u);
}
__device__ __forceinline__ unsigned mbcnt64(unsigned long long m) { return __builtin_amdgcn_mbcnt_hi((unsigned)(m >> 32), __builtin_amdgcn_mbcnt_lo((unsigned)m, 0u)); }
__device__ __forceinline__ void lds_hist_add(LAS unsigned char* hrow, unsigned bin) {
    __hip_atomic_fetch_add((LAS unsigned*)(hrow + ((bin & 127u) << 2)), (bin & 128u) ? 0x10000u : 1u, __ATOMIC_RELAXED, __HIP_MEMORY_SCOPE_WORKGROUP);
}
__device__ __forceinline__ void hist_select(const LAS unsigned char* hrow, unsigned target, int lane, unsigned& B, unsigned& above) {
    const u32x4 hv = *(const LAS u32x4*)(hrow + (lane & 31) * 16);
    const unsigned sh = (lane & 32) ? 16u : 0u;
    const unsigned h0 = (hv.x >> sh) & 0xffffu, h1 = (hv.y >> sh) & 0xffffu, h2 = (hv.z >> sh) & 0xffffu, h3 = (hv.w >> sh) & 0xffffu;
    const unsigned s = (h0 + h1) + (h2 + h3); unsigned S = s;
#pragma unroll
    for (int o = 1; o < 64; o <<= 1) { const unsigned v = (unsigned)__builtin_amdgcn_ds_bpermute(((lane + o) & 63) << 2, (int)S); if (lane + o < 64) S += v; }
    const unsigned long long mk = __ballot(S >= target);
    const int lb = 63 - __builtin_clzll(mk);
    const unsigned A = S - s, c3 = A + h3, c2 = c3 + h2, c1 = c2 + h1;
    const unsigned bsel = (c3 >= target) ? 3u : (c2 >= target) ? 2u : (c1 >= target) ? 1u : 0u;
    const unsigned asel = (c3 >= target) ? A : (c2 >= target) ? c3 : (c1 >= target) ? c2 : c1;
    B = 4u * (unsigned)lb + (unsigned)__builtin_amdgcn_readlane((int)bsel, lb);
    above = (unsigned)__builtin_amdgcn_readlane((int)asel, lb);
}
__device__ __forceinline__ void topk_unit(LAS unsigned char* lds, int b, int j, const bf16_t* QI, const bf16_t* KI, const float* WI, unsigned short* SEL, int tid, int lane, int wave) {
    asm volatile("" : "+v"(tid), "+v"(lane));
    const int t0 = 16 * j, L = t0 + 16, nkt = (L + 31) >> 5;
    const size_t rowbase = (size_t)b * SEQ + t0;
    const int c32 = lane & 31, hi = lane >> 5;
    *(LAS u32x4*)(lds + TK_HIST_OFF + tid * 16) = (u32x4){0u, 0u, 0u, 0u};
    __syncthreads();
    {
        bf16x8v qa[2][4]; f32x4 wq[2][4];
#pragma unroll
        for (int rt = 0; rt < 2; ++rt) {
#pragma unroll
            for (int ks = 0; ks < 4; ++ks) qa[rt][ks] = *(const bf16x8v*)(QI + (rowbase + 8 * rt + (c32 >> 2)) * 256 + (c32 & 3) * 64 + 16 * ks + 8 * hi);
#pragma unroll
            for (int gq = 0; gq < 4; ++gq) wq[rt][gq] = *(const f32x4*)(WI + (rowbase + 8 * rt + 2 * gq + hi) * 4);
        }
        const bf16_t* kbase = KI + ((size_t)b * SEQ + c32) * 64 + 8 * hi;
        bf16x8v kb[4], kn[4];
        int kt = wave;
        if (kt < nkt) {
#pragma unroll
            for (int ks = 0; ks < 4; ++ks) kb[ks] = *(const bf16x8v*)(kbase + (size_t)kt * 32 * 64 + 16 * ks);
        }
        for (; kt < nkt; kt += 8) {
            const int ktn = (kt + 8 < nkt) ? kt + 8 : kt;
#pragma unroll
            for (int ks = 0; ks < 4; ++ks) kn[ks] = *(const bf16x8v*)(kbase + (size_t)ktn * 32 * 64 + 16 * ks);
            const int key = kt * 32 + c32;
#pragma unroll
            for (int rt = 0; rt < 2; ++rt) {
                f32x16v c = {0.f, 0.f, 0.f, 0.f, 0.f, 0.f, 0.f, 0.f, 0.f, 0.f, 0.f, 0.f, 0.f, 0.f, 0.f, 0.f};
#pragma unroll
                for (int ks = 0; ks < 4; ++ks) c = __builtin_amdgcn_mfma_f32_32x32x16_bf16(qa[rt][ks], kb[ks], c, 0, 0, 0);
#pragma unroll
                for (int gq = 0; gq < 4; ++gq) {
                    const f32x4 w = wq[rt][gq];
                    const float sc = w[0] * fmaxf(c[4 * gq + 0], 0.f) + w[1] * fmaxf(c[4 * gq + 1], 0.f) + w[2] * fmaxf(c[4 * gq + 2], 0.f) + w[3] * fmaxf(c[4 * gq + 3], 0.f);
                    const int q = 8 * rt + 2 * gq + hi; const unsigned code = code16(sc);
                    *(LAS unsigned short*)(lds + q * 8192 + key * 2) = (unsigned short)code;
                    if (key <= t0 + q) lds_hist_add(lds + TK_HIST_OFF + q * 512, code >> 8);
                }
            }
#pragma unroll
            for (int ks = 0; ks < 4; ++ks) kb[ks] = kn[ks];
        }
    }
    __syncthreads();
#pragma unroll 1
    for (int qq = 0; qq < 2; ++qq) {
        const int q = 2 * wave + qq, t = t0 + q, n = t + 1;
        unsigned short* sel = SEL + (rowbase + q) * TOPK;
        if (n <= TOPK) {
#pragma unroll
            for (int i = 0; i < 4; ++i) { const int s = lane + 64 * i; if (s < n) sel[s] = (unsigned short)s; }
            continue;
        }
        const int nch = (n + 127) >> 7;
        LAS unsigned char* hrow = lds + TK_HIST_OFF + q * 512;
        const LAS unsigned* row = (const LAS unsigned*)(lds + q * 8192) + lane;
        unsigned B, above;
        hist_select(hrow, (unsigned)TOPK, lane, B, above);
        *(LAS u32x2*)(hrow + lane * 8) = (u32x2){0u, 0u};
        asm volatile("s_waitcnt lgkmcnt(0)" ::: "memory");
#pragma unroll 4
        for (int c = 0; c < nch; ++c) { const unsigned v = row[64 * c]; const int i0 = 128 * c + 2 * lane;
            const unsigned lo = v & 0xffffu, hi16 = v >> 16;
            if (i0 <= t && (lo >> 8) == B) lds_hist_add(hrow, lo & 255u);
            if (i0 + 1 <= t && (hi16 >> 8) == B) lds_hist_add(hrow, hi16 & 255u); }
        asm volatile("s_waitcnt lgkmcnt(0)" ::: "memory");
        unsigned b2, above2;
        hist_select(hrow, (unsigned)TOPK - above, lane, b2, above2);
        const unsigned T = (B << 8) | b2, cgt = above + above2, need = (unsigned)TOPK - cgt;
        unsigned eqrun = 0u, selrun = 0u;
#pragma unroll 2
        for (int c = 0; c < nch; ++c) { const unsigned v = row[64 * c]; const int i0 = 128 * c + 2 * lane;
            const unsigned lo = (i0 <= t) ? (v & 0xffffu) : 0u, hi16 = (i0 + 1 <= t) ? (v >> 16) : 0u;
            const bool glo = lo > T, ghi = hi16 > T;
            const unsigned long long mglo = __ballot(glo), mghi = __ballot(ghi);
            const unsigned plo = selrun + mbcnt64(mglo), phi = selrun + (unsigned)__popcll(mglo) + mbcnt64(mghi);
            if (glo) sel[plo] = (unsigned short)i0;
            if (ghi) sel[phi] = (unsigned short)(i0 + 1);
            selrun += (unsigned)__popcll(mglo) + (unsigned)__popcll(mghi);
            const bool elo = lo == T, ehi = hi16 == T;
            const unsigned long long melo = __ballot(elo), mehi = __ballot(ehi);
            if ((melo | mehi) != 0ull) {
                const unsigned rlo = eqrun + mbcnt64(melo) + mbcnt64(mehi), rhi = rlo + (elo ? 1u : 0u);
                if (elo && rlo < need) sel[cgt + rlo] = (unsigned short)i0;
                if (ehi && rhi < need) sel[cgt + rhi] = (unsigned short)(i0 + 1);
                eqrun += (unsigned)__popcll(melo) + (unsigned)__popcll(mehi);
            }
        }
    }
    __syncthreads();
}
__device__ __forceinline__ void topk_phase(LAS unsigned char* lds, int G, int vcu, const bf16_t* QI, const bf16_t* KI, const float* WI, unsigned short* SEL, int tid, int lane, int wave) {
    if (G == 256) {
        const int b = vcu >> 5, i = vcu & 31;
#pragma unroll 1
        for (int k = 0; k < 8; ++k) { const int j = 64 * (k >> 1) + ((k & 1) ? 63 - i : i); topk_unit(lds, b, j, QI, KI, WI, SEL, tid, lane, wave); }
    } else {
#pragma unroll 1
        for (int u = vcu; u < BATCH * 256; u += G) topk_unit(lds, u >> 8, u & 255, QI, KI, WI, SEL, tid, lane, wave);
    }
}
typedef short v4i16_t __attribute__((ext_vector_type(4)));
constexpr int SV_STRIDE = 160, SV_TILE_BYTES = 64 * SV_STRIDE, SV_WAVE_BYTES = SV_TILE_BYTES + 1024;
__device__ __forceinline__ v4i16_t tr_read16(const LAS unsigned char* p) { return __builtin_amdgcn_ds_read_tr16_b64_v4i16((LAS v4i16_t*)p); }
#define SP_FENCE() asm volatile("" ::: "memory")
typedef __bf16 bf16x2_t __attribute__((ext_vector_type(2)));
__device__ __forceinline__ bf16x8v fp8x8_to_bf16(unsigned a, unsigned b) {
    u32x4 r; r.x = __builtin_bit_cast(unsigned, __builtin_amdgcn_cvt_scalef32_pk_bf16_fp8(a, 1.0f, false)); r.y = __builtin_bit_cast(unsigned, __builtin_amdgcn_cvt_scalef32_pk_bf16_fp8(a, 1.0f, true));
    r.z = __builtin_bit_cast(unsigned, __builtin_amdgcn_cvt_scalef32_pk_bf16_fp8(b, 1.0f, false)); r.w = __builtin_bit_cast(unsigned, __builtin_amdgcn_cvt_scalef32_pk_bf16_fp8(b, 1.0f, true));
    return __builtin_bit_cast(bf16x8v, r);
}
__device__ __forceinline__ void sparse_attn_phase(LAS unsigned char* lds, int G, int vcu, const bf16_t* Q, const bf16_t* Kb, const bf16_t* Vb, const unsigned short* SEL, bf16_t* MIX, int lane, int wave) {
    asm volatile("" : "+v"(lane));
    LAS unsigned char* wl = lds + wave * SV_WAVE_BYTES;
    const int nq = (G == 256) ? 16 : (MTOK - (vcu * 8 + wave) + G * 8 - 1) / (G * 8);
    const int r_first = (G == 256) ? (vcu >> 5) * SEQ + (vcu & 31) * 8 + wave : vcu * 8 + wave, r_step = (G == 256) ? 256 : G * 8;
    const float c2 = 0.125f * 1.4426950408889634f;
    if (nq <= 0) { __syncthreads(); return; }
#define SP_LOAD_Q(QF, ROW) do { _Pragma("unroll") for (int ks = 0; ks < 2; ++ks) { u32x4 v_ = (u32x4){0u, 0u, 0u, 0u}; if (q16 < 8) v_ = *(const u32x4*)(Q + (ROW) * 512 + q16 * 64 + ks * 32 + g * 8); QF[ks] = __builtin_bit_cast(bf16x8v, v_); } } while (0)
#define SP_LOAD_K(KF, IB, NV, KBAT, SLOT0, I0, I1) do { _Pragma("unroll") for (int i = (I0); i < (I1); ++i) { const int slot_ = (SLOT0) + 16 * i + q16; unsigned idx_ = *(const LAS unsigned short*)((IB) + slot_ * 2); if (slot_ >= (NV)) idx_ = 0u; \
        KF[i] = *(const u32x4*)((KBAT) + (size_t)idx_ * 64); } } while (0)
#define SP_LOAD_V(VV, IB, NV, VBAT, CC) do { _Pragma("unroll") for (int i = 0; i < 4; ++i) { const int slot_ = 64 * (CC) + (lane_i >> 2) + 16 * i; unsigned idx_ = *(const LAS unsigned short*)((IB) + slot_ * 2); if (slot_ >= (NV)) idx_ = 0u; VV[i] = *(const u32x4*)((VBAT) + (size_t)idx_ * 64); } } while (0)
#define SP_PV(VV, CC) do { _Pragma("unroll") for (int i = 0; i < 8; ++i) *(LAS u32x4*)(wdst + i * 8 * SV_STRIDE) = VV[i]; \
        asm volatile("s_waitcnt lgkmcnt(0)" ::: "memory"); \
        _Pragma("unroll") for (int c2i = 0; c2i < 2; ++c2i) _Pragma("unroll") for (int dt = 0; dt < 4; ++dt) { const LAS unsigned char* p_ = rsrc + c2i * 32 * SV_STRIDE + dt * 32; \
            const v4i16_t lo_ = tr_read16(p_), hi_ = tr_read16(p_ + 16 * SV_STRIDE); const bf16x8v a_ = (bf16x8v){lo_[0], lo_[1], lo_[2], lo_[3], hi_[0], hi_[1], hi_[2], hi_[3]}; \
            O[dt] = __builtin_amdgcn_mfma_f32_16x16x32_bf16(a_, P[2 * (CC) + c2i], O[dt], 0, 0, 0); } \
        asm volatile("s_waitcnt lgkmcnt(0)" ::: "memory"); } while (0)
    u32x2 selv = *(const u32x2*)(SEL + (size_t)r_first * TOPK + 4 * lane);
    *(LAS u32x2*)(wl + SV_TILE_BYTES + lane * 8) = selv;
    if (nq > 1) selv = *(const u32x2*)(SEL + ((size_t)r_first + r_step) * TOPK + 4 * lane);
    asm volatile("s_waitcnt lgkmcnt(0)" ::: "memory");
    bf16x8v qf[2]; u32x4 kfA[8];
    { const int q16 = lane & 15, g = lane >> 4; const int t = r_first % SEQ, n = (t + 1 < TOPK) ? t + 1 : TOPK; const unsigned char* kbat = (const unsigned char*)Kb + (size_t)(r_first / SEQ) * SEQ * 64 + g * 16;
      SP_LOAD_Q(qf, (size_t)r_first); SP_LOAD_K(kfA, wl + SV_TILE_BYTES, n, kbat, 0, 0, 8); }
#pragma unroll 1
    for (int k = 0; k < nq; ++k) {
        int lane_i = lane; asm volatile("" : "+v"(lane_i));
        const int q16 = lane_i & 15, g = lane_i >> 4;
        LAS unsigned char* wdst = wl + (lane_i >> 2) * SV_STRIDE + (lane_i & 3) * 32;
        const LAS unsigned char* rsrc = wl + (4 * g + (q16 >> 2)) * SV_STRIDE + (q16 & 3) * 8;
        const size_t row = (size_t)r_first + (size_t)k * r_step; const int b = (int)(row / SEQ), t = (int)(row % SEQ);
        const int n = (t + 1 < TOPK) ? t + 1 : TOPK;
        const LAS unsigned char* ib = wl + SV_TILE_BYTES + (k & 1) * 512;
        const unsigned char* kbat = (const unsigned char*)Kb + (size_t)b * SEQ * 64 + g * 16;
        const unsigned char* vbat = (const unsigned char*)Vb + (size_t)b * SEQ * 64 + (lane_i & 3) * 16;
        f32x4 S[16];
        {
            u32x4 kfB[8];
            SP_LOAD_K(kfB, ib, n, kbat, 128, 0, 4);
            SP_FENCE();
#pragma unroll
            for (int i = 0; i < 8; ++i) { f32x4 c = (f32x4){0.f, 0.f, 0.f, 0.f};
                c = __builtin_amdgcn_mfma_f32_16x16x32_bf16(fp8x8_to_bf16(kfA[i].x, kfA[i].y), qf[0], c, 0, 0, 0);
                c = __builtin_amdgcn_mfma_f32_16x16x32_bf16(fp8x8_to_bf16(kfA[i].z, kfA[i].w), qf[1], c, 0, 0, 0); S[i] = c; }
            SP_FENCE();
            SP_LOAD_K(kfB, ib, n, kbat, 128, 4, 8);
            SP_FENCE();
#pragma unroll
            for (int i = 0; i < 8; ++i) { f32x4 c = (f32x4){0.f, 0.f, 0.f, 0.f};
                c = __builtin_amdgcn_mfma_f32_16x16x32_bf16(fp8x8_to_bf16(kfB[i].x, kfB[i].y), qf[0], c, 0, 0, 0);
                c = __builtin_amdgcn_mfma_f32_16x16x32_bf16(fp8x8_to_bf16(kfB[i].z, kfB[i].w), qf[1], c, 0, 0, 0); S[8 + i] = c; if (i == 3) SP_FENCE(); }
        }
        SP_FENCE();
        u32x4 vv0[4];
        SP_LOAD_V(vv0, ib, n, vbat, 0);
        if (k + 1 < nq) { *(LAS u32x2*)(wl + SV_TILE_BYTES + ((k + 1) & 1) * 512 + lane_i * 8) = selv; if (k + 2 < nq) selv = *(const u32x2*)(SEL + (row + 2 * (size_t)r_step) * TOPK + 4 * lane_i); }
        SP_FENCE();
        float m = -INFINITY;
#pragma unroll
        for (int kt = 0; kt < 16; ++kt)
#pragma unroll
            for (int r = 0; r < 4; ++r) { if (16 * kt + 4 * g + r >= n) S[kt][r] = -INFINITY; m = fmaxf(m, S[kt][r]); }
        m = fmaxf(m, shx(m, lane_i, 16)); m = fmaxf(m, shx(m, lane_i, 32));
        const float mc = m * c2; float l = 0.f;
#pragma unroll
        for (int kt = 0; kt < 16; ++kt)
#pragma unroll
            for (int r = 0; r < 4; ++r) { const float p = __builtin_amdgcn_exp2f(S[kt][r] * c2 - mc); S[kt][r] = p; l += p; }
        l += shx(l, lane_i, 16); l += shx(l, lane_i, 32);
        const float linv = __builtin_amdgcn_rcpf(l);
        bf16x8v P[8];
#pragma unroll
        for (int c = 0; c < 8; ++c) { u32x4 pk; pk.x = pg8::cvt_pk_bf16(S[2 * c][0], S[2 * c][1]); pk.y = pg8::cvt_pk_bf16(S[2 * c][2], S[2 * c][3]); pk.z = pg8::cvt_pk_bf16(S[2 * c + 1][0], S[2 * c + 1][1]); pk.w = pg8::cvt_pk_bf16(S[2 * c + 1][2], S[2 * c + 1][3]);
            P[c] = __builtin_bit_cast(bf16x8v, pk); asm volatile("" : "+v"(P[c])); }
        SP_FENCE();
        if (k + 1 < nq) { const size_t rown = row + r_step; const int tn = t + r_step, nn = (tn + 1 < TOPK) ? tn + 1 : TOPK;
            asm volatile("s_waitcnt lgkmcnt(0)" ::: "memory");
            SP_LOAD_Q(qf, rown); SP_LOAD_K(kfA, wl + SV_TILE_BYTES + ((k + 1) & 1) * 512, nn, kbat, 0, 0, 4); }
        SP_FENCE();
        f32x4 O[4];
#pragma unroll
        for (int dt = 0; dt < 4; ++dt) O[dt] = (f32x4){0.f, 0.f, 0.f, 0.f};
#define SP_STEP(CC, NEXT) do { _Pragma("unroll") for (int i = 0; i < 4; ++i) { *(LAS bf16x8v*)(wdst + i * 16 * SV_STRIDE) = fp8x8_to_bf16(vv0[i].x, vv0[i].y); *(LAS bf16x8v*)(wdst + i * 16 * SV_STRIDE + 16) = fp8x8_to_bf16(vv0[i].z, vv0[i].w); } SP_FENCE(); NEXT; asm volatile("s_waitcnt lgkmcnt(0)" ::: "memory"); \
        _Pragma("unroll") for (int c2i = 0; c2i < 2; ++c2i) _Pragma("unroll") for (int dt = 0; dt < 4; ++dt) { const LAS unsigned char* p_ = rsrc + c2i * 32 * SV_STRIDE + dt * 32; \
            const v4i16_t lo_ = tr_read16(p_), hi_ = tr_read16(p_ + 16 * SV_STRIDE); const bf16x8v a_ = (bf16x8v){lo_[0], lo_[1], lo_[2], lo_[3], hi_[0], hi_[1], hi_[2], hi_[3]}; \
            O[dt] = __builtin_amdgcn_mfma_f32_16x16x32_bf16(a_, P[2 * (CC) + c2i], O[dt], 0, 0, 0); } \
        asm volatile("s_waitcnt lgkmcnt(0)" ::: "memory"); SP_FENCE(); } while (0)
        SP_STEP(0, SP_LOAD_V(vv0, ib, n, vbat, 1));
        SP_STEP(1, SP_LOAD_V(vv0, ib, n, vbat, 2));
        SP_STEP(2, SP_LOAD_V(vv0, ib, n, vbat, 3));
        if (k + 1 < nq) { const int tn = t + r_step, nn = (tn + 1 < TOPK) ? tn + 1 : TOPK; SP_LOAD_K(kfA, wl + SV_TILE_BYTES + ((k + 1) & 1) * 512, nn, kbat, 0, 4, 8); }
        SP_FENCE();
        SP_STEP(3, (void)0);
#undef SP_STEP
        if (q16 < 8) {
#pragma unroll
            for (int dt = 0; dt < 4; ++dt) { const f32x4 o = O[dt] * linv; u32x2 w;
                w.x = pg8::cvt_pk_bf16(o[0], o[1]); w.y = pg8::cvt_pk_bf16(o[2], o[3]);
                *(u32x2*)(MIX + row * DM + q16 * 64 + dt * 16 + g * 4) = w; }
        }
    }
#undef SP_LOAD_Q
#undef SP_LOAD_K
#undef SP_LOAD_V
#undef SP_PV
    __syncthreads();
}
__device__ __forceinline__ void convb_phase(LAS unsigned char* lds, int G, int vcu, const bf16_t* U, const float* __restrict__ cw, const float* __restrict__ cb, const float* __restrict__ lng, const float* __restrict__ lnb, bf16_t* MIX, int tid, int lane, int wave) {
    asm volatile("" : "+v"(tid), "+v"(lane));
    typedef float f32x2v __attribute__((ext_vector_type(2)));
    const int cp = tid & 255, th = tid >> 8;
    f32x2v w[31];
#pragma unroll
    for (int j = 0; j < 31; ++j) w[j] = *(const f32x2v*)(cw + j * 512 + 2 * cp);
    const f32x2v bias = *(const f32x2v*)(cb + 2 * cp), gam = *(const f32x2v*)(lng + 2 * cp), bet = *(const f32x2v*)(lnb + 2 * cp);
    LAS float* red = (LAS float*)(lds + 65536);
#pragma unroll 1
    for (int tile = vcu; tile < MTOK / 32; tile += G) {
        const int row0 = tile * 32, t0 = row0 & (SEQ - 1);
        for (int i = tid; i < 62 * 64; i += 512) { const int r = i >> 6, ch = i & 63; u32x4 v = (u32x4){0u, 0u, 0u, 0u};
            if (t0 - 30 + r >= 0) v = *(const u32x4*)(U + (size_t)(row0 - 30 + r) * 512 + ch * 8);
            *(LAS u32x4*)(lds + r * 1024 + ch * 16) = v; }
        __syncthreads();
        f32x2v y[2][8];
#pragma unroll
        for (int k = 0; k < 2; ++k) {
            const int tg = th + 2 * k;
            f32x2v acc[8];
#pragma unroll
            for (int o = 0; o < 8; ++o) acc[o] = bias;
            const LAS unsigned* wp = (const LAS unsigned*)(lds + tg * 8 * 1024) + cp;
#pragma unroll
            for (int j = 0; j < 38; ++j) { const unsigned uu = wp[j * 256]; const f32x2v uv = (f32x2v){__uint_as_float(uu << 16), __uint_as_float(uu & 0xffff0000u)};
#pragma unroll
                for (int o = 0; o < 8; ++o) { const int tap = j - o; if (tap >= 0 && tap < 31) acc[o] += w[tap] * uv; } }
#pragma unroll
            for (int o = 0; o < 8; ++o) { y[k][o] = acc[o];
                float s = acc[o].x + acc[o].y, q = acc[o].x * acc[o].x + acc[o].y * acc[o].y;
                s = wave_sum_l(s, lane); q = wave_sum_l(q, lane);
                if (lane == 0) { red[((tg * 8 + o) * 4 + (wave & 3)) * 2] = s; red[((tg * 8 + o) * 4 + (wave & 3)) * 2 + 1] = q; } }
        }
        __syncthreads();
#pragma unroll
        for (int k = 0; k < 2; ++k) {
            const int tg = th + 2 * k;
#pragma unroll
            for (int o = 0; o < 8; ++o) { const int tl = tg * 8 + o;
                const f32x4 ra = *(const LAS f32x4*)(red + tl * 8), rb = *(const LAS f32x4*)(red + tl * 8 + 4);
                const float mu = ((ra[0] + ra[2]) + (rb[0] + rb[2])) * (1.f / 512.f), ex2 = ((ra[1] + ra[3]) + (rb[1] + rb[3])) * (1.f / 512.f);
                const float rstd = 1.f / sqrtf(fmaxf(ex2 - mu * mu, 0.f) + EPS);
                const float v0 = (y[k][o].x - mu) * rstd * gam.x + bet.x, v1 = (y[k][o].y - mu) * rstd * gam.y + bet.y;
                *(unsigned*)(MIX + (size_t)(row0 + tl) * DM + 512 + 2 * cp) = (unsigned)f2bf(silu_f(v0)) | ((unsigned)f2bf(silu_f(v1)) << 16); }
        }
        __syncthreads();
    }
}

__device__ __forceinline__ int wt_dst_row(int mode, int c) {
    if (mode == 0) return c;
    if (mode == 2) return 256 * (c >> 7) + (c & 127);
    if (mode == 3) return 256 * (c >> 7) + 128 + (c & 127);
    if (c < 512) return (c & ~63) + dperm(c & 63);
    if (c < 576) return 512 + dperm(c - 512);
    if (c < 640) return c;
    if (c < 896) return 768 + ((c - 640) & ~63) + dperm((c - 640) & 63);
    if (c < 960) return 640 + dperm(c - 896);
    if (c < 964) return 704 + (c - 960);
    if (c < 1476) { const int j = c - 964; return 1024 + 256 * (j >> 7) + (j & 127); }
    { const int j = c - 1476; return 1024 + 256 * (j >> 7) + 128 + (j & 127); }
}
__device__ __forceinline__ void wt_body(LAS unsigned char* sm, int vb, int tid, const float* __restrict__ W, int K, int N, bf16_t* WT, const float* __restrict__ gain, int mode) {
    LAS float* t = (LAS float*)sm;
    const int nbx = (N + 31) / 32; const int k0 = (vb / nbx) * 32, n0 = (vb % nbx) * 32, tx = tid & 31, ty = tid >> 5;
    for (int i = ty; i < 32; i += 8) { const int k = k0 + i, n = n0 + tx; float v = 0.f; if (k < K && n < N) { v = W[(size_t)k * N + n]; if (gain) v *= gain[k]; } t[i * 33 + tx] = v; }
    __syncthreads();
    for (int i = ty; i < 32; i += 8) { const int n = n0 + i, k = k0 + tx; if (n < N && k < K) WT[(size_t)wt_dst_row(mode, n) * K + k] = f2bf(t[tx * 33 + i]); }
    __syncthreads();
}
__device__ __forceinline__ void rmsnorm_bf16_row(const float* x, const float* __restrict__ g, bf16_t* out, int row, int lane) {
    const f32x4* xr = (const f32x4*)(x + (size_t)row * DM) + lane; const f32x4* gr = (const f32x4*)g + lane;
    f32x4 v[4]; float s = 0.f;
#pragma unroll
    for (int j = 0; j < 4; ++j) { v[j] = xr[64 * j]; s += (v[j].x * v[j].x + v[j].y * v[j].y) + (v[j].z * v[j].z + v[j].w * v[j].w); }
    const float rstd = 1.f / sqrtf(wave_sum_l(s, lane) * (1.f / DM) + EPS);
    u32x2* o = (u32x2*)(out + (size_t)row * DM) + lane;
#pragma unroll
    for (int j = 0; j < 4; ++j) { const f32x4 gg = gr[64 * j]; u32x2 w;
        w.x = (unsigned)f2bf(v[j].x * rstd * gg.x) | ((unsigned)f2bf(v[j].y * rstd * gg.y) << 16);
        w.y = (unsigned)f2bf(v[j].z * rstd * gg.z) | ((unsigned)f2bf(v[j].w * rstd * gg.w) << 16); o[64 * j] = w; }
}
__device__ __forceinline__ void rmsnorm_f32_row(float* x, const float* __restrict__ g, int row, int lane) {
    f32x4* xr = (f32x4*)(x + (size_t)row * DM) + lane; const f32x4* gr = (const f32x4*)g + lane;
    f32x4 v[4]; float s = 0.f;
#pragma unroll
    for (int j = 0; j < 4; ++j) { v[j] = xr[64 * j]; s += (v[j].x * v[j].x + v[j].y * v[j].y) + (v[j].z * v[j].z + v[j].w * v[j].w); }
    const float rstd = 1.f / sqrtf(wave_sum_l(s, lane) * (1.f / DM) + EPS);
#pragma unroll
    for (int j = 0; j < 4; ++j) { const f32x4 gg = gr[64 * j]; xr[64 * j] = v[j] * rstd * gg; }
}

__device__ __forceinline__ void wt_item(const float* __restrict__ W, int K, int N, bf16_t* WT, const float* __restrict__ gain, int mode, LAS float* scr, int item, int lane) {
    const int nblk = (N + 31) / 32, kb = item / nblk, nb = item - kb * nblk, k0 = 64 * kb, n0 = 32 * nb;
    const int nn = n0 + (lane & 31);
    float wv[32];
#pragma unroll
    for (int i = 0; i < 32; ++i) { const int kk = 2 * i + (lane >> 5); wv[i] = 0.f; if (nn < N) wv[i] = W[(size_t)(k0 + kk) * N + nn]; }
#pragma unroll
    for (int i = 0; i < 32; ++i) { const int kk = 2 * i + (lane >> 5); float v = wv[i]; if (gain) v *= gain[k0 + kk]; scr[kk * 33 + (lane & 31)] = v; }
    asm volatile("s_waitcnt lgkmcnt(0)" ::: "memory");
    const int c = lane & 7;
#pragma unroll
    for (int j = 0; j < 4; ++j) { const int n = (lane >> 3) + 8 * j; const LAS float* s = scr + (8 * c) * 33 + n;
        u32x4 o; o.x = pg8::cvt_pk_bf16(s[0 * 33], s[1 * 33]); o.y = pg8::cvt_pk_bf16(s[2 * 33], s[3 * 33]); o.z = pg8::cvt_pk_bf16(s[4 * 33], s[5 * 33]); o.w = pg8::cvt_pk_bf16(s[6 * 33], s[7 * 33]);
        if (n0 + n < N) *(u32x4*)(WT + (size_t)wt_dst_row(mode, n0 + n) * K + k0 + 8 * c) = o; }
    asm volatile("s_waitcnt lgkmcnt(0)" ::: "memory");
}

__device__ __forceinline__ void rmsnorm_bf16_2rows(const float* x, const float* __restrict__ g, bf16_t* out, int row, int lane) {
    const f32x4* xr = (const f32x4*)(x + (size_t)row * DM) + lane; const f32x4* gr = (const f32x4*)g + lane;
    f32x4 v[2][4]; float s[2] = {0.f, 0.f};
#pragma unroll
    for (int r = 0; r < 2; ++r)
#pragma unroll
        for (int j = 0; j < 4; ++j) v[r][j] = xr[r * (DM / 4) + 64 * j];
#pragma unroll
    for (int r = 0; r < 2; ++r)
#pragma unroll
        for (int j = 0; j < 4; ++j) s[r] += (v[r][j].x * v[r][j].x + v[r][j].y * v[r][j].y) + (v[r][j].z * v[r][j].z + v[r][j].w * v[r][j].w);
#pragma unroll
    for (int r = 0; r < 2; ++r) { const float rstd = 1.f / sqrtf(wave_sum_l(s[r], lane) * (1.f / DM) + EPS);
        u32x2* o = (u32x2*)(out + (size_t)(row + r) * DM) + lane;
#pragma unroll
        for (int j = 0; j < 4; ++j) { const f32x4 gg = gr[64 * j]; u32x2 w;
            w.x = pg8::cvt_pk_bf16(v[r][j].x * rstd * gg.x, v[r][j].y * rstd * gg.y); w.y = pg8::cvt_pk_bf16(v[r][j].z * rstd * gg.z, v[r][j].w * rstd * gg.w); o[64 * j] = w; } }
}

constexpr size_t MiB = 1u << 20;
constexpr int LDS_USER = 139264, LDSCTL_OFF = LDS_USER, MISC_OFF = LDSCTL_OFF + 320, LDS_BYTES = 147456;
constexpr size_t WS_CTL = 476 * MiB, CTL_ZERO_BYTES = 1 * MiB; constexpr int CW_BAR = 4096;
constexpr int NGU = 2 * DFF;
struct Args { const float* in[23]; float* out; unsigned char* ws; };
static_assert(sizeof(Args) == 25 * 8, "Args has no padding");

__global__ void __launch_bounds__(512, 2) mega_k(Args a) {
    extern __shared__ __attribute__((aligned(16))) unsigned char lds_raw[];
    LAS unsigned char* lds = (LAS unsigned char*)lds_raw;
    const int wave = __builtin_amdgcn_readfirstlane(threadIdx.x >> 6);
#define PH_IDS() int lane; asm volatile("v_mbcnt_lo_u32_b32 %0, -1, 0\n\tv_mbcnt_hi_u32_b32 %0, -1, %0" : "=v"(lane)); const int tid = wave * 64 + lane, half = wave >> 2, htid = tid & 255; LAS unsigned char* hsm = lds + half * 65536; (void)htid; (void)hsm
    const int G = gridDim.x, bx = blockIdx.x; const int vcu = (G % 8 == 0) ? (bx % 8) * (G / 8) + bx / 8 : bx;
    const float* x = a.in[0]; const float* mem = a.in[1]; const int* positions = (const int*)a.in[2];
    const float* g_mix = a.in[3]; const float* w_in = a.in[4]; const float* w_out = a.in[5];
    const float* conv_b_w = a.in[6]; const float* conv_b_b = a.in[7]; const float* ln_b_g = a.in[8]; const float* ln_b_b = a.in[9];
    const float* g_cross = a.in[10]; const float* g_mem = a.in[11];
    const float* w_q = a.in[12]; const float* w_k = a.in[13]; const float* w_v = a.in[14]; const float* w_o = a.in[15];
    const float* g_ffn = a.in[16]; const float* w_gate = a.in[17]; const float* w_up = a.in[18];
    const float* ffn_cw = a.in[19]; const float* ffn_cb = a.in[20]; const float* w_down = a.in[21]; const float* g_final = a.in[22];
    float* out = a.out; unsigned char* ws = a.ws;
    bf16_t* wt_in = (bf16_t*)(ws + 0 * MiB); bf16_t* wt_out = (bf16_t*)(ws + 4 * MiB);
    bf16_t* wt_q = (bf16_t*)(ws + 6 * MiB), *wt_k = (bf16_t*)(ws + 8 * MiB), *wt_v = (bf16_t*)(ws + 10 * MiB), *wt_o = (bf16_t*)(ws + 12 * MiB);
    bf16_t* wt_gu = (bf16_t*)(ws + 14 * MiB); bf16_t* wt_down = (bf16_t*)(ws + 26 * MiB);
    float* WI = (float*)(ws + 32 * MiB); float* CS = (float*)(ws + 33 * MiB);
    float* SS1 = (float*)(ws + 35 * MiB); float* SS2 = (float*)(ws + 37 * MiB); float* SS3 = (float*)(ws + 39 * MiB);
    bf16_t* MEMN = (bf16_t*)(ws + 41 * MiB), *KC = (bf16_t*)(ws + 45 * MiB), *VC = (bf16_t*)(ws + 49 * MiB);
    bf16_t* XB = (bf16_t*)(ws + 56 * MiB);
    bf16_t* Qb = (bf16_t*)(ws + 120 * MiB); bf16_t* QI = (bf16_t*)(ws + 152 * MiB);
    bf16_t* Kb = (bf16_t*)(ws + 168 * MiB), *Vb = (bf16_t*)(ws + 172 * MiB), *KI = (bf16_t*)(ws + 176 * MiB);
    bf16_t* U = (bf16_t*)(ws + 180 * MiB); unsigned short* SEL = (unsigned short*)(ws + 212 * MiB);
    bf16_t* MIX = (bf16_t*)(ws + 228 * MiB); bf16_t* QC = (bf16_t*)(ws + 292 * MiB); bf16_t* OC = (bf16_t*)(ws + 356 * MiB);
    bf16_t* Hb = (bf16_t*)(ws + 120 * MiB);
    float* TOPG = (float*)(ws + 300 * MiB); float* TOPU = (float*)(ws + 304 * MiB); float* BOTG = (float*)(ws + 308 * MiB);
    unsigned* ctl = (unsigned*)(ws + WS_CTL);

    { PH_IDS(); for (int u = tid; u < (LDS_BYTES - LDSCTL_OFF) / 4; u += 512) ((LAS unsigned*)(lds + LDSCTL_OFF))[u] = 0u; }
    __syncthreads();
    XcdBarrier bar = xcd_barrier_post(ctl + CW_BAR, (volatile LAS unsigned*)(lds + MISC_OFF) + 8);
#define GRID_BAR() xcd_barrier(bar)
#define FOR_VB(nvb) for (int vb = 2 * bx + half; vb < (nvb); vb += 2 * G)
#define GEMMX(EPI, EINIT, Aptr, Bptr, Mv, Nv, Kv) do { pg8::Gemm g_{Aptr, Bptr, Mv, Nv, Kv}; pg8::StaticOrder S_; S_.init(Mv, Nv, G, bx); EPI E_ EINIT; \
        PH_IDS(); pg8::gemm_phase<EPI, pg8::StaticOrder, true, true>(lds, g_, S_, E_, tid); } while (0)
#define EI(...) {__VA_ARGS__}

    { PH_IDS();
    for (int i = bx * 512 + tid; i < 60 * DM; i += G * 512) wt_in[(size_t)708 * DM + i] = 0;
    { LAS float* scr = (LAS float*)(lds + wave * 8704); const int gw = vcu * 8 + wave, NGW = G * 8;
      constexpr int I_IN = 16 * 63, I_SQ = 16 * 32, I_FF = 16 * 88, I_DN = 44 * 32, NIT = I_IN + 5 * I_SQ + 2 * I_FF + I_DN;
#pragma unroll 1
      for (int it = gw; it < NIT; it += NGW) { int r = it;
          if (r < I_IN) { wt_item(w_in, DM, INC, wt_in, nullptr, 1, scr, r, lane); continue; } r -= I_IN;
          if (r < I_SQ) { wt_item(w_out, DM, DM, wt_out, nullptr, 0, scr, r, lane); continue; } r -= I_SQ;
          if (r < I_SQ) { wt_item(w_q, DM, DM, wt_q, g_cross, 0, scr, r, lane); continue; } r -= I_SQ;
          if (r < I_SQ) { wt_item(w_k, DM, DM, wt_k, nullptr, 0, scr, r, lane); continue; } r -= I_SQ;
          if (r < I_SQ) { wt_item(w_v, DM, DM, wt_v, nullptr, 0, scr, r, lane); continue; } r -= I_SQ;
          if (r < I_SQ) { wt_item(w_o, DM, DM, wt_o, nullptr, 0, scr, r, lane); continue; } r -= I_SQ;
          if (r < I_FF) { wt_item(w_gate, DM, DFF, wt_gu, g_ffn, 2, scr, r, lane); continue; } r -= I_FF;
          if (r < I_FF) { wt_item(w_up, DM, DFF, wt_gu, g_ffn, 3, scr, r, lane); continue; } r -= I_FF;
          wt_item(w_down, DFF, DM, wt_down, nullptr, 0, scr, r, lane); } }
    for (int i = bx * 512 + tid; i < MTOK * 8; i += G * 512) { const int row = i >> 3, k = i & 7;
        const float fr8[8] = {1.000000000e+00f, 1.939227432e-01f, 3.760603070e-02f, 7.292664610e-03f, 1.414213562e-03f, 2.742481884e-04f, 5.318295734e-05f, 1.031338525e-05f};
        float freq = fr8[0];
#pragma unroll
        for (int kk = 1; kk < 8; ++kk) freq = (k == kk) ? fr8[kk] : freq;
        const float ang = (float)positions[row] * freq;
        CS[(size_t)row * 16 + k] = (float)cos((double)ang); CS[(size_t)row * 16 + 8 + k] = (float)sin((double)ang); }
    for (int r = 2 * (bx * 8 + wave); r < MTOK; r += G * 16) rmsnorm_bf16_2rows(x, g_mix, XB, r, lane);
    for (int r = bx * 8 + wave; r < MMEM; r += G * 8) rmsnorm_bf16_row(mem, g_mem, MEMN, r, lane);
    }
    GRID_BAR();
    GEMMX(EpiIn, EI(CS, Qb, Kb, Vb, QI, KI, U, WI), XB, wt_in, MTOK, INP, DM);
    GEMMX(EpiStore, EI(nullptr, KC, nullptr, DM), MEMN, wt_k, MMEM, DM, DM);
    GEMMX(EpiStore, EI(nullptr, VC, nullptr, MMEM), wt_v, MEMN, DM, MMEM, DM);
    GRID_BAR();
    { PH_IDS(); topk_phase(lds, G, vcu, QI, KI, WI, SEL, tid, lane, wave); }
    { PH_IDS(); convb_phase(lds, G, vcu, U, conv_b_w, conv_b_b, ln_b_g, ln_b_b, MIX, tid, lane, wave); }
    GRID_BAR();
    { PH_IDS(); sparse_attn_phase(lds, G, vcu, Qb, Kb, Vb, SEL, MIX, lane, wave); }
    GRID_BAR();
    GEMMX(EpiRes, EI(x, nullptr, nullptr, XB, SS1), MIX, wt_out, MTOK, DM, DM);
    GRID_BAR();
    GEMMX(EpiScale, EI(SS1, QC, DM, 1.0f), XB, wt_q, MTOK, DM, DM);
    GRID_BAR();
    { PH_IDS(); const int per = (512 + G - 1) / G; for (int i = 0; i < per; ++i) { const int u = vcu * per + i; if (u < 512) cross_attn_unit(lds, u >> 6, (u >> 4) & 3, u & 15, QC, KC, VC, OC, tid, lane, wave); } }
    GRID_BAR();
    GEMMX(EpiRes, EI(nullptr, XB, nullptr, XB, SS2), OC, wt_o, MTOK, DM, DM);
    GRID_BAR();
    GEMMX(EpiGateUpAct, EI(SS2, Hb, ffn_cw, ffn_cb, TOPG, TOPU, BOTG, lds + 131072), XB, wt_gu, MTOK, NGU, DM);
    GRID_BAR();
    { PH_IDS();
    for (int i = bx * 512 + tid; i < (MTOK / 256) * 2 * DFF; i += G * 512) {
        const int pm = i / (2 * DFF), rem = i - pm * (2 * DFF), j = rem / DFF, c = rem - j * DFF;
        const bool first = (pm & 15) == 0;
        const float gm2 = first ? 0.f : BOTG[((size_t)(pm - 1) * 2 + 0) * DFF + c], gm1 = first ? 0.f : BOTG[((size_t)(pm - 1) * 2 + 1) * DFF + c];
        const float g0 = TOPG[((size_t)pm * 2 + 0) * DFF + c], g1 = TOPG[((size_t)pm * 2 + 1) * DFF + c];
        const float cur = j ? g1 : g0, p1 = j ? g0 : gm1, p2 = j ? gm1 : gm2;
        const float gg = ffn_cb[c] + ffn_cw[2 * DFF + c] * cur + ffn_cw[DFF + c] * p1 + ffn_cw[c] * p2;
        Hb[((size_t)pm * 256 + j) * DFF + c] = f2bf(silu_f(gg) * TOPU[((size_t)pm * 2 + j) * DFF + c]);
    }
    }
    GRID_BAR();
    GEMMX(EpiRes, EI(nullptr, XB, nullptr, XB, SS3), Hb, wt_down, MTOK, DM, DFF);
    GRID_BAR();
    { PH_IDS();
    for (int r = bx * 8 + wave; r < MTOK; r += G * 8) {
        const float rs = rstd_from_ss(SS3, (size_t)r);
        const u32x4* xr = (const u32x4*)(XB + (size_t)r * DM) + lane; f32x4* orow = (f32x4*)(out + (size_t)r * DM); const f32x4* gr = (const f32x4*)g_final;
#pragma unroll
        for (int j = 0; j < 2; ++j) { const u32x4 v = xr[64 * j]; const int c4 = (64 * j + lane) * 2;
            const f32x4 a = (f32x4){__uint_as_float(v.x << 16), __uint_as_float(v.x & 0xffff0000u), __uint_as_float(v.y << 16), __uint_as_float(v.y & 0xffff0000u)};
            const f32x4 bq = (f32x4){__uint_as_float(v.z << 16), __uint_as_float(v.z & 0xffff0000u), __uint_as_float(v.w << 16), __uint_as_float(v.w & 0xffff0000u)};
            orow[c4] = a * rs * gr[c4]; orow[c4 + 1] = bq * rs * gr[c4 + 1]; }
    }
    }
}

extern "C" void kernel_launch(void* const* d_in, const int* in_sizes, int n_in, void* d_out, int out_size, void* d_ws, size_t ws_size, hipStream_t stream) {
    static int grid = 0;
    if (grid == 0) {
        int dev = 0, cus = 0, per_cu = 0;
        if (hipGetDevice(&dev) != hipSuccess || hipDeviceGetAttribute(&cus, hipDeviceAttributeMultiprocessorCount, dev) != hipSuccess) { fprintf(stderr, "kernel_launch: device query failed\n"); grid = -1; return; }
        if (hipFuncSetAttribute((const void*)mega_k, hipFuncAttributeMaxDynamicSharedMemorySize, LDS_BYTES) != hipSuccess) { fprintf(stderr, "kernel_launch: hipFuncSetAttribute failed\n"); grid = -1; return; }
        if (hipOccupancyMaxActiveBlocksPerMultiprocessor(&per_cu, (const void*)mega_k, 512, LDS_BYTES) != hipSuccess || per_cu < 1) { fprintf(stderr, "kernel_launch: occupancy query says %d\n", per_cu); per_cu = 1; }
        (void)hipGetLastError();
        grid = cus * 1;
        if (n_in != 23 || ws_size < 477 * MiB) { fprintf(stderr, "kernel_launch: unexpected n_in %d / ws %zu\n", n_in, ws_size); grid = -1; return; }
    }
    if (grid < 0) return;
    (void)hipMemsetAsync((char*)d_ws + WS_CTL, 0, CTL_ZERO_BYTES, stream);
    Args a{};
    for (int i = 0; i < 23; ++i) a.in[i] = (const float*)d_in[i];
    a.out = (float*)d_out; a.ws = (unsigned char*)d_ws;
    void* params[] = {&a};
    hipError_t e = hipLaunchCooperativeKernel((const void*)mega_k, dim3(grid), dim3(512), params, LDS_BYTES, stream);
    if (e != hipSuccess) fprintf(stderr, "cooperative launch failed: %s (grid %d)\n", hipGetErrorString(e), grid);
}
```

```cpp
#include <hip/hip_runtime.h>
#include <cstdio>
#include <cstdint>
#include <cmath>
namespace pg8 {
#define PG8_LAS __attribute__((address_space(3)))
typedef unsigned short bf16_t;
typedef short bf16x8 __attribute__((ext_vector_type(8)));
typedef float f32x4 __attribute__((ext_vector_type(4)));
typedef unsigned u32x4 __attribute__((ext_vector_type(4)));
constexpr int BM = 256, BK = 64, HALF = 128, HTB = HALF * BK * 2  , STAGE_BYTES = 8 * HTB, NXCD = 8, WGM = 8;

__host__ __device__ __forceinline__ int lds_byte(int r, int c) { const int st = (r >> 4) * 2 + (c >> 5), rr = r & 15, cc = c & 31, ob = rr * 64 + cc * 2; return st * 1024 + (ob ^ (((ob >> 9) & 1) << 5)); }
__host__ __device__ __forceinline__ void stage_rc(int b, int& R, int& C) { const int st = b / 1024, sb = b % 1024, swz = sb ^ (((sb >> 9) & 1) << 5); R = (st >> 1) * 16 + swz / 64; C = (st & 1) * 32 + (swz % 64) / 2; }
__host__ __device__ __forceinline__ int perm32(int rho) { const int n = rho >> 4, i = rho & 15; return 8 * (i >> 2) + 4 * n + (i & 3); }

struct Unit { int pm, pn; };
struct Gemm { const bf16_t* A; const bf16_t* Bt; int M, N, K; };

struct StaticOrder {
    int nM, nN, nwg, G, c;
    __host__ __device__ void init(int M, int N, int G_, int c_) { nM = M / BM; nN = N / BM; nwg = nM * nN; G = G_; c = c_; }
    __host__ __device__ bool next(int i, Unit& u) const {
        const long L = (long)i * G + c; if (L >= nwg) return false;
        int wgid = (int)L; { const int q = nwg / NXCD, r = nwg % NXCD, xcd = wgid % NXCD, off = wgid / NXCD; wgid = (xcd < r ? xcd * (q + 1) : r * (q + 1) + (xcd - r) * q) + off; }
        const int nig = WGM * nN, gid = wgid / nig, fm = gid * WGM, gsz = (nM - fm) < WGM ? (nM - fm) : WGM;
        u.pm = fm + ((wgid % nig) % gsz); u.pn = (wgid % nig) / gsz; return true;
    }
    __device__ __forceinline__ void a_ready(const Unit&) const {}
    __device__ __forceinline__ void done(const Unit&) const {}
};
__device__ __forceinline__ unsigned cvt_pk_bf16(float lo, float hi) { unsigned r; asm volatile("v_cvt_pk_bf16_f32 %0, %1, %2" : "=v"(r) : "v"(lo), "v"(hi)); return r; }
template <class Epi, class Sched, bool ALIGN_EPI = false, bool SP2 = false>
__device__ __forceinline__ void gemm_phase(PG8_LAS unsigned char* lds, const Gemm g, const Sched& S, const Epi& E, int tid_in) {
    int tid_l = tid_in; asm volatile("" : "+v"(tid_l));
    const int tid = tid_l, wid = __builtin_amdgcn_readfirstlane(tid >> 6), lane = tid & 63, wr = wid >> 2, wc = wid & 3, fr = lane & 15, fq = lane >> 4;
    const int K = g.K, nt = K / BK;
    unsigned voffA[2], voffB[2];
#pragma unroll
    for (int i = 0; i < 2; ++i) { int R, C; stage_rc(tid * 16 + i * 8192, R, C); const int Rb = Epi::PERM ? ((R & ~31) + perm32(R & 31)) : R;
        voffA[i] = (unsigned)(R * K + C) * 2u; voffB[i] = (unsigned)(Rb * K + C) * 2u; }
    const size_t kstep = (size_t)(BK * 2);
    const size_t hstep = (size_t)HALF * K * 2;
    const size_t tstep = 2 * hstep;
    const unsigned ldsw = (unsigned)wid * 1024u;
    const int aoff = lds_byte(wr * 64 + fr, fq * 8), boff = lds_byte(wc * 32 + fr, fq * 8);
#define PG8_SA(b, h) (((b) * 2 + (h)) * HTB)
#define PG8_SB(b, h) ((4 + (b) * 2 + (h)) * HTB)
#define PG8_STAGE(bufoff, gbase, voff) do { _Pragma("unroll") for (int _i = 0; _i < 2; ++_i) \
        __builtin_amdgcn_global_load_lds((const unsigned*)((const char*)(gbase) + (voff)[_i]), (PG8_LAS unsigned*)(lds + (bufoff) + ldsw + _i * 8192), 16, 0, 0); } while (0)
#define PG8_LDA(dst, b, h) do { _Pragma("unroll") for (int m = 0; m < 4; ++m) _Pragma("unroll") for (int k = 0; k < 2; ++k) dst[m][k] = *(const PG8_LAS bf16x8*)(lds + PG8_SA(b, h) + aoff + m * 2048 + k * 1024); } while (0)
#define PG8_LDB(dst, b, h) do { _Pragma("unroll") for (int n = 0; n < 2; ++n) _Pragma("unroll") for (int k = 0; k < 2; ++k) dst[n][k] = *(const PG8_LAS bf16x8*)(lds + PG8_SB(b, h) + boff + n * 2048 + k * 1024); } while (0)
#define PG8_MMA(ai, bj, At, Bt) do { __builtin_amdgcn_s_setprio(1); _Pragma("unroll") for (int m = 0; m < 4; ++m) _Pragma("unroll") for (int n = 0; n < 2; ++n) _Pragma("unroll") for (int k = 0; k < 2; ++k) \
        acc[ai][bj][m][n] = __builtin_amdgcn_mfma_f32_16x16x32_bf16(Bt[n][k], At[m][k], acc[ai][bj][m][n], 0, 0, 0); __builtin_amdgcn_s_setprio(0); } while (0)
#define PG8_WAIT_V(n) asm volatile("s_waitcnt vmcnt(" #n ")" ::: "memory")
#define PG8_WAIT_L(n) asm volatile("s_waitcnt lgkmcnt(" #n ")" ::: "memory")
#define PG8_BAR __builtin_amdgcn_s_barrier()
#define PG8_SCHED __builtin_amdgcn_sched_barrier(0)
    Unit cur, nxt; int ui = 0;
    if (!S.next(0, cur)) return;
    f32x4 acc[2][2][4][2];
#pragma unroll
    for (int a = 0; a < 2; ++a)
#pragma unroll
        for (int b = 0; b < 2; ++b)
#pragma unroll
            for (int m = 0; m < 4; ++m)
#pragma unroll
                for (int n = 0; n < 2; ++n) acc[a][b][m][n] = (f32x4){0.f, 0.f, 0.f, 0.f};
    bf16x8 At[4][2], B0[2][2], B1[2][2];
    const char* cA = (const char*)g.A + (size_t)cur.pm * tstep; const char* cB = (const char*)g.Bt + (size_t)cur.pn * tstep;
    S.a_ready(cur);
    if constexpr (SP2) {
        PG8_STAGE(PG8_SB(0, 0), cB, voffB); PG8_STAGE(PG8_SB(0, 1), cB + hstep, voffB); PG8_STAGE(PG8_SA(0, 0), cA, voffA); PG8_STAGE(PG8_SA(0, 1), cA + hstep, voffA);
        if (wr == 1) PG8_BAR;
        PG8_WAIT_V(2); PG8_BAR;
        PG8_STAGE(PG8_SB(1, 0), cB + kstep, voffB); PG8_STAGE(PG8_SA(1, 0), cA + kstep, voffA); PG8_STAGE(PG8_SB(1, 1), cB + hstep + kstep, voffB);
        PG8_WAIT_V(6); PG8_BAR;
    } else {
        PG8_STAGE(PG8_SB(0, 0), cB, voffB); PG8_STAGE(PG8_SA(0, 0), cA, voffA); PG8_STAGE(PG8_SB(0, 1), cB + hstep, voffB); PG8_STAGE(PG8_SA(0, 1), cA + hstep, voffA);
        if (wr == 1) PG8_BAR;
        PG8_WAIT_V(4); PG8_BAR;
        PG8_STAGE(PG8_SB(1, 0), cB + kstep, voffB); PG8_STAGE(PG8_SA(1, 0), cA + kstep, voffA); PG8_STAGE(PG8_SB(1, 1), cB + hstep + kstep, voffB);
        PG8_WAIT_V(6); PG8_BAR;
    }
    for (;;) {
        const bool has_next = S.next(ui + 1, nxt);
        const char* nA = has_next ? (const char*)g.A + (size_t)nxt.pm * tstep : cA; const char* nB = has_next ? (const char*)g.Bt + (size_t)nxt.pn * tstep : cB;
        for (int t = 0; t < nt; t += 2) {
            const bool last = (t == nt - 2);
            const char* a1 = cA + (size_t)(t + 1) * kstep;
            const char* a2 = last ? nA : cA + (size_t)(t + 2) * kstep; const char* b2 = last ? nB : cB + (size_t)(t + 2) * kstep;
            const char* a3 = a2 + kstep; const char* b3 = b2 + kstep;
            if (last && has_next) S.a_ready(nxt);
            if constexpr (SP2) {
            PG8_LDB(B0, 0, 0); PG8_LDB(B1, 0, 1); PG8_SCHED; PG8_LDA(At, 0, 0); PG8_STAGE(PG8_SA(1, 1), a1 + hstep, voffA);
            PG8_WAIT_V(8); PG8_WAIT_L(0); PG8_BAR; PG8_MMA(0, 0, At, B0); PG8_MMA(0, 1, At, B1); PG8_BAR; PG8_SCHED;
            PG8_LDA(At, 0, 1); PG8_STAGE(PG8_SB(0, 0), b2, voffB); PG8_STAGE(PG8_SB(0, 1), b2 + hstep, voffB); PG8_STAGE(PG8_SA(0, 0), a2, voffA);
            PG8_WAIT_V(8); PG8_WAIT_L(0); PG8_BAR; PG8_MMA(1, 0, At, B0); PG8_MMA(1, 1, At, B1); PG8_BAR; PG8_SCHED;
            PG8_LDB(B0, 1, 0); PG8_LDB(B1, 1, 1); PG8_SCHED; PG8_LDA(At, 1, 0); PG8_STAGE(PG8_SA(0, 1), a2 + hstep, voffA);
            PG8_WAIT_V(8); PG8_WAIT_L(0); PG8_BAR; PG8_MMA(0, 0, At, B0); PG8_MMA(0, 1, At, B1); PG8_BAR; PG8_SCHED;
            PG8_LDA(At, 1, 1); PG8_STAGE(PG8_SB(1, 0), b3, voffB); PG8_STAGE(PG8_SB(1, 1), b3 + hstep, voffB); PG8_STAGE(PG8_SA(1, 0), a3, voffA);
            PG8_WAIT_V(8); PG8_WAIT_L(0); PG8_BAR; PG8_MMA(1, 0, At, B0); PG8_MMA(1, 1, At, B1); PG8_BAR; PG8_SCHED;
            } else {
            PG8_LDB(B0, 0, 0); PG8_SCHED; PG8_LDA(At, 0, 0); PG8_STAGE(PG8_SA(1, 1), a1 + hstep, voffA);
            PG8_WAIT_L(8); PG8_BAR; PG8_WAIT_L(0); PG8_MMA(0, 0, At, B0); PG8_BAR; PG8_SCHED;
            PG8_LDB(B1, 0, 1); PG8_STAGE(PG8_SB(0, 0), b2, voffB);
            PG8_BAR; PG8_WAIT_L(0); PG8_MMA(0, 1, At, B1); PG8_BAR;
            PG8_LDA(At, 0, 1); PG8_STAGE(PG8_SA(0, 0), a2, voffA);
            PG8_BAR; PG8_WAIT_L(0); PG8_MMA(1, 0, At, B0); PG8_BAR; PG8_SCHED;
            PG8_STAGE(PG8_SB(0, 1), b2 + hstep, voffB);
            PG8_WAIT_V(6); PG8_BAR; PG8_MMA(1, 1, At, B1); PG8_BAR;
            PG8_LDB(B0, 1, 0); PG8_SCHED; PG8_LDA(At, 1, 0); PG8_STAGE(PG8_SA(0, 1), a2 + hstep, voffA);
            PG8_WAIT_L(8); PG8_BAR; PG8_WAIT_L(0); PG8_MMA(0, 0, At, B0); PG8_BAR; PG8_SCHED;
            PG8_LDB(B1, 1, 1); PG8_STAGE(PG8_SB(1, 0), b3, voffB);
            PG8_BAR; PG8_WAIT_L(0); PG8_MMA(0, 1, At, B1); PG8_BAR;
            PG8_LDA(At, 1, 1); PG8_STAGE(PG8_SA(1, 0), a3, voffA);
            PG8_BAR; PG8_WAIT_L(0); PG8_MMA(1, 0, At, B0); PG8_BAR; PG8_SCHED;
            PG8_STAGE(PG8_SB(1, 1), b3 + hstep, voffB);
            PG8_WAIT_V(6); PG8_BAR; PG8_MMA(1, 1, At, B1); PG8_BAR;
            }
        }
        if constexpr (ALIGN_EPI) { if (wr == 0) PG8_BAR; }
        if constexpr (!Epi::AFTER_DRAIN) { E(acc, cur, wr, wc, fr, fq); S.done(cur); }
        if (!has_next) break;
#pragma unroll
        for (int a = 0; a < 2; ++a)
#pragma unroll
            for (int b = 0; b < 2; ++b)
#pragma unroll
                for (int m = 0; m < 4; ++m)
#pragma unroll
                    for (int n = 0; n < 2; ++n) acc[a][b][m][n] = (f32x4){0.f, 0.f, 0.f, 0.f};
        cur = nxt; cA = nA; cB = nB; ++ui;
        if constexpr (ALIGN_EPI) { if (wr == 1) PG8_BAR; }
    }
    PG8_WAIT_V(0);
    if constexpr (!ALIGN_EPI) { if (wr == 0) PG8_BAR; }
    PG8_BAR;
    if constexpr (Epi::AFTER_DRAIN) { E.fused(acc, cur, wr, wc, fr, fq, lds, wid, lane); S.done(cur); }
#undef PG8_SA
#undef PG8_SB
#undef PG8_STAGE
#undef PG8_LDA
#undef PG8_LDB
#undef PG8_MMA
#undef PG8_WAIT_V
#undef PG8_WAIT_L
#undef PG8_BAR
#undef PG8_SCHED
}
}

constexpr int BATCH = 8, SEQ = 4096, DM = 1024, MTOK = BATCH * SEQ;
constexpr int NMEM = 256, MMEM = BATCH * NMEM;
constexpr int AW = 512, HD = 64, NH = 8, IH = 4, TOPK = 256;
constexpr int INC = 1988, INP = 2048;
constexpr int DFF = 2816;
constexpr float EPS = 1e-6f;
#define LAS __attribute__((address_space(3)))
typedef unsigned short bf16_t;
typedef float f32x4 __attribute__((ext_vector_type(4)));
typedef unsigned u32x4 __attribute__((ext_vector_type(4)));
typedef unsigned u32x2 __attribute__((ext_vector_type(2)));

__device__ __forceinline__ float bf2f(bf16_t v) { return __uint_as_float((unsigned)v << 16); }
__device__ __forceinline__ bf16_t f2bf(float f) { unsigned u = __float_as_uint(f); return (bf16_t)((u + 0x7fffu + ((u >> 16) & 1u)) >> 16); }
__device__ __forceinline__ float shx(float v, int lane, int o) { return __uint_as_float((unsigned)__builtin_amdgcn_ds_bpermute((lane ^ o) << 2, (int)__float_as_uint(v))); }
__device__ __forceinline__ float wave_sum_l(float v, int lane) {
#pragma unroll
    for (int o = 1; o < 64; o <<= 1) v += shx(v, lane, o);
    return v;
}
__device__ __forceinline__ float wave_sum(float v) {
#pragma unroll
    for (int o = 1; o < 64; o <<= 1) v += __shfl_xor(v, o);
    return v;
}
__device__ __forceinline__ float wave_max(float v) {
#pragma unroll
    for (int o = 1; o < 64; o <<= 1) v = fmaxf(v, __shfl_xor(v, o));
    return v;
}
__device__ __forceinline__ float silu_f(float v) { return v * __builtin_amdgcn_rcpf(1.f + __expf(-v)); }

struct EpiStore {
    static constexpr bool PERM = false, AFTER_DRAIN = false;
    float* outf; bf16_t* outb; const float* res; int ldc;
    __device__ __forceinline__ void operator()(const pg8::f32x4 (&acc)[2][2][4][2], const pg8::Unit& u, int wr, int wc, int fr, int fq) const {
        const int col0 = u.pn * 256 + wc * 32 + 4 * fq;
#pragma unroll
        for (int ai = 0; ai < 2; ++ai)
#pragma unroll
            for (int m = 0; m < 4; ++m) {
                const size_t row = (size_t)(u.pm * 256 + ai * 128 + wr * 64 + m * 16 + fr);
#pragma unroll
                for (int bj = 0; bj < 2; ++bj)
#pragma unroll
                    for (int n = 0; n < 2; ++n) {
                        const size_t off = row * ldc + col0 + bj * 128 + n * 16;
                        pg8::f32x4 v = acc[ai][bj][m][n];
                        if (res) { const pg8::f32x4 r = *(const pg8::f32x4*)(res + off); v = v + r; }
                        if (outf) *(pg8::f32x4*)(outf + off) = v;
                        if (outb) { u32x2 w; w.x = (unsigned)f2bf(v[0]) | ((unsigned)f2bf(v[1]) << 16); w.y = (unsigned)f2bf(v[2]) | ((unsigned)f2bf(v[3]) << 16); *(u32x2*)(outb + off) = w; }
                    }
            }
    }
};
#define XB_TMO      128
#define XB_XCNT(j)  (256  + 64 * (j))
#define XB_XSUB(j)  (1280 + 64 * (j))
#define XB_XGEN(j)  (2304 + 64 * (j))
#define XB_TOP      3328
#define XB_TOPGEN   3392
#define XCD_BAR_WORDS 3456
#define XB_SPIN_CAP (1u << 18)

__device__ __forceinline__ unsigned xb_ld(unsigned* p)              { return __hip_atomic_load(p, __ATOMIC_RELAXED, __HIP_MEMORY_SCOPE_AGENT); }
__device__ __forceinline__ unsigned xb_add(unsigned* p, unsigned v) { return __hip_atomic_fetch_add(p, v, __ATOMIC_RELAXED, __HIP_MEMORY_SCOPE_AGENT); }
__device__ __forceinline__ unsigned xb_xcc_id() { return (unsigned)__builtin_amdgcn_s_getreg((3 << 11) | 20) & 0xFu; }
#define XB_SPIN(cond, bar) do { unsigned _sp = 0; while (cond) { __builtin_amdgcn_s_sleep(1); \
    if ((++_sp & 255u) == 0u) { if (xb_ld(&(bar)[XB_TMO])) break; if (_sp > XB_SPIN_CAP) { atomicAdd(&(bar)[XB_TMO], 1u); break; } } } } while (0)

struct XcdBarrier {
    unsigned* bar; unsigned x;
    volatile LAS unsigned* st;
};

__device__ __forceinline__ XcdBarrier xcd_barrier_post(unsigned* bar, volatile LAS unsigned* st) {
    XcdBarrier b; b.bar = bar; b.x = xb_xcc_id(); b.st = st;
    if (threadIdx.x == 0) (void)xb_add(&bar[XB_XCNT(b.x)], 1u);
    return b;
}
__device__ __forceinline__ void xcd_barrier_complete(unsigned* bar, unsigned x, unsigned& nloc, unsigned& nx) {
    const unsigned G = gridDim.x * gridDim.y * gridDim.z;
    unsigned sum, cnt, mine, sp = 0u;
    for (;;) {
        sum = 0u; cnt = 0u; mine = 0u;
#pragma unroll
        for (unsigned j = 0; j < 16; ++j) { const unsigned c = xb_ld(&bar[XB_XCNT(j)]); sum += c; cnt += (c > 0u) ? 1u : 0u; mine = (j == x) ? c : mine; }
        if (sum == G) break;
        __builtin_amdgcn_s_sleep(1);
        if ((++sp & 255u) == 0u) { if (xb_ld(&bar[XB_TMO])) break; if (sp > XB_SPIN_CAP) { atomicAdd(&bar[XB_TMO], 1u); break; } }
    }
    nloc = mine > 0u ? mine : 1u; nx = cnt > 0u ? cnt : 1u;
}

__device__ __forceinline__ void xcd_barrier(const XcdBarrier& b) {
    asm volatile("s_waitcnt vmcnt(0)" ::: "memory");
    __syncthreads();
    if (threadIdx.x == 0) {
        unsigned* bar = b.bar;
        __builtin_amdgcn_s_waitcnt(0);
        unsigned nloc = b.st[0], nx = b.st[1];
        if (nloc == 0u) { xcd_barrier_complete(bar, b.x, nloc, nx); b.st[0] = nloc; b.st[1] = nx; }
        const unsigned old = xb_add(&bar[XB_XSUB(b.x)], 1u);
        const unsigned gen = old / nloc;
        if (old + 1u == (gen + 1u) * nloc) {
            __builtin_amdgcn_fence(__ATOMIC_RELEASE, "agent");
            asm volatile("s_waitcnt vmcnt(0)" ::: "memory");
            const unsigned og = xb_add(&bar[XB_TOP], 1u);
            const unsigned tg = og / nx;
            if (og + 1u == (tg + 1u) * nx) xb_add(&bar[XB_TOPGEN], 1u);
            else XB_SPIN(xb_ld(&bar[XB_TOPGEN]) == tg, bar);
            __builtin_amdgcn_fence(__ATOMIC_ACQUIRE, "agent");
            xb_add(&bar[XB_XGEN(b.x)], 1u);
            asm volatile("s_waitcnt vmcnt(0)" ::: "memory");
        } else {
            XB_SPIN(xb_ld(&bar[XB_XGEN(b.x)]) == gen, bar);
            __builtin_amdgcn_fence(__ATOMIC_ACQUIRE, "agent");
            asm volatile("s_waitcnt vmcnt(0)" ::: "memory");
        }
    }
    __syncthreads();
}

__device__ __forceinline__ u32x4 pack8(const pg8::f32x4 a, const pg8::f32x4 b) {
    u32x4 w; w.x = pg8::cvt_pk_bf16(a[0], a[1]); w.y = pg8::cvt_pk_bf16(a[2], a[3]); w.z = pg8::cvt_pk_bf16(b[0], b[1]); w.w = pg8::cvt_pk_bf16(b[2], b[3]); return w;
}
__device__ __forceinline__ u32x2 pack8_fp8(const pg8::f32x4 a, const pg8::f32x4 b) {
    int lo = __builtin_amdgcn_cvt_pk_fp8_f32(a[0], a[1], 0, false); lo = __builtin_amdgcn_cvt_pk_fp8_f32(a[2], a[3], lo, true);
    int hi = __builtin_amdgcn_cvt_pk_fp8_f32(b[0], b[1], 0, false); hi = __builtin_amdgcn_cvt_pk_fp8_f32(b[2], b[3], hi, true);
    return (u32x2){(unsigned)lo, (unsigned)hi};
}
__device__ __forceinline__ float sigmoid_f(float v) { return __builtin_amdgcn_rcpf(1.f + __expf(-v)); }
__host__ __device__ __forceinline__ int dperm(int pos) { return pos < 16 ? (4 * (pos >> 3) + (pos & 3) + 8 * ((pos >> 2) & 1)) : pos; }
__host__ __device__ __forceinline__ int in_orig_col(int n) {
    if (n < 512) return (n & ~63) + dperm(n & 63);
    if (n < 576) return 512 + dperm(n - 512);
    if (n < 640) return 576 + (n - 576);
    if (n < 704) return 896 + dperm(n - 640);
    if (n < 708) return 960 + (n - 704);
    if (n < 768) return -1;
    if (n < 1024) return 640 + ((n - 768) & ~63) + dperm((n - 768) & 63);
    const int i = (n - 1024) >> 8, c = (n - 1024) & 255;
    return c < 128 ? 964 + 128 * i + c : 1476 + 128 * i + (c - 128);
}
struct EpiIn {
    static constexpr bool PERM = true, AFTER_DRAIN = false;
    const float* cs; bf16_t *Q, *K, *V, *QI, *KI, *U; float* WI;
    __device__ __forceinline__ void operator()(const pg8::f32x4 (&acc)[2][2][4][2], const pg8::Unit& u, int wr, int wc, int fr, int fq) const {
        const int pn = u.pn;
        if (pn >= 4) {
            const int ch = 128 * (pn - 4) + 32 * wc + 8 * fq;
#pragma unroll
            for (int ai = 0; ai < 2; ++ai)
#pragma unroll
                for (int m = 0; m < 4; ++m) { const size_t row = (size_t)(u.pm * 256 + ai * 128 + wr * 64 + m * 16 + fr);
                    pg8::f32x4 a0 = acc[ai][0][m][0], a1 = acc[ai][0][m][1]; const pg8::f32x4 g0 = acc[ai][1][m][0], g1 = acc[ai][1][m][1];
#pragma unroll
                    for (int k = 0; k < 4; ++k) { a0[k] *= sigmoid_f(g0[k]); a1[k] *= sigmoid_f(g1[k]); }
                    *(u32x4*)(U + row * 512 + ch) = pack8(a0, a1); }
            return;
        }
        const bool rot = (pn == 2) ? (wc == 0 && fq < 2) : ((wc & 1) == 0 && fq < 2);
#pragma unroll
        for (int ai = 0; ai < 2; ++ai)
#pragma unroll
            for (int m = 0; m < 4; ++m) { const size_t row = (size_t)(u.pm * 256 + ai * 128 + wr * 64 + m * 16 + fr);
                pg8::f32x4 cv = {1.f, 1.f, 1.f, 1.f}, sv = {0.f, 0.f, 0.f, 0.f};
                if (rot) { cv = *(const pg8::f32x4*)(cs + row * 16 + 4 * fq); sv = *(const pg8::f32x4*)(cs + row * 16 + 8 + 4 * fq); }
#pragma unroll
                for (int bj = 0; bj < 2; ++bj) {
                    const pg8::f32x4 v0 = acc[ai][bj][m][0], v1 = acc[ai][bj][m][1];
                    pg8::f32x4 n0 = v0 * cv - v1 * sv, n1 = v1 * cv + v0 * sv;
                    if (!rot) { n0 = v0; n1 = v1; }
                    const int c = 128 * bj + 32 * wc + 8 * fq;
                    if (pn < 2) *(u32x4*)(Q + row * 512 + 256 * pn + c) = pack8(n0, n1);
                    else if (pn == 3) *(u32x4*)(QI + row * 256 + c) = pack8(n0 * 0.125f, n1 * 0.125f);
                    else {
                        if (bj == 0) {
                            if (wc < 2) *(u32x2*)((unsigned char*)K + row * 64 + 16 * fq + 8 * wc) = pack8_fp8(n0, n1); else *(u32x2*)((unsigned char*)V + row * 64 + 32 * (wc - 2) + 8 * fq) = pack8_fp8(v0, v1); }
                        else { if (wc < 2) *(u32x4*)(KI + row * 64 + 32 * wc + 8 * fq) = pack8(n0, n1); else if (wc == 2 && fq == 0) *(pg8::f32x4*)(WI + row * 4) = v0 * 0.5f; }
                    }
                }
            }
    }
};
struct EpiRes {
    static constexpr bool PERM = true, AFTER_DRAIN = false;
    const float* resf; const bf16_t* resb; float* outf; bf16_t* xb; float* ss;
    __device__ __forceinline__ void operator()(const pg8::f32x4 (&acc)[2][2][4][2], const pg8::Unit& u, int wr, int wc, int fr, int fq) const {
#pragma unroll
        for (int ai = 0; ai < 2; ++ai)
#pragma unroll
            for (int m = 0; m < 4; ++m) { const size_t row = (size_t)(u.pm * 256 + ai * 128 + wr * 64 + m * 16 + fr); float q = 0.f;
#pragma unroll
                for (int bj = 0; bj < 2; ++bj) { const size_t off = row * DM + u.pn * 256 + 128 * bj + 32 * wc + 8 * fq;
                    pg8::f32x4 r0, r1;
                    if (resf) { r0 = *(const pg8::f32x4*)(resf + off); r1 = *(const pg8::f32x4*)(resf + off + 4); }
                    else { const u32x4 rb = *(const u32x4*)(resb + off);
                        r0 = (pg8::f32x4){__uint_as_float(rb.x << 16), __uint_as_float(rb.x & 0xffff0000u), __uint_as_float(rb.y << 16), __uint_as_float(rb.y & 0xffff0000u)};
                        r1 = (pg8::f32x4){__uint_as_float(rb.z << 16), __uint_as_float(rb.z & 0xffff0000u), __uint_as_float(rb.w << 16), __uint_as_float(rb.w & 0xffff0000u)}; }
                    const pg8::f32x4 v0 = acc[ai][bj][m][0] + r0, v1 = acc[ai][bj][m][1] + r1;
                    if (outf) { *(pg8::f32x4*)(outf + off) = v0; *(pg8::f32x4*)(outf + off + 4) = v1; }
                    if (xb) *(u32x4*)(xb + off) = pack8(v0, v1);
                    q += (v0[0] * v0[0] + v0[1] * v0[1]) + (v0[2] * v0[2] + v0[3] * v0[3]) + (v1[0] * v1[0] + v1[1] * v1[1]) + (v1[2] * v1[2] + v1[3] * v1[3]); }
                { const int lane_ = fq * 16 + fr; q += shx(q, lane_, 16); q += shx(q, lane_, 32); }
                if (fq == 0) ss[row * 16 + u.pn * 4 + wc] = q; }
    }
};
__device__ __forceinline__ float rstd_from_ss(const float* ss, size_t row) {
    const pg8::f32x4 a = *(const pg8::f32x4*)(ss + row * 16), b = *(const pg8::f32x4*)(ss + row * 16 + 4), c = *(const pg8::f32x4*)(ss + row * 16 + 8), d = *(const pg8::f32x4*)(ss + row * 16 + 12);
    const float s = ((a[0] + a[1]) + (a[2] + a[3])) + ((b[0] + b[1]) + (b[2] + b[3])) + ((c[0] + c[1]) + (c[2] + c[3])) + ((d[0] + d[1]) + (d[2] + d[3]));
    return __builtin_amdgcn_rsqf(s * (1.f / DM) + EPS);
}
struct EpiScale {
    static constexpr bool PERM = true, AFTER_DRAIN = false;
    const float* ss; bf16_t* O; int ldc; float scale;
    __device__ __forceinline__ void operator()(const pg8::f32x4 (&acc)[2][2][4][2], const pg8::Unit& u, int wr, int wc, int fr, int fq) const {
#pragma unroll
        for (int ai = 0; ai < 2; ++ai)
#pragma unroll
            for (int m = 0; m < 4; ++m) { const size_t row = (size_t)(u.pm * 256 + ai * 128 + wr * 64 + m * 16 + fr); const float r = rstd_from_ss(ss, row) * scale;
#pragma unroll
                for (int bj = 0; bj < 2; ++bj) *(u32x4*)(O + row * ldc + u.pn * 256 + 128 * bj + 32 * wc + 8 * fq) = pack8(acc[ai][bj][m][0] * r, acc[ai][bj][m][1] * r); }
    }
};
struct EpiGateUp {
    static constexpr bool PERM = true, AFTER_DRAIN = false;
    const float* ss; bf16_t* Gb; bf16_t* Ub;
    __device__ __forceinline__ void operator()(const pg8::f32x4 (&acc)[2][2][4][2], const pg8::Unit& u, int wr, int wc, int fr, int fq) const {
        const int ch = 128 * u.pn + 32 * wc + 8 * fq;
#pragma unroll
        for (int ai = 0; ai < 2; ++ai)
#pragma unroll
            for (int m = 0; m < 4; ++m) { const size_t row = (size_t)(u.pm * 256 + ai * 128 + wr * 64 + m * 16 + fr); const float r = rstd_from_ss(ss, row);
                *(u32x4*)(Gb + row * DFF + ch) = pack8(acc[ai][0][m][0] * r, acc[ai][0][m][1] * r);
                *(u32x4*)(Ub + row * DFF + ch) = pack8(acc[ai][1][m][0] * r, acc[ai][1][m][1] * r); }
    }
};
struct EpiGateUpAct {
    static constexpr bool PERM = true, AFTER_DRAIN = false;
    const float* ss; bf16_t* H; const float* cw; const float* cb; float* topg; float* topu; float* botg; LAS unsigned char* xch;
    __device__ __forceinline__ void operator()(const pg8::f32x4 (&acc)[2][2][4][2], const pg8::Unit& u, int wr, int wc, int fr, int fq) const {
        const int lane = fq * 16 + fr, chl = 32 * wc + 8 * fq, ch = 128 * u.pn + chl;
        const int l1 = (fq * 16 + ((fr + 15) & 15)) << 2, l2 = (fq * 16 + ((fr + 14) & 15)) << 2;
        (void)lane;
#pragma unroll
        for (int ai = 0; ai < 2; ++ai) { const size_t row = (size_t)(u.pm * 256 + ai * 128 + wr * 64 + 48 + fr); const float r = rstd_from_ss(ss, row);
            if (fr >= 14) { LAS float* p = (LAS float*)xch + ((2 * ai + wr) * 2 + (fr - 14)) * 128 + chl;
                *(LAS pg8::f32x4*)p = acc[ai][0][3][0] * r; *(LAS pg8::f32x4*)(p + 4) = acc[ai][0][3][1] * r; } }
        asm volatile("s_waitcnt lgkmcnt(0)" ::: "memory"); __builtin_amdgcn_s_barrier(); asm volatile("" ::: "memory");
        pg8::f32x4 wb[2], w2[2], w1[2], w0[2];
#pragma unroll
        for (int hq = 0; hq < 2; ++hq) { wb[hq] = *(const pg8::f32x4*)(cb + ch + 4 * hq); w2[hq] = *(const pg8::f32x4*)(cw + 2 * DFF + ch + 4 * hq); w1[hq] = *(const pg8::f32x4*)(cw + DFF + ch + 4 * hq); w0[hq] = *(const pg8::f32x4*)(cw + ch + 4 * hq); }
#pragma unroll
        for (int ai = 0; ai < 2; ++ai) {
            const int blk = 2 * ai + wr;
            pg8::f32x4 pv[2] = {{0.f, 0.f, 0.f, 0.f}, {0.f, 0.f, 0.f, 0.f}};
            if (blk > 0 && fr >= 14) { const LAS float* p = (const LAS float*)xch + ((blk - 1) * 2 + (fr - 14)) * 128 + chl; pv[0] = *(const LAS pg8::f32x4*)p; pv[1] = *(const LAS pg8::f32x4*)(p + 4); }
#pragma unroll
            for (int m = 0; m < 4; ++m) { const size_t row = (size_t)(u.pm * 256 + ai * 128 + wr * 64 + m * 16 + fr); const float r = rstd_from_ss(ss, row);
                pg8::f32x4 g[2], uu[2], hh[2];
#pragma unroll
                for (int hq = 0; hq < 2; ++hq) { g[hq] = acc[ai][0][m][hq] * r; uu[hq] = acc[ai][1][m][hq] * r; }
#pragma unroll
                for (int hq = 0; hq < 2; ++hq)
#pragma unroll
                    for (int k = 0; k < 4; ++k) {
                        const float x1 = (fr == 15) ? pv[hq][k] : g[hq][k], x2 = (fr >= 14) ? pv[hq][k] : g[hq][k];
                        const float p1 = __uint_as_float((unsigned)__builtin_amdgcn_ds_bpermute(l1, (int)__float_as_uint(x1)));
                        const float p2 = __uint_as_float((unsigned)__builtin_amdgcn_ds_bpermute(l2, (int)__float_as_uint(x2)));
                        const float gg = wb[hq][k] + w2[hq][k] * g[hq][k] + w1[hq][k] * p1 + w0[hq][k] * p2;
                        hh[hq][k] = gg * __builtin_amdgcn_rcpf(1.f + __expf(-gg)) * uu[hq][k]; }
                *(u32x4*)(H + row * DFF + ch) = pack8(hh[0], hh[1]);
                if (blk == 0 && m == 0 && fr < 2) { float* tg = topg + ((size_t)u.pm * 2 + fr) * DFF + ch; float* tu = topu + ((size_t)u.pm * 2 + fr) * DFF + ch;
                    *(pg8::f32x4*)tg = g[0]; *(pg8::f32x4*)(tg + 4) = g[1]; *(pg8::f32x4*)tu = uu[0]; *(pg8::f32x4*)(tu + 4) = uu[1]; }
                if (blk == 3 && m == 3 && fr >= 14) { float* bg = botg + ((size_t)u.pm * 2 + (fr - 14)) * DFF + ch; *(pg8::f32x4*)bg = g[0]; *(pg8::f32x4*)(bg + 4) = g[1]; }
                pv[0] = g[0]; pv[1] = g[1];
            }
        }
    }
};
typedef short bf16x8v __attribute__((ext_vector_type(8)));
constexpr int CA_STRIDE = 528;
__device__ __forceinline__ void cross_attn_unit(LAS unsigned char* lds, int b, int h, int qb, const bf16_t* QC, const bf16_t* KC, const bf16_t* VT, bf16_t* OC, int tid, int lane, int wave) {
    const int q16 = lane & 15, g = lane >> 4;
    const size_t row0 = (size_t)b * SEQ + (size_t)qb * 256 + wave * 32;
    asm volatile("" : "+v"(tid));
    { const bf16_t* src = KC + ((size_t)b * NMEM + (tid >> 5)) * DM + h * 256 + (tid & 31) * 8; LAS unsigned char* dst = lds + (tid >> 5) * CA_STRIDE + (tid & 31) * 16;
#pragma unroll
      for (int i = 0; i < 16; ++i) { const u32x4 v = *(const u32x4*)(src + (size_t)i * 16 * DM); *(LAS u32x4*)(dst + i * 16 * CA_STRIDE) = v; } }
    __syncthreads();
    f32x4 S[2][16];
#pragma unroll
    for (int st = 0; st < 2; ++st)
#pragma unroll
        for (int kt = 0; kt < 16; ++kt) S[st][kt] = (f32x4){0.f, 0.f, 0.f, 0.f};
#pragma unroll 1
    for (int kh = 0; kh < 2; ++kh) {
        bf16x8v qf[2][4];
#pragma unroll
        for (int st = 0; st < 2; ++st)
#pragma unroll
            for (int ks = 0; ks < 4; ++ks) qf[st][ks] = *(const bf16x8v*)(QC + (row0 + st * 16 + q16) * DM + h * 256 + kh * 128 + ks * 32 + g * 8);
        const LAS unsigned char* kb = lds + q16 * CA_STRIDE + kh * 256 + g * 16;
#pragma unroll
        for (int kt = 0; kt < 16; ++kt)
#pragma unroll
            for (int ks = 0; ks < 4; ++ks) { const bf16x8v a = *(const LAS bf16x8v*)(kb + kt * 16 * CA_STRIDE + ks * 64);
                S[0][kt] = __builtin_amdgcn_mfma_f32_16x16x32_bf16(a, qf[0][ks], S[0][kt], 0, 0, 0);
                S[1][kt] = __builtin_amdgcn_mfma_f32_16x16x32_bf16(a, qf[1][ks], S[1][kt], 0, 0, 0); }
    }
    const float c2 = 0.0625f * 1.4426950408889634f;
    float linv[2]; bf16x8v P[2][8];
#pragma unroll
    for (int st = 0; st < 2; ++st) {
        float m = -INFINITY;
#pragma unroll
        for (int kt = 0; kt < 16; ++kt) m = fmaxf(fmaxf(fmaxf(S[st][kt][0], S[st][kt][1]), fmaxf(S[st][kt][2], S[st][kt][3])), m);
        m = fmaxf(m, shx(m, lane, 16)); m = fmaxf(m, shx(m, lane, 32));
        const float mc = m * c2; float l = 0.f;
#pragma unroll
        for (int kt = 0; kt < 16; ++kt)
#pragma unroll
            for (int r = 0; r < 4; ++r) { const float p = __builtin_amdgcn_exp2f(S[st][kt][r] * c2 - mc); S[st][kt][r] = p; l += p; }
        l += shx(l, lane, 16); l += shx(l, lane, 32); linv[st] = 1.f / l;
#pragma unroll
        for (int c = 0; c < 8; ++c) { bf16x8v pk;
#pragma unroll
            for (int j = 0; j < 4; ++j) { pk[j] = (short)f2bf(S[st][2 * c][j]); pk[4 + j] = (short)f2bf(S[st][2 * c + 1][j]); }
            P[st][c] = pk; }
    }
    __syncthreads();
    { int tid2 = tid; asm volatile("" : "+v"(tid2));
      const bf16_t* src = VT + (size_t)(h * 256 + (tid2 >> 5)) * MMEM + b * NMEM + (tid2 & 31) * 8; LAS unsigned char* dst = lds + (tid2 >> 5) * CA_STRIDE + (tid2 & 31) * 16;
#pragma unroll
      for (int i = 0; i < 16; ++i) { const u32x4 v = *(const u32x4*)(src + (size_t)i * 16 * MMEM); *(LAS u32x4*)(dst + i * 16 * CA_STRIDE) = v; } }
    __syncthreads();
#pragma unroll 1
    for (int dh = 0; dh < 2; ++dh) {
        f32x4 O[2][8];
#pragma unroll
        for (int st = 0; st < 2; ++st)
#pragma unroll
            for (int dt = 0; dt < 8; ++dt) O[st][dt] = (f32x4){0.f, 0.f, 0.f, 0.f};
        const LAS unsigned char* pb = lds + (dh * 128 + q16) * CA_STRIDE + g * 8;
#pragma unroll
        for (int dt = 0; dt < 8; ++dt)
#pragma unroll
            for (int c = 0; c < 8; ++c) { const LAS unsigned char* p = pb + dt * 16 * CA_STRIDE + c * 64;
                const u32x2 lo = *(const LAS u32x2*)p, hi = *(const LAS u32x2*)(p + 32);
                const u32x4 av = (u32x4){lo.x, lo.y, hi.x, hi.y}; const bf16x8v a = __builtin_bit_cast(bf16x8v, av);
                O[0][dt] = __builtin_amdgcn_mfma_f32_16x16x32_bf16(a, P[0][c], O[0][dt], 0, 0, 0);
                O[1][dt] = __builtin_amdgcn_mfma_f32_16x16x32_bf16(a, P[1][c], O[1][dt], 0, 0, 0); }
#pragma unroll
        for (int st = 0; st < 2; ++st)
#pragma unroll
            for (int dt = 0; dt < 8; ++dt) { const f32x4 o = O[st][dt] * linv[st]; u32x2 w;
                w.x = (unsigned)f2bf(o[0]) | ((unsigned)f2bf(o[1]) << 16); w.y = (unsigned)f2bf(o[2]) | ((unsigned)f2bf(o[3]) << 16);
                *(u32x2*)(OC + (row0 + st * 16 + q16) * DM + h * 256 + dh * 128 + dt * 16 + g * 4) = w; }
    }
    __syncthreads();
}
typedef float f32x16v __attribute__((ext_vector_type(16)));
constexpr int TK_HIST_OFF = 131072;
__device__ __forceinline__ unsigned code16(float s) {
    const _Float16 hf = (_Float16)s; unsigned u = (unsigned)__builtin_bit_cast(unsigned short, hf);
    if ((u & 0x7fffu) == 0u) u = 0u;
    return (u & 0x8000u) ? (~u & 0xffffu) : (u | 0x8000u);
}
__device__ __forceinline__ unsigned mbcnt64(unsigned long long m) { return __builtin_amdgcn_mbcnt_hi((unsigned)(m >> 32), __builtin_amdgcn_mbcnt_lo((unsigned)m, 0u)); }
__device__ __forceinline__ void lds_hist_add(LAS unsigned char* hrow, unsigned bin) {
    __hip_atomic_fetch_add((LAS unsigned*)(hrow + ((bin & 127u) << 2)), (bin & 128u) ? 0x10000u : 1u, __ATOMIC_RELAXED, __HIP_MEMORY_SCOPE_WORKGROUP);
}
__device__ __forceinline__ void hist_select(const LAS unsigned char* hrow, unsigned target, int lane, unsigned& B, unsigned& above) {
    const u32x4 hv = *(const LAS u32x4*)(hrow + (lane & 31) * 16);
    const unsigned sh = (lane & 32) ? 16u : 0u;
    const unsigned h0 = (hv.x >> sh) & 0xffffu, h1 = (hv.y >> sh) & 0xffffu, h2 = (hv.z >> sh) & 0xffffu, h3 = (hv.w >> sh) & 0xffffu;
    const unsigned s = (h0 + h1) + (h2 + h3); unsigned S = s;
#pragma unroll
    for (int o = 1; o < 64; o <<= 1) { const unsigned v = (unsigned)__builtin_amdgcn_ds_bpermute(((lane + o) & 63) << 2, (int)S); if (lane + o < 64) S += v; }
    const unsigned long long mk = __ballot(S >= target);
    const int lb = 63 - __builtin_clzll(mk);
    const unsigned A = S - s, c3 = A + h3, c2 = c3 + h2, c1 = c2 + h1;
    const unsigned bsel = (c3 >= target) ? 3u : (c2 >= target) ? 2u : (c1 >= target) ? 1u : 0u;
    const unsigned asel = (c3 >= target) ? A : (c2 >= target) ? c3 : (c1 >= target) ? c2 : c1;
    B = 4u * (unsigned)lb + (unsigned)__builtin_amdgcn_readlane((int)bsel, lb);
    above = (unsigned)__builtin_amdgcn_readlane((int)asel, lb);
}
__device__ __forceinline__ void topk_unit(LAS unsigned char* lds, int b, int j, const bf16_t* QI, const bf16_t* KI, const float* WI, unsigned short* SEL, int tid, int lane, int wave) {
    asm volatile("" : "+v"(tid), "+v"(lane));
    const int t0 = 16 * j, L = t0 + 16, nkt = (L + 31) >> 5;
    const size_t rowbase = (size_t)b * SEQ + t0;
    const int c32 = lane & 31, hi = lane >> 5;
    *(LAS u32x4*)(lds + TK_HIST_OFF + tid * 16) = (u32x4){0u, 0u, 0u, 0u};
    __syncthreads();
    {
        bf16x8v qa[2][4]; f32x4 wq[2][4];
#pragma unroll
        for (int rt = 0; rt < 2; ++rt) {
#pragma unroll
            for (int ks = 0; ks < 4; ++ks) qa[rt][ks] = *(const bf16x8v*)(QI + (rowbase + 8 * rt + (c32 >> 2)) * 256 + (c32 & 3) * 64 + 16 * ks + 8 * hi);
#pragma unroll
            for (int gq = 0; gq < 4; ++gq) wq[rt][gq] = *(const f32x4*)(WI + (rowbase + 8 * rt + 2 * gq + hi) * 4);
        }
        const bf16_t* kbase = KI + ((size_t)b * SEQ + c32) * 64 + 8 * hi;
        bf16x8v kb[4], kn[4];
        int kt = wave;
        if (kt < nkt) {
#pragma unroll
            for (int ks = 0; ks < 4; ++ks) kb[ks] = *(const bf16x8v*)(kbase + (size_t)kt * 32 * 64 + 16 * ks);
        }
        for (; kt < nkt; kt += 8) {
            const int ktn = (kt + 8 < nkt) ? kt + 8 : kt;
#pragma unroll
            for (int ks = 0; ks < 4; ++ks) kn[ks] = *(const bf16x8v*)(kbase + (size_t)ktn * 32 * 64 + 16 * ks);
            const int key = kt * 32 + c32;
#pragma unroll
            for (int rt = 0; rt < 2; ++rt) {
                f32x16v c = {0.f, 0.f, 0.f, 0.f, 0.f, 0.f, 0.f, 0.f, 0.f, 0.f, 0.f, 0.f, 0.f, 0.f, 0.f, 0.f};
#pragma unroll
                for (int ks = 0; ks < 4; ++ks) c = __builtin_amdgcn_mfma_f32_32x32x16_bf16(qa[rt][ks], kb[ks], c, 0, 0, 0);
#pragma unroll
                for (int gq = 0; gq < 4; ++gq) {
                    const f32x4 w = wq[rt][gq];
                    const float sc = w[0] * fmaxf(c[4 * gq + 0], 0.f) + w[1] * fmaxf(c[4 * gq + 1], 0.f) + w[2] * fmaxf(c[4 * gq + 2], 0.f) + w[3] * fmaxf(c[4 * gq + 3], 0.f);
                    const int q = 8 * rt + 2 * gq + hi; const unsigned code = code16(sc);
                    *(LAS unsigned short*)(lds + q * 8192 + key * 2) = (unsigned short)code;
                    if (key <= t0 + q) lds_hist_add(lds + TK_HIST_OFF + q * 512, code >> 8);
                }
            }
#pragma unroll
            for (int ks = 0; ks < 4; ++ks) kb[ks] = kn[ks];
        }
    }
    __syncthreads();
#pragma unroll 1
    for (int qq = 0; qq < 2; ++qq) {
        const int q = 2 * wave + qq, t = t0 + q, n = t + 1;
        unsigned short* sel = SEL + (rowbase + q) * TOPK;
        if (n <= TOPK) {
#pragma unroll
            for (int i = 0; i < 4; ++i) { const int s = lane + 64 * i; if (s < n) sel[s] = (unsigned short)s; }
            continue;
        }
        const int nch = (n + 127) >> 7;
        LAS unsigned char* hrow = lds + TK_HIST_OFF + q * 512;
        const LAS unsigned* row = (const LAS unsigned*)(lds + q * 8192) + lane;
        unsigned B, above;
        hist_select(hrow, (unsigned)TOPK, lane, B, above);
        *(LAS u32x2*)(hrow + lane * 8) = (u32x2){0u, 0u};
        asm volatile("s_waitcnt lgkmcnt(0)" ::: "memory");
#pragma unroll 4
        for (int c = 0; c < nch; ++c) { const unsigned v = row[64 * c]; const int i0 = 128 * c + 2 * lane;
            const unsigned lo = v & 0xffffu, hi16 = v >> 16;
            if (i0 <= t && (lo >> 8) == B) lds_hist_add(hrow, lo & 255u);
            if (i0 + 1 <= t && (hi16 >> 8) == B) lds_hist_add(hrow, hi16 & 255u); }
        asm volatile("s_waitcnt lgkmcnt(0)" ::: "memory");
        unsigned b2, above2;
        hist_select(hrow, (unsigned)TOPK - above, lane, b2, above2);
        const unsigned T = (B << 8) | b2, cgt = above + above2, need = (unsigned)TOPK - cgt;
        unsigned eqrun = 0u, selrun = 0u;
#pragma unroll 2
        for (int c = 0; c < nch; ++c) { const unsigned v = row[64 * c]; const int i0 = 128 * c + 2 * lane;
            const unsigned lo = (i0 <= t) ? (v & 0xffffu) : 0u, hi16 = (i0 + 1 <= t) ? (v >> 16) : 0u;
            const bool glo = lo > T, ghi = hi16 > T;
            const unsigned long long mglo = __ballot(glo), mghi = __ballot(ghi);
            const unsigned plo = selrun + mbcnt64(mglo), phi = selrun + (unsigned)__popcll(mglo) + mbcnt64(mghi);
            if (glo) sel[plo] = (unsigned short)i0;
            if (ghi) sel[phi] = (unsigned short)(i0 + 1);
            selrun += (unsigned)__popcll(mglo) + (unsigned)__popcll(mghi);
            const bool elo = lo == T, ehi = hi16 == T;
            const unsigned long long melo = __ballot(elo), mehi = __ballot(ehi);
            if ((melo | mehi) != 0ull) {
                const unsigned rlo = eqrun + mbcnt64(melo) + mbcnt64(mehi), rhi = rlo + (elo ? 1u : 0u);
                if (elo && rlo < need) sel[cgt + rlo] = (unsigned short)i0;
                if (ehi && rhi < need) sel[cgt + rhi] = (unsigned short)(i0 + 1);
                eqrun += (unsigned)__popcll(melo) + (unsigned)__popcll(mehi);
            }
        }
    }
    __syncthreads();
}
__device__ __forceinline__ void topk_phase(LAS unsigned char* lds, int G, int vcu, const bf16_t* QI, const bf16_t* KI, const float* WI, unsigned short* SEL, int tid, int lane, int wave) {
    if (G == 256) {
        const int b = vcu >> 5, i = vcu & 31;
#pragma unroll 1
        for (int k = 0; k < 8; ++k) { const int j = 64 * (k >> 1) + ((k & 1) ? 63 - i : i); topk_unit(lds, b, j, QI, KI, WI, SEL, tid, lane, wave); }
    } else {
#pragma unroll 1
        for (int u = vcu; u < BATCH * 256; u += G) topk_unit(lds, u >> 8, u & 255, QI, KI, WI, SEL, tid, lane, wave);
    }
}
typedef short v4i16_t __attribute__((ext_vector_type(4)));
constexpr int SV_STRIDE = 160, SV_TILE_BYTES = 64 * SV_STRIDE, SV_WAVE_BYTES = SV_TILE_BYTES + 1024;
__device__ __forceinline__ v4i16_t tr_read16(const LAS unsigned char* p) { return __builtin_amdgcn_ds_read_tr16_b64_v4i16((LAS v4i16_t*)p); }
#define SP_FENCE() asm volatile("" ::: "memory")
typedef __bf16 bf16x2_t __attribute__((ext_vector_type(2)));
__device__ __forceinline__ bf16x8v fp8x8_to_bf16(unsigned a, unsigned b) {
    u32x4 r; r.x = __builtin_bit_cast(unsigned, __builtin_amdgcn_cvt_scalef32_pk_bf16_fp8(a, 1.0f, false)); r.y = __builtin_bit_cast(unsigned, __builtin_amdgcn_cvt_scalef32_pk_bf16_fp8(a, 1.0f, true));
    r.z = __builtin_bit_cast(unsigned, __builtin_amdgcn_cvt_scalef32_pk_bf16_fp8(b, 1.0f, false)); r.w = __builtin_bit_cast(unsigned, __builtin_amdgcn_cvt_scalef32_pk_bf16_fp8(b, 1.0f, true));
    return __builtin_bit_cast(bf16x8v, r);
}
__device__ __forceinline__ void sparse_attn_phase(LAS unsigned char* lds, int G, int vcu, const bf16_t* Q, const bf16_t* Kb, const bf16_t* Vb, const unsigned short* SEL, bf16_t* MIX, int lane, int wave) {
    asm volatile("" : "+v"(lane));
    LAS unsigned char* wl = lds + wave * SV_WAVE_BYTES;
    const int nq = (G == 256) ? 16 : (MTOK - (vcu * 8 + wave) + G * 8 - 1) / (G * 8);
    const int r_first = (G == 256) ? (vcu >> 5) * SEQ + (vcu & 31) * 8 + wave : vcu * 8 + wave, r_step = (G == 256) ? 256 : G * 8;
    const float c2 = 0.125f * 1.4426950408889634f;
    if (nq <= 0) { __syncthreads(); return; }
#define SP_LOAD_Q(QF, ROW) do { _Pragma("unroll") for (int ks = 0; ks < 2; ++ks) { u32x4 v_ = (u32x4){0u, 0u, 0u, 0u}; if (q16 < 8) v_ = *(const u32x4*)(Q + (ROW) * 512 + q16 * 64 + ks * 32 + g * 8); QF[ks] = __builtin_bit_cast(bf16x8v, v_); } } while (0)
#define SP_LOAD_K(KF, IB, NV, KBAT, SLOT0, I0, I1) do { _Pragma("unroll") for (int i = (I0); i < (I1); ++i) { const int slot_ = (SLOT0) + 16 * i + q16; unsigned idx_ = *(const LAS unsigned short*)((IB) + slot_ * 2); if (slot_ >= (NV)) idx_ = 0u; \
        KF[i] = *(const u32x4*)((KBAT) + (size_t)idx_ * 64); } } while (0)
#define SP_LOAD_V(VV, IB, NV, VBAT, CC) do { _Pragma("unroll") for (int i = 0; i < 4; ++i) { const int slot_ = 64 * (CC) + (lane_i >> 2) + 16 * i; unsigned idx_ = *(const LAS unsigned short*)((IB) + slot_ * 2); if (slot_ >= (NV)) idx_ = 0u; VV[i] = *(const u32x4*)((VBAT) + (size_t)idx_ * 64); } } while (0)
#define SP_PV(VV, CC) do { _Pragma("unroll") for (int i = 0; i < 8; ++i) *(LAS u32x4*)(wdst + i * 8 * SV_STRIDE) = VV[i]; \
        asm volatile("s_waitcnt lgkmcnt(0)" ::: "memory"); \
        _Pragma("unroll") for (int c2i = 0; c2i < 2; ++c2i) _Pragma("unroll") for (int dt = 0; dt < 4; ++dt) { const LAS unsigned char* p_ = rsrc + c2i * 32 * SV_STRIDE + dt * 32; \
            const v4i16_t lo_ = tr_read16(p_), hi_ = tr_read16(p_ + 16 * SV_STRIDE); const bf16x8v a_ = (bf16x8v){lo_[0], lo_[1], lo_[2], lo_[3], hi_[0], hi_[1], hi_[2], hi_[3]}; \
            O[dt] = __builtin_amdgcn_mfma_f32_16x16x32_bf16(a_, P[2 * (CC) + c2i], O[dt], 0, 0, 0); } \
        asm volatile("s_waitcnt lgkmcnt(0)" ::: "memory"); } while (0)
    u32x2 selv = *(const u32x2*)(SEL + (size_t)r_first * TOPK + 4 * lane);
    *(LAS u32x2*)(wl + SV_TILE_BYTES + lane * 8) = selv;
    if (nq > 1) selv = *(const u32x2*)(SEL + ((size_t)r_first + r_step) * TOPK + 4 * lane);
    asm volatile("s_waitcnt lgkmcnt(0)" ::: "memory");
    bf16x8v qf[2]; u32x4 kfA[8];
    { const int q16 = lane & 15, g = lane >> 4; const int t = r_first % SEQ, n = (t + 1 < TOPK) ? t + 1 : TOPK; const unsigned char* kbat = (const unsigned char*)Kb + (size_t)(r_first / SEQ) * SEQ * 64 + g * 16;
      SP_LOAD_Q(qf, (size_t)r_first); SP_LOAD_K(kfA, wl + SV_TILE_BYTES, n, kbat, 0, 0, 8); }
#pragma unroll 1
    for (int k = 0; k < nq; ++k) {
        int lane_i = lane; asm volatile("" : "+v"(lane_i));
        const int q16 = lane_i & 15, g = lane_i >> 4;
        LAS unsigned char* wdst = wl + (lane_i >> 2) * SV_STRIDE + (lane_i & 3) * 32;
        const LAS unsigned char* rsrc = wl + (4 * g + (q16 >> 2)) * SV_STRIDE + (q16 & 3) * 8;
        const size_t row = (size_t)r_first + (size_t)k * r_step; const int b = (int)(row / SEQ), t = (int)(row % SEQ);
        const int n = (t + 1 < TOPK) ? t + 1 : TOPK;
        const LAS unsigned char* ib = wl + SV_TILE_BYTES + (k & 1) * 512;
        const unsigned char* kbat = (const unsigned char*)Kb + (size_t)b * SEQ * 64 + g * 16;
        const unsigned char* vbat = (const unsigned char*)Vb + (size_t)b * SEQ * 64 + (lane_i & 3) * 16;
        f32x4 S[16];
        {
            u32x4 kfB[8];
            SP_LOAD_K(kfB, ib, n, kbat, 128, 0, 4);
            SP_FENCE();
#pragma unroll
            for (int i = 0; i < 8; ++i) { f32x4 c = (f32x4){0.f, 0.f, 0.f, 0.f};
                c = __builtin_amdgcn_mfma_f32_16x16x32_bf16(fp8x8_to_bf16(kfA[i].x, kfA[i].y), qf[0], c, 0, 0, 0);
                c = __builtin_amdgcn_mfma_f32_16x16x32_bf16(fp8x8_to_bf16(kfA[i].z, kfA[i].w), qf[1], c, 0, 0, 0); S[i] = c; }
            SP_FENCE();
            SP_LOAD_K(kfB, ib, n, kbat, 128, 4, 8);
            SP_FENCE();
#pragma unroll
            for (int i = 0; i < 8; ++i) { f32x4 c = (f32x4){0.f, 0.f, 0.f, 0.f};
                c = __builtin_amdgcn_mfma_f32_16x16x32_bf16(fp8x8_to_bf16(kfB[i].x, kfB[i].y), qf[0], c, 0, 0, 0);
                c = __builtin_amdgcn_mfma_f32_16x16x32_bf16(fp8x8_to_bf16(kfB[i].z, kfB[i].w), qf[1], c, 0, 0, 0); S[8 + i] = c; if (i == 3) SP_FENCE(); }
        }
        SP_FENCE();
        u32x4 vv0[4], vv1[4];
        SP_LOAD_V(vv0, ib, n, vbat, 0); SP_LOAD_V(vv1, ib, n, vbat, 1);
        if (k + 1 < nq) { *(LAS u32x2*)(wl + SV_TILE_BYTES + ((k + 1) & 1) * 512 + lane_i * 8) = selv; if (k + 2 < nq) selv = *(const u32x2*)(SEL + (row + 2 * (size_t)r_step) * TOPK + 4 * lane_i); }
        SP_FENCE();
        float m = -INFINITY;
#pragma unroll
        for (int kt = 0; kt < 16; ++kt)
#pragma unroll
            for (int r = 0; r < 4; ++r) { if (16 * kt + 4 * g + r >= n) S[kt][r] = -INFINITY; m = fmaxf(m, S[kt][r]); }
        m = fmaxf(m, shx(m, lane_i, 16)); m = fmaxf(m, shx(m, lane_i, 32));
        const float mc = m * c2; float l = 0.f;
#pragma unroll
        for (int kt = 0; kt < 16; ++kt)
#pragma unroll
            for (int r = 0; r < 4; ++r) { const float p = __builtin_amdgcn_exp2f(S[kt][r] * c2 - mc); S[kt][r] = p; l += p; }
        l += shx(l, lane_i, 16); l += shx(l, lane_i, 32);
        const float linv = __builtin_amdgcn_rcpf(l);
        bf16x8v P[8];
#pragma unroll
        for (int c = 0; c < 8; ++c) { u32x4 pk; pk.x = pg8::cvt_pk_bf16(S[2 * c][0], S[2 * c][1]); pk.y = pg8::cvt_pk_bf16(S[2 * c][2], S[2 * c][3]); pk.z = pg8::cvt_pk_bf16(S[2 * c + 1][0], S[2 * c + 1][1]); pk.w = pg8::cvt_pk_bf16(S[2 * c + 1][2], S[2 * c + 1][3]);
            P[c] = __builtin_bit_cast(bf16x8v, pk); asm volatile("" : "+v"(P[c])); }
        SP_FENCE();
        if (k + 1 < nq) { const size_t rown = row + r_step; const int tn = t + r_step, nn = (tn + 1 < TOPK) ? tn + 1 : TOPK;
            asm volatile("s_waitcnt lgkmcnt(0)" ::: "memory");
            SP_LOAD_Q(qf, rown); SP_LOAD_K(kfA, wl + SV_TILE_BYTES + ((k + 1) & 1) * 512, nn, kbat, 0, 0, 4); }
        SP_FENCE();
        f32x4 O[4];
#pragma unroll
        for (int dt = 0; dt < 4; ++dt) O[dt] = (f32x4){0.f, 0.f, 0.f, 0.f};
#define SP_STEP(VV, CC, NEXT) do { _Pragma("unroll") for (int i = 0; i < 4; ++i) { *(LAS bf16x8v*)(wdst + i * 16 * SV_STRIDE) = fp8x8_to_bf16(VV[i].x, VV[i].y); *(LAS bf16x8v*)(wdst + i * 16 * SV_STRIDE + 16) = fp8x8_to_bf16(VV[i].z, VV[i].w); } SP_FENCE(); NEXT; asm volatile("s_waitcnt lgkmcnt(0)" ::: "memory"); \
        _Pragma("unroll") for (int c2i = 0; c2i < 2; ++c2i) _Pragma("unroll") for (int dt = 0; dt < 4; ++dt) { const LAS unsigned char* p_ = rsrc + c2i * 32 * SV_STRIDE + dt * 32; \
            const v4i16_t lo_ = tr_read16(p_), hi_ = tr_read16(p_ + 16 * SV_STRIDE); const bf16x8v a_ = (bf16x8v){lo_[0], lo_[1], lo_[2], lo_[3], hi_[0], hi_[1], hi_[2], hi_[3]}; \
            O[dt] = __builtin_amdgcn_mfma_f32_16x16x32_bf16(a_, P[2 * (CC) + c2i], O[dt], 0, 0, 0); } \
        asm volatile("s_waitcnt lgkmcnt(0)" ::: "memory"); SP_FENCE(); } while (0)
        SP_STEP(vv0, 0, SP_LOAD_V(vv0, ib, n, vbat, 2));
        SP_STEP(vv1, 1, SP_LOAD_V(vv1, ib, n, vbat, 3));
        SP_STEP(vv0, 2, (void)0);
        if (k + 1 < nq) { const int tn = t + r_step, nn = (tn + 1 < TOPK) ? tn + 1 : TOPK; SP_LOAD_K(kfA, wl + SV_TILE_BYTES + ((k + 1) & 1) * 512, nn, kbat, 0, 4, 8); }
        SP_FENCE();
        SP_STEP(vv1, 3, (void)0);
#undef SP_STEP
        if (q16 < 8) {
#pragma unroll
            for (int dt = 0; dt < 4; ++dt) { const f32x4 o = O[dt] * linv; u32x2 w;
                w.x = pg8::cvt_pk_bf16(o[0], o[1]); w.y = pg8::cvt_pk_bf16(o[2], o[3]);
                *(u32x2*)(MIX + row * DM + q16 * 64 + dt * 16 + g * 4) = w; }
        }
    }
#undef SP_LOAD_Q
#undef SP_LOAD_K
#undef SP_LOAD_V
#undef SP_PV
    __syncthreads();
}
__device__ __forceinline__ void convb_phase(LAS unsigned char* lds, int G, int vcu, const bf16_t* U, const float* __restrict__ cw, const float* __restrict__ cb, const float* __restrict__ lng, const float* __restrict__ lnb, bf16_t* MIX, int tid, int lane, int wave) {
    asm volatile("" : "+v"(tid), "+v"(lane));
    typedef float f32x2v __attribute__((ext_vector_type(2)));
    const int cp = tid & 255, th = tid >> 8;
    f32x2v w[31];
#pragma unroll
    for (int j = 0; j < 31; ++j) w[j] = *(const f32x2v*)(cw + j * 512 + 2 * cp);
    const f32x2v bias = *(const f32x2v*)(cb + 2 * cp), gam = *(const f32x2v*)(lng + 2 * cp), bet = *(const f32x2v*)(lnb + 2 * cp);
    LAS float* red = (LAS float*)(lds + 65536);
#pragma unroll 1
    for (int tile = vcu; tile < MTOK / 32; tile += G) {
        const int row0 = tile * 32, t0 = row0 & (SEQ - 1);
        for (int i = tid; i < 62 * 64; i += 512) { const int r = i >> 6, ch = i & 63; u32x4 v = (u32x4){0u, 0u, 0u, 0u};
            if (t0 - 30 + r >= 0) v = *(const u32x4*)(U + (size_t)(row0 - 30 + r) * 512 + ch * 8);
            *(LAS u32x4*)(lds + r * 1024 + ch * 16) = v; }
        __syncthreads();
        f32x2v y[2][8];
#pragma unroll
        for (int k = 0; k < 2; ++k) {
            const int tg = th + 2 * k;
            f32x2v acc[8];
#pragma unroll
            for (int o = 0; o < 8; ++o) acc[o] = bias;
            const LAS unsigned* wp = (const LAS unsigned*)(lds + tg * 8 * 1024) + cp;
#pragma unroll
            for (int j = 0; j < 38; ++j) { const unsigned uu = wp[j * 256]; const f32x2v uv = (f32x2v){__uint_as_float(uu << 16), __uint_as_float(uu & 0xffff0000u)};
#pragma unroll
                for (int o = 0; o < 8; ++o) { const int tap = j - o; if (tap >= 0 && tap < 31) acc[o] += w[tap] * uv; } }
#pragma unroll
            for (int o = 0; o < 8; ++o) { y[k][o] = acc[o];
                float s = acc[o].x + acc[o].y, q = acc[o].x * acc[o].x + acc[o].y * acc[o].y;
                s = wave_sum_l(s, lane); q = wave_sum_l(q, lane);
                if (lane == 0) { red[((tg * 8 + o) * 4 + (wave & 3)) * 2] = s; red[((tg * 8 + o) * 4 + (wave & 3)) * 2 + 1] = q; } }
        }
        __syncthreads();
#pragma unroll
        for (int k = 0; k < 2; ++k) {
            const int tg = th + 2 * k;
#pragma unroll
            for (int o = 0; o < 8; ++o) { const int tl = tg * 8 + o;
                const f32x4 ra = *(const LAS f32x4*)(red + tl * 8), rb = *(const LAS f32x4*)(red + tl * 8 + 4);
                const float mu = ((ra[0] + ra[2]) + (rb[0] + rb[2])) * (1.f / 512.f), ex2 = ((ra[1] + ra[3]) + (rb[1] + rb[3])) * (1.f / 512.f);
                const float rstd = 1.f / sqrtf(fmaxf(ex2 - mu * mu, 0.f) + EPS);
                const float v0 = (y[k][o].x - mu) * rstd * gam.x + bet.x, v1 = (y[k][o].y - mu) * rstd * gam.y + bet.y;
                *(unsigned*)(MIX + (size_t)(row0 + tl) * DM + 512 + 2 * cp) = (unsigned)f2bf(silu_f(v0)) | ((unsigned)f2bf(silu_f(v1)) << 16); }
        }
        __syncthreads();
    }
}

__device__ __forceinline__ int wt_dst_row(int mode, int c) {
    if (mode == 0) return c;
    if (mode == 2) return 256 * (c >> 7) + (c & 127);
    if (mode == 3) return 256 * (c >> 7) + 128 + (c & 127);
    if (c < 512) return (c & ~63) + dperm(c & 63);
    if (c < 576) return 512 + dperm(c - 512);
    if (c < 640) return c;
    if (c < 896) return 768 + ((c - 640) & ~63) + dperm((c - 640) & 63);
    if (c < 960) return 640 + dperm(c - 896);
    if (c < 964) return 704 + (c - 960);
    if (c < 1476) { const int j = c - 964; return 1024 + 256 * (j >> 7) + (j & 127); }
    { const int j = c - 1476; return 1024 + 256 * (j >> 7) + 128 + (j & 127); }
}
__device__ __forceinline__ void wt_body(LAS unsigned char* sm, int vb, int tid, const float* __restrict__ W, int K, int N, bf16_t* WT, const float* __restrict__ gain, int mode) {
    LAS float* t = (LAS float*)sm;
    const int nbx = (N + 31) / 32; const int k0 = (vb / nbx) * 32, n0 = (vb % nbx) * 32, tx = tid & 31, ty = tid >> 5;
    for (int i = ty; i < 32; i += 8) { const int k = k0 + i, n = n0 + tx; float v = 0.f; if (k < K && n < N) { v = W[(size_t)k * N + n]; if (gain) v *= gain[k]; } t[i * 33 + tx] = v; }
    __syncthreads();
    for (int i = ty; i < 32; i += 8) { const int n = n0 + i, k = k0 + tx; if (n < N && k < K) WT[(size_t)wt_dst_row(mode, n) * K + k] = f2bf(t[tx * 33 + i]); }
    __syncthreads();
}
__device__ __forceinline__ void rmsnorm_bf16_row(const float* x, const float* __restrict__ g, bf16_t* out, int row, int lane) {
    const f32x4* xr = (const f32x4*)(x + (size_t)row * DM) + lane; const f32x4* gr = (const f32x4*)g + lane;
    f32x4 v[4]; float s = 0.f;
#pragma unroll
    for (int j = 0; j < 4; ++j) { v[j] = xr[64 * j]; s += (v[j].x * v[j].x + v[j].y * v[j].y) + (v[j].z * v[j].z + v[j].w * v[j].w); }
    const float rstd = 1.f / sqrtf(wave_sum_l(s, lane) * (1.f / DM) + EPS);
    u32x2* o = (u32x2*)(out + (size_t)row * DM) + lane;
#pragma unroll
    for (int j = 0; j < 4; ++j) { const f32x4 gg = gr[64 * j]; u32x2 w;
        w.x = (unsigned)f2bf(v[j].x * rstd * gg.x) | ((unsigned)f2bf(v[j].y * rstd * gg.y) << 16);
        w.y = (unsigned)f2bf(v[j].z * rstd * gg.z) | ((unsigned)f2bf(v[j].w * rstd * gg.w) << 16); o[64 * j] = w; }
}
__device__ __forceinline__ void rmsnorm_f32_row(float* x, const float* __restrict__ g, int row, int lane) {
    f32x4* xr = (f32x4*)(x + (size_t)row * DM) + lane; const f32x4* gr = (const f32x4*)g + lane;
    f32x4 v[4]; float s = 0.f;
#pragma unroll
    for (int j = 0; j < 4; ++j) { v[j] = xr[64 * j]; s += (v[j].x * v[j].x + v[j].y * v[j].y) + (v[j].z * v[j].z + v[j].w * v[j].w); }
    const float rstd = 1.f / sqrtf(wave_sum_l(s, lane) * (1.f / DM) + EPS);
#pragma unroll
    for (int j = 0; j < 4; ++j) { const f32x4 gg = gr[64 * j]; xr[64 * j] = v[j] * rstd * gg; }
}

__device__ __forceinline__ void wt_item(const float* __restrict__ W, int K, int N, bf16_t* WT, const float* __restrict__ gain, int mode, LAS float* scr, int item, int lane) {
    const int nblk = (N + 31) / 32, kb = item / nblk, nb = item - kb * nblk, k0 = 64 * kb, n0 = 32 * nb;
    const int nn = n0 + (lane & 31);
    float wv[32];
#pragma unroll
    for (int i = 0; i < 32; ++i) { const int kk = 2 * i + (lane >> 5); wv[i] = 0.f; if (nn < N) wv[i] = W[(size_t)(k0 + kk) * N + nn]; }
#pragma unroll
    for (int i = 0; i < 32; ++i) { const int kk = 2 * i + (lane >> 5); float v = wv[i]; if (gain) v *= gain[k0 + kk]; scr[kk * 33 + (lane & 31)] = v; }
    asm volatile("s_waitcnt lgkmcnt(0)" ::: "memory");
    const int c = lane & 7;
#pragma unroll
    for (int j = 0; j < 4; ++j) { const int n = (lane >> 3) + 8 * j; const LAS float* s = scr + (8 * c) * 33 + n;
        u32x4 o; o.x = pg8::cvt_pk_bf16(s[0 * 33], s[1 * 33]); o.y = pg8::cvt_pk_bf16(s[2 * 33], s[3 * 33]); o.z = pg8::cvt_pk_bf16(s[4 * 33], s[5 * 33]); o.w = pg8::cvt_pk_bf16(s[6 * 33], s[7 * 33]);
        if (n0 + n < N) *(u32x4*)(WT + (size_t)wt_dst_row(mode, n0 + n) * K + k0 + 8 * c) = o; }
    asm volatile("s_waitcnt lgkmcnt(0)" ::: "memory");
}

__device__ __forceinline__ void rmsnorm_bf16_2rows(const float* x, const float* __restrict__ g, bf16_t* out, int row, int lane) {
    const f32x4* xr = (const f32x4*)(x + (size_t)row * DM) + lane; const f32x4* gr = (const f32x4*)g + lane;
    f32x4 v[2][4]; float s[2] = {0.f, 0.f};
#pragma unroll
    for (int r = 0; r < 2; ++r)
#pragma unroll
        for (int j = 0; j < 4; ++j) v[r][j] = xr[r * (DM / 4) + 64 * j];
#pragma unroll
    for (int r = 0; r < 2; ++r)
#pragma unroll
        for (int j = 0; j < 4; ++j) s[r] += (v[r][j].x * v[r][j].x + v[r][j].y * v[r][j].y) + (v[r][j].z * v[r][j].z + v[r][j].w * v[r][j].w);
#pragma unroll
    for (int r = 0; r < 2; ++r) { const float rstd = 1.f / sqrtf(wave_sum_l(s[r], lane) * (1.f / DM) + EPS);
        u32x2* o = (u32x2*)(out + (size_t)(row + r) * DM) + lane;
#pragma unroll
        for (int j = 0; j < 4; ++j) { const f32x4 gg = gr[64 * j]; u32x2 w;
            w.x = pg8::cvt_pk_bf16(v[r][j].x * rstd * gg.x, v[r][j].y * rstd * gg.y); w.y = pg8::cvt_pk_bf16(v[r][j].z * rstd * gg.z, v[r][j].w * rstd * gg.w); o[64 * j] = w; } }
}

constexpr size_t MiB = 1u << 20;
constexpr int LDS_USER = 139264, LDSCTL_OFF = LDS_USER, MISC_OFF = LDSCTL_OFF + 320, LDS_BYTES = 147456;
constexpr size_t WS_CTL = 476 * MiB, CTL_ZERO_BYTES = 1 * MiB; constexpr int CW_BAR = 4096;
constexpr int NGU = 2 * DFF;
struct Args { const float* in[23]; float* out; unsigned char* ws; };
static_assert(sizeof(Args) == 25 * 8, "Args has no padding");

__global__ void __launch_bounds__(512, 2) mega_k(Args a) {
    extern __shared__ __attribute__((aligned(16))) unsigned char lds_raw[];
    LAS unsigned char* lds = (LAS unsigned char*)lds_raw;
    const int wave = __builtin_amdgcn_readfirstlane(threadIdx.x >> 6);
#define PH_IDS() int lane; asm volatile("v_mbcnt_lo_u32_b32 %0, -1, 0\n\tv_mbcnt_hi_u32_b32 %0, -1, %0" : "=v"(lane)); const int tid = wave * 64 + lane, half = wave >> 2, htid = tid & 255; LAS unsigned char* hsm = lds + half * 65536; (void)htid; (void)hsm
    const int G = gridDim.x, bx = blockIdx.x; const int vcu = (G % 8 == 0) ? (bx % 8) * (G / 8) + bx / 8 : bx;
    const float* x = a.in[0]; const float* mem = a.in[1]; const int* positions = (const int*)a.in[2];
    const float* g_mix = a.in[3]; const float* w_in = a.in[4]; const float* w_out = a.in[5];
    const float* conv_b_w = a.in[6]; const float* conv_b_b = a.in[7]; const float* ln_b_g = a.in[8]; const float* ln_b_b = a.in[9];
    const float* g_cross = a.in[10]; const float* g_mem = a.in[11];
    const float* w_q = a.in[12]; const float* w_k = a.in[13]; const float* w_v = a.in[14]; const float* w_o = a.in[15];
    const float* g_ffn = a.in[16]; const float* w_gate = a.in[17]; const float* w_up = a.in[18];
    const float* ffn_cw = a.in[19]; const float* ffn_cb = a.in[20]; const float* w_down = a.in[21]; const float* g_final = a.in[22];
    float* out = a.out; unsigned char* ws = a.ws;
    bf16_t* wt_in = (bf16_t*)(ws + 0 * MiB); bf16_t* wt_out = (bf16_t*)(ws + 4 * MiB);
    bf16_t* wt_q = (bf16_t*)(ws + 6 * MiB), *wt_k = (bf16_t*)(ws + 8 * MiB), *wt_v = (bf16_t*)(ws + 10 * MiB), *wt_o = (bf16_t*)(ws + 12 * MiB);
    bf16_t* wt_gu = (bf16_t*)(ws + 14 * MiB); bf16_t* wt_down = (bf16_t*)(ws + 26 * MiB);
    float* WI = (float*)(ws + 32 * MiB); float* CS = (float*)(ws + 33 * MiB);
    float* SS1 = (float*)(ws + 35 * MiB); float* SS2 = (float*)(ws + 37 * MiB); float* SS3 = (float*)(ws + 39 * MiB);
    bf16_t* MEMN = (bf16_t*)(ws + 41 * MiB), *KC = (bf16_t*)(ws + 45 * MiB), *VC = (bf16_t*)(ws + 49 * MiB);
    bf16_t* XB = (bf16_t*)(ws + 56 * MiB);
    bf16_t* Qb = (bf16_t*)(ws + 120 * MiB); bf16_t* QI = (bf16_t*)(ws + 152 * MiB);
    bf16_t* Kb = (bf16_t*)(ws + 168 * MiB), *Vb = (bf16_t*)(ws + 172 * MiB), *KI = (bf16_t*)(ws + 176 * MiB);
    bf16_t* U = (bf16_t*)(ws + 180 * MiB); unsigned short* SEL = (unsigned short*)(ws + 212 * MiB);
    bf16_t* MIX = (bf16_t*)(ws + 228 * MiB); bf16_t* QC = (bf16_t*)(ws + 292 * MiB); bf16_t* OC = (bf16_t*)(ws + 356 * MiB);
    bf16_t* Hb = (bf16_t*)(ws + 120 * MiB);
    float* TOPG = (float*)(ws + 300 * MiB); float* TOPU = (float*)(ws + 304 * MiB); float* BOTG = (float*)(ws + 308 * MiB);
    unsigned* ctl = (unsigned*)(ws + WS_CTL);

    { PH_IDS(); for (int u = tid; u < (LDS_BYTES - LDSCTL_OFF) / 4; u += 512) ((LAS unsigned*)(lds + LDSCTL_OFF))[u] = 0u; }
    __syncthreads();
    XcdBarrier bar = xcd_barrier_post(ctl + CW_BAR, (volatile LAS unsigned*)(lds + MISC_OFF) + 8);
#define GRID_BAR() xcd_barrier(bar)
#define FOR_VB(nvb) for (int vb = 2 * bx + half; vb < (nvb); vb += 2 * G)
#define GEMMX(EPI, EINIT, Aptr, Bptr, Mv, Nv, Kv) do { pg8::Gemm g_{Aptr, Bptr, Mv, Nv, Kv}; pg8::StaticOrder S_; S_.init(Mv, Nv, G, bx); EPI E_ EINIT; \
        PH_IDS(); pg8::gemm_phase<EPI, pg8::StaticOrder, true, true>(lds, g_, S_, E_, tid); } while (0)
#define EI(...) {__VA_ARGS__}

    { PH_IDS();
    for (int i = bx * 512 + tid; i < 60 * DM; i += G * 512) wt_in[(size_t)708 * DM + i] = 0;
    { LAS float* scr = (LAS float*)(lds + wave * 8704); const int gw = vcu * 8 + wave, NGW = G * 8;
      constexpr int I_IN = 16 * 63, I_SQ = 16 * 32, NIT = I_IN + 2 * I_SQ;
#pragma unroll 1
      for (int it = gw; it < NIT; it += NGW) { int r = it;
          if (r < I_IN) { wt_item(w_in, DM, INC, wt_in, nullptr, 1, scr, r, lane); continue; } r -= I_IN;
          if (r < I_SQ) { wt_item(w_k, DM, DM, wt_k, nullptr, 0, scr, r, lane); continue; } r -= I_SQ;
          wt_item(w_v, DM, DM, wt_v, nullptr, 0, scr, r, lane); } }
    for (int i = bx * 512 + tid; i < MTOK * 8; i += G * 512) { const int row = i >> 3, k = i & 7;
        const float fr8[8] = {1.000000000e+00f, 1.939227432e-01f, 3.760603070e-02f, 7.292664610e-03f, 1.414213562e-03f, 2.742481884e-04f, 5.318295734e-05f, 1.031338525e-05f};
        float freq = fr8[0];
#pragma unroll
        for (int kk = 1; kk < 8; ++kk) freq = (k == kk) ? fr8[kk] : freq;
        const float ang = (float)positions[row] * freq;
        CS[(size_t)row * 16 + k] = (float)cos((double)ang); CS[(size_t)row * 16 + 8 + k] = (float)sin((double)ang); }
    for (int r = 2 * (bx * 8 + wave); r < MTOK; r += G * 16) rmsnorm_bf16_2rows(x, g_mix, XB, r, lane);
    for (int r = bx * 8 + wave; r < MMEM; r += G * 8) rmsnorm_bf16_row(mem, g_mem, MEMN, r, lane);
    }
    GRID_BAR();
    GEMMX(EpiIn, EI(CS, Qb, Kb, Vb, QI, KI, U, WI), XB, wt_in, MTOK, INP, DM);
    GEMMX(EpiStore, EI(nullptr, KC, nullptr, DM), MEMN, wt_k, MMEM, DM, DM);
    { pg8::Gemm g_{wt_v, MEMN, DM, MMEM, DM}; pg8::StaticOrder S_; S_.init(DM, MMEM, G, (bx + G - 32) % G); EpiStore E_{nullptr, VC, nullptr, MMEM};
      PH_IDS(); pg8::gemm_phase<EpiStore, pg8::StaticOrder, true, true>(lds, g_, S_, E_, tid); }
    if (bx >= 64 || G < 128) { PH_IDS(); LAS float* scr = (LAS float*)(lds + wave * 8704);
      const int nb = (G < 128) ? G : G - 64, gw = ((G < 128) ? bx : bx - 64) * 8 + wave, NGW = nb * 8;
      constexpr int I_SQ = 16 * 32, I_FF = 16 * 88, I_DN = 44 * 32, NIT = 3 * I_SQ + 2 * I_FF + I_DN;
#pragma unroll 1
      for (int it = gw; it < NIT; it += NGW) { int r = it;
          if (r < I_SQ) { wt_item(w_out, DM, DM, wt_out, nullptr, 0, scr, r, lane); continue; } r -= I_SQ;
          if (r < I_SQ) { wt_item(w_q, DM, DM, wt_q, g_cross, 0, scr, r, lane); continue; } r -= I_SQ;
          if (r < I_SQ) { wt_item(w_o, DM, DM, wt_o, nullptr, 0, scr, r, lane); continue; } r -= I_SQ;
          if (r < I_FF) { wt_item(w_gate, DM, DFF, wt_gu, g_ffn, 2, scr, r, lane); continue; } r -= I_FF;
          if (r < I_FF) { wt_item(w_up, DM, DFF, wt_gu, g_ffn, 3, scr, r, lane); continue; } r -= I_FF;
          wt_item(w_down, DFF, DM, wt_down, nullptr, 0, scr, r, lane); } }
    GRID_BAR();
    { PH_IDS(); topk_phase(lds, G, vcu, QI, KI, WI, SEL, tid, lane, wave); }
    { PH_IDS(); convb_phase(lds, G, vcu, U, conv_b_w, conv_b_b, ln_b_g, ln_b_b, MIX, tid, lane, wave); }
    GRID_BAR();
    { PH_IDS(); sparse_attn_phase(lds, G, vcu, Qb, Kb, Vb, SEL, MIX, lane, wave); }
    GRID_BAR();
    GEMMX(EpiRes, EI(x, nullptr, nullptr, XB, SS1), MIX, wt_out, MTOK, DM, DM);
    GRID_BAR();
    GEMMX(EpiScale, EI(SS1, QC, DM, 1.0f), XB, wt_q, MTOK, DM, DM);
    GRID_BAR();
    { PH_IDS(); const int per = (512 + G - 1) / G; for (int i = 0; i < per; ++i) { const int u = vcu * per + i; if (u < 512) cross_attn_unit(lds, u >> 6, (u >> 4) & 3, u & 15, QC, KC, VC, OC, tid, lane, wave); } }
    GRID_BAR();
    GEMMX(EpiRes, EI(nullptr, XB, nullptr, XB, SS2), OC, wt_o, MTOK, DM, DM);
    GRID_BAR();
    GEMMX(EpiGateUpAct, EI(SS2, Hb, ffn_cw, ffn_cb, TOPG, TOPU, BOTG, lds + 131072), XB, wt_gu, MTOK, NGU, DM);
    GRID_BAR();
    { PH_IDS();
    for (int i = bx * 512 + tid; i < (MTOK / 256) * 2 * DFF; i += G * 512) {
        const int pm = i / (2 * DFF), rem = i - pm * (2 * DFF), j = rem / DFF, c = rem - j * DFF;
        const bool first = (pm & 15) == 0;
        const float gm2 = first ? 0.f : BOTG[((size_t)(pm - 1) * 2 + 0) * DFF + c], gm1 = first ? 0.f : BOTG[((size_t)(pm - 1) * 2 + 1) * DFF + c];
        const float g0 = TOPG[((size_t)pm * 2 + 0) * DFF + c], g1 = TOPG[((size_t)pm * 2 + 1) * DFF + c];
        const float cur = j ? g1 : g0, p1 = j ? g0 : gm1, p2 = j ? gm1 : gm2;
        const float gg = ffn_cb[c] + ffn_cw[2 * DFF + c] * cur + ffn_cw[DFF + c] * p1 + ffn_cw[c] * p2;
        Hb[((size_t)pm * 256 + j) * DFF + c] = f2bf(silu_f(gg) * TOPU[((size_t)pm * 2 + j) * DFF + c]);
    }
    }
    GRID_BAR();
    GEMMX(EpiRes, EI(nullptr, XB, nullptr, XB, SS3), Hb, wt_down, MTOK, DM, DFF);
    GRID_BAR();
    { PH_IDS();
    for (int r = bx * 8 + wave; r < MTOK; r += G * 8) {
        const float rs = rstd_from_ss(SS3, (size_t)r);
        const u32x4* xr = (const u32x4*)(XB + (size_t)r * DM) + lane; f32x4* orow = (f32x4*)(out + (size_t)r * DM); const f32x4* gr = (const f32x4*)g_final;
#pragma unroll
        for (int j = 0; j < 2; ++j) { const u32x4 v = xr[64 * j]; const int c4 = (64 * j + lane) * 2;
            const f32x4 a = (f32x4){__uint_as_float(v.x << 16), __uint_as_float(v.x & 0xffff0000u), __uint_as_float(v.y << 16), __uint_as_float(v.y & 0xffff0000u)};
            const f32x4 bq = (f32x4){__uint_as_float(v.z << 16), __uint_as_float(v.z & 0xffff0000u), __uint_as_float(v.w << 16), __uint_as_float(v.w & 0xffff0000u)};
            orow[c4] = a * rs * gr[c4]; orow[c4 + 1] = bq * rs * gr[c4 + 1]; }
    }
    }
}

extern "C" void kernel_launch(void* const* d_in, const int* in_sizes, int n_in, void* d_out, int out_size, void* d_ws, size_t ws_size, hipStream_t stream) {
    static int grid = 0;
    if (grid == 0) {
        int dev = 0, cus = 0, per_cu = 0;
        if (hipGetDevice(&dev) != hipSuccess || hipDeviceGetAttribute(&cus, hipDeviceAttributeMultiprocessorCount, dev) != hipSuccess) { fprintf(stderr, "kernel_launch: device query failed\n"); grid = -1; return; }
        if (hipFuncSetAttribute((const void*)mega_k, hipFuncAttributeMaxDynamicSharedMemorySize, LDS_BYTES) != hipSuccess) { fprintf(stderr, "kernel_launch: hipFuncSetAttribute failed\n"); grid = -1; return; }
        if (hipOccupancyMaxActiveBlocksPerMultiprocessor(&per_cu, (const void*)mega_k, 512, LDS_BYTES) != hipSuccess || per_cu < 1) { fprintf(stderr, "kernel_launch: occupancy query says %d\n", per_cu); per_cu = 1; }
        (void)hipGetLastError();
        grid = cus * 1;
        if (n_in != 23 || ws_size < 477 * MiB) { fprintf(stderr, "kernel_launch: unexpected n_in %d / ws %zu\n", n_in, ws_size); grid = -1; return; }
    }
    if (grid < 0) return;
    (void)hipMemsetAsync((char*)d_ws + WS_CTL, 0, CTL_ZERO_BYTES, stream);
    Args a{};
    for (int i = 0; i < 23; ++i) a.in[i] = (const float*)d_in[i];
    a.out = (float*)d_out; a.ws = (unsigned char*)d_ws;
    void* params[] = {&a};
    hipError_t e = hipLaunchCooperativeKernel((const void*)mega_k, dim3(grid), dim3(512), params, LDS_BYTES, stream);
    if (e != hipSuccess) fprintf(stderr, "cooperative launch failed: %s (grid %d)\n", hipGetErrorString(e), grid);
}
```
